# Optimizing an MI355X kernel written in HIP

```python
import jax, jax.numpy as jnp
from jax import lax
import numpy as np

D_MODEL = 1024
BATCH = 4
SEQ = 4096
DEPTH = 2

CTX_LEN = 256
GRID_W = 64
ROPE_BASE = 10000.0
NORM_EPS = 1e-6

D_RNN = D_MODEL
LRU_BLOCKS = 8
LRU_BLOCK_W = D_RNN // LRU_BLOCKS
CONV_W = 4
CONV_PAD_L = 2
CONV_PAD_R = 1
LRU_C = 8.0

D_RET = D_MODEL
RET_HEADS = 4
RET_HEAD_DIM = D_RET // RET_HEADS
RET_CHUNK = 128

MLA_HEADS = 8
MLA_NOPE = 128
MLA_ROPE = 64
MLA_V = 128
D_MLA = MLA_HEADS * MLA_V
Q_LORA = 384
KV_LORA = 256
MLA_SCALE = (MLA_NOPE + MLA_ROPE) ** -0.5
Q_BLOCK = 128

N_BRANCH = 3
IN_SPLITS = (D_RNN, D_RNN, D_RET, D_RET, D_RET, D_RET, Q_LORA, KV_LORA, MLA_ROPE, D_MLA, N_BRANCH * D_MODEL)
IN_COLS = sum(IN_SPLITS)

kernel_name = 'hybrid_lru_retention_mla_prefix_dit'


def _rms(x, gain):
    xf = x.astype(jnp.float32)
    y = xf * lax.rsqrt(jnp.mean(xf * xf, axis=-1, keepdims=True) + NORM_EPS)
    return (y * gain.astype(jnp.float32)).astype(x.dtype)


def _split_cols(p):
    idx, acc = [], 0
    for s in IN_SPLITS[:-1]:
        acc += s
        idx.append(acc)
    return jnp.split(p, idx, axis=-1)


def _flip(t, rev, axis=1):
    return jnp.flip(t, axis=axis) if rev else t


def _axial_rope_tables(n_tokens, dim):
    rows = n_tokens // GRID_W
    row = jnp.repeat(jnp.arange(rows), GRID_W).astype(jnp.float32)
    col = jnp.tile(jnp.arange(GRID_W), rows).astype(jnp.float32)
    n_freq = dim // 4
    inv = ROPE_BASE ** (-jnp.arange(n_freq, dtype=jnp.float32) / n_freq)
    ang_r = row[:, None] * inv[None, :]
    ang_c = col[:, None] * inv[None, :]
    ang = jnp.concatenate([ang_r, ang_r, ang_c, ang_c], axis=-1)
    return jnp.cos(ang), jnp.sin(ang)


def _rope(x, cos, sin):
    q = x.shape[-1] // 4
    x1, x2, x3, x4 = x[..., :q], x[..., q:2 * q], x[..., 2 * q:3 * q], x[..., 3 * q:]
    rot = jnp.concatenate([-x2, x1, -x4, x3], axis=-1)
    return (x * cos + rot * sin).astype(x.dtype)


def _dwconv(u, w, b):
    T = u.shape[1]
    up = jnp.pad(u, ((0, 0), (CONV_PAD_L, CONV_PAD_R), (0, 0)))
    out = up[:, 0:T] * w[0]
    for j in range(1, CONV_W):
        out = out + up[:, j:j + T] * w[j]
    return out + b


def _lru_coeffs(u, wa, ba, wx, bx, lam):
    B, T, _ = u.shape
    ub = u.reshape(B, T, LRU_BLOCKS, LRU_BLOCK_W)
    r = jax.nn.sigmoid(jnp.einsum('btnc,ncd->btnd', ub, wa).reshape(B, T, D_RNN) + ba)
    i = jax.nn.sigmoid(jnp.einsum('btnc,ncd->btnd', ub, wx).reshape(B, T, D_RNN) + bx)
    log_a = -LRU_C * r * jax.nn.softplus(-lam.astype(jnp.float32))
    a = jnp.exp(log_a)
    b = jnp.sqrt(-jnp.expm1(2.0 * log_a)) * (i * u)
    return a, b


def _linear_scan(a, b, h0):
    def comb(l, r):
        return (l[0] * r[0], r[0] * l[1] + r[1])
    a_cum, h = lax.associative_scan(comb, (a, b), axis=1)
    return h + a_cum * h0[:, None, :]


def _rglru_branch(xa, xa_c, conv_w, conv_b, wa, ba, wx, bx, lam, with_ctx):
    u = _dwconv(xa.astype(jnp.float32), conv_w, conv_b)
    uc = _dwconv(xa_c.astype(jnp.float32), conv_w, conv_b)
    h_sum = jnp.zeros_like(u)
    hc_parts = []
    for d in range(2):
        rev = d == 1
        a, b = _lru_coeffs(u, wa[d], ba[d], wx[d], bx[d], lam[d])
        ac, bc = _lru_coeffs(uc, wa[d], ba[d], wx[d], bx[d], lam[d])
        hc = _linear_scan(_flip(ac, rev), _flip(bc, rev), jnp.zeros_like(uc[:, 0]))
        h = _linear_scan(_flip(a, rev), _flip(b, rev), hc[:, -1])
        h_sum = h_sum + _flip(h, rev)
        if with_ctx:
            hc_parts.append(_flip(hc, rev))
    y = h_sum.astype(xa.dtype)
    yc = (hc_parts[0] + hc_parts[1]).astype(xa.dtype) if with_ctx else None
    return y, yc


def _retention_chunks(q, k, v, log_g, s0):
    B, H, T, _ = q.shape
    dv = v.shape[-1]
    n = T // RET_CHUNK
    pos = jnp.arange(RET_CHUNK, dtype=jnp.float32)
    diff = pos[:, None] - pos[None, :]
    inner = jnp.where(diff >= 0, jnp.exp(log_g[:, None, None] * jnp.maximum(diff, 0.0)), 0.0)
    q_dec = jnp.exp(log_g[:, None] * (pos + 1.0))[None, :, :, None]
    k_dec = jnp.exp(log_g[:, None] * (RET_CHUNK - 1.0 - pos))[None, :, :, None]
    c_dec = jnp.exp(log_g * RET_CHUNK)[None, :, None, None]

    def chunks(t):
        return jnp.moveaxis(t.reshape(B, H, n, RET_CHUNK, t.shape[-1]), 2, 0)

    def step(s, blk):
        qc, kc, vc = blk
        att = jnp.einsum('bhnd,bhmd->bhnm', qc, kc) * inner
        o = jnp.einsum('bhnm,bhme->bhne', att, vc) + jnp.einsum('bhnd,bhde->bhne', qc, s) * q_dec
        s = s * c_dec + jnp.einsum('bhmd,bhme->bhde', kc * k_dec, vc)
        return s, o

    s, o = lax.scan(step, s0, (chunks(q), chunks(k), chunks(v)))
    return jnp.moveaxis(o, 0, 2).reshape(B, H, T, dv), s


def _head_layernorm(o, gain):
    B, H, T, dv = o.shape
    oc = o - jnp.mean(o, axis=-1, keepdims=True)
    y = oc * lax.rsqrt(jnp.mean(oc * oc, axis=-1, keepdims=True) + NORM_EPS)
    y = y * gain.astype(jnp.float32).reshape(H, 1, dv)
    return y.transpose(0, 2, 1, 3).reshape(B, T, H * dv)


def _retention_branch(q, k, v, qc, kc, vc, theta, gain, rope, with_ctx):
    cos, sin = rope
    B = q.shape[0]
    k_scale = RET_HEAD_DIM ** -0.5

    def heads(t):
        return t.astype(jnp.float32).reshape(t.shape[0], t.shape[1], RET_HEADS, RET_HEAD_DIM)

    def bhtd(t):
        return t.transpose(0, 2, 1, 3)

    q_l = bhtd(_rope(heads(q), cos[:, None], sin[:, None]))
    k_l = bhtd(_rope(heads(k), cos[:, None], sin[:, None]) * k_scale)
    v_l = bhtd(heads(v))
    q_c, k_c, v_c = bhtd(heads(qc)), bhtd(heads(kc) * k_scale), bhtd(heads(vc))
    s0 = jnp.zeros((B, RET_HEADS, RET_HEAD_DIM, RET_HEAD_DIM), jnp.float32)
    o_sum = jnp.zeros_like(v_l)
    oc_parts = []
    for d in range(2):
        rev = d == 1
        log_g = jax.nn.log_sigmoid(theta[d].astype(jnp.float32))
        oc, s_ctx = _retention_chunks(_flip(q_c, rev, 2), _flip(k_c, rev, 2), _flip(v_c, rev, 2), log_g, s0)
        o, _ = _retention_chunks(_flip(q_l, rev, 2), _flip(k_l, rev, 2), _flip(v_l, rev, 2), log_g, s_ctx)
        o_sum = o_sum + _flip(o, rev, 2)
        if with_ctx:
            oc_parts.append(_flip(oc, rev, 2))
    y = _head_layernorm(o_sum, gain).astype(q.dtype)
    yc = _head_layernorm(oc_parts[0] + oc_parts[1], gain).astype(q.dtype) if with_ctx else None
    return y, yc


def _mla_qkv(qd, kvd, kr, q_norm, w_q_up, kv_norm, w_kv_up, g_qn, g_qr, g_kn, g_kr, rope):
    B, T, _ = qd.shape
    q = (_rms(qd, q_norm) @ w_q_up).reshape(B, T, MLA_HEADS, MLA_NOPE + MLA_ROPE)
    kv = (_rms(kvd, kv_norm) @ w_kv_up).reshape(B, T, MLA_HEADS, MLA_NOPE + MLA_V)
    q_nope = _rms(q[..., :MLA_NOPE], g_qn)
    q_rope = _rms(q[..., MLA_NOPE:], g_qr)
    k_nope = _rms(kv[..., :MLA_NOPE], g_kn)
    v = kv[..., MLA_NOPE:]
    k_rope = _rms(kr, g_kr)
    if rope is not None:
        cos, sin = rope
        q_rope = _rope(q_rope, cos[:, None], sin[:, None])
        k_rope = _rope(k_rope, cos, sin)
    return q_nope, q_rope, k_nope, k_rope, v


def _mla_attend(q_nope, q_rope, k_nope, k_rope, v):
    s = (jnp.einsum('bqhd,bkhd->bhqk', q_nope, k_nope)
         + jnp.einsum('bqhr,bkr->bhqk', q_rope, k_rope)).astype(jnp.float32) * MLA_SCALE
    p = jax.nn.softmax(s, axis=-1)
    return jnp.einsum('bhqk,bkhe->bqhe', p.astype(v.dtype), v)


def _mla_latent(q_nope, q_rope, k_nope, k_rope, v):
    B, T = q_nope.shape[0], q_nope.shape[1]
    nb = T // Q_BLOCK

    def blocks(t):
        return jnp.moveaxis(t.reshape((B, nb, Q_BLOCK) + t.shape[2:]), 1, 0)

    out = lax.map(lambda qs: _mla_attend(qs[0], qs[1], k_nope, k_rope, v), (blocks(q_nope), blocks(q_rope)))
    return jnp.moveaxis(out, 0, 1).reshape(B, T, D_MLA)


def _merge(lp, ya, yb, yc, ga, gb, gc, gm):
    m_a, m_b, m_c = jnp.split(jax.nn.sigmoid(gm), 3, axis=-1)
    z = (m_a * ((ya * jax.nn.silu(ga)) @ lp['w_down_a'])
         + m_b * ((yb * jax.nn.silu(gb)) @ lp['w_down_b'])
         + m_c * ((yc * jax.nn.silu(gc)) @ lp['w_down_c']))
    return z @ lp['w_out']


def _layer(x, xc, c, c_ctx, lp, rope_ret, rope_mla, with_ctx):
    B, L = xc.shape[0], xc.shape[1]
    mod = jax.nn.silu(c) @ lp['w_mod'] + lp['b_mod']
    mod_c = jax.nn.silu(c_ctx) @ lp['w_mod'] + lp['b_mod']
    shift, scale, gate = jnp.split(mod, 3, axis=-1)
    shift_c, scale_c, gate_c = jnp.split(mod_c, 3, axis=-1)
    h = _rms(x, lp['norm_gain']) * (1.0 + scale[:, None]) + shift[:, None]
    hc = _rms(xc, lp['norm_gain']) * (1.0 + scale_c) + shift_c
    (xa, ga, qb, kb, vb, gb, qd, kvd, kr, gc, gm) = _split_cols(h @ lp['w_in'])
    (xa_c, ga_c, qb_c, kb_c, vb_c, gb_c, qd_c, kvd_c, kr_c, gc_c, gm_c) = _split_cols(hc @ lp['w_in'])

    ya, ya_c = _rglru_branch(xa, xa_c, lp['conv_w'], lp['conv_b'], lp['lru_wa'], lp['lru_ba'],
                             lp['lru_wx'], lp['lru_bx'], lp['lru_lambda'], with_ctx)
    yb, yb_c = _retention_branch(qb, kb, vb, qb_c, kb_c, vb_c, lp['ret_theta'], lp['ret_gain'], rope_ret, with_ctx)

    mla_w = (lp['mla_q_norm'], lp['mla_w_q_up'], lp['mla_kv_norm'], lp['mla_w_kv_up'],
             lp['mla_g_qn'], lp['mla_g_qr'], lp['mla_g_kn'], lp['mla_g_kr'])
    qn, qr, kn, krot, v = _mla_qkv(qd, kvd, kr, *mla_w, rope_mla)
    qn_c, qr_c, kn_c, krot_c, v_c = _mla_qkv(qd_c, kvd_c, kr_c, *mla_w, None)
    yc = _mla_latent(qn, qr, jnp.concatenate([kn_c, kn], axis=1),
                     jnp.concatenate([krot_c, krot], axis=1), jnp.concatenate([v_c, v], axis=1))

    x = x + (gate[:, None] * _merge(lp, ya, yb, yc, ga, gb, gc, gm)).astype(x.dtype)
    if with_ctx:
        yc_c = _mla_attend(qn_c, qr_c, kn_c, krot_c, v_c).reshape(B, L, D_MLA)
        xc = xc + (gate_c * _merge(lp, ya_c, yb_c, yc_c, ga_c, gb_c, gc_c, gm_c)).astype(xc.dtype)
    return x, xc


def setup_inputs(seed: int = 0) -> dict:
    key = jax.random.key(seed)
    ks = jax.random.split(key, 32)
    f32 = jnp.float32

    def nrm(k, shape, fan):
        return jax.random.normal(k, shape, f32) * (fan ** -0.5)

    def small(k, shape):
        return jax.random.normal(k, shape, f32) * 0.02

    def gain(k, shape):
        return 1.0 + 0.02 * jax.random.normal(k, shape, f32)

    u = jax.random.uniform(ks[10], (DEPTH, 2, D_RNN), f32, minval=0.9, maxval=0.999)
    a0 = u ** (1.0 / LRU_C)
    lru_lambda = jnp.log(a0) - jnp.log1p(-a0)
    ret_base = jnp.log(2.0 ** (5.0 + jnp.arange(RET_HEADS, dtype=f32)) - 1.0)
    ret_theta = ret_base + 0.05 * jax.random.normal(ks[11], (DEPTH, 2, RET_HEADS), f32)

    return {
        'x': jax.random.normal(ks[0], (BATCH, SEQ, D_MODEL), f32),
        'c': jax.random.normal(ks[1], (BATCH, D_MODEL), f32),
        'ctx': jax.random.normal(ks[2], (BATCH, CTX_LEN, D_MODEL), f32),
        'c_ctx': jax.random.normal(ks[3], (D_MODEL,), f32),
        'w_mod': nrm(ks[4], (DEPTH, D_MODEL, 3 * D_MODEL), D_MODEL),
        'b_mod': small(ks[5], (DEPTH, 3 * D_MODEL)),
        'norm_gain': gain(ks[6], (DEPTH, D_MODEL)),
        'w_in': nrm(ks[7], (DEPTH, D_MODEL, IN_COLS), D_MODEL),
        'conv_w': nrm(ks[8], (DEPTH, CONV_W, D_RNN), CONV_W),
        'conv_b': small(ks[9], (DEPTH, D_RNN)),
        'lru_wa': nrm(ks[12], (DEPTH, 2, LRU_BLOCKS, LRU_BLOCK_W, LRU_BLOCK_W), LRU_BLOCK_W),
        'lru_ba': small(ks[13], (DEPTH, 2, D_RNN)),
        'lru_wx': nrm(ks[14], (DEPTH, 2, LRU_BLOCKS, LRU_BLOCK_W, LRU_BLOCK_W), LRU_BLOCK_W),
        'lru_bx': small(ks[15], (DEPTH, 2, D_RNN)),
        'lru_lambda': lru_lambda,
        'ret_theta': ret_theta,
        'ret_gain': gain(ks[16], (DEPTH, D_RET)),
        'mla_q_norm': gain(ks[17], (DEPTH, Q_LORA)),
        'mla_w_q_up': nrm(ks[18], (DEPTH, Q_LORA, MLA_HEADS * (MLA_NOPE + MLA_ROPE)), Q_LORA),
        'mla_kv_norm': gain(ks[19], (DEPTH, KV_LORA)),
        'mla_w_kv_up': nrm(ks[20], (DEPTH, KV_LORA, MLA_HEADS * (MLA_NOPE + MLA_V)), KV_LORA),
        'mla_g_qn': gain(ks[21], (DEPTH, MLA_NOPE)),
        'mla_g_qr': gain(ks[22], (DEPTH, MLA_ROPE)),
        'mla_g_kn': gain(ks[23], (DEPTH, MLA_NOPE)),
        'mla_g_kr': gain(ks[24], (DEPTH, MLA_ROPE)),
        'w_down_a': nrm(ks[25], (DEPTH, D_RNN, D_MODEL), D_RNN),
        'w_down_b': nrm(ks[26], (DEPTH, D_RET, D_MODEL), D_RET),
        'w_down_c': nrm(ks[27], (DEPTH, D_MLA, D_MODEL), D_MLA),
        'w_out': nrm(ks[28], (DEPTH, D_MODEL, D_MODEL), D_MODEL),
    }


def reference(x, c, ctx, c_ctx, w_mod, b_mod, norm_gain, w_in, conv_w, conv_b, lru_wa, lru_ba, lru_wx, lru_bx,
              lru_lambda, ret_theta, ret_gain, mla_q_norm, mla_w_q_up, mla_kv_norm, mla_w_kv_up,
              mla_g_qn, mla_g_qr, mla_g_kn, mla_g_kr, w_down_a, w_down_b, w_down_c, w_out):
    n_lat = x.shape[1]
    rope_ret = _axial_rope_tables(n_lat, RET_HEAD_DIM)
    rope_mla = _axial_rope_tables(n_lat, MLA_ROPE)
    xc = ctx
    for l in range(DEPTH):
        lp = {
            'w_mod': w_mod[l], 'b_mod': b_mod[l], 'norm_gain': norm_gain[l], 'w_in': w_in[l],
            'conv_w': conv_w[l], 'conv_b': conv_b[l], 'lru_wa': lru_wa[l], 'lru_ba': lru_ba[l],
            'lru_wx': lru_wx[l], 'lru_bx': lru_bx[l], 'lru_lambda': lru_lambda[l],
            'ret_theta': ret_theta[l], 'ret_gain': ret_gain[l],
            'mla_q_norm': mla_q_norm[l], 'mla_w_q_up': mla_w_q_up[l], 'mla_kv_norm': mla_kv_norm[l],
            'mla_w_kv_up': mla_w_kv_up[l], 'mla_g_qn': mla_g_qn[l], 'mla_g_qr': mla_g_qr[l],
            'mla_g_kn': mla_g_kn[l], 'mla_g_kr': mla_g_kr[l],
            'w_down_a': w_down_a[l], 'w_down_b': w_down_b[l], 'w_down_c': w_down_c[l], 'w_out': w_out[l],
        }
        x, xc = _layer(x, xc, c, c_ctx, lp, rope_ret, rope_mla, l < DEPTH - 1)
    return x
```

```cpp
#include <hip/hip_runtime.h>
#include <hip/hip_cooperative_groups.h>
#include <cstdio>
#include <cstdint>
namespace cg = cooperative_groups;

#define LAS __attribute__((address_space(3)))
typedef unsigned short bf16_t;
typedef short bf16x8 __attribute__((ext_vector_type(8)));
typedef float f32x4 __attribute__((ext_vector_type(4)));
typedef float f32x2 __attribute__((ext_vector_type(2)));
typedef unsigned u32x4 __attribute__((ext_vector_type(4)));
typedef unsigned u32x2 __attribute__((ext_vector_type(2)));
typedef _Float16 f16_t;

namespace pg8 {
constexpr int BM = 256, BK = 64, HALF = 128, HTB = HALF * BK * 2, STAGE_BYTES = 8 * HTB, NXCD = 8, WGM = 8;
__host__ __device__ __forceinline__ int lds_byte(int r, int c) { const int st = (r >> 4) * 2 + (c >> 5), rr = r & 15, cc = c & 31, ob = rr * 64 + cc * 2; return st * 1024 + (ob ^ (((ob >> 9) & 1) << 5)); }
__host__ __device__ __forceinline__ void stage_rc(int b, int& R, int& C) { const int st = b / 1024, sb = b % 1024, swz = sb ^ (((sb >> 9) & 1) << 5); R = (st >> 1) * 16 + swz / 64; C = (st & 1) * 32 + (swz % 64) / 2; }
__host__ __device__ __forceinline__ int perm32(int rho) { const int n = rho >> 4, i = rho & 15; return 8 * (i >> 2) + 4 * n + (i & 3); }

struct Unit { int pm, pn, z; };

struct StaticOrder {
    int nM, nN, nwg, G, c, latent_only;
    __device__ void init(int nM_, int nN_, int G_, int c_, int latent_only_) { nM = nM_; nN = nN_; nwg = nM * nN; G = G_; c = c_; latent_only = latent_only_; }
    __device__ bool next(int i, Unit& u) const {
        const long L = (long)i * G + c; if (L >= nwg) return false;
        int wgid = (int)L; { const int q = nwg / NXCD, r = nwg % NXCD, xcd = wgid % NXCD, off = wgid / NXCD; wgid = (xcd < r ? xcd * (q + 1) : r * (q + 1) + (xcd - r) * q) + off; }
        const int nig = WGM * nN, gid = wgid / nig, fm = gid * WGM, gsz = (nM - fm) < WGM ? (nM - fm) : WGM;
        int pm = fm + ((wgid % nig) % gsz); u.pn = (wgid % nig) / gsz; u.z = 0;
        if (latent_only) pm = (pm >> 4) * 17 + 1 + (pm & 15);
        u.pm = pm; return true;
    }
};
struct ChainOrder {
    int ntiles, G, c, latent_only;
    __device__ void init(int nM_, int G_, int c_, int latent_only_) { ntiles = nM_ * 4; G = G_; c = c_; latent_only = latent_only_; }
    __device__ bool next(int i, Unit& u) const {
        const int r = i / 6, z = i - r * 6; const long T = (long)r * G + c; if (T >= ntiles) return false;
        int pm = (int)(T >> 2); u.pn = (int)(T & 3); u.z = z;
        if (latent_only) pm = (pm >> 4) * 17 + 1 + (pm & 15);
        u.pm = pm; return true;
    }
};

__device__ __forceinline__ unsigned cvt_pk_bf16(float lo, float hi) { unsigned r; asm volatile("v_cvt_pk_bf16_f32 %0, %1, %2" : "=v"(r) : "v"(lo), "v"(hi)); return r; }

template <class Epi, class Prob, class Sched, bool ALIGN_EPI>
__device__ __forceinline__ void gemm_phase(LAS unsigned char* lds, const Prob& P, const Sched& S, const Epi& E) {
    int tid_ = threadIdx.x; asm volatile("" : "+v"(tid_));
    const int tid = tid_, wid = __builtin_amdgcn_readfirstlane(tid >> 6), lane = tid & 63, wr = wid >> 2, wc = wid & 3, fr = lane & 15, fq = lane >> 4;
    const int K = P.K, nt = K / BK;
    int RA[2], CA[2]; unsigned voffB[2];
#pragma unroll
    for (int i = 0; i < 2; ++i) { int R, C; stage_rc(tid * 16 + i * 8192, R, C); const int Rb = Epi::PERM ? ((R & ~31) + perm32(R & 31)) : R;
        RA[i] = R; CA[i] = C; voffB[i] = (unsigned)(Rb * P.ldb + C) * 2u; }
    const unsigned kstep = (unsigned)(BK * 2);
    const unsigned hstepB = (unsigned)(HALF * P.ldb * 2);
    const unsigned ldsw = (unsigned)wid * 1024u;
    const int aoff = lds_byte(wr * 64 + fr, fq * 8), boff = lds_byte(wc * 32 + fr, fq * 8);
#define PG8_SA(b, h) (((b) * 2 + (h)) * HTB)
#define PG8_SB(b, h) ((4 + (b) * 2 + (h)) * HTB)
#define PG8_STAGE(bufoff, gbase, soff, voff) do { _Pragma("unroll") for (int _i = 0; _i < 2; ++_i) \
        __builtin_amdgcn_global_load_lds((const unsigned*)((const char*)(gbase) + (unsigned)((voff)[_i] + (soff))), (LAS unsigned*)(lds + (bufoff) + ldsw + _i * 8192), 16, 0, 0); } while (0)
#define PG8_LDA(dst, b, h) do { _Pragma("unroll") for (int m = 0; m < 4; ++m) _Pragma("unroll") for (int k = 0; k < 2; ++k) dst[m][k] = *(const LAS bf16x8*)(lds + PG8_SA(b, h) + aoff + m * 2048 + k * 1024); } while (0)
#define PG8_LDB(dst, b, h) do { _Pragma("unroll") for (int n = 0; n < 2; ++n) _Pragma("unroll") for (int k = 0; k < 2; ++k) dst[n][k] = *(const LAS bf16x8*)(lds + PG8_SB(b, h) + boff + n * 2048 + k * 1024); } while (0)
#define PG8_MMA(ai, bj, At, Bt) do { __builtin_amdgcn_s_setprio(1); _Pragma("unroll") for (int m = 0; m < 4; ++m) _Pragma("unroll") for (int n = 0; n < 2; ++n) _Pragma("unroll") for (int k = 0; k < 2; ++k) \
        acc[ai][bj][m][n] = __builtin_amdgcn_mfma_f32_16x16x32_bf16(Bt[n][k], At[m][k], acc[ai][bj][m][n], 0, 0, 0); __builtin_amdgcn_s_setprio(0); } while (0)
#define PG8_WAIT_V(n) asm volatile("s_waitcnt vmcnt(" #n ")" ::: "memory")
#define PG8_WAIT_L(n) asm volatile("s_waitcnt lgkmcnt(" #n ")" ::: "memory")
#define PG8_BAR __builtin_amdgcn_s_barrier()
#define PG8_SCHED __builtin_amdgcn_sched_barrier(0)
    Unit cur, nxt; int ui = 0;
    if (!S.next(0, cur)) return;
    f32x4 acc[2][2][4][2];
#pragma unroll
    for (int a = 0; a < 2; ++a)
#pragma unroll
        for (int b = 0; b < 2; ++b)
#pragma unroll
            for (int m = 0; m < 4; ++m)
#pragma unroll
                for (int n = 0; n < 2; ++n) acc[a][b][m][n] = (f32x4){0.f, 0.f, 0.f, 0.f};
    bf16x8 At[4][2], B0[2][2], B1[2][2];
    const char* cA; const char* cB; int ldaC; P.get(cur, cA, cB, ldaC);
    unsigned voffA[2] = {(unsigned)(RA[0] * ldaC + CA[0]) * 2u, (unsigned)(RA[1] * ldaC + CA[1]) * 2u};
    unsigned hstepA = (unsigned)(HALF * ldaC * 2);
    PG8_STAGE(PG8_SB(0, 0), cB, 0u, voffB); PG8_STAGE(PG8_SB(0, 1), cB, hstepB, voffB); PG8_STAGE(PG8_SA(0, 0), cA, 0u, voffA); PG8_STAGE(PG8_SA(0, 1), cA, hstepA, voffA);
    if (wr == 1) PG8_BAR;
    PG8_WAIT_V(2); PG8_BAR;
    PG8_STAGE(PG8_SB(1, 0), cB, kstep, voffB); PG8_STAGE(PG8_SA(1, 0), cA, kstep, voffA); PG8_STAGE(PG8_SB(1, 1), cB, hstepB + kstep, voffB);
    PG8_WAIT_V(6); PG8_BAR;
    for (;;) {
        const bool has_next = S.next(ui + 1, nxt);
        const char* nA = cA; const char* nB = cB; int ldaN = ldaC;
        if (has_next) P.get(nxt, nA, nB, ldaN);
        unsigned voffAn[2] = {(unsigned)(RA[0] * ldaN + CA[0]) * 2u, (unsigned)(RA[1] * ldaN + CA[1]) * 2u};
        const unsigned hstepAn = (unsigned)(HALF * ldaN * 2);
        for (int t = 0; t < nt; t += 2) {
            const bool last = (t == nt - 2);
            const unsigned o1 = (unsigned)(t + 1) * kstep;
            const char* a2b = last ? nA : cA; const char* b2b = last ? nB : cB;
            const unsigned o2 = last ? 0u : (unsigned)(t + 2) * kstep, o3 = o2 + kstep;
            unsigned vA2[2] = {last ? voffAn[0] : voffA[0], last ? voffAn[1] : voffA[1]};
            const unsigned hA2 = last ? hstepAn : hstepA;
            PG8_LDB(B0, 0, 0); PG8_LDB(B1, 0, 1); PG8_SCHED; PG8_LDA(At, 0, 0); PG8_STAGE(PG8_SA(1, 1), cA, o1 + hstepA, voffA);
            PG8_WAIT_V(8); PG8_WAIT_L(0); PG8_BAR; PG8_MMA(0, 0, At, B0); PG8_MMA(0, 1, At, B1); PG8_BAR; PG8_SCHED;
            PG8_LDA(At, 0, 1); PG8_STAGE(PG8_SB(0, 0), b2b, o2, voffB); PG8_STAGE(PG8_SB(0, 1), b2b, o2 + hstepB, voffB); PG8_STAGE(PG8_SA(0, 0), a2b, o2, vA2);
            PG8_WAIT_V(8); PG8_WAIT_L(0); PG8_BAR; PG8_MMA(1, 0, At, B0); PG8_MMA(1, 1, At, B1); PG8_BAR; PG8_SCHED;
            PG8_LDB(B0, 1, 0); PG8_LDB(B1, 1, 1); PG8_SCHED; PG8_LDA(At, 1, 0); PG8_STAGE(PG8_SA(0, 1), a2b, o2 + hA2, vA2);
            PG8_WAIT_V(8); PG8_WAIT_L(0); PG8_BAR; PG8_MMA(0, 0, At, B0); PG8_MMA(0, 1, At, B1); PG8_BAR; PG8_SCHED;
            PG8_LDA(At, 1, 1); PG8_STAGE(PG8_SB(1, 0), b2b, o3, voffB); PG8_STAGE(PG8_SB(1, 1), b2b, o3 + hstepB, voffB); PG8_STAGE(PG8_SA(1, 0), a2b, o3, vA2);
            PG8_WAIT_V(8); PG8_WAIT_L(0); PG8_BAR; PG8_MMA(1, 0, At, B0); PG8_MMA(1, 1, At, B1); PG8_BAR; PG8_SCHED;
        }
        if constexpr (ALIGN_EPI) { if (wr == 0) PG8_BAR; }
        E(acc, cur, wr, wc, fr, fq);
        if (!has_next) break;
#pragma unroll
        for (int a = 0; a < 2; ++a)
#pragma unroll
            for (int b = 0; b < 2; ++b)
#pragma unroll
                for (int m = 0; m < 4; ++m)
#pragma unroll
                    for (int n = 0; n < 2; ++n) acc[a][b][m][n] = (f32x4){0.f, 0.f, 0.f, 0.f};
        cur = nxt; cA = nA; cB = nB; ldaC = ldaN; voffA[0] = voffAn[0]; voffA[1] = voffAn[1]; hstepA = hstepAn; ++ui;
        if constexpr (ALIGN_EPI) { if (wr == 1) PG8_BAR; }
    }
    PG8_WAIT_V(0);
    if constexpr (!ALIGN_EPI) { if (wr == 0) PG8_BAR; }
    PG8_BAR;
#undef PG8_SA
#undef PG8_SB
#undef PG8_STAGE
#undef PG8_LDA
#undef PG8_LDB
#undef PG8_MMA
#undef PG8_WAIT_V
#undef PG8_WAIT_L
#undef PG8_BAR
#undef PG8_SCHED
}
}

constexpr int NB = 4, TT = 4096, LC = 256, SS = TT + LC  , DM = 1024, MR = NB * SS  ;
constexpr int INC = 10944;
constexpr float EPS = 1e-6f;
constexpr float LOG2E = 1.4426950408889634f;
constexpr float QSCALE = 0.07216878364870322f * 1.4426950408889634f;
constexpr int NWAVES = 8, NTHR = 512;

constexpr size_t MiB = 1u << 20;
constexpr size_t WS_CTL = 0;
constexpr size_t WS_XC1 = 1 * MiB;
constexpr size_t WS_W = 5 * MiB;
constexpr size_t WS_AR = 25 * MiB;
constexpr size_t AR_YB = WS_AR + 0 * MiB;
constexpr size_t AR_XA = WS_AR + 34 * MiB;
constexpr size_t AR_MD = WS_AR + 68 * MiB;
constexpr size_t AR_RQKV = WS_AR + 94 * MiB;
constexpr size_t AR_KV = WS_AR + 112 * MiB;
constexpr size_t AR_QN = WS_AR + 180 * MiB;
constexpr size_t AR_QP = WS_AR + 214 * MiB;
constexpr size_t AR_RI = WS_AR + 102 * MiB;
constexpr size_t AR_SUM = WS_AR + 170 * MiB;
constexpr size_t AR_Z = WS_AR + 102 * MiB;
constexpr size_t AR_GS = WS_AR + 136 * MiB;
constexpr size_t WS_END = 256 * MiB;
constexpr size_t W_WT1 = WS_W;
constexpr size_t W_WTQ = WS_W + 10 * MiB;
constexpr size_t W_WTKV = WS_W + 12 * MiB;
constexpr size_t W_WTL = WS_W + 13 * MiB;
constexpr size_t W_WTG = WS_W;
constexpr size_t W_WTGM = WS_W + 6 * MiB;
constexpr size_t W_WTD = WS_W + 12 * MiB;
constexpr size_t W_WTO = WS_W + 18 * MiB;
constexpr int CT_MOD = 16384;
constexpr int CT_ROPER = CT_MOD + 2 * 5 * 3072;
constexpr int CT_ROPEM = CT_ROPER + 2 * 4096;
constexpr int CT_SP = CT_ROPEM + 2 * 1024;
constexpr int CT_LG = CT_SP + 4096;
constexpr int CT_END = CT_LG + 16;
static_assert(CT_END * 4 <= (int)MiB, "CTL");

constexpr int LDS_BYTES = 147456;

struct Params {
    const float* in[29];
    float* out;
    unsigned char* ws;
};

__device__ __forceinline__ float bf2f(unsigned v) { return __uint_as_float(v << 16); }
__device__ __forceinline__ unsigned f2bf(float f) { unsigned u = __float_as_uint(f); return (u + 0x7fffu + ((u >> 16) & 1u)) >> 16; }
__device__ __forceinline__ unsigned pk2(float lo, float hi) { return f2bf(lo) | (f2bf(hi) << 16); }
__device__ __forceinline__ float lo_bf(unsigned w) { return __uint_as_float(w << 16); }
__device__ __forceinline__ float hi_bf(unsigned w) { return __uint_as_float(w & 0xffff0000u); }
__device__ __forceinline__ float wave_sum(float v) {
#pragma unroll
    for (int o = 1; o < 64; o <<= 1) v += __shfl_xor(v, o);
    return v;
}
__device__ __forceinline__ float wave_max(float v) {
#pragma unroll
    for (int o = 1; o < 64; o <<= 1) v = fmaxf(v, __shfl_xor(v, o));
    return v;
}
__device__ __forceinline__ float sigmoidf_(float x) { return 1.f / (1.f + __expf(-x)); }
__device__ __forceinline__ float siluf_(float x) { return x / (1.f + __expf(-x)); }

__device__ __forceinline__ const float* inp_(int i) { asm volatile("" : "+s"(i)); const float* const* ka = (const float* const*)__builtin_amdgcn_kernarg_segment_ptr(); return ka[i]; }
#define INP(i) inp_(i)
__device__ __forceinline__ unsigned char* wsp_(unsigned char* p) { asm volatile("" : "+s"(p)); return p; }
struct Ctx {
    float* out; unsigned char* ws; LAS unsigned char* lds; int tid, lane, wave, G, bid;
    int gw, ngw;
    int rot;
    float* ctl;
};

__device__ __forceinline__ Ctx mkctx(LAS unsigned char* lds) {
    Ctx C; int t = threadIdx.x; asm volatile("" : "+v"(t)); int b = blockIdx.x; asm volatile("" : "+s"(b)); int g = gridDim.x; asm volatile("" : "+s"(g));
    C.tid = t; C.lane = t & 63; C.wave = __builtin_amdgcn_readfirstlane(t >> 6); C.bid = b; C.G = g; C.gw = b * NWAVES + C.wave; C.ngw = g * NWAVES; C.rot = 0;
    int io = 29, iw = 30; asm volatile("" : "+s"(io)); asm volatile("" : "+s"(iw));
    unsigned char* const* ka = (unsigned char* const*)__builtin_amdgcn_kernarg_segment_ptr();
    C.out = (float*)ka[io]; C.ws = ka[iw]; C.ctl = (float*)(C.ws + WS_CTL); C.lds = lds;
    return C;
}
__device__ __forceinline__ const float* resid_row(const Ctx& C, int l, int m) {
    const int b = m / SS, s = m - b * SS;
    if (s < LC) { const float* base = (l == 0) ? INP(2) : (const float*)(C.ws + WS_XC1); return base + (size_t)(b * LC + s) * DM; }
    const float* base = (l == 0) ? INP(0) : C.out; return base + (size_t)(b * TT + (s - LC)) * DM;
}

__device__ __forceinline__ void phase_prep(Ctx& C) {
    LAS float* sl = (LAS float*)C.lds;
    LAS float* red = (LAS float*)(C.lds + 32768);
    for (int i = C.tid; i < 5 * 1024; i += NTHR) { const int r = i >> 10, k = i & 1023; const float v = (r < 4) ? INP(1)[r * 1024 + k] : INP(3)[k]; sl[i] = siluf_(v); }
    __syncthreads();
    for (int it = C.bid; it < 2 * 96; it += C.G) {
        const int l = it / 96, grp = it % 96, kg = C.tid >> 5, cj = C.tid & 31, col = grp * 32 + cj;
        const float* w = INP(4) + (size_t)l * 1024 * 3072 + col;
        float a0 = 0.f, a1 = 0.f, a2 = 0.f, a3 = 0.f, a4 = 0.f;
#pragma unroll 8
        for (int k = kg * 64; k < kg * 64 + 64; ++k) { const float wv = w[(size_t)k * 3072]; a0 += sl[k] * wv; a1 += sl[1024 + k] * wv; a2 += sl[2048 + k] * wv; a3 += sl[3072 + k] * wv; a4 += sl[4096 + k] * wv; }
        red[(kg * 32 + cj) * 5 + 0] = a0; red[(kg * 32 + cj) * 5 + 1] = a1; red[(kg * 32 + cj) * 5 + 2] = a2; red[(kg * 32 + cj) * 5 + 3] = a3; red[(kg * 32 + cj) * 5 + 4] = a4;
        __syncthreads();
        if (C.tid < 160) { const int c2 = C.tid / 5, r = C.tid % 5; float s = 0.f;
            for (int g = 0; g < 16; ++g) s += red[(g * 32 + c2) * 5 + r];
            C.ctl[CT_MOD + (l * 5 + r) * 3072 + grp * 32 + c2] = s + INP(5)[l * 3072 + grp * 32 + c2]; }
        __syncthreads();
    }
    const int gt = C.bid * NTHR + C.tid, ngt = C.G * NTHR;
    for (int i = gt; i < 4096; i += ngt) { const int pos = i >> 6, f = i & 63; const float inv = powf(10000.f, -(float)f / 64.f), ang = (float)pos * inv;
        C.ctl[CT_ROPER + i] = cosf(ang); C.ctl[CT_ROPER + 4096 + i] = sinf(ang); }
    for (int i = gt; i < 1024; i += ngt) { const int pos = i >> 4, f = i & 15; const float inv = powf(10000.f, -(float)f / 16.f), ang = (float)pos * inv;
        C.ctl[CT_ROPEM + i] = cosf(ang); C.ctl[CT_ROPEM + 1024 + i] = sinf(ang); }
    for (int i = gt; i < 4096; i += ngt) C.ctl[CT_SP + i] = log1pf(expf(-INP(14)[i]));
    for (int i = gt; i < 16; i += ngt) C.ctl[CT_LG + i] = -log1pf(expf(-INP(15)[i])) * LOG2E;
}

__device__ __forceinline__ void tr_item(const float* W, int ldw, int k0, int n0, bf16_t* WT, int ldt, int drow0, int dk0, LAS float* scr, int lane) {
#pragma unroll 8
    for (int i = 0; i < 32; ++i) { const int kk = 2 * i + (lane >> 5); scr[kk * 33 + (lane & 31)] = W[(size_t)(k0 + kk) * ldw + n0 + (lane & 31)]; }
    asm volatile("s_waitcnt lgkmcnt(0)" ::: "memory");
    const int c = lane & 7;
#pragma unroll
    for (int j = 0; j < 4; ++j) { const int n = (lane >> 3) + 8 * j; const LAS float* s = scr + (8 * c) * 33 + n;
        u32x4 o; o.x = pk2(s[0 * 33], s[1 * 33]); o.y = pk2(s[2 * 33], s[3 * 33]); o.z = pk2(s[4 * 33], s[5 * 33]); o.w = pk2(s[6 * 33], s[7 * 33]);
        *(u32x4*)(WT + (size_t)(drow0 + n) * ldt + dk0 + 8 * c) = o; }
    asm volatile("s_waitcnt lgkmcnt(0)" ::: "memory");
}
__device__ __forceinline__ void conv_rows(Ctx& C, const float* W, int ldw, int K, int scol0, bf16_t* WT, int ldt, int drow0, int dk0, int nrows, LAS float* scr) {
    const int nkb = K / 64, items = nkb * (nrows / 32);
    int g0 = C.gw - C.rot; if (g0 < 0) g0 += C.ngw; C.rot = (C.rot + items) % C.ngw;
    for (int it = g0; it < items; it += C.ngw) { const int nb = it / nkb, kb = it - nb * nkb;
        tr_item(W, ldw, kb * 64, scol0 + nb * 32, WT, ldt, drow0 + nb * 32, dk0 + kb * 64, scr, C.lane); }
}
__device__ __forceinline__ void zero_rows(Ctx& C, bf16_t* WT, int ldt, int drow0, int dk0, int nrows, int ncols) {
    const int per = ncols / 8, items = nrows * per;
    int g0 = C.gw - C.rot; if (g0 < 0) g0 += C.ngw; C.rot = (C.rot + (items + 63) / 64) % C.ngw;
    for (int it = g0 * 64 + C.lane; it < items; it += C.ngw * 64) { const int r = it / per, c = it - r * per; *(u32x4*)(WT + (size_t)(drow0 + r) * ldt + dk0 + c * 8) = (u32x4){0u, 0u, 0u, 0u}; }
}
__device__ __forceinline__ void phase_wconv_early(Ctx& C, int l) {
    LAS float* scr = (LAS float*)(C.lds + C.wave * 16384);
    unsigned char* ws = C.ws;
    const float* win = INP(7) + (size_t)l * 1024 * INC;
    bf16_t* WT1 = (bf16_t*)(ws + W_WT1);
    conv_rows(C, win, INC, 1024, 0, WT1, 1024, 0, 0, 1024, scr);
    conv_rows(C, win, INC, 1024, 2048, WT1, 1024, 1024, 0, 3072, scr);
    conv_rows(C, win, INC, 1024, 6144, WT1, 1024, 4096, 0, 704, scr);
    zero_rows(C, WT1, 1024, 4800, 0, 64, 1024);
    const float* wq = INP(18) + (size_t)l * 384 * 1536; bf16_t* WTQ = (bf16_t*)(ws + W_WTQ);
    for (int h = 0; h < 8; ++h) { conv_rows(C, wq, 1536, 384, h * 192, WTQ, 384, h * 128, 0, 128, scr); conv_rows(C, wq, 1536, 384, h * 192 + 128, WTQ, 384, 1024 + h * 64, 0, 64, scr); }
    const float* wkv = INP(20) + (size_t)l * 256 * 2048; bf16_t* WTKV = (bf16_t*)(ws + W_WTKV);
    for (int h = 0; h < 8; ++h) { conv_rows(C, wkv, 2048, 256, h * 256, WTKV, 256, h * 128, 0, 128, scr); conv_rows(C, wkv, 2048, 256, h * 256 + 128, WTKV, 256, 1024 + h * 128, 0, 128, scr); }
    bf16_t* WTL = (bf16_t*)(ws + W_WTL);
    for (int d = 0; d < 2; ++d) for (int n = 0; n < 8; ++n) for (int mat = 0; mat < 2; ++mat) {
        const float* w = INP(mat == 0 ? 10 : 12) + ((size_t)(l * 2 + d) * 8 + n) * 128 * 128;
        const int drow0 = d * 2048 + n * 256 + mat * 128;
        conv_rows(C, w, 128, 128, 0, WTL, 256, drow0, (n & 1) * 128, 128, scr);
        zero_rows(C, WTL, 256, drow0, ((n & 1) ^ 1) * 128, 128, 128);
    }
}
__device__ __forceinline__ void phase_wconv_late(Ctx& C, int l) {
    LAS float* scr = (LAS float*)(C.lds + C.wave * 16384);
    unsigned char* ws = C.ws;
    const float* win = INP(7) + (size_t)l * 1024 * INC;
    bf16_t* WTG = (bf16_t*)(ws + W_WTG);
    conv_rows(C, win, INC, 1024, 1024, WTG, 1024, 0, 0, 1024, scr);
    conv_rows(C, win, INC, 1024, 5120, WTG, 1024, 1024, 0, 1024, scr);
    conv_rows(C, win, INC, 1024, 6848, WTG, 1024, 2048, 0, 1024, scr);
    conv_rows(C, win, INC, 1024, 7872, (bf16_t*)(ws + W_WTGM), 1024, 0, 0, 3072, scr);
    for (int i = 0; i < 3; ++i) conv_rows(C, INP(25 + i) + (size_t)l * 1024 * 1024, 1024, 1024, 0, (bf16_t*)(ws + W_WTD) + (size_t)i * 1024 * 1024, 1024, 0, 0, 1024, scr);
    conv_rows(C, INP(28) + (size_t)l * 1024 * 1024, 1024, 1024, 0, (bf16_t*)(ws + W_WTO), 1024, 0, 0, 1024, scr);
}

__device__ __forceinline__ void phase_h(Ctx& C, int l, bf16_t* H) {
    const float* gain = INP(6) + l * 1024;
    for (int m = C.gw; m < MR; m += C.ngw) {
        const int b = m / SS, s = m - b * SS, r = (s < LC) ? 4 : b;
        const float* xr = resid_row(C, l, m);
        const float* mod = C.ctl + CT_MOD + (l * 5 + r) * 3072;
        f32x4 v[4]; float ss = 0.f;
#pragma unroll
        for (int j = 0; j < 4; ++j) { v[j] = *(const f32x4*)(xr + 4 * C.lane + 256 * j); ss += (v[j].x * v[j].x + v[j].y * v[j].y) + (v[j].z * v[j].z + v[j].w * v[j].w); }
        const float rstd = 1.f / sqrtf(wave_sum(ss) * (1.f / 1024.f) + EPS);
#pragma unroll
        for (int j = 0; j < 4; ++j) { const int c = 4 * C.lane + 256 * j;
            const f32x4 g = *(const f32x4*)(gain + c), sh = *(const f32x4*)(mod + c), sc = *(const f32x4*)(mod + 1024 + c);
            const f32x4 y = (v[j] * rstd) * g;
            const f32x4 o = y * (sc + 1.0f) + sh;
            u32x2 w; w.x = pk2(o.x, o.y); w.y = pk2(o.z, o.w);
            *(u32x2*)(H + (size_t)m * 1024 + c) = w; }
    }
}

using pg8::Unit;
struct ProbPlain {
    const bf16_t* A; const bf16_t* Bt; int lda, ldb, K;
    __device__ __forceinline__ void get(const Unit& u, const char*& a, const char*& b, int& lda_) const {
        a = (const char*)(A + (size_t)u.pm * 256 * lda); b = (const char*)(Bt + (size_t)u.pn * 256 * ldb); lda_ = lda; }
};
struct ProbLru {
    const bf16_t* A; const bf16_t* Bt; int ldb, K;
    __device__ __forceinline__ void get(const Unit& u, const char*& a, const char*& b, int& lda_) const {
        a = (const char*)(A + (size_t)u.pm * 256 * 1024 + (u.pn >> 1) * 256); b = (const char*)(Bt + (size_t)u.pn * 256 * 256); lda_ = 1024; }
};
struct ProbD {
    unsigned char* ws; int ldb, K;
    __device__ __forceinline__ void get(const Unit& u, const char*& a, const char*& b, int& lda_) const {
        const int i = u.z >> 1;
        if ((u.z & 1) == 0) { a = (const char*)(ws + AR_MD + (size_t)u.pm * 256 * 1024 * 2); b = (const char*)(ws + W_WTGM + ((size_t)i * 1024 + u.pn * 256) * 1024 * 2); lda_ = 1024; }
        else { const size_t yo = (i == 0) ? AR_XA : (i == 1) ? AR_YB : AR_QN;
            a = (const char*)(ws + yo + (size_t)u.pm * 256 * 1024 * 2); b = (const char*)(ws + W_WTD + ((size_t)i * 1024 + u.pn * 256) * 1024 * 2); lda_ = 1024; }
    }
};

#define EPI_ARGS const f32x4 (&acc)[2][2][4][2], const Unit& u, int wr, int wc, int fr, int fq
template <size_t O0, int L0, size_t O1, int L1, size_t O2, int L2, int T1, int T2>
struct EpiStore3 {
    static constexpr bool PERM = true;
    unsigned char* ws;
    __device__ __forceinline__ void operator()(EPI_ARGS) const {
        bf16_t* bs; int ldc, ct;
        size_t off;
        if (u.pn < T1) { off = O0; ldc = L0; ct = u.pn; } else if (u.pn < T2) { off = O1; ldc = L1; ct = u.pn - T1; } else { off = O2; ldc = L2; ct = u.pn - T2; }
        bs = (bf16_t*)(ws + off);
        const int row0 = u.pm * 256 + wr * 64 + fr, col0 = ct * 256 + wc * 32 + 8 * fq;
#pragma unroll
        for (int ai = 0; ai < 2; ++ai)
#pragma unroll
            for (int m = 0; m < 4; ++m) { bf16_t* rowp = bs + (size_t)(row0 + ai * 128 + m * 16) * ldc + col0;
#pragma unroll
                for (int bj = 0; bj < 2; ++bj) { const f32x4 v0 = acc[ai][bj][m][0], v1 = acc[ai][bj][m][1];
                    u32x4 w; w.x = pg8::cvt_pk_bf16(v0[0], v0[1]); w.y = pg8::cvt_pk_bf16(v0[2], v0[3]); w.z = pg8::cvt_pk_bf16(v1[0], v1[1]); w.w = pg8::cvt_pk_bf16(v1[2], v1[3]);
                    *(u32x4*)(rowp + bj * 128) = w; } }
    }
};
typedef f16_t f16x8 __attribute__((ext_vector_type(8)));
struct EpiLru {
    static constexpr bool PERM = true;
    const bf16_t* U; f16_t* RI; const float* ba; const float* bx; const float* sp;
    __device__ __forceinline__ void operator()(EPI_ARGS) const {
        const int row0 = u.pm * 256 + wr * 64 + fr, ch0 = u.pn * 128 + wc * 32 + 8 * fq;
        float bav[8], bxv[8], spv[8];
#pragma unroll
        for (int e = 0; e < 8; ++e) { bav[e] = ba[ch0 + e]; bxv[e] = bx[ch0 + e]; spv[e] = sp[ch0 + e] * (-8.f); }
#pragma unroll
        for (int ai = 0; ai < 2; ++ai)
#pragma unroll
            for (int m = 0; m < 4; ++m) { const int row = row0 + ai * 128 + m * 16;
                const u32x4 uw = *(const u32x4*)(U + (size_t)row * 1024 + ch0);
                float uv[8] = {lo_bf(uw.x), hi_bf(uw.x), lo_bf(uw.y), hi_bf(uw.y), lo_bf(uw.z), hi_bf(uw.z), lo_bf(uw.w), hi_bf(uw.w)};
                f16x8 la, bc;
#pragma unroll
                for (int e = 0; e < 8; ++e) { const float rp = acc[ai][0][m][e >> 2][e & 3] + bav[e], ip = acc[ai][1][m][e >> 2][e & 3] + bxv[e];
                    const float r = sigmoidf_(rp), ig = sigmoidf_(ip);
                    const float loga = r * spv[e];
                    const float bb = sqrtf(fmaxf(-expm1f(2.f * loga), 0.f)) * (ig * uv[e]);
                    la[e] = (f16_t)(loga * LOG2E); bc[e] = (f16_t)bb; }
                *(f16x8*)(RI + (size_t)row * 2048 + ch0) = la; *(f16x8*)(RI + (size_t)row * 2048 + 1024 + ch0) = bc;
                asm volatile("" ::: "memory"); }
    }
};
struct EpiGate {
    static constexpr bool PERM = true;
    unsigned char* ws;
    __device__ __forceinline__ void operator()(EPI_ARGS) const {
        const int br = u.pn >> 2; const size_t yo = (br == 0) ? AR_XA : (br == 1) ? AR_YB : AR_QN; bf16_t* bs = (bf16_t*)(ws + yo); const int ldc = 1024;
        const int row0 = u.pm * 256 + wr * 64 + fr, col0 = (u.pn & 3) * 256 + wc * 32 + 8 * fq;
#pragma unroll
        for (int ai = 0; ai < 2; ++ai)
#pragma unroll
            for (int m = 0; m < 4; ++m) { bf16_t* rowp = bs + (size_t)(row0 + ai * 128 + m * 16) * ldc + col0;
#pragma unroll
                for (int bj = 0; bj < 2; ++bj) { const f32x4 v0 = acc[ai][bj][m][0], v1 = acc[ai][bj][m][1];
                    const u32x4 y = *(const u32x4*)(rowp + bj * 128);
                    u32x4 w; w.x = pg8::cvt_pk_bf16(lo_bf(y.x) * siluf_(v0[0]), hi_bf(y.x) * siluf_(v0[1])); w.y = pg8::cvt_pk_bf16(lo_bf(y.y) * siluf_(v0[2]), hi_bf(y.y) * siluf_(v0[3]));
                    w.z = pg8::cvt_pk_bf16(lo_bf(y.z) * siluf_(v1[0]), hi_bf(y.z) * siluf_(v1[1])); w.w = pg8::cvt_pk_bf16(lo_bf(y.w) * siluf_(v1[2]), hi_bf(y.w) * siluf_(v1[3]));
                    *(u32x4*)(rowp + bj * 128) = w; }
                asm volatile("" ::: "memory"); }
    }
};
struct EpiD {
    static constexpr bool PERM = true;
    bf16_t* Z; unsigned char* gs;
    __device__ __forceinline__ void operator()(EPI_ARGS) const {
        const int row0 = u.pm * 256 + wr * 64 + fr, col0 = u.pn * 256 + wc * 32 + 8 * fq, i = u.z >> 1;
        const unsigned tq = (unsigned)(((wr * 4 + wc) * 64 + fq * 16 + fr) * 64);
        if ((u.z & 1) == 0) {
#pragma unroll
            for (int ai = 0; ai < 2; ++ai)
#pragma unroll
                for (int m = 0; m < 4; ++m)
#pragma unroll
                    for (int bj = 0; bj < 2; ++bj) { const f32x4 v0 = acc[ai][bj][m][0], v1 = acc[ai][bj][m][1];
                        u32x4 w; w.x = pg8::cvt_pk_bf16(sigmoidf_(v0[0]), sigmoidf_(v0[1])); w.y = pg8::cvt_pk_bf16(sigmoidf_(v0[2]), sigmoidf_(v0[3]));
                        w.z = pg8::cvt_pk_bf16(sigmoidf_(v1[0]), sigmoidf_(v1[1])); w.w = pg8::cvt_pk_bf16(sigmoidf_(v1[2]), sigmoidf_(v1[3]));
                        *(u32x4*)(gs + (((ai * 4 + m) * 2 + bj) >> 2) * 32768 + tq + (((ai * 4 + m) * 2 + bj) & 3) * 16) = w; }
        } else {
#pragma unroll
            for (int ai = 0; ai < 2; ++ai)
#pragma unroll
                for (int m = 0; m < 4; ++m) { bf16_t* zrow = Z + (size_t)(row0 + ai * 128 + m * 16) * 1024 + col0;
#pragma unroll
                    for (int bj = 0; bj < 2; ++bj) { const f32x4 v0 = acc[ai][bj][m][0], v1 = acc[ai][bj][m][1];
                        const u32x4 g = *(const u32x4*)(gs + (((ai * 4 + m) * 2 + bj) >> 2) * 32768 + tq + (((ai * 4 + m) * 2 + bj) & 3) * 16); bf16_t* zp = zrow + bj * 128;
                        float o0 = lo_bf(g.x) * v0[0], o1 = hi_bf(g.x) * v0[1], o2 = lo_bf(g.y) * v0[2], o3 = hi_bf(g.y) * v0[3], o4 = lo_bf(g.z) * v1[0], o5 = hi_bf(g.z) * v1[1], o6 = lo_bf(g.w) * v1[2], o7 = hi_bf(g.w) * v1[3];
                        if (i > 0) { const u32x4 zo = *(const u32x4*)zp; o0 += lo_bf(zo.x); o1 += hi_bf(zo.x); o2 += lo_bf(zo.y); o3 += hi_bf(zo.y); o4 += lo_bf(zo.z); o5 += hi_bf(zo.z); o6 += lo_bf(zo.w); o7 += hi_bf(zo.w); }
                        u32x4 w; w.x = pg8::cvt_pk_bf16(o0, o1); w.y = pg8::cvt_pk_bf16(o2, o3); w.z = pg8::cvt_pk_bf16(o4, o5); w.w = pg8::cvt_pk_bf16(o6, o7); *(u32x4*)zp = w; }
                    asm volatile("" ::: "memory"); }
        }
    }
};
struct EpiOut {
    static constexpr bool PERM = false;
    const float* xlat; const float* xctx; float* olat; float* octx; const float* mod;
    __device__ __forceinline__ void operator()(EPI_ARGS) const {
        const int b = u.pm / 17, isctx = (u.pm - b * 17) == 0;
        const float* gate = mod + (isctx ? 4 : b) * 3072 + 2048;
        const int col0 = u.pn * 256 + wc * 32 + 4 * fq;
        f32x4 gv[2][2];
#pragma unroll
        for (int bj = 0; bj < 2; ++bj)
#pragma unroll
            for (int n = 0; n < 2; ++n) gv[bj][n] = *(const f32x4*)(gate + col0 + bj * 128 + n * 16);
#pragma unroll
        for (int ai = 0; ai < 2; ++ai)
#pragma unroll
            for (int m = 0; m < 4; ++m) { const int s = (u.pm - b * 17) * 256 + ai * 128 + wr * 64 + m * 16 + fr;
                const size_t off = isctx ? ((size_t)(b * LC + s) * 1024 + col0) : ((size_t)(b * TT + (s - LC)) * 1024 + col0);
                const float* xin = isctx ? xctx : xlat; float* xo = isctx ? octx : olat;
#pragma unroll
                for (int bj = 0; bj < 2; ++bj)
#pragma unroll
                    for (int n = 0; n < 2; ++n) { const f32x4 xv = *(const f32x4*)(xin + off + bj * 128 + n * 16);
                        *(f32x4*)(xo + off + bj * 128 + n * 16) = xv + gv[bj][n] * acc[ai][bj][m][n]; }
                asm volatile("" ::: "memory"); }
    }
};

__device__ __forceinline__ void phase_ret_rope(Ctx& C, bf16_t* RQKV) {
    const float* cs = C.ctl + CT_ROPER; const float* sn = cs + 4096;
    for (int m = C.gw; m < MR; m += C.ngw) {
        const int b = m / SS, s = m - b * SS; const bool lat = s >= LC; const int t = s - LC, prow = lat ? (t >> 6) : 0, pcol = lat ? (t & 63) : 0;
        bf16_t* row = RQKV + (size_t)m * 3072;
#pragma unroll
        for (int j = 0; j < 16; ++j) {
            const int idx = j * 64 + C.lane, f = idx & 63, half = (idx >> 6) & 1, h = (idx >> 7) & 3, tz = idx >> 9;
            bf16_t* p = row + tz * 1024 + h * 256 + half * 128 + f;
            const float x1 = bf2f(p[0]), x2 = bf2f(p[64]);
            float o1 = x1, o2 = x2;
            if (lat) { const int pos = half ? pcol : prow; const float c = cs[pos * 64 + f], sv = sn[pos * 64 + f]; o1 = x1 * c - x2 * sv; o2 = x2 * c + x1 * sv; }
            if (tz) { o1 *= 0.0625f; o2 *= 0.0625f; }
            p[0] = (bf16_t)f2bf(o1); p[64] = (bf16_t)f2bf(o2);
        }
    }
}

#define RS_STEP(o, cnt, st) do { const bool up_ = (C.lane & (st)) != 0; _Pragma("unroll") for (int e_ = 0; e_ < (cnt) / 2; ++e_) { \
        const float send_ = up_ ? o[e_] : o[e_ + (cnt) / 2]; const float keep_ = up_ ? o[e_ + (cnt) / 2] : o[e_]; o[e_] = keep_ + __shfl_xor(send_, (st)); } } while (0)

__device__ __forceinline__ void phase_ret_naive(Ctx& C, int l, const bf16_t* RQKV, bf16_t* OI) {
    LAS unsigned char* qs = C.lds + C.wave * 512;
    const int nbu = (MR / 8) * 16;
    for (int bu = C.bid; bu < nbu; bu += C.G) {
        const int hq = bu & 15, h = hq >> 2, qd = hq & 3, n = (bu >> 4) * 8 + C.wave;
        const int b = n / SS, sn_ = n - b * SS;
        const float lgf = C.ctl[CT_LG + (l * 2 + 0) * 4 + h], lgb = C.ctl[CT_LG + (l * 2 + 1) * 4 + h];
        const int pfn = sn_, pbn = (sn_ < LC) ? (LC - 1 - sn_) : (SS + LC - 1 - sn_);
        asm volatile("s_waitcnt lgkmcnt(0)" ::: "memory");
        *(LAS u32x2*)(qs + C.lane * 8) = *(const u32x2*)(RQKV + (size_t)n * 3072 + h * 256 + C.lane * 4);
        asm volatile("s_waitcnt lgkmcnt(0)" ::: "memory");
        float o[64];
#pragma unroll
        for (int e = 0; e < 64; ++e) o[e] = 0.f;
        for (int sm = C.lane; sm < SS; sm += 64) {
            const bf16_t* krow = RQKV + (size_t)(b * SS + sm) * 3072 + 1024 + h * 256;
            float dot = 0.f;
#pragma unroll 4
            for (int c = 0; c < 32; ++c) { const u32x4 kv = *(const u32x4*)(krow + c * 8); const u32x4 qv = *(const LAS u32x4*)(qs + c * 16);
                dot += lo_bf(kv.x) * lo_bf(qv.x) + hi_bf(kv.x) * hi_bf(qv.x) + lo_bf(kv.y) * lo_bf(qv.y) + hi_bf(kv.y) * hi_bf(qv.y)
                     + lo_bf(kv.z) * lo_bf(qv.z) + hi_bf(kv.z) * hi_bf(qv.z) + lo_bf(kv.w) * lo_bf(qv.w) + hi_bf(kv.w) * hi_bf(qv.w); }
            const int pfm = sm, pbm = (sm < LC) ? (LC - 1 - sm) : (SS + LC - 1 - sm);
            float w = 0.f;
            if (pfn >= pfm) w += exp2f(lgf * (float)(pfn - pfm));
            if (pbn >= pbm) w += exp2f(lgb * (float)(pbn - pbm));
            const float ws_ = w * dot;
            const bf16_t* vrow = krow + 1024 + qd * 64;
#pragma unroll
            for (int c = 0; c < 8; ++c) { const u32x4 vv = *(const u32x4*)(vrow + c * 8);
                o[c * 8 + 0] += ws_ * lo_bf(vv.x); o[c * 8 + 1] += ws_ * hi_bf(vv.x); o[c * 8 + 2] += ws_ * lo_bf(vv.y); o[c * 8 + 3] += ws_ * hi_bf(vv.y);
                o[c * 8 + 4] += ws_ * lo_bf(vv.z); o[c * 8 + 5] += ws_ * hi_bf(vv.z); o[c * 8 + 6] += ws_ * lo_bf(vv.w); o[c * 8 + 7] += ws_ * hi_bf(vv.w); }
        }
        RS_STEP(o, 64, 32); RS_STEP(o, 32, 16); RS_STEP(o, 16, 8); RS_STEP(o, 8, 4); RS_STEP(o, 4, 2); RS_STEP(o, 2, 1);
        OI[(size_t)n * 1024 + h * 256 + qd * 64 + C.lane] = (bf16_t)f2bf(o[0]);
    }
}
__device__ __forceinline__ void phase_ret_ln(Ctx& C, int l, bf16_t* OI) {
    const float* gain = INP(16) + l * 1024;
    for (int m = C.gw; m < MR; m += C.ngw) {
#pragma unroll
        for (int h = 0; h < 4; ++h) { bf16_t* p = OI + (size_t)m * 1024 + h * 256 + C.lane * 4;
            const u32x2 w = *(const u32x2*)p; float x0 = lo_bf(w.x), x1 = hi_bf(w.x), x2 = lo_bf(w.y), x3 = hi_bf(w.y);
            const float mean = wave_sum((x0 + x1) + (x2 + x3)) * (1.f / 256.f);
            x0 -= mean; x1 -= mean; x2 -= mean; x3 -= mean;
            const float var = wave_sum((x0 * x0 + x1 * x1) + (x2 * x2 + x3 * x3)) * (1.f / 256.f);
            const float rstd = 1.f / sqrtf(var + EPS);
            const f32x4 g = *(const f32x4*)(gain + h * 256 + C.lane * 4);
            u32x2 o; o.x = pk2(x0 * rstd * g.x, x1 * rstd * g.y); o.y = pk2(x2 * rstd * g.z, x3 * rstd * g.w); *(u32x2*)p = o; }
    }
}

__device__ __forceinline__ void phase_md_post(Ctx& C, int l, bf16_t* MD) {
    const float* qn = INP(17) + l * 384; const float* kvn = INP(19) + l * 256; const float* gkr = INP(24) + l * 64;
    const float* cs = C.ctl + CT_ROPEM; const float* sn = cs + 1024;
    for (int m = C.gw; m < MR; m += C.ngw) {
        const int b = m / SS, s = m - b * SS; const bool lat = s >= LC; const int t = s - LC;
        bf16_t* row = MD + (size_t)m * 768;
        {   float x[6]; float ss = 0.f;
#pragma unroll
            for (int j = 0; j < 3; ++j) { const unsigned w = *(const unsigned*)(row + 2 * C.lane + 128 * j); x[2 * j] = lo_bf(w); x[2 * j + 1] = hi_bf(w); ss += x[2 * j] * x[2 * j] + x[2 * j + 1] * x[2 * j + 1]; }
            const float rstd = 1.f / sqrtf(wave_sum(ss) * (1.f / 384.f) + EPS);
#pragma unroll
            for (int j = 0; j < 3; ++j) { const int c = 2 * C.lane + 128 * j; *(unsigned*)(row + c) = pk2(x[2 * j] * rstd * qn[c], x[2 * j + 1] * rstd * qn[c + 1]); } }
        {   float x[4]; float ss = 0.f;
#pragma unroll
            for (int j = 0; j < 2; ++j) { const unsigned w = *(const unsigned*)(row + 384 + 2 * C.lane + 128 * j); x[2 * j] = lo_bf(w); x[2 * j + 1] = hi_bf(w); ss += x[2 * j] * x[2 * j] + x[2 * j + 1] * x[2 * j + 1]; }
            const float rstd = 1.f / sqrtf(wave_sum(ss) * (1.f / 256.f) + EPS);
#pragma unroll
            for (int j = 0; j < 2; ++j) { const int c = 2 * C.lane + 128 * j; *(unsigned*)(row + 384 + c) = pk2(x[2 * j] * rstd * kvn[c], x[2 * j + 1] * rstd * kvn[c + 1]); } }
        {   const float x = bf2f(row[640 + C.lane]);
            const float rstd = 1.f / sqrtf(wave_sum(x * x) * (1.f / 64.f) + EPS);
            float y = x * rstd * gkr[C.lane];
            if (lat) { const float pr = __shfl_xor(y, 16); const float rot = (C.lane & 16) ? pr : -pr; const int f = C.lane & 15, pos = (C.lane < 32) ? (t >> 6) : (t & 63);
                y = y * cs[pos * 16 + f] + rot * sn[pos * 16 + f]; }
            row[640 + C.lane] = (bf16_t)f2bf(y); }
    }
}
__device__ __forceinline__ void phase_qk_post(Ctx& C, int l, bf16_t* QN, bf16_t* QP, bf16_t* KV) {
    const float* gqn = INP(21) + l * 128; const float* gqr = INP(22) + l * 64; const float* gkn = INP(23) + l * 128;
    const float* cs = C.ctl + CT_ROPEM; const float* sn = cs + 1024;
    for (int m = C.gw; m < MR; m += C.ngw) {
        const int b = m / SS, s = m - b * SS; const bool lat = s >= LC; const int t = s - LC;
        bf16_t* qrow = QN + (size_t)m * 1024; bf16_t* prow = QP + (size_t)m * 512; bf16_t* krow = KV + (size_t)m * 2048;
#pragma unroll
        for (int h = 0; h < 8; ++h) {
            {   unsigned* p = (unsigned*)(qrow + h * 128 + 2 * C.lane); const unsigned w = *p; const float x0 = lo_bf(w), x1 = hi_bf(w);
                const float rstd = 1.f / sqrtf(wave_sum(x0 * x0 + x1 * x1) * (1.f / 128.f) + EPS);
                *p = pk2(x0 * rstd * gqn[2 * C.lane] * QSCALE, x1 * rstd * gqn[2 * C.lane + 1] * QSCALE); }
            {   bf16_t* p = prow + h * 64 + C.lane; const float x = bf2f(*p);
                const float rstd = 1.f / sqrtf(wave_sum(x * x) * (1.f / 64.f) + EPS);
                float y = x * rstd * gqr[C.lane];
                if (lat) { const float pr = __shfl_xor(y, 16); const float rot = (C.lane & 16) ? pr : -pr; const int f = C.lane & 15, pos = (C.lane < 32) ? (t >> 6) : (t & 63);
                    y = y * cs[pos * 16 + f] + rot * sn[pos * 16 + f]; }
                *p = (bf16_t)f2bf(y * QSCALE); }
            {   unsigned* p = (unsigned*)(krow + h * 128 + 2 * C.lane); const unsigned w = *p; const float x0 = lo_bf(w), x1 = hi_bf(w);
                const float rstd = 1.f / sqrtf(wave_sum(x0 * x0 + x1 * x1) * (1.f / 128.f) + EPS);
                *p = pk2(x0 * rstd * gkn[2 * C.lane], x1 * rstd * gkn[2 * C.lane + 1]); }
        }
    }
}

__device__ __forceinline__ void phase_attn_naive(Ctx& C, bool with_ctx, bf16_t* QN, const bf16_t* QP, const bf16_t* KV, const bf16_t* MD) {
    LAS unsigned char* qs = C.lds + C.wave * 512;
    const int nlat = NB * 8 * (TT / 8), nctx = with_ctx ? NB * 8 * (LC / 8) : 0;
    for (int bu = C.bid; bu < nlat + nctx; bu += C.G) {
        int b, h, s, nkeys;
        if (bu < nlat) { const int tb = bu % (TT / 8), bh = bu / (TT / 8); b = bh >> 3; h = bh & 7; s = LC + tb * 8 + C.wave; nkeys = SS; }
        else { const int r = bu - nlat, tb = r % (LC / 8), bh = r / (LC / 8); b = bh >> 3; h = bh & 7; s = tb * 8 + C.wave; nkeys = LC; }
        const size_t m = (size_t)b * SS + s;
        asm volatile("s_waitcnt lgkmcnt(0)" ::: "memory");
        if (C.lane < 32) *(LAS u32x2*)(qs + C.lane * 8) = *(const u32x2*)(QN + m * 1024 + h * 128 + C.lane * 4);
        else if (C.lane < 48) *(LAS u32x2*)(qs + 256 + (C.lane - 32) * 8) = *(const u32x2*)(QP + m * 512 + h * 64 + (C.lane - 32) * 4);
        asm volatile("s_waitcnt lgkmcnt(0)" ::: "memory");
        float o[128];
#pragma unroll
        for (int e = 0; e < 128; ++e) o[e] = 0.f;
        float mrun = -1e30f, lrun = 0.f;
        for (int key = C.lane; key < nkeys; key += 64) {
            const size_t kr = (size_t)b * SS + key;
            const bf16_t* kn = KV + kr * 2048 + h * 128; const bf16_t* kro = MD + kr * 768 + 640;
            float dot = 0.f;
#pragma unroll 4
            for (int c = 0; c < 16; ++c) { const u32x4 kv = *(const u32x4*)(kn + c * 8); const u32x4 qv = *(const LAS u32x4*)(qs + c * 16);
                dot += lo_bf(kv.x) * lo_bf(qv.x) + hi_bf(kv.x) * hi_bf(qv.x) + lo_bf(kv.y) * lo_bf(qv.y) + hi_bf(kv.y) * hi_bf(qv.y)
                     + lo_bf(kv.z) * lo_bf(qv.z) + hi_bf(kv.z) * hi_bf(qv.z) + lo_bf(kv.w) * lo_bf(qv.w) + hi_bf(kv.w) * hi_bf(qv.w); }
#pragma unroll 4
            for (int c = 0; c < 8; ++c) { const u32x4 kv = *(const u32x4*)(kro + c * 8); const u32x4 qv = *(const LAS u32x4*)(qs + 256 + c * 16);
                dot += lo_bf(kv.x) * lo_bf(qv.x) + hi_bf(kv.x) * hi_bf(qv.x) + lo_bf(kv.y) * lo_bf(qv.y) + hi_bf(kv.y) * hi_bf(qv.y)
                     + lo_bf(kv.z) * lo_bf(qv.z) + hi_bf(kv.z) * hi_bf(qv.z) + lo_bf(kv.w) * lo_bf(qv.w) + hi_bf(kv.w) * hi_bf(qv.w); }
            const float mnew = fmaxf(mrun, dot), alpha = exp2f(mrun - mnew), p = exp2f(dot - mnew);
            lrun = lrun * alpha + p; mrun = mnew;
            const bf16_t* vrow = KV + kr * 2048 + 1024 + h * 128;
#pragma unroll
            for (int c = 0; c < 16; ++c) { const u32x4 vv = *(const u32x4*)(vrow + c * 8);
                o[c * 8 + 0] = o[c * 8 + 0] * alpha + p * lo_bf(vv.x); o[c * 8 + 1] = o[c * 8 + 1] * alpha + p * hi_bf(vv.x);
                o[c * 8 + 2] = o[c * 8 + 2] * alpha + p * lo_bf(vv.y); o[c * 8 + 3] = o[c * 8 + 3] * alpha + p * hi_bf(vv.y);
                o[c * 8 + 4] = o[c * 8 + 4] * alpha + p * lo_bf(vv.z); o[c * 8 + 5] = o[c * 8 + 5] * alpha + p * hi_bf(vv.z);
                o[c * 8 + 6] = o[c * 8 + 6] * alpha + p * lo_bf(vv.w); o[c * 8 + 7] = o[c * 8 + 7] * alpha + p * hi_bf(vv.w); }
        }
        const float mall = wave_max(mrun), fsc = exp2f(mrun - mall);
        const float lall = wave_sum(lrun * fsc);
#pragma unroll
        for (int e = 0; e < 128; ++e) o[e] *= fsc;
        RS_STEP(o, 128, 32); RS_STEP(o, 64, 16); RS_STEP(o, 32, 8); RS_STEP(o, 16, 4); RS_STEP(o, 8, 2); RS_STEP(o, 4, 1);
        const float inv = 1.f / lall;
        *(unsigned*)(QN + m * 1024 + h * 128 + 2 * C.lane) = pk2(o[0] * inv, o[1] * inv);
    }
}

__device__ __forceinline__ void phase_conv(Ctx& C, int l, const bf16_t* XA, bf16_t* U) {
    const float* cw = INP(8) + l * 4 * 1024; const float* cb = INP(9) + l * 1024;
    const int gt = C.bid * NTHR + C.tid, ngt = C.G * NTHR;
    for (int it = gt; it < MR * 128; it += ngt) {
        const int m = it >> 7, c0 = (it & 127) * 8, b = m / SS, s = m - b * SS;
        const int lo = (s < LC) ? 0 : LC, hi = (s < LC) ? LC : SS;
        float a[8];
#pragma unroll
        for (int e = 0; e < 8; ++e) a[e] = cb[c0 + e];
#pragma unroll
        for (int j = 0; j < 4; ++j) { const int sj = s + j - 2;
            if (sj >= lo && sj < hi) { const u32x4 xv = *(const u32x4*)(XA + (size_t)(b * SS + sj) * 1024 + c0); const float* w = cw + j * 1024 + c0;
                a[0] += w[0] * lo_bf(xv.x); a[1] += w[1] * hi_bf(xv.x); a[2] += w[2] * lo_bf(xv.y); a[3] += w[3] * hi_bf(xv.y);
                a[4] += w[4] * lo_bf(xv.z); a[5] += w[5] * hi_bf(xv.z); a[6] += w[6] * lo_bf(xv.w); a[7] += w[7] * hi_bf(xv.w); } }
        u32x4 o; o.x = pk2(a[0], a[1]); o.y = pk2(a[2], a[3]); o.z = pk2(a[4], a[5]); o.w = pk2(a[6], a[7]);
        *(u32x4*)(U + (size_t)m * 1024 + c0) = o;
    }
}
typedef f16_t f16x2 __attribute__((ext_vector_type(2)));
__device__ __forceinline__ void phase_scan1(Ctx& C, int d, const f16_t* RI, float* SUM) {
    for (int un = C.gw; un < NB * 34 * 8; un += C.ngw) {
        const int cg_ = un & 7, sg = (un >> 3) % 34, b = (un >> 3) / 34, ch = cg_ * 128 + 2 * C.lane;
        float A0 = 1.f, A1 = 1.f, H0 = 0.f, H1 = 0.f;
        const f16_t* base = RI + (size_t)(b * SS + sg * 128) * 2048 + ch;
#pragma unroll 8
        for (int i = 0; i < 128; ++i) { const int r = d ? (127 - i) : i;
            const f16x2 la = *(const f16x2*)(base + (size_t)r * 2048), bc = *(const f16x2*)(base + (size_t)r * 2048 + 1024);
            const float a0 = exp2f((float)la[0]), a1 = exp2f((float)la[1]);
            H0 = a0 * H0 + (float)bc[0]; H1 = a1 * H1 + (float)bc[1]; A0 *= a0; A1 *= a1; }
        float* sp = SUM + ((size_t)(b * 34 + sg) * 1024 + ch) * 2;
        *(f32x4*)sp = (f32x4){A0, H0, A1, H1};
    }
}
__device__ __forceinline__ void phase_scan3(Ctx& C, int d, const f16_t* RI, const float* SUM, bf16_t* YA) {
    for (int un = C.gw; un < NB * 34 * 8; un += C.ngw) {
        const int cg_ = un & 7, sg = (un >> 3) % 34, b = (un >> 3) / 34, ch = cg_ * 128 + 2 * C.lane;
        float H0 = 0.f, H1 = 0.f;
        const int npre = d ? ((sg < 2) ? (1 - sg) : (35 - sg)) : sg;
        for (int p = 0; p < npre; ++p) { const int ps = d ? ((p < 2) ? (1 - p) : (35 - p)) : p;
            const f32x4 v = *(const f32x4*)(SUM + ((size_t)(b * 34 + ps) * 1024 + ch) * 2);
            H0 = v[0] * H0 + v[1]; H1 = v[2] * H1 + v[3]; }
        const f16_t* base = RI + (size_t)(b * SS + sg * 128) * 2048 + ch;
        bf16_t* yb = YA + (size_t)(b * SS + sg * 128) * 1024 + ch;
#pragma unroll 8
        for (int i = 0; i < 128; ++i) { const int r = d ? (127 - i) : i;
            const f16x2 la = *(const f16x2*)(base + (size_t)r * 2048), bc = *(const f16x2*)(base + (size_t)r * 2048 + 1024);
            const float a0 = exp2f((float)la[0]), a1 = exp2f((float)la[1]);
            H0 = a0 * H0 + (float)bc[0]; H1 = a1 * H1 + (float)bc[1];
            unsigned* yp = (unsigned*)(yb + (size_t)r * 1024);
            if (d == 0) *yp = pk2(H0, H1); else { const unsigned w = *yp; *yp = pk2(lo_bf(w) + H0, hi_bf(w) + H1); } }
    }
}

#define GSYNC() grid.sync()
__global__ void __launch_bounds__(NTHR) fwd_kernel(Params prm) {
    extern __shared__ __attribute__((aligned(16))) unsigned char lds_raw[];
    cg::grid_group grid = cg::this_grid();
    LAS unsigned char* const ldsb = (LAS unsigned char*)lds_raw;
#define CTX Ctx C = mkctx(ldsb)
#define WSB wsp_(C.ws)
#define bYB ((bf16_t*)(WSB + AR_YB))
#define bXA ((bf16_t*)(WSB + AR_XA))
#define bMD ((bf16_t*)(WSB + AR_MD))
#define bRQKV ((bf16_t*)(WSB + AR_RQKV))
#define bKV ((bf16_t*)(WSB + AR_KV))
#define bQN ((bf16_t*)(WSB + AR_QN))
#define bQP ((bf16_t*)(WSB + AR_QP))
#define bRI ((f16_t*)(WSB + AR_RI))
#define bSUM ((float*)(WSB + AR_SUM))
#define bZ ((bf16_t*)(WSB + AR_Z))
#define xc1 ((float*)(WSB + WS_XC1))

    { CTX; phase_prep(C); }
    for (int l = 0; l < 2; ++l) {
        const bool with_ctx = (l == 0); const int lat_only = with_ctx ? 0 : 1;
        { CTX; phase_wconv_early(C, l); }
        GSYNC();
        { CTX; phase_h(C, l, bYB); }
        GSYNC();
        {   CTX;
            ProbPlain P{bYB, (const bf16_t*)(WSB + W_WT1), 1024, 1024, 1024};
            pg8::StaticOrder S; S.init(68, 19, C.G, C.bid, 0);
            typedef EpiStore3<AR_XA, 1024, AR_RQKV, 3072, AR_MD, 768, 4, 16> Ep; Ep E{WSB};
            pg8::gemm_phase<Ep, ProbPlain, pg8::StaticOrder, true>(C.lds, P, S, E);
        }
        GSYNC();
        { CTX; phase_ret_rope(C, bRQKV); }
        { CTX; phase_md_post(C, l, bMD); }
        GSYNC();
        { CTX; phase_ret_naive(C, l, bRQKV, bYB); }
        GSYNC();
        { CTX; phase_ret_ln(C, l, bYB); }
        {   CTX; ProbPlain P{bMD, (const bf16_t*)(WSB + W_WTQ), 768, 384, 384};
            pg8::StaticOrder S; S.init(68, 6, C.G, C.bid, 0);
            typedef EpiStore3<AR_QN, 1024, AR_QP, 512, AR_QP, 512, 4, 6> Ep; Ep E{WSB};
            pg8::gemm_phase<Ep, ProbPlain, pg8::StaticOrder, true>(C.lds, P, S, E);
        }
        {   CTX; ProbPlain P{bMD + 384, (const bf16_t*)(WSB + W_WTKV), 768, 256, 256};
            pg8::StaticOrder S; S.init(68, 8, C.G, C.bid, 0);
            typedef EpiStore3<AR_KV, 2048, AR_KV, 2048, AR_KV, 2048, 8, 8> Ep; Ep E{WSB};
            pg8::gemm_phase<Ep, ProbPlain, pg8::StaticOrder, true>(C.lds, P, S, E);
        }
        GSYNC();
        { CTX; phase_qk_post(C, l, bQN, bQP, bKV); }
        GSYNC();
        { CTX; phase_attn_naive(C, with_ctx, bQN, bQP, bKV, bMD); }
        GSYNC();
        { CTX; phase_conv(C, l, bXA, bMD  ); }
        GSYNC();
        for (int d = 0; d < 2; ++d) {
            {   CTX; ProbLru P{bMD, (const bf16_t*)(WSB + W_WTL) + (size_t)d * 2048 * 256, 256, 256};
                pg8::StaticOrder S; S.init(68, 8, C.G, C.bid, 0);
                EpiLru E{bMD, bRI, INP(11) + (l * 2 + d) * 1024, INP(13) + (l * 2 + d) * 1024, C.ctl + CT_SP + (l * 2 + d) * 1024};
                pg8::gemm_phase<EpiLru, ProbLru, pg8::StaticOrder, true>(C.lds, P, S, E);
            }
            GSYNC();
            { CTX; phase_scan1(C, d, bRI, bSUM); }
            GSYNC();
            { CTX; phase_scan3(C, d, bRI, bSUM, bXA  ); }
            GSYNC();
        }
        { CTX; phase_wconv_late(C, l); }
        { CTX; phase_h(C, l, bMD  ); }
        GSYNC();
        {   CTX; ProbPlain P{bMD, (const bf16_t*)(WSB + W_WTG), 1024, 1024, 1024};
            pg8::StaticOrder S; S.init(lat_only ? 64 : 68, 12, C.G, C.bid, lat_only);
            EpiGate E{WSB};
            pg8::gemm_phase<EpiGate, ProbPlain, pg8::StaticOrder, true>(C.lds, P, S, E);
        }
        GSYNC();
        {   CTX; ProbD P{WSB, 1024, 1024};
            pg8::ChainOrder S; S.init(lat_only ? 64 : 68, C.G, C.bid, lat_only);
            EpiD E{bZ, WSB + AR_GS + (size_t)C.bid * 131072};
            pg8::gemm_phase<EpiD, ProbD, pg8::ChainOrder, true>(C.lds, P, S, E);
        }
        GSYNC();
        {   CTX; ProbPlain P{bZ, (const bf16_t*)(WSB + W_WTO), 1024, 1024, 1024};
            pg8::StaticOrder S; S.init(lat_only ? 64 : 68, 4, C.G, C.bid, lat_only);
            EpiOut E{(l == 0) ? INP(0) : (const float*)C.out, INP(2), C.out, xc1, C.ctl + CT_MOD + l * 5 * 3072};
            pg8::gemm_phase<EpiOut, ProbPlain, pg8::StaticOrder, true>(C.lds, P, S, E);
        }
        GSYNC();
    }
}

#undef xc1
#undef bZ
extern "C" void kernel_launch(void* const* d_in, const int* in_sizes, int n_in, void* d_out, int out_size, void* d_ws, size_t ws_size, hipStream_t stream) {
    static int grid = 0;
    if (grid == 0) {
        if (n_in != 29 || out_size != NB * TT * DM || ws_size < WS_END) { fprintf(stderr, "kernel_launch: unexpected shapes (n_in %d out %d ws %zu)\n", n_in, out_size, ws_size); grid = -1; return; }
        int dev = 0, cus = 0, per_cu = 0;
        hipGetDevice(&dev);
        hipDeviceGetAttribute(&cus, hipDeviceAttributeMultiprocessorCount, dev);
        if (hipFuncSetAttribute((const void*)fwd_kernel, hipFuncAttributeMaxDynamicSharedMemorySize, LDS_BYTES) != hipSuccess) { fprintf(stderr, "kernel_launch: hipFuncSetAttribute failed\n"); grid = -1; return; }
        if (hipOccupancyMaxActiveBlocksPerMultiprocessor(&per_cu, (const void*)fwd_kernel, NTHR, LDS_BYTES) != hipSuccess || per_cu < 1) { fprintf(stderr, "kernel_launch: occupancy query failed (%d)\n", per_cu); (void)hipGetLastError(); per_cu = 1; }
        grid = cus;
        fprintf(stderr, "kernel_launch: cus %d per_cu %d grid %d\n", cus, per_cu, grid);
    }
    if (grid < 0) return;
    Params p{};
    for (int i = 0; i < 29; ++i) p.in[i] = (const float*)d_in[i];
    p.out = (float*)d_out; p.ws = (unsigned char*)d_ws;
    void* args[] = {&p};
    hipError_t e = hipLaunchCooperativeKernel((const void*)fwd_kernel, dim3(grid), dim3(NTHR), args, LDS_BYTES, stream);
    if (e != hipSuccess) fprintf(stderr, "cooperative launch failed: %s (grid %d)\n", hipGetErrorString(e), grid);
}
```

```cpp
#include <hip/hip_runtime.h>
#include <hip/hip_cooperative_groups.h>
#include <cstdio>
#include <cstdint>
namespace cg = cooperative_groups;

#define LAS __attribute__((address_space(3)))
typedef unsigned short bf16_t;
typedef short bf16x8 __attribute__((ext_vector_type(8)));
typedef float f32x4 __attribute__((ext_vector_type(4)));
typedef float f32x2 __attribute__((ext_vector_type(2)));
typedef unsigned u32x4 __attribute__((ext_vector_type(4)));
typedef unsigned u32x2 __attribute__((ext_vector_type(2)));
typedef _Float16 f16_t;

namespace pg8 {
constexpr int BM = 256, BK = 64, HALF = 128, HTB = HALF * BK * 2, STAGE_BYTES = 8 * HTB, NXCD = 8, WGM = 8;
__host__ __device__ __forceinline__ int lds_byte(int r, int c) { const int st = (r >> 4) * 2 + (c >> 5), rr = r & 15, cc = c & 31, ob = rr * 64 + cc * 2; return st * 1024 + (ob ^ (((ob >> 9) & 1) << 5)); }
__host__ __device__ __forceinline__ void stage_rc(int b, int& R, int& C) { const int st = b / 1024, sb = b % 1024, swz = sb ^ (((sb >> 9) & 1) << 5); R = (st >> 1) * 16 + swz / 64; C = (st & 1) * 32 + (swz % 64) / 2; }
__host__ __device__ __forceinline__ int perm32(int rho) { const int n = rho >> 4, i = rho & 15; return 8 * (i >> 2) + 4 * n + (i & 3); }

struct Unit { int pm, pn, z; };

struct StaticOrder {
    int nM, nN, nwg, G, c, latent_only;
    __device__ void init(int nM_, int nN_, int G_, int c_, int latent_only_) { nM = nM_; nN = nN_; nwg = nM * nN; G = G_; c = c_; latent_only = latent_only_; }
    __device__ bool next(int i, Unit& u) const {
        const long L = (long)i * G + c; if (L >= nwg) return false;
        int wgid = (int)L; { const int q = nwg / NXCD, r = nwg % NXCD, xcd = wgid % NXCD, off = wgid / NXCD; wgid = (xcd < r ? xcd * (q + 1) : r * (q + 1) + (xcd - r) * q) + off; }
        const int nig = WGM * nN, gid = wgid / nig, fm = gid * WGM, gsz = (nM - fm) < WGM ? (nM - fm) : WGM;
        int pm = fm + ((wgid % nig) % gsz); u.pn = (wgid % nig) / gsz; u.z = 0;
        if (latent_only) pm = (pm >> 4) * 17 + 1 + (pm & 15);
        u.pm = pm; return true;
    }
};
struct ChainOrder {
    int ntiles, G, c, latent_only;
    __device__ void init(int nM_, int G_, int c_, int latent_only_) { ntiles = nM_ * 4; G = G_; c = c_; latent_only = latent_only_; }
    __device__ bool next(int i, Unit& u) const {
        const int r = i / 6, z = i - r * 6; const long T = (long)r * G + c; if (T >= ntiles) return false;
        int pm = (int)(T >> 2); u.pn = (int)(T & 3); u.z = z;
        if (latent_only) pm = (pm >> 4) * 17 + 1 + (pm & 15);
        u.pm = pm; return true;
    }
};

typedef __bf16 bf16x2_t __attribute__((ext_vector_type(2)));
__device__ __forceinline__ unsigned cvt_pk_bf16(float lo, float hi) { f32x2 v = {lo, hi}; bf16x2_t b = __builtin_convertvector(v, bf16x2_t); return __builtin_bit_cast(unsigned, b); }

template <class Epi, class Prob, class Sched, bool ALIGN_EPI>
__device__ __forceinline__ void gemm_phase(LAS unsigned char* lds, const Prob& P, const Sched& S, const Epi& E) {
    int tid_ = threadIdx.x; asm volatile("" : "+v"(tid_));
    const int tid = tid_, wid = __builtin_amdgcn_readfirstlane(tid >> 6), lane = tid & 63, wr = wid >> 2, wc = wid & 3, fr = lane & 15, fq = lane >> 4;
    const int K = P.K, nt = K / BK;
    int RA[2], CA[2]; unsigned voffB[2];
#pragma unroll
    for (int i = 0; i < 2; ++i) { int R, C; stage_rc(tid * 16 + i * 8192, R, C); const int Rb = Epi::PERM ? ((R & ~31) + perm32(R & 31)) : R;
        RA[i] = R; CA[i] = C; voffB[i] = (unsigned)(Rb * P.ldb + C) * 2u; }
    const unsigned kstep = (unsigned)(BK * 2);
    const unsigned hstepB = (unsigned)(HALF * P.ldb * 2);
    const unsigned ldsw = (unsigned)wid * 1024u;
    const int aoff = lds_byte(wr * 64 + fr, fq * 8), boff = lds_byte(wc * 32 + fr, fq * 8);
#define PG8_SA(b, h) (((b) * 2 + (h)) * HTB)
#define PG8_SB(b, h) ((4 + (b) * 2 + (h)) * HTB)
#define PG8_STAGE(bufoff, gbase, soff, voff) do { _Pragma("unroll") for (int _i = 0; _i < 2; ++_i) \
        __builtin_amdgcn_global_load_lds((const unsigned*)((const char*)(gbase) + (unsigned)((voff)[_i] + (soff))), (LAS unsigned*)(lds + (bufoff) + ldsw + _i * 8192), 16, 0, 0); } while (0)
#define PG8_LDA(dst, b, h) do { _Pragma("unroll") for (int m = 0; m < 4; ++m) _Pragma("unroll") for (int k = 0; k < 2; ++k) dst[m][k] = *(const LAS bf16x8*)(lds + PG8_SA(b, h) + aoff + m * 2048 + k * 1024); } while (0)
#define PG8_LDB(dst, b, h) do { _Pragma("unroll") for (int n = 0; n < 2; ++n) _Pragma("unroll") for (int k = 0; k < 2; ++k) dst[n][k] = *(const LAS bf16x8*)(lds + PG8_SB(b, h) + boff + n * 2048 + k * 1024); } while (0)
#define PG8_MMA(ai, bj, At, Bt) do { __builtin_amdgcn_s_setprio(1); _Pragma("unroll") for (int m = 0; m < 4; ++m) _Pragma("unroll") for (int n = 0; n < 2; ++n) _Pragma("unroll") for (int k = 0; k < 2; ++k) \
        acc[ai][bj][m][n] = __builtin_amdgcn_mfma_f32_16x16x32_bf16(Bt[n][k], At[m][k], acc[ai][bj][m][n], 0, 0, 0); __builtin_amdgcn_s_setprio(0); } while (0)
#define PG8_WAIT_V(n) asm volatile("s_waitcnt vmcnt(" #n ")" ::: "memory")
#define PG8_WAIT_L(n) asm volatile("s_waitcnt lgkmcnt(" #n ")" ::: "memory")
#define PG8_BAR __builtin_amdgcn_s_barrier()
#define PG8_SCHED __builtin_amdgcn_sched_barrier(0)
    Unit cur, nxt; int ui = 0;
    if (!S.next(0, cur)) return;
    f32x4 acc[2][2][4][2];
#pragma unroll
    for (int a = 0; a < 2; ++a)
#pragma unroll
        for (int b = 0; b < 2; ++b)
#pragma unroll
            for (int m = 0; m < 4; ++m)
#pragma unroll
                for (int n = 0; n < 2; ++n) acc[a][b][m][n] = (f32x4){0.f, 0.f, 0.f, 0.f};
    bf16x8 At[4][2], B0[2][2], B1[2][2];
    const char* cA; const char* cB; int ldaC; P.get(cur, cA, cB, ldaC);
    unsigned voffA[2] = {(unsigned)(RA[0] * ldaC + CA[0]) * 2u, (unsigned)(RA[1] * ldaC + CA[1]) * 2u};
    unsigned hstepA = (unsigned)(HALF * ldaC * 2);
    PG8_STAGE(PG8_SB(0, 0), cB, 0u, voffB); PG8_STAGE(PG8_SB(0, 1), cB, hstepB, voffB); PG8_STAGE(PG8_SA(0, 0), cA, 0u, voffA); PG8_STAGE(PG8_SA(0, 1), cA, hstepA, voffA);
    if (wr == 1) PG8_BAR;
    PG8_WAIT_V(2); PG8_BAR;
    PG8_STAGE(PG8_SB(1, 0), cB, kstep, voffB); PG8_STAGE(PG8_SA(1, 0), cA, kstep, voffA); PG8_STAGE(PG8_SB(1, 1), cB, hstepB + kstep, voffB);
    PG8_WAIT_V(6); PG8_BAR;
    for (;;) {
        const bool has_next = S.next(ui + 1, nxt);
        const char* nA = cA; const char* nB = cB; int ldaN = ldaC;
        if (has_next) P.get(nxt, nA, nB, ldaN);
        unsigned voffAn[2] = {(unsigned)(RA[0] * ldaN + CA[0]) * 2u, (unsigned)(RA[1] * ldaN + CA[1]) * 2u};
        const unsigned hstepAn = (unsigned)(HALF * ldaN * 2);
        for (int t = 0; t < nt; t += 2) {
            const bool last = (t == nt - 2);
            const unsigned o1 = (unsigned)(t + 1) * kstep;
            const char* a2b = last ? nA : cA; const char* b2b = last ? nB : cB;
            const unsigned o2 = last ? 0u : (unsigned)(t + 2) * kstep, o3 = o2 + kstep;
            unsigned vA2[2] = {last ? voffAn[0] : voffA[0], last ? voffAn[1] : voffA[1]};
            const unsigned hA2 = last ? hstepAn : hstepA;
            PG8_LDB(B0, 0, 0); PG8_LDB(B1, 0, 1); PG8_SCHED; PG8_LDA(At, 0, 0); PG8_STAGE(PG8_SA(1, 1), cA, o1 + hstepA, voffA);
            PG8_WAIT_V(8); PG8_WAIT_L(0); PG8_BAR; PG8_MMA(0, 0, At, B0); PG8_MMA(0, 1, At, B1); PG8_BAR; PG8_SCHED;
            PG8_LDA(At, 0, 1); PG8_STAGE(PG8_SB(0, 0), b2b, o2, voffB); PG8_STAGE(PG8_SB(0, 1), b2b, o2 + hstepB, voffB); PG8_STAGE(PG8_SA(0, 0), a2b, o2, vA2);
            PG8_WAIT_V(8); PG8_WAIT_L(0); PG8_BAR; PG8_MMA(1, 0, At, B0); PG8_MMA(1, 1, At, B1); PG8_BAR; PG8_SCHED;
            PG8_LDB(B0, 1, 0); PG8_LDB(B1, 1, 1); PG8_SCHED; PG8_LDA(At, 1, 0); PG8_STAGE(PG8_SA(0, 1), a2b, o2 + hA2, vA2);
            PG8_WAIT_V(8); PG8_WAIT_L(0); PG8_BAR; PG8_MMA(0, 0, At, B0); PG8_MMA(0, 1, At, B1); PG8_BAR; PG8_SCHED;
            PG8_LDA(At, 1, 1); PG8_STAGE(PG8_SB(1, 0), b2b, o3, voffB); PG8_STAGE(PG8_SB(1, 1), b2b, o3 + hstepB, voffB); PG8_STAGE(PG8_SA(1, 0), a2b, o3, vA2);
            PG8_WAIT_V(8); PG8_WAIT_L(0); PG8_BAR; PG8_MMA(1, 0, At, B0); PG8_MMA(1, 1, At, B1); PG8_BAR; PG8_SCHED;
        }
        if constexpr (ALIGN_EPI) { if (wr == 0) PG8_BAR; }
        E(acc, cur, wr, wc, fr, fq);
        if (!has_next) break;
#pragma unroll
        for (int a = 0; a < 2; ++a)
#pragma unroll
            for (int b = 0; b < 2; ++b)
#pragma unroll
                for (int m = 0; m < 4; ++m)
#pragma unroll
                    for (int n = 0; n < 2; ++n) acc[a][b][m][n] = (f32x4){0.f, 0.f, 0.f, 0.f};
        cur = nxt; cA = nA; cB = nB; ldaC = ldaN; voffA[0] = voffAn[0]; voffA[1] = voffAn[1]; hstepA = hstepAn; ++ui;
        if constexpr (ALIGN_EPI) { if (wr == 1) PG8_BAR; }
    }
    PG8_WAIT_V(0);
    if constexpr (!ALIGN_EPI) { if (wr == 0) PG8_BAR; }
    PG8_BAR;
#undef PG8_SA
#undef PG8_SB
#undef PG8_STAGE
#undef PG8_LDA
#undef PG8_LDB
#undef PG8_MMA
#undef PG8_WAIT_V
#undef PG8_WAIT_L
#undef PG8_BAR
#undef PG8_SCHED
}
}

constexpr int NB = 4, TT = 4096, LC = 256, SS = TT + LC  , DM = 1024, MR = NB * SS  ;
constexpr int INC = 10944;
constexpr float EPS = 1e-6f;
constexpr float LOG2E = 1.4426950408889634f;
constexpr float QSCALE = 0.07216878364870322f * 1.4426950408889634f;
constexpr int NWAVES = 8, NTHR = 512;

constexpr size_t MiB = 1u << 20;
constexpr size_t WS_CTL = 0;
constexpr size_t WS_XC1 = 1 * MiB;
constexpr size_t WS_W = 5 * MiB;
constexpr size_t WS_AR = 25 * MiB;
constexpr size_t AR_YB = WS_AR + 0 * MiB;
constexpr size_t AR_XA = WS_AR + 34 * MiB;
constexpr size_t AR_MD = WS_AR + 68 * MiB;
constexpr size_t AR_RQKV = WS_AR + 94 * MiB;
constexpr size_t AR_OB = WS_AR + 196 * MiB;
constexpr size_t AR_KV = WS_AR + 112 * MiB;
constexpr size_t AR_QN = WS_AR + 180 * MiB;
constexpr size_t AR_QP = WS_AR + 214 * MiB;
constexpr size_t AR_RI = WS_AR + 102 * MiB;
constexpr size_t AR_SUM = WS_AR + 170 * MiB;
constexpr size_t AR_Z = WS_AR + 102 * MiB;
constexpr size_t AR_GS = WS_AR + 136 * MiB;
constexpr size_t WS_END = 256 * MiB;
constexpr size_t W_WT1 = WS_W;
constexpr size_t W_WTQ = WS_W + 10 * MiB;
constexpr size_t W_WTKV = WS_W + 12 * MiB;
constexpr size_t W_WTL = WS_W + 13 * MiB;
constexpr size_t W_WTG = WS_W;
constexpr size_t W_WTGM = WS_W + 6 * MiB;
constexpr size_t W_WTD = WS_W + 12 * MiB;
constexpr size_t W_WTO = WS_W + 18 * MiB;
constexpr int CT_MOD = 16384;
constexpr int CT_ROPER = CT_MOD + 2 * 5 * 3072;
constexpr int CT_ROPEM = CT_ROPER + 2 * 4096;
constexpr int CT_SP = CT_ROPEM + 2 * 1024;
constexpr int CT_LG = CT_SP + 4096;
constexpr int CT_END = CT_LG + 16;
static_assert(CT_END * 4 <= (int)MiB, "CTL");

constexpr int LDS_BYTES = 147456;

struct Params {
    const float* in[29];
    float* out;
    unsigned char* ws;
};

#define EX2(x) __builtin_amdgcn_exp2f(x)
#define RSQ(x) __builtin_amdgcn_rsqf(x)
#define SQRT(x) __builtin_amdgcn_sqrtf(x)
__device__ __forceinline__ float bf2f(unsigned v) { return __uint_as_float(v << 16); }
__device__ __forceinline__ unsigned f2bf(float f) { unsigned u = __float_as_uint(f); return (u + 0x7fffu + ((u >> 16) & 1u)) >> 16; }
__device__ __forceinline__ unsigned pk2(float lo, float hi) { return f2bf(lo) | (f2bf(hi) << 16); }
__device__ __forceinline__ float lo_bf(unsigned w) { return __uint_as_float(w << 16); }
__device__ __forceinline__ float hi_bf(unsigned w) { return __uint_as_float(w & 0xffff0000u); }
__device__ __forceinline__ float wave_sum(float v) {
#pragma unroll
    for (int o = 1; o < 64; o <<= 1) v += __shfl_xor(v, o);
    return v;
}
__device__ __forceinline__ float wave_max(float v) {
#pragma unroll
    for (int o = 1; o < 64; o <<= 1) v = fmaxf(v, __shfl_xor(v, o));
    return v;
}
__device__ __forceinline__ float sigmoidf_(float x) { return __builtin_amdgcn_rcpf(1.f + __expf(-x)); }
__device__ __forceinline__ float siluf_(float x) { return x * __builtin_amdgcn_rcpf(1.f + __expf(-x)); }

__device__ __forceinline__ const float* inp_(int i) { asm volatile("" : "+s"(i)); const float* const* ka = (const float* const*)__builtin_amdgcn_kernarg_segment_ptr(); return ka[i]; }
#define INP(i) inp_(i)
__device__ __forceinline__ unsigned char* wsp_(unsigned char* p) { asm volatile("" : "+s"(p)); return p; }
struct Ctx {
    float* out; unsigned char* ws; LAS unsigned char* lds; int tid, lane, wave, G, bid;
    int gw, ngw;
    int rot;
    float* ctl;
};

__device__ __forceinline__ Ctx mkctx(LAS unsigned char* lds) {
    Ctx C; int t = threadIdx.x; asm volatile("" : "+v"(t)); int b = blockIdx.x; asm volatile("" : "+s"(b)); int g = gridDim.x; asm volatile("" : "+s"(g));
    C.tid = t; C.lane = t & 63; C.wave = __builtin_amdgcn_readfirstlane(t >> 6); C.bid = b; C.G = g; C.gw = b * NWAVES + C.wave; C.ngw = g * NWAVES; C.rot = 0;
    int io = 29, iw = 30; asm volatile("" : "+s"(io)); asm volatile("" : "+s"(iw));
    unsigned char* const* ka = (unsigned char* const*)__builtin_amdgcn_kernarg_segment_ptr();
    C.out = (float*)ka[io]; C.ws = ka[iw]; C.ctl = (float*)(C.ws + WS_CTL); C.lds = lds;
    return C;
}
__device__ __forceinline__ const float* resid_row(const Ctx& C, int l, int m) {
    const int b = m / SS, s = m - b * SS;
    if (s < LC) { const float* base = (l == 0) ? INP(2) : (const float*)(C.ws + WS_XC1); return base + (size_t)(b * LC + s) * DM; }
    const float* base = (l == 0) ? INP(0) : C.out; return base + (size_t)(b * TT + (s - LC)) * DM;
}

__device__ __forceinline__ void phase_prep(Ctx& C) {
    LAS float* sl = (LAS float*)C.lds;
    LAS float* red = (LAS float*)(C.lds + 32768);
    for (int i = C.tid; i < 5 * 1024; i += NTHR) { const int r = i >> 10, k = i & 1023; const float v = (r < 4) ? INP(1)[r * 1024 + k] : INP(3)[k]; sl[i] = siluf_(v); }
    __syncthreads();
    for (int it = C.bid; it < 2 * 96; it += C.G) {
        const int l = it / 96, grp = it % 96, kg = C.tid >> 5, cj = C.tid & 31, col = grp * 32 + cj;
        const float* w = INP(4) + (size_t)l * 1024 * 3072 + col;
        float a0 = 0.f, a1 = 0.f, a2 = 0.f, a3 = 0.f, a4 = 0.f;
#pragma unroll 8
        for (int k = kg * 64; k < kg * 64 + 64; ++k) { const float wv = w[(size_t)k * 3072]; a0 += sl[k] * wv; a1 += sl[1024 + k] * wv; a2 += sl[2048 + k] * wv; a3 += sl[3072 + k] * wv; a4 += sl[4096 + k] * wv; }
        red[(kg * 32 + cj) * 5 + 0] = a0; red[(kg * 32 + cj) * 5 + 1] = a1; red[(kg * 32 + cj) * 5 + 2] = a2; red[(kg * 32 + cj) * 5 + 3] = a3; red[(kg * 32 + cj) * 5 + 4] = a4;
        __syncthreads();
        if (C.tid < 160) { const int c2 = C.tid / 5, r = C.tid % 5; float s = 0.f;
            for (int g = 0; g < 16; ++g) s += red[(g * 32 + c2) * 5 + r];
            C.ctl[CT_MOD + (l * 5 + r) * 3072 + grp * 32 + c2] = s + INP(5)[l * 3072 + grp * 32 + c2]; }
        __syncthreads();
    }
    const int gt = C.bid * NTHR + C.tid, ngt = C.G * NTHR;
    for (int i = gt; i < 4096; i += ngt) { const int pos = i >> 6, f = i & 63; const float inv = powf(10000.f, -(float)f / 64.f), ang = (float)pos * inv;
        C.ctl[CT_ROPER + i] = cosf(ang); C.ctl[CT_ROPER + 4096 + i] = sinf(ang); }
    for (int i = gt; i < 1024; i += ngt) { const int pos = i >> 4, f = i & 15; const float inv = powf(10000.f, -(float)f / 16.f), ang = (float)pos * inv;
        C.ctl[CT_ROPEM + i] = cosf(ang); C.ctl[CT_ROPEM + 1024 + i] = sinf(ang); }
    for (int i = gt; i < 4096; i += ngt) C.ctl[CT_SP + i] = log1pf(expf(-INP(14)[i]));
    for (int i = gt; i < 16; i += ngt) C.ctl[CT_LG + i] = -log1pf(expf(-INP(15)[i])) * LOG2E;
}

__device__ __forceinline__ void tr_item(const float* W, int ldw, int k0, int n0, bf16_t* WT, int ldt, int drow0, int dk0, LAS float* scr, int lane) {
#pragma unroll 8
    for (int i = 0; i < 32; ++i) { const int kk = 2 * i + (lane >> 5); scr[kk * 33 + (lane & 31)] = W[(size_t)(k0 + kk) * ldw + n0 + (lane & 31)]; }
    asm volatile("s_waitcnt lgkmcnt(0)" ::: "memory");
    const int c = lane & 7;
#pragma unroll
    for (int j = 0; j < 4; ++j) { const int n = (lane >> 3) + 8 * j; const LAS float* s = scr + (8 * c) * 33 + n;
        u32x4 o; o.x = pk2(s[0 * 33], s[1 * 33]); o.y = pk2(s[2 * 33], s[3 * 33]); o.z = pk2(s[4 * 33], s[5 * 33]); o.w = pk2(s[6 * 33], s[7 * 33]);
        *(u32x4*)(WT + (size_t)(drow0 + n) * ldt + dk0 + 8 * c) = o; }
    asm volatile("s_waitcnt lgkmcnt(0)" ::: "memory");
}
__device__ __forceinline__ void conv_rows(Ctx& C, const float* W, int ldw, int K, int scol0, bf16_t* WT, int ldt, int drow0, int dk0, int nrows, LAS float* scr) {
    const int nkb = K / 64, items = nkb * (nrows / 32);
    int g0 = C.gw - C.rot; if (g0 < 0) g0 += C.ngw; C.rot = (C.rot + items) % C.ngw;
    for (int it = g0; it < items; it += C.ngw) { const int nb = it / nkb, kb = it - nb * nkb;
        tr_item(W, ldw, kb * 64, scol0 + nb * 32, WT, ldt, drow0 + nb * 32, dk0 + kb * 64, scr, C.lane); }
}
__device__ __forceinline__ void zero_rows(Ctx& C, bf16_t* WT, int ldt, int drow0, int dk0, int nrows, int ncols) {
    const int per = ncols / 8, items = nrows * per;
    int g0 = C.gw - C.rot; if (g0 < 0) g0 += C.ngw; C.rot = (C.rot + (items + 63) / 64) % C.ngw;
    for (int it = g0 * 64 + C.lane; it < items; it += C.ngw * 64) { const int r = it / per, c = it - r * per; *(u32x4*)(WT + (size_t)(drow0 + r) * ldt + dk0 + c * 8) = (u32x4){0u, 0u, 0u, 0u}; }
}
__device__ __forceinline__ void phase_wconv_early(Ctx& C, int l) {
    LAS float* scr = (LAS float*)(C.lds + C.wave * 16384);
    unsigned char* ws = C.ws;
    const float* win = INP(7) + (size_t)l * 1024 * INC;
    bf16_t* WT1 = (bf16_t*)(ws + W_WT1);
    conv_rows(C, win, INC, 1024, 0, WT1, 1024, 0, 0, 1024, scr);
    conv_rows(C, win, INC, 1024, 2048, WT1, 1024, 1024, 0, 3072, scr);
    conv_rows(C, win, INC, 1024, 6144, WT1, 1024, 4096, 0, 704, scr);
    zero_rows(C, WT1, 1024, 4800, 0, 64, 1024);
    const float* wq = INP(18) + (size_t)l * 384 * 1536; bf16_t* WTQ = (bf16_t*)(ws + W_WTQ);
    for (int h = 0; h < 8; ++h) { conv_rows(C, wq, 1536, 384, h * 192, WTQ, 384, h * 128, 0, 128, scr); conv_rows(C, wq, 1536, 384, h * 192 + 128, WTQ, 384, 1024 + h * 64, 0, 64, scr); }
    const float* wkv = INP(20) + (size_t)l * 256 * 2048; bf16_t* WTKV = (bf16_t*)(ws + W_WTKV);
    for (int h = 0; h < 8; ++h) { conv_rows(C, wkv, 2048, 256, h * 256, WTKV, 256, h * 128, 0, 128, scr); conv_rows(C, wkv, 2048, 256, h * 256 + 128, WTKV, 256, 1024 + h * 128, 0, 128, scr); }
    bf16_t* WTL = (bf16_t*)(ws + W_WTL);
    for (int d = 0; d < 2; ++d) for (int n = 0; n < 8; ++n) for (int mat = 0; mat < 2; ++mat) {
        const float* w = INP(mat == 0 ? 10 : 12) + ((size_t)(l * 2 + d) * 8 + n) * 128 * 128;
        const int drow0 = d * 2048 + n * 256 + mat * 128;
        conv_rows(C, w, 128, 128, 0, WTL, 256, drow0, (n & 1) * 128, 128, scr);
        zero_rows(C, WTL, 256, drow0, ((n & 1) ^ 1) * 128, 128, 128);
    }
}
__device__ __forceinline__ void phase_wconv_late(Ctx& C, int l) {
    LAS float* scr = (LAS float*)(C.lds + C.wave * 16384);
    unsigned char* ws = C.ws;
    const float* win = INP(7) + (size_t)l * 1024 * INC;
    bf16_t* WTG = (bf16_t*)(ws + W_WTG);
    conv_rows(C, win, INC, 1024, 1024, WTG, 1024, 0, 0, 1024, scr);
    conv_rows(C, win, INC, 1024, 5120, WTG, 1024, 1024, 0, 1024, scr);
    conv_rows(C, win, INC, 1024, 6848, WTG, 1024, 2048, 0, 1024, scr);
    conv_rows(C, win, INC, 1024, 7872, (bf16_t*)(ws + W_WTGM), 1024, 0, 0, 3072, scr);
    for (int i = 0; i < 3; ++i) conv_rows(C, INP(25 + i) + (size_t)l * 1024 * 1024, 1024, 1024, 0, (bf16_t*)(ws + W_WTD) + (size_t)i * 1024 * 1024, 1024, 0, 0, 1024, scr);
    conv_rows(C, INP(28) + (size_t)l * 1024 * 1024, 1024, 1024, 0, (bf16_t*)(ws + W_WTO), 1024, 0, 0, 1024, scr);
}

__device__ __forceinline__ void phase_h(Ctx& C, int l, bf16_t* H) {
    const float* gain = INP(6) + l * 1024;
    for (int m = C.gw; m < MR; m += C.ngw) {
        const int b = m / SS, s = m - b * SS, r = (s < LC) ? 4 : b;
        const float* xr = resid_row(C, l, m);
        const float* mod = C.ctl + CT_MOD + (l * 5 + r) * 3072;
        f32x4 v[4]; float ss = 0.f;
#pragma unroll
        for (int j = 0; j < 4; ++j) { v[j] = *(const f32x4*)(xr + 4 * C.lane + 256 * j); ss += (v[j].x * v[j].x + v[j].y * v[j].y) + (v[j].z * v[j].z + v[j].w * v[j].w); }
        const float rstd = RSQ(wave_sum(ss) * (1.f / 1024.f) + EPS);
#pragma unroll
        for (int j = 0; j < 4; ++j) { const int c = 4 * C.lane + 256 * j;
            const f32x4 g = *(const f32x4*)(gain + c), sh = *(const f32x4*)(mod + c), sc = *(const f32x4*)(mod + 1024 + c);
            const f32x4 y = (v[j] * rstd) * g;
            const f32x4 o = y * (sc + 1.0f) + sh;
            u32x2 w; w.x = pk2(o.x, o.y); w.y = pk2(o.z, o.w);
            *(u32x2*)(H + (size_t)m * 1024 + c) = w; }
    }
}

using pg8::Unit;
struct ProbPlain {
    const bf16_t* A; const bf16_t* Bt; int lda, ldb, K;
    __device__ __forceinline__ void get(const Unit& u, const char*& a, const char*& b, int& lda_) const {
        a = (const char*)(A + (size_t)u.pm * 256 * lda); b = (const char*)(Bt + (size_t)u.pn * 256 * ldb); lda_ = lda; }
};
struct ProbLru {
    const bf16_t* A; const bf16_t* Bt; int ldb, K;
    __device__ __forceinline__ void get(const Unit& u, const char*& a, const char*& b, int& lda_) const {
        a = (const char*)(A + (size_t)u.pm * 256 * 1024 + (u.pn >> 1) * 256); b = (const char*)(Bt + (size_t)u.pn * 256 * 256); lda_ = 1024; }
};
struct ProbD {
    unsigned char* ws; int ldb, K;
    __device__ __forceinline__ void get(const Unit& u, const char*& a, const char*& b, int& lda_) const {
        const int i = u.z >> 1;
        if ((u.z & 1) == 0) { a = (const char*)(ws + AR_MD + (size_t)u.pm * 256 * 1024 * 2); b = (const char*)(ws + W_WTGM + ((size_t)i * 1024 + u.pn * 256) * 1024 * 2); lda_ = 1024; }
        else { const size_t yo = (i == 0) ? AR_XA : (i == 1) ? AR_YB : AR_QN;
            a = (const char*)(ws + yo + (size_t)u.pm * 256 * 1024 * 2); b = (const char*)(ws + W_WTD + ((size_t)i * 1024 + u.pn * 256) * 1024 * 2); lda_ = 1024; }
    }
};

#define EPI_ARGS const f32x4 (&acc)[2][2][4][2], const Unit& u, int wr, int wc, int fr, int fq
template <size_t O0, int L0, size_t O1, int L1, size_t O2, int L2, int T1, int T2>
struct EpiStore3 {
    static constexpr bool PERM = true;
    unsigned char* ws;
    __device__ __forceinline__ void operator()(EPI_ARGS) const {
        bf16_t* bs; int ldc, ct;
        size_t off;
        if (u.pn < T1) { off = O0; ldc = L0; ct = u.pn; } else if (u.pn < T2) { off = O1; ldc = L1; ct = u.pn - T1; } else { off = O2; ldc = L2; ct = u.pn - T2; }
        bs = (bf16_t*)(ws + off);
        const int row0 = u.pm * 256 + wr * 64 + fr, col0 = ct * 256 + wc * 32 + 8 * fq;
#pragma unroll
        for (int ai = 0; ai < 2; ++ai)
#pragma unroll
            for (int m = 0; m < 4; ++m) { bf16_t* rowp = bs + (size_t)(row0 + ai * 128 + m * 16) * ldc + col0;
#pragma unroll
                for (int bj = 0; bj < 2; ++bj) { const f32x4 v0 = acc[ai][bj][m][0], v1 = acc[ai][bj][m][1];
                    u32x4 w; w.x = pg8::cvt_pk_bf16(v0[0], v0[1]); w.y = pg8::cvt_pk_bf16(v0[2], v0[3]); w.z = pg8::cvt_pk_bf16(v1[0], v1[1]); w.w = pg8::cvt_pk_bf16(v1[2], v1[3]);
                    *(u32x4*)(rowp + bj * 128) = w; } }
    }
};
typedef f16_t f16x8 __attribute__((ext_vector_type(8)));
struct EpiLru {
    static constexpr bool PERM = true;
    const bf16_t* U; f16_t* RI; const float* ba; const float* bx; const float* sp;
    __device__ __forceinline__ void operator()(EPI_ARGS) const {
        const int row0 = u.pm * 256 + wr * 64 + fr, ch0 = u.pn * 128 + wc * 32 + 8 * fq;
        float bav[8], bxv[8], spv[8];
#pragma unroll
        for (int e = 0; e < 8; ++e) { bav[e] = ba[ch0 + e]; bxv[e] = bx[ch0 + e]; spv[e] = sp[ch0 + e] * (-8.f); }
#pragma unroll
        for (int ai = 0; ai < 2; ++ai)
#pragma unroll
            for (int m = 0; m < 4; ++m) { const int row = row0 + ai * 128 + m * 16;
                const u32x4 uw = *(const u32x4*)(U + (size_t)row * 1024 + ch0);
                float uv[8] = {lo_bf(uw.x), hi_bf(uw.x), lo_bf(uw.y), hi_bf(uw.y), lo_bf(uw.z), hi_bf(uw.z), lo_bf(uw.w), hi_bf(uw.w)};
                f16x8 la, bc;
#pragma unroll
                for (int e = 0; e < 8; ++e) { const float rp = acc[ai][0][m][e >> 2][e & 3] + bav[e], ip = acc[ai][1][m][e >> 2][e & 3] + bxv[e];
                    const float r = sigmoidf_(rp), ig = sigmoidf_(ip);
                    const float loga = r * spv[e];
                    const float bb = SQRT(fmaxf(-expm1f(2.f * loga), 0.f)) * (ig * uv[e]);
                    la[e] = (f16_t)(loga * LOG2E); bc[e] = (f16_t)bb; }
                *(f16x8*)(RI + (size_t)row * 2048 + ch0) = la; *(f16x8*)(RI + (size_t)row * 2048 + 1024 + ch0) = bc;
                asm volatile("" ::: "memory"); }
    }
};
struct EpiGate {
    static constexpr bool PERM = true;
    unsigned char* ws;
    __device__ __forceinline__ void operator()(EPI_ARGS) const {
        const int br = u.pn >> 2; const size_t yo = (br == 0) ? AR_XA : (br == 1) ? AR_YB : AR_QN; bf16_t* bs = (bf16_t*)(ws + yo); const int ldc = 1024;
        const int row0 = u.pm * 256 + wr * 64 + fr, col0 = (u.pn & 3) * 256 + wc * 32 + 8 * fq;
#pragma unroll
        for (int ai = 0; ai < 2; ++ai)
#pragma unroll
            for (int m = 0; m < 4; ++m) { bf16_t* rowp = bs + (size_t)(row0 + ai * 128 + m * 16) * ldc + col0;
#pragma unroll
                for (int bj = 0; bj < 2; ++bj) { const f32x4 v0 = acc[ai][bj][m][0], v1 = acc[ai][bj][m][1];
                    const u32x4 y = *(const u32x4*)(rowp + bj * 128);
                    u32x4 w; w.x = pg8::cvt_pk_bf16(lo_bf(y.x) * siluf_(v0[0]), hi_bf(y.x) * siluf_(v0[1])); w.y = pg8::cvt_pk_bf16(lo_bf(y.y) * siluf_(v0[2]), hi_bf(y.y) * siluf_(v0[3]));
                    w.z = pg8::cvt_pk_bf16(lo_bf(y.z) * siluf_(v1[0]), hi_bf(y.z) * siluf_(v1[1])); w.w = pg8::cvt_pk_bf16(lo_bf(y.w) * siluf_(v1[2]), hi_bf(y.w) * siluf_(v1[3]));
                    *(u32x4*)(rowp + bj * 128) = w; }
                asm volatile("" ::: "memory"); }
    }
};
struct EpiD {
    static constexpr bool PERM = true;
    bf16_t* Z; unsigned char* gs;
    __device__ __forceinline__ void operator()(EPI_ARGS) const {
        const int row0 = u.pm * 256 + wr * 64 + fr, col0 = u.pn * 256 + wc * 32 + 8 * fq, i = u.z >> 1;
        const unsigned tq = (unsigned)(((wr * 4 + wc) * 64 + fq * 16 + fr) * 64);
        if ((u.z & 1) == 0) {
#pragma unroll
            for (int ai = 0; ai < 2; ++ai)
#pragma unroll
                for (int m = 0; m < 4; ++m)
#pragma unroll
                    for (int bj = 0; bj < 2; ++bj) { const f32x4 v0 = acc[ai][bj][m][0], v1 = acc[ai][bj][m][1];
                        u32x4 w; w.x = pg8::cvt_pk_bf16(sigmoidf_(v0[0]), sigmoidf_(v0[1])); w.y = pg8::cvt_pk_bf16(sigmoidf_(v0[2]), sigmoidf_(v0[3]));
                        w.z = pg8::cvt_pk_bf16(sigmoidf_(v1[0]), sigmoidf_(v1[1])); w.w = pg8::cvt_pk_bf16(sigmoidf_(v1[2]), sigmoidf_(v1[3]));
                        *(u32x4*)(gs + (((ai * 4 + m) * 2 + bj) >> 2) * 32768 + tq + (((ai * 4 + m) * 2 + bj) & 3) * 16) = w; }
        } else {
#pragma unroll
            for (int ai = 0; ai < 2; ++ai)
#pragma unroll
                for (int m = 0; m < 4; ++m) { bf16_t* zrow = Z + (size_t)(row0 + ai * 128 + m * 16) * 1024 + col0;
#pragma unroll
                    for (int bj = 0; bj < 2; ++bj) { const f32x4 v0 = acc[ai][bj][m][0], v1 = acc[ai][bj][m][1];
                        const u32x4 g = *(const u32x4*)(gs + (((ai * 4 + m) * 2 + bj) >> 2) * 32768 + tq + (((ai * 4 + m) * 2 + bj) & 3) * 16); bf16_t* zp = zrow + bj * 128;
                        float o0 = lo_bf(g.x) * v0[0], o1 = hi_bf(g.x) * v0[1], o2 = lo_bf(g.y) * v0[2], o3 = hi_bf(g.y) * v0[3], o4 = lo_bf(g.z) * v1[0], o5 = hi_bf(g.z) * v1[1], o6 = lo_bf(g.w) * v1[2], o7 = hi_bf(g.w) * v1[3];
                        if (i > 0) { const u32x4 zo = *(const u32x4*)zp; o0 += lo_bf(zo.x); o1 += hi_bf(zo.x); o2 += lo_bf(zo.y); o3 += hi_bf(zo.y); o4 += lo_bf(zo.z); o5 += hi_bf(zo.z); o6 += lo_bf(zo.w); o7 += hi_bf(zo.w); }
                        u32x4 w; w.x = pg8::cvt_pk_bf16(o0, o1); w.y = pg8::cvt_pk_bf16(o2, o3); w.z = pg8::cvt_pk_bf16(o4, o5); w.w = pg8::cvt_pk_bf16(o6, o7); *(u32x4*)zp = w; }
                    asm volatile("" ::: "memory"); }
        }
    }
};
struct EpiOut {
    static constexpr bool PERM = false;
    const float* xlat; const float* xctx; float* olat; float* octx; const float* mod;
    __device__ __forceinline__ void operator()(EPI_ARGS) const {
        const int b = u.pm / 17, isctx = (u.pm - b * 17) == 0;
        const float* gate = mod + (isctx ? 4 : b) * 3072 + 2048;
        const int col0 = u.pn * 256 + wc * 32 + 4 * fq;
        f32x4 gv[2][2];
#pragma unroll
        for (int bj = 0; bj < 2; ++bj)
#pragma unroll
            for (int n = 0; n < 2; ++n) gv[bj][n] = *(const f32x4*)(gate + col0 + bj * 128 + n * 16);
#pragma unroll
        for (int ai = 0; ai < 2; ++ai)
#pragma unroll
            for (int m = 0; m < 4; ++m) { const int s = (u.pm - b * 17) * 256 + ai * 128 + wr * 64 + m * 16 + fr;
                const size_t off = isctx ? ((size_t)(b * LC + s) * 1024 + col0) : ((size_t)(b * TT + (s - LC)) * 1024 + col0);
                const float* xin = isctx ? xctx : xlat; float* xo = isctx ? octx : olat;
#pragma unroll
                for (int bj = 0; bj < 2; ++bj)
#pragma unroll
                    for (int n = 0; n < 2; ++n) { const f32x4 xv = *(const f32x4*)(xin + off + bj * 128 + n * 16);
                        *(f32x4*)(xo + off + bj * 128 + n * 16) = xv + gv[bj][n] * acc[ai][bj][m][n]; }
                asm volatile("" ::: "memory"); }
    }
};

__device__ __forceinline__ void phase_ret_rope(Ctx& C, bf16_t* RQKV) {
    const float* cs = C.ctl + CT_ROPER; const float* sn = cs + 4096;
    for (int m = C.gw; m < MR; m += C.ngw) {
        const int b = m / SS, s = m - b * SS; const bool lat = s >= LC; const int t = s - LC, prow = lat ? (t >> 6) : 0, pcol = lat ? (t & 63) : 0;
        bf16_t* row = RQKV + (size_t)m * 3072;
#pragma unroll
        for (int j = 0; j < 16; ++j) {
            const int idx = j * 64 + C.lane, f = idx & 63, half = (idx >> 6) & 1, h = (idx >> 7) & 3, tz = idx >> 9;
            bf16_t* p = row + tz * 1024 + h * 256 + half * 128 + f;
            const float x1 = bf2f(p[0]), x2 = bf2f(p[64]);
            float o1 = x1, o2 = x2;
            if (lat) { const int pos = half ? pcol : prow; const float c = cs[pos * 64 + f], sv = sn[pos * 64 + f]; o1 = x1 * c - x2 * sv; o2 = x2 * c + x1 * sv; }
            if (tz) { o1 *= 0.0625f; o2 *= 0.0625f; }
            p[0] = (bf16_t)f2bf(o1); p[64] = (bf16_t)f2bf(o2);
        }
    }
}

#define RS_STEP(o, cnt, st) do { const bool up_ = (C.lane & (st)) != 0; _Pragma("unroll") for (int e_ = 0; e_ < (cnt) / 2; ++e_) { \
        const float send_ = up_ ? o[e_] : o[e_ + (cnt) / 2]; const float keep_ = up_ ? o[e_ + (cnt) / 2] : o[e_]; o[e_] = keep_ + __shfl_xor(send_, (st)); } } while (0)

__device__ __forceinline__ void phase_ret_naive(Ctx& C, int l, const bf16_t* RQKV, bf16_t* OI) {
    LAS unsigned char* qs = C.lds + C.wave * 512;
    const int nbu = (MR / 8) * 16;
    for (int bu = C.bid; bu < nbu; bu += C.G) {
        const int hq = bu & 15, h = hq >> 2, qd = hq & 3, n = (bu >> 4) * 8 + C.wave;
        const int b = n / SS, sn_ = n - b * SS;
        const float lgf = C.ctl[CT_LG + (l * 2 + 0) * 4 + h], lgb = C.ctl[CT_LG + (l * 2 + 1) * 4 + h];
        const int pfn = sn_, pbn = (sn_ < LC) ? (LC - 1 - sn_) : (SS + LC - 1 - sn_);
        asm volatile("s_waitcnt lgkmcnt(0)" ::: "memory");
        *(LAS u32x2*)(qs + C.lane * 8) = *(const u32x2*)(RQKV + (size_t)n * 3072 + h * 256 + C.lane * 4);
        asm volatile("s_waitcnt lgkmcnt(0)" ::: "memory");
        float o[64];
#pragma unroll
        for (int e = 0; e < 64; ++e) o[e] = 0.f;
        for (int sm = C.lane; sm < SS; sm += 64) {
            const bf16_t* krow = RQKV + (size_t)(b * SS + sm) * 3072 + 1024 + h * 256;
            float dot = 0.f;
#pragma unroll 4
            for (int c = 0; c < 32; ++c) { const u32x4 kv = *(const u32x4*)(krow + c * 8); const u32x4 qv = *(const LAS u32x4*)(qs + c * 16);
                dot += lo_bf(kv.x) * lo_bf(qv.x) + hi_bf(kv.x) * hi_bf(qv.x) + lo_bf(kv.y) * lo_bf(qv.y) + hi_bf(kv.y) * hi_bf(qv.y)
                     + lo_bf(kv.z) * lo_bf(qv.z) + hi_bf(kv.z) * hi_bf(qv.z) + lo_bf(kv.w) * lo_bf(qv.w) + hi_bf(kv.w) * hi_bf(qv.w); }
            const int pfm = sm, pbm = (sm < LC) ? (LC - 1 - sm) : (SS + LC - 1 - sm);
            float w = 0.f;
            if (pfn >= pfm) w += EX2(lgf * (float)(pfn - pfm));
            if (pbn >= pbm) w += EX2(lgb * (float)(pbn - pbm));
            const float ws_ = w * dot;
            const bf16_t* vrow = krow + 1024 + qd * 64;
#pragma unroll
            for (int c = 0; c < 8; ++c) { const u32x4 vv = *(const u32x4*)(vrow + c * 8);
                o[c * 8 + 0] += ws_ * lo_bf(vv.x); o[c * 8 + 1] += ws_ * hi_bf(vv.x); o[c * 8 + 2] += ws_ * lo_bf(vv.y); o[c * 8 + 3] += ws_ * hi_bf(vv.y);
                o[c * 8 + 4] += ws_ * lo_bf(vv.z); o[c * 8 + 5] += ws_ * hi_bf(vv.z); o[c * 8 + 6] += ws_ * lo_bf(vv.w); o[c * 8 + 7] += ws_ * hi_bf(vv.w); }
        }
        RS_STEP(o, 64, 32); RS_STEP(o, 32, 16); RS_STEP(o, 16, 8); RS_STEP(o, 8, 4); RS_STEP(o, 4, 2); RS_STEP(o, 2, 1);
        OI[(size_t)n * 1024 + h * 256 + qd * 64 + C.lane] = (bf16_t)f2bf(o[0]);
    }
}
__device__ __forceinline__ void phase_ret_ln(Ctx& C, int l, bf16_t* OI) {
    const float* gain = INP(16) + l * 1024;
    for (int m = C.gw; m < MR; m += C.ngw) {
#pragma unroll
        for (int h = 0; h < 4; ++h) { bf16_t* p = OI + (size_t)m * 1024 + h * 256 + C.lane * 4;
            const u32x2 w = *(const u32x2*)p; float x0 = lo_bf(w.x), x1 = hi_bf(w.x), x2 = lo_bf(w.y), x3 = hi_bf(w.y);
            const float mean = wave_sum((x0 + x1) + (x2 + x3)) * (1.f / 256.f);
            x0 -= mean; x1 -= mean; x2 -= mean; x3 -= mean;
            const float var = wave_sum((x0 * x0 + x1 * x1) + (x2 * x2 + x3 * x3)) * (1.f / 256.f);
            const float rstd = RSQ(var + EPS);
            const f32x4 g = *(const f32x4*)(gain + h * 256 + C.lane * 4);
            u32x2 o; o.x = pk2(x0 * rstd * g.x, x1 * rstd * g.y); o.y = pk2(x2 * rstd * g.z, x3 * rstd * g.w); *(u32x2*)p = o; }
    }
}

__device__ __forceinline__ void phase_md_post(Ctx& C, int l, bf16_t* MD) {
    const float* qn = INP(17) + l * 384; const float* kvn = INP(19) + l * 256; const float* gkr = INP(24) + l * 64;
    const float* cs = C.ctl + CT_ROPEM; const float* sn = cs + 1024;
    for (int m = C.gw; m < MR; m += C.ngw) {
        const int b = m / SS, s = m - b * SS; const bool lat = s >= LC; const int t = s - LC;
        bf16_t* row = MD + (size_t)m * 768;
        {   float x[6]; float ss = 0.f;
#pragma unroll
            for (int j = 0; j < 3; ++j) { const unsigned w = *(const unsigned*)(row + 2 * C.lane + 128 * j); x[2 * j] = lo_bf(w); x[2 * j + 1] = hi_bf(w); ss += x[2 * j] * x[2 * j] + x[2 * j + 1] * x[2 * j + 1]; }
            const float rstd = RSQ(wave_sum(ss) * (1.f / 384.f) + EPS);
#pragma unroll
            for (int j = 0; j < 3; ++j) { const int c = 2 * C.lane + 128 * j; *(unsigned*)(row + c) = pk2(x[2 * j] * rstd * qn[c], x[2 * j + 1] * rstd * qn[c + 1]); } }
        {   float x[4]; float ss = 0.f;
#pragma unroll
            for (int j = 0; j < 2; ++j) { const unsigned w = *(const unsigned*)(row + 384 + 2 * C.lane + 128 * j); x[2 * j] = lo_bf(w); x[2 * j + 1] = hi_bf(w); ss += x[2 * j] * x[2 * j] + x[2 * j + 1] * x[2 * j + 1]; }
            const float rstd = RSQ(wave_sum(ss) * (1.f / 256.f) + EPS);
#pragma unroll
            for (int j = 0; j < 2; ++j) { const int c = 2 * C.lane + 128 * j; *(unsigned*)(row + 384 + c) = pk2(x[2 * j] * rstd * kvn[c], x[2 * j + 1] * rstd * kvn[c + 1]); } }
        {   const float x = bf2f(row[640 + C.lane]);
            const float rstd = RSQ(wave_sum(x * x) * (1.f / 64.f) + EPS);
            float y = x * rstd * gkr[C.lane];
            if (lat) { const float pr = __shfl_xor(y, 16); const float rot = (C.lane & 16) ? pr : -pr; const int f = C.lane & 15, pos = (C.lane < 32) ? (t >> 6) : (t & 63);
                y = y * cs[pos * 16 + f] + rot * sn[pos * 16 + f]; }
            row[640 + C.lane] = (bf16_t)f2bf(y); }
    }
}
__device__ __forceinline__ void phase_qk_post(Ctx& C, int l, bf16_t* QN, bf16_t* QP, bf16_t* KV) {
    const float* gqn = INP(21) + l * 128; const float* gqr = INP(22) + l * 64; const float* gkn = INP(23) + l * 128;
    const float* cs = C.ctl + CT_ROPEM; const float* sn = cs + 1024;
    for (int m = C.gw; m < MR; m += C.ngw) {
        const int b = m / SS, s = m - b * SS; const bool lat = s >= LC; const int t = s - LC;
        bf16_t* qrow = QN + (size_t)m * 1024; bf16_t* prow = QP + (size_t)m * 512; bf16_t* krow = KV + (size_t)m * 2048;
#pragma unroll
        for (int h = 0; h < 8; ++h) {
            {   unsigned* p = (unsigned*)(qrow + h * 128 + 2 * C.lane); const unsigned w = *p; const float x0 = lo_bf(w), x1 = hi_bf(w);
                const float rstd = RSQ(wave_sum(x0 * x0 + x1 * x1) * (1.f / 128.f) + EPS);
                *p = pk2(x0 * rstd * gqn[2 * C.lane] * QSCALE, x1 * rstd * gqn[2 * C.lane + 1] * QSCALE); }
            {   bf16_t* p = prow + h * 64 + C.lane; const float x = bf2f(*p);
                const float rstd = RSQ(wave_sum(x * x) * (1.f / 64.f) + EPS);
                float y = x * rstd * gqr[C.lane];
                if (lat) { const float pr = __shfl_xor(y, 16); const float rot = (C.lane & 16) ? pr : -pr; const int f = C.lane & 15, pos = (C.lane < 32) ? (t >> 6) : (t & 63);
                    y = y * cs[pos * 16 + f] + rot * sn[pos * 16 + f]; }
                *p = (bf16_t)f2bf(y * QSCALE); }
            {   unsigned* p = (unsigned*)(krow + h * 128 + 2 * C.lane); const unsigned w = *p; const float x0 = lo_bf(w), x1 = hi_bf(w);
                const float rstd = RSQ(wave_sum(x0 * x0 + x1 * x1) * (1.f / 128.f) + EPS);
                *p = pk2(x0 * rstd * gkn[2 * C.lane], x1 * rstd * gkn[2 * C.lane + 1]); }
        }
    }
}

__device__ __forceinline__ void phase_attn_naive(Ctx& C, bool with_ctx, bf16_t* QN, const bf16_t* QP, const bf16_t* KV, const bf16_t* MD) {
    LAS unsigned char* qs = C.lds + C.wave * 512;
    const int nlat = NB * 8 * (TT / 8), nctx = with_ctx ? NB * 8 * (LC / 8) : 0;
    for (int bu = C.bid; bu < nlat + nctx; bu += C.G) {
        int b, h, s, nkeys;
        if (bu < nlat) { const int tb = bu % (TT / 8), bh = bu / (TT / 8); b = bh >> 3; h = bh & 7; s = LC + tb * 8 + C.wave; nkeys = SS; }
        else { const int r = bu - nlat, tb = r % (LC / 8), bh = r / (LC / 8); b = bh >> 3; h = bh & 7; s = tb * 8 + C.wave; nkeys = LC; }
        const size_t m = (size_t)b * SS + s;
        asm volatile("s_waitcnt lgkmcnt(0)" ::: "memory");
        if (C.lane < 32) *(LAS u32x2*)(qs + C.lane * 8) = *(const u32x2*)(QN + m * 1024 + h * 128 + C.lane * 4);
        else if (C.lane < 48) *(LAS u32x2*)(qs + 256 + (C.lane - 32) * 8) = *(const u32x2*)(QP + m * 512 + h * 64 + (C.lane - 32) * 4);
        asm volatile("s_waitcnt lgkmcnt(0)" ::: "memory");
        float o[128];
#pragma unroll
        for (int e = 0; e < 128; ++e) o[e] = 0.f;
        float mrun = -1e30f, lrun = 0.f;
        for (int key = C.lane; key < nkeys; key += 64) {
            const size_t kr = (size_t)b * SS + key;
            const bf16_t* kn = KV + kr * 2048 + h * 128; const bf16_t* kro = MD + kr * 768 + 640;
            float dot = 0.f;
#pragma unroll 4
            for (int c = 0; c < 16; ++c) { const u32x4 kv = *(const u32x4*)(kn + c * 8); const u32x4 qv = *(const LAS u32x4*)(qs + c * 16);
                dot += lo_bf(kv.x) * lo_bf(qv.x) + hi_bf(kv.x) * hi_bf(qv.x) + lo_bf(kv.y) * lo_bf(qv.y) + hi_bf(kv.y) * hi_bf(qv.y)
                     + lo_bf(kv.z) * lo_bf(qv.z) + hi_bf(kv.z) * hi_bf(qv.z) + lo_bf(kv.w) * lo_bf(qv.w) + hi_bf(kv.w) * hi_bf(qv.w); }
#pragma unroll 4
            for (int c = 0; c < 8; ++c) { const u32x4 kv = *(const u32x4*)(kro + c * 8); const u32x4 qv = *(const LAS u32x4*)(qs + 256 + c * 16);
                dot += lo_bf(kv.x) * lo_bf(qv.x) + hi_bf(kv.x) * hi_bf(qv.x) + lo_bf(kv.y) * lo_bf(qv.y) + hi_bf(kv.y) * hi_bf(qv.y)
                     + lo_bf(kv.z) * lo_bf(qv.z) + hi_bf(kv.z) * hi_bf(qv.z) + lo_bf(kv.w) * lo_bf(qv.w) + hi_bf(kv.w) * hi_bf(qv.w); }
            const float mnew = fmaxf(mrun, dot), alpha = EX2(mrun - mnew), p = EX2(dot - mnew);
            lrun = lrun * alpha + p; mrun = mnew;
            const bf16_t* vrow = KV + kr * 2048 + 1024 + h * 128;
#pragma unroll
            for (int c = 0; c < 16; ++c) { const u32x4 vv = *(const u32x4*)(vrow + c * 8);
                o[c * 8 + 0] = o[c * 8 + 0] * alpha + p * lo_bf(vv.x); o[c * 8 + 1] = o[c * 8 + 1] * alpha + p * hi_bf(vv.x);
                o[c * 8 + 2] = o[c * 8 + 2] * alpha + p * lo_bf(vv.y); o[c * 8 + 3] = o[c * 8 + 3] * alpha + p * hi_bf(vv.y);
                o[c * 8 + 4] = o[c * 8 + 4] * alpha + p * lo_bf(vv.z); o[c * 8 + 5] = o[c * 8 + 5] * alpha + p * hi_bf(vv.z);
                o[c * 8 + 6] = o[c * 8 + 6] * alpha + p * lo_bf(vv.w); o[c * 8 + 7] = o[c * 8 + 7] * alpha + p * hi_bf(vv.w); }
        }
        const float mall = wave_max(mrun), fsc = EX2(mrun - mall);
        const float lall = wave_sum(lrun * fsc);
#pragma unroll
        for (int e = 0; e < 128; ++e) o[e] *= fsc;
        RS_STEP(o, 128, 32); RS_STEP(o, 64, 16); RS_STEP(o, 32, 8); RS_STEP(o, 16, 4); RS_STEP(o, 8, 2); RS_STEP(o, 4, 1);
        const float inv = 1.f / lall;
        *(unsigned*)(QN + m * 1024 + h * 128 + 2 * C.lane) = pk2(o[0] * inv, o[1] * inv);
    }
}

__device__ __forceinline__ void phase_conv(Ctx& C, int l, const bf16_t* XA, bf16_t* U) {
    const float* cw = INP(8) + l * 4 * 1024; const float* cb = INP(9) + l * 1024;
    const int gt = C.bid * NTHR + C.tid, ngt = C.G * NTHR;
    for (int it = gt; it < MR * 128; it += ngt) {
        const int m = it >> 7, c0 = (it & 127) * 8, b = m / SS, s = m - b * SS;
        const int lo = (s < LC) ? 0 : LC, hi = (s < LC) ? LC : SS;
        float a[8];
#pragma unroll
        for (int e = 0; e < 8; ++e) a[e] = cb[c0 + e];
#pragma unroll
        for (int j = 0; j < 4; ++j) { const int sj = s + j - 2;
            if (sj >= lo && sj < hi) { const u32x4 xv = *(const u32x4*)(XA + (size_t)(b * SS + sj) * 1024 + c0); const float* w = cw + j * 1024 + c0;
                a[0] += w[0] * lo_bf(xv.x); a[1] += w[1] * hi_bf(xv.x); a[2] += w[2] * lo_bf(xv.y); a[3] += w[3] * hi_bf(xv.y);
                a[4] += w[4] * lo_bf(xv.z); a[5] += w[5] * hi_bf(xv.z); a[6] += w[6] * lo_bf(xv.w); a[7] += w[7] * hi_bf(xv.w); } }
        u32x4 o; o.x = pk2(a[0], a[1]); o.y = pk2(a[2], a[3]); o.z = pk2(a[4], a[5]); o.w = pk2(a[6], a[7]);
        *(u32x4*)(U + (size_t)m * 1024 + c0) = o;
    }
}
typedef f16_t f16x2 __attribute__((ext_vector_type(2)));
__device__ __forceinline__ void phase_scan1(Ctx& C, int d, const f16_t* RI, float* SUM) {
    for (int un = C.gw; un < NB * 34 * 8; un += C.ngw) {
        const int cg_ = un & 7, sg = (un >> 3) % 34, b = (un >> 3) / 34, ch = cg_ * 128 + 2 * C.lane;
        float A0 = 1.f, A1 = 1.f, H0 = 0.f, H1 = 0.f;
        const f16_t* base = RI + (size_t)(b * SS + sg * 128) * 2048 + ch;
#pragma unroll 8
        for (int i = 0; i < 128; ++i) { const int r = d ? (127 - i) : i;
            const f16x2 la = *(const f16x2*)(base + (size_t)r * 2048), bc = *(const f16x2*)(base + (size_t)r * 2048 + 1024);
            const float a0 = EX2((float)la[0]), a1 = EX2((float)la[1]);
            H0 = a0 * H0 + (float)bc[0]; H1 = a1 * H1 + (float)bc[1]; A0 *= a0; A1 *= a1; }
        float* sp = SUM + ((size_t)(b * 34 + sg) * 1024 + ch) * 2;
        *(f32x4*)sp = (f32x4){A0, H0, A1, H1};
    }
}
__device__ __forceinline__ void phase_scan3(Ctx& C, int d, const f16_t* RI, const float* SUM, bf16_t* YA) {
    for (int un = C.gw; un < NB * 34 * 8; un += C.ngw) {
        const int cg_ = un & 7, sg = (un >> 3) % 34, b = (un >> 3) / 34, ch = cg_ * 128 + 2 * C.lane;
        float H0 = 0.f, H1 = 0.f;
        const int npre = d ? ((sg < 2) ? (1 - sg) : (35 - sg)) : sg;
        for (int p = 0; p < npre; ++p) { const int ps = d ? ((p < 2) ? (1 - p) : (35 - p)) : p;
            const f32x4 v = *(const f32x4*)(SUM + ((size_t)(b * 34 + ps) * 1024 + ch) * 2);
            H0 = v[0] * H0 + v[1]; H1 = v[2] * H1 + v[3]; }
        const f16_t* base = RI + (size_t)(b * SS + sg * 128) * 2048 + ch;
        bf16_t* yb = YA + (size_t)(b * SS + sg * 128) * 1024 + ch;
#pragma unroll 8
        for (int i = 0; i < 128; ++i) { const int r = d ? (127 - i) : i;
            const f16x2 la = *(const f16x2*)(base + (size_t)r * 2048), bc = *(const f16x2*)(base + (size_t)r * 2048 + 1024);
            const float a0 = EX2((float)la[0]), a1 = EX2((float)la[1]);
            H0 = a0 * H0 + (float)bc[0]; H1 = a1 * H1 + (float)bc[1];
            unsigned* yp = (unsigned*)(yb + (size_t)r * 1024);
            if (d == 0) *yp = pk2(H0, H1); else { const unsigned w = *yp; *yp = pk2(lo_bf(w) + H0, hi_bf(w) + H1); } }
    }
}

typedef float f32x16 __attribute__((ext_vector_type(16)));
typedef short v4i16_t __attribute__((ext_vector_type(4)));
constexpr int AT_KP = 400, AT_VP = 320;
constexpr int AT_KB = 64 * AT_KP, AT_VB = 64 * AT_VP, AT_STG = AT_KB + AT_VB, AT_WSF = 2 * AT_STG;
__device__ __forceinline__ int crow(int r, int hi) { return (r & 3) + 8 * (r >> 2) + 4 * hi; }
__device__ __forceinline__ bf16x8 pack8(float a, float b, float c, float d, float e, float f, float g, float h) {
    u32x4 w; w.x = pg8::cvt_pk_bf16(a, b); w.y = pg8::cvt_pk_bf16(c, d); w.z = pg8::cvt_pk_bf16(e, f); w.w = pg8::cvt_pk_bf16(g, h); return __builtin_bit_cast(bf16x8, w); }
__device__ __forceinline__ bf16x8 tr2(LAS unsigned char* p0, LAS unsigned char* p1) {
    const v4i16_t lo = __builtin_amdgcn_ds_read_tr16_b64_v4i16((LAS v4i16_t*)p0), hi = __builtin_amdgcn_ds_read_tr16_b64_v4i16((LAS v4i16_t*)p1);
    return (bf16x8){lo[0], lo[1], lo[2], lo[3], hi[0], hi[1], hi[2], hi[3]}; }

__device__ __forceinline__ void phase_attn(Ctx& C, bool with_ctx, bf16_t* QN, const bf16_t* QP, const bf16_t* KV, const bf16_t* MD) {
    const int lane = C.lane, r32 = lane & 31, hi = lane >> 5, wave = C.wave, tid = C.tid;
    LAS unsigned char* lds = C.lds;
    LAS float* wsf = (LAS float*)(lds + AT_WSF + wave * 128);
    const int nunits = 512 + (with_ctx ? 32 : 0);
    const int rowA = tid >> 4, ccA = tid & 15, rowR = tid >> 3, ccR = tid & 7;
    const int i16 = lane & 15, q4 = i16 >> 2, p4 = i16 & 3, g1 = (lane >> 4) & 1;
    const int vb = AT_KB + (4 * hi + q4) * AT_VP + (16 * g1 + 4 * p4) * 2;
    for (int un = C.bid; un < nunits; un += C.G) {
        int bh, qb, isctx;
        if (un < 512) { const int x = un & 7, jj = un >> 3; bh = x * 4 + (jj >> 4); qb = jj & 15; isctx = 0; } else { bh = un - 512; qb = 0; isctx = 1; }
        const int b = bh >> 3, h = bh & 7;
        const size_t kb0 = (size_t)b * SS;
        const size_t m0 = kb0 + (isctx ? 0 : LC + qb * 256) + wave * 32;
        const int NT = (isctx ? LC : SS) / 64;
        bf16x8 qf[12];
        {   const bf16_t* qn = QN + (m0 + r32) * 1024 + h * 128 + hi * 8; const bf16_t* qp = QP + (m0 + r32) * 512 + h * 64 + hi * 8;
#pragma unroll
            for (int s = 0; s < 8; ++s) qf[s] = *(const bf16x8*)(qn + s * 16);
#pragma unroll
            for (int s = 0; s < 4; ++s) qf[8 + s] = *(const bf16x8*)(qp + s * 16); }
        f32x16 o[4];
#pragma unroll
        for (int d = 0; d < 4; ++d)
#pragma unroll
            for (int r = 0; r < 16; ++r) o[d][r] = 0.f;
        float mrun = -1e30f, lrun = 0.f;
        u32x4 kn0, kn1, kr0, vv0, vv1;
        const bf16_t* kvp = KV + (kb0 + rowA) * 2048 + h * 128 + ccA * 8;
        const bf16_t* krp = MD + (kb0 + rowR) * 768 + 640 + ccR * 8;
#define AT_LOAD(t) do { const bf16_t* kp_ = kvp + (size_t)(t) * 64 * 2048; kn0 = *(const u32x4*)kp_; kn1 = *(const u32x4*)(kp_ + 32 * 2048); vv0 = *(const u32x4*)(kp_ + 1024); vv1 = *(const u32x4*)(kp_ + 32 * 2048 + 1024); \
        kr0 = *(const u32x4*)(krp + (size_t)(t) * 64 * 768); } while (0)
#define AT_WRITE(sb) do { LAS unsigned char* s_ = lds + (sb); *(LAS u32x4*)(s_ + rowA * AT_KP + ccA * 16) = kn0; *(LAS u32x4*)(s_ + (rowA + 32) * AT_KP + ccA * 16) = kn1; \
        *(LAS u32x4*)(s_ + rowR * AT_KP + 256 + ccR * 16) = kr0; *(LAS u32x4*)(s_ + AT_KB + rowA * AT_VP + ccA * 16) = vv0; *(LAS u32x4*)(s_ + AT_KB + (rowA + 32) * AT_VP + ccA * 16) = vv1; } while (0)
        AT_LOAD(0); AT_WRITE(0);
        __syncthreads();
        for (int t = 0; t < NT; ++t) {
            const int sb = (t & 1) * AT_STG;
            if (t + 1 < NT) AT_LOAD(t + 1);
            f32x16 p0, p1;
#pragma unroll
            for (int r = 0; r < 16; ++r) { p0[r] = 0.f; p1[r] = 0.f; }
            {   LAS unsigned char* ka = lds + sb + r32 * AT_KP + hi * 16;
#pragma unroll
                for (int s = 0; s < 12; ++s) { const bf16x8 a0 = *(const LAS bf16x8*)(ka + s * 32), a1 = *(const LAS bf16x8*)(ka + 32 * AT_KP + s * 32);
                    p0 = __builtin_amdgcn_mfma_f32_32x32x16_bf16(a0, qf[s], p0, 0, 0, 0); p1 = __builtin_amdgcn_mfma_f32_32x32x16_bf16(a1, qf[s], p1, 0, 0, 0);
                    if ((s & 3) == 3) asm volatile("" ::: "memory"); } }
            float rm = fmaxf(p0[0], p1[0]);
#pragma unroll
            for (int r = 1; r < 16; ++r) rm = fmaxf(rm, fmaxf(p0[r], p1[r]));
            rm = fmaxf(rm, __shfl_xor(rm, 32));
            const float mnew = fmaxf(mrun, rm), alpha = EX2(mrun - mnew); mrun = mnew;
            float ls = 0.f;
#pragma unroll
            for (int r = 0; r < 16; ++r) { p0[r] = EX2(p0[r] - mnew); p1[r] = EX2(p1[r] - mnew); ls += p0[r] + p1[r]; }
            lrun = lrun * alpha + ls;
            if (hi == 0) wsf[r32] = alpha;
            const bf16x8 pa0 = pack8(p0[0], p0[1], p0[2], p0[3], p0[4], p0[5], p0[6], p0[7]), pa1 = pack8(p0[8], p0[9], p0[10], p0[11], p0[12], p0[13], p0[14], p0[15]);
            const bf16x8 pa2 = pack8(p1[0], p1[1], p1[2], p1[3], p1[4], p1[5], p1[6], p1[7]), pa3 = pack8(p1[8], p1[9], p1[10], p1[11], p1[12], p1[13], p1[14], p1[15]);
#pragma unroll
            for (int r = 0; r < 16; ++r) { const float a = wsf[crow(r, hi)];
#pragma unroll
                for (int d = 0; d < 4; ++d) o[d][r] *= a; }
            {   LAS unsigned char* vp = lds + sb + vb;
#pragma unroll
                for (int d = 0; d < 4; ++d) {
                    o[d] = __builtin_amdgcn_mfma_f32_32x32x16_bf16(pa0, tr2(vp + d * 64, vp + d * 64 + 8 * AT_VP), o[d], 0, 0, 0);
                    o[d] = __builtin_amdgcn_mfma_f32_32x32x16_bf16(pa1, tr2(vp + d * 64 + 16 * AT_VP, vp + d * 64 + 24 * AT_VP), o[d], 0, 0, 0);
                    o[d] = __builtin_amdgcn_mfma_f32_32x32x16_bf16(pa2, tr2(vp + d * 64 + 32 * AT_VP, vp + d * 64 + 40 * AT_VP), o[d], 0, 0, 0);
                    o[d] = __builtin_amdgcn_mfma_f32_32x32x16_bf16(pa3, tr2(vp + d * 64 + 48 * AT_VP, vp + d * 64 + 56 * AT_VP), o[d], 0, 0, 0);
                    asm volatile("" ::: "memory"); } }
            if (t + 1 < NT) AT_WRITE(AT_STG - sb);
            __syncthreads();
        }
#undef AT_LOAD
#undef AT_WRITE
        const float ltot = lrun + __shfl_xor(lrun, 32);
        if (hi == 0) wsf[r32] = 1.f / ltot;
        bf16_t* op = QN + (m0 + 4 * hi) * 1024 + h * 128 + r32;
#pragma unroll
        for (int r = 0; r < 16; ++r) { const float inv = wsf[crow(r, hi)];
#pragma unroll
            for (int d = 0; d < 4; ++d) op[d * 32] = (bf16_t)f2bf(o[d][r] * inv);
            op += ((r & 3) == 3) ? 5 * 1024 : 1024; asm volatile("" : "+v"(op)); }
        __syncthreads();
    }
}

constexpr int RI_KP = 528, RI_VP = 576, RI_PTP = 272;
constexpr int RI_A = 0, RI_PT = 128 * RI_VP;
__device__ __forceinline__ void phase_ret_intra(Ctx& C, int l, const bf16_t* RQKV, bf16_t* OI) {
    const int lane = C.lane, r32 = lane & 31, hi = lane >> 5, wave = C.wave, tid = C.tid;
    LAS unsigned char* lds = C.lds;
    const int i16 = lane & 15, q4 = i16 >> 2, p4 = i16 & 3, g1 = (lane >> 4) & 1;
    const int nb = wave & 3, wh = wave >> 2;
    const int srow = tid >> 5, scc = tid & 31;
    for (int un = C.bid; un < NB * 4 * 34; un += C.G) {
        const int c = un % 34, bh = un / 34, b = bh >> 2, h = bh & 3;
        const size_t row0 = (size_t)b * SS + c * 128;
        const float lgf = C.ctl[CT_LG + (l * 2 + 0) * 4 + h], lgb = C.ctl[CT_LG + (l * 2 + 1) * 4 + h];
        const bf16_t* gk = RQKV + (row0 + srow) * 3072 + 1024 + h * 256 + scc * 8;
        u32x4 st[8];
#pragma unroll
        for (int j = 0; j < 8; ++j) st[j] = *(const u32x4*)(gk + (size_t)j * 16 * 3072);
#pragma unroll
        for (int j = 0; j < 8; ++j) *(LAS u32x4*)(lds + RI_A + (srow + 16 * j) * RI_KP + scc * 16) = st[j];
        __syncthreads();
#pragma unroll
        for (int j = 0; j < 8; ++j) st[j] = *(const u32x4*)(gk + 1024 + (size_t)j * 16 * 3072);
        {
            f32x16 x0, x1;
#pragma unroll
            for (int r = 0; r < 16; ++r) { x0[r] = 0.f; x1[r] = 0.f; }
            const bf16_t* gq = RQKV + (row0 + nb * 32 + r32) * 3072 + h * 256 + hi * 8;
            LAS unsigned char* ka = lds + RI_A + (wh * 64 + r32) * RI_KP + hi * 16;
#pragma unroll
            for (int s = 0; s < 16; ++s) { const bf16x8 qf = *(const bf16x8*)(gq + s * 16);
                const bf16x8 a0 = *(const LAS bf16x8*)(ka + s * 32), a1 = *(const LAS bf16x8*)(ka + 32 * RI_KP + s * 32);
                x0 = __builtin_amdgcn_mfma_f32_32x32x16_bf16(a0, qf, x0, 0, 0, 0); x1 = __builtin_amdgcn_mfma_f32_32x32x16_bf16(a1, qf, x1, 0, 0, 0);
                if ((s & 3) == 3) asm volatile("" ::: "memory"); }
            const int n = nb * 32 + r32;
            LAS unsigned char* pt = lds + RI_PT + n * RI_PTP + (wh * 64 + 4 * hi) * 2;
#pragma unroll
            for (int g = 0; g < 4; ++g) { float w0[4], w1[4];
#pragma unroll
                for (int e = 0; e < 4; ++e) { const int m0 = wh * 64 + 8 * g + 4 * hi + e; const float d0 = (float)(n - m0), d1 = d0 - 32.f;
                    const float f0 = (d0 >= 0.f ? EX2(lgf * d0) : 0.f) + (d0 <= 0.f ? EX2(-lgb * d0) : 0.f);
                    const float f1 = (d1 >= 0.f ? EX2(lgf * d1) : 0.f) + (d1 <= 0.f ? EX2(-lgb * d1) : 0.f);
                    w0[e] = x0[4 * g + e] * f0; w1[e] = x1[4 * g + e] * f1; }
                u32x2 o0, o1; o0.x = pg8::cvt_pk_bf16(w0[0], w0[1]); o0.y = pg8::cvt_pk_bf16(w0[2], w0[3]); o1.x = pg8::cvt_pk_bf16(w1[0], w1[1]); o1.y = pg8::cvt_pk_bf16(w1[2], w1[3]);
                *(LAS u32x2*)(pt + g * 16) = o0; *(LAS u32x2*)(pt + 64 + g * 16) = o1; }
        }
        __syncthreads();
#pragma unroll
        for (int j = 0; j < 8; ++j) *(LAS u32x4*)(lds + RI_A + (srow + 16 * j) * RI_VP + scc * 16) = st[j];
        __syncthreads();
        {
            f32x16 o[4];
#pragma unroll
            for (int d = 0; d < 4; ++d)
#pragma unroll
                for (int r = 0; r < 16; ++r) o[d][r] = 0.f;
            bf16x8 pa[8];
            LAS unsigned char* pr = lds + RI_PT + (nb * 32 + r32) * RI_PTP + hi * 16;
#pragma unroll
            for (int s = 0; s < 8; ++s) pa[s] = *(const LAS bf16x8*)(pr + s * 32);
            LAS unsigned char* vp = lds + RI_A + (8 * hi + q4) * RI_VP + (wh * 128 + 16 * g1 + 4 * p4) * 2;
#pragma unroll
            for (int d = 0; d < 4; ++d) {
#pragma unroll
                for (int s = 0; s < 8; ++s) o[d] = __builtin_amdgcn_mfma_f32_32x32x16_bf16(pa[s], tr2(vp + d * 64 + s * 16 * RI_VP, vp + d * 64 + (s * 16 + 4) * RI_VP), o[d], 0, 0, 0);
                asm volatile("" ::: "memory"); }
            bf16_t* op = OI + (row0 + nb * 32 + 4 * hi) * 1024 + h * 256 + wh * 128 + r32;
#pragma unroll
            for (int r = 0; r < 16; ++r) {
#pragma unroll
                for (int d = 0; d < 4; ++d) op[d * 32] = (bf16_t)f2bf(o[d][r]);
                op += ((r & 3) == 3) ? 5 * 1024 : 1024; asm volatile("" : "+v"(op)); }
        }
        __syncthreads();
    }
}

constexpr int RC_KT = 0, RC_KTP = 576, RC_VT = 128 * 576, RC_VTP = 64, RC_ST = RC_VT + 128 * 64, RC_STP = 528, RC_XO = RC_ST + 32 * 528, RC_END = RC_XO + 16384;
static_assert(RC_END <= 131072, "R-chain LDS");
__device__ __forceinline__ void phase_ret_chain(Ctx& C, int l, const bf16_t* RQKV, bf16_t* OI, bf16_t* OB) {
    const int lane = C.lane, r32 = lane & 31, hi = lane >> 5, wave = C.wave, tid = C.tid;
    LAS unsigned char* lds = C.lds;
    const int i16 = lane & 15, q4 = i16 >> 2, p4 = i16 & 3, g1 = (lane >> 4) & 1;
    const int nb = wave & 3, dh = wave >> 2;
    const int srow = tid >> 5, scc = tid & 31, vrow = tid >> 2, vcc = tid & 3;
    for (int un = C.bid; un < 256; un += C.G) {
        const int x = un & 7, j8 = un >> 3, bhd = x * 4 + (j8 >> 3), sl = j8 & 7, b = bhd >> 3, h = (bhd >> 1) & 3, dir = bhd & 1;
        const float lg = C.ctl[CT_LG + (l * 2 + dir) * 4 + h];
        const float cdec = EX2(lg * 128.f);
        const float vdec = dir ? EX2(lg * (float)vrow) : EX2(lg * (float)(127 - vrow));
        f32x16 sacc;
#pragma unroll
        for (int r = 0; r < 16; ++r) sacc[r] = 0.f;
        for (int i = tid; i < 32 * RC_STP / 16; i += NTHR) *(LAS u32x4*)(lds + RC_ST + i * 16) = (u32x4){0u, 0u, 0u, 0u};
        u32x4 st[8]; u32x4 sv;
#define RC_LOAD(cc_) do { const size_t r0_ = (size_t)b * SS + (cc_) * 128; const bf16_t* gk_ = RQKV + (r0_ + srow) * 3072 + 1024 + h * 256 + scc * 8; \
        _Pragma("unroll") for (int j = 0; j < 8; ++j) st[j] = *(const u32x4*)(gk_ + (size_t)j * 16 * 3072); \
        sv = *(const u32x4*)(RQKV + (r0_ + vrow) * 3072 + 2048 + h * 256 + sl * 32 + vcc * 8); } while (0)
#define RC_WRITE() do { _Pragma("unroll") for (int j = 0; j < 8; ++j) *(LAS u32x4*)(lds + RC_KT + (srow + 16 * j) * RC_KTP + scc * 16) = st[j]; \
        u32x4 w_; w_.x = pg8::cvt_pk_bf16(lo_bf(sv.x) * vdec, hi_bf(sv.x) * vdec); w_.y = pg8::cvt_pk_bf16(lo_bf(sv.y) * vdec, hi_bf(sv.y) * vdec); \
        w_.z = pg8::cvt_pk_bf16(lo_bf(sv.z) * vdec, hi_bf(sv.z) * vdec); w_.w = pg8::cvt_pk_bf16(lo_bf(sv.w) * vdec, hi_bf(sv.w) * vdec); \
        *(LAS u32x4*)(lds + RC_VT + vrow * RC_VTP + vcc * 16) = w_; } while (0)
        {   const int c0 = dir ? 1 : 0; RC_LOAD(c0); RC_WRITE(); }
        __syncthreads();
        for (int i = 0; i < 34; ++i) {
            const int c = dir ? ((i < 2) ? (1 - i) : (35 - i)) : i;
            const size_t r0 = (size_t)b * SS + c * 128;
            if (i + 1 < 34) { const int cn = dir ? ((i + 1 < 2) ? (1 - (i + 1)) : (35 - (i + 1))) : (i + 1); RC_LOAD(cn); }
            f32x16 oacc;
#pragma unroll
            for (int r = 0; r < 16; ++r) oacc[r] = 0.f;
            {   const bf16_t* gq = RQKV + (r0 + nb * 32 + r32) * 3072 + h * 256 + dh * 128 + hi * 8;
                LAS unsigned char* sb = lds + RC_ST + r32 * RC_STP + (dh * 128 + hi * 8) * 2;
#pragma unroll
                for (int s = 0; s < 8; ++s) { const bf16x8 qa = *(const bf16x8*)(gq + s * 16); const bf16x8 sbf = *(const LAS bf16x8*)(sb + s * 32);
                    oacc = __builtin_amdgcn_mfma_f32_32x32x16_bf16(qa, sbf, oacc, 0, 0, 0); } }
#pragma unroll
            for (int r = 0; r < 16; ++r) sacc[r] *= cdec;
            {   LAS unsigned char* kp = lds + RC_KT + (8 * hi + q4) * RC_KTP + (wave * 32 + 16 * g1 + 4 * p4) * 2;
                LAS unsigned char* vp = lds + RC_VT + (8 * hi + q4) * RC_VTP + (16 * g1 + 4 * p4) * 2;
#pragma unroll
                for (int s = 0; s < 8; ++s) sacc = __builtin_amdgcn_mfma_f32_32x32x16_bf16(tr2(kp + s * 16 * RC_KTP, kp + (s * 16 + 4) * RC_KTP), tr2(vp + s * 16 * RC_VTP, vp + (s * 16 + 4) * RC_VTP), sacc, 0, 0, 0); }
            if (dh == 1) {
#pragma unroll
                for (int r = 0; r < 16; ++r) *(LAS float*)(lds + RC_XO + nb * 4096 + r * 256 + lane * 4) = oacc[r]; }
            __syncthreads();
            if (dh == 0) {
                bf16_t* op = (dir ? OB : OI) + (r0 + nb * 32 + 4 * hi) * 1024 + h * 256 + sl * 32 + r32;
#pragma unroll
                for (int r = 0; r < 16; ++r) { const int n = nb * 32 + crow(r, hi);
                    const float qd = dir ? EX2(lg * (float)(128 - n)) : EX2(lg * (float)(n + 1));
                    float v = (oacc[r] + *(const LAS float*)(lds + RC_XO + nb * 4096 + r * 256 + lane * 4)) * qd;
                    if (dir == 0) v += bf2f(*op);
                    *op = (bf16_t)f2bf(v);
                    op += ((r & 3) == 3) ? 5 * 1024 : 1024; asm volatile("" : "+v"(op)); }
            }
            {   LAS unsigned char* sp = lds + RC_ST + r32 * RC_STP + (wave * 32 + 4 * hi) * 2;
#pragma unroll
                for (int g = 0; g < 4; ++g) { u32x2 o2; o2.x = pg8::cvt_pk_bf16(sacc[4 * g], sacc[4 * g + 1]); o2.y = pg8::cvt_pk_bf16(sacc[4 * g + 2], sacc[4 * g + 3]); *(LAS u32x2*)(sp + g * 16) = o2; } }
            if (i + 1 < 34) RC_WRITE();
            __syncthreads();
        }
#undef RC_LOAD
#undef RC_WRITE
    }
}
__device__ __forceinline__ void phase_ret_ln2(Ctx& C, int l, bf16_t* OI, const bf16_t* OB) {
    const float* gain = INP(16) + l * 1024;
    for (int m = C.gw; m < MR; m += C.ngw) {
#pragma unroll
        for (int h = 0; h < 4; ++h) { bf16_t* p = OI + (size_t)m * 1024 + h * 256 + C.lane * 4;
            const u32x2 w = *(const u32x2*)p, w2 = *(const u32x2*)(OB + (size_t)m * 1024 + h * 256 + C.lane * 4);
            float x0 = lo_bf(w.x) + lo_bf(w2.x), x1 = hi_bf(w.x) + hi_bf(w2.x), x2 = lo_bf(w.y) + lo_bf(w2.y), x3 = hi_bf(w.y) + hi_bf(w2.y);
            const float mean = wave_sum((x0 + x1) + (x2 + x3)) * (1.f / 256.f);
            x0 -= mean; x1 -= mean; x2 -= mean; x3 -= mean;
            const float var = wave_sum((x0 * x0 + x1 * x1) + (x2 * x2 + x3 * x3)) * (1.f / 256.f);
            const float rstd = RSQ(var + EPS);
            const f32x4 g = *(const f32x4*)(gain + h * 256 + C.lane * 4);
            u32x2 o; o.x = pk2(x0 * rstd * g.x, x1 * rstd * g.y); o.y = pk2(x2 * rstd * g.z, x3 * rstd * g.w); *(u32x2*)p = o; }
    }
}

#define GSYNC() grid.sync()
__global__ void __launch_bounds__(NTHR) fwd_kernel(Params prm) {
    extern __shared__ __attribute__((aligned(16))) unsigned char lds_raw[];
    cg::grid_group grid = cg::this_grid();
    LAS unsigned char* const ldsb = (LAS unsigned char*)lds_raw;
#define CTX Ctx C = mkctx(ldsb)
#define WSB wsp_(C.ws)
#define bYB ((bf16_t*)(WSB + AR_YB))
#define bXA ((bf16_t*)(WSB + AR_XA))
#define bMD ((bf16_t*)(WSB + AR_MD))
#define bRQKV ((bf16_t*)(WSB + AR_RQKV))
#define bKV ((bf16_t*)(WSB + AR_KV))
#define bQN ((bf16_t*)(WSB + AR_QN))
#define bQP ((bf16_t*)(WSB + AR_QP))
#define bRI ((f16_t*)(WSB + AR_RI))
#define bSUM ((float*)(WSB + AR_SUM))
#define bOB ((bf16_t*)(WSB + AR_OB))
#define bZ ((bf16_t*)(WSB + AR_Z))
#define xc1 ((float*)(WSB + WS_XC1))

    { CTX; phase_prep(C); }
    for (int l = 0; l < 2; ++l) {
        const bool with_ctx = (l == 0); const int lat_only = with_ctx ? 0 : 1;
        { CTX; phase_wconv_early(C, l); }
        GSYNC();
        { CTX; phase_h(C, l, bYB); }
        GSYNC();
        {   CTX;
            ProbPlain P{bYB, (const bf16_t*)(WSB + W_WT1), 1024, 1024, 1024};
            pg8::StaticOrder S; S.init(68, 19, C.G, C.bid, 0);
            typedef EpiStore3<AR_XA, 1024, AR_RQKV, 3072, AR_MD, 768, 4, 16> Ep; Ep E{WSB};
            pg8::gemm_phase<Ep, ProbPlain, pg8::StaticOrder, true>(C.lds, P, S, E);
        }
        GSYNC();
        { CTX; phase_ret_rope(C, bRQKV); }
        { CTX; phase_md_post(C, l, bMD); }
        GSYNC();
        { CTX; phase_ret_intra(C, l, bRQKV, bYB); }
        GSYNC();
        { CTX; phase_ret_chain(C, l, bRQKV, bYB, bOB); }
        GSYNC();
        { CTX; phase_ret_ln2(C, l, bYB, bOB); }
        {   CTX; ProbPlain P{bMD, (const bf16_t*)(WSB + W_WTQ), 768, 384, 384};
            pg8::StaticOrder S; S.init(68, 6, C.G, C.bid, 0);
            typedef EpiStore3<AR_QN, 1024, AR_QP, 512, AR_QP, 512, 4, 6> Ep; Ep E{WSB};
            pg8::gemm_phase<Ep, ProbPlain, pg8::StaticOrder, true>(C.lds, P, S, E);
        }
        {   CTX; ProbPlain P{bMD + 384, (const bf16_t*)(WSB + W_WTKV), 768, 256, 256};
            pg8::StaticOrder S; S.init(68, 8, C.G, C.bid, 0);
            typedef EpiStore3<AR_KV, 2048, AR_KV, 2048, AR_KV, 2048, 8, 8> Ep; Ep E{WSB};
            pg8::gemm_phase<Ep, ProbPlain, pg8::StaticOrder, true>(C.lds, P, S, E);
        }
        GSYNC();
        { CTX; phase_qk_post(C, l, bQN, bQP, bKV); }
        GSYNC();
        { CTX; phase_attn(C, with_ctx, bQN, bQP, bKV, bMD); }
        GSYNC();
        { CTX; phase_conv(C, l, bXA, bMD  ); }
        GSYNC();
        for (int d = 0; d < 2; ++d) {
            {   CTX; ProbLru P{bMD, (const bf16_t*)(WSB + W_WTL) + (size_t)d * 2048 * 256, 256, 256};
                pg8::StaticOrder S; S.init(68, 8, C.G, C.bid, 0);
                EpiLru E{bMD, bRI, INP(11) + (l * 2 + d) * 1024, INP(13) + (l * 2 + d) * 1024, C.ctl + CT_SP + (l * 2 + d) * 1024};
                pg8::gemm_phase<EpiLru, ProbLru, pg8::StaticOrder, true>(C.lds, P, S, E);
            }
            GSYNC();
            { CTX; phase_scan1(C, d, bRI, bSUM); }
            GSYNC();
            { CTX; phase_scan3(C, d, bRI, bSUM, bXA  ); }
            GSYNC();
        }
        { CTX; phase_wconv_late(C, l); }
        { CTX; phase_h(C, l, bMD  ); }
        GSYNC();
        {   CTX; ProbPlain P{bMD, (const bf16_t*)(WSB + W_WTG), 1024, 1024, 1024};
            pg8::StaticOrder S; S.init(lat_only ? 64 : 68, 12, C.G, C.bid, lat_only);
            EpiGate E{WSB};
            pg8::gemm_phase<EpiGate, ProbPlain, pg8::StaticOrder, true>(C.lds, P, S, E);
        }
        GSYNC();
        {   CTX; ProbD P{WSB, 1024, 1024};
            pg8::ChainOrder S; S.init(lat_only ? 64 : 68, C.G, C.bid, lat_only);
            EpiD E{bZ, WSB + AR_GS + (size_t)C.bid * 131072};
            pg8::gemm_phase<EpiD, ProbD, pg8::ChainOrder, true>(C.lds, P, S, E);
        }
        GSYNC();
        {   CTX; ProbPlain P{bZ, (const bf16_t*)(WSB + W_WTO), 1024, 1024, 1024};
            pg8::StaticOrder S; S.init(lat_only ? 64 : 68, 4, C.G, C.bid, lat_only);
            EpiOut E{(l == 0) ? INP(0) : (const float*)C.out, INP(2), C.out, xc1, C.ctl + CT_MOD + l * 5 * 3072};
            pg8::gemm_phase<EpiOut, ProbPlain, pg8::StaticOrder, true>(C.lds, P, S, E);
        }
        GSYNC();
    }
}

#undef xc1
#undef bZ
extern "C" void kernel_launch(void* const* d_in, const int* in_sizes, int n_in, void* d_out, int out_size, void* d_ws, size_t ws_size, hipStream_t stream) {
    static int grid = 0;
    if (grid == 0) {
        if (n_in != 29 || out_size != NB * TT * DM || ws_size < WS_END) { fprintf(stderr, "kernel_launch: unexpected shapes (n_in %d out %d ws %zu)\n", n_in, out_size, ws_size); grid = -1; return; }
        int dev = 0, cus = 0, per_cu = 0;
        hipGetDevice(&dev);
        hipDeviceGetAttribute(&cus, hipDeviceAttributeMultiprocessorCount, dev);
        if (hipFuncSetAttribute((const void*)fwd_kernel, hipFuncAttributeMaxDynamicSharedMemorySize, LDS_BYTES) != hipSuccess) { fprintf(stderr, "kernel_launch: hipFuncSetAttribute failed\n"); grid = -1; return; }
        if (hipOccupancyMaxActiveBlocksPerMultiprocessor(&per_cu, (const void*)fwd_kernel, NTHR, LDS_BYTES) != hipSuccess || per_cu < 1) { fprintf(stderr, "kernel_launch: occupancy query failed (%d)\n", per_cu); (void)hipGetLastError(); per_cu = 1; }
        grid = cus;
        fprintf(stderr, "kernel_launch: cus %d per_cu %d grid %d\n", cus, per_cu, grid);
    }
    if (grid < 0) return;
    Params p{};
    for (int i = 0; i < 29; ++i) p.in[i] = (const float*)d_in[i];
    p.out = (float*)d_out; p.ws = (unsigned char*)d_ws;
    void* args[] = {&p};
    hipError_t e = hipLaunchCooperativeKernel((const void*)fwd_kernel, dim3(grid), dim3(NTHR), args, LDS_BYTES, stream);
    if (e != hipSuccess) fprintf(stderr, "cooperative launch failed: %s (grid %d)\n", hipGetErrorString(e), grid);
}
```

```cpp
#include <hip/hip_runtime.h>
#include <hip/hip_cooperative_groups.h>
#include <cstdio>
#include <cstdint>
namespace cg = cooperative_groups;

#define LAS __attribute__((address_space(3)))
typedef unsigned short bf16_t;
typedef short bf16x8 __attribute__((ext_vector_type(8)));
typedef float f32x4 __attribute__((ext_vector_type(4)));
typedef float f32x2 __attribute__((ext_vector_type(2)));
typedef unsigned u32x4 __attribute__((ext_vector_type(4)));
typedef unsigned u32x2 __attribute__((ext_vector_type(2)));
typedef _Float16 f16_t;

namespace pg8 {
constexpr int BM = 256, BK = 64, HALF = 128, HTB = HALF * BK * 2, STAGE_BYTES = 8 * HTB, NXCD = 8, WGM = 8;
__host__ __device__ __forceinline__ int lds_byte(int r, int c) { const int st = (r >> 4) * 2 + (c >> 5), rr = r & 15, cc = c & 31, ob = rr * 64 + cc * 2; return st * 1024 + (ob ^ (((ob >> 9) & 1) << 5)); }
__host__ __device__ __forceinline__ void stage_rc(int b, int& R, int& C) { const int st = b / 1024, sb = b % 1024, swz = sb ^ (((sb >> 9) & 1) << 5); R = (st >> 1) * 16 + swz / 64; C = (st & 1) * 32 + (swz % 64) / 2; }
__host__ __device__ __forceinline__ int perm32(int rho) { const int n = rho >> 4, i = rho & 15; return 8 * (i >> 2) + 4 * n + (i & 3); }

struct Unit { int pm, pn, z; };

struct StaticOrder {
    int nM, nN, nwg, G, c, latent_only;
    __device__ void init(int nM_, int nN_, int G_, int c_, int latent_only_) { nM = nM_; nN = nN_; nwg = nM * nN; G = G_; c = c_; latent_only = latent_only_; }
    __device__ bool next(int i, Unit& u) const {
        const long L = (long)i * G + c; if (L >= nwg) return false;
        int wgid = (int)L; { const int q = nwg / NXCD, r = nwg % NXCD, xcd = wgid % NXCD, off = wgid / NXCD; wgid = (xcd < r ? xcd * (q + 1) : r * (q + 1) + (xcd - r) * q) + off; }
        const int nig = WGM * nN, gid = wgid / nig, fm = gid * WGM, gsz = (nM - fm) < WGM ? (nM - fm) : WGM;
        int pm = fm + ((wgid % nig) % gsz); u.pn = (wgid % nig) / gsz; u.z = 0;
        if (latent_only) pm = (pm >> 4) * 17 + 1 + (pm & 15);
        u.pm = pm; return true;
    }
};
struct ChainOrder {
    int ntiles, G, c, latent_only;
    __device__ void init(int nM_, int G_, int c_, int latent_only_) { ntiles = nM_ * 4; G = G_; c = c_; latent_only = latent_only_; }
    __device__ bool next(int i, Unit& u) const {
        const int r = i / 6, z = i - r * 6; const long T = (long)r * G + c; if (T >= ntiles) return false;
        int pm = (int)(T >> 2); u.pn = (int)(T & 3); u.z = z;
        if (latent_only) pm = (pm >> 4) * 17 + 1 + (pm & 15);
        u.pm = pm; return true;
    }
};

typedef __bf16 bf16x2_t __attribute__((ext_vector_type(2)));
__device__ __forceinline__ unsigned cvt_pk_bf16(float lo, float hi) { f32x2 v = {lo, hi}; bf16x2_t b = __builtin_convertvector(v, bf16x2_t); return __builtin_bit_cast(unsigned, b); }

template <class Epi, class Prob, class Sched, bool ALIGN_EPI>
__device__ __forceinline__ void gemm_phase(LAS unsigned char* lds, const Prob& P, const Sched& S, const Epi& E) {
    int tid_ = threadIdx.x; asm volatile("" : "+v"(tid_));
    const int tid = tid_, wid = __builtin_amdgcn_readfirstlane(tid >> 6), lane = tid & 63, wr = wid >> 2, wc = wid & 3, fr = lane & 15, fq = lane >> 4;
    const int K = P.K, nt = K / BK;
    int RA[2], CA[2]; unsigned voffB[2];
#pragma unroll
    for (int i = 0; i < 2; ++i) { int R, C; stage_rc(tid * 16 + i * 8192, R, C); const int Rb = Epi::PERM ? ((R & ~31) + perm32(R & 31)) : R;
        RA[i] = R; CA[i] = C; voffB[i] = (unsigned)(Rb * P.ldb + C) * 2u; }
    const unsigned kstep = (unsigned)(BK * 2);
    const unsigned hstepB = (unsigned)(HALF * P.ldb * 2);
    const unsigned ldsw = (unsigned)wid * 1024u;
    const int aoff = lds_byte(wr * 64 + fr, fq * 8), boff = lds_byte(wc * 32 + fr, fq * 8);
#define PG8_SA(b, h) (((b) * 2 + (h)) * HTB)
#define PG8_SB(b, h) ((4 + (b) * 2 + (h)) * HTB)
#define PG8_STAGE(bufoff, gbase, soff, voff) do { _Pragma("unroll") for (int _i = 0; _i < 2; ++_i) \
        __builtin_amdgcn_global_load_lds((const unsigned*)((const char*)(gbase) + (unsigned)((voff)[_i] + (soff))), (LAS unsigned*)(lds + (bufoff) + ldsw + _i * 8192), 16, 0, 0); } while (0)
#define PG8_LDA(dst, b, h) do { _Pragma("unroll") for (int m = 0; m < 4; ++m) _Pragma("unroll") for (int k = 0; k < 2; ++k) dst[m][k] = *(const LAS bf16x8*)(lds + PG8_SA(b, h) + aoff + m * 2048 + k * 1024); } while (0)
#define PG8_LDB(dst, b, h) do { _Pragma("unroll") for (int n = 0; n < 2; ++n) _Pragma("unroll") for (int k = 0; k < 2; ++k) dst[n][k] = *(const LAS bf16x8*)(lds + PG8_SB(b, h) + boff + n * 2048 + k * 1024); } while (0)
#define PG8_MMA(ai, bj, At, Bt) do { __builtin_amdgcn_s_setprio(1); _Pragma("unroll") for (int m = 0; m < 4; ++m) _Pragma("unroll") for (int n = 0; n < 2; ++n) _Pragma("unroll") for (int k = 0; k < 2; ++k) \
        acc[ai][bj][m][n] = __builtin_amdgcn_mfma_f32_16x16x32_bf16(Bt[n][k], At[m][k], acc[ai][bj][m][n], 0, 0, 0); __builtin_amdgcn_s_setprio(0); } while (0)
#define PG8_WAIT_V(n) asm volatile("s_waitcnt vmcnt(" #n ")" ::: "memory")
#define PG8_WAIT_L(n) asm volatile("s_waitcnt lgkmcnt(" #n ")" ::: "memory")
#define PG8_BAR __builtin_amdgcn_s_barrier()
#define PG8_SCHED __builtin_amdgcn_sched_barrier(0)
    Unit cur, nxt; int ui = 0;
    if (!S.next(0, cur)) return;
    f32x4 acc[2][2][4][2];
#pragma unroll
    for (int a = 0; a < 2; ++a)
#pragma unroll
        for (int b = 0; b < 2; ++b)
#pragma unroll
            for (int m = 0; m < 4; ++m)
#pragma unroll
                for (int n = 0; n < 2; ++n) acc[a][b][m][n] = (f32x4){0.f, 0.f, 0.f, 0.f};
    bf16x8 At[4][2], B0[2][2], B1[2][2];
    const char* cA; const char* cB; int ldaC; P.get(cur, cA, cB, ldaC);
    unsigned voffA[2] = {(unsigned)(RA[0] * ldaC + CA[0]) * 2u, (unsigned)(RA[1] * ldaC + CA[1]) * 2u};
    unsigned hstepA = (unsigned)(HALF * ldaC * 2);
    PG8_STAGE(PG8_SB(0, 0), cB, 0u, voffB); PG8_STAGE(PG8_SB(0, 1), cB, hstepB, voffB); PG8_STAGE(PG8_SA(0, 0), cA, 0u, voffA); PG8_STAGE(PG8_SA(0, 1), cA, hstepA, voffA);
    if (wr == 1) PG8_BAR;
    PG8_WAIT_V(2); PG8_BAR;
    PG8_STAGE(PG8_SB(1, 0), cB, kstep, voffB); PG8_STAGE(PG8_SA(1, 0), cA, kstep, voffA); PG8_STAGE(PG8_SB(1, 1), cB, hstepB + kstep, voffB);
    PG8_WAIT_V(6); PG8_BAR;
    for (;;) {
        const bool has_next = S.next(ui + 1, nxt);
        const char* nA = cA; const char* nB = cB; int ldaN = ldaC;
        if (has_next) P.get(nxt, nA, nB, ldaN);
        unsigned voffAn[2] = {(unsigned)(RA[0] * ldaN + CA[0]) * 2u, (unsigned)(RA[1] * ldaN + CA[1]) * 2u};
        const unsigned hstepAn = (unsigned)(HALF * ldaN * 2);
        for (int t = 0; t < nt; t += 2) {
            const bool last = (t == nt - 2);
            const unsigned o1 = (unsigned)(t + 1) * kstep;
            const char* a2b = last ? nA : cA; const char* b2b = last ? nB : cB;
            const unsigned o2 = last ? 0u : (unsigned)(t + 2) * kstep, o3 = o2 + kstep;
            unsigned vA2[2] = {last ? voffAn[0] : voffA[0], last ? voffAn[1] : voffA[1]};
            const unsigned hA2 = last ? hstepAn : hstepA;
            PG8_LDB(B0, 0, 0); PG8_LDB(B1, 0, 1); PG8_SCHED; PG8_LDA(At, 0, 0); PG8_STAGE(PG8_SA(1, 1), cA, o1 + hstepA, voffA);
            PG8_WAIT_V(8); PG8_WAIT_L(0); PG8_BAR; PG8_MMA(0, 0, At, B0); PG8_MMA(0, 1, At, B1); PG8_BAR; PG8_SCHED;
            PG8_LDA(At, 0, 1); PG8_STAGE(PG8_SB(0, 0), b2b, o2, voffB); PG8_STAGE(PG8_SB(0, 1), b2b, o2 + hstepB, voffB); PG8_STAGE(PG8_SA(0, 0), a2b, o2, vA2);
            PG8_WAIT_V(8); PG8_WAIT_L(0); PG8_BAR; PG8_MMA(1, 0, At, B0); PG8_MMA(1, 1, At, B1); PG8_BAR; PG8_SCHED;
            PG8_LDB(B0, 1, 0); PG8_LDB(B1, 1, 1); PG8_SCHED; PG8_LDA(At, 1, 0); PG8_STAGE(PG8_SA(0, 1), a2b, o2 + hA2, vA2);
            PG8_WAIT_V(8); PG8_WAIT_L(0); PG8_BAR; PG8_MMA(0, 0, At, B0); PG8_MMA(0, 1, At, B1); PG8_BAR; PG8_SCHED;
            PG8_LDA(At, 1, 1); PG8_STAGE(PG8_SB(1, 0), b2b, o3, voffB); PG8_STAGE(PG8_SB(1, 1), b2b, o3 + hstepB, voffB); PG8_STAGE(PG8_SA(1, 0), a2b, o3, vA2);
            PG8_WAIT_V(8); PG8_WAIT_L(0); PG8_BAR; PG8_MMA(1, 0, At, B0); PG8_MMA(1, 1, At, B1); PG8_BAR; PG8_SCHED;
        }
        if constexpr (ALIGN_EPI) { if (wr == 0) PG8_BAR; }
        E(acc, cur, wr, wc, fr, fq);
        if (!has_next) break;
#pragma unroll
        for (int a = 0; a < 2; ++a)
#pragma unroll
            for (int b = 0; b < 2; ++b)
#pragma unroll
                for (int m = 0; m < 4; ++m)
#pragma unroll
                    for (int n = 0; n < 2; ++n) acc[a][b][m][n] = (f32x4){0.f, 0.f, 0.f, 0.f};
        cur = nxt; cA = nA; cB = nB; ldaC = ldaN; voffA[0] = voffAn[0]; voffA[1] = voffAn[1]; hstepA = hstepAn; ++ui;
        if constexpr (ALIGN_EPI) { if (wr == 1) PG8_BAR; }
    }
    PG8_WAIT_V(0);
    if constexpr (!ALIGN_EPI) { if (wr == 0) PG8_BAR; }
    PG8_BAR;
#undef PG8_SA
#undef PG8_SB
#undef PG8_STAGE
#undef PG8_LDA
#undef PG8_LDB
#undef PG8_MMA
#undef PG8_WAIT_V
#undef PG8_WAIT_L
#undef PG8_BAR
#undef PG8_SCHED
}
}

constexpr int NB = 4, TT = 4096, LC = 256, SS = TT + LC  , DM = 1024, MR = NB * SS  ;
constexpr int INC = 10944;
constexpr float EPS = 1e-6f;
constexpr float LOG2E = 1.4426950408889634f;
constexpr float QSCALE = 0.07216878364870322f * 1.4426950408889634f;
constexpr int NWAVES = 8, NTHR = 512;

constexpr size_t MiB = 1u << 20;
constexpr size_t WS_CTL = 0;
constexpr size_t WS_XC1 = 1 * MiB;
constexpr size_t WS_W = 5 * MiB;
constexpr size_t WS_AR = 25 * MiB;
constexpr size_t AR_YB = WS_AR + 0 * MiB;
constexpr size_t AR_XA = WS_AR + 34 * MiB;
constexpr size_t AR_MD = WS_AR + 68 * MiB;
constexpr size_t AR_RQKV = WS_AR + 94 * MiB;
constexpr size_t AR_OB = WS_AR + 196 * MiB;
constexpr size_t AR_KV = WS_AR + 112 * MiB;
constexpr size_t AR_QN = WS_AR + 180 * MiB;
constexpr size_t AR_QP = WS_AR + 214 * MiB;
constexpr size_t AR_RI = WS_AR + 102 * MiB;
constexpr size_t AR_Y0 = WS_AR + 68 * MiB;
constexpr size_t AR_CAF = WS_AR + 102 * MiB;
constexpr size_t AR_CAB = WS_AR + 136 * MiB;
constexpr size_t AR_SUM = WS_AR + 170 * MiB;
constexpr size_t AR_Z = WS_AR + 102 * MiB;
constexpr size_t AR_GS = WS_AR + 136 * MiB;
constexpr size_t WS_END = 256 * MiB;
constexpr size_t W_WT1 = WS_W;
constexpr size_t W_WTQ = WS_W + 10 * MiB;
constexpr size_t W_WTKV = WS_W + 12 * MiB;
constexpr size_t W_WTL = WS_W + 13 * MiB;
constexpr size_t W_WTG = WS_W;
constexpr size_t W_WTGM = WS_W + 6 * MiB;
constexpr size_t W_WTD = WS_W + 12 * MiB;
constexpr size_t W_WTO = WS_W + 18 * MiB;
constexpr int CT_MOD = 16384;
constexpr int CT_ROPER = CT_MOD + 2 * 5 * 3072;
constexpr int CT_ROPEM = CT_ROPER + 2 * 4096;
constexpr int CT_SP = CT_ROPEM + 2 * 1024;
constexpr int CT_LG = CT_SP + 4096;
constexpr int CT_END = CT_LG + 16;
static_assert(CT_END * 4 <= (int)MiB, "CTL");

constexpr int LDS_BYTES = 147456;

struct Params {
    const float* in[29];
    float* out;
    unsigned char* ws;
};

#define EX2(x) __builtin_amdgcn_exp2f(x)
#define RSQ(x) __builtin_amdgcn_rsqf(x)
#define SQRT(x) __builtin_amdgcn_sqrtf(x)
__device__ __forceinline__ float bf2f(unsigned v) { return __uint_as_float(v << 16); }
__device__ __forceinline__ unsigned f2bf(float f) { unsigned u = __float_as_uint(f); return (u + 0x7fffu + ((u >> 16) & 1u)) >> 16; }
__device__ __forceinline__ unsigned pk2(float lo, float hi) { return f2bf(lo) | (f2bf(hi) << 16); }
__device__ __forceinline__ float lo_bf(unsigned w) { return __uint_as_float(w << 16); }
__device__ __forceinline__ float hi_bf(unsigned w) { return __uint_as_float(w & 0xffff0000u); }
__device__ __forceinline__ float wave_sum(float v) {
#pragma unroll
    for (int o = 1; o < 64; o <<= 1) v += __shfl_xor(v, o);
    return v;
}
__device__ __forceinline__ float wave_max(float v) {
#pragma unroll
    for (int o = 1; o < 64; o <<= 1) v = fmaxf(v, __shfl_xor(v, o));
    return v;
}
__device__ __forceinline__ float sigmoidf_(float x) { return __builtin_amdgcn_rcpf(1.f + __expf(-x)); }
__device__ __forceinline__ float siluf_(float x) { return x * __builtin_amdgcn_rcpf(1.f + __expf(-x)); }

__device__ __forceinline__ const float* inp_(int i) { asm volatile("" : "+s"(i)); const float* const* ka = (const float* const*)__builtin_amdgcn_kernarg_segment_ptr(); return ka[i]; }
#define INP(i) inp_(i)
__device__ __forceinline__ unsigned char* wsp_(unsigned char* p) { asm volatile("" : "+s"(p)); return p; }
struct Ctx {
    float* out; unsigned char* ws; LAS unsigned char* lds; int tid, lane, wave, G, bid;
    int gw, ngw;
    int rot;
    float* ctl;
};

__device__ __forceinline__ Ctx mkctx(LAS unsigned char* lds) {
    Ctx C; int t = threadIdx.x; asm volatile("" : "+v"(t)); int b = blockIdx.x; asm volatile("" : "+s"(b)); int g = gridDim.x; asm volatile("" : "+s"(g));
    C.tid = t; C.lane = t & 63; C.wave = __builtin_amdgcn_readfirstlane(t >> 6); C.bid = b; C.G = g; C.gw = b * NWAVES + C.wave; C.ngw = g * NWAVES; C.rot = 0;
    int io = 29, iw = 30; asm volatile("" : "+s"(io)); asm volatile("" : "+s"(iw));
    unsigned char* const* ka = (unsigned char* const*)__builtin_amdgcn_kernarg_segment_ptr();
    C.out = (float*)ka[io]; C.ws = ka[iw]; C.ctl = (float*)(C.ws + WS_CTL); C.lds = lds;
    return C;
}
__device__ __forceinline__ const float* resid_row(const Ctx& C, int l, int m) {
    const int b = m / SS, s = m - b * SS;
    if (s < LC) { const float* base = (l == 0) ? INP(2) : (const float*)(C.ws + WS_XC1); return base + (size_t)(b * LC + s) * DM; }
    const float* base = (l == 0) ? INP(0) : C.out; return base + (size_t)(b * TT + (s - LC)) * DM;
}

__device__ __forceinline__ void phase_prep(Ctx& C) {
    LAS float* sl = (LAS float*)C.lds;
    LAS float* red = (LAS float*)(C.lds + 32768);
    for (int i = C.tid; i < 5 * 1024; i += NTHR) { const int r = i >> 10, k = i & 1023; const float v = (r < 4) ? INP(1)[r * 1024 + k] : INP(3)[k]; sl[i] = siluf_(v); }
    __syncthreads();
    for (int it = C.bid; it < 2 * 96; it += C.G) {
        const int l = it / 96, grp = it % 96, kg = C.tid >> 5, cj = C.tid & 31, col = grp * 32 + cj;
        const float* w = INP(4) + (size_t)l * 1024 * 3072 + col;
        float a0 = 0.f, a1 = 0.f, a2 = 0.f, a3 = 0.f, a4 = 0.f;
#pragma unroll 8
        for (int k = kg * 64; k < kg * 64 + 64; ++k) { const float wv = w[(size_t)k * 3072]; a0 += sl[k] * wv; a1 += sl[1024 + k] * wv; a2 += sl[2048 + k] * wv; a3 += sl[3072 + k] * wv; a4 += sl[4096 + k] * wv; }
        red[(kg * 32 + cj) * 5 + 0] = a0; red[(kg * 32 + cj) * 5 + 1] = a1; red[(kg * 32 + cj) * 5 + 2] = a2; red[(kg * 32 + cj) * 5 + 3] = a3; red[(kg * 32 + cj) * 5 + 4] = a4;
        __syncthreads();
        if (C.tid < 160) { const int c2 = C.tid / 5, r = C.tid % 5; float s = 0.f;
            for (int g = 0; g < 16; ++g) s += red[(g * 32 + c2) * 5 + r];
            C.ctl[CT_MOD + (l * 5 + r) * 3072 + grp * 32 + c2] = s + INP(5)[l * 3072 + grp * 32 + c2]; }
        __syncthreads();
    }
    const int gt = C.bid * NTHR + C.tid, ngt = C.G * NTHR;
    for (int i = gt; i < 4096; i += ngt) { const int pos = i >> 6, f = i & 63; const float inv = powf(10000.f, -(float)f / 64.f), ang = (float)pos * inv;
        C.ctl[CT_ROPER + i] = cosf(ang); C.ctl[CT_ROPER + 4096 + i] = sinf(ang); }
    for (int i = gt; i < 1024; i += ngt) { const int pos = i >> 4, f = i & 15; const float inv = powf(10000.f, -(float)f / 16.f), ang = (float)pos * inv;
        C.ctl[CT_ROPEM + i] = cosf(ang); C.ctl[CT_ROPEM + 1024 + i] = sinf(ang); }
    for (int i = gt; i < 4096; i += ngt) C.ctl[CT_SP + i] = log1pf(expf(-INP(14)[i]));
    for (int i = gt; i < 16; i += ngt) C.ctl[CT_LG + i] = -log1pf(expf(-INP(15)[i])) * LOG2E;
}

__device__ __forceinline__ void tr_item(const float* W, int ldw, int k0, int n0, bf16_t* WT, int ldt, int drow0, int dk0, LAS float* scr, int lane) {
#pragma unroll 8
    for (int i = 0; i < 32; ++i) { const int kk = 2 * i + (lane >> 5); scr[kk * 33 + (lane & 31)] = W[(size_t)(k0 + kk) * ldw + n0 + (lane & 31)]; }
    asm volatile("s_waitcnt lgkmcnt(0)" ::: "memory");
    const int c = lane & 7;
#pragma unroll
    for (int j = 0; j < 4; ++j) { const int n = (lane >> 3) + 8 * j; const LAS float* s = scr + (8 * c) * 33 + n;
        u32x4 o; o.x = pk2(s[0 * 33], s[1 * 33]); o.y = pk2(s[2 * 33], s[3 * 33]); o.z = pk2(s[4 * 33], s[5 * 33]); o.w = pk2(s[6 * 33], s[7 * 33]);
        *(u32x4*)(WT + (size_t)(drow0 + n) * ldt + dk0 + 8 * c) = o; }
    asm volatile("s_waitcnt lgkmcnt(0)" ::: "memory");
}
__device__ __forceinline__ void conv_rows(Ctx& C, const float* W, int ldw, int K, int scol0, bf16_t* WT, int ldt, int drow0, int dk0, int nrows, LAS float* scr) {
    const int nkb = K / 64, items = nkb * (nrows / 32);
    int g0 = C.gw - C.rot; if (g0 < 0) g0 += C.ngw; C.rot = (C.rot + items) % C.ngw;
    for (int it = g0; it < items; it += C.ngw) { const int nb = it / nkb, kb = it - nb * nkb;
        tr_item(W, ldw, kb * 64, scol0 + nb * 32, WT, ldt, drow0 + nb * 32, dk0 + kb * 64, scr, C.lane); }
}
__device__ __forceinline__ int ropeperm(int j) { const int h = j >> 8, jj = j & 255, half = jj >> 7, g = (jj & 127) >> 3, r8 = jj & 7; return h * 256 + (half * 2 + (r8 >> 2)) * 64 + g * 4 + (r8 & 3); }
__device__ __forceinline__ void tr_item_rope(const float* W, int ldw, int k0, int scol0, int jbase, bf16_t* WT, int ldt, int drow0, int dk0, LAS float* scr, int lane) {
    const int sc = scol0 + ropeperm(jbase + (lane & 31));
#pragma unroll 8
    for (int i = 0; i < 32; ++i) { const int kk = 2 * i + (lane >> 5); scr[kk * 33 + (lane & 31)] = W[(size_t)(k0 + kk) * ldw + sc]; }
    asm volatile("s_waitcnt lgkmcnt(0)" ::: "memory");
    const int c = lane & 7;
#pragma unroll
    for (int j = 0; j < 4; ++j) { const int n = (lane >> 3) + 8 * j; const LAS float* s = scr + (8 * c) * 33 + n;
        u32x4 o; o.x = pk2(s[0 * 33], s[1 * 33]); o.y = pk2(s[2 * 33], s[3 * 33]); o.z = pk2(s[4 * 33], s[5 * 33]); o.w = pk2(s[6 * 33], s[7 * 33]);
        *(u32x4*)(WT + (size_t)(drow0 + n) * ldt + dk0 + 8 * c) = o; }
    asm volatile("s_waitcnt lgkmcnt(0)" ::: "memory");
}
__device__ __forceinline__ void conv_rows_rope(Ctx& C, const float* W, int ldw, int K, int scol0, bf16_t* WT, int ldt, int drow0, int nrows, LAS float* scr) {
    const int nkb = K / 64, items = nkb * (nrows / 32);
    int g0 = C.gw - C.rot; if (g0 < 0) g0 += C.ngw; C.rot = (C.rot + items) % C.ngw;
    for (int it = g0; it < items; it += C.ngw) { const int nb = it / nkb, kb = it - nb * nkb;
        tr_item_rope(W, ldw, kb * 64, scol0, nb * 32, WT, ldt, drow0 + nb * 32, kb * 64, scr, C.lane); }
}
__device__ __forceinline__ void zero_rows(Ctx& C, bf16_t* WT, int ldt, int drow0, int dk0, int nrows, int ncols) {
    const int per = ncols / 8, items = nrows * per;
    int g0 = C.gw - C.rot; if (g0 < 0) g0 += C.ngw; C.rot = (C.rot + (items + 63) / 64) % C.ngw;
    for (int it = g0 * 64 + C.lane; it < items; it += C.ngw * 64) { const int r = it / per, c = it - r * per; *(u32x4*)(WT + (size_t)(drow0 + r) * ldt + dk0 + c * 8) = (u32x4){0u, 0u, 0u, 0u}; }
}
__device__ __forceinline__ void phase_wconv_early(Ctx& C, int l) {
    LAS float* scr = (LAS float*)(C.lds + C.wave * 16384);
    unsigned char* ws = C.ws;
    const float* win = INP(7) + (size_t)l * 1024 * INC;
    bf16_t* WT1 = (bf16_t*)(ws + W_WT1);
    conv_rows(C, win, INC, 1024, 0, WT1, 1024, 0, 0, 1024, scr);
    conv_rows_rope(C, win, INC, 1024, 2048, WT1, 1024, 1024, 1024, scr);
    conv_rows_rope(C, win, INC, 1024, 3072, WT1, 1024, 2048, 1024, scr);
    conv_rows(C, win, INC, 1024, 4096, WT1, 1024, 3072, 0, 1024, scr);
    conv_rows(C, win, INC, 1024, 6144, WT1, 1024, 4096, 0, 704, scr);
    zero_rows(C, WT1, 1024, 4800, 0, 64, 1024);
    const float* wq = INP(18) + (size_t)l * 384 * 1536; bf16_t* WTQ = (bf16_t*)(ws + W_WTQ);
    for (int h = 0; h < 8; ++h) { conv_rows(C, wq, 1536, 384, h * 192, WTQ, 384, h * 128, 0, 128, scr); conv_rows(C, wq, 1536, 384, h * 192 + 128, WTQ, 384, 1024 + h * 64, 0, 64, scr); }
    const float* wkv = INP(20) + (size_t)l * 256 * 2048; bf16_t* WTKV = (bf16_t*)(ws + W_WTKV);
    for (int h = 0; h < 8; ++h) { conv_rows(C, wkv, 2048, 256, h * 256, WTKV, 256, h * 128, 0, 128, scr); conv_rows(C, wkv, 2048, 256, h * 256 + 128, WTKV, 256, 1024 + h * 128, 0, 128, scr); }
    bf16_t* WTL = (bf16_t*)(ws + W_WTL);
    for (int d = 0; d < 2; ++d) for (int n = 0; n < 8; ++n) for (int mat = 0; mat < 2; ++mat) {
        const float* w = INP(mat == 0 ? 10 : 12) + ((size_t)(l * 2 + d) * 8 + n) * 128 * 128;
        const int drow0 = d * 2048 + n * 256 + mat * 128;
        conv_rows(C, w, 128, 128, 0, WTL, 256, drow0, (n & 1) * 128, 128, scr);
        zero_rows(C, WTL, 256, drow0, ((n & 1) ^ 1) * 128, 128, 128);
    }
}
__device__ __forceinline__ void phase_wconv_late(Ctx& C, int l) {
    LAS float* scr = (LAS float*)(C.lds + C.wave * 16384);
    unsigned char* ws = C.ws;
    const float* win = INP(7) + (size_t)l * 1024 * INC;
    bf16_t* WTG = (bf16_t*)(ws + W_WTG);
    conv_rows(C, win, INC, 1024, 1024, WTG, 1024, 0, 0, 1024, scr);
    conv_rows(C, win, INC, 1024, 5120, WTG, 1024, 1024, 0, 1024, scr);
    conv_rows(C, win, INC, 1024, 6848, WTG, 1024, 2048, 0, 1024, scr);
    conv_rows(C, win, INC, 1024, 7872, (bf16_t*)(ws + W_WTGM), 1024, 0, 0, 3072, scr);
    for (int i = 0; i < 3; ++i) conv_rows(C, INP(25 + i) + (size_t)l * 1024 * 1024, 1024, 1024, 0, (bf16_t*)(ws + W_WTD) + (size_t)i * 1024 * 1024, 1024, 0, 0, 1024, scr);
    conv_rows(C, INP(28) + (size_t)l * 1024 * 1024, 1024, 1024, 0, (bf16_t*)(ws + W_WTO), 1024, 0, 0, 1024, scr);
}

__device__ __forceinline__ void phase_h(Ctx& C, int l, bf16_t* H) {
    const float* gain = INP(6) + l * 1024;
    for (int m = C.gw; m < MR; m += C.ngw) {
        const int b = m / SS, s = m - b * SS, r = (s < LC) ? 4 : b;
        const float* xr = resid_row(C, l, m);
        const float* mod = C.ctl + CT_MOD + (l * 5 + r) * 3072;
        f32x4 v[4]; float ss = 0.f;
#pragma unroll
        for (int j = 0; j < 4; ++j) { v[j] = *(const f32x4*)(xr + 4 * C.lane + 256 * j); ss += (v[j].x * v[j].x + v[j].y * v[j].y) + (v[j].z * v[j].z + v[j].w * v[j].w); }
        const float rstd = RSQ(wave_sum(ss) * (1.f / 1024.f) + EPS);
#pragma unroll
        for (int j = 0; j < 4; ++j) { const int c = 4 * C.lane + 256 * j;
            const f32x4 g = *(const f32x4*)(gain + c), sh = *(const f32x4*)(mod + c), sc = *(const f32x4*)(mod + 1024 + c);
            const f32x4 y = (v[j] * rstd) * g;
            const f32x4 o = y * (sc + 1.0f) + sh;
            u32x2 w; w.x = pk2(o.x, o.y); w.y = pk2(o.z, o.w);
            *(u32x2*)(H + (size_t)m * 1024 + c) = w; }
    }
}

using pg8::Unit;
struct ProbPlain {
    const bf16_t* A; const bf16_t* Bt; int lda, ldb, K;
    __device__ __forceinline__ void get(const Unit& u, const char*& a, const char*& b, int& lda_) const {
        a = (const char*)(A + (size_t)u.pm * 256 * lda); b = (const char*)(Bt + (size_t)u.pn * 256 * ldb); lda_ = lda; }
};
struct ProbLru {
    const bf16_t* A; const bf16_t* Bt; int ldb, K;
    __device__ __forceinline__ void get(const Unit& u, const char*& a, const char*& b, int& lda_) const {
        a = (const char*)(A + (size_t)u.pm * 256 * 1024 + (u.pn >> 1) * 256); b = (const char*)(Bt + (size_t)u.pn * 256 * 256); lda_ = 1024; }
};
struct ProbD {
    unsigned char* ws; int ldb, K;
    __device__ __forceinline__ void get(const Unit& u, const char*& a, const char*& b, int& lda_) const {
        const int i = u.z >> 1;
        if ((u.z & 1) == 0) { a = (const char*)(ws + AR_MD + (size_t)u.pm * 256 * 1024 * 2); b = (const char*)(ws + W_WTGM + ((size_t)i * 1024 + u.pn * 256) * 1024 * 2); lda_ = 1024; }
        else { const size_t yo = (i == 0) ? AR_XA : (i == 1) ? AR_YB : AR_QN;
            a = (const char*)(ws + yo + (size_t)u.pm * 256 * 1024 * 2); b = (const char*)(ws + W_WTD + ((size_t)i * 1024 + u.pn * 256) * 1024 * 2); lda_ = 1024; }
    }
};

#define EPI_ARGS const f32x4 (&acc)[2][2][4][2], const Unit& u, int wr, int wc, int fr, int fq
template <size_t O0, int L0, size_t O1, int L1, size_t O2, int L2, int T1, int T2>
struct EpiStore3 {
    static constexpr bool PERM = true;
    unsigned char* ws;
    __device__ __forceinline__ void operator()(EPI_ARGS) const {
        bf16_t* bs; int ldc, ct;
        size_t off;
        if (u.pn < T1) { off = O0; ldc = L0; ct = u.pn; } else if (u.pn < T2) { off = O1; ldc = L1; ct = u.pn - T1; } else { off = O2; ldc = L2; ct = u.pn - T2; }
        bs = (bf16_t*)(ws + off);
        const int row0 = u.pm * 256 + wr * 64 + fr, col0 = ct * 256 + wc * 32 + 8 * fq;
#pragma unroll
        for (int ai = 0; ai < 2; ++ai)
#pragma unroll
            for (int m = 0; m < 4; ++m) { bf16_t* rowp = bs + (size_t)(row0 + ai * 128 + m * 16) * ldc + col0;
#pragma unroll
                for (int bj = 0; bj < 2; ++bj) { const f32x4 v0 = acc[ai][bj][m][0], v1 = acc[ai][bj][m][1];
                    u32x4 w; w.x = pg8::cvt_pk_bf16(v0[0], v0[1]); w.y = pg8::cvt_pk_bf16(v0[2], v0[3]); w.z = pg8::cvt_pk_bf16(v1[0], v1[1]); w.w = pg8::cvt_pk_bf16(v1[2], v1[3]);
                    *(u32x4*)(rowp + bj * 128) = w; } }
    }
};
struct EpiG1 {
    static constexpr bool PERM = true;
    unsigned char* ws; const float* cs;
    __device__ __forceinline__ void operator()(EPI_ARGS) const {
        bf16_t* bs; int ldc, ct;
        if (u.pn < 4) { bs = (bf16_t*)(ws + AR_XA); ldc = 1024; ct = u.pn; } else if (u.pn < 16) { bs = (bf16_t*)(ws + AR_RQKV); ldc = 3072; ct = u.pn - 4; } else { bs = (bf16_t*)(ws + AR_MD); ldc = 768; ct = u.pn - 16; }
        const int row0 = u.pm * 256 + wr * 64 + fr, col0 = ct * 256 + wc * 32 + 8 * fq;
        const bool rope = (u.pn >= 4) && (u.pn < 12), iskey = (u.pn >= 8);
        const int bq = u.pm / 17, s0 = (u.pm - bq * 17) * 256 + wr * 64 + fr;
        const int f0 = (wc * 4 + fq) * 4;
#pragma unroll
        for (int ai = 0; ai < 2; ++ai)
#pragma unroll
            for (int m = 0; m < 4; ++m) { bf16_t* rowp = bs + (size_t)(row0 + ai * 128 + m * 16) * ldc + col0;
                const int s = s0 + ai * 128 + m * 16, t = s - LC; const bool lat = s >= LC;
#pragma unroll
                for (int bj = 0; bj < 2; ++bj) { f32x4 v0 = acc[ai][bj][m][0], v1 = acc[ai][bj][m][1];
                    if (rope) {
                        if (lat) { const int pos = bj ? (t & 63) : (t >> 6); const f32x4 c = *(const f32x4*)(cs + pos * 64 + f0), sn = *(const f32x4*)(cs + 4096 + pos * 64 + f0);
                            const f32x4 a = v0 * c - v1 * sn, b = v1 * c + v0 * sn; v0 = a; v1 = b; }
                        if (iskey) { v0 = v0 * 0.0625f; v1 = v1 * 0.0625f; } }
                    u32x4 w; w.x = pg8::cvt_pk_bf16(v0[0], v0[1]); w.y = pg8::cvt_pk_bf16(v0[2], v0[3]); w.z = pg8::cvt_pk_bf16(v1[0], v1[1]); w.w = pg8::cvt_pk_bf16(v1[2], v1[3]);
                    *(u32x4*)(rowp + bj * 128) = w; }
                asm volatile("" ::: "memory"); }
    }
};
typedef f16_t f16x8 __attribute__((ext_vector_type(8)));
struct EpiLru {
    static constexpr bool PERM = true;
    const bf16_t* U; f16_t* RI; const float* ba; const float* bx; const float* sp;
    __device__ __forceinline__ void operator()(EPI_ARGS) const {
        const int row0 = u.pm * 256 + wr * 64 + fr, ch0 = u.pn * 128 + wc * 32 + 8 * fq;
        float bav[8], bxv[8], spv[8];
#pragma unroll
        for (int e = 0; e < 8; ++e) { bav[e] = ba[ch0 + e]; bxv[e] = bx[ch0 + e]; spv[e] = sp[ch0 + e] * (-8.f); }
#pragma unroll
        for (int ai = 0; ai < 2; ++ai)
#pragma unroll
            for (int m = 0; m < 4; ++m) { const int row = row0 + ai * 128 + m * 16;
                const u32x4 uw = *(const u32x4*)(U + (size_t)row * 1024 + ch0);
                float uv[8] = {lo_bf(uw.x), hi_bf(uw.x), lo_bf(uw.y), hi_bf(uw.y), lo_bf(uw.z), hi_bf(uw.z), lo_bf(uw.w), hi_bf(uw.w)};
                f16x8 la, bc;
#pragma unroll
                for (int e = 0; e < 8; ++e) { const float rp = acc[ai][0][m][e >> 2][e & 3] + bav[e], ip = acc[ai][1][m][e >> 2][e & 3] + bxv[e];
                    const float r = sigmoidf_(rp), ig = sigmoidf_(ip);
                    const float loga = r * spv[e];
                    const float bb = SQRT(fmaxf(-expm1f(2.f * loga), 0.f)) * (ig * uv[e]);
                    la[e] = (f16_t)(loga * LOG2E); bc[e] = (f16_t)bb; }
                *(f16x8*)(RI + (size_t)row * 2048 + ch0) = la; *(f16x8*)(RI + (size_t)row * 2048 + 1024 + ch0) = bc;
                asm volatile("" ::: "memory"); }
    }
};
struct EpiGate {
    static constexpr bool PERM = true;
    unsigned char* ws;
    __device__ __forceinline__ void operator()(EPI_ARGS) const {
        const int br = u.pn >> 2; const size_t yo = (br == 0) ? AR_XA : (br == 1) ? AR_YB : AR_QN; bf16_t* bs = (bf16_t*)(ws + yo); const int ldc = 1024;
        const int row0 = u.pm * 256 + wr * 64 + fr, col0 = (u.pn & 3) * 256 + wc * 32 + 8 * fq;
#pragma unroll
        for (int ai = 0; ai < 2; ++ai)
#pragma unroll
            for (int m = 0; m < 4; ++m) { bf16_t* rowp = bs + (size_t)(row0 + ai * 128 + m * 16) * ldc + col0;
#pragma unroll
                for (int bj = 0; bj < 2; ++bj) { const f32x4 v0 = acc[ai][bj][m][0], v1 = acc[ai][bj][m][1];
                    const u32x4 y = *(const u32x4*)(rowp + bj * 128);
                    u32x4 w; w.x = pg8::cvt_pk_bf16(lo_bf(y.x) * siluf_(v0[0]), hi_bf(y.x) * siluf_(v0[1])); w.y = pg8::cvt_pk_bf16(lo_bf(y.y) * siluf_(v0[2]), hi_bf(y.y) * siluf_(v0[3]));
                    w.z = pg8::cvt_pk_bf16(lo_bf(y.z) * siluf_(v1[0]), hi_bf(y.z) * siluf_(v1[1])); w.w = pg8::cvt_pk_bf16(lo_bf(y.w) * siluf_(v1[2]), hi_bf(y.w) * siluf_(v1[3]));
                    *(u32x4*)(rowp + bj * 128) = w; }
                asm volatile("" ::: "memory"); }
    }
};
struct EpiD {
    static constexpr bool PERM = true;
    bf16_t* Z; unsigned char* gs;
    __device__ __forceinline__ void operator()(EPI_ARGS) const {
        const int row0 = u.pm * 256 + wr * 64 + fr, col0 = u.pn * 256 + wc * 32 + 8 * fq, i = u.z >> 1;
        const unsigned tq = (unsigned)(((wr * 4 + wc) * 64 + fq * 16 + fr) * 64);
        if ((u.z & 1) == 0) {
#pragma unroll
            for (int ai = 0; ai < 2; ++ai)
#pragma unroll
                for (int m = 0; m < 4; ++m)
#pragma unroll
                    for (int bj = 0; bj < 2; ++bj) { const f32x4 v0 = acc[ai][bj][m][0], v1 = acc[ai][bj][m][1];
                        u32x4 w; w.x = pg8::cvt_pk_bf16(sigmoidf_(v0[0]), sigmoidf_(v0[1])); w.y = pg8::cvt_pk_bf16(sigmoidf_(v0[2]), sigmoidf_(v0[3]));
                        w.z = pg8::cvt_pk_bf16(sigmoidf_(v1[0]), sigmoidf_(v1[1])); w.w = pg8::cvt_pk_bf16(sigmoidf_(v1[2]), sigmoidf_(v1[3]));
                        *(u32x4*)(gs + (((ai * 4 + m) * 2 + bj) >> 2) * 32768 + tq + (((ai * 4 + m) * 2 + bj) & 3) * 16) = w; }
        } else {
#pragma unroll
            for (int ai = 0; ai < 2; ++ai)
#pragma unroll
                for (int m = 0; m < 4; ++m) { bf16_t* zrow = Z + (size_t)(row0 + ai * 128 + m * 16) * 1024 + col0;
#pragma unroll
                    for (int bj = 0; bj < 2; ++bj) { const f32x4 v0 = acc[ai][bj][m][0], v1 = acc[ai][bj][m][1];
                        const u32x4 g = *(const u32x4*)(gs + (((ai * 4 + m) * 2 + bj) >> 2) * 32768 + tq + (((ai * 4 + m) * 2 + bj) & 3) * 16); bf16_t* zp = zrow + bj * 128;
                        float o0 = lo_bf(g.x) * v0[0], o1 = hi_bf(g.x) * v0[1], o2 = lo_bf(g.y) * v0[2], o3 = hi_bf(g.y) * v0[3], o4 = lo_bf(g.z) * v1[0], o5 = hi_bf(g.z) * v1[1], o6 = lo_bf(g.w) * v1[2], o7 = hi_bf(g.w) * v1[3];
                        if (i > 0) { const u32x4 zo = *(const u32x4*)zp; o0 += lo_bf(zo.x); o1 += hi_bf(zo.x); o2 += lo_bf(zo.y); o3 += hi_bf(zo.y); o4 += lo_bf(zo.z); o5 += hi_bf(zo.z); o6 += lo_bf(zo.w); o7 += hi_bf(zo.w); }
                        u32x4 w; w.x = pg8::cvt_pk_bf16(o0, o1); w.y = pg8::cvt_pk_bf16(o2, o3); w.z = pg8::cvt_pk_bf16(o4, o5); w.w = pg8::cvt_pk_bf16(o6, o7); *(u32x4*)zp = w; }
                    asm volatile("" ::: "memory"); }
        }
    }
};
struct EpiOut {
    static constexpr bool PERM = false;
    const float* xlat; const float* xctx; float* olat; float* octx; const float* mod;
    __device__ __forceinline__ void operator()(EPI_ARGS) const {
        const int b = u.pm / 17, isctx = (u.pm - b * 17) == 0;
        const float* gate = mod + (isctx ? 4 : b) * 3072 + 2048;
        const int col0 = u.pn * 256 + wc * 32 + 4 * fq;
        f32x4 gv[2][2];
#pragma unroll
        for (int bj = 0; bj < 2; ++bj)
#pragma unroll
            for (int n = 0; n < 2; ++n) gv[bj][n] = *(const f32x4*)(gate + col0 + bj * 128 + n * 16);
#pragma unroll
        for (int ai = 0; ai < 2; ++ai)
#pragma unroll
            for (int m = 0; m < 4; ++m) { const int s = (u.pm - b * 17) * 256 + ai * 128 + wr * 64 + m * 16 + fr;
                const size_t off = isctx ? ((size_t)(b * LC + s) * 1024 + col0) : ((size_t)(b * TT + (s - LC)) * 1024 + col0);
                const float* xin = isctx ? xctx : xlat; float* xo = isctx ? octx : olat;
#pragma unroll
                for (int bj = 0; bj < 2; ++bj)
#pragma unroll
                    for (int n = 0; n < 2; ++n) { const f32x4 xv = *(const f32x4*)(xin + off + bj * 128 + n * 16);
                        *(f32x4*)(xo + off + bj * 128 + n * 16) = xv + gv[bj][n] * acc[ai][bj][m][n]; }
                asm volatile("" ::: "memory"); }
    }
};

__device__ __forceinline__ void phase_ret_rope(Ctx& C, bf16_t* RQKV) {
    const float* cs = C.ctl + CT_ROPER; const float* sn = cs + 4096;
    for (int m = C.gw; m < MR; m += C.ngw) {
        const int b = m / SS, s = m - b * SS; const bool lat = s >= LC; const int t = s - LC, prow = lat ? (t >> 6) : 0, pcol = lat ? (t & 63) : 0;
        bf16_t* row = RQKV + (size_t)m * 3072;
#pragma unroll
        for (int j = 0; j < 16; ++j) {
            const int idx = j * 64 + C.lane, f = idx & 63, half = (idx >> 6) & 1, h = (idx >> 7) & 3, tz = idx >> 9;
            bf16_t* p = row + tz * 1024 + h * 256 + half * 128 + f;
            const float x1 = bf2f(p[0]), x2 = bf2f(p[64]);
            float o1 = x1, o2 = x2;
            if (lat) { const int pos = half ? pcol : prow; const float c = cs[pos * 64 + f], sv = sn[pos * 64 + f]; o1 = x1 * c - x2 * sv; o2 = x2 * c + x1 * sv; }
            if (tz) { o1 *= 0.0625f; o2 *= 0.0625f; }
            p[0] = (bf16_t)f2bf(o1); p[64] = (bf16_t)f2bf(o2);
        }
    }
}

#define RS_STEP(o, cnt, st) do { const bool up_ = (C.lane & (st)) != 0; _Pragma("unroll") for (int e_ = 0; e_ < (cnt) / 2; ++e_) { \
        const float send_ = up_ ? o[e_] : o[e_ + (cnt) / 2]; const float keep_ = up_ ? o[e_ + (cnt) / 2] : o[e_]; o[e_] = keep_ + __shfl_xor(send_, (st)); } } while (0)

__device__ __forceinline__ void phase_ret_naive(Ctx& C, int l, const bf16_t* RQKV, bf16_t* OI) {
    LAS unsigned char* qs = C.lds + C.wave * 512;
    const int nbu = (MR / 8) * 16;
    for (int bu = C.bid; bu < nbu; bu += C.G) {
        const int hq = bu & 15, h = hq >> 2, qd = hq & 3, n = (bu >> 4) * 8 + C.wave;
        const int b = n / SS, sn_ = n - b * SS;
        const float lgf = C.ctl[CT_LG + (l * 2 + 0) * 4 + h], lgb = C.ctl[CT_LG + (l * 2 + 1) * 4 + h];
        const int pfn = sn_, pbn = (sn_ < LC) ? (LC - 1 - sn_) : (SS + LC - 1 - sn_);
        asm volatile("s_waitcnt lgkmcnt(0)" ::: "memory");
        *(LAS u32x2*)(qs + C.lane * 8) = *(const u32x2*)(RQKV + (size_t)n * 3072 + h * 256 + C.lane * 4);
        asm volatile("s_waitcnt lgkmcnt(0)" ::: "memory");
        float o[64];
#pragma unroll
        for (int e = 0; e < 64; ++e) o[e] = 0.f;
        for (int sm = C.lane; sm < SS; sm += 64) {
            const bf16_t* krow = RQKV + (size_t)(b * SS + sm) * 3072 + 1024 + h * 256;
            float dot = 0.f;
#pragma unroll 4
            for (int c = 0; c < 32; ++c) { const u32x4 kv = *(const u32x4*)(krow + c * 8); const u32x4 qv = *(const LAS u32x4*)(qs + c * 16);
                dot += lo_bf(kv.x) * lo_bf(qv.x) + hi_bf(kv.x) * hi_bf(qv.x) + lo_bf(kv.y) * lo_bf(qv.y) + hi_bf(kv.y) * hi_bf(qv.y)
                     + lo_bf(kv.z) * lo_bf(qv.z) + hi_bf(kv.z) * hi_bf(qv.z) + lo_bf(kv.w) * lo_bf(qv.w) + hi_bf(kv.w) * hi_bf(qv.w); }
            const int pfm = sm, pbm = (sm < LC) ? (LC - 1 - sm) : (SS + LC - 1 - sm);
            float w = 0.f;
            if (pfn >= pfm) w += EX2(lgf * (float)(pfn - pfm));
            if (pbn >= pbm) w += EX2(lgb * (float)(pbn - pbm));
            const float ws_ = w * dot;
            const bf16_t* vrow = krow + 1024 + qd * 64;
#pragma unroll
            for (int c = 0; c < 8; ++c) { const u32x4 vv = *(const u32x4*)(vrow + c * 8);
                o[c * 8 + 0] += ws_ * lo_bf(vv.x); o[c * 8 + 1] += ws_ * hi_bf(vv.x); o[c * 8 + 2] += ws_ * lo_bf(vv.y); o[c * 8 + 3] += ws_ * hi_bf(vv.y);
                o[c * 8 + 4] += ws_ * lo_bf(vv.z); o[c * 8 + 5] += ws_ * hi_bf(vv.z); o[c * 8 + 6] += ws_ * lo_bf(vv.w); o[c * 8 + 7] += ws_ * hi_bf(vv.w); }
        }
        RS_STEP(o, 64, 32); RS_STEP(o, 32, 16); RS_STEP(o, 16, 8); RS_STEP(o, 8, 4); RS_STEP(o, 4, 2); RS_STEP(o, 2, 1);
        OI[(size_t)n * 1024 + h * 256 + qd * 64 + C.lane] = (bf16_t)f2bf(o[0]);
    }
}
__device__ __forceinline__ void phase_ret_ln(Ctx& C, int l, bf16_t* OI) {
    const float* gain = INP(16) + l * 1024;
    for (int m = C.gw; m < MR; m += C.ngw) {
#pragma unroll
        for (int h = 0; h < 4; ++h) { bf16_t* p = OI + (size_t)m * 1024 + h * 256 + C.lane * 4;
            const u32x2 w = *(const u32x2*)p; float x0 = lo_bf(w.x), x1 = hi_bf(w.x), x2 = lo_bf(w.y), x3 = hi_bf(w.y);
            const float mean = wave_sum((x0 + x1) + (x2 + x3)) * (1.f / 256.f);
            x0 -= mean; x1 -= mean; x2 -= mean; x3 -= mean;
            const float var = wave_sum((x0 * x0 + x1 * x1) + (x2 * x2 + x3 * x3)) * (1.f / 256.f);
            const float rstd = RSQ(var + EPS);
            const f32x4 g = *(const f32x4*)(gain + h * 256 + C.lane * 4);
            u32x2 o; o.x = pk2(x0 * rstd * g.x, x1 * rstd * g.y); o.y = pk2(x2 * rstd * g.z, x3 * rstd * g.w); *(u32x2*)p = o; }
    }
}

__device__ __forceinline__ void phase_md_post(Ctx& C, int l, bf16_t* MD) {
    const float* qn = INP(17) + l * 384; const float* kvn = INP(19) + l * 256; const float* gkr = INP(24) + l * 64;
    const float* cs = C.ctl + CT_ROPEM; const float* sn = cs + 1024;
    for (int m = C.gw; m < MR; m += C.ngw) {
        const int b = m / SS, s = m - b * SS; const bool lat = s >= LC; const int t = s - LC;
        bf16_t* row = MD + (size_t)m * 768;
        {   float x[6]; float ss = 0.f;
#pragma unroll
            for (int j = 0; j < 3; ++j) { const unsigned w = *(const unsigned*)(row + 2 * C.lane + 128 * j); x[2 * j] = lo_bf(w); x[2 * j + 1] = hi_bf(w); ss += x[2 * j] * x[2 * j] + x[2 * j + 1] * x[2 * j + 1]; }
            const float rstd = RSQ(wave_sum(ss) * (1.f / 384.f) + EPS);
#pragma unroll
            for (int j = 0; j < 3; ++j) { const int c = 2 * C.lane + 128 * j; *(unsigned*)(row + c) = pk2(x[2 * j] * rstd * qn[c], x[2 * j + 1] * rstd * qn[c + 1]); } }
        {   float x[4]; float ss = 0.f;
#pragma unroll
            for (int j = 0; j < 2; ++j) { const unsigned w = *(const unsigned*)(row + 384 + 2 * C.lane + 128 * j); x[2 * j] = lo_bf(w); x[2 * j + 1] = hi_bf(w); ss += x[2 * j] * x[2 * j] + x[2 * j + 1] * x[2 * j + 1]; }
            const float rstd = RSQ(wave_sum(ss) * (1.f / 256.f) + EPS);
#pragma unroll
            for (int j = 0; j < 2; ++j) { const int c = 2 * C.lane + 128 * j; *(unsigned*)(row + 384 + c) = pk2(x[2 * j] * rstd * kvn[c], x[2 * j + 1] * rstd * kvn[c + 1]); } }
        {   const float x = bf2f(row[640 + C.lane]);
            const float rstd = RSQ(wave_sum(x * x) * (1.f / 64.f) + EPS);
            float y = x * rstd * gkr[C.lane];
            if (lat) { const float pr = __shfl_xor(y, 16); const float rot = (C.lane & 16) ? pr : -pr; const int f = C.lane & 15, pos = (C.lane < 32) ? (t >> 6) : (t & 63);
                y = y * cs[pos * 16 + f] + rot * sn[pos * 16 + f]; }
            row[640 + C.lane] = (bf16_t)f2bf(y); }
    }
}
__device__ __forceinline__ void phase_qk_post(Ctx& C, int l, bf16_t* QN, bf16_t* QP, bf16_t* KV) {
    const float* gqn = INP(21) + l * 128; const float* gqr = INP(22) + l * 64; const float* gkn = INP(23) + l * 128;
    const float* cs = C.ctl + CT_ROPEM; const float* sn = cs + 1024;
    for (int m = C.gw; m < MR; m += C.ngw) {
        const int b = m / SS, s = m - b * SS; const bool lat = s >= LC; const int t = s - LC;
        bf16_t* qrow = QN + (size_t)m * 1024; bf16_t* prow = QP + (size_t)m * 512; bf16_t* krow = KV + (size_t)m * 2048;
#pragma unroll
        for (int h = 0; h < 8; ++h) {
            {   unsigned* p = (unsigned*)(qrow + h * 128 + 2 * C.lane); const unsigned w = *p; const float x0 = lo_bf(w), x1 = hi_bf(w);
                const float rstd = RSQ(wave_sum(x0 * x0 + x1 * x1) * (1.f / 128.f) + EPS);
                *p = pk2(x0 * rstd * gqn[2 * C.lane] * QSCALE, x1 * rstd * gqn[2 * C.lane + 1] * QSCALE); }
            {   bf16_t* p = prow + h * 64 + C.lane; const float x = bf2f(*p);
                const float rstd = RSQ(wave_sum(x * x) * (1.f / 64.f) + EPS);
                float y = x * rstd * gqr[C.lane];
                if (lat) { const float pr = __shfl_xor(y, 16); const float rot = (C.lane & 16) ? pr : -pr; const int f = C.lane & 15, pos = (C.lane < 32) ? (t >> 6) : (t & 63);
                    y = y * cs[pos * 16 + f] + rot * sn[pos * 16 + f]; }
                *p = (bf16_t)f2bf(y * QSCALE); }
            {   unsigned* p = (unsigned*)(krow + h * 128 + 2 * C.lane); const unsigned w = *p; const float x0 = lo_bf(w), x1 = hi_bf(w);
                const float rstd = RSQ(wave_sum(x0 * x0 + x1 * x1) * (1.f / 128.f) + EPS);
                *p = pk2(x0 * rstd * gkn[2 * C.lane], x1 * rstd * gkn[2 * C.lane + 1]); }
        }
    }
}

__device__ __forceinline__ void phase_attn_naive(Ctx& C, bool with_ctx, bf16_t* QN, const bf16_t* QP, const bf16_t* KV, const bf16_t* MD) {
    LAS unsigned char* qs = C.lds + C.wave * 512;
    const int nlat = NB * 8 * (TT / 8), nctx = with_ctx ? NB * 8 * (LC / 8) : 0;
    for (int bu = C.bid; bu < nlat + nctx; bu += C.G) {
        int b, h, s, nkeys;
        if (bu < nlat) { const int tb = bu % (TT / 8), bh = bu / (TT / 8); b = bh >> 3; h = bh & 7; s = LC + tb * 8 + C.wave; nkeys = SS; }
        else { const int r = bu - nlat, tb = r % (LC / 8), bh = r / (LC / 8); b = bh >> 3; h = bh & 7; s = tb * 8 + C.wave; nkeys = LC; }
        const size_t m = (size_t)b * SS + s;
        asm volatile("s_waitcnt lgkmcnt(0)" ::: "memory");
        if (C.lane < 32) *(LAS u32x2*)(qs + C.lane * 8) = *(const u32x2*)(QN + m * 1024 + h * 128 + C.lane * 4);
        else if (C.lane < 48) *(LAS u32x2*)(qs + 256 + (C.lane - 32) * 8) = *(const u32x2*)(QP + m * 512 + h * 64 + (C.lane - 32) * 4);
        asm volatile("s_waitcnt lgkmcnt(0)" ::: "memory");
        float o[128];
#pragma unroll
        for (int e = 0; e < 128; ++e) o[e] = 0.f;
        float mrun = -1e30f, lrun = 0.f;
        for (int key = C.lane; key < nkeys; key += 64) {
            const size_t kr = (size_t)b * SS + key;
            const bf16_t* kn = KV + kr * 2048 + h * 128; const bf16_t* kro = MD + kr * 768 + 640;
            float dot = 0.f;
#pragma unroll 4
            for (int c = 0; c < 16; ++c) { const u32x4 kv = *(const u32x4*)(kn + c * 8); const u32x4 qv = *(const LAS u32x4*)(qs + c * 16);
                dot += lo_bf(kv.x) * lo_bf(qv.x) + hi_bf(kv.x) * hi_bf(qv.x) + lo_bf(kv.y) * lo_bf(qv.y) + hi_bf(kv.y) * hi_bf(qv.y)
                     + lo_bf(kv.z) * lo_bf(qv.z) + hi_bf(kv.z) * hi_bf(qv.z) + lo_bf(kv.w) * lo_bf(qv.w) + hi_bf(kv.w) * hi_bf(qv.w); }
#pragma unroll 4
            for (int c = 0; c < 8; ++c) { const u32x4 kv = *(const u32x4*)(kro + c * 8); const u32x4 qv = *(const LAS u32x4*)(qs + 256 + c * 16);
                dot += lo_bf(kv.x) * lo_bf(qv.x) + hi_bf(kv.x) * hi_bf(qv.x) + lo_bf(kv.y) * lo_bf(qv.y) + hi_bf(kv.y) * hi_bf(qv.y)
                     + lo_bf(kv.z) * lo_bf(qv.z) + hi_bf(kv.z) * hi_bf(qv.z) + lo_bf(kv.w) * lo_bf(qv.w) + hi_bf(kv.w) * hi_bf(qv.w); }
            const float mnew = fmaxf(mrun, dot), alpha = EX2(mrun - mnew), p = EX2(dot - mnew);
            lrun = lrun * alpha + p; mrun = mnew;
            const bf16_t* vrow = KV + kr * 2048 + 1024 + h * 128;
#pragma unroll
            for (int c = 0; c < 16; ++c) { const u32x4 vv = *(const u32x4*)(vrow + c * 8);
                o[c * 8 + 0] = o[c * 8 + 0] * alpha + p * lo_bf(vv.x); o[c * 8 + 1] = o[c * 8 + 1] * alpha + p * hi_bf(vv.x);
                o[c * 8 + 2] = o[c * 8 + 2] * alpha + p * lo_bf(vv.y); o[c * 8 + 3] = o[c * 8 + 3] * alpha + p * hi_bf(vv.y);
                o[c * 8 + 4] = o[c * 8 + 4] * alpha + p * lo_bf(vv.z); o[c * 8 + 5] = o[c * 8 + 5] * alpha + p * hi_bf(vv.z);
                o[c * 8 + 6] = o[c * 8 + 6] * alpha + p * lo_bf(vv.w); o[c * 8 + 7] = o[c * 8 + 7] * alpha + p * hi_bf(vv.w); }
        }
        const float mall = wave_max(mrun), fsc = EX2(mrun - mall);
        const float lall = wave_sum(lrun * fsc);
#pragma unroll
        for (int e = 0; e < 128; ++e) o[e] *= fsc;
        RS_STEP(o, 128, 32); RS_STEP(o, 64, 16); RS_STEP(o, 32, 8); RS_STEP(o, 16, 4); RS_STEP(o, 8, 2); RS_STEP(o, 4, 1);
        const float inv = 1.f / lall;
        *(unsigned*)(QN + m * 1024 + h * 128 + 2 * C.lane) = pk2(o[0] * inv, o[1] * inv);
    }
}

__device__ __forceinline__ void phase_conv(Ctx& C, int l, const bf16_t* XA, bf16_t* U) {
    const float* cw = INP(8) + l * 4 * 1024; const float* cb = INP(9) + l * 1024;
    const int gt = C.bid * NTHR + C.tid, ngt = C.G * NTHR;
    for (int it = gt; it < MR * 128; it += ngt) {
        const int m = it >> 7, c0 = (it & 127) * 8, b = m / SS, s = m - b * SS;
        const int lo = (s < LC) ? 0 : LC, hi = (s < LC) ? LC : SS;
        float a[8];
#pragma unroll
        for (int e = 0; e < 8; ++e) a[e] = cb[c0 + e];
#pragma unroll
        for (int j = 0; j < 4; ++j) { const int sj = s + j - 2;
            if (sj >= lo && sj < hi) { const u32x4 xv = *(const u32x4*)(XA + (size_t)(b * SS + sj) * 1024 + c0); const float* w = cw + j * 1024 + c0;
                a[0] += w[0] * lo_bf(xv.x); a[1] += w[1] * hi_bf(xv.x); a[2] += w[2] * lo_bf(xv.y); a[3] += w[3] * hi_bf(xv.y);
                a[4] += w[4] * lo_bf(xv.z); a[5] += w[5] * hi_bf(xv.z); a[6] += w[6] * lo_bf(xv.w); a[7] += w[7] * hi_bf(xv.w); } }
        u32x4 o; o.x = pk2(a[0], a[1]); o.y = pk2(a[2], a[3]); o.z = pk2(a[4], a[5]); o.w = pk2(a[6], a[7]);
        *(u32x4*)(U + (size_t)m * 1024 + c0) = o;
    }
}
typedef f16_t f16x2 __attribute__((ext_vector_type(2)));
__device__ __forceinline__ void phase_scan1(Ctx& C, int d, const f16_t* RI, float* SUM) {
    for (int un = C.gw; un < NB * 68 * 8; un += C.ngw) {
        const int cg_ = un & 7, sg = (un >> 3) % 68, b = (un >> 3) / 68, ch = cg_ * 128 + 2 * C.lane;
        float A0 = 1.f, A1 = 1.f, H0 = 0.f, H1 = 0.f;
        const f16_t* base = RI + (size_t)(b * SS + sg * 64) * 2048 + ch;
#pragma unroll 16
        for (int i = 0; i < 64; ++i) { const int r = d ? (63 - i) : i;
            const f16x2 la = *(const f16x2*)(base + (size_t)r * 2048), bc = *(const f16x2*)(base + (size_t)r * 2048 + 1024);
            const float a0 = EX2((float)la[0]), a1 = EX2((float)la[1]);
            H0 = a0 * H0 + (float)bc[0]; H1 = a1 * H1 + (float)bc[1]; A0 *= a0; A1 *= a1; }
        float* sp = SUM + ((size_t)(b * 68 + sg) * 1024 + ch) * 2;
        *(f32x4*)sp = (f32x4){A0, H0, A1, H1};
    }
}
__device__ __forceinline__ void phase_scan3(Ctx& C, int d, const f16_t* RI, const float* SUM, bf16_t* YA) {
    for (int un = C.gw; un < NB * 68 * 8; un += C.ngw) {
        const int cg_ = un & 7, sg = (un >> 3) % 68, b = (un >> 3) / 68, ch = cg_ * 128 + 2 * C.lane;
        float H0 = 0.f, H1 = 0.f;
        const int npre = d ? ((sg < 4) ? (3 - sg) : (71 - sg)) : sg;
#pragma unroll 4
        for (int p = 0; p < npre; ++p) { const int ps = d ? ((p < 4) ? (3 - p) : (71 - p)) : p;
            const f32x4 v = *(const f32x4*)(SUM + ((size_t)(b * 68 + ps) * 1024 + ch) * 2);
            H0 = v[0] * H0 + v[1]; H1 = v[2] * H1 + v[3]; }
        const f16_t* base = RI + (size_t)(b * SS + sg * 64) * 2048 + ch;
        bf16_t* yb = YA + (size_t)(b * SS + sg * 64) * 1024 + ch;
#pragma unroll 16
        for (int i = 0; i < 64; ++i) { const int r = d ? (63 - i) : i;
            const f16x2 la = *(const f16x2*)(base + (size_t)r * 2048), bc = *(const f16x2*)(base + (size_t)r * 2048 + 1024);
            const float a0 = EX2((float)la[0]), a1 = EX2((float)la[1]);
            H0 = a0 * H0 + (float)bc[0]; H1 = a1 * H1 + (float)bc[1];
            unsigned* yp = (unsigned*)(yb + (size_t)r * 1024);
            if (d == 0) *yp = pk2(H0, H1); else { const unsigned w = *yp; *yp = pk2(lo_bf(w) + H0, hi_bf(w) + H1); } }
    }
}

typedef float f32x16 __attribute__((ext_vector_type(16)));
typedef short v4i16_t __attribute__((ext_vector_type(4)));
constexpr int AT_KP = 400, AT_VP = 320;
constexpr int AT_KB = 64 * AT_KP, AT_VB = 64 * AT_VP, AT_STG = AT_KB + AT_VB, AT_WSF = 2 * AT_STG;
__device__ __forceinline__ int crow(int r, int hi) { return (r & 3) + 8 * (r >> 2) + 4 * hi; }
__device__ __forceinline__ bf16x8 pack8(float a, float b, float c, float d, float e, float f, float g, float h) {
    u32x4 w; w.x = pg8::cvt_pk_bf16(a, b); w.y = pg8::cvt_pk_bf16(c, d); w.z = pg8::cvt_pk_bf16(e, f); w.w = pg8::cvt_pk_bf16(g, h); return __builtin_bit_cast(bf16x8, w); }
__device__ __forceinline__ bf16x8 tr2(LAS unsigned char* p0, LAS unsigned char* p1) {
    const v4i16_t lo = __builtin_amdgcn_ds_read_tr16_b64_v4i16((LAS v4i16_t*)p0), hi = __builtin_amdgcn_ds_read_tr16_b64_v4i16((LAS v4i16_t*)p1);
    return (bf16x8){lo[0], lo[1], lo[2], lo[3], hi[0], hi[1], hi[2], hi[3]}; }

__device__ __forceinline__ void phase_attn(Ctx& C, bool with_ctx, bf16_t* QN, const bf16_t* QP, const bf16_t* KV, const bf16_t* MD) {
    const int lane = C.lane, r32 = lane & 31, hi = lane >> 5, wave = C.wave, tid = C.tid;
    LAS unsigned char* lds = C.lds;
    LAS float* wsf = (LAS float*)(lds + AT_WSF + wave * 128);
    const int nunits = 512 + (with_ctx ? 32 : 0);
    const int rowA = tid >> 4, ccA = tid & 15, rowR = tid >> 3, ccR = tid & 7;
    const int i16 = lane & 15, q4 = i16 >> 2, p4 = i16 & 3, g1 = (lane >> 4) & 1;
    const int vb = AT_KB + (4 * hi + q4) * AT_VP + (16 * g1 + 4 * p4) * 2;
    for (int un = C.bid; un < nunits; un += C.G) {
        int bh, qb, isctx;
        if (un < 512) { const int x = un & 7, jj = un >> 3; bh = x * 4 + (jj >> 4); qb = jj & 15; isctx = 0; } else { bh = un - 512; qb = 0; isctx = 1; }
        const int b = bh >> 3, h = bh & 7;
        const size_t kb0 = (size_t)b * SS;
        const size_t m0 = kb0 + (isctx ? 0 : LC + qb * 256) + wave * 32;
        const int NT = (isctx ? LC : SS) / 64;
        bf16x8 qf[12];
        {   const bf16_t* qn = QN + (m0 + r32) * 1024 + h * 128 + hi * 8; const bf16_t* qp = QP + (m0 + r32) * 512 + h * 64 + hi * 8;
#pragma unroll
            for (int s = 0; s < 8; ++s) qf[s] = *(const bf16x8*)(qn + s * 16);
#pragma unroll
            for (int s = 0; s < 4; ++s) qf[8 + s] = *(const bf16x8*)(qp + s * 16); }
        f32x16 o[4];
#pragma unroll
        for (int d = 0; d < 4; ++d)
#pragma unroll
            for (int r = 0; r < 16; ++r) o[d][r] = 0.f;
        float mrun = -1e30f, lrun = 0.f;
        u32x4 kn0, kn1, kr0, vv0, vv1;
        const bf16_t* kvp = KV + (kb0 + rowA) * 2048 + h * 128 + ccA * 8;
        const bf16_t* krp = MD + (kb0 + rowR) * 768 + 640 + ccR * 8;
#define AT_LOAD(t) do { const bf16_t* kp_ = kvp + (size_t)(t) * 64 * 2048; kn0 = *(const u32x4*)kp_; kn1 = *(const u32x4*)(kp_ + 32 * 2048); vv0 = *(const u32x4*)(kp_ + 1024); vv1 = *(const u32x4*)(kp_ + 32 * 2048 + 1024); \
        kr0 = *(const u32x4*)(krp + (size_t)(t) * 64 * 768); } while (0)
#define AT_WRITE(sb) do { LAS unsigned char* s_ = lds + (sb); *(LAS u32x4*)(s_ + rowA * AT_KP + ccA * 16) = kn0; *(LAS u32x4*)(s_ + (rowA + 32) * AT_KP + ccA * 16) = kn1; \
        *(LAS u32x4*)(s_ + rowR * AT_KP + 256 + ccR * 16) = kr0; *(LAS u32x4*)(s_ + AT_KB + rowA * AT_VP + ccA * 16) = vv0; *(LAS u32x4*)(s_ + AT_KB + (rowA + 32) * AT_VP + ccA * 16) = vv1; } while (0)
        AT_LOAD(0); AT_WRITE(0);
        __syncthreads();
        for (int t = 0; t < NT; ++t) {
            const int sb = (t & 1) * AT_STG;
            if (t + 1 < NT) AT_LOAD(t + 1);
            f32x16 p0, p1;
#pragma unroll
            for (int r = 0; r < 16; ++r) { p0[r] = 0.f; p1[r] = 0.f; }
            {   LAS unsigned char* ka = lds + sb + r32 * AT_KP + hi * 16;
#pragma unroll
                for (int s = 0; s < 12; ++s) { const bf16x8 a0 = *(const LAS bf16x8*)(ka + s * 32), a1 = *(const LAS bf16x8*)(ka + 32 * AT_KP + s * 32);
                    p0 = __builtin_amdgcn_mfma_f32_32x32x16_bf16(a0, qf[s], p0, 0, 0, 0); p1 = __builtin_amdgcn_mfma_f32_32x32x16_bf16(a1, qf[s], p1, 0, 0, 0);
                    if ((s & 3) == 3) asm volatile("" ::: "memory"); } }
            float rm = fmaxf(p0[0], p1[0]);
#pragma unroll
            for (int r = 1; r < 16; ++r) rm = fmaxf(rm, fmaxf(p0[r], p1[r]));
            rm = fmaxf(rm, __shfl_xor(rm, 32));
            const float mnew = fmaxf(mrun, rm), alpha = EX2(mrun - mnew); mrun = mnew;
            float ls = 0.f;
#pragma unroll
            for (int r = 0; r < 16; ++r) { p0[r] = EX2(p0[r] - mnew); p1[r] = EX2(p1[r] - mnew); ls += p0[r] + p1[r]; }
            lrun = lrun * alpha + ls;
            if (hi == 0) wsf[r32] = alpha;
            const bf16x8 pa0 = pack8(p0[0], p0[1], p0[2], p0[3], p0[4], p0[5], p0[6], p0[7]), pa1 = pack8(p0[8], p0[9], p0[10], p0[11], p0[12], p0[13], p0[14], p0[15]);
            const bf16x8 pa2 = pack8(p1[0], p1[1], p1[2], p1[3], p1[4], p1[5], p1[6], p1[7]), pa3 = pack8(p1[8], p1[9], p1[10], p1[11], p1[12], p1[13], p1[14], p1[15]);
#pragma unroll
            for (int r = 0; r < 16; ++r) { const float a = wsf[crow(r, hi)];
#pragma unroll
                for (int d = 0; d < 4; ++d) o[d][r] *= a; }
            {   LAS unsigned char* vp = lds + sb + vb;
#pragma unroll
                for (int d = 0; d < 4; ++d) {
                    o[d] = __builtin_amdgcn_mfma_f32_32x32x16_bf16(pa0, tr2(vp + d * 64, vp + d * 64 + 8 * AT_VP), o[d], 0, 0, 0);
                    o[d] = __builtin_amdgcn_mfma_f32_32x32x16_bf16(pa1, tr2(vp + d * 64 + 16 * AT_VP, vp + d * 64 + 24 * AT_VP), o[d], 0, 0, 0);
                    o[d] = __builtin_amdgcn_mfma_f32_32x32x16_bf16(pa2, tr2(vp + d * 64 + 32 * AT_VP, vp + d * 64 + 40 * AT_VP), o[d], 0, 0, 0);
                    o[d] = __builtin_amdgcn_mfma_f32_32x32x16_bf16(pa3, tr2(vp + d * 64 + 48 * AT_VP, vp + d * 64 + 56 * AT_VP), o[d], 0, 0, 0);
                    asm volatile("" ::: "memory"); } }
            if (t + 1 < NT) AT_WRITE(AT_STG - sb);
            __syncthreads();
        }
#undef AT_LOAD
#undef AT_WRITE
        const float ltot = lrun + __shfl_xor(lrun, 32);
        if (hi == 0) wsf[r32] = 1.f / ltot;
        bf16_t* op = QN + (m0 + 4 * hi) * 1024 + h * 128 + r32;
#pragma unroll
        for (int r = 0; r < 16; ++r) { const float inv = wsf[crow(r, hi)];
#pragma unroll
            for (int d = 0; d < 4; ++d) op[d * 32] = (bf16_t)f2bf(o[d][r] * inv);
            op += ((r & 3) == 3) ? 5 * 1024 : 1024; asm volatile("" : "+v"(op)); }
        __syncthreads();
    }
}

constexpr int RI_KP = 528, RI_VP = 576, RI_PTP = 272;
constexpr int RI_A = 0, RI_PT = 128 * RI_VP;
__device__ __forceinline__ void phase_ret_intra(Ctx& C, int l, const bf16_t* RQKV, bf16_t* OI) {
    const int lane = C.lane, r32 = lane & 31, hi = lane >> 5, wave = C.wave, tid = C.tid;
    LAS unsigned char* lds = C.lds;
    const int i16 = lane & 15, q4 = i16 >> 2, p4 = i16 & 3, g1 = (lane >> 4) & 1;
    const int nb = wave & 3, wh = wave >> 2;
    const int srow = tid >> 5, scc = tid & 31;
    for (int un = C.bid; un < NB * 4 * 34; un += C.G) {
        const int c = un % 34, bh = un / 34, b = bh >> 2, h = bh & 3;
        const size_t row0 = (size_t)b * SS + c * 128;
        const float lgf = C.ctl[CT_LG + (l * 2 + 0) * 4 + h], lgb = C.ctl[CT_LG + (l * 2 + 1) * 4 + h];
        const bf16_t* gk = RQKV + (row0 + srow) * 3072 + 1024 + h * 256 + scc * 8;
        u32x4 st[8];
        {   const bf16_t* gp = gk;
#pragma unroll
            for (int j = 0; j < 8; ++j) { st[j] = *(const u32x4*)gp; gp += 16 * 3072; asm volatile("" : "+v"(gp)); } }
#pragma unroll
        for (int j = 0; j < 8; ++j) *(LAS u32x4*)(lds + RI_A + (srow + 16 * j) * RI_KP + scc * 16) = st[j];
        __syncthreads();
        {   const bf16_t* gp = gk + 1024;
#pragma unroll
            for (int j = 0; j < 8; ++j) { st[j] = *(const u32x4*)gp; gp += 16 * 3072; asm volatile("" : "+v"(gp)); } }
        {
            f32x16 x0, x1;
#pragma unroll
            for (int r = 0; r < 16; ++r) { x0[r] = 0.f; x1[r] = 0.f; }
            const bf16_t* gq = RQKV + (row0 + nb * 32 + r32) * 3072 + h * 256 + hi * 8;
            LAS unsigned char* ka = lds + RI_A + (wh * 64 + r32) * RI_KP + hi * 16;
#pragma unroll
            for (int s = 0; s < 16; ++s) { const bf16x8 qf = *(const bf16x8*)(gq + s * 16);
                const bf16x8 a0 = *(const LAS bf16x8*)(ka + s * 32), a1 = *(const LAS bf16x8*)(ka + 32 * RI_KP + s * 32);
                x0 = __builtin_amdgcn_mfma_f32_32x32x16_bf16(a0, qf, x0, 0, 0, 0); x1 = __builtin_amdgcn_mfma_f32_32x32x16_bf16(a1, qf, x1, 0, 0, 0);
                if ((s & 3) == 3) asm volatile("" ::: "memory"); }
            const int n = nb * 32 + r32;
            LAS unsigned char* pt = lds + RI_PT + n * RI_PTP + (wh * 64 + 4 * hi) * 2;
#pragma unroll
            for (int g = 0; g < 4; ++g) { float w0[4], w1[4];
#pragma unroll
                for (int e = 0; e < 4; ++e) { const int m0 = wh * 64 + 8 * g + 4 * hi + e; const float d0 = (float)(n - m0), d1 = d0 - 32.f;
                    const float f0 = (d0 >= 0.f ? EX2(lgf * d0) : 0.f) + (d0 <= 0.f ? EX2(-lgb * d0) : 0.f);
                    const float f1 = (d1 >= 0.f ? EX2(lgf * d1) : 0.f) + (d1 <= 0.f ? EX2(-lgb * d1) : 0.f);
                    w0[e] = x0[4 * g + e] * f0; w1[e] = x1[4 * g + e] * f1; }
                u32x2 o0, o1; o0.x = pg8::cvt_pk_bf16(w0[0], w0[1]); o0.y = pg8::cvt_pk_bf16(w0[2], w0[3]); o1.x = pg8::cvt_pk_bf16(w1[0], w1[1]); o1.y = pg8::cvt_pk_bf16(w1[2], w1[3]);
                *(LAS u32x2*)(pt + g * 16) = o0; *(LAS u32x2*)(pt + 64 + g * 16) = o1; }
        }
        __syncthreads();
#pragma unroll
        for (int j = 0; j < 8; ++j) *(LAS u32x4*)(lds + RI_A + (srow + 16 * j) * RI_VP + scc * 16) = st[j];
        __syncthreads();
        {
            f32x16 o[4];
#pragma unroll
            for (int d = 0; d < 4; ++d)
#pragma unroll
                for (int r = 0; r < 16; ++r) o[d][r] = 0.f;
            bf16x8 pa[8];
            LAS unsigned char* pr = lds + RI_PT + (nb * 32 + r32) * RI_PTP + hi * 16;
#pragma unroll
            for (int s = 0; s < 8; ++s) pa[s] = *(const LAS bf16x8*)(pr + s * 32);
            LAS unsigned char* vp = lds + RI_A + (8 * hi + q4) * RI_VP + (wh * 128 + 16 * g1 + 4 * p4) * 2;
#pragma unroll
            for (int d = 0; d < 4; ++d) {
#pragma unroll
                for (int s = 0; s < 8; ++s) o[d] = __builtin_amdgcn_mfma_f32_32x32x16_bf16(pa[s], tr2(vp + d * 64 + s * 16 * RI_VP, vp + d * 64 + (s * 16 + 4) * RI_VP), o[d], 0, 0, 0);
                asm volatile("" ::: "memory"); }
            bf16_t* op = OI + (row0 + nb * 32 + 4 * hi) * 1024 + h * 256 + wh * 128 + r32;
#pragma unroll
            for (int r = 0; r < 16; ++r) {
#pragma unroll
                for (int d = 0; d < 4; ++d) op[d * 32] = (bf16_t)f2bf(o[d][r]);
                op += ((r & 3) == 3) ? 5 * 1024 : 1024; asm volatile("" : "+v"(op)); }
        }
        __syncthreads();
    }
}

constexpr int RC_KT = 0, RC_KTP = 576, RC_VT = 128 * 576, RC_VTP = 64, RC_ST = RC_VT + 128 * 64, RC_STP = 528, RC_XO = RC_ST + 32 * 528, RC_END = RC_XO + 16384;
static_assert(RC_END <= 131072, "R-chain LDS");
__device__ __forceinline__ void phase_ret_chain(Ctx& C, int l, const bf16_t* RQKV, bf16_t* OI, bf16_t* OB) {
    const int lane = C.lane, r32 = lane & 31, hi = lane >> 5, wave = C.wave, tid = C.tid;
    LAS unsigned char* lds = C.lds;
    const int i16 = lane & 15, q4 = i16 >> 2, p4 = i16 & 3, g1 = (lane >> 4) & 1;
    const int nb = wave & 3, dh = wave >> 2;
    const int srow = tid >> 5, scc = tid & 31, vrow = tid >> 2, vcc = tid & 3;
    for (int un = C.bid; un < 256; un += C.G) {
        const int x = un & 7, j8 = un >> 3, bhd = x * 4 + (j8 >> 3), sl = j8 & 7, b = bhd >> 3, h = (bhd >> 1) & 3, dir = bhd & 1;
        const float lg = C.ctl[CT_LG + (l * 2 + dir) * 4 + h];
        const float cdec = EX2(lg * 128.f);
        const float vdec = dir ? EX2(lg * (float)vrow) : EX2(lg * (float)(127 - vrow));
        f32x16 sacc;
#pragma unroll
        for (int r = 0; r < 16; ++r) sacc[r] = 0.f;
        for (int i = tid; i < 32 * RC_STP / 16; i += NTHR) *(LAS u32x4*)(lds + RC_ST + i * 16) = (u32x4){0u, 0u, 0u, 0u};
        u32x4 st[8]; u32x4 sv;
#define RC_LOAD(cc_) do { const size_t r0_ = (size_t)b * SS + (cc_) * 128; const bf16_t* gk_ = RQKV + (r0_ + srow) * 3072 + 1024 + h * 256 + scc * 8; \
        _Pragma("unroll") for (int j = 0; j < 8; ++j) { st[j] = *(const u32x4*)gk_; gk_ += 16 * 3072; asm volatile("" : "+v"(gk_)); } \
        sv = *(const u32x4*)(RQKV + (r0_ + vrow) * 3072 + 2048 + h * 256 + sl * 32 + vcc * 8); } while (0)
#define RC_WRITE() do { _Pragma("unroll") for (int j = 0; j < 8; ++j) *(LAS u32x4*)(lds + RC_KT + (srow + 16 * j) * RC_KTP + scc * 16) = st[j]; \
        u32x4 w_; w_.x = pg8::cvt_pk_bf16(lo_bf(sv.x) * vdec, hi_bf(sv.x) * vdec); w_.y = pg8::cvt_pk_bf16(lo_bf(sv.y) * vdec, hi_bf(sv.y) * vdec); \
        w_.z = pg8::cvt_pk_bf16(lo_bf(sv.z) * vdec, hi_bf(sv.z) * vdec); w_.w = pg8::cvt_pk_bf16(lo_bf(sv.w) * vdec, hi_bf(sv.w) * vdec); \
        *(LAS u32x4*)(lds + RC_VT + vrow * RC_VTP + vcc * 16) = w_; } while (0)
        bf16x8 qa[8];
#define RC_QLOAD(dst, cc_) do { const bf16_t* gq_ = RQKV + ((size_t)b * SS + (cc_) * 128 + nb * 32 + r32) * 3072 + h * 256 + dh * 128 + hi * 8; \
        _Pragma("unroll") for (int s = 0; s < 8; ++s) dst[s] = *(const bf16x8*)(gq_ + s * 16); } while (0)
        {   const int c0 = dir ? 1 : 0; RC_LOAD(c0); RC_WRITE(); RC_QLOAD(qa, c0); }
        __syncthreads();
        for (int i = 0; i < 34; ++i) {
            const int c = dir ? ((i < 2) ? (1 - i) : (35 - i)) : i;
            const size_t r0 = (size_t)b * SS + c * 128;
            const int cn = (i + 1 < 34) ? (dir ? ((i + 1 < 2) ? (1 - (i + 1)) : (35 - (i + 1))) : (i + 1)) : c;
            if (i + 1 < 34) RC_LOAD(cn);
            unsigned short oiv[16];
            if (dh == 0 && dir == 0) { const bf16_t* ip = OI + (r0 + nb * 32 + 4 * hi) * 1024 + h * 256 + sl * 32 + r32;
#pragma unroll
                for (int r = 0; r < 16; ++r) oiv[r] = ip[(size_t)((r & 3) + 8 * (r >> 2)) * 1024]; }
            f32x16 oacc;
#pragma unroll
            for (int r = 0; r < 16; ++r) oacc[r] = 0.f;
            {   LAS unsigned char* sb = lds + RC_ST + r32 * RC_STP + (dh * 128 + hi * 8) * 2;
#pragma unroll
                for (int s = 0; s < 8; ++s) { const bf16x8 sbf = *(const LAS bf16x8*)(sb + s * 32);
                    oacc = __builtin_amdgcn_mfma_f32_32x32x16_bf16(qa[s], sbf, oacc, 0, 0, 0); } }
            asm volatile("" ::: "memory");
            RC_QLOAD(qa, cn);
#pragma unroll
            for (int r = 0; r < 16; ++r) sacc[r] *= cdec;
            {   LAS unsigned char* kp = lds + RC_KT + (8 * hi + q4) * RC_KTP + (wave * 32 + 16 * g1 + 4 * p4) * 2;
                LAS unsigned char* vp = lds + RC_VT + (8 * hi + q4) * RC_VTP + (16 * g1 + 4 * p4) * 2;
#pragma unroll
                for (int s = 0; s < 8; ++s) sacc = __builtin_amdgcn_mfma_f32_32x32x16_bf16(tr2(kp + s * 16 * RC_KTP, kp + (s * 16 + 4) * RC_KTP), tr2(vp + s * 16 * RC_VTP, vp + (s * 16 + 4) * RC_VTP), sacc, 0, 0, 0); }
            if (dh == 1) {
#pragma unroll
                for (int r = 0; r < 16; ++r) *(LAS float*)(lds + RC_XO + nb * 4096 + r * 256 + lane * 4) = oacc[r]; }
            __syncthreads();
            if (dh == 0) {
                bf16_t* op = (dir ? OB : OI) + (r0 + nb * 32 + 4 * hi) * 1024 + h * 256 + sl * 32 + r32;
#pragma unroll
                for (int r = 0; r < 16; ++r) { const int n = nb * 32 + crow(r, hi);
                    const float qd = dir ? EX2(lg * (float)(128 - n)) : EX2(lg * (float)(n + 1));
                    float v = (oacc[r] + *(const LAS float*)(lds + RC_XO + nb * 4096 + r * 256 + lane * 4)) * qd;
                    if (dir == 0) v += bf2f(oiv[r]);
                    *op = (bf16_t)f2bf(v);
                    op += ((r & 3) == 3) ? 5 * 1024 : 1024; asm volatile("" : "+v"(op)); }
            }
            {   LAS unsigned char* sp = lds + RC_ST + r32 * RC_STP + (wave * 32 + 4 * hi) * 2;
#pragma unroll
                for (int g = 0; g < 4; ++g) { u32x2 o2; o2.x = pg8::cvt_pk_bf16(sacc[4 * g], sacc[4 * g + 1]); o2.y = pg8::cvt_pk_bf16(sacc[4 * g + 2], sacc[4 * g + 3]); *(LAS u32x2*)(sp + g * 16) = o2; } }
            if (i + 1 < 34) RC_WRITE();
            __syncthreads();
        }
#undef RC_QLOAD
#undef RC_LOAD
#undef RC_WRITE
    }
}
__device__ __forceinline__ void phase_ret_ln2(Ctx& C, int l, bf16_t* OI, const bf16_t* OB) {
    const float* gain = INP(16) + l * 1024;
    for (int m = C.gw; m < MR; m += C.ngw) {
#pragma unroll
        for (int h = 0; h < 4; ++h) { bf16_t* p = OI + (size_t)m * 1024 + h * 256 + C.lane * 4;
            const u32x2 w = *(const u32x2*)p, w2 = *(const u32x2*)(OB + (size_t)m * 1024 + h * 256 + C.lane * 4);
            float x0 = lo_bf(w.x) + lo_bf(w2.x), x1 = hi_bf(w.x) + hi_bf(w2.x), x2 = lo_bf(w.y) + lo_bf(w2.y), x3 = hi_bf(w.y) + hi_bf(w2.y);
            const float mean = wave_sum((x0 + x1) + (x2 + x3)) * (1.f / 256.f);
            x0 -= mean; x1 -= mean; x2 -= mean; x3 -= mean;
            const float var = wave_sum((x0 * x0 + x1 * x1) + (x2 * x2 + x3 * x3)) * (1.f / 256.f);
            const float rstd = RSQ(var + EPS);
            const f32x4 g = *(const f32x4*)(gain + h * 256 + C.lane * 4);
            u32x2 o; o.x = pk2(x0 * rstd * g.x, x1 * rstd * g.y); o.y = pk2(x2 * rstd * g.z, x3 * rstd * g.w); *(u32x2*)p = o; }
    }
}

template <int W> __device__ __forceinline__ float group_sum(float v) {
#pragma unroll
    for (int o = 1; o < W; o <<= 1) v += __shfl_xor(v, o);
    return v;
}
__device__ __forceinline__ void unpack8(const u32x4& w, float (&x)[8]) { x[0] = lo_bf(w.x); x[1] = hi_bf(w.x); x[2] = lo_bf(w.y); x[3] = hi_bf(w.y); x[4] = lo_bf(w.z); x[5] = hi_bf(w.z); x[6] = lo_bf(w.w); x[7] = hi_bf(w.w); }
__device__ __forceinline__ u32x4 pack8u(const float (&x)[8]) { u32x4 w; w.x = pk2(x[0], x[1]); w.y = pk2(x[2], x[3]); w.z = pk2(x[4], x[5]); w.w = pk2(x[6], x[7]); return w; }
__device__ __forceinline__ float sumsq8(const float (&x)[8]) { return ((x[0] * x[0] + x[1] * x[1]) + (x[2] * x[2] + x[3] * x[3])) + ((x[4] * x[4] + x[5] * x[5]) + (x[6] * x[6] + x[7] * x[7])); }

__device__ __forceinline__ void phase_h2(Ctx& C, int l, bf16_t* H) {
    const float* gain = INP(6) + l * 1024;
    for (int m0 = C.gw * 2; m0 < MR; m0 += C.ngw * 2) {
        f32x4 v[2][4]; float ss[2];
#pragma unroll
        for (int q = 0; q < 2; ++q) { const float* xr = resid_row(C, l, m0 + q);
#pragma unroll
            for (int j = 0; j < 4; ++j) v[q][j] = *(const f32x4*)(xr + 4 * C.lane + 256 * j); }
        const int b = m0 / SS, s = m0 - b * SS, r = (s < LC) ? 4 : b;
        const float* mod = C.ctl + CT_MOD + (l * 5 + r) * 3072;
#pragma unroll
        for (int q = 0; q < 2; ++q) { float a = 0.f;
#pragma unroll
            for (int j = 0; j < 4; ++j) a += (v[q][j].x * v[q][j].x + v[q][j].y * v[q][j].y) + (v[q][j].z * v[q][j].z + v[q][j].w * v[q][j].w);
            ss[q] = a; }
        ss[0] = wave_sum(ss[0]); ss[1] = wave_sum(ss[1]);
#pragma unroll
        for (int j = 0; j < 4; ++j) { const int c = 4 * C.lane + 256 * j;
            const f32x4 g = *(const f32x4*)(gain + c), sh = *(const f32x4*)(mod + c), sc = *(const f32x4*)(mod + 1024 + c) + 1.0f;
#pragma unroll
            for (int q = 0; q < 2; ++q) { const float rstd = RSQ(ss[q] * (1.f / 1024.f) + EPS);
                const f32x4 o = ((v[q][j] * rstd) * g) * sc + sh;
                u32x2 w; w.x = pk2(o.x, o.y); w.y = pk2(o.z, o.w);
                *(u32x2*)(H + (size_t)(m0 + q) * 1024 + c) = w; } }
    }
}
__device__ __forceinline__ void phase_md_post2(Ctx& C, int l, bf16_t* MD) {
    const float* qn = INP(17) + l * 384; const float* kvn = INP(19) + l * 256; const float* gkr = INP(24) + l * 64;
    const float* cs = C.ctl + CT_ROPEM; const float* sn = cs + 1024;
    const int L = C.lane;
    for (int m0 = C.gw * 2; m0 < MR; m0 += C.ngw * 2) {
        u32x4 w0[2], w1[2];
#pragma unroll
        for (int q = 0; q < 2; ++q) { const bf16_t* row = MD + (size_t)(m0 + q) * 768; w0[q] = *(const u32x4*)(row + 8 * L); w1[q] = (L < 32) ? *(const u32x4*)(row + 512 + 8 * L) : (u32x4){0u, 0u, 0u, 0u}; }
#pragma unroll
        for (int q = 0; q < 2; ++q) { const int m = m0 + q, b = m / SS, s = m - b * SS; const bool lat = s >= LC; const int t = s - LC;
            bf16_t* row = MD + (size_t)m * 768;
            float x0[8], x1[8]; unpack8(w0[q], x0); unpack8(w1[q], x1);
            const float s0 = sumsq8(x0), s1 = sumsq8(x1);
            const float sq = wave_sum(L < 48 ? s0 : 0.f), skv = wave_sum((L >= 48 ? s0 : 0.f) + (L < 16 ? s1 : 0.f)), skr = wave_sum((L >= 16 && L < 24) ? s1 : 0.f);
            const float rq = RSQ(sq * (1.f / 384.f) + EPS), rkv = RSQ(skv * (1.f / 256.f) + EPS), rkr = RSQ(skr * (1.f / 64.f) + EPS);
            {   const float* g = (L < 48) ? (qn + 8 * L) : (kvn + 8 * (L - 48)); const float rs = (L < 48) ? rq : rkv;
#pragma unroll
                for (int e = 0; e < 8; ++e) x0[e] *= rs * g[e];
                *(u32x4*)(row + 8 * L) = pack8u(x0); }
            if (L < 16) {
#pragma unroll
                for (int e = 0; e < 8; ++e) x1[e] *= rkv * kvn[128 + 8 * L + e];
            } else if (L < 24) {
#pragma unroll
                for (int e = 0; e < 8; ++e) x1[e] *= rkr * gkr[8 * (L - 16) + e];
            }
            float pr[8];
#pragma unroll
            for (int e = 0; e < 8; ++e) pr[e] = __shfl_xor(x1[e], 2);
            if (lat && L >= 16 && L < 24) { const int qt = (L - 16) >> 1, f0 = ((L - 16) & 1) * 8, pos = (qt < 2) ? (t >> 6) : (t & 63); const float sg = (qt & 1) ? 1.f : -1.f;
#pragma unroll
                for (int e = 0; e < 8; ++e) x1[e] = x1[e] * cs[pos * 16 + f0 + e] + sg * pr[e] * sn[pos * 16 + f0 + e]; }
            if (L < 24) *(u32x4*)(row + 512 + 8 * L) = pack8u(x1);
        }
    }
}
__device__ __forceinline__ void phase_qk_post2(Ctx& C, int l, bf16_t* QN, bf16_t* QP, bf16_t* KV) {
    const float* gqn = INP(21) + l * 128; const float* gqr = INP(22) + l * 64; const float* gkn = INP(23) + l * 128;
    const float* cs = C.ctl + CT_ROPEM; const float* sn = cs + 1024;
    const int L = C.lane;
    for (int m0 = C.gw * 2; m0 < MR; m0 += C.ngw * 2) {
        u32x4 a[2][2], k[2][2], p[2];
#pragma unroll
        for (int q = 0; q < 2; ++q) { const size_t m = m0 + q;
            a[q][0] = *(const u32x4*)(QN + m * 1024 + 8 * L); a[q][1] = *(const u32x4*)(QN + m * 1024 + 512 + 8 * L);
            k[q][0] = *(const u32x4*)(KV + m * 2048 + 8 * L); k[q][1] = *(const u32x4*)(KV + m * 2048 + 512 + 8 * L);
            p[q] = *(const u32x4*)(QP + m * 512 + 8 * L); }
#pragma unroll
        for (int q = 0; q < 2; ++q) { const int m = m0 + q, b = m / SS, s = m - b * SS; const bool lat = s >= LC; const int t = s - LC;
#pragma unroll
            for (int c = 0; c < 2; ++c) {
                float x[8]; unpack8(a[q][c], x);
                const float rs = RSQ(group_sum<16>(sumsq8(x)) * (1.f / 128.f) + EPS) * QSCALE;
#pragma unroll
                for (int e = 0; e < 8; ++e) x[e] *= rs * gqn[8 * (L & 15) + e];
                *(u32x4*)(QN + (size_t)m * 1024 + c * 512 + 8 * L) = pack8u(x);
                float y[8]; unpack8(k[q][c], y);
                const float rk = RSQ(group_sum<16>(sumsq8(y)) * (1.f / 128.f) + EPS);
#pragma unroll
                for (int e = 0; e < 8; ++e) y[e] *= rk * gkn[8 * (L & 15) + e];
                *(u32x4*)(KV + (size_t)m * 2048 + c * 512 + 8 * L) = pack8u(y); }
            {   float x[8]; unpack8(p[q], x);
                const float rs = RSQ(group_sum<8>(sumsq8(x)) * (1.f / 64.f) + EPS);
#pragma unroll
                for (int e = 0; e < 8; ++e) x[e] *= rs * gqr[8 * (L & 7) + e];
                float pr[8];
#pragma unroll
                for (int e = 0; e < 8; ++e) pr[e] = __shfl_xor(x[e], 2);
                if (lat) { const int qt = (L >> 1) & 3, f0 = (L & 1) * 8, pos = (qt < 2) ? (t >> 6) : (t & 63); const float sg = (qt & 1) ? 1.f : -1.f;
#pragma unroll
                    for (int e = 0; e < 8; ++e) x[e] = x[e] * cs[pos * 16 + f0 + e] + sg * pr[e] * sn[pos * 16 + f0 + e]; }
#pragma unroll
                for (int e = 0; e < 8; ++e) x[e] *= QSCALE;
                *(u32x4*)(QP + (size_t)m * 512 + 8 * L) = pack8u(x); }
        }
    }
}
__device__ __forceinline__ void phase_ret_ln3(Ctx& C, int l, bf16_t* OI, const bf16_t* OB) {
    const float* gain = INP(16) + l * 1024;
    const int L = C.lane;
    for (int m0 = C.gw * 2; m0 < MR; m0 += C.ngw * 2) {
        u32x4 a[2][2], bb[2][2];
#pragma unroll
        for (int q = 0; q < 2; ++q)
#pragma unroll
            for (int c = 0; c < 2; ++c) { a[q][c] = *(const u32x4*)(OI + (size_t)(m0 + q) * 1024 + c * 512 + 8 * L); bb[q][c] = *(const u32x4*)(OB + (size_t)(m0 + q) * 1024 + c * 512 + 8 * L); }
#pragma unroll
        for (int q = 0; q < 2; ++q)
#pragma unroll
            for (int c = 0; c < 2; ++c) { float x[8], y[8]; unpack8(a[q][c], x); unpack8(bb[q][c], y);
                float s = 0.f;
#pragma unroll
                for (int e = 0; e < 8; ++e) { x[e] += y[e]; s += x[e]; }
                const float mean = group_sum<32>(s) * (1.f / 256.f);
                float v = 0.f;
#pragma unroll
                for (int e = 0; e < 8; ++e) { x[e] -= mean; v += x[e] * x[e]; }
                const float rstd = RSQ(group_sum<32>(v) * (1.f / 256.f) + EPS);
#pragma unroll
                for (int e = 0; e < 8; ++e) x[e] *= rstd * gain[c * 512 + 8 * L + e];
                *(u32x4*)(OI + (size_t)(m0 + q) * 1024 + c * 512 + 8 * L) = pack8u(x); }
    }
}

constexpr int LR_UP = 272;
constexpr int LR_U = 0, LR_LA = 128 * LR_UP, LR_BC = LR_LA + 32768, LR_Y0 = LR_BC + 32768, LR_XS = LR_Y0 + 32768, LR_END = LR_XS + 4096;
static_assert(LR_END <= 147456 - 1024, "fused LRU LDS");
__device__ __forceinline__ void phase_lru_fused(Ctx& C, int l, const bf16_t* XA, const bf16_t* WTL, bf16_t* Y0, f16_t* CAF, f16_t* CAB, float* SUM) {
    const int lane = C.lane, r32 = lane & 31, hi = lane >> 5, wave = C.wave, tid = C.tid;
    LAS unsigned char* lds = C.lds;
    const float* cw = INP(8) + l * 4 * 1024; const float* cb = INP(9) + l * 1024;
    const int rb = wave & 3, cgp = wave >> 2;
    for (int un = C.bid; un < NB * 8 * 34; un += C.G) {
        const int sg = un % 34, bn = un / 34, b = bn >> 3, n = bn & 7;
        const int R0 = b * SS + sg * 128, lo = (sg < 2) ? b * SS : b * SS + LC, hi_ = (sg < 2) ? b * SS + LC : (b + 1) * SS;
#pragma unroll
        for (int j = 0; j < 4; ++j) { const int item = tid + 512 * j, row = item >> 4, cc = item & 15, ch0 = n * 128 + cc * 8;
            float a[8];
#pragma unroll
            for (int e = 0; e < 8; ++e) a[e] = cb[ch0 + e];
#pragma unroll
            for (int t = 0; t < 4; ++t) { const int rr = R0 + row + t - 2;
                if (rr >= lo && rr < hi_) { const u32x4 xv = *(const u32x4*)(XA + (size_t)rr * 1024 + ch0); const float* w = cw + t * 1024 + ch0;
                    a[0] += w[0] * lo_bf(xv.x); a[1] += w[1] * hi_bf(xv.x); a[2] += w[2] * lo_bf(xv.y); a[3] += w[3] * hi_bf(xv.y);
                    a[4] += w[4] * lo_bf(xv.z); a[5] += w[5] * hi_bf(xv.z); a[6] += w[6] * lo_bf(xv.w); a[7] += w[7] * hi_bf(xv.w); } }
            *(LAS u32x4*)(lds + LR_U + row * LR_UP + cc * 16) = pack8u(a); }
        __syncthreads();
        bf16x8 af[8];
        {   LAS unsigned char* ua = lds + LR_U + (rb * 32 + r32) * LR_UP + hi * 16;
#pragma unroll
            for (int s = 0; s < 8; ++s) af[s] = *(const LAS bf16x8*)(ua + s * 32); }
        for (int d = 0; d < 2; ++d) {
            f32x16 aR[2], aI[2];
#pragma unroll
            for (int q = 0; q < 2; ++q)
#pragma unroll
                for (int r = 0; r < 16; ++r) { aR[q][r] = 0.f; aI[q][r] = 0.f; }
            {   const bf16_t* wb = WTL + ((size_t)d * 2048 + n * 256 + cgp * 64 + r32) * 256 + (n & 1) * 128 + hi * 8;
#pragma unroll
                for (int s = 0; s < 8; ++s) {
                    const bf16x8 b0 = *(const bf16x8*)(wb + s * 16), b1 = *(const bf16x8*)(wb + 32 * 256 + s * 16), b2 = *(const bf16x8*)(wb + 128 * 256 + s * 16), b3 = *(const bf16x8*)(wb + 160 * 256 + s * 16);
                    aR[0] = __builtin_amdgcn_mfma_f32_32x32x16_bf16(af[s], b0, aR[0], 0, 0, 0); aR[1] = __builtin_amdgcn_mfma_f32_32x32x16_bf16(af[s], b1, aR[1], 0, 0, 0);
                    aI[0] = __builtin_amdgcn_mfma_f32_32x32x16_bf16(af[s], b2, aI[0], 0, 0, 0); aI[1] = __builtin_amdgcn_mfma_f32_32x32x16_bf16(af[s], b3, aI[1], 0, 0, 0);
                    if (s & 1) asm volatile("" ::: "memory"); } }
#pragma unroll
            for (int q = 0; q < 2; ++q) { const int chl = cgp * 64 + q * 32 + r32, ch = n * 128 + chl;
                const float bav = INP(11)[(l * 2 + d) * 1024 + ch], bxv = INP(13)[(l * 2 + d) * 1024 + ch], spv = C.ctl[CT_SP + (l * 2 + d) * 1024 + ch] * (-8.f);
#pragma unroll
                for (int r = 0; r < 16; ++r) { const int t = rb * 32 + crow(r, hi);
                    const float uu = bf2f(*(const LAS bf16_t*)(lds + LR_U + t * LR_UP + chl * 2));
                    const float rg = sigmoidf_(aR[q][r] + bav), ig = sigmoidf_(aI[q][r] + bxv);
                    const float loga = rg * spv, y2 = 2.f * loga;
                    const float om = -y2 * (1.f + y2 * 0.5f * (1.f + y2 * (1.f / 3.f) * (1.f + y2 * 0.25f * (1.f + y2 * 0.2f))));
                    const float bb = SQRT(fmaxf(om, 0.f)) * (ig * uu);
                    *(LAS f16_t*)(lds + LR_LA + (t * 128 + chl) * 2) = (f16_t)(loga * LOG2E); *(LAS f16_t*)(lds + LR_BC + (t * 128 + chl) * 2) = (f16_t)bb; } }
            __syncthreads();
            const int chl = tid & 127, sub = tid >> 7;
            {   float A = 1.f, H = 0.f;
#pragma unroll 8
                for (int i = 0; i < 32; ++i) { const int p = sub * 32 + i, t = d ? (127 - p) : p;
                    const float a = EX2((float)*(const LAS f16_t*)(lds + LR_LA + (t * 128 + chl) * 2)), bc = (float)*(const LAS f16_t*)(lds + LR_BC + (t * 128 + chl) * 2);
                    H = a * H + bc; A *= a; }
                *(LAS f32x2*)(lds + LR_XS + (sub * 128 + chl) * 8) = (f32x2){A, H}; }
            __syncthreads();
            {   float A = 1.f, H = 0.f;
                for (int p = 0; p < sub; ++p) { const f32x2 v = *(const LAS f32x2*)(lds + LR_XS + (p * 128 + chl) * 8); H = v.x * H + v.y; A *= v.x; }
                f16_t* cap = (d ? CAB : CAF) + (size_t)R0 * 1024 + n * 128 + chl;
#pragma unroll 8
                for (int i = 0; i < 32; ++i) { const int p = sub * 32 + i, t = d ? (127 - p) : p;
                    const float a = EX2((float)*(const LAS f16_t*)(lds + LR_LA + (t * 128 + chl) * 2)), bc = (float)*(const LAS f16_t*)(lds + LR_BC + (t * 128 + chl) * 2);
                    H = a * H + bc; A *= a;
                    cap[(size_t)t * 1024] = (f16_t)A;
                    LAS bf16_t* yp = (LAS bf16_t*)(lds + LR_Y0 + (t * 128 + chl) * 2);
                    if (d == 0) *yp = (bf16_t)f2bf(H); else Y0[(size_t)(R0 + t) * 1024 + n * 128 + chl] = (bf16_t)f2bf(bf2f(*yp) + H); }
                if (sub == 3) *(f32x2*)(SUM + ((size_t)((d * NB + b) * 34 + sg) * 1024 + n * 128 + chl) * 2) = (f32x2){A, H}; }
            __syncthreads();
        }
    }
}
__device__ __forceinline__ void phase_lru_fix(Ctx& C, const bf16_t* Y0, const f16_t* CAF, const f16_t* CAB, const float* SUM, bf16_t* YA) {
    for (int un = C.gw; un < NB * 34 * 8; un += C.ngw) {
        const int cg_ = un & 7, sg = (un >> 3) % 34, b = (un >> 3) / 34, ch = cg_ * 128 + 2 * C.lane;
        float F0 = 0.f, F1 = 0.f, B0 = 0.f, B1 = 0.f;
#pragma unroll 4
        for (int p = 0; p < sg; ++p) { const f32x4 v = *(const f32x4*)(SUM + ((size_t)((0 * NB + b) * 34 + p) * 1024 + ch) * 2); F0 = v[0] * F0 + v[1]; F1 = v[2] * F1 + v[3]; }
        const int npre = (sg < 2) ? (1 - sg) : (35 - sg);
#pragma unroll 4
        for (int p = 0; p < npre; ++p) { const int ps = (p < 2) ? (1 - p) : (35 - p);
            const f32x4 v = *(const f32x4*)(SUM + ((size_t)((1 * NB + b) * 34 + ps) * 1024 + ch) * 2); B0 = v[0] * B0 + v[1]; B1 = v[2] * B1 + v[3]; }
        const size_t base = (size_t)(b * SS + sg * 128) * 1024 + ch;
        for (int t0 = 0; t0 < 128; t0 += 16) {
            unsigned y[16]; f16x2 cf[16], cbk[16];
#pragma unroll
            for (int i = 0; i < 16; ++i) { const size_t o = base + (size_t)(t0 + i) * 1024; y[i] = *(const unsigned*)(Y0 + o); cf[i] = *(const f16x2*)(CAF + o); cbk[i] = *(const f16x2*)(CAB + o); }
#pragma unroll
            for (int i = 0; i < 16; ++i) { const size_t o = base + (size_t)(t0 + i) * 1024;
                *(unsigned*)(YA + o) = pk2(lo_bf(y[i]) + (float)cf[i][0] * F0 + (float)cbk[i][0] * B0, hi_bf(y[i]) + (float)cf[i][1] * F1 + (float)cbk[i][1] * B1); }
        }
    }
}

#ifdef PROBE_TS
#define GSYNC(g) do { grid.sync(); if (blockIdx.x == 0 && threadIdx.x == 0) { unsigned long long* ts_ = (unsigned long long*)(prm.ws + 8192); const unsigned long long now_ = __builtin_amdgcn_s_memrealtime(); \
    ts_[1 + (g)] += now_ - ts_[0]; ts_[0] = now_; } } while (0)
#else
#define GSYNC(g) grid.sync()
#endif
__global__ void __launch_bounds__(NTHR) fwd_kernel(Params prm) {
    extern __shared__ __attribute__((aligned(16))) unsigned char lds_raw[];
    cg::grid_group grid = cg::this_grid();
    LAS unsigned char* const ldsb = (LAS unsigned char*)lds_raw;
#define CTX Ctx C = mkctx(ldsb)
#define WSB wsp_(C.ws)
#define bYB ((bf16_t*)(WSB + AR_YB))
#define bXA ((bf16_t*)(WSB + AR_XA))
#define bMD ((bf16_t*)(WSB + AR_MD))
#define bRQKV ((bf16_t*)(WSB + AR_RQKV))
#define bKV ((bf16_t*)(WSB + AR_KV))
#define bQN ((bf16_t*)(WSB + AR_QN))
#define bQP ((bf16_t*)(WSB + AR_QP))
#define bRI ((f16_t*)(WSB + AR_RI))
#define bSUM ((float*)(WSB + AR_SUM))
#define bOB ((bf16_t*)(WSB + AR_OB))
#define bZ ((bf16_t*)(WSB + AR_Z))
#define xc1 ((float*)(WSB + WS_XC1))

#ifdef PROBE_TS
    if (blockIdx.x == 0 && threadIdx.x == 0) { unsigned long long* ts_ = (unsigned long long*)(prm.ws + 8192); for (int i = 1; i < 32; ++i) ts_[i] = 0ull; ts_[0] = __builtin_amdgcn_s_memrealtime(); }
#endif
    { CTX; phase_prep(C); }
    for (int l = 0; l < 2; ++l) {
        const bool with_ctx = (l == 0); const int lat_only = with_ctx ? 0 : 1;
        { CTX; phase_wconv_early(C, l); }
        GSYNC(0);
        { CTX; phase_h2(C, l, bYB); }
        GSYNC(1);
        {   CTX;
            ProbPlain P{bYB, (const bf16_t*)(WSB + W_WT1), 1024, 1024, 1024};
            pg8::StaticOrder S; S.init(68, 19, C.G, C.bid, 0);
            EpiG1 E{WSB, C.ctl + CT_ROPER};
            pg8::gemm_phase<EpiG1, ProbPlain, pg8::StaticOrder, true>(C.lds, P, S, E);
        }
        GSYNC(2);
        { CTX; phase_md_post2(C, l, bMD); }
        GSYNC(3);
        { CTX; phase_ret_intra(C, l, bRQKV, bYB); }
        GSYNC(4);
        { CTX; phase_ret_chain(C, l, bRQKV, bYB, bOB); }
        GSYNC(5);
        { CTX; phase_ret_ln3(C, l, bYB, bOB); }
        {   CTX; ProbPlain P{bMD, (const bf16_t*)(WSB + W_WTQ), 768, 384, 384};
            pg8::StaticOrder S; S.init(68, 6, C.G, C.bid, 0);
            typedef EpiStore3<AR_QN, 1024, AR_QP, 512, AR_QP, 512, 4, 6> Ep; Ep E{WSB};
            pg8::gemm_phase<Ep, ProbPlain, pg8::StaticOrder, true>(C.lds, P, S, E);
        }
        {   CTX; ProbPlain P{bMD + 384, (const bf16_t*)(WSB + W_WTKV), 768, 256, 256};
            pg8::StaticOrder S; S.init(68, 8, C.G, C.bid, 0);
            typedef EpiStore3<AR_KV, 2048, AR_KV, 2048, AR_KV, 2048, 8, 8> Ep; Ep E{WSB};
            pg8::gemm_phase<Ep, ProbPlain, pg8::StaticOrder, true>(C.lds, P, S, E);
        }
        GSYNC(6);
        { CTX; phase_qk_post2(C, l, bQN, bQP, bKV); }
        GSYNC(7);
        { CTX; phase_attn(C, with_ctx, bQN, bQP, bKV, bMD); }
        GSYNC(8);
        { CTX; phase_lru_fused(C, l, bXA, (const bf16_t*)(WSB + W_WTL), (bf16_t*)(WSB + AR_Y0), (f16_t*)(WSB + AR_CAF), (f16_t*)(WSB + AR_CAB), bSUM); }
        GSYNC(9);
        { CTX; phase_lru_fix(C, (const bf16_t*)(WSB + AR_Y0), (const f16_t*)(WSB + AR_CAF), (const f16_t*)(WSB + AR_CAB), bSUM, bXA  ); }
        GSYNC(10);
        { CTX; phase_wconv_late(C, l); }
        { CTX; phase_h2(C, l, bMD  ); }
        GSYNC(13);
        {   CTX; ProbPlain P{bMD, (const bf16_t*)(WSB + W_WTG), 1024, 1024, 1024};
            pg8::StaticOrder S; S.init(lat_only ? 64 : 68, 12, C.G, C.bid, lat_only);
            EpiGate E{WSB};
            pg8::gemm_phase<EpiGate, ProbPlain, pg8::StaticOrder, true>(C.lds, P, S, E);
        }
        GSYNC(14);
        {   CTX; ProbD P{WSB, 1024, 1024};
            pg8::ChainOrder S; S.init(lat_only ? 64 : 68, C.G, C.bid, lat_only);
            EpiD E{bZ, WSB + AR_GS + (size_t)C.bid * 131072};
            pg8::gemm_phase<EpiD, ProbD, pg8::ChainOrder, true>(C.lds, P, S, E);
        }
        GSYNC(15);
        {   CTX; ProbPlain P{bZ, (const bf16_t*)(WSB + W_WTO), 1024, 1024, 1024};
            pg8::StaticOrder S; S.init(lat_only ? 64 : 68, 4, C.G, C.bid, lat_only);
            EpiOut E{(l == 0) ? INP(0) : (const float*)C.out, INP(2), C.out, xc1, C.ctl + CT_MOD + l * 5 * 3072};
            pg8::gemm_phase<EpiOut, ProbPlain, pg8::StaticOrder, true>(C.lds, P, S, E);
        }
        GSYNC(16);
    }
#ifdef PROBE_TS
    if (blockIdx.x == 0 && threadIdx.x == 0) { const unsigned long long* ts_ = (const unsigned long long*)(prm.ws + 8192); unsigned long long tot = 0ull;
        for (int g = 0; g < 17; ++g) if ((PROBE_TS >> g) & 1u) tot += ts_[1 + g];
        prm.out[0] += (float)(((tot / 100ull) + PROBE_Q / 2) / PROBE_Q * PROBE_Q); }
#endif
}

#undef xc1
#undef bZ
extern "C" void kernel_launch(void* const* d_in, const int* in_sizes, int n_in, void* d_out, int out_size, void* d_ws, size_t ws_size, hipStream_t stream) {
    static int grid = 0;
    if (grid == 0) {
        if (n_in != 29 || out_size != NB * TT * DM || ws_size < WS_END) { fprintf(stderr, "kernel_launch: unexpected shapes (n_in %d out %d ws %zu)\n", n_in, out_size, ws_size); grid = -1; return; }
        int dev = 0, cus = 0, per_cu = 0;
        hipGetDevice(&dev);
        hipDeviceGetAttribute(&cus, hipDeviceAttributeMultiprocessorCount, dev);
        if (hipFuncSetAttribute((const void*)fwd_kernel, hipFuncAttributeMaxDynamicSharedMemorySize, LDS_BYTES) != hipSuccess) { fprintf(stderr, "kernel_launch: hipFuncSetAttribute failed\n"); grid = -1; return; }
        if (hipOccupancyMaxActiveBlocksPerMultiprocessor(&per_cu, (const void*)fwd_kernel, NTHR, LDS_BYTES) != hipSuccess || per_cu < 1) { fprintf(stderr, "kernel_launch: occupancy query failed (%d)\n", per_cu); (void)hipGetLastError(); per_cu = 1; }
        grid = cus;
        fprintf(stderr, "kernel_launch: cus %d per_cu %d grid %d\n", cus, per_cu, grid);
    }
    if (grid < 0) return;
    Params p{};
    for (int i = 0; i < 29; ++i) p.in[i] = (const float*)d_in[i];
    p.out = (float*)d_out; p.ws = (unsigned char*)d_ws;
    void* args[] = {&p};
    hipError_t e = hipLaunchCooperativeKernel((const void*)fwd_kernel, dim3(grid), dim3(NTHR), args, LDS_BYTES, stream);
    if (e != hipSuccess) fprintf(stderr, "cooperative launch failed: %s (grid %d)\n", hipGetErrorString(e), grid);
}
```

```cpp
#include <hip/hip_runtime.h>
#include <hip/hip_cooperative_groups.h>
#include <cstdio>
#include <cstdint>
namespace cg = cooperative_groups;

#define LAS __attribute__((address_space(3)))
typedef unsigned short bf16_t;
typedef short bf16x8 __attribute__((ext_vector_type(8)));
typedef float f32x4 __attribute__((ext_vector_type(4)));
typedef float f32x2 __attribute__((ext_vector_type(2)));
typedef unsigned u32x4 __attribute__((ext_vector_type(4)));
typedef unsigned u32x2 __attribute__((ext_vector_type(2)));
typedef _Float16 f16_t;

namespace pg8 {
constexpr int BM = 256, BK = 64, HALF = 128, HTB = HALF * BK * 2, STAGE_BYTES = 8 * HTB, NXCD = 8, WGM = 8;
__host__ __device__ __forceinline__ int lds_byte(int r, int c) { const int st = (r >> 4) * 2 + (c >> 5), rr = r & 15, cc = c & 31, ob = rr * 64 + cc * 2; return st * 1024 + (ob ^ (((ob >> 9) & 1) << 5)); }
__host__ __device__ __forceinline__ void stage_rc(int b, int& R, int& C) { const int st = b / 1024, sb = b % 1024, swz = sb ^ (((sb >> 9) & 1) << 5); R = (st >> 1) * 16 + swz / 64; C = (st & 1) * 32 + (swz % 64) / 2; }
__host__ __device__ __forceinline__ int perm32(int rho) { const int n = rho >> 4, i = rho & 15; return 8 * (i >> 2) + 4 * n + (i & 3); }

struct Unit { int pm, pn, z; };

struct StaticOrder {
    int nM, nN, nwg, G, c, latent_only;
    __device__ void init(int nM_, int nN_, int G_, int c_, int latent_only_) { nM = nM_; nN = nN_; nwg = nM * nN; G = G_; c = c_; latent_only = latent_only_; }
    __device__ bool next(int i, Unit& u) const {
        const long L = (long)i * G + c; if (L >= nwg) return false;
        int wgid = (int)L; { const int q = nwg / NXCD, r = nwg % NXCD, xcd = wgid % NXCD, off = wgid / NXCD; wgid = (xcd < r ? xcd * (q + 1) : r * (q + 1) + (xcd - r) * q) + off; }
        const int nig = WGM * nN, gid = wgid / nig, fm = gid * WGM, gsz = (nM - fm) < WGM ? (nM - fm) : WGM;
        int pm = fm + ((wgid % nig) % gsz); u.pn = (wgid % nig) / gsz; u.z = 0;
        if (latent_only) pm = (pm >> 4) * 17 + 1 + (pm & 15);
        u.pm = pm; return true;
    }
};
struct ChainOrder {
    int ntiles, G, c, latent_only;
    __device__ void init(int nM_, int G_, int c_, int latent_only_) { ntiles = nM_ * 4; G = G_; c = c_; latent_only = latent_only_; }
    __device__ bool next(int i, Unit& u) const {
        const int r = i / 6, z = i - r * 6; const long T = (long)r * G + c; if (T >= ntiles) return false;
        int pm = (int)(T >> 2); u.pn = (int)(T & 3); u.z = z;
        if (latent_only) pm = (pm >> 4) * 17 + 1 + (pm & 15);
        u.pm = pm; return true;
    }
};

typedef __bf16 bf16x2_t __attribute__((ext_vector_type(2)));
__device__ __forceinline__ unsigned cvt_pk_bf16(float lo, float hi) { f32x2 v = {lo, hi}; bf16x2_t b = __builtin_convertvector(v, bf16x2_t); return __builtin_bit_cast(unsigned, b); }

template <class Epi, class Prob, class Sched, bool ALIGN_EPI>
__device__ __forceinline__ void gemm_phase(LAS unsigned char* lds, const Prob& P, const Sched& S, const Epi& E) {
    int tid_ = threadIdx.x; asm volatile("" : "+v"(tid_));
    const int tid = tid_, wid = __builtin_amdgcn_readfirstlane(tid >> 6), lane = tid & 63, wr = wid >> 2, wc = wid & 3, fr = lane & 15, fq = lane >> 4;
    const int K = P.K, nt = K / BK;
    int RA[2], CA[2]; unsigned voffB[2];
#pragma unroll
    for (int i = 0; i < 2; ++i) { int R, C; stage_rc(tid * 16 + i * 8192, R, C); const int Rb = Epi::PERM ? ((R & ~31) + perm32(R & 31)) : R;
        RA[i] = R; CA[i] = C; voffB[i] = (unsigned)(Rb * P.ldb + C) * 2u; }
    const unsigned kstep = (unsigned)(BK * 2);
    const unsigned hstepB = (unsigned)(HALF * P.ldb * 2);
    const unsigned ldsw = (unsigned)wid * 1024u;
    const int aoff = lds_byte(wr * 64 + fr, fq * 8), boff = lds_byte(wc * 32 + fr, fq * 8);
#define PG8_SA(b, h) (((b) * 2 + (h)) * HTB)
#define PG8_SB(b, h) ((4 + (b) * 2 + (h)) * HTB)
#define PG8_STAGE(bufoff, gbase, soff, voff) do { _Pragma("unroll") for (int _i = 0; _i < 2; ++_i) \
        __builtin_amdgcn_global_load_lds((const unsigned*)((const char*)(gbase) + (unsigned)((voff)[_i] + (soff))), (LAS unsigned*)(lds + (bufoff) + ldsw + _i * 8192), 16, 0, 0); } while (0)
#define PG8_LDA(dst, b, h) do { _Pragma("unroll") for (int m = 0; m < 4; ++m) _Pragma("unroll") for (int k = 0; k < 2; ++k) dst[m][k] = *(const LAS bf16x8*)(lds + PG8_SA(b, h) + aoff + m * 2048 + k * 1024); } while (0)
#define PG8_LDB(dst, b, h) do { _Pragma("unroll") for (int n = 0; n < 2; ++n) _Pragma("unroll") for (int k = 0; k < 2; ++k) dst[n][k] = *(const LAS bf16x8*)(lds + PG8_SB(b, h) + boff + n * 2048 + k * 1024); } while (0)
#define PG8_MMA(ai, bj, At, Bt) do { __builtin_amdgcn_s_setprio(1); _Pragma("unroll") for (int m = 0; m < 4; ++m) _Pragma("unroll") for (int n = 0; n < 2; ++n) _Pragma("unroll") for (int k = 0; k < 2; ++k) \
        acc[ai][bj][m][n] = __builtin_amdgcn_mfma_f32_16x16x32_bf16(Bt[n][k], At[m][k], acc[ai][bj][m][n], 0, 0, 0); __builtin_amdgcn_s_setprio(0); } while (0)
#define PG8_WAIT_V(n) asm volatile("s_waitcnt vmcnt(" #n ")" ::: "memory")
#define PG8_WAIT_L(n) asm volatile("s_waitcnt lgkmcnt(" #n ")" ::: "memory")
#define PG8_BAR __builtin_amdgcn_s_barrier()
#define PG8_SCHED __builtin_amdgcn_sched_barrier(0)
    Unit cur, nxt; int ui = 0;
    if (!S.next(0, cur)) return;
    f32x4 acc[2][2][4][2];
#pragma unroll
    for (int a = 0; a < 2; ++a)
#pragma unroll
        for (int b = 0; b < 2; ++b)
#pragma unroll
            for (int m = 0; m < 4; ++m)
#pragma unroll
                for (int n = 0; n < 2; ++n) acc[a][b][m][n] = (f32x4){0.f, 0.f, 0.f, 0.f};
    bf16x8 At[4][2], B0[2][2], B1[2][2];
    const char* cA; const char* cB; int ldaC; P.get(cur, cA, cB, ldaC);
    unsigned voffA[2] = {(unsigned)(RA[0] * ldaC + CA[0]) * 2u, (unsigned)(RA[1] * ldaC + CA[1]) * 2u};
    unsigned hstepA = (unsigned)(HALF * ldaC * 2);
    PG8_STAGE(PG8_SB(0, 0), cB, 0u, voffB); PG8_STAGE(PG8_SB(0, 1), cB, hstepB, voffB); PG8_STAGE(PG8_SA(0, 0), cA, 0u, voffA); PG8_STAGE(PG8_SA(0, 1), cA, hstepA, voffA);
    if (wr == 1) PG8_BAR;
    PG8_WAIT_V(2); PG8_BAR;
    PG8_STAGE(PG8_SB(1, 0), cB, kstep, voffB); PG8_STAGE(PG8_SA(1, 0), cA, kstep, voffA); PG8_STAGE(PG8_SB(1, 1), cB, hstepB + kstep, voffB);
    PG8_WAIT_V(6); PG8_BAR;
    for (;;) {
        const bool has_next = S.next(ui + 1, nxt);
        const char* nA = cA; const char* nB = cB; int ldaN = ldaC;
        if (has_next) P.get(nxt, nA, nB, ldaN);
        unsigned voffAn[2] = {(unsigned)(RA[0] * ldaN + CA[0]) * 2u, (unsigned)(RA[1] * ldaN + CA[1]) * 2u};
        const unsigned hstepAn = (unsigned)(HALF * ldaN * 2);
        for (int t = 0; t < nt; t += 2) {
            const bool last = (t == nt - 2);
            const unsigned o1 = (unsigned)(t + 1) * kstep;
            const char* a2b = last ? nA : cA; const char* b2b = last ? nB : cB;
            const unsigned o2 = last ? 0u : (unsigned)(t + 2) * kstep, o3 = o2 + kstep;
            unsigned vA2[2] = {last ? voffAn[0] : voffA[0], last ? voffAn[1] : voffA[1]};
            const unsigned hA2 = last ? hstepAn : hstepA;
            PG8_LDB(B0, 0, 0); PG8_LDB(B1, 0, 1); PG8_SCHED; PG8_LDA(At, 0, 0); PG8_STAGE(PG8_SA(1, 1), cA, o1 + hstepA, voffA);
            PG8_WAIT_V(8); PG8_WAIT_L(0); PG8_BAR; PG8_MMA(0, 0, At, B0); PG8_MMA(0, 1, At, B1); PG8_BAR; PG8_SCHED;
            PG8_LDA(At, 0, 1); PG8_STAGE(PG8_SB(0, 0), b2b, o2, voffB); PG8_STAGE(PG8_SB(0, 1), b2b, o2 + hstepB, voffB); PG8_STAGE(PG8_SA(0, 0), a2b, o2, vA2);
            PG8_WAIT_V(8); PG8_WAIT_L(0); PG8_BAR; PG8_MMA(1, 0, At, B0); PG8_MMA(1, 1, At, B1); PG8_BAR; PG8_SCHED;
            PG8_LDB(B0, 1, 0); PG8_LDB(B1, 1, 1); PG8_SCHED; PG8_LDA(At, 1, 0); PG8_STAGE(PG8_SA(0, 1), a2b, o2 + hA2, vA2);
            PG8_WAIT_V(8); PG8_WAIT_L(0); PG8_BAR; PG8_MMA(0, 0, At, B0); PG8_MMA(0, 1, At, B1); PG8_BAR; PG8_SCHED;
            PG8_LDA(At, 1, 1); PG8_STAGE(PG8_SB(1, 0), b2b, o3, voffB); PG8_STAGE(PG8_SB(1, 1), b2b, o3 + hstepB, voffB); PG8_STAGE(PG8_SA(1, 0), a2b, o3, vA2);
            PG8_WAIT_V(8); PG8_WAIT_L(0); PG8_BAR; PG8_MMA(1, 0, At, B0); PG8_MMA(1, 1, At, B1); PG8_BAR; PG8_SCHED;
        }
        if constexpr (ALIGN_EPI) { if (wr == 0) PG8_BAR; }
        E(acc, cur, wr, wc, fr, fq);
        if (!has_next) break;
#pragma unroll
        for (int a = 0; a < 2; ++a)
#pragma unroll
            for (int b = 0; b < 2; ++b)
#pragma unroll
                for (int m = 0; m < 4; ++m)
#pragma unroll
                    for (int n = 0; n < 2; ++n) acc[a][b][m][n] = (f32x4){0.f, 0.f, 0.f, 0.f};
        cur = nxt; cA = nA; cB = nB; ldaC = ldaN; voffA[0] = voffAn[0]; voffA[1] = voffAn[1]; hstepA = hstepAn; ++ui;
        if constexpr (ALIGN_EPI) { if (wr == 1) PG8_BAR; }
    }
    PG8_WAIT_V(0);
    if constexpr (!ALIGN_EPI) { if (wr == 0) PG8_BAR; }
    PG8_BAR;
#undef PG8_SA
#undef PG8_SB
#undef PG8_STAGE
#undef PG8_LDA
#undef PG8_LDB
#undef PG8_MMA
#undef PG8_WAIT_V
#undef PG8_WAIT_L
#undef PG8_BAR
#undef PG8_SCHED
}
}

constexpr int NB = 4, TT = 4096, LC = 256, SS = TT + LC  , DM = 1024, MR = NB * SS  ;
constexpr int INC = 10944;
constexpr float EPS = 1e-6f;
constexpr float LOG2E = 1.4426950408889634f;
constexpr float QSCALE = 0.07216878364870322f * 1.4426950408889634f;
constexpr int NWAVES = 8, NTHR = 512;

constexpr size_t MiB = 1u << 20;
constexpr size_t WS_CTL = 0;
constexpr size_t WS_XC1 = 1 * MiB;
constexpr size_t WS_W = 5 * MiB;
constexpr size_t WS_AR = 25 * MiB;
constexpr size_t AR_YB = WS_AR + 0 * MiB;
constexpr size_t AR_XA = WS_AR + 34 * MiB;
constexpr size_t AR_MD = WS_AR + 68 * MiB;
constexpr size_t AR_RQKV = WS_AR + 94 * MiB;
constexpr size_t AR_OB = WS_AR + 196 * MiB;
constexpr size_t AR_KV = WS_AR + 112 * MiB;
constexpr size_t AR_QN = WS_AR + 180 * MiB;
constexpr size_t AR_QP = WS_AR + 214 * MiB;
constexpr size_t AR_RI = WS_AR + 102 * MiB;
constexpr size_t AR_Y0 = WS_AR + 68 * MiB;
constexpr size_t AR_CAF = WS_AR + 102 * MiB;
constexpr size_t AR_CAB = WS_AR + 136 * MiB;
constexpr size_t AR_SUM = WS_AR + 170 * MiB;
constexpr size_t AR_Z = WS_AR + 102 * MiB;
constexpr size_t AR_GS = WS_AR + 136 * MiB;
constexpr size_t WS_END = 256 * MiB;
constexpr size_t W_WT1 = WS_W;
constexpr size_t W_WTQ = WS_W + 10 * MiB;
constexpr size_t W_WTKV = WS_W + 12 * MiB;
constexpr size_t W_WTL = WS_W + 13 * MiB;
constexpr size_t W_WTG = WS_W;
constexpr size_t W_WTGM = WS_W + 6 * MiB;
constexpr size_t W_WTD = WS_W + 12 * MiB;
constexpr size_t W_WTO = WS_W + 18 * MiB;
constexpr int CT_MOD = 16384;
constexpr int CT_ROPER = CT_MOD + 2 * 5 * 3072;
constexpr int CT_ROPEM = CT_ROPER + 2 * 4096;
constexpr int CT_SP = CT_ROPEM + 2 * 1024;
constexpr int CT_LG = CT_SP + 4096;
constexpr int CT_END = CT_LG + 16;
static_assert(CT_END * 4 <= (int)MiB, "CTL");

constexpr int LDS_BYTES = 147456;


#define XB_TMO      128
#define XB_XCNT(j)  (256  + 64 * (j))
#define XB_XSUB(j)  (1280 + 64 * (j))
#define XB_XGEN(j)  (2304 + 64 * (j))
#define XB_TOP      3328
#define XB_TOPGEN   3392
#define XCD_BAR_WORDS 3456
#define XB_SPIN_CAP (1u << 18)
constexpr size_t WS_BAR = 16384;
constexpr int LDS_ST = LDS_BYTES - 64;
__device__ __forceinline__ unsigned xb_ld(unsigned* p)              { return __hip_atomic_load(p, __ATOMIC_RELAXED, __HIP_MEMORY_SCOPE_AGENT); }
__device__ __forceinline__ unsigned xb_add(unsigned* p, unsigned v) { return __hip_atomic_fetch_add(p, v, __ATOMIC_RELAXED, __HIP_MEMORY_SCOPE_AGENT); }
__device__ __forceinline__ unsigned xb_xcc_id() { return (unsigned)__builtin_amdgcn_s_getreg((3 << 11) | 20) & 0xFu; }
#define XB_SPIN(cond, bar) do { unsigned _sp = 0; while (cond) { __builtin_amdgcn_s_sleep(1); \
    if ((++_sp & 255u) == 0u) { if (xb_ld(&(bar)[XB_TMO])) break; if (_sp > XB_SPIN_CAP) { atomicAdd(&(bar)[XB_TMO], 1u); break; } } } } while (0)
__device__ __forceinline__ void xcd_barrier_complete(unsigned* bar, unsigned x, unsigned& nloc, unsigned& nx) {
    const unsigned G = gridDim.x * gridDim.y * gridDim.z;
    unsigned sum, cnt, mine, sp = 0u;
    for (;;) {
        sum = 0u; cnt = 0u; mine = 0u;
#pragma unroll
        for (unsigned j = 0; j < 16; ++j) { const unsigned c = xb_ld(&bar[XB_XCNT(j)]); sum += c; cnt += (c > 0u) ? 1u : 0u; mine = (j == x) ? c : mine; }
        if (sum == G) break;
        __builtin_amdgcn_s_sleep(1);
        if ((++sp & 255u) == 0u) { if (xb_ld(&bar[XB_TMO])) break; if (sp > XB_SPIN_CAP) { atomicAdd(&bar[XB_TMO], 1u); break; } }
    }
    nloc = mine > 0u ? mine : 1u; nx = cnt > 0u ? cnt : 1u;
}
__device__ __forceinline__ void xcd_barrier(unsigned* bar, volatile LAS unsigned* st) {
    asm volatile("s_waitcnt vmcnt(0)" ::: "memory");
    __syncthreads();
    if (threadIdx.x == 0) {
        const unsigned x = xb_xcc_id();
        __builtin_amdgcn_s_waitcnt(0);
        unsigned nloc = st[0], nx = st[1];
        if (nloc == 0u) { xcd_barrier_complete(bar, x, nloc, nx); st[0] = nloc; st[1] = nx; }
        const unsigned old = xb_add(&bar[XB_XSUB(x)], 1u);
        const unsigned gen = old / nloc;
        if (old + 1u == (gen + 1u) * nloc) {
            __builtin_amdgcn_fence(__ATOMIC_RELEASE, "agent");
            asm volatile("s_waitcnt vmcnt(0)" ::: "memory");
            const unsigned og = xb_add(&bar[XB_TOP], 1u);
            const unsigned tg = og / nx;
            if (og + 1u == (tg + 1u) * nx) xb_add(&bar[XB_TOPGEN], 1u);
            else XB_SPIN(xb_ld(&bar[XB_TOPGEN]) == tg, bar);
            __builtin_amdgcn_fence(__ATOMIC_ACQUIRE, "agent");
            xb_add(&bar[XB_XGEN(x)], 1u);
            asm volatile("s_waitcnt vmcnt(0)" ::: "memory");
        } else {
            XB_SPIN(xb_ld(&bar[XB_XGEN(x)]) == gen, bar);
            __builtin_amdgcn_fence(__ATOMIC_ACQUIRE, "agent");
            asm volatile("s_waitcnt vmcnt(0)" ::: "memory");
        }
    }
    __syncthreads();
}

struct Params {
    const float* in[29];
    float* out;
    unsigned char* ws;
};

#define EX2(x) __builtin_amdgcn_exp2f(x)
#define RSQ(x) __builtin_amdgcn_rsqf(x)
#define SQRT(x) __builtin_amdgcn_sqrtf(x)
__device__ __forceinline__ float bf2f(unsigned v) { return __uint_as_float(v << 16); }
__device__ __forceinline__ unsigned f2bf(float f) { unsigned u = __float_as_uint(f); return (u + 0x7fffu + ((u >> 16) & 1u)) >> 16; }
__device__ __forceinline__ unsigned pk2(float lo, float hi) { return f2bf(lo) | (f2bf(hi) << 16); }
__device__ __forceinline__ float lo_bf(unsigned w) { return __uint_as_float(w << 16); }
__device__ __forceinline__ float hi_bf(unsigned w) { return __uint_as_float(w & 0xffff0000u); }
__device__ __forceinline__ float wave_sum(float v) {
#pragma unroll
    for (int o = 1; o < 64; o <<= 1) v += __shfl_xor(v, o);
    return v;
}
__device__ __forceinline__ float wave_max(float v) {
#pragma unroll
    for (int o = 1; o < 64; o <<= 1) v = fmaxf(v, __shfl_xor(v, o));
    return v;
}
__device__ __forceinline__ float sigmoidf_(float x) { return __builtin_amdgcn_rcpf(1.f + __expf(-x)); }
__device__ __forceinline__ float siluf_(float x) { return x * __builtin_amdgcn_rcpf(1.f + __expf(-x)); }

__device__ __forceinline__ const float* inp_(int i) { asm volatile("" : "+s"(i)); const float* const* ka = (const float* const*)__builtin_amdgcn_kernarg_segment_ptr(); return ka[i]; }
#define INP(i) inp_(i)
__device__ __forceinline__ unsigned char* wsp_(unsigned char* p) { asm volatile("" : "+s"(p)); return p; }
struct Ctx {
    float* out; unsigned char* ws; LAS unsigned char* lds; int tid, lane, wave, G, bid;
    int gw, ngw;
    int rot;
    float* ctl;
};

__device__ __forceinline__ Ctx mkctx(LAS unsigned char* lds) {
    Ctx C; int t = threadIdx.x; asm volatile("" : "+v"(t)); int b = blockIdx.x; asm volatile("" : "+s"(b)); int g = gridDim.x; asm volatile("" : "+s"(g));
    C.tid = t; C.lane = t & 63; C.wave = __builtin_amdgcn_readfirstlane(t >> 6); C.bid = b; C.G = g; C.gw = b * NWAVES + C.wave; C.ngw = g * NWAVES; C.rot = 0;
    int io = 29, iw = 30; asm volatile("" : "+s"(io)); asm volatile("" : "+s"(iw));
    unsigned char* const* ka = (unsigned char* const*)__builtin_amdgcn_kernarg_segment_ptr();
    C.out = (float*)ka[io]; C.ws = ka[iw]; C.ctl = (float*)(C.ws + WS_CTL); C.lds = lds;
    return C;
}
__device__ __forceinline__ const float* resid_row(const Ctx& C, int l, int m) {
    const int b = m / SS, s = m - b * SS;
    if (s < LC) { const float* base = (l == 0) ? INP(2) : (const float*)(C.ws + WS_XC1); return base + (size_t)(b * LC + s) * DM; }
    const float* base = (l == 0) ? INP(0) : C.out; return base + (size_t)(b * TT + (s - LC)) * DM;
}

__device__ __forceinline__ void phase_prep(Ctx& C) {
    LAS float* sl = (LAS float*)C.lds;
    LAS float* red = (LAS float*)(C.lds + 32768);
    for (int i = C.tid; i < 5 * 1024; i += NTHR) { const int r = i >> 10, k = i & 1023; const float v = (r < 4) ? INP(1)[r * 1024 + k] : INP(3)[k]; sl[i] = siluf_(v); }
    __syncthreads();
    for (int it = C.bid; it < 2 * 96; it += C.G) {
        const int l = it / 96, grp = it % 96, kg = C.tid >> 5, cj = C.tid & 31, col = grp * 32 + cj;
        const float* w = INP(4) + (size_t)l * 1024 * 3072 + col;
        float a0 = 0.f, a1 = 0.f, a2 = 0.f, a3 = 0.f, a4 = 0.f;
#pragma unroll 8
        for (int k = kg * 64; k < kg * 64 + 64; ++k) { const float wv = w[(size_t)k * 3072]; a0 += sl[k] * wv; a1 += sl[1024 + k] * wv; a2 += sl[2048 + k] * wv; a3 += sl[3072 + k] * wv; a4 += sl[4096 + k] * wv; }
        red[(kg * 32 + cj) * 5 + 0] = a0; red[(kg * 32 + cj) * 5 + 1] = a1; red[(kg * 32 + cj) * 5 + 2] = a2; red[(kg * 32 + cj) * 5 + 3] = a3; red[(kg * 32 + cj) * 5 + 4] = a4;
        __syncthreads();
        if (C.tid < 160) { const int c2 = C.tid / 5, r = C.tid % 5; float s = 0.f;
            for (int g = 0; g < 16; ++g) s += red[(g * 32 + c2) * 5 + r];
            C.ctl[CT_MOD + (l * 5 + r) * 3072 + grp * 32 + c2] = s + INP(5)[l * 3072 + grp * 32 + c2]; }
        __syncthreads();
    }
    const int gt = C.bid * NTHR + C.tid, ngt = C.G * NTHR;
    for (int i = gt; i < 4096; i += ngt) { const int pos = i >> 6, f = i & 63; const float inv = powf(10000.f, -(float)f / 64.f), ang = (float)pos * inv;
        C.ctl[CT_ROPER + i] = cosf(ang); C.ctl[CT_ROPER + 4096 + i] = sinf(ang); }
    for (int i = gt; i < 1024; i += ngt) { const int pos = i >> 4, f = i & 15; const float inv = powf(10000.f, -(float)f / 16.f), ang = (float)pos * inv;
        C.ctl[CT_ROPEM + i] = cosf(ang); C.ctl[CT_ROPEM + 1024 + i] = sinf(ang); }
    for (int i = gt; i < 4096; i += ngt) C.ctl[CT_SP + i] = log1pf(expf(-INP(14)[i]));
    for (int i = gt; i < 16; i += ngt) C.ctl[CT_LG + i] = -log1pf(expf(-INP(15)[i])) * LOG2E;
}

__device__ __forceinline__ void tr_item(const float* W, int ldw, int k0, int n0, bf16_t* WT, int ldt, int drow0, int dk0, LAS float* scr, int lane) {
#pragma unroll 8
    for (int i = 0; i < 32; ++i) { const int kk = 2 * i + (lane >> 5); scr[kk * 33 + (lane & 31)] = W[(size_t)(k0 + kk) * ldw + n0 + (lane & 31)]; }
    asm volatile("s_waitcnt lgkmcnt(0)" ::: "memory");
    const int c = lane & 7;
#pragma unroll
    for (int j = 0; j < 4; ++j) { const int n = (lane >> 3) + 8 * j; const LAS float* s = scr + (8 * c) * 33 + n;
        u32x4 o; o.x = pk2(s[0 * 33], s[1 * 33]); o.y = pk2(s[2 * 33], s[3 * 33]); o.z = pk2(s[4 * 33], s[5 * 33]); o.w = pk2(s[6 * 33], s[7 * 33]);
        *(u32x4*)(WT + (size_t)(drow0 + n) * ldt + dk0 + 8 * c) = o; }
    asm volatile("s_waitcnt lgkmcnt(0)" ::: "memory");
}
__device__ __forceinline__ void conv_rows(Ctx& C, const float* W, int ldw, int K, int scol0, bf16_t* WT, int ldt, int drow0, int dk0, int nrows, LAS float* scr) {
    const int nkb = K / 64, items = nkb * (nrows / 32);
    int g0 = C.gw - C.rot; if (g0 < 0) g0 += C.ngw; C.rot = (C.rot + items) % C.ngw;
    for (int it = g0; it < items; it += C.ngw) { const int nb = it / nkb, kb = it - nb * nkb;
        tr_item(W, ldw, kb * 64, scol0 + nb * 32, WT, ldt, drow0 + nb * 32, dk0 + kb * 64, scr, C.lane); }
}
__device__ __forceinline__ int ropeperm(int j) { const int h = j >> 8, jj = j & 255, half = jj >> 7, g = (jj & 127) >> 3, r8 = jj & 7; return h * 256 + (half * 2 + (r8 >> 2)) * 64 + g * 4 + (r8 & 3); }
__device__ __forceinline__ void tr_item_rope(const float* W, int ldw, int k0, int scol0, int jbase, bf16_t* WT, int ldt, int drow0, int dk0, LAS float* scr, int lane) {
    const int sc = scol0 + ropeperm(jbase + (lane & 31));
#pragma unroll 8
    for (int i = 0; i < 32; ++i) { const int kk = 2 * i + (lane >> 5); scr[kk * 33 + (lane & 31)] = W[(size_t)(k0 + kk) * ldw + sc]; }
    asm volatile("s_waitcnt lgkmcnt(0)" ::: "memory");
    const int c = lane & 7;
#pragma unroll
    for (int j = 0; j < 4; ++j) { const int n = (lane >> 3) + 8 * j; const LAS float* s = scr + (8 * c) * 33 + n;
        u32x4 o; o.x = pk2(s[0 * 33], s[1 * 33]); o.y = pk2(s[2 * 33], s[3 * 33]); o.z = pk2(s[4 * 33], s[5 * 33]); o.w = pk2(s[6 * 33], s[7 * 33]);
        *(u32x4*)(WT + (size_t)(drow0 + n) * ldt + dk0 + 8 * c) = o; }
    asm volatile("s_waitcnt lgkmcnt(0)" ::: "memory");
}
__device__ __forceinline__ void conv_rows_rope(Ctx& C, const float* W, int ldw, int K, int scol0, bf16_t* WT, int ldt, int drow0, int nrows, LAS float* scr) {
    const int nkb = K / 64, items = nkb * (nrows / 32);
    int g0 = C.gw - C.rot; if (g0 < 0) g0 += C.ngw; C.rot = (C.rot + items) % C.ngw;
    for (int it = g0; it < items; it += C.ngw) { const int nb = it / nkb, kb = it - nb * nkb;
        tr_item_rope(W, ldw, kb * 64, scol0, nb * 32, WT, ldt, drow0 + nb * 32, kb * 64, scr, C.lane); }
}
__device__ __forceinline__ void zero_rows(Ctx& C, bf16_t* WT, int ldt, int drow0, int dk0, int nrows, int ncols) {
    const int per = ncols / 8, items = nrows * per;
    int g0 = C.gw - C.rot; if (g0 < 0) g0 += C.ngw; C.rot = (C.rot + (items + 63) / 64) % C.ngw;
    for (int it = g0 * 64 + C.lane; it < items; it += C.ngw * 64) { const int r = it / per, c = it - r * per; *(u32x4*)(WT + (size_t)(drow0 + r) * ldt + dk0 + c * 8) = (u32x4){0u, 0u, 0u, 0u}; }
}
__device__ __forceinline__ void phase_wconv_early(Ctx& C, int l) {
    LAS float* scr = (LAS float*)(C.lds + C.wave * 16384);
    unsigned char* ws = C.ws;
    const float* win = INP(7) + (size_t)l * 1024 * INC;
    bf16_t* WT1 = (bf16_t*)(ws + W_WT1);
    conv_rows(C, win, INC, 1024, 0, WT1, 1024, 0, 0, 1024, scr);
    conv_rows_rope(C, win, INC, 1024, 2048, WT1, 1024, 1024, 1024, scr);
    conv_rows_rope(C, win, INC, 1024, 3072, WT1, 1024, 2048, 1024, scr);
    conv_rows(C, win, INC, 1024, 4096, WT1, 1024, 3072, 0, 1024, scr);
    conv_rows(C, win, INC, 1024, 6144, WT1, 1024, 4096, 0, 704, scr);
    zero_rows(C, WT1, 1024, 4800, 0, 64, 1024);
    const float* wq = INP(18) + (size_t)l * 384 * 1536; bf16_t* WTQ = (bf16_t*)(ws + W_WTQ);
    for (int h = 0; h < 8; ++h) { conv_rows(C, wq, 1536, 384, h * 192, WTQ, 384, h * 128, 0, 128, scr); conv_rows(C, wq, 1536, 384, h * 192 + 128, WTQ, 384, 1024 + h * 64, 0, 64, scr); }
    const float* wkv = INP(20) + (size_t)l * 256 * 2048; bf16_t* WTKV = (bf16_t*)(ws + W_WTKV);
    for (int h = 0; h < 8; ++h) { conv_rows(C, wkv, 2048, 256, h * 256, WTKV, 256, h * 128, 0, 128, scr); conv_rows(C, wkv, 2048, 256, h * 256 + 128, WTKV, 256, 1024 + h * 128, 0, 128, scr); }
    bf16_t* WTL = (bf16_t*)(ws + W_WTL);
    for (int d = 0; d < 2; ++d) for (int n = 0; n < 8; ++n) for (int mat = 0; mat < 2; ++mat) {
        const float* w = INP(mat == 0 ? 10 : 12) + ((size_t)(l * 2 + d) * 8 + n) * 128 * 128;
        const int drow0 = d * 2048 + n * 256 + mat * 128;
        conv_rows(C, w, 128, 128, 0, WTL, 256, drow0, (n & 1) * 128, 128, scr);
        zero_rows(C, WTL, 256, drow0, ((n & 1) ^ 1) * 128, 128, 128);
    }
}
__device__ __forceinline__ void phase_wconv_late(Ctx& C, int l) {
    LAS float* scr = (LAS float*)(C.lds + C.wave * 16384);
    unsigned char* ws = C.ws;
    const float* win = INP(7) + (size_t)l * 1024 * INC;
    bf16_t* WTG = (bf16_t*)(ws + W_WTG);
    conv_rows(C, win, INC, 1024, 1024, WTG, 1024, 0, 0, 1024, scr);
    conv_rows(C, win, INC, 1024, 5120, WTG, 1024, 1024, 0, 1024, scr);
    conv_rows(C, win, INC, 1024, 6848, WTG, 1024, 2048, 0, 1024, scr);
    conv_rows(C, win, INC, 1024, 7872, (bf16_t*)(ws + W_WTGM), 1024, 0, 0, 3072, scr);
    for (int i = 0; i < 3; ++i) conv_rows(C, INP(25 + i) + (size_t)l * 1024 * 1024, 1024, 1024, 0, (bf16_t*)(ws + W_WTD) + (size_t)i * 1024 * 1024, 1024, 0, 0, 1024, scr);
    conv_rows(C, INP(28) + (size_t)l * 1024 * 1024, 1024, 1024, 0, (bf16_t*)(ws + W_WTO), 1024, 0, 0, 1024, scr);
}

__device__ __forceinline__ void phase_h(Ctx& C, int l, bf16_t* H) {
    const float* gain = INP(6) + l * 1024;
    for (int m = C.gw; m < MR; m += C.ngw) {
        const int b = m / SS, s = m - b * SS, r = (s < LC) ? 4 : b;
        const float* xr = resid_row(C, l, m);
        const float* mod = C.ctl + CT_MOD + (l * 5 + r) * 3072;
        f32x4 v[4]; float ss = 0.f;
#pragma unroll
        for (int j = 0; j < 4; ++j) { v[j] = *(const f32x4*)(xr + 4 * C.lane + 256 * j); ss += (v[j].x * v[j].x + v[j].y * v[j].y) + (v[j].z * v[j].z + v[j].w * v[j].w); }
        const float rstd = RSQ(wave_sum(ss) * (1.f / 1024.f) + EPS);
#pragma unroll
        for (int j = 0; j < 4; ++j) { const int c = 4 * C.lane + 256 * j;
            const f32x4 g = *(const f32x4*)(gain + c), sh = *(const f32x4*)(mod + c), sc = *(const f32x4*)(mod + 1024 + c);
            const f32x4 y = (v[j] * rstd) * g;
            const f32x4 o = y * (sc + 1.0f) + sh;
            u32x2 w; w.x = pk2(o.x, o.y); w.y = pk2(o.z, o.w);
            *(u32x2*)(H + (size_t)m * 1024 + c) = w; }
    }
}

using pg8::Unit;
struct ProbPlain {
    const bf16_t* A; const bf16_t* Bt; int lda, ldb, K;
    __device__ __forceinline__ void get(const Unit& u, const char*& a, const char*& b, int& lda_) const {
        a = (const char*)(A + (size_t)u.pm * 256 * lda); b = (const char*)(Bt + (size_t)u.pn * 256 * ldb); lda_ = lda; }
};
struct ProbLru {
    const bf16_t* A; const bf16_t* Bt; int ldb, K;
    __device__ __forceinline__ void get(const Unit& u, const char*& a, const char*& b, int& lda_) const {
        a = (const char*)(A + (size_t)u.pm * 256 * 1024 + (u.pn >> 1) * 256); b = (const char*)(Bt + (size_t)u.pn * 256 * 256); lda_ = 1024; }
};
struct ProbD {
    unsigned char* ws; int ldb, K;
    __device__ __forceinline__ void get(const Unit& u, const char*& a, const char*& b, int& lda_) const {
        const int i = u.z >> 1;
        if ((u.z & 1) == 0) { a = (const char*)(ws + AR_MD + (size_t)u.pm * 256 * 1024 * 2); b = (const char*)(ws + W_WTGM + ((size_t)i * 1024 + u.pn * 256) * 1024 * 2); lda_ = 1024; }
        else { const size_t yo = (i == 0) ? AR_XA : (i == 1) ? AR_YB : AR_QN;
            a = (const char*)(ws + yo + (size_t)u.pm * 256 * 1024 * 2); b = (const char*)(ws + W_WTD + ((size_t)i * 1024 + u.pn * 256) * 1024 * 2); lda_ = 1024; }
    }
};

#define EPI_ARGS const f32x4 (&acc)[2][2][4][2], const Unit& u, int wr, int wc, int fr, int fq
template <size_t O0, int L0, size_t O1, int L1, size_t O2, int L2, int T1, int T2>
struct EpiStore3 {
    static constexpr bool PERM = true;
    unsigned char* ws;
    __device__ __forceinline__ void operator()(EPI_ARGS) const {
        bf16_t* bs; int ldc, ct;
        size_t off;
        if (u.pn < T1) { off = O0; ldc = L0; ct = u.pn; } else if (u.pn < T2) { off = O1; ldc = L1; ct = u.pn - T1; } else { off = O2; ldc = L2; ct = u.pn - T2; }
        bs = (bf16_t*)(ws + off);
        const int row0 = u.pm * 256 + wr * 64 + fr, col0 = ct * 256 + wc * 32 + 8 * fq;
#pragma unroll
        for (int ai = 0; ai < 2; ++ai)
#pragma unroll
            for (int m = 0; m < 4; ++m) { bf16_t* rowp = bs + (size_t)(row0 + ai * 128 + m * 16) * ldc + col0;
#pragma unroll
                for (int bj = 0; bj < 2; ++bj) { const f32x4 v0 = acc[ai][bj][m][0], v1 = acc[ai][bj][m][1];
                    u32x4 w; w.x = pg8::cvt_pk_bf16(v0[0], v0[1]); w.y = pg8::cvt_pk_bf16(v0[2], v0[3]); w.z = pg8::cvt_pk_bf16(v1[0], v1[1]); w.w = pg8::cvt_pk_bf16(v1[2], v1[3]);
                    *(u32x4*)(rowp + bj * 128) = w; } }
    }
};
struct EpiG1 {
    static constexpr bool PERM = true;
    unsigned char* ws; const float* cs;
    __device__ __forceinline__ void operator()(EPI_ARGS) const {
        bf16_t* bs; int ldc, ct;
        if (u.pn < 4) { bs = (bf16_t*)(ws + AR_XA); ldc = 1024; ct = u.pn; } else if (u.pn < 16) { bs = (bf16_t*)(ws + AR_RQKV); ldc = 3072; ct = u.pn - 4; } else { bs = (bf16_t*)(ws + AR_MD); ldc = 768; ct = u.pn - 16; }
        const int row0 = u.pm * 256 + wr * 64 + fr, col0 = ct * 256 + wc * 32 + 8 * fq;
        const bool rope = (u.pn >= 4) && (u.pn < 12), iskey = (u.pn >= 8);
        const int bq = u.pm / 17, s0 = (u.pm - bq * 17) * 256 + wr * 64 + fr;
        const int f0 = (wc * 4 + fq) * 4;
#pragma unroll
        for (int ai = 0; ai < 2; ++ai)
#pragma unroll
            for (int m = 0; m < 4; ++m) { bf16_t* rowp = bs + (size_t)(row0 + ai * 128 + m * 16) * ldc + col0;
                const int s = s0 + ai * 128 + m * 16, t = s - LC; const bool lat = s >= LC;
#pragma unroll
                for (int bj = 0; bj < 2; ++bj) { f32x4 v0 = acc[ai][bj][m][0], v1 = acc[ai][bj][m][1];
                    if (rope) {
                        if (lat) { const int pos = bj ? (t & 63) : (t >> 6); const f32x4 c = *(const f32x4*)(cs + pos * 64 + f0), sn = *(const f32x4*)(cs + 4096 + pos * 64 + f0);
                            const f32x4 a = v0 * c - v1 * sn, b = v1 * c + v0 * sn; v0 = a; v1 = b; }
                        if (iskey) { v0 = v0 * 0.0625f; v1 = v1 * 0.0625f; } }
                    u32x4 w; w.x = pg8::cvt_pk_bf16(v0[0], v0[1]); w.y = pg8::cvt_pk_bf16(v0[2], v0[3]); w.z = pg8::cvt_pk_bf16(v1[0], v1[1]); w.w = pg8::cvt_pk_bf16(v1[2], v1[3]);
                    *(u32x4*)(rowp + bj * 128) = w; }
                asm volatile("" ::: "memory"); }
    }
};
typedef f16_t f16x8 __attribute__((ext_vector_type(8)));
struct EpiLru {
    static constexpr bool PERM = true;
    const bf16_t* U; f16_t* RI; const float* ba; const float* bx; const float* sp;
    __device__ __forceinline__ void operator()(EPI_ARGS) const {
        const int row0 = u.pm * 256 + wr * 64 + fr, ch0 = u.pn * 128 + wc * 32 + 8 * fq;
        float bav[8], bxv[8], spv[8];
#pragma unroll
        for (int e = 0; e < 8; ++e) { bav[e] = ba[ch0 + e]; bxv[e] = bx[ch0 + e]; spv[e] = sp[ch0 + e] * (-8.f); }
#pragma unroll
        for (int ai = 0; ai < 2; ++ai)
#pragma unroll
            for (int m = 0; m < 4; ++m) { const int row = row0 + ai * 128 + m * 16;
                const u32x4 uw = *(const u32x4*)(U + (size_t)row * 1024 + ch0);
                float uv[8] = {lo_bf(uw.x), hi_bf(uw.x), lo_bf(uw.y), hi_bf(uw.y), lo_bf(uw.z), hi_bf(uw.z), lo_bf(uw.w), hi_bf(uw.w)};
                f16x8 la, bc;
#pragma unroll
                for (int e = 0; e < 8; ++e) { const float rp = acc[ai][0][m][e >> 2][e & 3] + bav[e], ip = acc[ai][1][m][e >> 2][e & 3] + bxv[e];
                    const float r = sigmoidf_(rp), ig = sigmoidf_(ip);
                    const float loga = r * spv[e];
                    const float bb = SQRT(fmaxf(-expm1f(2.f * loga), 0.f)) * (ig * uv[e]);
                    la[e] = (f16_t)(loga * LOG2E); bc[e] = (f16_t)bb; }
                *(f16x8*)(RI + (size_t)row * 2048 + ch0) = la; *(f16x8*)(RI + (size_t)row * 2048 + 1024 + ch0) = bc;
                asm volatile("" ::: "memory"); }
    }
};
struct EpiGate {
    static constexpr bool PERM = true;
    unsigned char* ws;
    __device__ __forceinline__ void operator()(EPI_ARGS) const {
        const int br = u.pn >> 2; const size_t yo = (br == 0) ? AR_XA : (br == 1) ? AR_YB : AR_QN; bf16_t* bs = (bf16_t*)(ws + yo); const int ldc = 1024;
        const int row0 = u.pm * 256 + wr * 64 + fr, col0 = (u.pn & 3) * 256 + wc * 32 + 8 * fq;
#pragma unroll
        for (int ai = 0; ai < 2; ++ai)
#pragma unroll
            for (int m = 0; m < 4; ++m) { bf16_t* rowp = bs + (size_t)(row0 + ai * 128 + m * 16) * ldc + col0;
#pragma unroll
                for (int bj = 0; bj < 2; ++bj) { const f32x4 v0 = acc[ai][bj][m][0], v1 = acc[ai][bj][m][1];
                    const u32x4 y = *(const u32x4*)(rowp + bj * 128);
                    u32x4 w; w.x = pg8::cvt_pk_bf16(lo_bf(y.x) * siluf_(v0[0]), hi_bf(y.x) * siluf_(v0[1])); w.y = pg8::cvt_pk_bf16(lo_bf(y.y) * siluf_(v0[2]), hi_bf(y.y) * siluf_(v0[3]));
                    w.z = pg8::cvt_pk_bf16(lo_bf(y.z) * siluf_(v1[0]), hi_bf(y.z) * siluf_(v1[1])); w.w = pg8::cvt_pk_bf16(lo_bf(y.w) * siluf_(v1[2]), hi_bf(y.w) * siluf_(v1[3]));
                    *(u32x4*)(rowp + bj * 128) = w; }
                asm volatile("" ::: "memory"); }
    }
};
struct EpiD {
    static constexpr bool PERM = true;
    bf16_t* Z; unsigned char* gs;
    __device__ __forceinline__ void operator()(EPI_ARGS) const {
        const int row0 = u.pm * 256 + wr * 64 + fr, col0 = u.pn * 256 + wc * 32 + 8 * fq, i = u.z >> 1;
        const unsigned tq = (unsigned)(((wr * 4 + wc) * 64 + fq * 16 + fr) * 64);
        if ((u.z & 1) == 0) {
#pragma unroll
            for (int ai = 0; ai < 2; ++ai)
#pragma unroll
                for (int m = 0; m < 4; ++m)
#pragma unroll
                    for (int bj = 0; bj < 2; ++bj) { const f32x4 v0 = acc[ai][bj][m][0], v1 = acc[ai][bj][m][1];
                        u32x4 w; w.x = pg8::cvt_pk_bf16(sigmoidf_(v0[0]), sigmoidf_(v0[1])); w.y = pg8::cvt_pk_bf16(sigmoidf_(v0[2]), sigmoidf_(v0[3]));
                        w.z = pg8::cvt_pk_bf16(sigmoidf_(v1[0]), sigmoidf_(v1[1])); w.w = pg8::cvt_pk_bf16(sigmoidf_(v1[2]), sigmoidf_(v1[3]));
                        *(u32x4*)(gs + (((ai * 4 + m) * 2 + bj) >> 2) * 32768 + tq + (((ai * 4 + m) * 2 + bj) & 3) * 16) = w; }
        } else {
#pragma unroll
            for (int ai = 0; ai < 2; ++ai)
#pragma unroll
                for (int m = 0; m < 4; ++m) { bf16_t* zrow = Z + (size_t)(row0 + ai * 128 + m * 16) * 1024 + col0;
#pragma unroll
                    for (int bj = 0; bj < 2; ++bj) { const f32x4 v0 = acc[ai][bj][m][0], v1 = acc[ai][bj][m][1];
                        const u32x4 g = *(const u32x4*)(gs + (((ai * 4 + m) * 2 + bj) >> 2) * 32768 + tq + (((ai * 4 + m) * 2 + bj) & 3) * 16); bf16_t* zp = zrow + bj * 128;
                        float o0 = lo_bf(g.x) * v0[0], o1 = hi_bf(g.x) * v0[1], o2 = lo_bf(g.y) * v0[2], o3 = hi_bf(g.y) * v0[3], o4 = lo_bf(g.z) * v1[0], o5 = hi_bf(g.z) * v1[1], o6 = lo_bf(g.w) * v1[2], o7 = hi_bf(g.w) * v1[3];
                        if (i > 0) { const u32x4 zo = *(const u32x4*)zp; o0 += lo_bf(zo.x); o1 += hi_bf(zo.x); o2 += lo_bf(zo.y); o3 += hi_bf(zo.y); o4 += lo_bf(zo.z); o5 += hi_bf(zo.z); o6 += lo_bf(zo.w); o7 += hi_bf(zo.w); }
                        u32x4 w; w.x = pg8::cvt_pk_bf16(o0, o1); w.y = pg8::cvt_pk_bf16(o2, o3); w.z = pg8::cvt_pk_bf16(o4, o5); w.w = pg8::cvt_pk_bf16(o6, o7); *(u32x4*)zp = w; }
                    asm volatile("" ::: "memory"); }
        }
    }
};
struct EpiOut {
    static constexpr bool PERM = false;
    const float* xlat; const float* xctx; float* olat; float* octx; const float* mod;
    __device__ __forceinline__ void operator()(EPI_ARGS) const {
        const int b = u.pm / 17, isctx = (u.pm - b * 17) == 0;
        const float* gate = mod + (isctx ? 4 : b) * 3072 + 2048;
        const int col0 = u.pn * 256 + wc * 32 + 4 * fq;
        f32x4 gv[2][2];
#pragma unroll
        for (int bj = 0; bj < 2; ++bj)
#pragma unroll
            for (int n = 0; n < 2; ++n) gv[bj][n] = *(const f32x4*)(gate + col0 + bj * 128 + n * 16);
#pragma unroll
        for (int ai = 0; ai < 2; ++ai)
#pragma unroll
            for (int m = 0; m < 4; ++m) { const int s = (u.pm - b * 17) * 256 + ai * 128 + wr * 64 + m * 16 + fr;
                const size_t off = isctx ? ((size_t)(b * LC + s) * 1024 + col0) : ((size_t)(b * TT + (s - LC)) * 1024 + col0);
                const float* xin = isctx ? xctx : xlat; float* xo = isctx ? octx : olat;
#pragma unroll
                for (int bj = 0; bj < 2; ++bj)
#pragma unroll
                    for (int n = 0; n < 2; ++n) { const f32x4 xv = *(const f32x4*)(xin + off + bj * 128 + n * 16);
                        *(f32x4*)(xo + off + bj * 128 + n * 16) = xv + gv[bj][n] * acc[ai][bj][m][n]; }
                asm volatile("" ::: "memory"); }
    }
};

__device__ __forceinline__ void phase_ret_rope(Ctx& C, bf16_t* RQKV) {
    const float* cs = C.ctl + CT_ROPER; const float* sn = cs + 4096;
    for (int m = C.gw; m < MR; m += C.ngw) {
        const int b = m / SS, s = m - b * SS; const bool lat = s >= LC; const int t = s - LC, prow = lat ? (t >> 6) : 0, pcol = lat ? (t & 63) : 0;
        bf16_t* row = RQKV + (size_t)m * 3072;
#pragma unroll
        for (int j = 0; j < 16; ++j) {
            const int idx = j * 64 + C.lane, f = idx & 63, half = (idx >> 6) & 1, h = (idx >> 7) & 3, tz = idx >> 9;
            bf16_t* p = row + tz * 1024 + h * 256 + half * 128 + f;
            const float x1 = bf2f(p[0]), x2 = bf2f(p[64]);
            float o1 = x1, o2 = x2;
            if (lat) { const int pos = half ? pcol : prow; const float c = cs[pos * 64 + f], sv = sn[pos * 64 + f]; o1 = x1 * c - x2 * sv; o2 = x2 * c + x1 * sv; }
            if (tz) { o1 *= 0.0625f; o2 *= 0.0625f; }
            p[0] = (bf16_t)f2bf(o1); p[64] = (bf16_t)f2bf(o2);
        }
    }
}

#define RS_STEP(o, cnt, st) do { const bool up_ = (C.lane & (st)) != 0; _Pragma("unroll") for (int e_ = 0; e_ < (cnt) / 2; ++e_) { \
        const float send_ = up_ ? o[e_] : o[e_ + (cnt) / 2]; const float keep_ = up_ ? o[e_ + (cnt) / 2] : o[e_]; o[e_] = keep_ + __shfl_xor(send_, (st)); } } while (0)

__device__ __forceinline__ void phase_ret_naive(Ctx& C, int l, const bf16_t* RQKV, bf16_t* OI) {
    LAS unsigned char* qs = C.lds + C.wave * 512;
    const int nbu = (MR / 8) * 16;
    for (int bu = C.bid; bu < nbu; bu += C.G) {
        const int hq = bu & 15, h = hq >> 2, qd = hq & 3, n = (bu >> 4) * 8 + C.wave;
        const int b = n / SS, sn_ = n - b * SS;
        const float lgf = C.ctl[CT_LG + (l * 2 + 0) * 4 + h], lgb = C.ctl[CT_LG + (l * 2 + 1) * 4 + h];
        const int pfn = sn_, pbn = (sn_ < LC) ? (LC - 1 - sn_) : (SS + LC - 1 - sn_);
        asm volatile("s_waitcnt lgkmcnt(0)" ::: "memory");
        *(LAS u32x2*)(qs + C.lane * 8) = *(const u32x2*)(RQKV + (size_t)n * 3072 + h * 256 + C.lane * 4);
        asm volatile("s_waitcnt lgkmcnt(0)" ::: "memory");
        float o[64];
#pragma unroll
        for (int e = 0; e < 64; ++e) o[e] = 0.f;
        for (int sm = C.lane; sm < SS; sm += 64) {
            const bf16_t* krow = RQKV + (size_t)(b * SS + sm) * 3072 + 1024 + h * 256;
            float dot = 0.f;
#pragma unroll 4
            for (int c = 0; c < 32; ++c) { const u32x4 kv = *(const u32x4*)(krow + c * 8); const u32x4 qv = *(const LAS u32x4*)(qs + c * 16);
                dot += lo_bf(kv.x) * lo_bf(qv.x) + hi_bf(kv.x) * hi_bf(qv.x) + lo_bf(kv.y) * lo_bf(qv.y) + hi_bf(kv.y) * hi_bf(qv.y)
                     + lo_bf(kv.z) * lo_bf(qv.z) + hi_bf(kv.z) * hi_bf(qv.z) + lo_bf(kv.w) * lo_bf(qv.w) + hi_bf(kv.w) * hi_bf(qv.w); }
            const int pfm = sm, pbm = (sm < LC) ? (LC - 1 - sm) : (SS + LC - 1 - sm);
            float w = 0.f;
            if (pfn >= pfm) w += EX2(lgf * (float)(pfn - pfm));
            if (pbn >= pbm) w += EX2(lgb * (float)(pbn - pbm));
            const float ws_ = w * dot;
            const bf16_t* vrow = krow + 1024 + qd * 64;
#pragma unroll
            for (int c = 0; c < 8; ++c) { const u32x4 vv = *(const u32x4*)(vrow + c * 8);
                o[c * 8 + 0] += ws_ * lo_bf(vv.x); o[c * 8 + 1] += ws_ * hi_bf(vv.x); o[c * 8 + 2] += ws_ * lo_bf(vv.y); o[c * 8 + 3] += ws_ * hi_bf(vv.y);
                o[c * 8 + 4] += ws_ * lo_bf(vv.z); o[c * 8 + 5] += ws_ * hi_bf(vv.z); o[c * 8 + 6] += ws_ * lo_bf(vv.w); o[c * 8 + 7] += ws_ * hi_bf(vv.w); }
        }
        RS_STEP(o, 64, 32); RS_STEP(o, 32, 16); RS_STEP(o, 16, 8); RS_STEP(o, 8, 4); RS_STEP(o, 4, 2); RS_STEP(o, 2, 1);
        OI[(size_t)n * 1024 + h * 256 + qd * 64 + C.lane] = (bf16_t)f2bf(o[0]);
    }
}
__device__ __forceinline__ void phase_ret_ln(Ctx& C, int l, bf16_t* OI) {
    const float* gain = INP(16) + l * 1024;
    for (int m = C.gw; m < MR; m += C.ngw) {
#pragma unroll
        for (int h = 0; h < 4; ++h) { bf16_t* p = OI + (size_t)m * 1024 + h * 256 + C.lane * 4;
            const u32x2 w = *(const u32x2*)p; float x0 = lo_bf(w.x), x1 = hi_bf(w.x), x2 = lo_bf(w.y), x3 = hi_bf(w.y);
            const float mean = wave_sum((x0 + x1) + (x2 + x3)) * (1.f / 256.f);
            x0 -= mean; x1 -= mean; x2 -= mean; x3 -= mean;
            const float var = wave_sum((x0 * x0 + x1 * x1) + (x2 * x2 + x3 * x3)) * (1.f / 256.f);
            const float rstd = RSQ(var + EPS);
            const f32x4 g = *(const f32x4*)(gain + h * 256 + C.lane * 4);
            u32x2 o; o.x = pk2(x0 * rstd * g.x, x1 * rstd * g.y); o.y = pk2(x2 * rstd * g.z, x3 * rstd * g.w); *(u32x2*)p = o; }
    }
}

__device__ __forceinline__ void phase_md_post(Ctx& C, int l, bf16_t* MD) {
    const float* qn = INP(17) + l * 384; const float* kvn = INP(19) + l * 256; const float* gkr = INP(24) + l * 64;
    const float* cs = C.ctl + CT_ROPEM; const float* sn = cs + 1024;
    for (int m = C.gw; m < MR; m += C.ngw) {
        const int b = m / SS, s = m - b * SS; const bool lat = s >= LC; const int t = s - LC;
        bf16_t* row = MD + (size_t)m * 768;
        {   float x[6]; float ss = 0.f;
#pragma unroll
            for (int j = 0; j < 3; ++j) { const unsigned w = *(const unsigned*)(row + 2 * C.lane + 128 * j); x[2 * j] = lo_bf(w); x[2 * j + 1] = hi_bf(w); ss += x[2 * j] * x[2 * j] + x[2 * j + 1] * x[2 * j + 1]; }
            const float rstd = RSQ(wave_sum(ss) * (1.f / 384.f) + EPS);
#pragma unroll
            for (int j = 0; j < 3; ++j) { const int c = 2 * C.lane + 128 * j; *(unsigned*)(row + c) = pk2(x[2 * j] * rstd * qn[c], x[2 * j + 1] * rstd * qn[c + 1]); } }
        {   float x[4]; float ss = 0.f;
#pragma unroll
            for (int j = 0; j < 2; ++j) { const unsigned w = *(const unsigned*)(row + 384 + 2 * C.lane + 128 * j); x[2 * j] = lo_bf(w); x[2 * j + 1] = hi_bf(w); ss += x[2 * j] * x[2 * j] + x[2 * j + 1] * x[2 * j + 1]; }
            const float rstd = RSQ(wave_sum(ss) * (1.f / 256.f) + EPS);
#pragma unroll
            for (int j = 0; j < 2; ++j) { const int c = 2 * C.lane + 128 * j; *(unsigned*)(row + 384 + c) = pk2(x[2 * j] * rstd * kvn[c], x[2 * j + 1] * rstd * kvn[c + 1]); } }
        {   const float x = bf2f(row[640 + C.lane]);
            const float rstd = RSQ(wave_sum(x * x) * (1.f / 64.f) + EPS);
            float y = x * rstd * gkr[C.lane];
            if (lat) { const float pr = __shfl_xor(y, 16); const float rot = (C.lane & 16) ? pr : -pr; const int f = C.lane & 15, pos = (C.lane < 32) ? (t >> 6) : (t & 63);
                y = y * cs[pos * 16 + f] + rot * sn[pos * 16 + f]; }
            row[640 + C.lane] = (bf16_t)f2bf(y); }
    }
}
__device__ __forceinline__ void phase_qk_post(Ctx& C, int l, bf16_t* QN, bf16_t* QP, bf16_t* KV) {
    const float* gqn = INP(21) + l * 128; const float* gqr = INP(22) + l * 64; const float* gkn = INP(23) + l * 128;
    const float* cs = C.ctl + CT_ROPEM; const float* sn = cs + 1024;
    for (int m = C.gw; m < MR; m += C.ngw) {
        const int b = m / SS, s = m - b * SS; const bool lat = s >= LC; const int t = s - LC;
        bf16_t* qrow = QN + (size_t)m * 1024; bf16_t* prow = QP + (size_t)m * 512; bf16_t* krow = KV + (size_t)m * 2048;
#pragma unroll
        for (int h = 0; h < 8; ++h) {
            {   unsigned* p = (unsigned*)(qrow + h * 128 + 2 * C.lane); const unsigned w = *p; const float x0 = lo_bf(w), x1 = hi_bf(w);
                const float rstd = RSQ(wave_sum(x0 * x0 + x1 * x1) * (1.f / 128.f) + EPS);
                *p = pk2(x0 * rstd * gqn[2 * C.lane] * QSCALE, x1 * rstd * gqn[2 * C.lane + 1] * QSCALE); }
            {   bf16_t* p = prow + h * 64 + C.lane; const float x = bf2f(*p);
                const float rstd = RSQ(wave_sum(x * x) * (1.f / 64.f) + EPS);
                float y = x * rstd * gqr[C.lane];
                if (lat) { const float pr = __shfl_xor(y, 16); const float rot = (C.lane & 16) ? pr : -pr; const int f = C.lane & 15, pos = (C.lane < 32) ? (t >> 6) : (t & 63);
                    y = y * cs[pos * 16 + f] + rot * sn[pos * 16 + f]; }
                *p = (bf16_t)f2bf(y * QSCALE); }
            {   unsigned* p = (unsigned*)(krow + h * 128 + 2 * C.lane); const unsigned w = *p; const float x0 = lo_bf(w), x1 = hi_bf(w);
                const float rstd = RSQ(wave_sum(x0 * x0 + x1 * x1) * (1.f / 128.f) + EPS);
                *p = pk2(x0 * rstd * gkn[2 * C.lane], x1 * rstd * gkn[2 * C.lane + 1]); }
        }
    }
}

__device__ __forceinline__ void phase_attn_naive(Ctx& C, bool with_ctx, bf16_t* QN, const bf16_t* QP, const bf16_t* KV, const bf16_t* MD) {
    LAS unsigned char* qs = C.lds + C.wave * 512;
    const int nlat = NB * 8 * (TT / 8), nctx = with_ctx ? NB * 8 * (LC / 8) : 0;
    for (int bu = C.bid; bu < nlat + nctx; bu += C.G) {
        int b, h, s, nkeys;
        if (bu < nlat) { const int tb = bu % (TT / 8), bh = bu / (TT / 8); b = bh >> 3; h = bh & 7; s = LC + tb * 8 + C.wave; nkeys = SS; }
        else { const int r = bu - nlat, tb = r % (LC / 8), bh = r / (LC / 8); b = bh >> 3; h = bh & 7; s = tb * 8 + C.wave; nkeys = LC; }
        const size_t m = (size_t)b * SS + s;
        asm volatile("s_waitcnt lgkmcnt(0)" ::: "memory");
        if (C.lane < 32) *(LAS u32x2*)(qs + C.lane * 8) = *(const u32x2*)(QN + m * 1024 + h * 128 + C.lane * 4);
        else if (C.lane < 48) *(LAS u32x2*)(qs + 256 + (C.lane - 32) * 8) = *(const u32x2*)(QP + m * 512 + h * 64 + (C.lane - 32) * 4);
        asm volatile("s_waitcnt lgkmcnt(0)" ::: "memory");
        float o[128];
#pragma unroll
        for (int e = 0; e < 128; ++e) o[e] = 0.f;
        float mrun = -1e30f, lrun = 0.f;
        for (int key = C.lane; key < nkeys; key += 64) {
            const size_t kr = (size_t)b * SS + key;
            const bf16_t* kn = KV + kr * 2048 + h * 128; const bf16_t* kro = MD + kr * 768 + 640;
            float dot = 0.f;
#pragma unroll 4
            for (int c = 0; c < 16; ++c) { const u32x4 kv = *(const u32x4*)(kn + c * 8); const u32x4 qv = *(const LAS u32x4*)(qs + c * 16);
                dot += lo_bf(kv.x) * lo_bf(qv.x) + hi_bf(kv.x) * hi_bf(qv.x) + lo_bf(kv.y) * lo_bf(qv.y) + hi_bf(kv.y) * hi_bf(qv.y)
                     + lo_bf(kv.z) * lo_bf(qv.z) + hi_bf(kv.z) * hi_bf(qv.z) + lo_bf(kv.w) * lo_bf(qv.w) + hi_bf(kv.w) * hi_bf(qv.w); }
#pragma unroll 4
            for (int c = 0; c < 8; ++c) { const u32x4 kv = *(const u32x4*)(kro + c * 8); const u32x4 qv = *(const LAS u32x4*)(qs + 256 + c * 16);
                dot += lo_bf(kv.x) * lo_bf(qv.x) + hi_bf(kv.x) * hi_bf(qv.x) + lo_bf(kv.y) * lo_bf(qv.y) + hi_bf(kv.y) * hi_bf(qv.y)
                     + lo_bf(kv.z) * lo_bf(qv.z) + hi_bf(kv.z) * hi_bf(qv.z) + lo_bf(kv.w) * lo_bf(qv.w) + hi_bf(kv.w) * hi_bf(qv.w); }
            const float mnew = fmaxf(mrun, dot), alpha = EX2(mrun - mnew), p = EX2(dot - mnew);
            lrun = lrun * alpha + p; mrun = mnew;
            const bf16_t* vrow = KV + kr * 2048 + 1024 + h * 128;
#pragma unroll
            for (int c = 0; c < 16; ++c) { const u32x4 vv = *(const u32x4*)(vrow + c * 8);
                o[c * 8 + 0] = o[c * 8 + 0] * alpha + p * lo_bf(vv.x); o[c * 8 + 1] = o[c * 8 + 1] * alpha + p * hi_bf(vv.x);
                o[c * 8 + 2] = o[c * 8 + 2] * alpha + p * lo_bf(vv.y); o[c * 8 + 3] = o[c * 8 + 3] * alpha + p * hi_bf(vv.y);
                o[c * 8 + 4] = o[c * 8 + 4] * alpha + p * lo_bf(vv.z); o[c * 8 + 5] = o[c * 8 + 5] * alpha + p * hi_bf(vv.z);
                o[c * 8 + 6] = o[c * 8 + 6] * alpha + p * lo_bf(vv.w); o[c * 8 + 7] = o[c * 8 + 7] * alpha + p * hi_bf(vv.w); }
        }
        const float mall = wave_max(mrun), fsc = EX2(mrun - mall);
        const float lall = wave_sum(lrun * fsc);
#pragma unroll
        for (int e = 0; e < 128; ++e) o[e] *= fsc;
        RS_STEP(o, 128, 32); RS_STEP(o, 64, 16); RS_STEP(o, 32, 8); RS_STEP(o, 16, 4); RS_STEP(o, 8, 2); RS_STEP(o, 4, 1);
        const float inv = 1.f / lall;
        *(unsigned*)(QN + m * 1024 + h * 128 + 2 * C.lane) = pk2(o[0] * inv, o[1] * inv);
    }
}

__device__ __forceinline__ void phase_conv(Ctx& C, int l, const bf16_t* XA, bf16_t* U) {
    const float* cw = INP(8) + l * 4 * 1024; const float* cb = INP(9) + l * 1024;
    const int gt = C.bid * NTHR + C.tid, ngt = C.G * NTHR;
    for (int it = gt; it < MR * 128; it += ngt) {
        const int m = it >> 7, c0 = (it & 127) * 8, b = m / SS, s = m - b * SS;
        const int lo = (s < LC) ? 0 : LC, hi = (s < LC) ? LC : SS;
        float a[8];
#pragma unroll
        for (int e = 0; e < 8; ++e) a[e] = cb[c0 + e];
#pragma unroll
        for (int j = 0; j < 4; ++j) { const int sj = s + j - 2;
            if (sj >= lo && sj < hi) { const u32x4 xv = *(const u32x4*)(XA + (size_t)(b * SS + sj) * 1024 + c0); const float* w = cw + j * 1024 + c0;
                a[0] += w[0] * lo_bf(xv.x); a[1] += w[1] * hi_bf(xv.x); a[2] += w[2] * lo_bf(xv.y); a[3] += w[3] * hi_bf(xv.y);
                a[4] += w[4] * lo_bf(xv.z); a[5] += w[5] * hi_bf(xv.z); a[6] += w[6] * lo_bf(xv.w); a[7] += w[7] * hi_bf(xv.w); } }
        u32x4 o; o.x = pk2(a[0], a[1]); o.y = pk2(a[2], a[3]); o.z = pk2(a[4], a[5]); o.w = pk2(a[6], a[7]);
        *(u32x4*)(U + (size_t)m * 1024 + c0) = o;
    }
}
typedef f16_t f16x2 __attribute__((ext_vector_type(2)));
__device__ __forceinline__ void phase_scan1(Ctx& C, int d, const f16_t* RI, float* SUM) {
    for (int un = C.gw; un < NB * 68 * 8; un += C.ngw) {
        const int cg_ = un & 7, sg = (un >> 3) % 68, b = (un >> 3) / 68, ch = cg_ * 128 + 2 * C.lane;
        float A0 = 1.f, A1 = 1.f, H0 = 0.f, H1 = 0.f;
        const f16_t* base = RI + (size_t)(b * SS + sg * 64) * 2048 + ch;
#pragma unroll 16
        for (int i = 0; i < 64; ++i) { const int r = d ? (63 - i) : i;
            const f16x2 la = *(const f16x2*)(base + (size_t)r * 2048), bc = *(const f16x2*)(base + (size_t)r * 2048 + 1024);
            const float a0 = EX2((float)la[0]), a1 = EX2((float)la[1]);
            H0 = a0 * H0 + (float)bc[0]; H1 = a1 * H1 + (float)bc[1]; A0 *= a0; A1 *= a1; }
        float* sp = SUM + ((size_t)(b * 68 + sg) * 1024 + ch) * 2;
        *(f32x4*)sp = (f32x4){A0, H0, A1, H1};
    }
}
__device__ __forceinline__ void phase_scan3(Ctx& C, int d, const f16_t* RI, const float* SUM, bf16_t* YA) {
    for (int un = C.gw; un < NB * 68 * 8; un += C.ngw) {
        const int cg_ = un & 7, sg = (un >> 3) % 68, b = (un >> 3) / 68, ch = cg_ * 128 + 2 * C.lane;
        float H0 = 0.f, H1 = 0.f;
        const int npre = d ? ((sg < 4) ? (3 - sg) : (71 - sg)) : sg;
#pragma unroll 4
        for (int p = 0; p < npre; ++p) { const int ps = d ? ((p < 4) ? (3 - p) : (71 - p)) : p;
            const f32x4 v = *(const f32x4*)(SUM + ((size_t)(b * 68 + ps) * 1024 + ch) * 2);
            H0 = v[0] * H0 + v[1]; H1 = v[2] * H1 + v[3]; }
        const f16_t* base = RI + (size_t)(b * SS + sg * 64) * 2048 + ch;
        bf16_t* yb = YA + (size_t)(b * SS + sg * 64) * 1024 + ch;
#pragma unroll 16
        for (int i = 0; i < 64; ++i) { const int r = d ? (63 - i) : i;
            const f16x2 la = *(const f16x2*)(base + (size_t)r * 2048), bc = *(const f16x2*)(base + (size_t)r * 2048 + 1024);
            const float a0 = EX2((float)la[0]), a1 = EX2((float)la[1]);
            H0 = a0 * H0 + (float)bc[0]; H1 = a1 * H1 + (float)bc[1];
            unsigned* yp = (unsigned*)(yb + (size_t)r * 1024);
            if (d == 0) *yp = pk2(H0, H1); else { const unsigned w = *yp; *yp = pk2(lo_bf(w) + H0, hi_bf(w) + H1); } }
    }
}

typedef float f32x16 __attribute__((ext_vector_type(16)));
typedef short v4i16_t __attribute__((ext_vector_type(4)));
constexpr int AT_KP = 400, AT_VP = 320;
constexpr int AT_KB = 64 * AT_KP, AT_VB = 64 * AT_VP, AT_STG = AT_KB + AT_VB, AT_WSF = 2 * AT_STG;
__device__ __forceinline__ int crow(int r, int hi) { return (r & 3) + 8 * (r >> 2) + 4 * hi; }
__device__ __forceinline__ bf16x8 pack8(float a, float b, float c, float d, float e, float f, float g, float h) {
    u32x4 w; w.x = pg8::cvt_pk_bf16(a, b); w.y = pg8::cvt_pk_bf16(c, d); w.z = pg8::cvt_pk_bf16(e, f); w.w = pg8::cvt_pk_bf16(g, h); return __builtin_bit_cast(bf16x8, w); }
__device__ __forceinline__ bf16x8 tr2(LAS unsigned char* p0, LAS unsigned char* p1) {
    const v4i16_t lo = __builtin_amdgcn_ds_read_tr16_b64_v4i16((LAS v4i16_t*)p0), hi = __builtin_amdgcn_ds_read_tr16_b64_v4i16((LAS v4i16_t*)p1);
    return (bf16x8){lo[0], lo[1], lo[2], lo[3], hi[0], hi[1], hi[2], hi[3]}; }

__device__ __forceinline__ void phase_attn(Ctx& C, bool with_ctx, bf16_t* QN, const bf16_t* QP, const bf16_t* KV, const bf16_t* MD) {
    const int lane = C.lane, r32 = lane & 31, hi = lane >> 5, wave = C.wave, tid = C.tid;
    LAS unsigned char* lds = C.lds;
    LAS float* wsf = (LAS float*)(lds + AT_WSF + wave * 128);
    const int nunits = 512 + (with_ctx ? 32 : 0);
    const int rowA = tid >> 4, ccA = tid & 15, rowR = tid >> 3, ccR = tid & 7;
    const int i16 = lane & 15, q4 = i16 >> 2, p4 = i16 & 3, g1 = (lane >> 4) & 1;
    const int vb = AT_KB + (4 * hi + q4) * AT_VP + (16 * g1 + 4 * p4) * 2;
    for (int un = C.bid; un < nunits; un += C.G) {
        int bh, qb, isctx;
        if (un < 512) { const int x = un & 7, jj = un >> 3; bh = x * 4 + (jj >> 4); qb = jj & 15; isctx = 0; } else { bh = un - 512; qb = 0; isctx = 1; }
        const int b = bh >> 3, h = bh & 7;
        const size_t kb0 = (size_t)b * SS;
        const size_t m0 = kb0 + (isctx ? 0 : LC + qb * 256) + wave * 32;
        const int NT = (isctx ? LC : SS) / 64;
        bf16x8 qf[12];
        {   const bf16_t* qn = QN + (m0 + r32) * 1024 + h * 128 + hi * 8; const bf16_t* qp = QP + (m0 + r32) * 512 + h * 64 + hi * 8;
#pragma unroll
            for (int s = 0; s < 8; ++s) qf[s] = *(const bf16x8*)(qn + s * 16);
#pragma unroll
            for (int s = 0; s < 4; ++s) qf[8 + s] = *(const bf16x8*)(qp + s * 16); }
        f32x16 o[4];
#pragma unroll
        for (int d = 0; d < 4; ++d)
#pragma unroll
            for (int r = 0; r < 16; ++r) o[d][r] = 0.f;
        float mrun = -1e30f, lrun = 0.f;
        u32x4 kn0, kn1, kr0, vv0, vv1;
        const bf16_t* kvp = KV + (kb0 + rowA) * 2048 + h * 128 + ccA * 8;
        const bf16_t* krp = MD + (kb0 + rowR) * 768 + 640 + ccR * 8;
#define AT_LOAD(t) do { const bf16_t* kp_ = kvp + (size_t)(t) * 64 * 2048; kn0 = *(const u32x4*)kp_; kn1 = *(const u32x4*)(kp_ + 32 * 2048); vv0 = *(const u32x4*)(kp_ + 1024); vv1 = *(const u32x4*)(kp_ + 32 * 2048 + 1024); \
        kr0 = *(const u32x4*)(krp + (size_t)(t) * 64 * 768); } while (0)
#define AT_WRITE(sb) do { LAS unsigned char* s_ = lds + (sb); *(LAS u32x4*)(s_ + rowA * AT_KP + ccA * 16) = kn0; *(LAS u32x4*)(s_ + (rowA + 32) * AT_KP + ccA * 16) = kn1; \
        *(LAS u32x4*)(s_ + rowR * AT_KP + 256 + ccR * 16) = kr0; *(LAS u32x4*)(s_ + AT_KB + rowA * AT_VP + ccA * 16) = vv0; *(LAS u32x4*)(s_ + AT_KB + (rowA + 32) * AT_VP + ccA * 16) = vv1; } while (0)
        AT_LOAD(0); AT_WRITE(0);
        __syncthreads();
        for (int t = 0; t < NT; ++t) {
            const int sb = (t & 1) * AT_STG;
            if (t + 1 < NT) AT_LOAD(t + 1);
            f32x16 p0, p1;
#pragma unroll
            for (int r = 0; r < 16; ++r) { p0[r] = 0.f; p1[r] = 0.f; }
            {   LAS unsigned char* ka = lds + sb + r32 * AT_KP + hi * 16;
#pragma unroll
                for (int s = 0; s < 12; ++s) { const bf16x8 a0 = *(const LAS bf16x8*)(ka + s * 32), a1 = *(const LAS bf16x8*)(ka + 32 * AT_KP + s * 32);
                    p0 = __builtin_amdgcn_mfma_f32_32x32x16_bf16(a0, qf[s], p0, 0, 0, 0); p1 = __builtin_amdgcn_mfma_f32_32x32x16_bf16(a1, qf[s], p1, 0, 0, 0);
                    if ((s & 3) == 3) asm volatile("" ::: "memory"); } }
            float rm = fmaxf(p0[0], p1[0]);
#pragma unroll
            for (int r = 1; r < 16; ++r) rm = fmaxf(rm, fmaxf(p0[r], p1[r]));
            rm = fmaxf(rm, __shfl_xor(rm, 32));
            const float mnew = fmaxf(mrun, rm), alpha = EX2(mrun - mnew); mrun = mnew;
            float ls = 0.f;
#pragma unroll
            for (int r = 0; r < 16; ++r) { p0[r] = EX2(p0[r] - mnew); p1[r] = EX2(p1[r] - mnew); ls += p0[r] + p1[r]; }
            lrun = lrun * alpha + ls;
            if (hi == 0) wsf[r32] = alpha;
            const bf16x8 pa0 = pack8(p0[0], p0[1], p0[2], p0[3], p0[4], p0[5], p0[6], p0[7]), pa1 = pack8(p0[8], p0[9], p0[10], p0[11], p0[12], p0[13], p0[14], p0[15]);
            const bf16x8 pa2 = pack8(p1[0], p1[1], p1[2], p1[3], p1[4], p1[5], p1[6], p1[7]), pa3 = pack8(p1[8], p1[9], p1[10], p1[11], p1[12], p1[13], p1[14], p1[15]);
#pragma unroll
            for (int r = 0; r < 16; ++r) { const float a = wsf[crow(r, hi)];
#pragma unroll
                for (int d = 0; d < 4; ++d) o[d][r] *= a; }
            {   LAS unsigned char* vp = lds + sb + vb;
#pragma unroll
                for (int d = 0; d < 4; ++d) {
                    o[d] = __builtin_amdgcn_mfma_f32_32x32x16_bf16(pa0, tr2(vp + d * 64, vp + d * 64 + 8 * AT_VP), o[d], 0, 0, 0);
                    o[d] = __builtin_amdgcn_mfma_f32_32x32x16_bf16(pa1, tr2(vp + d * 64 + 16 * AT_VP, vp + d * 64 + 24 * AT_VP), o[d], 0, 0, 0);
                    o[d] = __builtin_amdgcn_mfma_f32_32x32x16_bf16(pa2, tr2(vp + d * 64 + 32 * AT_VP, vp + d * 64 + 40 * AT_VP), o[d], 0, 0, 0);
                    o[d] = __builtin_amdgcn_mfma_f32_32x32x16_bf16(pa3, tr2(vp + d * 64 + 48 * AT_VP, vp + d * 64 + 56 * AT_VP), o[d], 0, 0, 0);
                    asm volatile("" ::: "memory"); } }
            if (t + 1 < NT) AT_WRITE(AT_STG - sb);
            __syncthreads();
        }
#undef AT_LOAD
#undef AT_WRITE
        const float ltot = lrun + __shfl_xor(lrun, 32);
        if (hi == 0) wsf[r32] = 1.f / ltot;
        bf16_t* op = QN + (m0 + 4 * hi) * 1024 + h * 128 + r32;
#pragma unroll
        for (int r = 0; r < 16; ++r) { const float inv = wsf[crow(r, hi)];
#pragma unroll
            for (int d = 0; d < 4; ++d) op[d * 32] = (bf16_t)f2bf(o[d][r] * inv);
            op += ((r & 3) == 3) ? 5 * 1024 : 1024; asm volatile("" : "+v"(op)); }
        __syncthreads();
    }
}

constexpr int RI_KP = 528, RI_VP = 576, RI_PTP = 272;
constexpr int RI_A = 0, RI_PT = 128 * RI_VP;
__device__ __forceinline__ void phase_ret_intra(Ctx& C, int l, const bf16_t* RQKV, bf16_t* OI) {
    const int lane = C.lane, r32 = lane & 31, hi = lane >> 5, wave = C.wave, tid = C.tid;
    LAS unsigned char* lds = C.lds;
    const int i16 = lane & 15, q4 = i16 >> 2, p4 = i16 & 3, g1 = (lane >> 4) & 1;
    const int nb = wave & 3, wh = wave >> 2;
    const int srow = tid >> 5, scc = tid & 31;
    for (int un = C.bid; un < NB * 4 * 34; un += C.G) {
        const int c = un % 34, bh = un / 34, b = bh >> 2, h = bh & 3;
        const size_t row0 = (size_t)b * SS + c * 128;
        const float lgf = C.ctl[CT_LG + (l * 2 + 0) * 4 + h], lgb = C.ctl[CT_LG + (l * 2 + 1) * 4 + h];
        const bf16_t* gk = RQKV + (row0 + srow) * 3072 + 1024 + h * 256 + scc * 8;
        u32x4 st[8];
        {   const bf16_t* gp = gk;
#pragma unroll
            for (int j = 0; j < 8; ++j) { st[j] = *(const u32x4*)gp; gp += 16 * 3072; asm volatile("" : "+v"(gp)); } }
#pragma unroll
        for (int j = 0; j < 8; ++j) *(LAS u32x4*)(lds + RI_A + (srow + 16 * j) * RI_KP + scc * 16) = st[j];
        __syncthreads();
        {   const bf16_t* gp = gk + 1024;
#pragma unroll
            for (int j = 0; j < 8; ++j) { st[j] = *(const u32x4*)gp; gp += 16 * 3072; asm volatile("" : "+v"(gp)); } }
        {
            f32x16 x0, x1;
#pragma unroll
            for (int r = 0; r < 16; ++r) { x0[r] = 0.f; x1[r] = 0.f; }
            const bf16_t* gq = RQKV + (row0 + nb * 32 + r32) * 3072 + h * 256 + hi * 8;
            LAS unsigned char* ka = lds + RI_A + (wh * 64 + r32) * RI_KP + hi * 16;
#pragma unroll
            for (int s = 0; s < 16; ++s) { const bf16x8 qf = *(const bf16x8*)(gq + s * 16);
                const bf16x8 a0 = *(const LAS bf16x8*)(ka + s * 32), a1 = *(const LAS bf16x8*)(ka + 32 * RI_KP + s * 32);
                x0 = __builtin_amdgcn_mfma_f32_32x32x16_bf16(a0, qf, x0, 0, 0, 0); x1 = __builtin_amdgcn_mfma_f32_32x32x16_bf16(a1, qf, x1, 0, 0, 0);
                if ((s & 3) == 3) asm volatile("" ::: "memory"); }
            const int n = nb * 32 + r32;
            LAS unsigned char* pt = lds + RI_PT + n * RI_PTP + (wh * 64 + 4 * hi) * 2;
#pragma unroll
            for (int g = 0; g < 4; ++g) { float w0[4], w1[4];
#pragma unroll
                for (int e = 0; e < 4; ++e) { const int m0 = wh * 64 + 8 * g + 4 * hi + e; const float d0 = (float)(n - m0), d1 = d0 - 32.f;
                    const float f0 = (d0 >= 0.f ? EX2(lgf * d0) : 0.f) + (d0 <= 0.f ? EX2(-lgb * d0) : 0.f);
                    const float f1 = (d1 >= 0.f ? EX2(lgf * d1) : 0.f) + (d1 <= 0.f ? EX2(-lgb * d1) : 0.f);
                    w0[e] = x0[4 * g + e] * f0; w1[e] = x1[4 * g + e] * f1; }
                u32x2 o0, o1; o0.x = pg8::cvt_pk_bf16(w0[0], w0[1]); o0.y = pg8::cvt_pk_bf16(w0[2], w0[3]); o1.x = pg8::cvt_pk_bf16(w1[0], w1[1]); o1.y = pg8::cvt_pk_bf16(w1[2], w1[3]);
                *(LAS u32x2*)(pt + g * 16) = o0; *(LAS u32x2*)(pt + 64 + g * 16) = o1; }
        }
        __syncthreads();
#pragma unroll
        for (int j = 0; j < 8; ++j) *(LAS u32x4*)(lds + RI_A + (srow + 16 * j) * RI_VP + scc * 16) = st[j];
        __syncthreads();
        {
            f32x16 o[4];
#pragma unroll
            for (int d = 0; d < 4; ++d)
#pragma unroll
                for (int r = 0; r < 16; ++r) o[d][r] = 0.f;
            bf16x8 pa[8];
            LAS unsigned char* pr = lds + RI_PT + (nb * 32 + r32) * RI_PTP + hi * 16;
#pragma unroll
            for (int s = 0; s < 8; ++s) pa[s] = *(const LAS bf16x8*)(pr + s * 32);
            LAS unsigned char* vp = lds + RI_A + (8 * hi + q4) * RI_VP + (wh * 128 + 16 * g1 + 4 * p4) * 2;
#pragma unroll
            for (int d = 0; d < 4; ++d) {
#pragma unroll
                for (int s = 0; s < 8; ++s) o[d] = __builtin_amdgcn_mfma_f32_32x32x16_bf16(pa[s], tr2(vp + d * 64 + s * 16 * RI_VP, vp + d * 64 + (s * 16 + 4) * RI_VP), o[d], 0, 0, 0);
                asm volatile("" ::: "memory"); }
            bf16_t* op = OI + (row0 + nb * 32 + 4 * hi) * 1024 + h * 256 + wh * 128 + r32;
#pragma unroll
            for (int r = 0; r < 16; ++r) {
#pragma unroll
                for (int d = 0; d < 4; ++d) op[d * 32] = (bf16_t)f2bf(o[d][r]);
                op += ((r & 3) == 3) ? 5 * 1024 : 1024; asm volatile("" : "+v"(op)); }
        }
        __syncthreads();
    }
}

constexpr int RC_KT = 0, RC_KTP = 576, RC_VT = 128 * 576, RC_VTP = 64, RC_ST = RC_VT + 128 * 64, RC_STP = 528, RC_XO = RC_ST + 32 * 528, RC_END = RC_XO + 16384;
static_assert(RC_END <= 131072, "R-chain LDS");
__device__ __forceinline__ void phase_ret_chain(Ctx& C, int l, const bf16_t* RQKV, bf16_t* OI, bf16_t* OB) {
    const int lane = C.lane, r32 = lane & 31, hi = lane >> 5, wave = C.wave, tid = C.tid;
    LAS unsigned char* lds = C.lds;
    const int i16 = lane & 15, q4 = i16 >> 2, p4 = i16 & 3, g1 = (lane >> 4) & 1;
    const int nb = wave & 3, dh = wave >> 2;
    const int srow = tid >> 5, scc = tid & 31, vrow = tid >> 2, vcc = tid & 3;
    for (int un = C.bid; un < 256; un += C.G) {
        const int x = un & 7, j8 = un >> 3, bhd = x * 4 + (j8 >> 3), sl = j8 & 7, b = bhd >> 3, h = (bhd >> 1) & 3, dir = bhd & 1;
        const float lg = C.ctl[CT_LG + (l * 2 + dir) * 4 + h];
        const float cdec = EX2(lg * 128.f);
        const float vdec = dir ? EX2(lg * (float)vrow) : EX2(lg * (float)(127 - vrow));
        f32x16 sacc;
#pragma unroll
        for (int r = 0; r < 16; ++r) sacc[r] = 0.f;
        for (int i = tid; i < 32 * RC_STP / 16; i += NTHR) *(LAS u32x4*)(lds + RC_ST + i * 16) = (u32x4){0u, 0u, 0u, 0u};
        u32x4 st[8]; u32x4 sv;
#define RC_LOAD(cc_) do { const size_t r0_ = (size_t)b * SS + (cc_) * 128; const bf16_t* gk_ = RQKV + (r0_ + srow) * 3072 + 1024 + h * 256 + scc * 8; \
        _Pragma("unroll") for (int j = 0; j < 8; ++j) { st[j] = *(const u32x4*)gk_; gk_ += 16 * 3072; asm volatile("" : "+v"(gk_)); } \
        sv = *(const u32x4*)(RQKV + (r0_ + vrow) * 3072 + 2048 + h * 256 + sl * 32 + vcc * 8); } while (0)
#define RC_WRITE() do { _Pragma("unroll") for (int j = 0; j < 8; ++j) *(LAS u32x4*)(lds + RC_KT + (srow + 16 * j) * RC_KTP + scc * 16) = st[j]; \
        u32x4 w_; w_.x = pg8::cvt_pk_bf16(lo_bf(sv.x) * vdec, hi_bf(sv.x) * vdec); w_.y = pg8::cvt_pk_bf16(lo_bf(sv.y) * vdec, hi_bf(sv.y) * vdec); \
        w_.z = pg8::cvt_pk_bf16(lo_bf(sv.z) * vdec, hi_bf(sv.z) * vdec); w_.w = pg8::cvt_pk_bf16(lo_bf(sv.w) * vdec, hi_bf(sv.w) * vdec); \
        *(LAS u32x4*)(lds + RC_VT + vrow * RC_VTP + vcc * 16) = w_; } while (0)
        bf16x8 qa[8];
#define RC_QLOAD(dst, cc_) do { const bf16_t* gq_ = RQKV + ((size_t)b * SS + (cc_) * 128 + nb * 32 + r32) * 3072 + h * 256 + dh * 128 + hi * 8; \
        _Pragma("unroll") for (int s = 0; s < 8; ++s) dst[s] = *(const bf16x8*)(gq_ + s * 16); } while (0)
        {   const int c0 = dir ? 1 : 0; RC_LOAD(c0); RC_WRITE(); RC_QLOAD(qa, c0); }
        __syncthreads();
        for (int i = 0; i < 34; ++i) {
            const int c = dir ? ((i < 2) ? (1 - i) : (35 - i)) : i;
            const size_t r0 = (size_t)b * SS + c * 128;
            const int cn = (i + 1 < 34) ? (dir ? ((i + 1 < 2) ? (1 - (i + 1)) : (35 - (i + 1))) : (i + 1)) : c;
            if (i + 1 < 34) RC_LOAD(cn);
            unsigned short oiv[16];
            if (dh == 0 && dir == 0) { const bf16_t* ip = OI + (r0 + nb * 32 + 4 * hi) * 1024 + h * 256 + sl * 32 + r32;
#pragma unroll
                for (int r = 0; r < 16; ++r) oiv[r] = ip[(size_t)((r & 3) + 8 * (r >> 2)) * 1024]; }
            f32x16 oacc;
#pragma unroll
            for (int r = 0; r < 16; ++r) oacc[r] = 0.f;
            {   LAS unsigned char* sb = lds + RC_ST + r32 * RC_STP + (dh * 128 + hi * 8) * 2;
#pragma unroll
                for (int s = 0; s < 8; ++s) { const bf16x8 sbf = *(const LAS bf16x8*)(sb + s * 32);
                    oacc = __builtin_amdgcn_mfma_f32_32x32x16_bf16(qa[s], sbf, oacc, 0, 0, 0); } }
            asm volatile("" ::: "memory");
            RC_QLOAD(qa, cn);
#pragma unroll
            for (int r = 0; r < 16; ++r) sacc[r] *= cdec;
            {   LAS unsigned char* kp = lds + RC_KT + (8 * hi + q4) * RC_KTP + (wave * 32 + 16 * g1 + 4 * p4) * 2;
                LAS unsigned char* vp = lds + RC_VT + (8 * hi + q4) * RC_VTP + (16 * g1 + 4 * p4) * 2;
#pragma unroll
                for (int s = 0; s < 8; ++s) sacc = __builtin_amdgcn_mfma_f32_32x32x16_bf16(tr2(kp + s * 16 * RC_KTP, kp + (s * 16 + 4) * RC_KTP), tr2(vp + s * 16 * RC_VTP, vp + (s * 16 + 4) * RC_VTP), sacc, 0, 0, 0); }
            if (dh == 1) {
#pragma unroll
                for (int r = 0; r < 16; ++r) *(LAS float*)(lds + RC_XO + nb * 4096 + r * 256 + lane * 4) = oacc[r]; }
            __syncthreads();
            if (dh == 0) {
                bf16_t* op = (dir ? OB : OI) + (r0 + nb * 32 + 4 * hi) * 1024 + h * 256 + sl * 32 + r32;
#pragma unroll
                for (int r = 0; r < 16; ++r) { const int n = nb * 32 + crow(r, hi);
                    const float qd = dir ? EX2(lg * (float)(128 - n)) : EX2(lg * (float)(n + 1));
                    float v = (oacc[r] + *(const LAS float*)(lds + RC_XO + nb * 4096 + r * 256 + lane * 4)) * qd;
                    if (dir == 0) v += bf2f(oiv[r]);
                    *op = (bf16_t)f2bf(v);
                    op += ((r & 3) == 3) ? 5 * 1024 : 1024; asm volatile("" : "+v"(op)); }
            }
            {   LAS unsigned char* sp = lds + RC_ST + r32 * RC_STP + (wave * 32 + 4 * hi) * 2;
#pragma unroll
                for (int g = 0; g < 4; ++g) { u32x2 o2; o2.x = pg8::cvt_pk_bf16(sacc[4 * g], sacc[4 * g + 1]); o2.y = pg8::cvt_pk_bf16(sacc[4 * g + 2], sacc[4 * g + 3]); *(LAS u32x2*)(sp + g * 16) = o2; } }
            if (i + 1 < 34) RC_WRITE();
            __syncthreads();
        }
#undef RC_QLOAD
#undef RC_LOAD
#undef RC_WRITE
    }
}
__device__ __forceinline__ void phase_ret_ln2(Ctx& C, int l, bf16_t* OI, const bf16_t* OB) {
    const float* gain = INP(16) + l * 1024;
    for (int m = C.gw; m < MR; m += C.ngw) {
#pragma unroll
        for (int h = 0; h < 4; ++h) { bf16_t* p = OI + (size_t)m * 1024 + h * 256 + C.lane * 4;
            const u32x2 w = *(const u32x2*)p, w2 = *(const u32x2*)(OB + (size_t)m * 1024 + h * 256 + C.lane * 4);
            float x0 = lo_bf(w.x) + lo_bf(w2.x), x1 = hi_bf(w.x) + hi_bf(w2.x), x2 = lo_bf(w.y) + lo_bf(w2.y), x3 = hi_bf(w.y) + hi_bf(w2.y);
            const float mean = wave_sum((x0 + x1) + (x2 + x3)) * (1.f / 256.f);
            x0 -= mean; x1 -= mean; x2 -= mean; x3 -= mean;
            const float var = wave_sum((x0 * x0 + x1 * x1) + (x2 * x2 + x3 * x3)) * (1.f / 256.f);
            const float rstd = RSQ(var + EPS);
            const f32x4 g = *(const f32x4*)(gain + h * 256 + C.lane * 4);
            u32x2 o; o.x = pk2(x0 * rstd * g.x, x1 * rstd * g.y); o.y = pk2(x2 * rstd * g.z, x3 * rstd * g.w); *(u32x2*)p = o; }
    }
}

template <int W> __device__ __forceinline__ float group_sum(float v) {
#pragma unroll
    for (int o = 1; o < W; o <<= 1) v += __shfl_xor(v, o);
    return v;
}
__device__ __forceinline__ void unpack8(const u32x4& w, float (&x)[8]) { x[0] = lo_bf(w.x); x[1] = hi_bf(w.x); x[2] = lo_bf(w.y); x[3] = hi_bf(w.y); x[4] = lo_bf(w.z); x[5] = hi_bf(w.z); x[6] = lo_bf(w.w); x[7] = hi_bf(w.w); }
__device__ __forceinline__ u32x4 pack8u(const float (&x)[8]) { u32x4 w; w.x = pk2(x[0], x[1]); w.y = pk2(x[2], x[3]); w.z = pk2(x[4], x[5]); w.w = pk2(x[6], x[7]); return w; }
__device__ __forceinline__ float sumsq8(const float (&x)[8]) { return ((x[0] * x[0] + x[1] * x[1]) + (x[2] * x[2] + x[3] * x[3])) + ((x[4] * x[4] + x[5] * x[5]) + (x[6] * x[6] + x[7] * x[7])); }

__device__ __forceinline__ void phase_h2(Ctx& C, int l, bf16_t* H) {
    const float* gain = INP(6) + l * 1024;
    for (int m0 = C.gw * 2; m0 < MR; m0 += C.ngw * 2) {
        f32x4 v[2][4]; float ss[2];
#pragma unroll
        for (int q = 0; q < 2; ++q) { const float* xr = resid_row(C, l, m0 + q);
#pragma unroll
            for (int j = 0; j < 4; ++j) v[q][j] = *(const f32x4*)(xr + 4 * C.lane + 256 * j); }
        const int b = m0 / SS, s = m0 - b * SS, r = (s < LC) ? 4 : b;
        const float* mod = C.ctl + CT_MOD + (l * 5 + r) * 3072;
#pragma unroll
        for (int q = 0; q < 2; ++q) { float a = 0.f;
#pragma unroll
            for (int j = 0; j < 4; ++j) a += (v[q][j].x * v[q][j].x + v[q][j].y * v[q][j].y) + (v[q][j].z * v[q][j].z + v[q][j].w * v[q][j].w);
            ss[q] = a; }
        ss[0] = wave_sum(ss[0]); ss[1] = wave_sum(ss[1]);
#pragma unroll
        for (int j = 0; j < 4; ++j) { const int c = 4 * C.lane + 256 * j;
            const f32x4 g = *(const f32x4*)(gain + c), sh = *(const f32x4*)(mod + c), sc = *(const f32x4*)(mod + 1024 + c) + 1.0f;
#pragma unroll
            for (int q = 0; q < 2; ++q) { const float rstd = RSQ(ss[q] * (1.f / 1024.f) + EPS);
                const f32x4 o = ((v[q][j] * rstd) * g) * sc + sh;
                u32x2 w; w.x = pk2(o.x, o.y); w.y = pk2(o.z, o.w);
                *(u32x2*)(H + (size_t)(m0 + q) * 1024 + c) = w; } }
    }
}
__device__ __forceinline__ void phase_md_post2(Ctx& C, int l, bf16_t* MD) {
    const float* qn = INP(17) + l * 384; const float* kvn = INP(19) + l * 256; const float* gkr = INP(24) + l * 64;
    const float* cs = C.ctl + CT_ROPEM; const float* sn = cs + 1024;
    const int L = C.lane;
    for (int m0 = C.gw * 2; m0 < MR; m0 += C.ngw * 2) {
        u32x4 w0[2], w1[2];
#pragma unroll
        for (int q = 0; q < 2; ++q) { const bf16_t* row = MD + (size_t)(m0 + q) * 768; w0[q] = *(const u32x4*)(row + 8 * L); w1[q] = (L < 32) ? *(const u32x4*)(row + 512 + 8 * L) : (u32x4){0u, 0u, 0u, 0u}; }
#pragma unroll
        for (int q = 0; q < 2; ++q) { const int m = m0 + q, b = m / SS, s = m - b * SS; const bool lat = s >= LC; const int t = s - LC;
            bf16_t* row = MD + (size_t)m * 768;
            float x0[8], x1[8]; unpack8(w0[q], x0); unpack8(w1[q], x1);
            const float s0 = sumsq8(x0), s1 = sumsq8(x1);
            const float sq = wave_sum(L < 48 ? s0 : 0.f), skv = wave_sum((L >= 48 ? s0 : 0.f) + (L < 16 ? s1 : 0.f)), skr = wave_sum((L >= 16 && L < 24) ? s1 : 0.f);
            const float rq = RSQ(sq * (1.f / 384.f) + EPS), rkv = RSQ(skv * (1.f / 256.f) + EPS), rkr = RSQ(skr * (1.f / 64.f) + EPS);
            {   const float* g = (L < 48) ? (qn + 8 * L) : (kvn + 8 * (L - 48)); const float rs = (L < 48) ? rq : rkv;
#pragma unroll
                for (int e = 0; e < 8; ++e) x0[e] *= rs * g[e];
                *(u32x4*)(row + 8 * L) = pack8u(x0); }
            if (L < 16) {
#pragma unroll
                for (int e = 0; e < 8; ++e) x1[e] *= rkv * kvn[128 + 8 * L + e];
            } else if (L < 24) {
#pragma unroll
                for (int e = 0; e < 8; ++e) x1[e] *= rkr * gkr[8 * (L - 16) + e];
            }
            float pr[8];
#pragma unroll
            for (int e = 0; e < 8; ++e) pr[e] = __shfl_xor(x1[e], 2);
            if (lat && L >= 16 && L < 24) { const int qt = (L - 16) >> 1, f0 = ((L - 16) & 1) * 8, pos = (qt < 2) ? (t >> 6) : (t & 63); const float sg = (qt & 1) ? 1.f : -1.f;
#pragma unroll
                for (int e = 0; e < 8; ++e) x1[e] = x1[e] * cs[pos * 16 + f0 + e] + sg * pr[e] * sn[pos * 16 + f0 + e]; }
            if (L < 24) *(u32x4*)(row + 512 + 8 * L) = pack8u(x1);
        }
    }
}
__device__ __forceinline__ void phase_qk_post2(Ctx& C, int l, bf16_t* QN, bf16_t* QP, bf16_t* KV) {
    const float* gqn = INP(21) + l * 128; const float* gqr = INP(22) + l * 64; const float* gkn = INP(23) + l * 128;
    const float* cs = C.ctl + CT_ROPEM; const float* sn = cs + 1024;
    const int L = C.lane;
    for (int m0 = C.gw * 2; m0 < MR; m0 += C.ngw * 2) {
        u32x4 a[2][2], k[2][2], p[2];
#pragma unroll
        for (int q = 0; q < 2; ++q) { const size_t m = m0 + q;
            a[q][0] = *(const u32x4*)(QN + m * 1024 + 8 * L); a[q][1] = *(const u32x4*)(QN + m * 1024 + 512 + 8 * L);
            k[q][0] = *(const u32x4*)(KV + m * 2048 + 8 * L); k[q][1] = *(const u32x4*)(KV + m * 2048 + 512 + 8 * L);
            p[q] = *(const u32x4*)(QP + m * 512 + 8 * L); }
#pragma unroll
        for (int q = 0; q < 2; ++q) { const int m = m0 + q, b = m / SS, s = m - b * SS; const bool lat = s >= LC; const int t = s - LC;
#pragma unroll
            for (int c = 0; c < 2; ++c) {
                float x[8]; unpack8(a[q][c], x);
                const float rs = RSQ(group_sum<16>(sumsq8(x)) * (1.f / 128.f) + EPS) * QSCALE;
#pragma unroll
                for (int e = 0; e < 8; ++e) x[e] *= rs * gqn[8 * (L & 15) + e];
                *(u32x4*)(QN + (size_t)m * 1024 + c * 512 + 8 * L) = pack8u(x);
                float y[8]; unpack8(k[q][c], y);
                const float rk = RSQ(group_sum<16>(sumsq8(y)) * (1.f / 128.f) + EPS);
#pragma unroll
                for (int e = 0; e < 8; ++e) y[e] *= rk * gkn[8 * (L & 15) + e];
                *(u32x4*)(KV + (size_t)m * 2048 + c * 512 + 8 * L) = pack8u(y); }
            {   float x[8]; unpack8(p[q], x);
                const float rs = RSQ(group_sum<8>(sumsq8(x)) * (1.f / 64.f) + EPS);
#pragma unroll
                for (int e = 0; e < 8; ++e) x[e] *= rs * gqr[8 * (L & 7) + e];
                float pr[8];
#pragma unroll
                for (int e = 0; e < 8; ++e) pr[e] = __shfl_xor(x[e], 2);
                if (lat) { const int qt = (L >> 1) & 3, f0 = (L & 1) * 8, pos = (qt < 2) ? (t >> 6) : (t & 63); const float sg = (qt & 1) ? 1.f : -1.f;
#pragma unroll
                    for (int e = 0; e < 8; ++e) x[e] = x[e] * cs[pos * 16 + f0 + e] + sg * pr[e] * sn[pos * 16 + f0 + e]; }
#pragma unroll
                for (int e = 0; e < 8; ++e) x[e] *= QSCALE;
                *(u32x4*)(QP + (size_t)m * 512 + 8 * L) = pack8u(x); }
        }
    }
}
__device__ __forceinline__ void phase_ret_ln3(Ctx& C, int l, bf16_t* OI, const bf16_t* OB) {
    const float* gain = INP(16) + l * 1024;
    const int L = C.lane;
    for (int m0 = C.gw * 2; m0 < MR; m0 += C.ngw * 2) {
        u32x4 a[2][2], bb[2][2];
#pragma unroll
        for (int q = 0; q < 2; ++q)
#pragma unroll
            for (int c = 0; c < 2; ++c) { a[q][c] = *(const u32x4*)(OI + (size_t)(m0 + q) * 1024 + c * 512 + 8 * L); bb[q][c] = *(const u32x4*)(OB + (size_t)(m0 + q) * 1024 + c * 512 + 8 * L); }
#pragma unroll
        for (int q = 0; q < 2; ++q)
#pragma unroll
            for (int c = 0; c < 2; ++c) { float x[8], y[8]; unpack8(a[q][c], x); unpack8(bb[q][c], y);
                float s = 0.f;
#pragma unroll
                for (int e = 0; e < 8; ++e) { x[e] += y[e]; s += x[e]; }
                const float mean = group_sum<32>(s) * (1.f / 256.f);
                float v = 0.f;
#pragma unroll
                for (int e = 0; e < 8; ++e) { x[e] -= mean; v += x[e] * x[e]; }
                const float rstd = RSQ(group_sum<32>(v) * (1.f / 256.f) + EPS);
#pragma unroll
                for (int e = 0; e < 8; ++e) x[e] *= rstd * gain[c * 512 + 8 * L + e];
                *(u32x4*)(OI + (size_t)(m0 + q) * 1024 + c * 512 + 8 * L) = pack8u(x); }
    }
}

constexpr int LR_UP = 272;
constexpr int LR_U = 0, LR_LA = 128 * LR_UP, LR_BC = LR_LA + 32768, LR_Y0 = LR_BC + 32768, LR_XS = LR_Y0 + 32768, LR_END = LR_XS + 4096;
static_assert(LR_END <= 147456 - 1024, "fused LRU LDS");
__device__ __forceinline__ void phase_lru_fused(Ctx& C, int l, const bf16_t* XA, const bf16_t* WTL, bf16_t* Y0, f16_t* CAF, f16_t* CAB, float* SUM) {
    const int lane = C.lane, r32 = lane & 31, hi = lane >> 5, wave = C.wave, tid = C.tid;
    LAS unsigned char* lds = C.lds;
    const float* cw = INP(8) + l * 4 * 1024; const float* cb = INP(9) + l * 1024;
    const int rb = wave & 3, cgp = wave >> 2;
    for (int un = C.bid; un < NB * 8 * 34; un += C.G) {
        const int sg = un % 34, bn = un / 34, b = bn >> 3, n = bn & 7;
        const int R0 = b * SS + sg * 128, lo = (sg < 2) ? b * SS : b * SS + LC, hi_ = (sg < 2) ? b * SS + LC : (b + 1) * SS;
#pragma unroll
        for (int j = 0; j < 4; ++j) { const int item = tid + 512 * j, row = item >> 4, cc = item & 15, ch0 = n * 128 + cc * 8;
            float a[8];
#pragma unroll
            for (int e = 0; e < 8; ++e) a[e] = cb[ch0 + e];
#pragma unroll
            for (int t = 0; t < 4; ++t) { const int rr = R0 + row + t - 2;
                if (rr >= lo && rr < hi_) { const u32x4 xv = *(const u32x4*)(XA + (size_t)rr * 1024 + ch0); const float* w = cw + t * 1024 + ch0;
                    a[0] += w[0] * lo_bf(xv.x); a[1] += w[1] * hi_bf(xv.x); a[2] += w[2] * lo_bf(xv.y); a[3] += w[3] * hi_bf(xv.y);
                    a[4] += w[4] * lo_bf(xv.z); a[5] += w[5] * hi_bf(xv.z); a[6] += w[6] * lo_bf(xv.w); a[7] += w[7] * hi_bf(xv.w); } }
            *(LAS u32x4*)(lds + LR_U + row * LR_UP + cc * 16) = pack8u(a); }
        __syncthreads();
        bf16x8 af[8];
        {   LAS unsigned char* ua = lds + LR_U + (rb * 32 + r32) * LR_UP + hi * 16;
#pragma unroll
            for (int s = 0; s < 8; ++s) af[s] = *(const LAS bf16x8*)(ua + s * 32); }
        for (int d = 0; d < 2; ++d) {
            f32x16 aR[2], aI[2];
#pragma unroll
            for (int q = 0; q < 2; ++q)
#pragma unroll
                for (int r = 0; r < 16; ++r) { aR[q][r] = 0.f; aI[q][r] = 0.f; }
            {   const bf16_t* wb = WTL + ((size_t)d * 2048 + n * 256 + cgp * 64 + r32) * 256 + (n & 1) * 128 + hi * 8;
#pragma unroll
                for (int s = 0; s < 8; ++s) {
                    const bf16x8 b0 = *(const bf16x8*)(wb + s * 16), b1 = *(const bf16x8*)(wb + 32 * 256 + s * 16), b2 = *(const bf16x8*)(wb + 128 * 256 + s * 16), b3 = *(const bf16x8*)(wb + 160 * 256 + s * 16);
                    aR[0] = __builtin_amdgcn_mfma_f32_32x32x16_bf16(af[s], b0, aR[0], 0, 0, 0); aR[1] = __builtin_amdgcn_mfma_f32_32x32x16_bf16(af[s], b1, aR[1], 0, 0, 0);
                    aI[0] = __builtin_amdgcn_mfma_f32_32x32x16_bf16(af[s], b2, aI[0], 0, 0, 0); aI[1] = __builtin_amdgcn_mfma_f32_32x32x16_bf16(af[s], b3, aI[1], 0, 0, 0);
                    if (s & 1) asm volatile("" ::: "memory"); } }
#pragma unroll
            for (int q = 0; q < 2; ++q) { const int chl = cgp * 64 + q * 32 + r32, ch = n * 128 + chl;
                const float bav = INP(11)[(l * 2 + d) * 1024 + ch], bxv = INP(13)[(l * 2 + d) * 1024 + ch], spv = C.ctl[CT_SP + (l * 2 + d) * 1024 + ch] * (-8.f);
#pragma unroll
                for (int r = 0; r < 16; ++r) { const int t = rb * 32 + crow(r, hi);
                    const float uu = bf2f(*(const LAS bf16_t*)(lds + LR_U + t * LR_UP + chl * 2));
                    const float rg = sigmoidf_(aR[q][r] + bav), ig = sigmoidf_(aI[q][r] + bxv);
                    const float loga = rg * spv, y2 = 2.f * loga;
                    const float om = -y2 * (1.f + y2 * 0.5f * (1.f + y2 * (1.f / 3.f) * (1.f + y2 * 0.25f * (1.f + y2 * 0.2f))));
                    const float bb = SQRT(fmaxf(om, 0.f)) * (ig * uu);
                    *(LAS f16_t*)(lds + LR_LA + (t * 128 + chl) * 2) = (f16_t)(loga * LOG2E); *(LAS f16_t*)(lds + LR_BC + (t * 128 + chl) * 2) = (f16_t)bb; } }
            __syncthreads();
            const int chl = tid & 127, sub = tid >> 7;
            {   float A = 1.f, H = 0.f;
#pragma unroll 8
                for (int i = 0; i < 32; ++i) { const int p = sub * 32 + i, t = d ? (127 - p) : p;
                    const float a = EX2((float)*(const LAS f16_t*)(lds + LR_LA + (t * 128 + chl) * 2)), bc = (float)*(const LAS f16_t*)(lds + LR_BC + (t * 128 + chl) * 2);
                    H = a * H + bc; A *= a; }
                *(LAS f32x2*)(lds + LR_XS + (sub * 128 + chl) * 8) = (f32x2){A, H}; }
            __syncthreads();
            {   float A = 1.f, H = 0.f;
                for (int p = 0; p < sub; ++p) { const f32x2 v = *(const LAS f32x2*)(lds + LR_XS + (p * 128 + chl) * 8); H = v.x * H + v.y; A *= v.x; }
                f16_t* cap = (d ? CAB : CAF) + (size_t)R0 * 1024 + n * 128 + chl;
#pragma unroll 8
                for (int i = 0; i < 32; ++i) { const int p = sub * 32 + i, t = d ? (127 - p) : p;
                    const float a = EX2((float)*(const LAS f16_t*)(lds + LR_LA + (t * 128 + chl) * 2)), bc = (float)*(const LAS f16_t*)(lds + LR_BC + (t * 128 + chl) * 2);
                    H = a * H + bc; A *= a;
                    cap[(size_t)t * 1024] = (f16_t)A;
                    LAS bf16_t* yp = (LAS bf16_t*)(lds + LR_Y0 + (t * 128 + chl) * 2);
                    if (d == 0) *yp = (bf16_t)f2bf(H); else Y0[(size_t)(R0 + t) * 1024 + n * 128 + chl] = (bf16_t)f2bf(bf2f(*yp) + H); }
                if (sub == 3) *(f32x2*)(SUM + ((size_t)((d * NB + b) * 34 + sg) * 1024 + n * 128 + chl) * 2) = (f32x2){A, H}; }
            __syncthreads();
        }
    }
}
__device__ __forceinline__ void phase_lru_fix(Ctx& C, const bf16_t* Y0, const f16_t* CAF, const f16_t* CAB, const float* SUM, bf16_t* YA) {
    for (int un = C.gw; un < NB * 34 * 8; un += C.ngw) {
        const int cg_ = un & 7, sg = (un >> 3) % 34, b = (un >> 3) / 34, ch = cg_ * 128 + 2 * C.lane;
        float F0 = 0.f, F1 = 0.f, B0 = 0.f, B1 = 0.f;
#pragma unroll 4
        for (int p = 0; p < sg; ++p) { const f32x4 v = *(const f32x4*)(SUM + ((size_t)((0 * NB + b) * 34 + p) * 1024 + ch) * 2); F0 = v[0] * F0 + v[1]; F1 = v[2] * F1 + v[3]; }
        const int npre = (sg < 2) ? (1 - sg) : (35 - sg);
#pragma unroll 4
        for (int p = 0; p < npre; ++p) { const int ps = (p < 2) ? (1 - p) : (35 - p);
            const f32x4 v = *(const f32x4*)(SUM + ((size_t)((1 * NB + b) * 34 + ps) * 1024 + ch) * 2); B0 = v[0] * B0 + v[1]; B1 = v[2] * B1 + v[3]; }
        const size_t base = (size_t)(b * SS + sg * 128) * 1024 + ch;
        for (int t0 = 0; t0 < 128; t0 += 16) {
            unsigned y[16]; f16x2 cf[16], cbk[16];
#pragma unroll
            for (int i = 0; i < 16; ++i) { const size_t o = base + (size_t)(t0 + i) * 1024; y[i] = *(const unsigned*)(Y0 + o); cf[i] = *(const f16x2*)(CAF + o); cbk[i] = *(const f16x2*)(CAB + o); }
#pragma unroll
            for (int i = 0; i < 16; ++i) { const size_t o = base + (size_t)(t0 + i) * 1024;
                *(unsigned*)(YA + o) = pk2(lo_bf(y[i]) + (float)cf[i][0] * F0 + (float)cbk[i][0] * B0, hi_bf(y[i]) + (float)cf[i][1] * F1 + (float)cbk[i][1] * B1); }
        }
    }
}

#ifdef PROBE_TS
#define GSYNC(g) do { { unsigned char* w_ = prm.ws; asm volatile("" : "+s"(w_)); xcd_barrier((unsigned*)(w_ + WS_BAR), (volatile LAS unsigned*)(ldsb + LDS_ST)); } if (blockIdx.x == 0 && threadIdx.x == 0) { unsigned long long* ts_ = (unsigned long long*)(prm.ws + 8192); const unsigned long long now_ = __builtin_amdgcn_s_memrealtime(); \
    ts_[1 + (g)] += now_ - ts_[0]; ts_[0] = now_; } } while (0)
#else
#define GSYNC(g) do { unsigned char* w_ = prm.ws; asm volatile("" : "+s"(w_)); xcd_barrier((unsigned*)(w_ + WS_BAR), (volatile LAS unsigned*)(ldsb + LDS_ST)); } while (0)
#endif
__global__ void __launch_bounds__(NTHR) fwd_kernel(Params prm) {
    extern __shared__ __attribute__((aligned(16))) unsigned char lds_raw[];
    cg::grid_group grid = cg::this_grid();
    LAS unsigned char* const ldsb = (LAS unsigned char*)lds_raw;
    if (threadIdx.x < 16) ((LAS unsigned*)(ldsb + LDS_ST))[threadIdx.x] = 0u;
    __syncthreads();
    if (threadIdx.x == 0) (void)xb_add(&((unsigned*)(prm.ws + WS_BAR))[XB_XCNT(xb_xcc_id())], 1u);
    grid.sync();
#define CTX Ctx C = mkctx(ldsb)
#define WSB wsp_(C.ws)
#define bYB ((bf16_t*)(WSB + AR_YB))
#define bXA ((bf16_t*)(WSB + AR_XA))
#define bMD ((bf16_t*)(WSB + AR_MD))
#define bRQKV ((bf16_t*)(WSB + AR_RQKV))
#define bKV ((bf16_t*)(WSB + AR_KV))
#define bQN ((bf16_t*)(WSB + AR_QN))
#define bQP ((bf16_t*)(WSB + AR_QP))
#define bRI ((f16_t*)(WSB + AR_RI))
#define bSUM ((float*)(WSB + AR_SUM))
#define bOB ((bf16_t*)(WSB + AR_OB))
#define bZ ((bf16_t*)(WSB + AR_Z))
#define xc1 ((float*)(WSB + WS_XC1))

#ifdef PROBE_TS
    if (blockIdx.x == 0 && threadIdx.x == 0) { unsigned long long* ts_ = (unsigned long long*)(prm.ws + 8192); for (int i = 1; i < 32; ++i) ts_[i] = 0ull; ts_[0] = __builtin_amdgcn_s_memrealtime(); }
#endif
    { CTX; phase_prep(C); }
    for (int l = 0; l < 2; ++l) {
        const bool with_ctx = (l == 0); const int lat_only = with_ctx ? 0 : 1;
        { CTX; phase_wconv_early(C, l); }
        GSYNC(0);
        { CTX; phase_h2(C, l, bYB); }
        GSYNC(1);
        {   CTX;
            ProbPlain P{bYB, (const bf16_t*)(WSB + W_WT1), 1024, 1024, 1024};
            pg8::StaticOrder S; S.init(68, 19, C.G, C.bid, 0);
            EpiG1 E{WSB, C.ctl + CT_ROPER};
            pg8::gemm_phase<EpiG1, ProbPlain, pg8::StaticOrder, true>(C.lds, P, S, E);
        }
        GSYNC(2);
        { CTX; phase_md_post2(C, l, bMD); }
        GSYNC(3);
        { CTX; phase_ret_intra(C, l, bRQKV, bYB); }
        GSYNC(4);
        { CTX; phase_ret_chain(C, l, bRQKV, bYB, bOB); }
        GSYNC(5);
        { CTX; phase_ret_ln3(C, l, bYB, bOB); }
        {   CTX; ProbPlain P{bMD, (const bf16_t*)(WSB + W_WTQ), 768, 384, 384};
            pg8::StaticOrder S; S.init(68, 6, C.G, C.bid, 0);
            typedef EpiStore3<AR_QN, 1024, AR_QP, 512, AR_QP, 512, 4, 6> Ep; Ep E{WSB};
            pg8::gemm_phase<Ep, ProbPlain, pg8::StaticOrder, true>(C.lds, P, S, E);
        }
        {   CTX; ProbPlain P{bMD + 384, (const bf16_t*)(WSB + W_WTKV), 768, 256, 256};
            pg8::StaticOrder S; S.init(68, 8, C.G, C.bid, 0);
            typedef EpiStore3<AR_KV, 2048, AR_KV, 2048, AR_KV, 2048, 8, 8> Ep; Ep E{WSB};
            pg8::gemm_phase<Ep, ProbPlain, pg8::StaticOrder, true>(C.lds, P, S, E);
        }
        GSYNC(6);
        { CTX; phase_qk_post2(C, l, bQN, bQP, bKV); }
        GSYNC(7);
        { CTX; phase_attn(C, with_ctx, bQN, bQP, bKV, bMD); }
        GSYNC(8);
        { CTX; phase_lru_fused(C, l, bXA, (const bf16_t*)(WSB + W_WTL), (bf16_t*)(WSB + AR_Y0), (f16_t*)(WSB + AR_CAF), (f16_t*)(WSB + AR_CAB), bSUM); }
        GSYNC(9);
        { CTX; phase_lru_fix(C, (const bf16_t*)(WSB + AR_Y0), (const f16_t*)(WSB + AR_CAF), (const f16_t*)(WSB + AR_CAB), bSUM, bXA  ); }
        GSYNC(10);
        { CTX; phase_wconv_late(C, l); }
        { CTX; phase_h2(C, l, bMD  ); }
        GSYNC(13);
        {   CTX; ProbPlain P{bMD, (const bf16_t*)(WSB + W_WTG), 1024, 1024, 1024};
            pg8::StaticOrder S; S.init(lat_only ? 64 : 68, 12, C.G, C.bid, lat_only);
            EpiGate E{WSB};
            pg8::gemm_phase<EpiGate, ProbPlain, pg8::StaticOrder, true>(C.lds, P, S, E);
        }
        GSYNC(14);
        {   CTX; ProbD P{WSB, 1024, 1024};
            pg8::ChainOrder S; S.init(lat_only ? 64 : 68, C.G, C.bid, lat_only);
            EpiD E{bZ, WSB + AR_GS + (size_t)C.bid * 131072};
            pg8::gemm_phase<EpiD, ProbD, pg8::ChainOrder, true>(C.lds, P, S, E);
        }
        GSYNC(15);
        {   CTX; ProbPlain P{bZ, (const bf16_t*)(WSB + W_WTO), 1024, 1024, 1024};
            pg8::StaticOrder S; S.init(lat_only ? 64 : 68, 4, C.G, C.bid, lat_only);
            EpiOut E{(l == 0) ? INP(0) : (const float*)C.out, INP(2), C.out, xc1, C.ctl + CT_MOD + l * 5 * 3072};
            pg8::gemm_phase<EpiOut, ProbPlain, pg8::StaticOrder, true>(C.lds, P, S, E);
        }
        GSYNC(16);
    }
#ifdef PROBE_TS
    if (blockIdx.x == 0 && threadIdx.x == 0) { const unsigned long long* ts_ = (const unsigned long long*)(prm.ws + 8192); unsigned long long tot = 0ull;
        for (int g = 0; g < 17; ++g) if ((PROBE_TS >> g) & 1u) tot += ts_[1 + g];
        prm.out[0] += (float)(((tot / 100ull) + PROBE_Q / 2) / PROBE_Q * PROBE_Q); }
#endif
}

#undef xc1
#undef bZ
extern "C" void kernel_launch(void* const* d_in, const int* in_sizes, int n_in, void* d_out, int out_size, void* d_ws, size_t ws_size, hipStream_t stream) {
    static int grid = 0;
    if (grid == 0) {
        if (n_in != 29 || out_size != NB * TT * DM || ws_size < WS_END) { fprintf(stderr, "kernel_launch: unexpected shapes (n_in %d out %d ws %zu)\n", n_in, out_size, ws_size); grid = -1; return; }
        int dev = 0, cus = 0, per_cu = 0;
        hipGetDevice(&dev);
        hipDeviceGetAttribute(&cus, hipDeviceAttributeMultiprocessorCount, dev);
        if (hipFuncSetAttribute((const void*)fwd_kernel, hipFuncAttributeMaxDynamicSharedMemorySize, LDS_BYTES) != hipSuccess) { fprintf(stderr, "kernel_launch: hipFuncSetAttribute failed\n"); grid = -1; return; }
        if (hipOccupancyMaxActiveBlocksPerMultiprocessor(&per_cu, (const void*)fwd_kernel, NTHR, LDS_BYTES) != hipSuccess || per_cu < 1) { fprintf(stderr, "kernel_launch: occupancy query failed (%d)\n", per_cu); (void)hipGetLastError(); per_cu = 1; }
        grid = cus;
        fprintf(stderr, "kernel_launch: cus %d per_cu %d grid %d\n", cus, per_cu, grid);
    }
    if (grid < 0) return;
    if (hipMemsetAsync((char*)d_ws + WS_BAR, 0, XCD_BAR_WORDS * 4, stream) != hipSuccess) { fprintf(stderr, "kernel_launch: memset failed\n"); return; }
    Params p{};
    for (int i = 0; i < 29; ++i) p.in[i] = (const float*)d_in[i];
    p.out = (float*)d_out; p.ws = (unsigned char*)d_ws;
    void* args[] = {&p};
    hipError_t e = hipLaunchCooperativeKernel((const void*)fwd_kernel, dim3(grid), dim3(NTHR), args, LDS_BYTES, stream);
    if (e != hipSuccess) fprintf(stderr, "cooperative launch failed: %s (grid %d)\n", hipGetErrorString(e), grid);
}
```

```cpp
#include <hip/hip_runtime.h>
#include <hip/hip_cooperative_groups.h>
#include <cstdio>
#include <cstdint>
namespace cg = cooperative_groups;

#define LAS __attribute__((address_space(3)))
typedef unsigned short bf16_t;
typedef short bf16x8 __attribute__((ext_vector_type(8)));
typedef float f32x4 __attribute__((ext_vector_type(4)));
typedef float f32x2 __attribute__((ext_vector_type(2)));
typedef unsigned u32x4 __attribute__((ext_vector_type(4)));
typedef unsigned u32x2 __attribute__((ext_vector_type(2)));
typedef _Float16 f16_t;

namespace pg8 {
constexpr int BM = 256, BK = 64, HALF = 128, HTB = HALF * BK * 2, STAGE_BYTES = 8 * HTB, NXCD = 8, WGM = 8;
__host__ __device__ __forceinline__ int lds_byte(int r, int c) { const int st = (r >> 4) * 2 + (c >> 5), rr = r & 15, cc = c & 31, ob = rr * 64 + cc * 2; return st * 1024 + (ob ^ (((ob >> 9) & 1) << 5)); }
__host__ __device__ __forceinline__ void stage_rc(int b, int& R, int& C) { const int st = b / 1024, sb = b % 1024, swz = sb ^ (((sb >> 9) & 1) << 5); R = (st >> 1) * 16 + swz / 64; C = (st & 1) * 32 + (swz % 64) / 2; }
__host__ __device__ __forceinline__ int perm32(int rho) { const int n = rho >> 4, i = rho & 15; return 8 * (i >> 2) + 4 * n + (i & 3); }

struct Unit { int pm, pn, z; };

struct StaticOrder {
    int nM, nN, nwg, G, c, latent_only;
    __device__ void init(int nM_, int nN_, int G_, int c_, int latent_only_) { nM = nM_; nN = nN_; nwg = nM * nN; G = G_; c = c_; latent_only = latent_only_; }
    __device__ bool next(int i, Unit& u) const {
        const long L = (long)i * G + c; if (L >= nwg) return false;
        int wgid = (int)L; { const int q = nwg / NXCD, r = nwg % NXCD, xcd = wgid % NXCD, off = wgid / NXCD; wgid = (xcd < r ? xcd * (q + 1) : r * (q + 1) + (xcd - r) * q) + off; }
        const int nig = WGM * nN, gid = wgid / nig, fm = gid * WGM, gsz = (nM - fm) < WGM ? (nM - fm) : WGM;
        int pm = fm + ((wgid % nig) % gsz); u.pn = (wgid % nig) / gsz; u.z = 0;
        if (latent_only) pm = (pm >> 4) * 17 + 1 + (pm & 15);
        u.pm = pm; return true;
    }
};
struct ChainOrder {
    int G, c, with_ctx;
    __device__ void init(int G_, int c_, int with_ctx_) { G = G_; c = c_; with_ctx = with_ctx_; }
    __device__ bool next(int i, Unit& u) const {
        if (i < 6) { const int T = c; if (T >= 256) return false; int pm = T >> 2; u.pn = T & 3; u.z = i; u.pm = (pm >> 4) * 17 + 1 + (pm & 15); return true; }
        if (i < 8 && with_ctx && c < 48) { const int ct = c / 3, br = c - ct * 3; u.pm = (ct >> 2) * 17; u.pn = ct & 3; u.z = 8 + 2 * br + (i - 6); return true; }
        return false;
    }
};

typedef __bf16 bf16x2_t __attribute__((ext_vector_type(2)));
__device__ __forceinline__ unsigned cvt_pk_bf16(float lo, float hi) { f32x2 v = {lo, hi}; bf16x2_t b = __builtin_convertvector(v, bf16x2_t); return __builtin_bit_cast(unsigned, b); }

template <class Epi, class Prob, class Sched, bool ALIGN_EPI>
__device__ __forceinline__ void gemm_phase(LAS unsigned char* lds, const Prob& P, const Sched& S, const Epi& E) {
    int tid_ = threadIdx.x; asm volatile("" : "+v"(tid_));
    const int tid = tid_, wid = __builtin_amdgcn_readfirstlane(tid >> 6), lane = tid & 63, wr = wid >> 2, wc = wid & 3, fr = lane & 15, fq = lane >> 4;
    const int K = P.K, nt = K / BK;
    int RA[2], CA[2]; unsigned voffB[2];
#pragma unroll
    for (int i = 0; i < 2; ++i) { int R, C; stage_rc(tid * 16 + i * 8192, R, C); const int Rb = Epi::PERM ? ((R & ~31) + perm32(R & 31)) : R;
        RA[i] = R; CA[i] = C; voffB[i] = (unsigned)(Rb * P.ldb + C) * 2u; }
    const unsigned kstep = (unsigned)(BK * 2);
    const unsigned hstepB = (unsigned)(HALF * P.ldb * 2);
    const unsigned ldsw = (unsigned)wid * 1024u;
    const int aoff = lds_byte(wr * 64 + fr, fq * 8), boff = lds_byte(wc * 32 + fr, fq * 8);
#define PG8_SA(b, h) (((b) * 2 + (h)) * HTB)
#define PG8_SB(b, h) ((4 + (b) * 2 + (h)) * HTB)
#define PG8_STAGE(bufoff, gbase, soff, voff) do { _Pragma("unroll") for (int _i = 0; _i < 2; ++_i) \
        __builtin_amdgcn_global_load_lds((const unsigned*)((const char*)(gbase) + (unsigned)((voff)[_i] + (soff))), (LAS unsigned*)(lds + (bufoff) + ldsw + _i * 8192), 16, 0, 0); } while (0)
#define PG8_LDA(dst, b, h) do { _Pragma("unroll") for (int m = 0; m < 4; ++m) _Pragma("unroll") for (int k = 0; k < 2; ++k) dst[m][k] = *(const LAS bf16x8*)(lds + PG8_SA(b, h) + aoff + m * 2048 + k * 1024); } while (0)
#define PG8_LDB(dst, b, h) do { _Pragma("unroll") for (int n = 0; n < 2; ++n) _Pragma("unroll") for (int k = 0; k < 2; ++k) dst[n][k] = *(const LAS bf16x8*)(lds + PG8_SB(b, h) + boff + n * 2048 + k * 1024); } while (0)
#define PG8_MMA(ai, bj, At, Bt) do { __builtin_amdgcn_s_setprio(1); _Pragma("unroll") for (int m = 0; m < 4; ++m) _Pragma("unroll") for (int n = 0; n < 2; ++n) _Pragma("unroll") for (int k = 0; k < 2; ++k) \
        acc[ai][bj][m][n] = __builtin_amdgcn_mfma_f32_16x16x32_bf16(Bt[n][k], At[m][k], acc[ai][bj][m][n], 0, 0, 0); __builtin_amdgcn_s_setprio(0); } while (0)
#define PG8_WAIT_V(n) asm volatile("s_waitcnt vmcnt(" #n ")" ::: "memory")
#define PG8_WAIT_L(n) asm volatile("s_waitcnt lgkmcnt(" #n ")" ::: "memory")
#define PG8_BAR __builtin_amdgcn_s_barrier()
#define PG8_SCHED __builtin_amdgcn_sched_barrier(0)
    Unit cur, nxt; int ui = 0;
    if (!S.next(0, cur)) return;
    f32x4 acc[2][2][4][2];
#pragma unroll
    for (int a = 0; a < 2; ++a)
#pragma unroll
        for (int b = 0; b < 2; ++b)
#pragma unroll
            for (int m = 0; m < 4; ++m)
#pragma unroll
                for (int n = 0; n < 2; ++n) acc[a][b][m][n] = (f32x4){0.f, 0.f, 0.f, 0.f};
    bf16x8 At[4][2], B0[2][2], B1[2][2];
    const char* cA; const char* cB; int ldaC; P.get(cur, cA, cB, ldaC);
    unsigned voffA[2] = {(unsigned)(RA[0] * ldaC + CA[0]) * 2u, (unsigned)(RA[1] * ldaC + CA[1]) * 2u};
    unsigned hstepA = (unsigned)(HALF * ldaC * 2);
    PG8_STAGE(PG8_SB(0, 0), cB, 0u, voffB); PG8_STAGE(PG8_SB(0, 1), cB, hstepB, voffB); PG8_STAGE(PG8_SA(0, 0), cA, 0u, voffA); PG8_STAGE(PG8_SA(0, 1), cA, hstepA, voffA);
    if (wr == 1) PG8_BAR;
    PG8_WAIT_V(2); PG8_BAR;
    PG8_STAGE(PG8_SB(1, 0), cB, kstep, voffB); PG8_STAGE(PG8_SA(1, 0), cA, kstep, voffA); PG8_STAGE(PG8_SB(1, 1), cB, hstepB + kstep, voffB);
    PG8_WAIT_V(6); PG8_BAR;
    for (;;) {
        const bool has_next = S.next(ui + 1, nxt);
        const char* nA = cA; const char* nB = cB; int ldaN = ldaC;
        if (has_next) P.get(nxt, nA, nB, ldaN);
        unsigned voffAn[2] = {(unsigned)(RA[0] * ldaN + CA[0]) * 2u, (unsigned)(RA[1] * ldaN + CA[1]) * 2u};
        const unsigned hstepAn = (unsigned)(HALF * ldaN * 2);
        for (int t = 0; t < nt; t += 2) {
            const bool last = (t == nt - 2);
            const unsigned o1 = (unsigned)(t + 1) * kstep;
            const char* a2b = last ? nA : cA; const char* b2b = last ? nB : cB;
            const unsigned o2 = last ? 0u : (unsigned)(t + 2) * kstep, o3 = o2 + kstep;
            unsigned vA2[2] = {last ? voffAn[0] : voffA[0], last ? voffAn[1] : voffA[1]};
            const unsigned hA2 = last ? hstepAn : hstepA;
            PG8_LDB(B0, 0, 0); PG8_LDB(B1, 0, 1); PG8_SCHED; PG8_LDA(At, 0, 0); PG8_STAGE(PG8_SA(1, 1), cA, o1 + hstepA, voffA);
            PG8_WAIT_V(8); PG8_WAIT_L(0); PG8_BAR; PG8_MMA(0, 0, At, B0); PG8_MMA(0, 1, At, B1); PG8_BAR; PG8_SCHED;
            PG8_LDA(At, 0, 1); PG8_STAGE(PG8_SB(0, 0), b2b, o2, voffB); PG8_STAGE(PG8_SB(0, 1), b2b, o2 + hstepB, voffB); PG8_STAGE(PG8_SA(0, 0), a2b, o2, vA2);
            PG8_WAIT_V(8); PG8_WAIT_L(0); PG8_BAR; PG8_MMA(1, 0, At, B0); PG8_MMA(1, 1, At, B1); PG8_BAR; PG8_SCHED;
            PG8_LDB(B0, 1, 0); PG8_LDB(B1, 1, 1); PG8_SCHED; PG8_LDA(At, 1, 0); PG8_STAGE(PG8_SA(0, 1), a2b, o2 + hA2, vA2);
            PG8_WAIT_V(8); PG8_WAIT_L(0); PG8_BAR; PG8_MMA(0, 0, At, B0); PG8_MMA(0, 1, At, B1); PG8_BAR; PG8_SCHED;
            PG8_LDA(At, 1, 1); PG8_STAGE(PG8_SB(1, 0), b2b, o3, voffB); PG8_STAGE(PG8_SB(1, 1), b2b, o3 + hstepB, voffB); PG8_STAGE(PG8_SA(1, 0), a2b, o3, vA2);
            PG8_WAIT_V(8); PG8_WAIT_L(0); PG8_BAR; PG8_MMA(1, 0, At, B0); PG8_MMA(1, 1, At, B1); PG8_BAR; PG8_SCHED;
        }
        if constexpr (ALIGN_EPI) { if (wr == 0) PG8_BAR; }
        E(acc, cur, wr, wc, fr, fq);
        if (!has_next) break;
#pragma unroll
        for (int a = 0; a < 2; ++a)
#pragma unroll
            for (int b = 0; b < 2; ++b)
#pragma unroll
                for (int m = 0; m < 4; ++m)
#pragma unroll
                    for (int n = 0; n < 2; ++n) acc[a][b][m][n] = (f32x4){0.f, 0.f, 0.f, 0.f};
        cur = nxt; cA = nA; cB = nB; ldaC = ldaN; voffA[0] = voffAn[0]; voffA[1] = voffAn[1]; hstepA = hstepAn; ++ui;
        if constexpr (ALIGN_EPI) { if (wr == 1) PG8_BAR; }
    }
    PG8_WAIT_V(0);
    if constexpr (!ALIGN_EPI) { if (wr == 0) PG8_BAR; }
    PG8_BAR;
#undef PG8_SA
#undef PG8_SB
#undef PG8_STAGE
#undef PG8_LDA
#undef PG8_LDB
#undef PG8_MMA
#undef PG8_WAIT_V
#undef PG8_WAIT_L
#undef PG8_BAR
#undef PG8_SCHED
}
}

constexpr int NB = 4, TT = 4096, LC = 256, SS = TT + LC  , DM = 1024, MR = NB * SS  ;
constexpr int INC = 10944;
constexpr float EPS = 1e-6f;
constexpr float LOG2E = 1.4426950408889634f;
constexpr float QSCALE = 0.07216878364870322f * 1.4426950408889634f;
constexpr int NWAVES = 8, NTHR = 512;

constexpr size_t MiB = 1u << 20;
constexpr size_t WS_CTL = 0;
constexpr size_t WS_XC1 = 1 * MiB;
constexpr size_t WS_W = 5 * MiB;
constexpr size_t WS_AR = 25 * MiB;
constexpr size_t AR_YB = WS_AR + 0 * MiB;
constexpr size_t AR_XA = WS_AR + 34 * MiB;
constexpr size_t AR_MD = WS_AR + 68 * MiB;
constexpr size_t AR_RQKV = WS_AR + 94 * MiB;
constexpr size_t AR_OB = WS_AR + 196 * MiB;
constexpr size_t AR_KV = WS_AR + 112 * MiB;
constexpr size_t AR_QN = WS_AR + 180 * MiB;
constexpr size_t AR_QP = WS_AR + 214 * MiB;
constexpr size_t AR_RI = WS_AR + 102 * MiB;
constexpr size_t AR_Y0 = WS_AR + 68 * MiB;
constexpr size_t AR_CAF = WS_AR + 102 * MiB;
constexpr size_t AR_CAB = WS_AR + 136 * MiB;
constexpr size_t AR_SUM = WS_AR + 170 * MiB;
constexpr size_t AR_Z = WS_AR + 102 * MiB;
constexpr size_t AR_ZP = WS_AR + 170 * MiB;
constexpr size_t AR_GS = WS_AR + 136 * MiB;
constexpr size_t WS_END = 256 * MiB;
constexpr size_t W_WT1 = WS_W;
constexpr size_t W_WTQ = WS_W + 10 * MiB;
constexpr size_t W_WTKV = WS_W + 12 * MiB;
constexpr size_t W_WTL = WS_W + 13 * MiB;
constexpr size_t W_WTG = WS_W;
constexpr size_t W_WTGM = WS_W + 6 * MiB;
constexpr size_t W_WTD = WS_W + 12 * MiB;
constexpr size_t W_WTO = WS_W + 18 * MiB;
constexpr int CT_MOD = 16384;
constexpr int CT_ROPER = CT_MOD + 2 * 5 * 3072;
constexpr int CT_ROPEM = CT_ROPER + 2 * 4096;
constexpr int CT_SP = CT_ROPEM + 2 * 1024;
constexpr int CT_LG = CT_SP + 4096;
constexpr int CT_END = CT_LG + 16;
static_assert(CT_END * 4 <= (int)MiB, "CTL");

constexpr int LDS_BYTES = 147456;


#define XB_TMO      128
#define XB_XCNT(j)  (256  + 64 * (j))
#define XB_XSUB(j)  (1280 + 64 * (j))
#define XB_XGEN(j)  (2304 + 64 * (j))
#define XB_TOP      3328
#define XB_TOPGEN   3392
#define XCD_BAR_WORDS 3456
#define XB_SPIN_CAP (1u << 18)
constexpr size_t WS_BAR = 16384;
constexpr int LDS_ST = LDS_BYTES - 64;
__device__ __forceinline__ unsigned xb_ld(unsigned* p)              { return __hip_atomic_load(p, __ATOMIC_RELAXED, __HIP_MEMORY_SCOPE_AGENT); }
__device__ __forceinline__ unsigned xb_add(unsigned* p, unsigned v) { return __hip_atomic_fetch_add(p, v, __ATOMIC_RELAXED, __HIP_MEMORY_SCOPE_AGENT); }
__device__ __forceinline__ unsigned xb_xcc_id() { return (unsigned)__builtin_amdgcn_s_getreg((3 << 11) | 20) & 0xFu; }
#define XB_SPIN(cond, bar) do { unsigned _sp = 0; while (cond) { __builtin_amdgcn_s_sleep(1); \
    if ((++_sp & 255u) == 0u) { if (xb_ld(&(bar)[XB_TMO])) break; if (_sp > XB_SPIN_CAP) { atomicAdd(&(bar)[XB_TMO], 1u); break; } } } } while (0)
__device__ __forceinline__ void xcd_barrier_complete(unsigned* bar, unsigned x, unsigned& nloc, unsigned& nx) {
    const unsigned G = gridDim.x * gridDim.y * gridDim.z;
    unsigned sum, cnt, mine, sp = 0u;
    for (;;) {
        sum = 0u; cnt = 0u; mine = 0u;
#pragma unroll
        for (unsigned j = 0; j < 16; ++j) { const unsigned c = xb_ld(&bar[XB_XCNT(j)]); sum += c; cnt += (c > 0u) ? 1u : 0u; mine = (j == x) ? c : mine; }
        if (sum == G) break;
        __builtin_amdgcn_s_sleep(1);
        if ((++sp & 255u) == 0u) { if (xb_ld(&bar[XB_TMO])) break; if (sp > XB_SPIN_CAP) { atomicAdd(&bar[XB_TMO], 1u); break; } }
    }
    nloc = mine > 0u ? mine : 1u; nx = cnt > 0u ? cnt : 1u;
}
__device__ __forceinline__ void xcd_barrier(unsigned* bar, volatile LAS unsigned* st) {
    asm volatile("s_waitcnt vmcnt(0)" ::: "memory");
    __syncthreads();
    if (threadIdx.x == 0) {
        const unsigned x = xb_xcc_id();
        __builtin_amdgcn_s_waitcnt(0);
        unsigned nloc = st[0], nx = st[1];
        if (nloc == 0u) { xcd_barrier_complete(bar, x, nloc, nx); st[0] = nloc; st[1] = nx; }
        const unsigned old = xb_add(&bar[XB_XSUB(x)], 1u);
        const unsigned gen = old / nloc;
        if (old + 1u == (gen + 1u) * nloc) {
            __builtin_amdgcn_fence(__ATOMIC_RELEASE, "agent");
            asm volatile("s_waitcnt vmcnt(0)" ::: "memory");
            const unsigned og = xb_add(&bar[XB_TOP], 1u);
            const unsigned tg = og / nx;
            if (og + 1u == (tg + 1u) * nx) xb_add(&bar[XB_TOPGEN], 1u);
            else XB_SPIN(xb_ld(&bar[XB_TOPGEN]) == tg, bar);
            __builtin_amdgcn_fence(__ATOMIC_ACQUIRE, "agent");
            xb_add(&bar[XB_XGEN(x)], 1u);
            asm volatile("s_waitcnt vmcnt(0)" ::: "memory");
        } else {
            XB_SPIN(xb_ld(&bar[XB_XGEN(x)]) == gen, bar);
            __builtin_amdgcn_fence(__ATOMIC_ACQUIRE, "agent");
            asm volatile("s_waitcnt vmcnt(0)" ::: "memory");
        }
    }
    __syncthreads();
}

struct Params {
    const float* in[29];
    float* out;
    unsigned char* ws;
};

#define EX2(x) __builtin_amdgcn_exp2f(x)
#define RSQ(x) __builtin_amdgcn_rsqf(x)
#define SQRT(x) __builtin_amdgcn_sqrtf(x)
__device__ __forceinline__ float bf2f(unsigned v) { return __uint_as_float(v << 16); }
__device__ __forceinline__ unsigned f2bf(float f) { unsigned u = __float_as_uint(f); return (u + 0x7fffu + ((u >> 16) & 1u)) >> 16; }
__device__ __forceinline__ unsigned pk2(float lo, float hi) { return f2bf(lo) | (f2bf(hi) << 16); }
__device__ __forceinline__ float lo_bf(unsigned w) { return __uint_as_float(w << 16); }
__device__ __forceinline__ float hi_bf(unsigned w) { return __uint_as_float(w & 0xffff0000u); }
__device__ __forceinline__ float wave_sum(float v) {
#pragma unroll
    for (int o = 1; o < 64; o <<= 1) v += __shfl_xor(v, o);
    return v;
}
__device__ __forceinline__ float wave_max(float v) {
#pragma unroll
    for (int o = 1; o < 64; o <<= 1) v = fmaxf(v, __shfl_xor(v, o));
    return v;
}
__device__ __forceinline__ float sigmoidf_(float x) { return __builtin_amdgcn_rcpf(1.f + __expf(-x)); }
__device__ __forceinline__ float siluf_(float x) { return x * __builtin_amdgcn_rcpf(1.f + __expf(-x)); }

__device__ __forceinline__ const float* inp_(int i) { asm volatile("" : "+s"(i)); const float* const* ka = (const float* const*)__builtin_amdgcn_kernarg_segment_ptr(); return ka[i]; }
#define INP(i) inp_(i)
__device__ __forceinline__ unsigned char* wsp_(unsigned char* p) { asm volatile("" : "+s"(p)); return p; }
struct Ctx {
    float* out; unsigned char* ws; LAS unsigned char* lds; int tid, lane, wave, G, bid;
    int gw, ngw;
    int rot;
    float* ctl;
};

__device__ __forceinline__ Ctx mkctx(LAS unsigned char* lds) {
    Ctx C; int t = threadIdx.x; asm volatile("" : "+v"(t)); int b = blockIdx.x; asm volatile("" : "+s"(b)); int g = gridDim.x; asm volatile("" : "+s"(g));
    C.tid = t; C.lane = t & 63; C.wave = __builtin_amdgcn_readfirstlane(t >> 6); C.bid = b; C.G = g; C.gw = b * NWAVES + C.wave; C.ngw = g * NWAVES; C.rot = 0;
    int io = 29, iw = 30; asm volatile("" : "+s"(io)); asm volatile("" : "+s"(iw));
    unsigned char* const* ka = (unsigned char* const*)__builtin_amdgcn_kernarg_segment_ptr();
    C.out = (float*)ka[io]; C.ws = ka[iw]; C.ctl = (float*)(C.ws + WS_CTL); C.lds = lds;
    return C;
}
__device__ __forceinline__ const float* resid_row(const Ctx& C, int l, int m) {
    const int b = m / SS, s = m - b * SS;
    if (s < LC) { const float* base = (l == 0) ? INP(2) : (const float*)(C.ws + WS_XC1); return base + (size_t)(b * LC + s) * DM; }
    const float* base = (l == 0) ? INP(0) : C.out; return base + (size_t)(b * TT + (s - LC)) * DM;
}

__device__ __forceinline__ void phase_prep(Ctx& C) {
    LAS float* sl = (LAS float*)C.lds;
    LAS float* red = (LAS float*)(C.lds + 32768);
    for (int i = C.tid; i < 5 * 1024; i += NTHR) { const int r = i >> 10, k = i & 1023; const float v = (r < 4) ? INP(1)[r * 1024 + k] : INP(3)[k]; sl[i] = siluf_(v); }
    __syncthreads();
    for (int it = C.bid; it < 2 * 96; it += C.G) {
        const int l = it / 96, grp = it % 96, kg = C.tid >> 5, cj = C.tid & 31, col = grp * 32 + cj;
        const float* w = INP(4) + (size_t)l * 1024 * 3072 + col;
        float a0 = 0.f, a1 = 0.f, a2 = 0.f, a3 = 0.f, a4 = 0.f;
#pragma unroll 8
        for (int k = kg * 64; k < kg * 64 + 64; ++k) { const float wv = w[(size_t)k * 3072]; a0 += sl[k] * wv; a1 += sl[1024 + k] * wv; a2 += sl[2048 + k] * wv; a3 += sl[3072 + k] * wv; a4 += sl[4096 + k] * wv; }
        red[(kg * 32 + cj) * 5 + 0] = a0; red[(kg * 32 + cj) * 5 + 1] = a1; red[(kg * 32 + cj) * 5 + 2] = a2; red[(kg * 32 + cj) * 5 + 3] = a3; red[(kg * 32 + cj) * 5 + 4] = a4;
        __syncthreads();
        if (C.tid < 160) { const int c2 = C.tid / 5, r = C.tid % 5; float s = 0.f;
            for (int g = 0; g < 16; ++g) s += red[(g * 32 + c2) * 5 + r];
            C.ctl[CT_MOD + (l * 5 + r) * 3072 + grp * 32 + c2] = s + INP(5)[l * 3072 + grp * 32 + c2]; }
        __syncthreads();
    }
    const int gt = C.bid * NTHR + C.tid, ngt = C.G * NTHR;
    for (int i = gt; i < 4096; i += ngt) { const int pos = i >> 6, f = i & 63; const float inv = powf(10000.f, -(float)f / 64.f), ang = (float)pos * inv;
        C.ctl[CT_ROPER + i] = cosf(ang); C.ctl[CT_ROPER + 4096 + i] = sinf(ang); }
    for (int i = gt; i < 1024; i += ngt) { const int pos = i >> 4, f = i & 15; const float inv = powf(10000.f, -(float)f / 16.f), ang = (float)pos * inv;
        C.ctl[CT_ROPEM + i] = cosf(ang); C.ctl[CT_ROPEM + 1024 + i] = sinf(ang); }
    for (int i = gt; i < 4096; i += ngt) C.ctl[CT_SP + i] = log1pf(expf(-INP(14)[i]));
    for (int i = gt; i < 16; i += ngt) C.ctl[CT_LG + i] = -log1pf(expf(-INP(15)[i])) * LOG2E;
}

__device__ __forceinline__ void tr_item(const float* W, int ldw, int k0, int n0, bf16_t* WT, int ldt, int drow0, int dk0, LAS float* scr, int lane) {
#pragma unroll 8
    for (int i = 0; i < 32; ++i) { const int kk = 2 * i + (lane >> 5); scr[kk * 33 + (lane & 31)] = W[(size_t)(k0 + kk) * ldw + n0 + (lane & 31)]; }
    asm volatile("s_waitcnt lgkmcnt(0)" ::: "memory");
    const int c = lane & 7;
#pragma unroll
    for (int j = 0; j < 4; ++j) { const int n = (lane >> 3) + 8 * j; const LAS float* s = scr + (8 * c) * 33 + n;
        u32x4 o; o.x = pk2(s[0 * 33], s[1 * 33]); o.y = pk2(s[2 * 33], s[3 * 33]); o.z = pk2(s[4 * 33], s[5 * 33]); o.w = pk2(s[6 * 33], s[7 * 33]);
        *(u32x4*)(WT + (size_t)(drow0 + n) * ldt + dk0 + 8 * c) = o; }
    asm volatile("s_waitcnt lgkmcnt(0)" ::: "memory");
}
__device__ __forceinline__ void conv_rows(Ctx& C, const float* W, int ldw, int K, int scol0, bf16_t* WT, int ldt, int drow0, int dk0, int nrows, LAS float* scr) {
    const int nkb = K / 64, items = nkb * (nrows / 32);
    int g0 = C.gw - C.rot; if (g0 < 0) g0 += C.ngw; C.rot = (C.rot + items) % C.ngw;
    for (int it = g0; it < items; it += C.ngw) { const int nb = it / nkb, kb = it - nb * nkb;
        tr_item(W, ldw, kb * 64, scol0 + nb * 32, WT, ldt, drow0 + nb * 32, dk0 + kb * 64, scr, C.lane); }
}
__device__ __forceinline__ int ropeperm(int j) { const int h = j >> 8, jj = j & 255, half = jj >> 7, g = (jj & 127) >> 3, r8 = jj & 7; return h * 256 + (half * 2 + (r8 >> 2)) * 64 + g * 4 + (r8 & 3); }
__device__ __forceinline__ void tr_item_rope(const float* W, int ldw, int k0, int scol0, int jbase, bf16_t* WT, int ldt, int drow0, int dk0, LAS float* scr, int lane) {
    const int sc = scol0 + ropeperm(jbase + (lane & 31));
#pragma unroll 8
    for (int i = 0; i < 32; ++i) { const int kk = 2 * i + (lane >> 5); scr[kk * 33 + (lane & 31)] = W[(size_t)(k0 + kk) * ldw + sc]; }
    asm volatile("s_waitcnt lgkmcnt(0)" ::: "memory");
    const int c = lane & 7;
#pragma unroll
    for (int j = 0; j < 4; ++j) { const int n = (lane >> 3) + 8 * j; const LAS float* s = scr + (8 * c) * 33 + n;
        u32x4 o; o.x = pk2(s[0 * 33], s[1 * 33]); o.y = pk2(s[2 * 33], s[3 * 33]); o.z = pk2(s[4 * 33], s[5 * 33]); o.w = pk2(s[6 * 33], s[7 * 33]);
        *(u32x4*)(WT + (size_t)(drow0 + n) * ldt + dk0 + 8 * c) = o; }
    asm volatile("s_waitcnt lgkmcnt(0)" ::: "memory");
}
__device__ __forceinline__ void conv_rows_rope(Ctx& C, const float* W, int ldw, int K, int scol0, bf16_t* WT, int ldt, int drow0, int nrows, LAS float* scr) {
    const int nkb = K / 64, items = nkb * (nrows / 32);
    int g0 = C.gw - C.rot; if (g0 < 0) g0 += C.ngw; C.rot = (C.rot + items) % C.ngw;
    for (int it = g0; it < items; it += C.ngw) { const int nb = it / nkb, kb = it - nb * nkb;
        tr_item_rope(W, ldw, kb * 64, scol0, nb * 32, WT, ldt, drow0 + nb * 32, kb * 64, scr, C.lane); }
}
__device__ __forceinline__ void zero_rows(Ctx& C, bf16_t* WT, int ldt, int drow0, int dk0, int nrows, int ncols) {
    const int per = ncols / 8, items = nrows * per;
    int g0 = C.gw - C.rot; if (g0 < 0) g0 += C.ngw; C.rot = (C.rot + (items + 63) / 64) % C.ngw;
    for (int it = g0 * 64 + C.lane; it < items; it += C.ngw * 64) { const int r = it / per, c = it - r * per; *(u32x4*)(WT + (size_t)(drow0 + r) * ldt + dk0 + c * 8) = (u32x4){0u, 0u, 0u, 0u}; }
}
__device__ __forceinline__ void phase_wconv_early(Ctx& C, int l) {
    LAS float* scr = (LAS float*)(C.lds + C.wave * 16384);
    unsigned char* ws = C.ws;
    const float* win = INP(7) + (size_t)l * 1024 * INC;
    bf16_t* WT1 = (bf16_t*)(ws + W_WT1);
    conv_rows(C, win, INC, 1024, 0, WT1, 1024, 0, 0, 1024, scr);
    conv_rows_rope(C, win, INC, 1024, 2048, WT1, 1024, 1024, 1024, scr);
    conv_rows_rope(C, win, INC, 1024, 3072, WT1, 1024, 2048, 1024, scr);
    conv_rows(C, win, INC, 1024, 4096, WT1, 1024, 3072, 0, 1024, scr);
    conv_rows(C, win, INC, 1024, 6144, WT1, 1024, 4096, 0, 704, scr);
    zero_rows(C, WT1, 1024, 4800, 0, 64, 1024);
    const float* wq = INP(18) + (size_t)l * 384 * 1536; bf16_t* WTQ = (bf16_t*)(ws + W_WTQ);
    for (int h = 0; h < 8; ++h) { conv_rows(C, wq, 1536, 384, h * 192, WTQ, 384, h * 128, 0, 128, scr); conv_rows(C, wq, 1536, 384, h * 192 + 128, WTQ, 384, 1024 + h * 64, 0, 64, scr); }
    const float* wkv = INP(20) + (size_t)l * 256 * 2048; bf16_t* WTKV = (bf16_t*)(ws + W_WTKV);
    for (int h = 0; h < 8; ++h) { conv_rows(C, wkv, 2048, 256, h * 256, WTKV, 256, h * 128, 0, 128, scr); conv_rows(C, wkv, 2048, 256, h * 256 + 128, WTKV, 256, 1024 + h * 128, 0, 128, scr); }
    bf16_t* WTL = (bf16_t*)(ws + W_WTL);
    for (int d = 0; d < 2; ++d) for (int n = 0; n < 8; ++n) for (int mat = 0; mat < 2; ++mat) {
        const float* w = INP(mat == 0 ? 10 : 12) + ((size_t)(l * 2 + d) * 8 + n) * 128 * 128;
        const int drow0 = d * 2048 + n * 256 + mat * 128;
        conv_rows(C, w, 128, 128, 0, WTL, 256, drow0, (n & 1) * 128, 128, scr);
        zero_rows(C, WTL, 256, drow0, ((n & 1) ^ 1) * 128, 128, 128);
    }
}
__device__ __forceinline__ void phase_wconv_late(Ctx& C, int l) {
    LAS float* scr = (LAS float*)(C.lds + C.wave * 16384);
    unsigned char* ws = C.ws;
    const float* win = INP(7) + (size_t)l * 1024 * INC;
    bf16_t* WTG = (bf16_t*)(ws + W_WTG);
    conv_rows(C, win, INC, 1024, 1024, WTG, 1024, 0, 0, 1024, scr);
    conv_rows(C, win, INC, 1024, 5120, WTG, 1024, 1024, 0, 1024, scr);
    conv_rows(C, win, INC, 1024, 6848, WTG, 1024, 2048, 0, 1024, scr);
    conv_rows(C, win, INC, 1024, 7872, (bf16_t*)(ws + W_WTGM), 1024, 0, 0, 3072, scr);
    for (int i = 0; i < 3; ++i) conv_rows(C, INP(25 + i) + (size_t)l * 1024 * 1024, 1024, 1024, 0, (bf16_t*)(ws + W_WTD) + (size_t)i * 1024 * 1024, 1024, 0, 0, 1024, scr);
    conv_rows(C, INP(28) + (size_t)l * 1024 * 1024, 1024, 1024, 0, (bf16_t*)(ws + W_WTO), 1024, 0, 0, 1024, scr);
}

__device__ __forceinline__ void phase_h(Ctx& C, int l, bf16_t* H) {
    const float* gain = INP(6) + l * 1024;
    for (int m = C.gw; m < MR; m += C.ngw) {
        const int b = m / SS, s = m - b * SS, r = (s < LC) ? 4 : b;
        const float* xr = resid_row(C, l, m);
        const float* mod = C.ctl + CT_MOD + (l * 5 + r) * 3072;
        f32x4 v[4]; float ss = 0.f;
#pragma unroll
        for (int j = 0; j < 4; ++j) { v[j] = *(const f32x4*)(xr + 4 * C.lane + 256 * j); ss += (v[j].x * v[j].x + v[j].y * v[j].y) + (v[j].z * v[j].z + v[j].w * v[j].w); }
        const float rstd = RSQ(wave_sum(ss) * (1.f / 1024.f) + EPS);
#pragma unroll
        for (int j = 0; j < 4; ++j) { const int c = 4 * C.lane + 256 * j;
            const f32x4 g = *(const f32x4*)(gain + c), sh = *(const f32x4*)(mod + c), sc = *(const f32x4*)(mod + 1024 + c);
            const f32x4 y = (v[j] * rstd) * g;
            const f32x4 o = y * (sc + 1.0f) + sh;
            u32x2 w; w.x = pk2(o.x, o.y); w.y = pk2(o.z, o.w);
            *(u32x2*)(H + (size_t)m * 1024 + c) = w; }
    }
}

using pg8::Unit;
struct ProbPlain {
    const bf16_t* A; const bf16_t* Bt; int lda, ldb, K;
    __device__ __forceinline__ void get(const Unit& u, const char*& a, const char*& b, int& lda_) const {
        a = (const char*)(A + (size_t)u.pm * 256 * lda); b = (const char*)(Bt + (size_t)u.pn * 256 * ldb); lda_ = lda; }
};
struct ProbLru {
    const bf16_t* A; const bf16_t* Bt; int ldb, K;
    __device__ __forceinline__ void get(const Unit& u, const char*& a, const char*& b, int& lda_) const {
        a = (const char*)(A + (size_t)u.pm * 256 * 1024 + (u.pn >> 1) * 256); b = (const char*)(Bt + (size_t)u.pn * 256 * 256); lda_ = 1024; }
};
struct ProbD {
    unsigned char* ws; int ldb, K;
    __device__ __forceinline__ void get(const Unit& u, const char*& a, const char*& b, int& lda_) const {
        const int i = (u.z & 7) >> 1;
        if ((u.z & 1) == 0) { a = (const char*)(ws + AR_MD + (size_t)u.pm * 256 * 1024 * 2); b = (const char*)(ws + W_WTGM + ((size_t)i * 1024 + u.pn * 256) * 1024 * 2); lda_ = 1024; }
        else { const size_t yo = (i == 0) ? AR_XA : (i == 1) ? AR_YB : AR_QN;
            a = (const char*)(ws + yo + (size_t)u.pm * 256 * 1024 * 2); b = (const char*)(ws + W_WTD + ((size_t)i * 1024 + u.pn * 256) * 1024 * 2); lda_ = 1024; }
    }
};

#define EPI_ARGS const f32x4 (&acc)[2][2][4][2], const Unit& u, int wr, int wc, int fr, int fq
template <size_t O0, int L0, size_t O1, int L1, size_t O2, int L2, int T1, int T2>
struct EpiStore3 {
    static constexpr bool PERM = true;
    unsigned char* ws;
    __device__ __forceinline__ void operator()(EPI_ARGS) const {
        bf16_t* bs; int ldc, ct;
        size_t off;
        if (u.pn < T1) { off = O0; ldc = L0; ct = u.pn; } else if (u.pn < T2) { off = O1; ldc = L1; ct = u.pn - T1; } else { off = O2; ldc = L2; ct = u.pn - T2; }
        bs = (bf16_t*)(ws + off);
        const int row0 = u.pm * 256 + wr * 64 + fr, col0 = ct * 256 + wc * 32 + 8 * fq;
#pragma unroll
        for (int ai = 0; ai < 2; ++ai)
#pragma unroll
            for (int m = 0; m < 4; ++m) { bf16_t* rowp = bs + (size_t)(row0 + ai * 128 + m * 16) * ldc + col0;
#pragma unroll
                for (int bj = 0; bj < 2; ++bj) { const f32x4 v0 = acc[ai][bj][m][0], v1 = acc[ai][bj][m][1];
                    u32x4 w; w.x = pg8::cvt_pk_bf16(v0[0], v0[1]); w.y = pg8::cvt_pk_bf16(v0[2], v0[3]); w.z = pg8::cvt_pk_bf16(v1[0], v1[1]); w.w = pg8::cvt_pk_bf16(v1[2], v1[3]);
                    *(u32x4*)(rowp + bj * 128) = w; } }
    }
};
struct EpiG1 {
    static constexpr bool PERM = true;
    unsigned char* ws; const float* cs;
    __device__ __forceinline__ void operator()(EPI_ARGS) const {
        bf16_t* bs; int ldc, ct;
        if (u.pn < 4) { bs = (bf16_t*)(ws + AR_XA); ldc = 1024; ct = u.pn; } else if (u.pn < 16) { bs = (bf16_t*)(ws + AR_RQKV); ldc = 3072; ct = u.pn - 4; } else { bs = (bf16_t*)(ws + AR_MD); ldc = 768; ct = u.pn - 16; }
        const int row0 = u.pm * 256 + wr * 64 + fr, col0 = ct * 256 + wc * 32 + 8 * fq;
        const bool rope = (u.pn >= 4) && (u.pn < 12), iskey = (u.pn >= 8);
        const int bq = u.pm / 17, s0 = (u.pm - bq * 17) * 256 + wr * 64 + fr;
        const int f0 = (wc * 4 + fq) * 4;
#pragma unroll
        for (int ai = 0; ai < 2; ++ai)
#pragma unroll
            for (int m = 0; m < 4; ++m) { bf16_t* rowp = bs + (size_t)(row0 + ai * 128 + m * 16) * ldc + col0;
                const int s = s0 + ai * 128 + m * 16, t = s - LC; const bool lat = s >= LC;
#pragma unroll
                for (int bj = 0; bj < 2; ++bj) { f32x4 v0 = acc[ai][bj][m][0], v1 = acc[ai][bj][m][1];
                    if (rope) {
                        if (lat) { const int pos = bj ? (t & 63) : (t >> 6); const f32x4 c = *(const f32x4*)(cs + pos * 64 + f0), sn = *(const f32x4*)(cs + 4096 + pos * 64 + f0);
                            const f32x4 a = v0 * c - v1 * sn, b = v1 * c + v0 * sn; v0 = a; v1 = b; }
                        if (iskey) { v0 = v0 * 0.0625f; v1 = v1 * 0.0625f; } }
                    u32x4 w; w.x = pg8::cvt_pk_bf16(v0[0], v0[1]); w.y = pg8::cvt_pk_bf16(v0[2], v0[3]); w.z = pg8::cvt_pk_bf16(v1[0], v1[1]); w.w = pg8::cvt_pk_bf16(v1[2], v1[3]);
                    *(u32x4*)(rowp + bj * 128) = w; }
                asm volatile("" ::: "memory"); }
    }
};
typedef f16_t f16x8 __attribute__((ext_vector_type(8)));
struct EpiLru {
    static constexpr bool PERM = true;
    const bf16_t* U; f16_t* RI; const float* ba; const float* bx; const float* sp;
    __device__ __forceinline__ void operator()(EPI_ARGS) const {
        const int row0 = u.pm * 256 + wr * 64 + fr, ch0 = u.pn * 128 + wc * 32 + 8 * fq;
        float bav[8], bxv[8], spv[8];
#pragma unroll
        for (int e = 0; e < 8; ++e) { bav[e] = ba[ch0 + e]; bxv[e] = bx[ch0 + e]; spv[e] = sp[ch0 + e] * (-8.f); }
#pragma unroll
        for (int ai = 0; ai < 2; ++ai)
#pragma unroll
            for (int m = 0; m < 4; ++m) { const int row = row0 + ai * 128 + m * 16;
                const u32x4 uw = *(const u32x4*)(U + (size_t)row * 1024 + ch0);
                float uv[8] = {lo_bf(uw.x), hi_bf(uw.x), lo_bf(uw.y), hi_bf(uw.y), lo_bf(uw.z), hi_bf(uw.z), lo_bf(uw.w), hi_bf(uw.w)};
                f16x8 la, bc;
#pragma unroll
                for (int e = 0; e < 8; ++e) { const float rp = acc[ai][0][m][e >> 2][e & 3] + bav[e], ip = acc[ai][1][m][e >> 2][e & 3] + bxv[e];
                    const float r = sigmoidf_(rp), ig = sigmoidf_(ip);
                    const float loga = r * spv[e];
                    const float bb = SQRT(fmaxf(-expm1f(2.f * loga), 0.f)) * (ig * uv[e]);
                    la[e] = (f16_t)(loga * LOG2E); bc[e] = (f16_t)bb; }
                *(f16x8*)(RI + (size_t)row * 2048 + ch0) = la; *(f16x8*)(RI + (size_t)row * 2048 + 1024 + ch0) = bc;
                asm volatile("" ::: "memory"); }
    }
};
struct EpiGate {
    static constexpr bool PERM = true;
    unsigned char* ws;
    __device__ __forceinline__ void operator()(EPI_ARGS) const {
        const int br = u.pn >> 2; const size_t yo = (br == 0) ? AR_XA : (br == 1) ? AR_YB : AR_QN; bf16_t* bs = (bf16_t*)(ws + yo); const int ldc = 1024;
        const int row0 = u.pm * 256 + wr * 64 + fr, col0 = (u.pn & 3) * 256 + wc * 32 + 8 * fq;
#pragma unroll
        for (int ai = 0; ai < 2; ++ai)
#pragma unroll
            for (int m = 0; m < 4; ++m) { bf16_t* rowp = bs + (size_t)(row0 + ai * 128 + m * 16) * ldc + col0;
#pragma unroll
                for (int bj = 0; bj < 2; ++bj) { const f32x4 v0 = acc[ai][bj][m][0], v1 = acc[ai][bj][m][1];
                    const u32x4 y = *(const u32x4*)(rowp + bj * 128);
                    u32x4 w; w.x = pg8::cvt_pk_bf16(lo_bf(y.x) * siluf_(v0[0]), hi_bf(y.x) * siluf_(v0[1])); w.y = pg8::cvt_pk_bf16(lo_bf(y.y) * siluf_(v0[2]), hi_bf(y.y) * siluf_(v0[3]));
                    w.z = pg8::cvt_pk_bf16(lo_bf(y.z) * siluf_(v1[0]), hi_bf(y.z) * siluf_(v1[1])); w.w = pg8::cvt_pk_bf16(lo_bf(y.w) * siluf_(v1[2]), hi_bf(y.w) * siluf_(v1[3]));
                    *(u32x4*)(rowp + bj * 128) = w; }
                asm volatile("" ::: "memory"); }
    }
};
struct EpiD {
    static constexpr bool PERM = true;
    bf16_t* Z; unsigned char* gs; bf16_t* ZP;
    __device__ __forceinline__ void operator()(EPI_ARGS) const {
        const int col0 = u.pn * 256 + wc * 32 + 8 * fq, i = (u.z & 7) >> 1; const bool part = u.z >= 8;
        const int row0 = part ? ((u.pm / 17) * 256 + wr * 64 + fr) : (u.pm * 256 + wr * 64 + fr);
        bf16_t* const zb = part ? (ZP + (size_t)i * 1024 * 1024) : Z;
        const unsigned tq = (unsigned)(((wr * 4 + wc) * 64 + fq * 16 + fr) * 64);
        if ((u.z & 1) == 0) {
#pragma unroll
            for (int ai = 0; ai < 2; ++ai)
#pragma unroll
                for (int m = 0; m < 4; ++m)
#pragma unroll
                    for (int bj = 0; bj < 2; ++bj) { const f32x4 v0 = acc[ai][bj][m][0], v1 = acc[ai][bj][m][1];
                        u32x4 w; w.x = pg8::cvt_pk_bf16(sigmoidf_(v0[0]), sigmoidf_(v0[1])); w.y = pg8::cvt_pk_bf16(sigmoidf_(v0[2]), sigmoidf_(v0[3]));
                        w.z = pg8::cvt_pk_bf16(sigmoidf_(v1[0]), sigmoidf_(v1[1])); w.w = pg8::cvt_pk_bf16(sigmoidf_(v1[2]), sigmoidf_(v1[3]));
                        *(u32x4*)(gs + (((ai * 4 + m) * 2 + bj) >> 2) * 32768 + tq + (((ai * 4 + m) * 2 + bj) & 3) * 16) = w; }
        } else {
#pragma unroll
            for (int ai = 0; ai < 2; ++ai)
#pragma unroll
                for (int m = 0; m < 4; ++m) { bf16_t* zrow = zb + (size_t)(row0 + ai * 128 + m * 16) * 1024 + col0;
#pragma unroll
                    for (int bj = 0; bj < 2; ++bj) { const f32x4 v0 = acc[ai][bj][m][0], v1 = acc[ai][bj][m][1];
                        const u32x4 g = *(const u32x4*)(gs + (((ai * 4 + m) * 2 + bj) >> 2) * 32768 + tq + (((ai * 4 + m) * 2 + bj) & 3) * 16); bf16_t* zp = zrow + bj * 128;
                        float o0 = lo_bf(g.x) * v0[0], o1 = hi_bf(g.x) * v0[1], o2 = lo_bf(g.y) * v0[2], o3 = hi_bf(g.y) * v0[3], o4 = lo_bf(g.z) * v1[0], o5 = hi_bf(g.z) * v1[1], o6 = lo_bf(g.w) * v1[2], o7 = hi_bf(g.w) * v1[3];
                        if (i > 0 && !part) { const u32x4 zo = *(const u32x4*)zp; o0 += lo_bf(zo.x); o1 += hi_bf(zo.x); o2 += lo_bf(zo.y); o3 += hi_bf(zo.y); o4 += lo_bf(zo.z); o5 += hi_bf(zo.z); o6 += lo_bf(zo.w); o7 += hi_bf(zo.w); }
                        u32x4 w; w.x = pg8::cvt_pk_bf16(o0, o1); w.y = pg8::cvt_pk_bf16(o2, o3); w.z = pg8::cvt_pk_bf16(o4, o5); w.w = pg8::cvt_pk_bf16(o6, o7); *(u32x4*)zp = w; }
                    asm volatile("" ::: "memory"); }
        }
    }
};
struct EpiOut {
    static constexpr bool PERM = false;
    const float* xlat; const float* xctx; float* olat; float* octx; const float* mod;
    __device__ __forceinline__ void operator()(EPI_ARGS) const {
        const int b = u.pm / 17, isctx = (u.pm - b * 17) == 0;
        const float* gate = mod + (isctx ? 4 : b) * 3072 + 2048;
        const int col0 = u.pn * 256 + wc * 32 + 4 * fq;
        f32x4 gv[2][2];
#pragma unroll
        for (int bj = 0; bj < 2; ++bj)
#pragma unroll
            for (int n = 0; n < 2; ++n) gv[bj][n] = *(const f32x4*)(gate + col0 + bj * 128 + n * 16);
#pragma unroll
        for (int ai = 0; ai < 2; ++ai)
#pragma unroll
            for (int m = 0; m < 4; ++m) { const int s = (u.pm - b * 17) * 256 + ai * 128 + wr * 64 + m * 16 + fr;
                const size_t off = isctx ? ((size_t)(b * LC + s) * 1024 + col0) : ((size_t)(b * TT + (s - LC)) * 1024 + col0);
                const float* xin = isctx ? xctx : xlat; float* xo = isctx ? octx : olat;
#pragma unroll
                for (int bj = 0; bj < 2; ++bj)
#pragma unroll
                    for (int n = 0; n < 2; ++n) { const f32x4 xv = *(const f32x4*)(xin + off + bj * 128 + n * 16);
                        *(f32x4*)(xo + off + bj * 128 + n * 16) = xv + gv[bj][n] * acc[ai][bj][m][n]; }
                asm volatile("" ::: "memory"); }
    }
};

__device__ __forceinline__ void phase_ret_rope(Ctx& C, bf16_t* RQKV) {
    const float* cs = C.ctl + CT_ROPER; const float* sn = cs + 4096;
    for (int m = C.gw; m < MR; m += C.ngw) {
        const int b = m / SS, s = m - b * SS; const bool lat = s >= LC; const int t = s - LC, prow = lat ? (t >> 6) : 0, pcol = lat ? (t & 63) : 0;
        bf16_t* row = RQKV + (size_t)m * 3072;
#pragma unroll
        for (int j = 0; j < 16; ++j) {
            const int idx = j * 64 + C.lane, f = idx & 63, half = (idx >> 6) & 1, h = (idx >> 7) & 3, tz = idx >> 9;
            bf16_t* p = row + tz * 1024 + h * 256 + half * 128 + f;
            const float x1 = bf2f(p[0]), x2 = bf2f(p[64]);
            float o1 = x1, o2 = x2;
            if (lat) { const int pos = half ? pcol : prow; const float c = cs[pos * 64 + f], sv = sn[pos * 64 + f]; o1 = x1 * c - x2 * sv; o2 = x2 * c + x1 * sv; }
            if (tz) { o1 *= 0.0625f; o2 *= 0.0625f; }
            p[0] = (bf16_t)f2bf(o1); p[64] = (bf16_t)f2bf(o2);
        }
    }
}

#define RS_STEP(o, cnt, st) do { const bool up_ = (C.lane & (st)) != 0; _Pragma("unroll") for (int e_ = 0; e_ < (cnt) / 2; ++e_) { \
        const float send_ = up_ ? o[e_] : o[e_ + (cnt) / 2]; const float keep_ = up_ ? o[e_ + (cnt) / 2] : o[e_]; o[e_] = keep_ + __shfl_xor(send_, (st)); } } while (0)

__device__ __forceinline__ void phase_ret_naive(Ctx& C, int l, const bf16_t* RQKV, bf16_t* OI) {
    LAS unsigned char* qs = C.lds + C.wave * 512;
    const int nbu = (MR / 8) * 16;
    for (int bu = C.bid; bu < nbu; bu += C.G) {
        const int hq = bu & 15, h = hq >> 2, qd = hq & 3, n = (bu >> 4) * 8 + C.wave;
        const int b = n / SS, sn_ = n - b * SS;
        const float lgf = C.ctl[CT_LG + (l * 2 + 0) * 4 + h], lgb = C.ctl[CT_LG + (l * 2 + 1) * 4 + h];
        const int pfn = sn_, pbn = (sn_ < LC) ? (LC - 1 - sn_) : (SS + LC - 1 - sn_);
        asm volatile("s_waitcnt lgkmcnt(0)" ::: "memory");
        *(LAS u32x2*)(qs + C.lane * 8) = *(const u32x2*)(RQKV + (size_t)n * 3072 + h * 256 + C.lane * 4);
        asm volatile("s_waitcnt lgkmcnt(0)" ::: "memory");
        float o[64];
#pragma unroll
        for (int e = 0; e < 64; ++e) o[e] = 0.f;
        for (int sm = C.lane; sm < SS; sm += 64) {
            const bf16_t* krow = RQKV + (size_t)(b * SS + sm) * 3072 + 1024 + h * 256;
            float dot = 0.f;
#pragma unroll 4
            for (int c = 0; c < 32; ++c) { const u32x4 kv = *(const u32x4*)(krow + c * 8); const u32x4 qv = *(const LAS u32x4*)(qs + c * 16);
                dot += lo_bf(kv.x) * lo_bf(qv.x) + hi_bf(kv.x) * hi_bf(qv.x) + lo_bf(kv.y) * lo_bf(qv.y) + hi_bf(kv.y) * hi_bf(qv.y)
                     + lo_bf(kv.z) * lo_bf(qv.z) + hi_bf(kv.z) * hi_bf(qv.z) + lo_bf(kv.w) * lo_bf(qv.w) + hi_bf(kv.w) * hi_bf(qv.w); }
            const int pfm = sm, pbm = (sm < LC) ? (LC - 1 - sm) : (SS + LC - 1 - sm);
            float w = 0.f;
            if (pfn >= pfm) w += EX2(lgf * (float)(pfn - pfm));
            if (pbn >= pbm) w += EX2(lgb * (float)(pbn - pbm));
            const float ws_ = w * dot;
            const bf16_t* vrow = krow + 1024 + qd * 64;
#pragma unroll
            for (int c = 0; c < 8; ++c) { const u32x4 vv = *(const u32x4*)(vrow + c * 8);
                o[c * 8 + 0] += ws_ * lo_bf(vv.x); o[c * 8 + 1] += ws_ * hi_bf(vv.x); o[c * 8 + 2] += ws_ * lo_bf(vv.y); o[c * 8 + 3] += ws_ * hi_bf(vv.y);
                o[c * 8 + 4] += ws_ * lo_bf(vv.z); o[c * 8 + 5] += ws_ * hi_bf(vv.z); o[c * 8 + 6] += ws_ * lo_bf(vv.w); o[c * 8 + 7] += ws_ * hi_bf(vv.w); }
        }
        RS_STEP(o, 64, 32); RS_STEP(o, 32, 16); RS_STEP(o, 16, 8); RS_STEP(o, 8, 4); RS_STEP(o, 4, 2); RS_STEP(o, 2, 1);
        OI[(size_t)n * 1024 + h * 256 + qd * 64 + C.lane] = (bf16_t)f2bf(o[0]);
    }
}
__device__ __forceinline__ void phase_ret_ln(Ctx& C, int l, bf16_t* OI) {
    const float* gain = INP(16) + l * 1024;
    for (int m = C.gw; m < MR; m += C.ngw) {
#pragma unroll
        for (int h = 0; h < 4; ++h) { bf16_t* p = OI + (size_t)m * 1024 + h * 256 + C.lane * 4;
            const u32x2 w = *(const u32x2*)p; float x0 = lo_bf(w.x), x1 = hi_bf(w.x), x2 = lo_bf(w.y), x3 = hi_bf(w.y);
            const float mean = wave_sum((x0 + x1) + (x2 + x3)) * (1.f / 256.f);
            x0 -= mean; x1 -= mean; x2 -= mean; x3 -= mean;
            const float var = wave_sum((x0 * x0 + x1 * x1) + (x2 * x2 + x3 * x3)) * (1.f / 256.f);
            const float rstd = RSQ(var + EPS);
            const f32x4 g = *(const f32x4*)(gain + h * 256 + C.lane * 4);
            u32x2 o; o.x = pk2(x0 * rstd * g.x, x1 * rstd * g.y); o.y = pk2(x2 * rstd * g.z, x3 * rstd * g.w); *(u32x2*)p = o; }
    }
}

__device__ __forceinline__ void phase_md_post(Ctx& C, int l, bf16_t* MD) {
    const float* qn = INP(17) + l * 384; const float* kvn = INP(19) + l * 256; const float* gkr = INP(24) + l * 64;
    const float* cs = C.ctl + CT_ROPEM; const float* sn = cs + 1024;
    for (int m = C.gw; m < MR; m += C.ngw) {
        const int b = m / SS, s = m - b * SS; const bool lat = s >= LC; const int t = s - LC;
        bf16_t* row = MD + (size_t)m * 768;
        {   float x[6]; float ss = 0.f;
#pragma unroll
            for (int j = 0; j < 3; ++j) { const unsigned w = *(const unsigned*)(row + 2 * C.lane + 128 * j); x[2 * j] = lo_bf(w); x[2 * j + 1] = hi_bf(w); ss += x[2 * j] * x[2 * j] + x[2 * j + 1] * x[2 * j + 1]; }
            const float rstd = RSQ(wave_sum(ss) * (1.f / 384.f) + EPS);
#pragma unroll
            for (int j = 0; j < 3; ++j) { const int c = 2 * C.lane + 128 * j; *(unsigned*)(row + c) = pk2(x[2 * j] * rstd * qn[c], x[2 * j + 1] * rstd * qn[c + 1]); } }
        {   float x[4]; float ss = 0.f;
#pragma unroll
            for (int j = 0; j < 2; ++j) { const unsigned w = *(const unsigned*)(row + 384 + 2 * C.lane + 128 * j); x[2 * j] = lo_bf(w); x[2 * j + 1] = hi_bf(w); ss += x[2 * j] * x[2 * j] + x[2 * j + 1] * x[2 * j + 1]; }
            const float rstd = RSQ(wave_sum(ss) * (1.f / 256.f) + EPS);
#pragma unroll
            for (int j = 0; j < 2; ++j) { const int c = 2 * C.lane + 128 * j; *(unsigned*)(row + 384 + c) = pk2(x[2 * j] * rstd * kvn[c], x[2 * j + 1] * rstd * kvn[c + 1]); } }
        {   const float x = bf2f(row[640 + C.lane]);
            const float rstd = RSQ(wave_sum(x * x) * (1.f / 64.f) + EPS);
            float y = x * rstd * gkr[C.lane];
            if (lat) { const float pr = __shfl_xor(y, 16); const float rot = (C.lane & 16) ? pr : -pr; const int f = C.lane & 15, pos = (C.lane < 32) ? (t >> 6) : (t & 63);
                y = y * cs[pos * 16 + f] + rot * sn[pos * 16 + f]; }
            row[640 + C.lane] = (bf16_t)f2bf(y); }
    }
}
__device__ __forceinline__ void phase_qk_post(Ctx& C, int l, bf16_t* QN, bf16_t* QP, bf16_t* KV) {
    const float* gqn = INP(21) + l * 128; const float* gqr = INP(22) + l * 64; const float* gkn = INP(23) + l * 128;
    const float* cs = C.ctl + CT_ROPEM; const float* sn = cs + 1024;
    for (int m = C.gw; m < MR; m += C.ngw) {
        const int b = m / SS, s = m - b * SS; const bool lat = s >= LC; const int t = s - LC;
        bf16_t* qrow = QN + (size_t)m * 1024; bf16_t* prow = QP + (size_t)m * 512; bf16_t* krow = KV + (size_t)m * 2048;
#pragma unroll
        for (int h = 0; h < 8; ++h) {
            {   unsigned* p = (unsigned*)(qrow + h * 128 + 2 * C.lane); const unsigned w = *p; const float x0 = lo_bf(w), x1 = hi_bf(w);
                const float rstd = RSQ(wave_sum(x0 * x0 + x1 * x1) * (1.f / 128.f) + EPS);
                *p = pk2(x0 * rstd * gqn[2 * C.lane] * QSCALE, x1 * rstd * gqn[2 * C.lane + 1] * QSCALE); }
            {   bf16_t* p = prow + h * 64 + C.lane; const float x = bf2f(*p);
                const float rstd = RSQ(wave_sum(x * x) * (1.f / 64.f) + EPS);
                float y = x * rstd * gqr[C.lane];
                if (lat) { const float pr = __shfl_xor(y, 16); const float rot = (C.lane & 16) ? pr : -pr; const int f = C.lane & 15, pos = (C.lane < 32) ? (t >> 6) : (t & 63);
                    y = y * cs[pos * 16 + f] + rot * sn[pos * 16 + f]; }
                *p = (bf16_t)f2bf(y * QSCALE); }
            {   unsigned* p = (unsigned*)(krow + h * 128 + 2 * C.lane); const unsigned w = *p; const float x0 = lo_bf(w), x1 = hi_bf(w);
                const float rstd = RSQ(wave_sum(x0 * x0 + x1 * x1) * (1.f / 128.f) + EPS);
                *p = pk2(x0 * rstd * gkn[2 * C.lane], x1 * rstd * gkn[2 * C.lane + 1]); }
        }
    }
}

__device__ __forceinline__ void phase_attn_naive(Ctx& C, bool with_ctx, bf16_t* QN, const bf16_t* QP, const bf16_t* KV, const bf16_t* MD) {
    LAS unsigned char* qs = C.lds + C.wave * 512;
    const int nlat = NB * 8 * (TT / 8), nctx = with_ctx ? NB * 8 * (LC / 8) : 0;
    for (int bu = C.bid; bu < nlat + nctx; bu += C.G) {
        int b, h, s, nkeys;
        if (bu < nlat) { const int tb = bu % (TT / 8), bh = bu / (TT / 8); b = bh >> 3; h = bh & 7; s = LC + tb * 8 + C.wave; nkeys = SS; }
        else { const int r = bu - nlat, tb = r % (LC / 8), bh = r / (LC / 8); b = bh >> 3; h = bh & 7; s = tb * 8 + C.wave; nkeys = LC; }
        const size_t m = (size_t)b * SS + s;
        asm volatile("s_waitcnt lgkmcnt(0)" ::: "memory");
        if (C.lane < 32) *(LAS u32x2*)(qs + C.lane * 8) = *(const u32x2*)(QN + m * 1024 + h * 128 + C.lane * 4);
        else if (C.lane < 48) *(LAS u32x2*)(qs + 256 + (C.lane - 32) * 8) = *(const u32x2*)(QP + m * 512 + h * 64 + (C.lane - 32) * 4);
        asm volatile("s_waitcnt lgkmcnt(0)" ::: "memory");
        float o[128];
#pragma unroll
        for (int e = 0; e < 128; ++e) o[e] = 0.f;
        float mrun = -1e30f, lrun = 0.f;
        for (int key = C.lane; key < nkeys; key += 64) {
            const size_t kr = (size_t)b * SS + key;
            const bf16_t* kn = KV + kr * 2048 + h * 128; const bf16_t* kro = MD + kr * 768 + 640;
            float dot = 0.f;
#pragma unroll 4
            for (int c = 0; c < 16; ++c) { const u32x4 kv = *(const u32x4*)(kn + c * 8); const u32x4 qv = *(const LAS u32x4*)(qs + c * 16);
                dot += lo_bf(kv.x) * lo_bf(qv.x) + hi_bf(kv.x) * hi_bf(qv.x) + lo_bf(kv.y) * lo_bf(qv.y) + hi_bf(kv.y) * hi_bf(qv.y)
                     + lo_bf(kv.z) * lo_bf(qv.z) + hi_bf(kv.z) * hi_bf(qv.z) + lo_bf(kv.w) * lo_bf(qv.w) + hi_bf(kv.w) * hi_bf(qv.w); }
#pragma unroll 4
            for (int c = 0; c < 8; ++c) { const u32x4 kv = *(const u32x4*)(kro + c * 8); const u32x4 qv = *(const LAS u32x4*)(qs + 256 + c * 16);
                dot += lo_bf(kv.x) * lo_bf(qv.x) + hi_bf(kv.x) * hi_bf(qv.x) + lo_bf(kv.y) * lo_bf(qv.y) + hi_bf(kv.y) * hi_bf(qv.y)
                     + lo_bf(kv.z) * lo_bf(qv.z) + hi_bf(kv.z) * hi_bf(qv.z) + lo_bf(kv.w) * lo_bf(qv.w) + hi_bf(kv.w) * hi_bf(qv.w); }
            const float mnew = fmaxf(mrun, dot), alpha = EX2(mrun - mnew), p = EX2(dot - mnew);
            lrun = lrun * alpha + p; mrun = mnew;
            const bf16_t* vrow = KV + kr * 2048 + 1024 + h * 128;
#pragma unroll
            for (int c = 0; c < 16; ++c) { const u32x4 vv = *(const u32x4*)(vrow + c * 8);
                o[c * 8 + 0] = o[c * 8 + 0] * alpha + p * lo_bf(vv.x); o[c * 8 + 1] = o[c * 8 + 1] * alpha + p * hi_bf(vv.x);
                o[c * 8 + 2] = o[c * 8 + 2] * alpha + p * lo_bf(vv.y); o[c * 8 + 3] = o[c * 8 + 3] * alpha + p * hi_bf(vv.y);
                o[c * 8 + 4] = o[c * 8 + 4] * alpha + p * lo_bf(vv.z); o[c * 8 + 5] = o[c * 8 + 5] * alpha + p * hi_bf(vv.z);
                o[c * 8 + 6] = o[c * 8 + 6] * alpha + p * lo_bf(vv.w); o[c * 8 + 7] = o[c * 8 + 7] * alpha + p * hi_bf(vv.w); }
        }
        const float mall = wave_max(mrun), fsc = EX2(mrun - mall);
        const float lall = wave_sum(lrun * fsc);
#pragma unroll
        for (int e = 0; e < 128; ++e) o[e] *= fsc;
        RS_STEP(o, 128, 32); RS_STEP(o, 64, 16); RS_STEP(o, 32, 8); RS_STEP(o, 16, 4); RS_STEP(o, 8, 2); RS_STEP(o, 4, 1);
        const float inv = 1.f / lall;
        *(unsigned*)(QN + m * 1024 + h * 128 + 2 * C.lane) = pk2(o[0] * inv, o[1] * inv);
    }
}

__device__ __forceinline__ void phase_conv(Ctx& C, int l, const bf16_t* XA, bf16_t* U) {
    const float* cw = INP(8) + l * 4 * 1024; const float* cb = INP(9) + l * 1024;
    const int gt = C.bid * NTHR + C.tid, ngt = C.G * NTHR;
    for (int it = gt; it < MR * 128; it += ngt) {
        const int m = it >> 7, c0 = (it & 127) * 8, b = m / SS, s = m - b * SS;
        const int lo = (s < LC) ? 0 : LC, hi = (s < LC) ? LC : SS;
        float a[8];
#pragma unroll
        for (int e = 0; e < 8; ++e) a[e] = cb[c0 + e];
#pragma unroll
        for (int j = 0; j < 4; ++j) { const int sj = s + j - 2;
            if (sj >= lo && sj < hi) { const u32x4 xv = *(const u32x4*)(XA + (size_t)(b * SS + sj) * 1024 + c0); const float* w = cw + j * 1024 + c0;
                a[0] += w[0] * lo_bf(xv.x); a[1] += w[1] * hi_bf(xv.x); a[2] += w[2] * lo_bf(xv.y); a[3] += w[3] * hi_bf(xv.y);
                a[4] += w[4] * lo_bf(xv.z); a[5] += w[5] * hi_bf(xv.z); a[6] += w[6] * lo_bf(xv.w); a[7] += w[7] * hi_bf(xv.w); } }
        u32x4 o; o.x = pk2(a[0], a[1]); o.y = pk2(a[2], a[3]); o.z = pk2(a[4], a[5]); o.w = pk2(a[6], a[7]);
        *(u32x4*)(U + (size_t)m * 1024 + c0) = o;
    }
}
typedef f16_t f16x2 __attribute__((ext_vector_type(2)));
__device__ __forceinline__ void phase_scan1(Ctx& C, int d, const f16_t* RI, float* SUM) {
    for (int un = C.gw; un < NB * 68 * 8; un += C.ngw) {
        const int cg_ = un & 7, sg = (un >> 3) % 68, b = (un >> 3) / 68, ch = cg_ * 128 + 2 * C.lane;
        float A0 = 1.f, A1 = 1.f, H0 = 0.f, H1 = 0.f;
        const f16_t* base = RI + (size_t)(b * SS + sg * 64) * 2048 + ch;
#pragma unroll 16
        for (int i = 0; i < 64; ++i) { const int r = d ? (63 - i) : i;
            const f16x2 la = *(const f16x2*)(base + (size_t)r * 2048), bc = *(const f16x2*)(base + (size_t)r * 2048 + 1024);
            const float a0 = EX2((float)la[0]), a1 = EX2((float)la[1]);
            H0 = a0 * H0 + (float)bc[0]; H1 = a1 * H1 + (float)bc[1]; A0 *= a0; A1 *= a1; }
        float* sp = SUM + ((size_t)(b * 68 + sg) * 1024 + ch) * 2;
        *(f32x4*)sp = (f32x4){A0, H0, A1, H1};
    }
}
__device__ __forceinline__ void phase_scan3(Ctx& C, int d, const f16_t* RI, const float* SUM, bf16_t* YA) {
    for (int un = C.gw; un < NB * 68 * 8; un += C.ngw) {
        const int cg_ = un & 7, sg = (un >> 3) % 68, b = (un >> 3) / 68, ch = cg_ * 128 + 2 * C.lane;
        float H0 = 0.f, H1 = 0.f;
        const int npre = d ? ((sg < 4) ? (3 - sg) : (71 - sg)) : sg;
#pragma unroll 4
        for (int p = 0; p < npre; ++p) { const int ps = d ? ((p < 4) ? (3 - p) : (71 - p)) : p;
            const f32x4 v = *(const f32x4*)(SUM + ((size_t)(b * 68 + ps) * 1024 + ch) * 2);
            H0 = v[0] * H0 + v[1]; H1 = v[2] * H1 + v[3]; }
        const f16_t* base = RI + (size_t)(b * SS + sg * 64) * 2048 + ch;
        bf16_t* yb = YA + (size_t)(b * SS + sg * 64) * 1024 + ch;
#pragma unroll 16
        for (int i = 0; i < 64; ++i) { const int r = d ? (63 - i) : i;
            const f16x2 la = *(const f16x2*)(base + (size_t)r * 2048), bc = *(const f16x2*)(base + (size_t)r * 2048 + 1024);
            const float a0 = EX2((float)la[0]), a1 = EX2((float)la[1]);
            H0 = a0 * H0 + (float)bc[0]; H1 = a1 * H1 + (float)bc[1];
            unsigned* yp = (unsigned*)(yb + (size_t)r * 1024);
            if (d == 0) *yp = pk2(H0, H1); else { const unsigned w = *yp; *yp = pk2(lo_bf(w) + H0, hi_bf(w) + H1); } }
    }
}

typedef float f32x16 __attribute__((ext_vector_type(16)));
typedef short v4i16_t __attribute__((ext_vector_type(4)));
constexpr int AT_KP = 400, AT_VP = 320;
constexpr int AT_KB = 64 * AT_KP, AT_VB = 64 * AT_VP, AT_STG = AT_KB + AT_VB, AT_WSF = 2 * AT_STG;
__device__ __forceinline__ int crow(int r, int hi) { return (r & 3) + 8 * (r >> 2) + 4 * hi; }
__device__ __forceinline__ bf16x8 pack8(float a, float b, float c, float d, float e, float f, float g, float h) {
    u32x4 w; w.x = pg8::cvt_pk_bf16(a, b); w.y = pg8::cvt_pk_bf16(c, d); w.z = pg8::cvt_pk_bf16(e, f); w.w = pg8::cvt_pk_bf16(g, h); return __builtin_bit_cast(bf16x8, w); }
__device__ __forceinline__ bf16x8 tr2(LAS unsigned char* p0, LAS unsigned char* p1) {
    const v4i16_t lo = __builtin_amdgcn_ds_read_tr16_b64_v4i16((LAS v4i16_t*)p0), hi = __builtin_amdgcn_ds_read_tr16_b64_v4i16((LAS v4i16_t*)p1);
    return (bf16x8){lo[0], lo[1], lo[2], lo[3], hi[0], hi[1], hi[2], hi[3]}; }

__device__ __forceinline__ void phase_attn(Ctx& C, bool with_ctx, bf16_t* QN, const bf16_t* QP, const bf16_t* KV, const bf16_t* MD) {
    const int lane = C.lane, r32 = lane & 31, hi = lane >> 5, wave = C.wave, tid = C.tid;
    LAS unsigned char* lds = C.lds;
    LAS float* wsf = (LAS float*)(lds + AT_WSF + wave * 128);
    const int nunits = 512 + (with_ctx ? 32 : 0);
    const int rowA = tid >> 4, ccA = tid & 15, rowR = tid >> 3, ccR = tid & 7;
    const int i16 = lane & 15, q4 = i16 >> 2, p4 = i16 & 3, g1 = (lane >> 4) & 1;
    const int vb = AT_KB + (4 * hi + q4) * AT_VP + (16 * g1 + 4 * p4) * 2;
    for (int un = C.bid; un < nunits; un += C.G) {
        int bh, qb, isctx;
        if (un < 512) { const int x = un & 7, jj = un >> 3; bh = x * 4 + (jj >> 4); qb = jj & 15; isctx = 0; } else { bh = un - 512; qb = 0; isctx = 1; }
        const int b = bh >> 3, h = bh & 7;
        const size_t kb0 = (size_t)b * SS;
        const size_t m0 = kb0 + (isctx ? 0 : LC + qb * 256) + wave * 32;
        const int NT = (isctx ? LC : SS) / 64;
        bf16x8 qf[12];
        {   const bf16_t* qn = QN + (m0 + r32) * 1024 + h * 128 + hi * 8; const bf16_t* qp = QP + (m0 + r32) * 512 + h * 64 + hi * 8;
#pragma unroll
            for (int s = 0; s < 8; ++s) qf[s] = *(const bf16x8*)(qn + s * 16);
#pragma unroll
            for (int s = 0; s < 4; ++s) qf[8 + s] = *(const bf16x8*)(qp + s * 16); }
        f32x16 o[4];
#pragma unroll
        for (int d = 0; d < 4; ++d)
#pragma unroll
            for (int r = 0; r < 16; ++r) o[d][r] = 0.f;
        float mrun = -1e30f, lrun = 0.f;
        u32x4 kn0, kn1, kr0, vv0, vv1;
        const unsigned kvo = (unsigned)(((kb0 + rowA) * 2048 + h * 128 + ccA * 8) * 2);
        const unsigned kro = (unsigned)(((kb0 + rowR) * 768 + 640 + ccR * 8) * 2);
#define AT_LOAD(t) do { const char* kp_ = (const char*)KV + (size_t)(t) * (64 * 2048 * 2); kn0 = *(const u32x4*)(kp_ + kvo); kn1 = *(const u32x4*)(kp_ + 32 * 2048 * 2 + kvo); vv0 = *(const u32x4*)(kp_ + 1024 * 2 + kvo); vv1 = *(const u32x4*)(kp_ + (32 * 2048 + 1024) * 2 + kvo); \
        kr0 = *(const u32x4*)((const char*)MD + (size_t)(t) * (64 * 768 * 2) + kro); } while (0)
#define AT_WRITE(sb) do { LAS unsigned char* s_ = lds + (sb); *(LAS u32x4*)(s_ + rowA * AT_KP + ccA * 16) = kn0; *(LAS u32x4*)(s_ + (rowA + 32) * AT_KP + ccA * 16) = kn1; \
        *(LAS u32x4*)(s_ + rowR * AT_KP + 256 + ccR * 16) = kr0; *(LAS u32x4*)(s_ + AT_KB + rowA * AT_VP + ccA * 16) = vv0; *(LAS u32x4*)(s_ + AT_KB + (rowA + 32) * AT_VP + ccA * 16) = vv1; } while (0)
#define AT_QK(sbv) do { _Pragma("unroll") for (int r = 0; r < 16; ++r) { p0[r] = 0.f; p1[r] = 0.f; } \
        LAS unsigned char* ka = lds + (sbv) + r32 * AT_KP + hi * 16; __builtin_amdgcn_s_setprio(1); \
        _Pragma("unroll") for (int s = 0; s < 12; ++s) { const bf16x8 a0 = *(const LAS bf16x8*)(ka + s * 32), a1 = *(const LAS bf16x8*)(ka + 32 * AT_KP + s * 32); \
            p0 = __builtin_amdgcn_mfma_f32_32x32x16_bf16(a0, qf[s], p0, 0, 0, 0); p1 = __builtin_amdgcn_mfma_f32_32x32x16_bf16(a1, qf[s], p1, 0, 0, 0); \
            asm volatile("" ::: "memory"); } \
        __builtin_amdgcn_s_setprio(0); } while (0)
#define AT_SM() do { float rm = fmaxf(p0[0], p1[0]); \
        _Pragma("unroll") for (int r = 1; r < 16; ++r) rm = fmaxf(rm, fmaxf(p0[r], p1[r])); \
        rm = fmaxf(rm, __shfl_xor(rm, 32)); \
        if (__any(rm > mrun + 8.f)) { const float mnew = fmaxf(mrun, rm), alpha = EX2(mrun - mnew); mrun = mnew; lrun *= alpha; \
            if (hi == 0) wsf[r32] = alpha; \
            _Pragma("unroll") for (int r = 0; r < 16; ++r) { const float a = wsf[crow(r, hi)]; _Pragma("unroll") for (int d = 0; d < 4; ++d) o[d][r] *= a; } } \
        float ls = 0.f; \
        _Pragma("unroll") for (int r = 0; r < 16; ++r) { p0[r] = EX2(p0[r] - mrun); p1[r] = EX2(p1[r] - mrun); ls += p0[r] + p1[r]; } \
        lrun += ls; \
        pa0 = pack8(p0[0], p0[1], p0[2], p0[3], p0[4], p0[5], p0[6], p0[7]); pa1 = pack8(p0[8], p0[9], p0[10], p0[11], p0[12], p0[13], p0[14], p0[15]); \
        pa2 = pack8(p1[0], p1[1], p1[2], p1[3], p1[4], p1[5], p1[6], p1[7]); pa3 = pack8(p1[8], p1[9], p1[10], p1[11], p1[12], p1[13], p1[14], p1[15]); } while (0)
#define AT_PV(sbv) do { LAS unsigned char* vp = lds + (sbv) + vb; __builtin_amdgcn_s_setprio(1); \
        _Pragma("unroll") for (int d = 0; d < 4; ++d) { \
            o[d] = __builtin_amdgcn_mfma_f32_32x32x16_bf16(pa0, tr2(vp + d * 64, vp + d * 64 + 8 * AT_VP), o[d], 0, 0, 0); \
            o[d] = __builtin_amdgcn_mfma_f32_32x32x16_bf16(pa1, tr2(vp + d * 64 + 16 * AT_VP, vp + d * 64 + 24 * AT_VP), o[d], 0, 0, 0); \
            o[d] = __builtin_amdgcn_mfma_f32_32x32x16_bf16(pa2, tr2(vp + d * 64 + 32 * AT_VP, vp + d * 64 + 40 * AT_VP), o[d], 0, 0, 0); \
            o[d] = __builtin_amdgcn_mfma_f32_32x32x16_bf16(pa3, tr2(vp + d * 64 + 48 * AT_VP, vp + d * 64 + 56 * AT_VP), o[d], 0, 0, 0); \
            asm volatile("" ::: "memory"); } \
        __builtin_amdgcn_s_setprio(0); } while (0)
        AT_LOAD(0); AT_WRITE(0);
        __syncthreads();
        bf16x8 pa0, pa1, pa2, pa3;
        if (wave < 4) {
            for (int t = 0; t < NT; ++t) {
                const int sb = (t & 1) * AT_STG;
                if (t + 1 < NT) AT_LOAD(t + 1);
                f32x16 p0, p1;
                AT_QK(sb);
                __syncthreads();
                if (t + 1 < NT) AT_WRITE(AT_STG - sb);
                AT_SM(); AT_PV(sb);
                __syncthreads();
            }
            __syncthreads(); __syncthreads();
        } else {
            for (int t = 0; t <= NT; ++t) {
                const int sb = (t & 1) * AT_STG;
                if (t + 1 < NT) AT_LOAD(t + 1);
                if (t > 0) AT_PV(AT_STG - sb);
                __syncthreads();
                if (t + 1 < NT) AT_WRITE(AT_STG - sb);
                if (t < NT) { f32x16 p0, p1; AT_QK(sb); AT_SM(); }
                __syncthreads();
            }
        }
#undef AT_QK
#undef AT_SM
#undef AT_PV
#undef AT_LOAD
#undef AT_WRITE
        const float ltot = lrun + __shfl_xor(lrun, 32);
        if (hi == 0) wsf[r32] = 1.f / ltot;
        bf16_t* op = QN + (m0 + 4 * hi) * 1024 + h * 128 + r32;
#pragma unroll
        for (int r = 0; r < 16; ++r) { const float inv = wsf[crow(r, hi)];
#pragma unroll
            for (int d = 0; d < 4; ++d) op[d * 32] = (bf16_t)f2bf(o[d][r] * inv);
            op += ((r & 3) == 3) ? 5 * 1024 : 1024; asm volatile("" : "+v"(op)); }
        __syncthreads();
    }
}

constexpr int RI_KP = 528, RI_VP = 576, RI_PTP = 272;
constexpr int RI_A = 0, RI_PT = 128 * RI_VP;
__device__ __forceinline__ void phase_ret_intra(Ctx& C, int l, const bf16_t* RQKV, bf16_t* OI) {
    const int lane = C.lane, r32 = lane & 31, hi = lane >> 5, wave = C.wave, tid = C.tid;
    LAS unsigned char* lds = C.lds;
    const int i16 = lane & 15, q4 = i16 >> 2, p4 = i16 & 3, g1 = (lane >> 4) & 1;
    const int nb = wave & 3, wh = wave >> 2;
    const int srow = tid >> 5, scc = tid & 31;
    for (int un = C.bid; un < NB * 4 * 34; un += C.G) {
        const int c = un % 34, bh = un / 34, b = bh >> 2, h = bh & 3;
        const size_t row0 = (size_t)b * SS + c * 128;
        const float lgf = C.ctl[CT_LG + (l * 2 + 0) * 4 + h], lgb = C.ctl[CT_LG + (l * 2 + 1) * 4 + h];
        const bf16_t* gk = RQKV + (row0 + srow) * 3072 + 1024 + h * 256 + scc * 8;
        u32x4 st[8];
        {   const bf16_t* gp = gk;
#pragma unroll
            for (int j = 0; j < 8; ++j) { st[j] = *(const u32x4*)gp; gp += 16 * 3072; asm volatile("" : "+v"(gp)); } }
#pragma unroll
        for (int j = 0; j < 8; ++j) *(LAS u32x4*)(lds + RI_A + (srow + 16 * j) * RI_KP + scc * 16) = st[j];
        __syncthreads();
        {   const bf16_t* gp = gk + 1024;
#pragma unroll
            for (int j = 0; j < 8; ++j) { st[j] = *(const u32x4*)gp; gp += 16 * 3072; asm volatile("" : "+v"(gp)); } }
        {
            f32x16 x0, x1;
#pragma unroll
            for (int r = 0; r < 16; ++r) { x0[r] = 0.f; x1[r] = 0.f; }
            const bf16_t* gq = RQKV + (row0 + nb * 32 + r32) * 3072 + h * 256 + hi * 8;
            LAS unsigned char* ka = lds + RI_A + (wh * 64 + r32) * RI_KP + hi * 16;
#pragma unroll
            for (int s = 0; s < 16; ++s) { const bf16x8 qf = *(const bf16x8*)(gq + s * 16);
                const bf16x8 a0 = *(const LAS bf16x8*)(ka + s * 32), a1 = *(const LAS bf16x8*)(ka + 32 * RI_KP + s * 32);
                x0 = __builtin_amdgcn_mfma_f32_32x32x16_bf16(a0, qf, x0, 0, 0, 0); x1 = __builtin_amdgcn_mfma_f32_32x32x16_bf16(a1, qf, x1, 0, 0, 0);
                if ((s & 3) == 3) asm volatile("" ::: "memory"); }
            const int n = nb * 32 + r32;
            LAS unsigned char* pt = lds + RI_PT + n * RI_PTP + (wh * 64 + 4 * hi) * 2;
#pragma unroll
            for (int g = 0; g < 4; ++g) { float w0[4], w1[4];
#pragma unroll
                for (int e = 0; e < 4; ++e) { const int m0 = wh * 64 + 8 * g + 4 * hi + e; const float d0 = (float)(n - m0), d1 = d0 - 32.f;
                    const float f0 = EX2(lgf * fmaxf(d0, 0.f)) * fminf(fmaxf(d0 + 1.f, 0.f), 1.f) + EX2(lgb * fmaxf(-d0, 0.f)) * fminf(fmaxf(1.f - d0, 0.f), 1.f);
                    const float f1 = EX2(lgf * fmaxf(d1, 0.f)) * fminf(fmaxf(d1 + 1.f, 0.f), 1.f) + EX2(lgb * fmaxf(-d1, 0.f)) * fminf(fmaxf(1.f - d1, 0.f), 1.f);
                    w0[e] = x0[4 * g + e] * f0; w1[e] = x1[4 * g + e] * f1; }
                u32x2 o0, o1; o0.x = pg8::cvt_pk_bf16(w0[0], w0[1]); o0.y = pg8::cvt_pk_bf16(w0[2], w0[3]); o1.x = pg8::cvt_pk_bf16(w1[0], w1[1]); o1.y = pg8::cvt_pk_bf16(w1[2], w1[3]);
                *(LAS u32x2*)(pt + g * 16) = o0; *(LAS u32x2*)(pt + 64 + g * 16) = o1; }
        }
        __syncthreads();
#pragma unroll
        for (int j = 0; j < 8; ++j) *(LAS u32x4*)(lds + RI_A + (srow + 16 * j) * RI_VP + scc * 16) = st[j];
        __syncthreads();
        {
            f32x16 o[4];
#pragma unroll
            for (int d = 0; d < 4; ++d)
#pragma unroll
                for (int r = 0; r < 16; ++r) o[d][r] = 0.f;
            bf16x8 pa[8];
            LAS unsigned char* pr = lds + RI_PT + (nb * 32 + r32) * RI_PTP + hi * 16;
#pragma unroll
            for (int s = 0; s < 8; ++s) pa[s] = *(const LAS bf16x8*)(pr + s * 32);
            LAS unsigned char* vp = lds + RI_A + (8 * hi + q4) * RI_VP + (wh * 128 + 16 * g1 + 4 * p4) * 2;
#pragma unroll
            for (int d = 0; d < 4; ++d) {
#pragma unroll
                for (int s = 0; s < 8; ++s) o[d] = __builtin_amdgcn_mfma_f32_32x32x16_bf16(pa[s], tr2(vp + d * 64 + s * 16 * RI_VP, vp + d * 64 + (s * 16 + 4) * RI_VP), o[d], 0, 0, 0);
                asm volatile("" ::: "memory"); }
            bf16_t* op = OI + (row0 + nb * 32 + 4 * hi) * 1024 + h * 256 + wh * 128 + r32;
#pragma unroll
            for (int r = 0; r < 16; ++r) {
#pragma unroll
                for (int d = 0; d < 4; ++d) op[d * 32] = (bf16_t)f2bf(o[d][r]);
                op += ((r & 3) == 3) ? 5 * 1024 : 1024; asm volatile("" : "+v"(op)); }
        }
        __syncthreads();
    }
}

constexpr int RC_KT = 0, RC_KTP = 576, RC_VT = 128 * 576, RC_VTP = 64, RC_ST = RC_VT + 128 * 64, RC_STP = 528, RC_XO = RC_ST + 32 * 528, RC_END = RC_XO + 16384;
static_assert(RC_END <= 131072, "R-chain LDS");
__device__ __forceinline__ void phase_ret_chain(Ctx& C, int l, const bf16_t* RQKV, bf16_t* OI, bf16_t* OB) {
    const int lane = C.lane, r32 = lane & 31, hi = lane >> 5, wave = C.wave, tid = C.tid;
    LAS unsigned char* lds = C.lds;
    const int i16 = lane & 15, q4 = i16 >> 2, p4 = i16 & 3, g1 = (lane >> 4) & 1;
    const int nb = wave & 3, dh = wave >> 2;
    const int srow = tid >> 5, scc = tid & 31, vrow = tid >> 2, vcc = tid & 3;
    for (int un = C.bid; un < 256; un += C.G) {
        const int x = un & 7, j8 = un >> 3, bhd = x * 4 + (j8 >> 3), sl = j8 & 7, b = bhd >> 3, h = (bhd >> 1) & 3, dir = bhd & 1;
        const float lg = C.ctl[CT_LG + (l * 2 + dir) * 4 + h];
        const float cdec = EX2(lg * 128.f);
        const float vdec = dir ? EX2(lg * (float)vrow) : EX2(lg * (float)(127 - vrow));
        f32x16 sacc;
#pragma unroll
        for (int r = 0; r < 16; ++r) sacc[r] = 0.f;
        for (int i = tid; i < 32 * RC_STP / 16; i += NTHR) *(LAS u32x4*)(lds + RC_ST + i * 16) = (u32x4){0u, 0u, 0u, 0u};
        u32x4 st[8]; u32x4 sv;
#define RC_LOAD(cc_) do { const size_t r0_ = (size_t)b * SS + (cc_) * 128; const bf16_t* gk_ = RQKV + (r0_ + srow) * 3072 + 1024 + h * 256 + scc * 8; \
        _Pragma("unroll") for (int j = 0; j < 8; ++j) { st[j] = *(const u32x4*)gk_; gk_ += 16 * 3072; asm volatile("" : "+v"(gk_)); } \
        sv = *(const u32x4*)(RQKV + (r0_ + vrow) * 3072 + 2048 + h * 256 + sl * 32 + vcc * 8); } while (0)
#define RC_WRITE() do { _Pragma("unroll") for (int j = 0; j < 8; ++j) *(LAS u32x4*)(lds + RC_KT + (srow + 16 * j) * RC_KTP + scc * 16) = st[j]; \
        u32x4 w_; w_.x = pg8::cvt_pk_bf16(lo_bf(sv.x) * vdec, hi_bf(sv.x) * vdec); w_.y = pg8::cvt_pk_bf16(lo_bf(sv.y) * vdec, hi_bf(sv.y) * vdec); \
        w_.z = pg8::cvt_pk_bf16(lo_bf(sv.z) * vdec, hi_bf(sv.z) * vdec); w_.w = pg8::cvt_pk_bf16(lo_bf(sv.w) * vdec, hi_bf(sv.w) * vdec); \
        *(LAS u32x4*)(lds + RC_VT + vrow * RC_VTP + vcc * 16) = w_; } while (0)
        bf16x8 qa[8];
#define RC_QLOAD(dst, cc_) do { const bf16_t* gq_ = RQKV + ((size_t)b * SS + (cc_) * 128 + nb * 32 + r32) * 3072 + h * 256 + dh * 128 + hi * 8; \
        _Pragma("unroll") for (int s = 0; s < 8; ++s) dst[s] = *(const bf16x8*)(gq_ + s * 16); } while (0)
        {   const int c0 = dir ? 1 : 0; RC_LOAD(c0); RC_WRITE(); RC_QLOAD(qa, c0); }
        __syncthreads();
        for (int i = 0; i < 34; ++i) {
            const int c = dir ? ((i < 2) ? (1 - i) : (35 - i)) : i;
            const size_t r0 = (size_t)b * SS + c * 128;
            const int cn = (i + 1 < 34) ? (dir ? ((i + 1 < 2) ? (1 - (i + 1)) : (35 - (i + 1))) : (i + 1)) : c;
            if (i + 1 < 34) RC_LOAD(cn);
            unsigned short oiv[16];
            if (dh == 0 && dir == 0) { const bf16_t* ip = OI + (r0 + nb * 32 + 4 * hi) * 1024 + h * 256 + sl * 32 + r32;
#pragma unroll
                for (int r = 0; r < 16; ++r) oiv[r] = ip[(size_t)((r & 3) + 8 * (r >> 2)) * 1024]; }
            f32x16 oacc;
#pragma unroll
            for (int r = 0; r < 16; ++r) oacc[r] = 0.f;
            {   LAS unsigned char* sb = lds + RC_ST + r32 * RC_STP + (dh * 128 + hi * 8) * 2;
#pragma unroll
                for (int s = 0; s < 8; ++s) { const bf16x8 sbf = *(const LAS bf16x8*)(sb + s * 32);
                    oacc = __builtin_amdgcn_mfma_f32_32x32x16_bf16(qa[s], sbf, oacc, 0, 0, 0); } }
            asm volatile("" ::: "memory");
            RC_QLOAD(qa, cn);
#pragma unroll
            for (int r = 0; r < 16; ++r) sacc[r] *= cdec;
            {   LAS unsigned char* kp = lds + RC_KT + (8 * hi + q4) * RC_KTP + (wave * 32 + 16 * g1 + 4 * p4) * 2;
                LAS unsigned char* vp = lds + RC_VT + (8 * hi + q4) * RC_VTP + (16 * g1 + 4 * p4) * 2;
#pragma unroll
                for (int s = 0; s < 8; ++s) sacc = __builtin_amdgcn_mfma_f32_32x32x16_bf16(tr2(kp + s * 16 * RC_KTP, kp + (s * 16 + 4) * RC_KTP), tr2(vp + s * 16 * RC_VTP, vp + (s * 16 + 4) * RC_VTP), sacc, 0, 0, 0); }
            if (dh == 1) {
#pragma unroll
                for (int r = 0; r < 16; ++r) *(LAS float*)(lds + RC_XO + nb * 4096 + r * 256 + lane * 4) = oacc[r]; }
            __syncthreads();
            if (dh == 0) {
                bf16_t* op = (dir ? OB : OI) + (r0 + nb * 32 + 4 * hi) * 1024 + h * 256 + sl * 32 + r32;
#pragma unroll
                for (int r = 0; r < 16; ++r) { const int n = nb * 32 + crow(r, hi);
                    const float qd = dir ? EX2(lg * (float)(128 - n)) : EX2(lg * (float)(n + 1));
                    float v = (oacc[r] + *(const LAS float*)(lds + RC_XO + nb * 4096 + r * 256 + lane * 4)) * qd;
                    if (dir == 0) v += bf2f(oiv[r]);
                    *op = (bf16_t)f2bf(v);
                    op += ((r & 3) == 3) ? 5 * 1024 : 1024; asm volatile("" : "+v"(op)); }
            }
            {   LAS unsigned char* sp = lds + RC_ST + r32 * RC_STP + (wave * 32 + 4 * hi) * 2;
#pragma unroll
                for (int g = 0; g < 4; ++g) { u32x2 o2; o2.x = pg8::cvt_pk_bf16(sacc[4 * g], sacc[4 * g + 1]); o2.y = pg8::cvt_pk_bf16(sacc[4 * g + 2], sacc[4 * g + 3]); *(LAS u32x2*)(sp + g * 16) = o2; } }
            if (i + 1 < 34) RC_WRITE();
            __syncthreads();
        }
#undef RC_QLOAD
#undef RC_LOAD
#undef RC_WRITE
    }
}
__device__ __forceinline__ void phase_ret_ln2(Ctx& C, int l, bf16_t* OI, const bf16_t* OB) {
    const float* gain = INP(16) + l * 1024;
    for (int m = C.gw; m < MR; m += C.ngw) {
#pragma unroll
        for (int h = 0; h < 4; ++h) { bf16_t* p = OI + (size_t)m * 1024 + h * 256 + C.lane * 4;
            const u32x2 w = *(const u32x2*)p, w2 = *(const u32x2*)(OB + (size_t)m * 1024 + h * 256 + C.lane * 4);
            float x0 = lo_bf(w.x) + lo_bf(w2.x), x1 = hi_bf(w.x) + hi_bf(w2.x), x2 = lo_bf(w.y) + lo_bf(w2.y), x3 = hi_bf(w.y) + hi_bf(w2.y);
            const float mean = wave_sum((x0 + x1) + (x2 + x3)) * (1.f / 256.f);
            x0 -= mean; x1 -= mean; x2 -= mean; x3 -= mean;
            const float var = wave_sum((x0 * x0 + x1 * x1) + (x2 * x2 + x3 * x3)) * (1.f / 256.f);
            const float rstd = RSQ(var + EPS);
            const f32x4 g = *(const f32x4*)(gain + h * 256 + C.lane * 4);
            u32x2 o; o.x = pk2(x0 * rstd * g.x, x1 * rstd * g.y); o.y = pk2(x2 * rstd * g.z, x3 * rstd * g.w); *(u32x2*)p = o; }
    }
}

template <int W> __device__ __forceinline__ float group_sum(float v) {
#pragma unroll
    for (int o = 1; o < W; o <<= 1) v += __shfl_xor(v, o);
    return v;
}
__device__ __forceinline__ void unpack8(const u32x4& w, float (&x)[8]) { x[0] = lo_bf(w.x); x[1] = hi_bf(w.x); x[2] = lo_bf(w.y); x[3] = hi_bf(w.y); x[4] = lo_bf(w.z); x[5] = hi_bf(w.z); x[6] = lo_bf(w.w); x[7] = hi_bf(w.w); }
__device__ __forceinline__ u32x4 pack8u(const float (&x)[8]) { u32x4 w; w.x = pk2(x[0], x[1]); w.y = pk2(x[2], x[3]); w.z = pk2(x[4], x[5]); w.w = pk2(x[6], x[7]); return w; }
__device__ __forceinline__ float sumsq8(const float (&x)[8]) { return ((x[0] * x[0] + x[1] * x[1]) + (x[2] * x[2] + x[3] * x[3])) + ((x[4] * x[4] + x[5] * x[5]) + (x[6] * x[6] + x[7] * x[7])); }

__device__ __forceinline__ void phase_h2(Ctx& C, int l, bf16_t* H) {
    const float* gain = INP(6) + l * 1024;
    for (int m0 = C.gw * 2; m0 < MR; m0 += C.ngw * 2) {
        f32x4 v[2][4]; float ss[2];
#pragma unroll
        for (int q = 0; q < 2; ++q) { const float* xr = resid_row(C, l, m0 + q);
#pragma unroll
            for (int j = 0; j < 4; ++j) v[q][j] = *(const f32x4*)(xr + 4 * C.lane + 256 * j); }
        const int b = m0 / SS, s = m0 - b * SS, r = (s < LC) ? 4 : b;
        const float* mod = C.ctl + CT_MOD + (l * 5 + r) * 3072;
#pragma unroll
        for (int q = 0; q < 2; ++q) { float a = 0.f;
#pragma unroll
            for (int j = 0; j < 4; ++j) a += (v[q][j].x * v[q][j].x + v[q][j].y * v[q][j].y) + (v[q][j].z * v[q][j].z + v[q][j].w * v[q][j].w);
            ss[q] = a; }
        ss[0] = wave_sum(ss[0]); ss[1] = wave_sum(ss[1]);
#pragma unroll
        for (int j = 0; j < 4; ++j) { const int c = 4 * C.lane + 256 * j;
            const f32x4 g = *(const f32x4*)(gain + c), sh = *(const f32x4*)(mod + c), sc = *(const f32x4*)(mod + 1024 + c) + 1.0f;
#pragma unroll
            for (int q = 0; q < 2; ++q) { const float rstd = RSQ(ss[q] * (1.f / 1024.f) + EPS);
                const f32x4 o = ((v[q][j] * rstd) * g) * sc + sh;
                u32x2 w; w.x = pk2(o.x, o.y); w.y = pk2(o.z, o.w);
                *(u32x2*)(H + (size_t)(m0 + q) * 1024 + c) = w; } }
    }
}
__device__ __forceinline__ void phase_md_post2(Ctx& C, int l, bf16_t* MD) {
    const float* qn = INP(17) + l * 384; const float* kvn = INP(19) + l * 256; const float* gkr = INP(24) + l * 64;
    const float* cs = C.ctl + CT_ROPEM; const float* sn = cs + 1024;
    const int L = C.lane;
    for (int m0 = C.gw * 2; m0 < MR; m0 += C.ngw * 2) {
        u32x4 w0[2], w1[2];
#pragma unroll
        for (int q = 0; q < 2; ++q) { const bf16_t* row = MD + (size_t)(m0 + q) * 768; w0[q] = *(const u32x4*)(row + 8 * L); w1[q] = (L < 32) ? *(const u32x4*)(row + 512 + 8 * L) : (u32x4){0u, 0u, 0u, 0u}; }
#pragma unroll
        for (int q = 0; q < 2; ++q) { const int m = m0 + q, b = m / SS, s = m - b * SS; const bool lat = s >= LC; const int t = s - LC;
            bf16_t* row = MD + (size_t)m * 768;
            float x0[8], x1[8]; unpack8(w0[q], x0); unpack8(w1[q], x1);
            const float s0 = sumsq8(x0), s1 = sumsq8(x1);
            const float sq = wave_sum(L < 48 ? s0 : 0.f), skv = wave_sum((L >= 48 ? s0 : 0.f) + (L < 16 ? s1 : 0.f)), skr = wave_sum((L >= 16 && L < 24) ? s1 : 0.f);
            const float rq = RSQ(sq * (1.f / 384.f) + EPS), rkv = RSQ(skv * (1.f / 256.f) + EPS), rkr = RSQ(skr * (1.f / 64.f) + EPS);
            {   const float* g = (L < 48) ? (qn + 8 * L) : (kvn + 8 * (L - 48)); const float rs = (L < 48) ? rq : rkv;
#pragma unroll
                for (int e = 0; e < 8; ++e) x0[e] *= rs * g[e];
                *(u32x4*)(row + 8 * L) = pack8u(x0); }
            if (L < 16) {
#pragma unroll
                for (int e = 0; e < 8; ++e) x1[e] *= rkv * kvn[128 + 8 * L + e];
            } else if (L < 24) {
#pragma unroll
                for (int e = 0; e < 8; ++e) x1[e] *= rkr * gkr[8 * (L - 16) + e];
            }
            float pr[8];
#pragma unroll
            for (int e = 0; e < 8; ++e) pr[e] = __shfl_xor(x1[e], 2);
            if (lat && L >= 16 && L < 24) { const int qt = (L - 16) >> 1, f0 = ((L - 16) & 1) * 8, pos = (qt < 2) ? (t >> 6) : (t & 63); const float sg = (qt & 1) ? 1.f : -1.f;
#pragma unroll
                for (int e = 0; e < 8; ++e) x1[e] = x1[e] * cs[pos * 16 + f0 + e] + sg * pr[e] * sn[pos * 16 + f0 + e]; }
            if (L < 24) *(u32x4*)(row + 512 + 8 * L) = pack8u(x1);
        }
    }
}
__device__ __forceinline__ void phase_qk_post2(Ctx& C, int l, bf16_t* QN, bf16_t* QP, bf16_t* KV) {
    const float* gqn = INP(21) + l * 128; const float* gqr = INP(22) + l * 64; const float* gkn = INP(23) + l * 128;
    const float* cs = C.ctl + CT_ROPEM; const float* sn = cs + 1024;
    const int L = C.lane;
    for (int m0 = C.gw * 2; m0 < MR; m0 += C.ngw * 2) {
        u32x4 a[2][2], k[2][2], p[2];
#pragma unroll
        for (int q = 0; q < 2; ++q) { const size_t m = m0 + q;
            a[q][0] = *(const u32x4*)(QN + m * 1024 + 8 * L); a[q][1] = *(const u32x4*)(QN + m * 1024 + 512 + 8 * L);
            k[q][0] = *(const u32x4*)(KV + m * 2048 + 8 * L); k[q][1] = *(const u32x4*)(KV + m * 2048 + 512 + 8 * L);
            p[q] = *(const u32x4*)(QP + m * 512 + 8 * L); }
#pragma unroll
        for (int q = 0; q < 2; ++q) { const int m = m0 + q, b = m / SS, s = m - b * SS; const bool lat = s >= LC; const int t = s - LC;
#pragma unroll
            for (int c = 0; c < 2; ++c) {
                float x[8]; unpack8(a[q][c], x);
                const float rs = RSQ(group_sum<16>(sumsq8(x)) * (1.f / 128.f) + EPS) * QSCALE;
#pragma unroll
                for (int e = 0; e < 8; ++e) x[e] *= rs * gqn[8 * (L & 15) + e];
                *(u32x4*)(QN + (size_t)m * 1024 + c * 512 + 8 * L) = pack8u(x);
                float y[8]; unpack8(k[q][c], y);
                const float rk = RSQ(group_sum<16>(sumsq8(y)) * (1.f / 128.f) + EPS);
#pragma unroll
                for (int e = 0; e < 8; ++e) y[e] *= rk * gkn[8 * (L & 15) + e];
                *(u32x4*)(KV + (size_t)m * 2048 + c * 512 + 8 * L) = pack8u(y); }
            {   float x[8]; unpack8(p[q], x);
                const float rs = RSQ(group_sum<8>(sumsq8(x)) * (1.f / 64.f) + EPS);
#pragma unroll
                for (int e = 0; e < 8; ++e) x[e] *= rs * gqr[8 * (L & 7) + e];
                float pr[8];
#pragma unroll
                for (int e = 0; e < 8; ++e) pr[e] = __shfl_xor(x[e], 2);
                if (lat) { const int qt = (L >> 1) & 3, f0 = (L & 1) * 8, pos = (qt < 2) ? (t >> 6) : (t & 63); const float sg = (qt & 1) ? 1.f : -1.f;
#pragma unroll
                    for (int e = 0; e < 8; ++e) x[e] = x[e] * cs[pos * 16 + f0 + e] + sg * pr[e] * sn[pos * 16 + f0 + e]; }
#pragma unroll
                for (int e = 0; e < 8; ++e) x[e] *= QSCALE;
                *(u32x4*)(QP + (size_t)m * 512 + 8 * L) = pack8u(x); }
        }
    }
}
__device__ __forceinline__ void phase_ret_ln3(Ctx& C, int l, bf16_t* OI, const bf16_t* OB) {
    const float* gain = INP(16) + l * 1024;
    const int L = C.lane;
    for (int m0 = C.gw * 2; m0 < MR; m0 += C.ngw * 2) {
        u32x4 a[2][2], bb[2][2];
#pragma unroll
        for (int q = 0; q < 2; ++q)
#pragma unroll
            for (int c = 0; c < 2; ++c) { a[q][c] = *(const u32x4*)(OI + (size_t)(m0 + q) * 1024 + c * 512 + 8 * L); bb[q][c] = *(const u32x4*)(OB + (size_t)(m0 + q) * 1024 + c * 512 + 8 * L); }
#pragma unroll
        for (int q = 0; q < 2; ++q)
#pragma unroll
            for (int c = 0; c < 2; ++c) { float x[8], y[8]; unpack8(a[q][c], x); unpack8(bb[q][c], y);
                float s = 0.f;
#pragma unroll
                for (int e = 0; e < 8; ++e) { x[e] += y[e]; s += x[e]; }
                const float mean = group_sum<32>(s) * (1.f / 256.f);
                float v = 0.f;
#pragma unroll
                for (int e = 0; e < 8; ++e) { x[e] -= mean; v += x[e] * x[e]; }
                const float rstd = RSQ(group_sum<32>(v) * (1.f / 256.f) + EPS);
#pragma unroll
                for (int e = 0; e < 8; ++e) x[e] *= rstd * gain[c * 512 + 8 * L + e];
                *(u32x4*)(OI + (size_t)(m0 + q) * 1024 + c * 512 + 8 * L) = pack8u(x); }
    }
}

__device__ __forceinline__ void phase_zsum(Ctx& C, const bf16_t* ZP, bf16_t* Z) {
    const int gt = C.bid * NTHR + C.tid, ngt = C.G * NTHR;
    for (int it = gt; it < 1024 * 128; it += ngt) { const int r = it >> 7, c0 = (it & 127) * 8, b = r >> 8, s = r & 255;
        const u32x4 a = *(const u32x4*)(ZP + (size_t)r * 1024 + c0), bq = *(const u32x4*)(ZP + (size_t)(1024 + r) * 1024 + c0), cq = *(const u32x4*)(ZP + (size_t)(2048 + r) * 1024 + c0);
        float x[8], y[8], z[8]; unpack8(a, x); unpack8(bq, y); unpack8(cq, z);
#pragma unroll
        for (int e = 0; e < 8; ++e) x[e] += y[e] + z[e];
        *(u32x4*)(Z + (size_t)(b * SS + s) * 1024 + c0) = pack8u(x); }
}

constexpr int LR_UP = 272;
constexpr int LR_U = 0, LR_LA = 128 * LR_UP, LR_BC = LR_LA + 32768, LR_Y0 = LR_BC + 32768, LR_XS = LR_Y0 + 32768, LR_END = LR_XS + 4096;
static_assert(LR_END <= 147456 - 1024, "fused LRU LDS");
__device__ __forceinline__ void phase_lru_fused(Ctx& C, int l, const bf16_t* XA, const bf16_t* WTL, bf16_t* Y0, f16_t* CAF, f16_t* CAB, float* SUM) {
    const int lane = C.lane, r32 = lane & 31, hi = lane >> 5, wave = C.wave, tid = C.tid;
    LAS unsigned char* lds = C.lds;
    const float* cw = INP(8) + l * 4 * 1024; const float* cb = INP(9) + l * 1024;
    const int rb = wave & 3, cgp = wave >> 2;
    for (int un = C.bid; un < NB * 8 * 34; un += C.G) {
        const int sg = un % 34, bn = un / 34, b = bn >> 3, n = bn & 7;
        const int R0 = b * SS + sg * 128, lo = (sg < 2) ? b * SS : b * SS + LC, hi_ = (sg < 2) ? b * SS + LC : (b + 1) * SS;
#pragma unroll
        for (int j = 0; j < 4; ++j) { const int item = tid + 512 * j, row = item >> 4, cc = item & 15, ch0 = n * 128 + cc * 8;
            float a[8];
            {   const f32x4 c0 = *(const f32x4*)(cb + ch0), c1 = *(const f32x4*)(cb + ch0 + 4); a[0] = c0[0]; a[1] = c0[1]; a[2] = c0[2]; a[3] = c0[3]; a[4] = c1[0]; a[5] = c1[1]; a[6] = c1[2]; a[7] = c1[3]; }
#pragma unroll
            for (int t = 0; t < 4; ++t) { const int rr = R0 + row + t - 2;
                const f32x4 wA = *(const f32x4*)(cw + t * 1024 + ch0), wB = *(const f32x4*)(cw + t * 1024 + ch0 + 4);
                if (rr >= lo && rr < hi_) { const u32x4 xv = *(const u32x4*)(XA + (size_t)rr * 1024 + ch0);
                    a[0] += wA[0] * lo_bf(xv.x); a[1] += wA[1] * hi_bf(xv.x); a[2] += wA[2] * lo_bf(xv.y); a[3] += wA[3] * hi_bf(xv.y);
                    a[4] += wB[0] * lo_bf(xv.z); a[5] += wB[1] * hi_bf(xv.z); a[6] += wB[2] * lo_bf(xv.w); a[7] += wB[3] * hi_bf(xv.w); } }
            *(LAS u32x4*)(lds + LR_U + row * LR_UP + cc * 16) = pack8u(a); }
        __syncthreads();
        bf16x8 af[8];
        {   LAS unsigned char* ua = lds + LR_U + (rb * 32 + r32) * LR_UP + hi * 16;
#pragma unroll
            for (int s = 0; s < 8; ++s) af[s] = *(const LAS bf16x8*)(ua + s * 32); }
        for (int d = 0; d < 2; ++d) {
            f32x16 aR[2], aI[2];
#pragma unroll
            for (int q = 0; q < 2; ++q)
#pragma unroll
                for (int r = 0; r < 16; ++r) { aR[q][r] = 0.f; aI[q][r] = 0.f; }
            {   const bf16_t* wb = WTL + ((size_t)d * 2048 + n * 256 + cgp * 64 + r32) * 256 + (n & 1) * 128 + hi * 8;
#pragma unroll
                for (int s = 0; s < 8; ++s) {
                    const bf16x8 b0 = *(const bf16x8*)(wb + s * 16), b1 = *(const bf16x8*)(wb + 32 * 256 + s * 16), b2 = *(const bf16x8*)(wb + 128 * 256 + s * 16), b3 = *(const bf16x8*)(wb + 160 * 256 + s * 16);
                    aR[0] = __builtin_amdgcn_mfma_f32_32x32x16_bf16(af[s], b0, aR[0], 0, 0, 0); aR[1] = __builtin_amdgcn_mfma_f32_32x32x16_bf16(af[s], b1, aR[1], 0, 0, 0);
                    aI[0] = __builtin_amdgcn_mfma_f32_32x32x16_bf16(af[s], b2, aI[0], 0, 0, 0); aI[1] = __builtin_amdgcn_mfma_f32_32x32x16_bf16(af[s], b3, aI[1], 0, 0, 0);
                    if ((s & 3) == 3) asm volatile("" ::: "memory"); } }
#pragma unroll
            for (int q = 0; q < 2; ++q) { const int chl = cgp * 64 + q * 32 + r32, ch = n * 128 + chl;
                const float bav = INP(11)[(l * 2 + d) * 1024 + ch], bxv = INP(13)[(l * 2 + d) * 1024 + ch], spv = C.ctl[CT_SP + (l * 2 + d) * 1024 + ch] * (-8.f);
#pragma unroll
                for (int r = 0; r < 16; ++r) { const int t = rb * 32 + crow(r, hi);
                    const float uu = bf2f(*(const LAS bf16_t*)(lds + LR_U + t * LR_UP + chl * 2));
                    const float rg = sigmoidf_(aR[q][r] + bav), ig = sigmoidf_(aI[q][r] + bxv);
                    const float loga = rg * spv, y2 = 2.f * loga;
                    const float om = -y2 * (1.f + y2 * 0.5f * (1.f + y2 * (1.f / 3.f) * (1.f + y2 * 0.25f * (1.f + y2 * 0.2f))));
                    const float bb = SQRT(fmaxf(om, 0.f)) * (ig * uu);
                    *(LAS f16_t*)(lds + LR_LA + (t * 128 + chl) * 2) = (f16_t)(loga * LOG2E); *(LAS f16_t*)(lds + LR_BC + (t * 128 + chl) * 2) = (f16_t)bb; } }
            __syncthreads();
            const int chl = tid & 127, sub = tid >> 7;
            {   float A = 1.f, H = 0.f;
#pragma unroll 8
                for (int i = 0; i < 32; ++i) { const int p = sub * 32 + i, t = d ? (127 - p) : p;
                    const float a = EX2((float)*(const LAS f16_t*)(lds + LR_LA + (t * 128 + chl) * 2)), bc = (float)*(const LAS f16_t*)(lds + LR_BC + (t * 128 + chl) * 2);
                    H = a * H + bc; A *= a; }
                *(LAS f32x2*)(lds + LR_XS + (sub * 128 + chl) * 8) = (f32x2){A, H}; }
            __syncthreads();
            {   float A = 1.f, H = 0.f;
                for (int p = 0; p < sub; ++p) { const f32x2 v = *(const LAS f32x2*)(lds + LR_XS + (p * 128 + chl) * 8); H = v.x * H + v.y; A *= v.x; }
                f16_t* cap = (d ? CAB : CAF) + (size_t)R0 * 1024 + n * 128 + chl;
#pragma unroll 8
                for (int i = 0; i < 32; ++i) { const int p = sub * 32 + i, t = d ? (127 - p) : p;
                    const float a = EX2((float)*(const LAS f16_t*)(lds + LR_LA + (t * 128 + chl) * 2)), bc = (float)*(const LAS f16_t*)(lds + LR_BC + (t * 128 + chl) * 2);
                    H = a * H + bc; A *= a;
                    cap[(size_t)t * 1024] = (f16_t)A;
                    LAS bf16_t* yp = (LAS bf16_t*)(lds + LR_Y0 + (t * 128 + chl) * 2);
                    if (d == 0) *yp = (bf16_t)f2bf(H); else Y0[(size_t)(R0 + t) * 1024 + n * 128 + chl] = (bf16_t)f2bf(bf2f(*yp) + H); }
                if (sub == 3) *(f32x2*)(SUM + ((size_t)((d * NB + b) * 34 + sg) * 1024 + n * 128 + chl) * 2) = (f32x2){A, H}; }
            __syncthreads();
        }
    }
}
__device__ __forceinline__ void phase_lru_fix(Ctx& C, const bf16_t* Y0, const f16_t* CAF, const f16_t* CAB, const float* SUM, bf16_t* YA) {
    for (int un = C.gw; un < NB * 34 * 8; un += C.ngw) {
        const int cg_ = un & 7, sg = (un >> 3) % 34, b = (un >> 3) / 34, ch = cg_ * 128 + 2 * C.lane;
        float F0 = 0.f, F1 = 0.f, B0 = 0.f, B1 = 0.f;
#pragma unroll 4
        for (int p = 0; p < sg; ++p) { const f32x4 v = *(const f32x4*)(SUM + ((size_t)((0 * NB + b) * 34 + p) * 1024 + ch) * 2); F0 = v[0] * F0 + v[1]; F1 = v[2] * F1 + v[3]; }
        const int npre = (sg < 2) ? (1 - sg) : (35 - sg);
#pragma unroll 4
        for (int p = 0; p < npre; ++p) { const int ps = (p < 2) ? (1 - p) : (35 - p);
            const f32x4 v = *(const f32x4*)(SUM + ((size_t)((1 * NB + b) * 34 + ps) * 1024 + ch) * 2); B0 = v[0] * B0 + v[1]; B1 = v[2] * B1 + v[3]; }
        const size_t base = (size_t)(b * SS + sg * 128) * 1024 + ch;
        for (int t0 = 0; t0 < 128; t0 += 16) {
            unsigned y[16]; f16x2 cf[16], cbk[16];
#pragma unroll
            for (int i = 0; i < 16; ++i) { const size_t o = base + (size_t)(t0 + i) * 1024; y[i] = *(const unsigned*)(Y0 + o); cf[i] = *(const f16x2*)(CAF + o); cbk[i] = *(const f16x2*)(CAB + o); }
#pragma unroll
            for (int i = 0; i < 16; ++i) { const size_t o = base + (size_t)(t0 + i) * 1024;
                *(unsigned*)(YA + o) = pk2(lo_bf(y[i]) + (float)cf[i][0] * F0 + (float)cbk[i][0] * B0, hi_bf(y[i]) + (float)cf[i][1] * F1 + (float)cbk[i][1] * B1); }
        }
    }
}

#ifdef PROBE_TS
#define GSYNC(g) do { { unsigned char* w_ = prm.ws; asm volatile("" : "+s"(w_)); xcd_barrier((unsigned*)(w_ + WS_BAR), (volatile LAS unsigned*)(ldsb + LDS_ST)); } if (blockIdx.x == 0 && threadIdx.x == 0) { unsigned long long* ts_ = (unsigned long long*)(prm.ws + 8192); const unsigned long long now_ = __builtin_amdgcn_s_memrealtime(); \
    ts_[1 + (g)] += now_ - ts_[0]; ts_[0] = now_; } } while (0)
#else
#define GSYNC(g) do { unsigned char* w_ = prm.ws; asm volatile("" : "+s"(w_)); xcd_barrier((unsigned*)(w_ + WS_BAR), (volatile LAS unsigned*)(ldsb + LDS_ST)); } while (0)
#endif
#define CTX Ctx C = mkctx(ldsb)
#define WSB wsp_(C.ws)
#define bYB ((bf16_t*)(WSB + AR_YB))
#define bXA ((bf16_t*)(WSB + AR_XA))
#define bMD ((bf16_t*)(WSB + AR_MD))
#define bRQKV ((bf16_t*)(WSB + AR_RQKV))
#define bKV ((bf16_t*)(WSB + AR_KV))
#define bQN ((bf16_t*)(WSB + AR_QN))
#define bQP ((bf16_t*)(WSB + AR_QP))
#define bRI ((f16_t*)(WSB + AR_RI))
#define bSUM ((float*)(WSB + AR_SUM))
#define bOB ((bf16_t*)(WSB + AR_OB))
#define bZ ((bf16_t*)(WSB + AR_Z))
#define xc1 ((float*)(WSB + WS_XC1))
template <int l> __device__ __forceinline__ void run_layer(const Params& prm, LAS unsigned char* ldsb) {
        const bool with_ctx = (l == 0); const int lat_only = with_ctx ? 0 : 1;
        { CTX; phase_wconv_early(C, l); }
        GSYNC(0);
        { CTX; phase_h2(C, l, bYB); }
        GSYNC(1);
        {   CTX;
            ProbPlain P{bYB, (const bf16_t*)(WSB + W_WT1), 1024, 1024, 1024};
            pg8::StaticOrder S; S.init(68, 19, C.G, C.bid, 0);
            EpiG1 E{WSB, C.ctl + CT_ROPER};
            pg8::gemm_phase<EpiG1, ProbPlain, pg8::StaticOrder, true>(C.lds, P, S, E);
        }
        GSYNC(2);
        { CTX; phase_ret_intra(C, l, bRQKV, bYB); }
        { CTX; phase_md_post2(C, l, bMD); }
        GSYNC(4);
        { CTX; phase_ret_chain(C, l, bRQKV, bYB, bOB); }
        GSYNC(5);
        { CTX; phase_ret_ln3(C, l, bYB, bOB); }
        {   CTX; ProbPlain P{bMD, (const bf16_t*)(WSB + W_WTQ), 768, 384, 384};
            pg8::StaticOrder S; S.init(68, 6, C.G, C.bid, 0);
            typedef EpiStore3<AR_QN, 1024, AR_QP, 512, AR_QP, 512, 4, 6> Ep; Ep E{WSB};
            pg8::gemm_phase<Ep, ProbPlain, pg8::StaticOrder, true>(C.lds, P, S, E);
        }
        {   CTX; ProbPlain P{bMD + 384, (const bf16_t*)(WSB + W_WTKV), 768, 256, 256};
            pg8::StaticOrder S; S.init(68, 8, C.G, C.bid, 0);
            typedef EpiStore3<AR_KV, 2048, AR_KV, 2048, AR_KV, 2048, 8, 8> Ep; Ep E{WSB};
            pg8::gemm_phase<Ep, ProbPlain, pg8::StaticOrder, true>(C.lds, P, S, E);
        }
        GSYNC(6);
        { CTX; phase_qk_post2(C, l, bQN, bQP, bKV); }
        GSYNC(7);
        { CTX; phase_attn(C, with_ctx, bQN, bQP, bKV, bMD); }
        GSYNC(8);
        { CTX; phase_lru_fused(C, l, bXA, (const bf16_t*)(WSB + W_WTL), (bf16_t*)(WSB + AR_Y0), (f16_t*)(WSB + AR_CAF), (f16_t*)(WSB + AR_CAB), bSUM); }
        GSYNC(9);
        { CTX; phase_lru_fix(C, (const bf16_t*)(WSB + AR_Y0), (const f16_t*)(WSB + AR_CAF), (const f16_t*)(WSB + AR_CAB), bSUM, bXA  ); }
        GSYNC(10);
        { CTX; phase_wconv_late(C, l); }
        { CTX; phase_h2(C, l, bMD  ); }
        GSYNC(13);
        {   CTX; ProbPlain P{bMD, (const bf16_t*)(WSB + W_WTG), 1024, 1024, 1024};
            pg8::StaticOrder S; S.init(lat_only ? 64 : 68, 12, C.G, C.bid, lat_only);
            EpiGate E{WSB};
            pg8::gemm_phase<EpiGate, ProbPlain, pg8::StaticOrder, true>(C.lds, P, S, E);
        }
        GSYNC(14);
        {   CTX; ProbD P{WSB, 1024, 1024};
            pg8::ChainOrder S; S.init(C.G, C.bid, with_ctx ? 1 : 0);
            EpiD E{bZ, WSB + AR_GS + (size_t)C.bid * 131072, (bf16_t*)(WSB + AR_ZP)};
            pg8::gemm_phase<EpiD, ProbD, pg8::ChainOrder, true>(C.lds, P, S, E);
        }
        GSYNC(15);
        if (with_ctx) { { CTX; phase_zsum(C, (const bf16_t*)(WSB + AR_ZP), bZ); } GSYNC(12); }
        {   CTX; ProbPlain P{bZ, (const bf16_t*)(WSB + W_WTO), 1024, 1024, 1024};
            pg8::StaticOrder S; S.init(lat_only ? 64 : 68, 4, C.G, C.bid, lat_only);
            EpiOut E{(l == 0) ? INP(0) : (const float*)C.out, INP(2), C.out, xc1, C.ctl + CT_MOD + l * 5 * 3072};
            pg8::gemm_phase<EpiOut, ProbPlain, pg8::StaticOrder, true>(C.lds, P, S, E);
        }
        GSYNC(16);
    }

__global__ void __launch_bounds__(NTHR) fwd_kernel(Params prm) {
    extern __shared__ __attribute__((aligned(16))) unsigned char lds_raw[];
    cg::grid_group grid = cg::this_grid();
    LAS unsigned char* const ldsb = (LAS unsigned char*)lds_raw;
    if (threadIdx.x < 16) ((LAS unsigned*)(ldsb + LDS_ST))[threadIdx.x] = 0u;
    __syncthreads();
    if (threadIdx.x == 0) (void)xb_add(&((unsigned*)(prm.ws + WS_BAR))[XB_XCNT(xb_xcc_id())], 1u);
    grid.sync();


#ifdef PROBE_TS
    if (blockIdx.x == 0 && threadIdx.x == 0) { unsigned long long* ts_ = (unsigned long long*)(prm.ws + 8192); for (int i = 1; i < 32; ++i) ts_[i] = 0ull; ts_[0] = __builtin_amdgcn_s_memrealtime(); }
#endif
    { CTX; phase_prep(C); }
    run_layer<0>(prm, ldsb);
    run_layer<1>(prm, ldsb);
#ifdef PROBE_TS
    if (blockIdx.x == 0 && threadIdx.x == 0) { const unsigned long long* ts_ = (const unsigned long long*)(prm.ws + 8192); unsigned long long tot = 0ull;
        for (int g = 0; g < 17; ++g) if ((PROBE_TS >> g) & 1u) tot += ts_[1 + g];
        prm.out[0] += (float)(((tot / 100ull) + PROBE_Q / 2) / PROBE_Q * PROBE_Q); }
#endif
}

#undef xc1
#undef bZ
extern "C" void kernel_launch(void* const* d_in, const int* in_sizes, int n_in, void* d_out, int out_size, void* d_ws, size_t ws_size, hipStream_t stream) {
    static int grid = 0;
    if (grid == 0) {
        if (n_in != 29 || out_size != NB * TT * DM || ws_size < WS_END) { fprintf(stderr, "kernel_launch: unexpected shapes (n_in %d out %d ws %zu)\n", n_in, out_size, ws_size); grid = -1; return; }
        int dev = 0, cus = 0, per_cu = 0;
        hipGetDevice(&dev);
        hipDeviceGetAttribute(&cus, hipDeviceAttributeMultiprocessorCount, dev);
        if (hipFuncSetAttribute((const void*)fwd_kernel, hipFuncAttributeMaxDynamicSharedMemorySize, LDS_BYTES) != hipSuccess) { fprintf(stderr, "kernel_launch: hipFuncSetAttribute failed\n"); grid = -1; return; }
        if (hipOccupancyMaxActiveBlocksPerMultiprocessor(&per_cu, (const void*)fwd_kernel, NTHR, LDS_BYTES) != hipSuccess || per_cu < 1) { fprintf(stderr, "kernel_launch: occupancy query failed (%d)\n", per_cu); (void)hipGetLastError(); per_cu = 1; }
        grid = cus;
        fprintf(stderr, "kernel_launch: cus %d per_cu %d grid %d\n", cus, per_cu, grid);
    }
    if (grid < 0) return;
    if (hipMemsetAsync((char*)d_ws + WS_BAR, 0, XCD_BAR_WORDS * 4, stream) != hipSuccess) { fprintf(stderr, "kernel_launch: memset failed\n"); return; }
    Params p{};
    for (int i = 0; i < 29; ++i) p.in[i] = (const float*)d_in[i];
    p.out = (float*)d_out; p.ws = (unsigned char*)d_ws;
    void* args[] = {&p};
    hipError_t e = hipLaunchCooperativeKernel((const void*)fwd_kernel, dim3(grid), dim3(NTHR), args, LDS_BYTES, stream);
    if (e != hipSuccess) fprintf(stderr, "cooperative launch failed: %s (grid %d)\n", hipGetErrorString(e), grid);
}
```

```cpp
#include <hip/hip_runtime.h>
#include <hip/hip_cooperative_groups.h>
#include <cstdio>
#include <cstdint>
namespace cg = cooperative_groups;

#define LAS __attribute__((address_space(3)))
typedef unsigned short bf16_t;
typedef short bf16x8 __attribute__((ext_vector_type(8)));
typedef float f32x4 __attribute__((ext_vector_type(4)));
typedef float f32x2 __attribute__((ext_vector_type(2)));
typedef unsigned u32x4 __attribute__((ext_vector_type(4)));
typedef unsigned u32x2 __attribute__((ext_vector_type(2)));
typedef _Float16 f16_t;

namespace pg8 {
constexpr int BM = 256, BK = 64, HALF = 128, HTB = HALF * BK * 2, STAGE_BYTES = 8 * HTB, NXCD = 8, WGM = 8;
__host__ __device__ __forceinline__ int lds_byte(int r, int c) { const int st = (r >> 4) * 2 + (c >> 5), rr = r & 15, cc = c & 31, ob = rr * 64 + cc * 2; return st * 1024 + (ob ^ (((ob >> 9) & 1) << 5)); }
__host__ __device__ __forceinline__ void stage_rc(int b, int& R, int& C) { const int st = b / 1024, sb = b % 1024, swz = sb ^ (((sb >> 9) & 1) << 5); R = (st >> 1) * 16 + swz / 64; C = (st & 1) * 32 + (swz % 64) / 2; }
__host__ __device__ __forceinline__ int perm32(int rho) { const int n = rho >> 4, i = rho & 15; return 8 * (i >> 2) + 4 * n + (i & 3); }

struct Unit { int pm, pn, z; };

struct StaticOrder {
    int nM, nN, nwg, G, c, latent_only;
    __device__ void init(int nM_, int nN_, int G_, int c_, int latent_only_) { nM = nM_; nN = nN_; nwg = nM * nN; G = G_; c = c_; latent_only = latent_only_; }
    __device__ bool next(int i, Unit& u) const {
        const long L = (long)i * G + c; if (L >= nwg) return false;
        int wgid = (int)L; { const int q = nwg / NXCD, r = nwg % NXCD, xcd = wgid % NXCD, off = wgid / NXCD; wgid = (xcd < r ? xcd * (q + 1) : r * (q + 1) + (xcd - r) * q) + off; }
        const int nig = WGM * nN, gid = wgid / nig, fm = gid * WGM, gsz = (nM - fm) < WGM ? (nM - fm) : WGM;
        int pm = fm + ((wgid % nig) % gsz); u.pn = (wgid % nig) / gsz; u.z = 0;
        if (latent_only) pm = (pm >> 4) * 17 + 1 + (pm & 15);
        u.pm = pm; return true;
    }
};
struct ChainOrder {
    int G, c, with_ctx;
    __device__ void init(int G_, int c_, int with_ctx_) { G = G_; c = c_; with_ctx = with_ctx_; }
    __device__ bool next(int i, Unit& u) const {
        if (i < 6) { const int T = c; if (T >= 256) return false; int pm = T >> 2; u.pn = T & 3; u.z = i; u.pm = (pm >> 4) * 17 + 1 + (pm & 15); return true; }
        if (i < 8 && with_ctx && c < 48) { const int ct = c / 3, br = c - ct * 3; u.pm = (ct >> 2) * 17; u.pn = ct & 3; u.z = 8 + 2 * br + (i - 6); return true; }
        return false;
    }
};

typedef __bf16 bf16x2_t __attribute__((ext_vector_type(2)));
__device__ __forceinline__ unsigned cvt_pk_bf16(float lo, float hi) { f32x2 v = {lo, hi}; bf16x2_t b = __builtin_convertvector(v, bf16x2_t); return __builtin_bit_cast(unsigned, b); }

template <class Epi, class Prob, class Sched, bool ALIGN_EPI>
__device__ __forceinline__ void gemm_phase(LAS unsigned char* lds, const Prob& P, const Sched& S, const Epi& E) {
    int tid_ = threadIdx.x; asm volatile("" : "+v"(tid_));
    const int tid = tid_, wid = __builtin_amdgcn_readfirstlane(tid >> 6), lane = tid & 63, wr = wid >> 2, wc = wid & 3, fr = lane & 15, fq = lane >> 4;
    const int K = P.K, nt = K / BK;
    int RA[2], CA[2]; unsigned voffB[2];
#pragma unroll
    for (int i = 0; i < 2; ++i) { int R, C; stage_rc(tid * 16 + i * 8192, R, C); const int Rb = Epi::PERM ? ((R & ~31) + perm32(R & 31)) : R;
        RA[i] = R; CA[i] = C; voffB[i] = (unsigned)(Rb * P.ldb + C) * 2u; }
    const unsigned kstep = (unsigned)(BK * 2);
    const unsigned hstepB = (unsigned)(HALF * P.ldb * 2);
    const unsigned ldsw = (unsigned)wid * 1024u;
    const int aoff = lds_byte(wr * 64 + fr, fq * 8), boff = lds_byte(wc * 32 + fr, fq * 8);
#define PG8_SA(b, h) (((b) * 2 + (h)) * HTB)
#define PG8_SB(b, h) ((4 + (b) * 2 + (h)) * HTB)
#define PG8_STAGE(bufoff, gbase, soff, voff) do { _Pragma("unroll") for (int _i = 0; _i < 2; ++_i) \
        __builtin_amdgcn_global_load_lds((const unsigned*)((const char*)(gbase) + (unsigned)((voff)[_i] + (soff))), (LAS unsigned*)(lds + (bufoff) + ldsw + _i * 8192), 16, 0, 0); } while (0)
#define PG8_LDA(dst, b, h) do { _Pragma("unroll") for (int m = 0; m < 4; ++m) _Pragma("unroll") for (int k = 0; k < 2; ++k) dst[m][k] = *(const LAS bf16x8*)(lds + PG8_SA(b, h) + aoff + m * 2048 + k * 1024); } while (0)
#define PG8_LDB(dst, b, h) do { _Pragma("unroll") for (int n = 0; n < 2; ++n) _Pragma("unroll") for (int k = 0; k < 2; ++k) dst[n][k] = *(const LAS bf16x8*)(lds + PG8_SB(b, h) + boff + n * 2048 + k * 1024); } while (0)
#define PG8_MMA(ai, bj, At, Bt) do { __builtin_amdgcn_s_setprio(1); _Pragma("unroll") for (int m = 0; m < 4; ++m) _Pragma("unroll") for (int n = 0; n < 2; ++n) _Pragma("unroll") for (int k = 0; k < 2; ++k) \
        acc[ai][bj][m][n] = __builtin_amdgcn_mfma_f32_16x16x32_bf16(Bt[n][k], At[m][k], acc[ai][bj][m][n], 0, 0, 0); __builtin_amdgcn_s_setprio(0); } while (0)
#define PG8_WAIT_V(n) asm volatile("s_waitcnt vmcnt(" #n ")" ::: "memory")
#define PG8_WAIT_L(n) asm volatile("s_waitcnt lgkmcnt(" #n ")" ::: "memory")
#define PG8_BAR __builtin_amdgcn_s_barrier()
#define PG8_SCHED __builtin_amdgcn_sched_barrier(0)
    Unit cur, nxt; int ui = 0;
    if (!S.next(0, cur)) return;
    f32x4 acc[2][2][4][2];
#pragma unroll
    for (int a = 0; a < 2; ++a)
#pragma unroll
        for (int b = 0; b < 2; ++b)
#pragma unroll
            for (int m = 0; m < 4; ++m)
#pragma unroll
                for (int n = 0; n < 2; ++n) acc[a][b][m][n] = (f32x4){0.f, 0.f, 0.f, 0.f};
    bf16x8 At[4][2], B0[2][2], B1[2][2];
    const char* cA; const char* cB; int ldaC; P.get(cur, cA, cB, ldaC);
    unsigned voffA[2] = {(unsigned)(RA[0] * ldaC + CA[0]) * 2u, (unsigned)(RA[1] * ldaC + CA[1]) * 2u};
    unsigned hstepA = (unsigned)(HALF * ldaC * 2);
    PG8_STAGE(PG8_SB(0, 0), cB, 0u, voffB); PG8_STAGE(PG8_SB(0, 1), cB, hstepB, voffB); PG8_STAGE(PG8_SA(0, 0), cA, 0u, voffA); PG8_STAGE(PG8_SA(0, 1), cA, hstepA, voffA);
    if (wr == 1) PG8_BAR;
    PG8_WAIT_V(2); PG8_BAR;
    PG8_STAGE(PG8_SB(1, 0), cB, kstep, voffB); PG8_STAGE(PG8_SA(1, 0), cA, kstep, voffA); PG8_STAGE(PG8_SB(1, 1), cB, hstepB + kstep, voffB);
    PG8_WAIT_V(6); PG8_BAR;
    for (;;) {
        const bool has_next = S.next(ui + 1, nxt);
        const char* nA = cA; const char* nB = cB; int ldaN = ldaC;
        if (has_next) P.get(nxt, nA, nB, ldaN);
        unsigned voffAn[2] = {(unsigned)(RA[0] * ldaN + CA[0]) * 2u, (unsigned)(RA[1] * ldaN + CA[1]) * 2u};
        const unsigned hstepAn = (unsigned)(HALF * ldaN * 2);
        for (int t = 0; t < nt; t += 2) {
            const bool last = (t == nt - 2);
            const unsigned o1 = (unsigned)(t + 1) * kstep;
            const char* a2b = last ? nA : cA; const char* b2b = last ? nB : cB;
            const unsigned o2 = last ? 0u : (unsigned)(t + 2) * kstep, o3 = o2 + kstep;
            unsigned vA2[2] = {last ? voffAn[0] : voffA[0], last ? voffAn[1] : voffA[1]};
            const unsigned hA2 = last ? hstepAn : hstepA;
            PG8_LDB(B0, 0, 0); PG8_LDB(B1, 0, 1); PG8_SCHED; PG8_LDA(At, 0, 0); PG8_STAGE(PG8_SA(1, 1), cA, o1 + hstepA, voffA);
            PG8_WAIT_V(8); PG8_WAIT_L(0); PG8_BAR; PG8_MMA(0, 0, At, B0); PG8_MMA(0, 1, At, B1); PG8_BAR; PG8_SCHED;
            PG8_LDA(At, 0, 1); PG8_STAGE(PG8_SB(0, 0), b2b, o2, voffB); PG8_STAGE(PG8_SB(0, 1), b2b, o2 + hstepB, voffB); PG8_STAGE(PG8_SA(0, 0), a2b, o2, vA2);
            PG8_WAIT_V(8); PG8_WAIT_L(0); PG8_BAR; PG8_MMA(1, 0, At, B0); PG8_MMA(1, 1, At, B1); PG8_BAR; PG8_SCHED;
            PG8_LDB(B0, 1, 0); PG8_LDB(B1, 1, 1); PG8_SCHED; PG8_LDA(At, 1, 0); PG8_STAGE(PG8_SA(0, 1), a2b, o2 + hA2, vA2);
            PG8_WAIT_V(8); PG8_WAIT_L(0); PG8_BAR; PG8_MMA(0, 0, At, B0); PG8_MMA(0, 1, At, B1); PG8_BAR; PG8_SCHED;
            PG8_LDA(At, 1, 1); PG8_STAGE(PG8_SB(1, 0), b2b, o3, voffB); PG8_STAGE(PG8_SB(1, 1), b2b, o3 + hstepB, voffB); PG8_STAGE(PG8_SA(1, 0), a2b, o3, vA2);
            PG8_WAIT_V(8); PG8_WAIT_L(0); PG8_BAR; PG8_MMA(1, 0, At, B0); PG8_MMA(1, 1, At, B1); PG8_BAR; PG8_SCHED;
        }
        if constexpr (ALIGN_EPI) { if (wr == 0) PG8_BAR; }
        E(acc, cur, wr, wc, fr, fq);
        if (!has_next) break;
#pragma unroll
        for (int a = 0; a < 2; ++a)
#pragma unroll
            for (int b = 0; b < 2; ++b)
#pragma unroll
                for (int m = 0; m < 4; ++m)
#pragma unroll
                    for (int n = 0; n < 2; ++n) acc[a][b][m][n] = (f32x4){0.f, 0.f, 0.f, 0.f};
        cur = nxt; cA = nA; cB = nB; ldaC = ldaN; voffA[0] = voffAn[0]; voffA[1] = voffAn[1]; hstepA = hstepAn; ++ui;
        if constexpr (ALIGN_EPI) { if (wr == 1) PG8_BAR; }
    }
    PG8_WAIT_V(0);
    if constexpr (!ALIGN_EPI) { if (wr == 0) PG8_BAR; }
    PG8_BAR;
#undef PG8_SA
#undef PG8_SB
#undef PG8_STAGE
#undef PG8_LDA
#undef PG8_LDB
#undef PG8_MMA
#undef PG8_WAIT_V
#undef PG8_WAIT_L
#undef PG8_BAR
#undef PG8_SCHED
}
}

constexpr int NB = 4, TT = 4096, LC = 256, SS = TT + LC  , DM = 1024, MR = NB * SS  ;
constexpr int INC = 10944;
constexpr float EPS = 1e-6f;
constexpr float LOG2E = 1.4426950408889634f;
constexpr float QSCALE = 0.07216878364870322f * 1.4426950408889634f;
constexpr int NWAVES = 8, NTHR = 512;

constexpr size_t MiB = 1u << 20;
constexpr size_t WS_CTL = 0;
constexpr size_t WS_XC1 = 1 * MiB;
constexpr size_t WS_W = 5 * MiB;
constexpr size_t WS_AR = 25 * MiB;
constexpr size_t AR_YB = WS_AR + 0 * MiB;
constexpr size_t AR_XA = WS_AR + 34 * MiB;
constexpr size_t AR_MD = WS_AR + 68 * MiB;
constexpr size_t AR_RQKV = WS_AR + 94 * MiB;
constexpr size_t AR_OB = WS_AR + 196 * MiB;
constexpr size_t AR_KV = WS_AR + 112 * MiB;
constexpr size_t AR_QN = WS_AR + 180 * MiB;
constexpr size_t AR_QP = WS_AR + 214 * MiB;
constexpr size_t AR_RI = WS_AR + 102 * MiB;
constexpr size_t AR_Y0 = WS_AR + 68 * MiB;
constexpr size_t AR_CAF = WS_AR + 102 * MiB;
constexpr size_t AR_CAB = WS_AR + 136 * MiB;
constexpr size_t AR_SUM = WS_AR + 170 * MiB;
constexpr size_t AR_Z = WS_AR + 102 * MiB;
constexpr size_t AR_ZP = WS_AR + 170 * MiB;
constexpr size_t AR_GS = WS_AR + 136 * MiB;
constexpr size_t WS_END = 256 * MiB;
constexpr size_t W_WT1 = WS_W;
constexpr size_t W_WTQ = WS_W + 10 * MiB;
constexpr size_t W_WTKV = WS_W + 12 * MiB;
constexpr size_t W_WTL = WS_W + 13 * MiB;
constexpr size_t W_WTG = WS_W;
constexpr size_t W_WTGM = WS_W + 6 * MiB;
constexpr size_t W_WTD = WS_W + 12 * MiB;
constexpr size_t W_WTO = WS_W + 18 * MiB;
constexpr int CT_MOD = 16384;
constexpr int CT_ROPER = CT_MOD + 2 * 5 * 3072;
constexpr int CT_ROPEM = CT_ROPER + 2 * 4096;
constexpr int CT_SP = CT_ROPEM + 2 * 1024;
constexpr int CT_LG = CT_SP + 4096;
constexpr int CT_END = CT_LG + 16;
static_assert(CT_END * 4 <= (int)MiB, "CTL");

constexpr int LDS_BYTES = 147456;


#define XB_TMO      128
#define XB_XCNT(j)  (256  + 64 * (j))
#define XB_XSUB(j)  (1280 + 64 * (j))
#define XB_XGEN(j)  (2304 + 64 * (j))
#define XB_TOP      3328
#define XB_TOPGEN   3392
#define XCD_BAR_WORDS 3456
#define XB_SPIN_CAP (1u << 18)
constexpr size_t WS_BAR = 16384;
constexpr int LDS_ST = LDS_BYTES - 64;
__device__ __forceinline__ unsigned xb_ld(unsigned* p)              { return __hip_atomic_load(p, __ATOMIC_RELAXED, __HIP_MEMORY_SCOPE_AGENT); }
__device__ __forceinline__ unsigned xb_add(unsigned* p, unsigned v) { return __hip_atomic_fetch_add(p, v, __ATOMIC_RELAXED, __HIP_MEMORY_SCOPE_AGENT); }
__device__ __forceinline__ unsigned xb_xcc_id() { return (unsigned)__builtin_amdgcn_s_getreg((3 << 11) | 20) & 0xFu; }
#define XB_SPIN(cond, bar) do { unsigned _sp = 0; while (cond) { __builtin_amdgcn_s_sleep(1); \
    if ((++_sp & 255u) == 0u) { if (xb_ld(&(bar)[XB_TMO])) break; if (_sp > XB_SPIN_CAP) { atomicAdd(&(bar)[XB_TMO], 1u); break; } } } } while (0)
__device__ __forceinline__ void xcd_barrier_complete(unsigned* bar, unsigned x, unsigned& nloc, unsigned& nx) {
    const unsigned G = gridDim.x * gridDim.y * gridDim.z;
    unsigned sum, cnt, mine, sp = 0u;
    for (;;) {
        sum = 0u; cnt = 0u; mine = 0u;
#pragma unroll
        for (unsigned j = 0; j < 16; ++j) { const unsigned c = xb_ld(&bar[XB_XCNT(j)]); sum += c; cnt += (c > 0u) ? 1u : 0u; mine = (j == x) ? c : mine; }
        if (sum == G) break;
        __builtin_amdgcn_s_sleep(1);
        if ((++sp & 255u) == 0u) { if (xb_ld(&bar[XB_TMO])) break; if (sp > XB_SPIN_CAP) { atomicAdd(&bar[XB_TMO], 1u); break; } }
    }
    nloc = mine > 0u ? mine : 1u; nx = cnt > 0u ? cnt : 1u;
}
__device__ __forceinline__ void xcd_barrier(unsigned* bar, volatile LAS unsigned* st) {
    asm volatile("s_waitcnt vmcnt(0)" ::: "memory");
    __syncthreads();
    if (threadIdx.x == 0) {
        const unsigned x = xb_xcc_id();
        __builtin_amdgcn_s_waitcnt(0);
        unsigned nloc = st[0], nx = st[1];
        if (nloc == 0u) { xcd_barrier_complete(bar, x, nloc, nx); st[0] = nloc; st[1] = nx; }
        const unsigned old = xb_add(&bar[XB_XSUB(x)], 1u);
        const unsigned gen = old / nloc;
        if (old + 1u == (gen + 1u) * nloc) {
            __builtin_amdgcn_fence(__ATOMIC_RELEASE, "agent");
            asm volatile("s_waitcnt vmcnt(0)" ::: "memory");
            const unsigned og = xb_add(&bar[XB_TOP], 1u);
            const unsigned tg = og / nx;
            if (og + 1u == (tg + 1u) * nx) xb_add(&bar[XB_TOPGEN], 1u);
            else XB_SPIN(xb_ld(&bar[XB_TOPGEN]) == tg, bar);
            __builtin_amdgcn_fence(__ATOMIC_ACQUIRE, "agent");
            xb_add(&bar[XB_XGEN(x)], 1u);
            asm volatile("s_waitcnt vmcnt(0)" ::: "memory");
        } else {
            XB_SPIN(xb_ld(&bar[XB_XGEN(x)]) == gen, bar);
            __builtin_amdgcn_fence(__ATOMIC_ACQUIRE, "agent");
            asm volatile("s_waitcnt vmcnt(0)" ::: "memory");
        }
    }
    __syncthreads();
}

struct Params {
    const float* in[29];
    float* out;
    unsigned char* ws;
};

#define EX2(x) __builtin_amdgcn_exp2f(x)
#define RSQ(x) __builtin_amdgcn_rsqf(x)
#define SQRT(x) __builtin_amdgcn_sqrtf(x)
__device__ __forceinline__ float bf2f(unsigned v) { return __uint_as_float(v << 16); }
__device__ __forceinline__ unsigned f2bf(float f) { unsigned u = __float_as_uint(f); return (u + 0x7fffu + ((u >> 16) & 1u)) >> 16; }
__device__ __forceinline__ unsigned pk2(float lo, float hi) { return f2bf(lo) | (f2bf(hi) << 16); }
__device__ __forceinline__ float lo_bf(unsigned w) { return __uint_as_float(w << 16); }
__device__ __forceinline__ float hi_bf(unsigned w) { return __uint_as_float(w & 0xffff0000u); }
__device__ __forceinline__ float wave_sum(float v) {
#pragma unroll
    for (int o = 1; o < 64; o <<= 1) v += __shfl_xor(v, o);
    return v;
}
__device__ __forceinline__ float wave_max(float v) {
#pragma unroll
    for (int o = 1; o < 64; o <<= 1) v = fmaxf(v, __shfl_xor(v, o));
    return v;
}
__device__ __forceinline__ float sigmoidf_(float x) { return __builtin_amdgcn_rcpf(1.f + __expf(-x)); }
__device__ __forceinline__ float siluf_(float x) { return x * __builtin_amdgcn_rcpf(1.f + __expf(-x)); }

__device__ __forceinline__ const float* inp_(int i) { asm volatile("" : "+s"(i)); const float* const* ka = (const float* const*)__builtin_amdgcn_kernarg_segment_ptr(); return ka[i]; }
#define INP(i) inp_(i)
__device__ __forceinline__ unsigned char* wsp_(unsigned char* p) { asm volatile("" : "+s"(p)); return p; }
struct Ctx {
    float* out; unsigned char* ws; LAS unsigned char* lds; int tid, lane, wave, G, bid;
    int gw, ngw;
    int rot;
    float* ctl;
};

__device__ __forceinline__ Ctx mkctx(LAS unsigned char* lds) {
    Ctx C; int t = threadIdx.x; asm volatile("" : "+v"(t)); int b = blockIdx.x; asm volatile("" : "+s"(b)); int g = gridDim.x; asm volatile("" : "+s"(g));
    C.tid = t; C.lane = t & 63; C.wave = __builtin_amdgcn_readfirstlane(t >> 6); C.bid = b; C.G = g; C.gw = b * NWAVES + C.wave; C.ngw = g * NWAVES; C.rot = 0;
    int io = 29, iw = 30; asm volatile("" : "+s"(io)); asm volatile("" : "+s"(iw));
    unsigned char* const* ka = (unsigned char* const*)__builtin_amdgcn_kernarg_segment_ptr();
    C.out = (float*)ka[io]; C.ws = ka[iw]; C.ctl = (float*)(C.ws + WS_CTL); C.lds = lds;
    return C;
}
__device__ __forceinline__ const float* resid_row(const Ctx& C, int l, int m) {
    const int b = m / SS, s = m - b * SS;
    if (s < LC) { const float* base = (l == 0) ? INP(2) : (const float*)(C.ws + WS_XC1); return base + (size_t)(b * LC + s) * DM; }
    const float* base = (l == 0) ? INP(0) : C.out; return base + (size_t)(b * TT + (s - LC)) * DM;
}

__device__ __forceinline__ void phase_prep(Ctx& C) {
    LAS float* sl = (LAS float*)C.lds;
    LAS float* red = (LAS float*)(C.lds + 32768);
    for (int i = C.tid; i < 5 * 1024; i += NTHR) { const int r = i >> 10, k = i & 1023; const float v = (r < 4) ? INP(1)[r * 1024 + k] : INP(3)[k]; sl[i] = siluf_(v); }
    __syncthreads();
    for (int it = C.bid; it < 2 * 96; it += C.G) {
        const int l = it / 96, grp = it % 96, kg = C.tid >> 5, cj = C.tid & 31, col = grp * 32 + cj;
        const float* w = INP(4) + (size_t)l * 1024 * 3072 + col;
        float a0 = 0.f, a1 = 0.f, a2 = 0.f, a3 = 0.f, a4 = 0.f;
#pragma unroll 8
        for (int k = kg * 64; k < kg * 64 + 64; ++k) { const float wv = w[(size_t)k * 3072]; a0 += sl[k] * wv; a1 += sl[1024 + k] * wv; a2 += sl[2048 + k] * wv; a3 += sl[3072 + k] * wv; a4 += sl[4096 + k] * wv; }
        red[(kg * 32 + cj) * 5 + 0] = a0; red[(kg * 32 + cj) * 5 + 1] = a1; red[(kg * 32 + cj) * 5 + 2] = a2; red[(kg * 32 + cj) * 5 + 3] = a3; red[(kg * 32 + cj) * 5 + 4] = a4;
        __syncthreads();
        if (C.tid < 160) { const int c2 = C.tid / 5, r = C.tid % 5; float s = 0.f;
            for (int g = 0; g < 16; ++g) s += red[(g * 32 + c2) * 5 + r];
            C.ctl[CT_MOD + (l * 5 + r) * 3072 + grp * 32 + c2] = s + INP(5)[l * 3072 + grp * 32 + c2]; }
        __syncthreads();
    }
    const int gt = C.bid * NTHR + C.tid, ngt = C.G * NTHR;
    for (int i = gt; i < 4096; i += ngt) { const int pos = i >> 6, f = i & 63; const float inv = powf(10000.f, -(float)f / 64.f), ang = (float)pos * inv;
        C.ctl[CT_ROPER + i] = cosf(ang); C.ctl[CT_ROPER + 4096 + i] = sinf(ang); }
    for (int i = gt; i < 1024; i += ngt) { const int pos = i >> 4, f = i & 15; const float inv = powf(10000.f, -(float)f / 16.f), ang = (float)pos * inv;
        C.ctl[CT_ROPEM + i] = cosf(ang); C.ctl[CT_ROPEM + 1024 + i] = sinf(ang); }
    for (int i = gt; i < 4096; i += ngt) C.ctl[CT_SP + i] = log1pf(expf(-INP(14)[i]));
    for (int i = gt; i < 16; i += ngt) C.ctl[CT_LG + i] = -log1pf(expf(-INP(15)[i])) * LOG2E;
}

__device__ __forceinline__ void tr_item(const float* W, int ldw, int k0, int n0, bf16_t* WT, int ldt, int drow0, int dk0, LAS float* scr, int lane) {
#pragma unroll 8
    for (int i = 0; i < 32; ++i) { const int kk = 2 * i + (lane >> 5); scr[kk * 33 + (lane & 31)] = W[(size_t)(k0 + kk) * ldw + n0 + (lane & 31)]; }
    asm volatile("s_waitcnt lgkmcnt(0)" ::: "memory");
    const int c = lane & 7;
#pragma unroll
    for (int j = 0; j < 4; ++j) { const int n = (lane >> 3) + 8 * j; const LAS float* s = scr + (8 * c) * 33 + n;
        u32x4 o; o.x = pk2(s[0 * 33], s[1 * 33]); o.y = pk2(s[2 * 33], s[3 * 33]); o.z = pk2(s[4 * 33], s[5 * 33]); o.w = pk2(s[6 * 33], s[7 * 33]);
        *(u32x4*)(WT + (size_t)(drow0 + n) * ldt + dk0 + 8 * c) = o; }
    asm volatile("s_waitcnt lgkmcnt(0)" ::: "memory");
}
__device__ __forceinline__ void conv_rows(Ctx& C, const float* W, int ldw, int K, int scol0, bf16_t* WT, int ldt, int drow0, int dk0, int nrows, LAS float* scr) {
    const int nkb = K / 64, items = nkb * (nrows / 32);
    int g0 = C.gw - C.rot; if (g0 < 0) g0 += C.ngw; C.rot = (C.rot + items) % C.ngw;
    for (int it = g0; it < items; it += C.ngw) { const int nb = it / nkb, kb = it - nb * nkb;
        tr_item(W, ldw, kb * 64, scol0 + nb * 32, WT, ldt, drow0 + nb * 32, dk0 + kb * 64, scr, C.lane); }
}
__device__ __forceinline__ int ropeperm(int j) { const int h = j >> 8, jj = j & 255, half = jj >> 7, g = (jj & 127) >> 3, r8 = jj & 7; return h * 256 + (half * 2 + (r8 >> 2)) * 64 + g * 4 + (r8 & 3); }
__device__ __forceinline__ void tr_item_rope(const float* W, int ldw, int k0, int scol0, int jbase, bf16_t* WT, int ldt, int drow0, int dk0, LAS float* scr, int lane) {
    const int sc = scol0 + ropeperm(jbase + (lane & 31));
#pragma unroll 8
    for (int i = 0; i < 32; ++i) { const int kk = 2 * i + (lane >> 5); scr[kk * 33 + (lane & 31)] = W[(size_t)(k0 + kk) * ldw + sc]; }
    asm volatile("s_waitcnt lgkmcnt(0)" ::: "memory");
    const int c = lane & 7;
#pragma unroll
    for (int j = 0; j < 4; ++j) { const int n = (lane >> 3) + 8 * j; const LAS float* s = scr + (8 * c) * 33 + n;
        u32x4 o; o.x = pk2(s[0 * 33], s[1 * 33]); o.y = pk2(s[2 * 33], s[3 * 33]); o.z = pk2(s[4 * 33], s[5 * 33]); o.w = pk2(s[6 * 33], s[7 * 33]);
        *(u32x4*)(WT + (size_t)(drow0 + n) * ldt + dk0 + 8 * c) = o; }
    asm volatile("s_waitcnt lgkmcnt(0)" ::: "memory");
}
__device__ __forceinline__ void conv_rows_rope(Ctx& C, const float* W, int ldw, int K, int scol0, bf16_t* WT, int ldt, int drow0, int nrows, LAS float* scr) {
    const int nkb = K / 64, items = nkb * (nrows / 32);
    int g0 = C.gw - C.rot; if (g0 < 0) g0 += C.ngw; C.rot = (C.rot + items) % C.ngw;
    for (int it = g0; it < items; it += C.ngw) { const int nb = it / nkb, kb = it - nb * nkb;
        tr_item_rope(W, ldw, kb * 64, scol0, nb * 32, WT, ldt, drow0 + nb * 32, kb * 64, scr, C.lane); }
}
__device__ __forceinline__ void zero_rows(Ctx& C, bf16_t* WT, int ldt, int drow0, int dk0, int nrows, int ncols) {
    const int per = ncols / 8, items = nrows * per;
    int g0 = C.gw - C.rot; if (g0 < 0) g0 += C.ngw; C.rot = (C.rot + (items + 63) / 64) % C.ngw;
    for (int it = g0 * 64 + C.lane; it < items; it += C.ngw * 64) { const int r = it / per, c = it - r * per; *(u32x4*)(WT + (size_t)(drow0 + r) * ldt + dk0 + c * 8) = (u32x4){0u, 0u, 0u, 0u}; }
}
__device__ __forceinline__ void phase_wconv_early(Ctx& C, int l) {
    LAS float* scr = (LAS float*)(C.lds + C.wave * 16384);
    unsigned char* ws = C.ws;
    const float* win = INP(7) + (size_t)l * 1024 * INC;
    bf16_t* WT1 = (bf16_t*)(ws + W_WT1);
    conv_rows(C, win, INC, 1024, 0, WT1, 1024, 0, 0, 1024, scr);
    conv_rows_rope(C, win, INC, 1024, 2048, WT1, 1024, 1024, 1024, scr);
    conv_rows_rope(C, win, INC, 1024, 3072, WT1, 1024, 2048, 1024, scr);
    conv_rows(C, win, INC, 1024, 4096, WT1, 1024, 3072, 0, 1024, scr);
    conv_rows(C, win, INC, 1024, 6144, WT1, 1024, 4096, 0, 704, scr);
    zero_rows(C, WT1, 1024, 4800, 0, 64, 1024);
    const float* wq = INP(18) + (size_t)l * 384 * 1536; bf16_t* WTQ = (bf16_t*)(ws + W_WTQ);
    for (int h = 0; h < 8; ++h) { conv_rows(C, wq, 1536, 384, h * 192, WTQ, 384, h * 128, 0, 128, scr); conv_rows(C, wq, 1536, 384, h * 192 + 128, WTQ, 384, 1024 + h * 64, 0, 64, scr); }
    const float* wkv = INP(20) + (size_t)l * 256 * 2048; bf16_t* WTKV = (bf16_t*)(ws + W_WTKV);
    for (int h = 0; h < 8; ++h) { conv_rows(C, wkv, 2048, 256, h * 256, WTKV, 256, h * 128, 0, 128, scr); conv_rows(C, wkv, 2048, 256, h * 256 + 128, WTKV, 256, 1024 + h * 128, 0, 128, scr); }
    bf16_t* WTL = (bf16_t*)(ws + W_WTL);
    for (int d = 0; d < 2; ++d) for (int n = 0; n < 8; ++n) for (int mat = 0; mat < 2; ++mat) {
        const float* w = INP(mat == 0 ? 10 : 12) + ((size_t)(l * 2 + d) * 8 + n) * 128 * 128;
        const int drow0 = d * 2048 + n * 256 + mat * 128;
        conv_rows(C, w, 128, 128, 0, WTL, 256, drow0, (n & 1) * 128, 128, scr);
        zero_rows(C, WTL, 256, drow0, ((n & 1) ^ 1) * 128, 128, 128);
    }
}
__device__ __forceinline__ void phase_wconv_late(Ctx& C, int l) {
    LAS float* scr = (LAS float*)(C.lds + C.wave * 16384);
    unsigned char* ws = C.ws;
    const float* win = INP(7) + (size_t)l * 1024 * INC;
    bf16_t* WTG = (bf16_t*)(ws + W_WTG);
    conv_rows(C, win, INC, 1024, 1024, WTG, 1024, 0, 0, 1024, scr);
    conv_rows(C, win, INC, 1024, 5120, WTG, 1024, 1024, 0, 1024, scr);
    conv_rows(C, win, INC, 1024, 6848, WTG, 1024, 2048, 0, 1024, scr);
    conv_rows(C, win, INC, 1024, 7872, (bf16_t*)(ws + W_WTGM), 1024, 0, 0, 3072, scr);
    for (int i = 0; i < 3; ++i) conv_rows(C, INP(25 + i) + (size_t)l * 1024 * 1024, 1024, 1024, 0, (bf16_t*)(ws + W_WTD) + (size_t)i * 1024 * 1024, 1024, 0, 0, 1024, scr);
    conv_rows(C, INP(28) + (size_t)l * 1024 * 1024, 1024, 1024, 0, (bf16_t*)(ws + W_WTO), 1024, 0, 0, 1024, scr);
}

__device__ __forceinline__ void phase_h(Ctx& C, int l, bf16_t* H) {
    const float* gain = INP(6) + l * 1024;
    for (int m = C.gw; m < MR; m += C.ngw) {
        const int b = m / SS, s = m - b * SS, r = (s < LC) ? 4 : b;
        const float* xr = resid_row(C, l, m);
        const float* mod = C.ctl + CT_MOD + (l * 5 + r) * 3072;
        f32x4 v[4]; float ss = 0.f;
#pragma unroll
        for (int j = 0; j < 4; ++j) { v[j] = *(const f32x4*)(xr + 4 * C.lane + 256 * j); ss += (v[j].x * v[j].x + v[j].y * v[j].y) + (v[j].z * v[j].z + v[j].w * v[j].w); }
        const float rstd = RSQ(wave_sum(ss) * (1.f / 1024.f) + EPS);
#pragma unroll
        for (int j = 0; j < 4; ++j) { const int c = 4 * C.lane + 256 * j;
            const f32x4 g = *(const f32x4*)(gain + c), sh = *(const f32x4*)(mod + c), sc = *(const f32x4*)(mod + 1024 + c);
            const f32x4 y = (v[j] * rstd) * g;
            const f32x4 o = y * (sc + 1.0f) + sh;
            u32x2 w; w.x = pk2(o.x, o.y); w.y = pk2(o.z, o.w);
            *(u32x2*)(H + (size_t)m * 1024 + c) = w; }
    }
}

using pg8::Unit;
struct ProbPlain {
    const bf16_t* A; const bf16_t* Bt; int lda, ldb, K;
    __device__ __forceinline__ void get(const Unit& u, const char*& a, const char*& b, int& lda_) const {
        a = (const char*)(A + (size_t)u.pm * 256 * lda); b = (const char*)(Bt + (size_t)u.pn * 256 * ldb); lda_ = lda; }
};
struct ProbLru {
    const bf16_t* A; const bf16_t* Bt; int ldb, K;
    __device__ __forceinline__ void get(const Unit& u, const char*& a, const char*& b, int& lda_) const {
        a = (const char*)(A + (size_t)u.pm * 256 * 1024 + (u.pn >> 1) * 256); b = (const char*)(Bt + (size_t)u.pn * 256 * 256); lda_ = 1024; }
};
struct ProbD {
    unsigned char* ws; int ldb, K;
    __device__ __forceinline__ void get(const Unit& u, const char*& a, const char*& b, int& lda_) const {
        const int i = (u.z & 7) >> 1;
        if ((u.z & 1) == 0) { a = (const char*)(ws + AR_MD + (size_t)u.pm * 256 * 1024 * 2); b = (const char*)(ws + W_WTGM + ((size_t)i * 1024 + u.pn * 256) * 1024 * 2); lda_ = 1024; }
        else { const size_t yo = (i == 0) ? AR_XA : (i == 1) ? AR_YB : AR_QN;
            a = (const char*)(ws + yo + (size_t)u.pm * 256 * 1024 * 2); b = (const char*)(ws + W_WTD + ((size_t)i * 1024 + u.pn * 256) * 1024 * 2); lda_ = 1024; }
    }
};

#define EPI_ARGS const f32x4 (&acc)[2][2][4][2], const Unit& u, int wr, int wc, int fr, int fq
template <size_t O0, int L0, size_t O1, int L1, size_t O2, int L2, int T1, int T2>
struct EpiStore3 {
    static constexpr bool PERM = true;
    unsigned char* ws;
    __device__ __forceinline__ void operator()(EPI_ARGS) const {
        bf16_t* bs; int ldc, ct;
        size_t off;
        if (u.pn < T1) { off = O0; ldc = L0; ct = u.pn; } else if (u.pn < T2) { off = O1; ldc = L1; ct = u.pn - T1; } else { off = O2; ldc = L2; ct = u.pn - T2; }
        bs = (bf16_t*)(ws + off);
        const int row0 = u.pm * 256 + wr * 64 + fr, col0 = ct * 256 + wc * 32 + 8 * fq;
#pragma unroll
        for (int ai = 0; ai < 2; ++ai)
#pragma unroll
            for (int m = 0; m < 4; ++m) { bf16_t* rowp = bs + (size_t)(row0 + ai * 128 + m * 16) * ldc + col0;
#pragma unroll
                for (int bj = 0; bj < 2; ++bj) { const f32x4 v0 = acc[ai][bj][m][0], v1 = acc[ai][bj][m][1];
                    u32x4 w; w.x = pg8::cvt_pk_bf16(v0[0], v0[1]); w.y = pg8::cvt_pk_bf16(v0[2], v0[3]); w.z = pg8::cvt_pk_bf16(v1[0], v1[1]); w.w = pg8::cvt_pk_bf16(v1[2], v1[3]);
                    *(u32x4*)(rowp + bj * 128) = w; } }
    }
};
struct EpiG1 {
    static constexpr bool PERM = true;
    unsigned char* ws; const float* cs;
    __device__ __forceinline__ void operator()(EPI_ARGS) const {
        bf16_t* bs; int ldc, ct;
        if (u.pn < 4) { bs = (bf16_t*)(ws + AR_XA); ldc = 1024; ct = u.pn; } else if (u.pn < 16) { bs = (bf16_t*)(ws + AR_RQKV); ldc = 3072; ct = u.pn - 4; } else { bs = (bf16_t*)(ws + AR_MD); ldc = 768; ct = u.pn - 16; }
        const int row0 = u.pm * 256 + wr * 64 + fr, col0 = ct * 256 + wc * 32 + 8 * fq;
        const bool rope = (u.pn >= 4) && (u.pn < 12), iskey = (u.pn >= 8);
        const int bq = u.pm / 17, s0 = (u.pm - bq * 17) * 256 + wr * 64 + fr;
        const int f0 = (wc * 4 + fq) * 4;
#pragma unroll
        for (int ai = 0; ai < 2; ++ai)
#pragma unroll
            for (int m = 0; m < 4; ++m) { bf16_t* rowp = bs + (size_t)(row0 + ai * 128 + m * 16) * ldc + col0;
                const int s = s0 + ai * 128 + m * 16, t = s - LC; const bool lat = s >= LC;
#pragma unroll
                for (int bj = 0; bj < 2; ++bj) { f32x4 v0 = acc[ai][bj][m][0], v1 = acc[ai][bj][m][1];
                    if (rope) {
                        if (lat) { const int pos = bj ? (t & 63) : (t >> 6); const f32x4 c = *(const f32x4*)(cs + pos * 64 + f0), sn = *(const f32x4*)(cs + 4096 + pos * 64 + f0);
                            const f32x4 a = v0 * c - v1 * sn, b = v1 * c + v0 * sn; v0 = a; v1 = b; }
                        if (iskey) { v0 = v0 * 0.0625f; v1 = v1 * 0.0625f; } }
                    u32x4 w; w.x = pg8::cvt_pk_bf16(v0[0], v0[1]); w.y = pg8::cvt_pk_bf16(v0[2], v0[3]); w.z = pg8::cvt_pk_bf16(v1[0], v1[1]); w.w = pg8::cvt_pk_bf16(v1[2], v1[3]);
                    *(u32x4*)(rowp + bj * 128) = w; }
                asm volatile("" ::: "memory"); }
    }
};
typedef f16_t f16x8 __attribute__((ext_vector_type(8)));
struct EpiLru {
    static constexpr bool PERM = true;
    const bf16_t* U; f16_t* RI; const float* ba; const float* bx; const float* sp;
    __device__ __forceinline__ void operator()(EPI_ARGS) const {
        const int row0 = u.pm * 256 + wr * 64 + fr, ch0 = u.pn * 128 + wc * 32 + 8 * fq;
        float bav[8], bxv[8], spv[8];
#pragma unroll
        for (int e = 0; e < 8; ++e) { bav[e] = ba[ch0 + e]; bxv[e] = bx[ch0 + e]; spv[e] = sp[ch0 + e] * (-8.f); }
#pragma unroll
        for (int ai = 0; ai < 2; ++ai)
#pragma unroll
            for (int m = 0; m < 4; ++m) { const int row = row0 + ai * 128 + m * 16;
                const u32x4 uw = *(const u32x4*)(U + (size_t)row * 1024 + ch0);
                float uv[8] = {lo_bf(uw.x), hi_bf(uw.x), lo_bf(uw.y), hi_bf(uw.y), lo_bf(uw.z), hi_bf(uw.z), lo_bf(uw.w), hi_bf(uw.w)};
                f16x8 la, bc;
#pragma unroll
                for (int e = 0; e < 8; ++e) { const float rp = acc[ai][0][m][e >> 2][e & 3] + bav[e], ip = acc[ai][1][m][e >> 2][e & 3] + bxv[e];
                    const float r = sigmoidf_(rp), ig = sigmoidf_(ip);
                    const float loga = r * spv[e];
                    const float bb = SQRT(fmaxf(-expm1f(2.f * loga), 0.f)) * (ig * uv[e]);
                    la[e] = (f16_t)(loga * LOG2E); bc[e] = (f16_t)bb; }
                *(f16x8*)(RI + (size_t)row * 2048 + ch0) = la; *(f16x8*)(RI + (size_t)row * 2048 + 1024 + ch0) = bc;
                asm volatile("" ::: "memory"); }
    }
};
struct EpiGate {
    static constexpr bool PERM = true;
    unsigned char* ws;
    __device__ __forceinline__ void operator()(EPI_ARGS) const {
        const int br = u.pn >> 2; const size_t yo = (br == 0) ? AR_XA : (br == 1) ? AR_YB : AR_QN; bf16_t* bs = (bf16_t*)(ws + yo); const int ldc = 1024;
        const int row0 = u.pm * 256 + wr * 64 + fr, col0 = (u.pn & 3) * 256 + wc * 32 + 8 * fq;
#pragma unroll
        for (int ai = 0; ai < 2; ++ai)
#pragma unroll
            for (int m = 0; m < 4; ++m) { bf16_t* rowp = bs + (size_t)(row0 + ai * 128 + m * 16) * ldc + col0;
#pragma unroll
                for (int bj = 0; bj < 2; ++bj) { const f32x4 v0 = acc[ai][bj][m][0], v1 = acc[ai][bj][m][1];
                    const u32x4 y = *(const u32x4*)(rowp + bj * 128);
                    u32x4 w; w.x = pg8::cvt_pk_bf16(lo_bf(y.x) * siluf_(v0[0]), hi_bf(y.x) * siluf_(v0[1])); w.y = pg8::cvt_pk_bf16(lo_bf(y.y) * siluf_(v0[2]), hi_bf(y.y) * siluf_(v0[3]));
                    w.z = pg8::cvt_pk_bf16(lo_bf(y.z) * siluf_(v1[0]), hi_bf(y.z) * siluf_(v1[1])); w.w = pg8::cvt_pk_bf16(lo_bf(y.w) * siluf_(v1[2]), hi_bf(y.w) * siluf_(v1[3]));
                    *(u32x4*)(rowp + bj * 128) = w; }
                asm volatile("" ::: "memory"); }
    }
};
struct EpiD {
    static constexpr bool PERM = true;
    bf16_t* Z; unsigned char* gs; bf16_t* ZP;
    __device__ __forceinline__ void operator()(EPI_ARGS) const {
        const int col0 = u.pn * 256 + wc * 32 + 8 * fq, i = (u.z & 7) >> 1; const bool part = u.z >= 8;
        const int row0 = part ? ((u.pm / 17) * 256 + wr * 64 + fr) : (u.pm * 256 + wr * 64 + fr);
        bf16_t* const zb = part ? (ZP + (size_t)i * 1024 * 1024) : Z;
        const unsigned tq = (unsigned)(((wr * 4 + wc) * 64 + fq * 16 + fr) * 64);
        if ((u.z & 1) == 0) {
#pragma unroll
            for (int ai = 0; ai < 2; ++ai)
#pragma unroll
                for (int m = 0; m < 4; ++m)
#pragma unroll
                    for (int bj = 0; bj < 2; ++bj) { const f32x4 v0 = acc[ai][bj][m][0], v1 = acc[ai][bj][m][1];
                        u32x4 w; w.x = pg8::cvt_pk_bf16(sigmoidf_(v0[0]), sigmoidf_(v0[1])); w.y = pg8::cvt_pk_bf16(sigmoidf_(v0[2]), sigmoidf_(v0[3]));
                        w.z = pg8::cvt_pk_bf16(sigmoidf_(v1[0]), sigmoidf_(v1[1])); w.w = pg8::cvt_pk_bf16(sigmoidf_(v1[2]), sigmoidf_(v1[3]));
                        *(u32x4*)(gs + (((ai * 4 + m) * 2 + bj) >> 2) * 32768 + tq + (((ai * 4 + m) * 2 + bj) & 3) * 16) = w; }
        } else {
#pragma unroll
            for (int ai = 0; ai < 2; ++ai)
#pragma unroll
                for (int m = 0; m < 4; ++m) { bf16_t* zrow = zb + (size_t)(row0 + ai * 128 + m * 16) * 1024 + col0;
#pragma unroll
                    for (int bj = 0; bj < 2; ++bj) { const f32x4 v0 = acc[ai][bj][m][0], v1 = acc[ai][bj][m][1];
                        const u32x4 g = *(const u32x4*)(gs + (((ai * 4 + m) * 2 + bj) >> 2) * 32768 + tq + (((ai * 4 + m) * 2 + bj) & 3) * 16); bf16_t* zp = zrow + bj * 128;
                        float o0 = lo_bf(g.x) * v0[0], o1 = hi_bf(g.x) * v0[1], o2 = lo_bf(g.y) * v0[2], o3 = hi_bf(g.y) * v0[3], o4 = lo_bf(g.z) * v1[0], o5 = hi_bf(g.z) * v1[1], o6 = lo_bf(g.w) * v1[2], o7 = hi_bf(g.w) * v1[3];
                        if (i > 0 && !part) { const u32x4 zo = *(const u32x4*)zp; o0 += lo_bf(zo.x); o1 += hi_bf(zo.x); o2 += lo_bf(zo.y); o3 += hi_bf(zo.y); o4 += lo_bf(zo.z); o5 += hi_bf(zo.z); o6 += lo_bf(zo.w); o7 += hi_bf(zo.w); }
                        u32x4 w; w.x = pg8::cvt_pk_bf16(o0, o1); w.y = pg8::cvt_pk_bf16(o2, o3); w.z = pg8::cvt_pk_bf16(o4, o5); w.w = pg8::cvt_pk_bf16(o6, o7); *(u32x4*)zp = w; }
                    asm volatile("" ::: "memory"); }
        }
    }
};
struct EpiOut {
    static constexpr bool PERM = false;
    const float* xlat; const float* xctx; float* olat; float* octx; const float* mod;
    __device__ __forceinline__ void operator()(EPI_ARGS) const {
        const int b = u.pm / 17, isctx = (u.pm - b * 17) == 0;
        const float* gate = mod + (isctx ? 4 : b) * 3072 + 2048;
        const int col0 = u.pn * 256 + wc * 32 + 4 * fq;
        f32x4 gv[2][2];
#pragma unroll
        for (int bj = 0; bj < 2; ++bj)
#pragma unroll
            for (int n = 0; n < 2; ++n) gv[bj][n] = *(const f32x4*)(gate + col0 + bj * 128 + n * 16);
#pragma unroll
        for (int ai = 0; ai < 2; ++ai)
#pragma unroll
            for (int m = 0; m < 4; ++m) { const int s = (u.pm - b * 17) * 256 + ai * 128 + wr * 64 + m * 16 + fr;
                const size_t off = isctx ? ((size_t)(b * LC + s) * 1024 + col0) : ((size_t)(b * TT + (s - LC)) * 1024 + col0);
                const float* xin = isctx ? xctx : xlat; float* xo = isctx ? octx : olat;
#pragma unroll
                for (int bj = 0; bj < 2; ++bj)
#pragma unroll
                    for (int n = 0; n < 2; ++n) { const f32x4 xv = *(const f32x4*)(xin + off + bj * 128 + n * 16);
                        *(f32x4*)(xo + off + bj * 128 + n * 16) = xv + gv[bj][n] * acc[ai][bj][m][n]; }
                asm volatile("" ::: "memory"); }
    }
};

__device__ __forceinline__ void phase_ret_rope(Ctx& C, bf16_t* RQKV) {
    const float* cs = C.ctl + CT_ROPER; const float* sn = cs + 4096;
    for (int m = C.gw; m < MR; m += C.ngw) {
        const int b = m / SS, s = m - b * SS; const bool lat = s >= LC; const int t = s - LC, prow = lat ? (t >> 6) : 0, pcol = lat ? (t & 63) : 0;
        bf16_t* row = RQKV + (size_t)m * 3072;
#pragma unroll
        for (int j = 0; j < 16; ++j) {
            const int idx = j * 64 + C.lane, f = idx & 63, half = (idx >> 6) & 1, h = (idx >> 7) & 3, tz = idx >> 9;
            bf16_t* p = row + tz * 1024 + h * 256 + half * 128 + f;
            const float x1 = bf2f(p[0]), x2 = bf2f(p[64]);
            float o1 = x1, o2 = x2;
            if (lat) { const int pos = half ? pcol : prow; const float c = cs[pos * 64 + f], sv = sn[pos * 64 + f]; o1 = x1 * c - x2 * sv; o2 = x2 * c + x1 * sv; }
            if (tz) { o1 *= 0.0625f; o2 *= 0.0625f; }
            p[0] = (bf16_t)f2bf(o1); p[64] = (bf16_t)f2bf(o2);
        }
    }
}

#define RS_STEP(o, cnt, st) do { const bool up_ = (C.lane & (st)) != 0; _Pragma("unroll") for (int e_ = 0; e_ < (cnt) / 2; ++e_) { \
        const float send_ = up_ ? o[e_] : o[e_ + (cnt) / 2]; const float keep_ = up_ ? o[e_ + (cnt) / 2] : o[e_]; o[e_] = keep_ + __shfl_xor(send_, (st)); } } while (0)

__device__ __forceinline__ void phase_ret_naive(Ctx& C, int l, const bf16_t* RQKV, bf16_t* OI) {
    LAS unsigned char* qs = C.lds + C.wave * 512;
    const int nbu = (MR / 8) * 16;
    for (int bu = C.bid; bu < nbu; bu += C.G) {
        const int hq = bu & 15, h = hq >> 2, qd = hq & 3, n = (bu >> 4) * 8 + C.wave;
        const int b = n / SS, sn_ = n - b * SS;
        const float lgf = C.ctl[CT_LG + (l * 2 + 0) * 4 + h], lgb = C.ctl[CT_LG + (l * 2 + 1) * 4 + h];
        const int pfn = sn_, pbn = (sn_ < LC) ? (LC - 1 - sn_) : (SS + LC - 1 - sn_);
        asm volatile("s_waitcnt lgkmcnt(0)" ::: "memory");
        *(LAS u32x2*)(qs + C.lane * 8) = *(const u32x2*)(RQKV + (size_t)n * 3072 + h * 256 + C.lane * 4);
        asm volatile("s_waitcnt lgkmcnt(0)" ::: "memory");
        float o[64];
#pragma unroll
        for (int e = 0; e < 64; ++e) o[e] = 0.f;
        for (int sm = C.lane; sm < SS; sm += 64) {
            const bf16_t* krow = RQKV + (size_t)(b * SS + sm) * 3072 + 1024 + h * 256;
            float dot = 0.f;
#pragma unroll 4
            for (int c = 0; c < 32; ++c) { const u32x4 kv = *(const u32x4*)(krow + c * 8); const u32x4 qv = *(const LAS u32x4*)(qs + c * 16);
                dot += lo_bf(kv.x) * lo_bf(qv.x) + hi_bf(kv.x) * hi_bf(qv.x) + lo_bf(kv.y) * lo_bf(qv.y) + hi_bf(kv.y) * hi_bf(qv.y)
                     + lo_bf(kv.z) * lo_bf(qv.z) + hi_bf(kv.z) * hi_bf(qv.z) + lo_bf(kv.w) * lo_bf(qv.w) + hi_bf(kv.w) * hi_bf(qv.w); }
            const int pfm = sm, pbm = (sm < LC) ? (LC - 1 - sm) : (SS + LC - 1 - sm);
            float w = 0.f;
            if (pfn >= pfm) w += EX2(lgf * (float)(pfn - pfm));
            if (pbn >= pbm) w += EX2(lgb * (float)(pbn - pbm));
            const float ws_ = w * dot;
            const bf16_t* vrow = krow + 1024 + qd * 64;
#pragma unroll
            for (int c = 0; c < 8; ++c) { const u32x4 vv = *(const u32x4*)(vrow + c * 8);
                o[c * 8 + 0] += ws_ * lo_bf(vv.x); o[c * 8 + 1] += ws_ * hi_bf(vv.x); o[c * 8 + 2] += ws_ * lo_bf(vv.y); o[c * 8 + 3] += ws_ * hi_bf(vv.y);
                o[c * 8 + 4] += ws_ * lo_bf(vv.z); o[c * 8 + 5] += ws_ * hi_bf(vv.z); o[c * 8 + 6] += ws_ * lo_bf(vv.w); o[c * 8 + 7] += ws_ * hi_bf(vv.w); }
        }
        RS_STEP(o, 64, 32); RS_STEP(o, 32, 16); RS_STEP(o, 16, 8); RS_STEP(o, 8, 4); RS_STEP(o, 4, 2); RS_STEP(o, 2, 1);
        OI[(size_t)n * 1024 + h * 256 + qd * 64 + C.lane] = (bf16_t)f2bf(o[0]);
    }
}
__device__ __forceinline__ void phase_ret_ln(Ctx& C, int l, bf16_t* OI) {
    const float* gain = INP(16) + l * 1024;
    for (int m = C.gw; m < MR; m += C.ngw) {
#pragma unroll
        for (int h = 0; h < 4; ++h) { bf16_t* p = OI + (size_t)m * 1024 + h * 256 + C.lane * 4;
            const u32x2 w = *(const u32x2*)p; float x0 = lo_bf(w.x), x1 = hi_bf(w.x), x2 = lo_bf(w.y), x3 = hi_bf(w.y);
            const float mean = wave_sum((x0 + x1) + (x2 + x3)) * (1.f / 256.f);
            x0 -= mean; x1 -= mean; x2 -= mean; x3 -= mean;
            const float var = wave_sum((x0 * x0 + x1 * x1) + (x2 * x2 + x3 * x3)) * (1.f / 256.f);
            const float rstd = RSQ(var + EPS);
            const f32x4 g = *(const f32x4*)(gain + h * 256 + C.lane * 4);
            u32x2 o; o.x = pk2(x0 * rstd * g.x, x1 * rstd * g.y); o.y = pk2(x2 * rstd * g.z, x3 * rstd * g.w); *(u32x2*)p = o; }
    }
}

__device__ __forceinline__ void phase_md_post(Ctx& C, int l, bf16_t* MD) {
    const float* qn = INP(17) + l * 384; const float* kvn = INP(19) + l * 256; const float* gkr = INP(24) + l * 64;
    const float* cs = C.ctl + CT_ROPEM; const float* sn = cs + 1024;
    for (int m = C.gw; m < MR; m += C.ngw) {
        const int b = m / SS, s = m - b * SS; const bool lat = s >= LC; const int t = s - LC;
        bf16_t* row = MD + (size_t)m * 768;
        {   float x[6]; float ss = 0.f;
#pragma unroll
            for (int j = 0; j < 3; ++j) { const unsigned w = *(const unsigned*)(row + 2 * C.lane + 128 * j); x[2 * j] = lo_bf(w); x[2 * j + 1] = hi_bf(w); ss += x[2 * j] * x[2 * j] + x[2 * j + 1] * x[2 * j + 1]; }
            const float rstd = RSQ(wave_sum(ss) * (1.f / 384.f) + EPS);
#pragma unroll
            for (int j = 0; j < 3; ++j) { const int c = 2 * C.lane + 128 * j; *(unsigned*)(row + c) = pk2(x[2 * j] * rstd * qn[c], x[2 * j + 1] * rstd * qn[c + 1]); } }
        {   float x[4]; float ss = 0.f;
#pragma unroll
            for (int j = 0; j < 2; ++j) { const unsigned w = *(const unsigned*)(row + 384 + 2 * C.lane + 128 * j); x[2 * j] = lo_bf(w); x[2 * j + 1] = hi_bf(w); ss += x[2 * j] * x[2 * j] + x[2 * j + 1] * x[2 * j + 1]; }
            const float rstd = RSQ(wave_sum(ss) * (1.f / 256.f) + EPS);
#pragma unroll
            for (int j = 0; j < 2; ++j) { const int c = 2 * C.lane + 128 * j; *(unsigned*)(row + 384 + c) = pk2(x[2 * j] * rstd * kvn[c], x[2 * j + 1] * rstd * kvn[c + 1]); } }
        {   const float x = bf2f(row[640 + C.lane]);
            const float rstd = RSQ(wave_sum(x * x) * (1.f / 64.f) + EPS);
            float y = x * rstd * gkr[C.lane];
            if (lat) { const float pr = __shfl_xor(y, 16); const float rot = (C.lane & 16) ? pr : -pr; const int f = C.lane & 15, pos = (C.lane < 32) ? (t >> 6) : (t & 63);
                y = y * cs[pos * 16 + f] + rot * sn[pos * 16 + f]; }
            row[640 + C.lane] = (bf16_t)f2bf(y); }
    }
}
__device__ __forceinline__ void phase_qk_post(Ctx& C, int l, bf16_t* QN, bf16_t* QP, bf16_t* KV) {
    const float* gqn = INP(21) + l * 128; const float* gqr = INP(22) + l * 64; const float* gkn = INP(23) + l * 128;
    const float* cs = C.ctl + CT_ROPEM; const float* sn = cs + 1024;
    for (int m = C.gw; m < MR; m += C.ngw) {
        const int b = m / SS, s = m - b * SS; const bool lat = s >= LC; const int t = s - LC;
        bf16_t* qrow = QN + (size_t)m * 1024; bf16_t* prow = QP + (size_t)m * 512; bf16_t* krow = KV + (size_t)m * 2048;
#pragma unroll
        for (int h = 0; h < 8; ++h) {
            {   unsigned* p = (unsigned*)(qrow + h * 128 + 2 * C.lane); const unsigned w = *p; const float x0 = lo_bf(w), x1 = hi_bf(w);
                const float rstd = RSQ(wave_sum(x0 * x0 + x1 * x1) * (1.f / 128.f) + EPS);
                *p = pk2(x0 * rstd * gqn[2 * C.lane] * QSCALE, x1 * rstd * gqn[2 * C.lane + 1] * QSCALE); }
            {   bf16_t* p = prow + h * 64 + C.lane; const float x = bf2f(*p);
                const float rstd = RSQ(wave_sum(x * x) * (1.f / 64.f) + EPS);
                float y = x * rstd * gqr[C.lane];
                if (lat) { const float pr = __shfl_xor(y, 16); const float rot = (C.lane & 16) ? pr : -pr; const int f = C.lane & 15, pos = (C.lane < 32) ? (t >> 6) : (t & 63);
                    y = y * cs[pos * 16 + f] + rot * sn[pos * 16 + f]; }
                *p = (bf16_t)f2bf(y * QSCALE); }
            {   unsigned* p = (unsigned*)(krow + h * 128 + 2 * C.lane); const unsigned w = *p; const float x0 = lo_bf(w), x1 = hi_bf(w);
                const float rstd = RSQ(wave_sum(x0 * x0 + x1 * x1) * (1.f / 128.f) + EPS);
                *p = pk2(x0 * rstd * gkn[2 * C.lane], x1 * rstd * gkn[2 * C.lane + 1]); }
        }
    }
}

__device__ __forceinline__ void phase_attn_naive(Ctx& C, bool with_ctx, bf16_t* QN, const bf16_t* QP, const bf16_t* KV, const bf16_t* MD) {
    LAS unsigned char* qs = C.lds + C.wave * 512;
    const int nlat = NB * 8 * (TT / 8), nctx = with_ctx ? NB * 8 * (LC / 8) : 0;
    for (int bu = C.bid; bu < nlat + nctx; bu += C.G) {
        int b, h, s, nkeys;
        if (bu < nlat) { const int tb = bu % (TT / 8), bh = bu / (TT / 8); b = bh >> 3; h = bh & 7; s = LC + tb * 8 + C.wave; nkeys = SS; }
        else { const int r = bu - nlat, tb = r % (LC / 8), bh = r / (LC / 8); b = bh >> 3; h = bh & 7; s = tb * 8 + C.wave; nkeys = LC; }
        const size_t m = (size_t)b * SS + s;
        asm volatile("s_waitcnt lgkmcnt(0)" ::: "memory");
        if (C.lane < 32) *(LAS u32x2*)(qs + C.lane * 8) = *(const u32x2*)(QN + m * 1024 + h * 128 + C.lane * 4);
        else if (C.lane < 48) *(LAS u32x2*)(qs + 256 + (C.lane - 32) * 8) = *(const u32x2*)(QP + m * 512 + h * 64 + (C.lane - 32) * 4);
        asm volatile("s_waitcnt lgkmcnt(0)" ::: "memory");
        float o[128];
#pragma unroll
        for (int e = 0; e < 128; ++e) o[e] = 0.f;
        float mrun = -1e30f, lrun = 0.f;
        for (int key = C.lane; key < nkeys; key += 64) {
            const size_t kr = (size_t)b * SS + key;
            const bf16_t* kn = KV + kr * 2048 + h * 128; const bf16_t* kro = MD + kr * 768 + 640;
            float dot = 0.f;
#pragma unroll 4
            for (int c = 0; c < 16; ++c) { const u32x4 kv = *(const u32x4*)(kn + c * 8); const u32x4 qv = *(const LAS u32x4*)(qs + c * 16);
                dot += lo_bf(kv.x) * lo_bf(qv.x) + hi_bf(kv.x) * hi_bf(qv.x) + lo_bf(kv.y) * lo_bf(qv.y) + hi_bf(kv.y) * hi_bf(qv.y)
                     + lo_bf(kv.z) * lo_bf(qv.z) + hi_bf(kv.z) * hi_bf(qv.z) + lo_bf(kv.w) * lo_bf(qv.w) + hi_bf(kv.w) * hi_bf(qv.w); }
#pragma unroll 4
            for (int c = 0; c < 8; ++c) { const u32x4 kv = *(const u32x4*)(kro + c * 8); const u32x4 qv = *(const LAS u32x4*)(qs + 256 + c * 16);
                dot += lo_bf(kv.x) * lo_bf(qv.x) + hi_bf(kv.x) * hi_bf(qv.x) + lo_bf(kv.y) * lo_bf(qv.y) + hi_bf(kv.y) * hi_bf(qv.y)
                     + lo_bf(kv.z) * lo_bf(qv.z) + hi_bf(kv.z) * hi_bf(qv.z) + lo_bf(kv.w) * lo_bf(qv.w) + hi_bf(kv.w) * hi_bf(qv.w); }
            const float mnew = fmaxf(mrun, dot), alpha = EX2(mrun - mnew), p = EX2(dot - mnew);
            lrun = lrun * alpha + p; mrun = mnew;
            const bf16_t* vrow = KV + kr * 2048 + 1024 + h * 128;
#pragma unroll
            for (int c = 0; c < 16; ++c) { const u32x4 vv = *(const u32x4*)(vrow + c * 8);
                o[c * 8 + 0] = o[c * 8 + 0] * alpha + p * lo_bf(vv.x); o[c * 8 + 1] = o[c * 8 + 1] * alpha + p * hi_bf(vv.x);
                o[c * 8 + 2] = o[c * 8 + 2] * alpha + p * lo_bf(vv.y); o[c * 8 + 3] = o[c * 8 + 3] * alpha + p * hi_bf(vv.y);
                o[c * 8 + 4] = o[c * 8 + 4] * alpha + p * lo_bf(vv.z); o[c * 8 + 5] = o[c * 8 + 5] * alpha + p * hi_bf(vv.z);
                o[c * 8 + 6] = o[c * 8 + 6] * alpha + p * lo_bf(vv.w); o[c * 8 + 7] = o[c * 8 + 7] * alpha + p * hi_bf(vv.w); }
        }
        const float mall = wave_max(mrun), fsc = EX2(mrun - mall);
        const float lall = wave_sum(lrun * fsc);
#pragma unroll
        for (int e = 0; e < 128; ++e) o[e] *= fsc;
        RS_STEP(o, 128, 32); RS_STEP(o, 64, 16); RS_STEP(o, 32, 8); RS_STEP(o, 16, 4); RS_STEP(o, 8, 2); RS_STEP(o, 4, 1);
        const float inv = 1.f / lall;
        *(unsigned*)(QN + m * 1024 + h * 128 + 2 * C.lane) = pk2(o[0] * inv, o[1] * inv);
    }
}

__device__ __forceinline__ void phase_conv(Ctx& C, int l, const bf16_t* XA, bf16_t* U) {
    const float* cw = INP(8) + l * 4 * 1024; const float* cb = INP(9) + l * 1024;
    const int gt = C.bid * NTHR + C.tid, ngt = C.G * NTHR;
    for (int it = gt; it < MR * 128; it += ngt) {
        const int m = it >> 7, c0 = (it & 127) * 8, b = m / SS, s = m - b * SS;
        const int lo = (s < LC) ? 0 : LC, hi = (s < LC) ? LC : SS;
        float a[8];
#pragma unroll
        for (int e = 0; e < 8; ++e) a[e] = cb[c0 + e];
#pragma unroll
        for (int j = 0; j < 4; ++j) { const int sj = s + j - 2;
            if (sj >= lo && sj < hi) { const u32x4 xv = *(const u32x4*)(XA + (size_t)(b * SS + sj) * 1024 + c0); const float* w = cw + j * 1024 + c0;
                a[0] += w[0] * lo_bf(xv.x); a[1] += w[1] * hi_bf(xv.x); a[2] += w[2] * lo_bf(xv.y); a[3] += w[3] * hi_bf(xv.y);
                a[4] += w[4] * lo_bf(xv.z); a[5] += w[5] * hi_bf(xv.z); a[6] += w[6] * lo_bf(xv.w); a[7] += w[7] * hi_bf(xv.w); } }
        u32x4 o; o.x = pk2(a[0], a[1]); o.y = pk2(a[2], a[3]); o.z = pk2(a[4], a[5]); o.w = pk2(a[6], a[7]);
        *(u32x4*)(U + (size_t)m * 1024 + c0) = o;
    }
}
typedef f16_t f16x2 __attribute__((ext_vector_type(2)));
__device__ __forceinline__ void phase_scan1(Ctx& C, int d, const f16_t* RI, float* SUM) {
    for (int un = C.gw; un < NB * 68 * 8; un += C.ngw) {
        const int cg_ = un & 7, sg = (un >> 3) % 68, b = (un >> 3) / 68, ch = cg_ * 128 + 2 * C.lane;
        float A0 = 1.f, A1 = 1.f, H0 = 0.f, H1 = 0.f;
        const f16_t* base = RI + (size_t)(b * SS + sg * 64) * 2048 + ch;
#pragma unroll 16
        for (int i = 0; i < 64; ++i) { const int r = d ? (63 - i) : i;
            const f16x2 la = *(const f16x2*)(base + (size_t)r * 2048), bc = *(const f16x2*)(base + (size_t)r * 2048 + 1024);
            const float a0 = EX2((float)la[0]), a1 = EX2((float)la[1]);
            H0 = a0 * H0 + (float)bc[0]; H1 = a1 * H1 + (float)bc[1]; A0 *= a0; A1 *= a1; }
        float* sp = SUM + ((size_t)(b * 68 + sg) * 1024 + ch) * 2;
        *(f32x4*)sp = (f32x4){A0, H0, A1, H1};
    }
}
__device__ __forceinline__ void phase_scan3(Ctx& C, int d, const f16_t* RI, const float* SUM, bf16_t* YA) {
    for (int un = C.gw; un < NB * 68 * 8; un += C.ngw) {
        const int cg_ = un & 7, sg = (un >> 3) % 68, b = (un >> 3) / 68, ch = cg_ * 128 + 2 * C.lane;
        float H0 = 0.f, H1 = 0.f;
        const int npre = d ? ((sg < 4) ? (3 - sg) : (71 - sg)) : sg;
#pragma unroll 4
        for (int p = 0; p < npre; ++p) { const int ps = d ? ((p < 4) ? (3 - p) : (71 - p)) : p;
            const f32x4 v = *(const f32x4*)(SUM + ((size_t)(b * 68 + ps) * 1024 + ch) * 2);
            H0 = v[0] * H0 + v[1]; H1 = v[2] * H1 + v[3]; }
        const f16_t* base = RI + (size_t)(b * SS + sg * 64) * 2048 + ch;
        bf16_t* yb = YA + (size_t)(b * SS + sg * 64) * 1024 + ch;
#pragma unroll 16
        for (int i = 0; i < 64; ++i) { const int r = d ? (63 - i) : i;
            const f16x2 la = *(const f16x2*)(base + (size_t)r * 2048), bc = *(const f16x2*)(base + (size_t)r * 2048 + 1024);
            const float a0 = EX2((float)la[0]), a1 = EX2((float)la[1]);
            H0 = a0 * H0 + (float)bc[0]; H1 = a1 * H1 + (float)bc[1];
            unsigned* yp = (unsigned*)(yb + (size_t)r * 1024);
            if (d == 0) *yp = pk2(H0, H1); else { const unsigned w = *yp; *yp = pk2(lo_bf(w) + H0, hi_bf(w) + H1); } }
    }
}

typedef float f32x16 __attribute__((ext_vector_type(16)));
typedef short v4i16_t __attribute__((ext_vector_type(4)));
constexpr int AT_KP = 400, AT_VP = 320;
constexpr int AT_KB = 64 * AT_KP, AT_VB = 64 * AT_VP, AT_STG = AT_KB + AT_VB, AT_WSF = 2 * AT_STG;
__device__ __forceinline__ int crow(int r, int hi) { return (r & 3) + 8 * (r >> 2) + 4 * hi; }
__device__ __forceinline__ bf16x8 pack8(float a, float b, float c, float d, float e, float f, float g, float h) {
    u32x4 w; w.x = pg8::cvt_pk_bf16(a, b); w.y = pg8::cvt_pk_bf16(c, d); w.z = pg8::cvt_pk_bf16(e, f); w.w = pg8::cvt_pk_bf16(g, h); return __builtin_bit_cast(bf16x8, w); }
__device__ __forceinline__ bf16x8 tr2(LAS unsigned char* p0, LAS unsigned char* p1) {
    const v4i16_t lo = __builtin_amdgcn_ds_read_tr16_b64_v4i16((LAS v4i16_t*)p0), hi = __builtin_amdgcn_ds_read_tr16_b64_v4i16((LAS v4i16_t*)p1);
    return (bf16x8){lo[0], lo[1], lo[2], lo[3], hi[0], hi[1], hi[2], hi[3]}; }

__device__ __forceinline__ void phase_attn(Ctx& C, bool with_ctx, bf16_t* QN, const bf16_t* QP, const bf16_t* KV, const bf16_t* MD) {
    const int lane = C.lane, r32 = lane & 31, hi = lane >> 5, wave = C.wave, tid = C.tid;
    LAS unsigned char* lds = C.lds;
    LAS float* wsf = (LAS float*)(lds + AT_WSF + wave * 128);
    const int nunits = 512 + (with_ctx ? 32 : 0);
    const int rowA = tid >> 4, ccA = tid & 15, rowR = tid >> 3, ccR = tid & 7;
    const int i16 = lane & 15, q4 = i16 >> 2, p4 = i16 & 3, g1 = (lane >> 4) & 1;
    const int vb = AT_KB + (4 * hi + q4) * AT_VP + (16 * g1 + 4 * p4) * 2;
    for (int un = C.bid; un < nunits; un += C.G) {
        int bh, qb, isctx;
        if (un < 512) { const int x = un & 7, jj = un >> 3; bh = x * 4 + (jj >> 4); qb = jj & 15; isctx = 0; } else { bh = un - 512; qb = 0; isctx = 1; }
        const int b = bh >> 3, h = bh & 7;
        const size_t kb0 = (size_t)b * SS;
        const size_t m0 = kb0 + (isctx ? 0 : LC + qb * 256) + wave * 32;
        const int NT = (isctx ? LC : SS) / 64;
        bf16x8 qf[12];
        {   const bf16_t* qn = QN + (m0 + r32) * 1024 + h * 128 + hi * 8; const bf16_t* qp = QP + (m0 + r32) * 512 + h * 64 + hi * 8;
#pragma unroll
            for (int s = 0; s < 8; ++s) qf[s] = *(const bf16x8*)(qn + s * 16);
#pragma unroll
            for (int s = 0; s < 4; ++s) qf[8 + s] = *(const bf16x8*)(qp + s * 16); }
        f32x16 o[4];
#pragma unroll
        for (int d = 0; d < 4; ++d)
#pragma unroll
            for (int r = 0; r < 16; ++r) o[d][r] = 0.f;
        float mrun = -1e30f, lrun = 0.f;
        u32x4 kn0, kn1, kr0, vv0, vv1;
        const unsigned kvo = (unsigned)(((kb0 + rowA) * 2048 + h * 128 + ccA * 8) * 2);
        const unsigned kro = (unsigned)(((kb0 + rowR) * 768 + 640 + ccR * 8) * 2);
#define AT_LOAD(t) do { const char* kp_ = (const char*)KV + (size_t)(t) * (64 * 2048 * 2); kn0 = *(const u32x4*)(kp_ + kvo); kn1 = *(const u32x4*)(kp_ + 32 * 2048 * 2 + kvo); vv0 = *(const u32x4*)(kp_ + 1024 * 2 + kvo); vv1 = *(const u32x4*)(kp_ + (32 * 2048 + 1024) * 2 + kvo); \
        kr0 = *(const u32x4*)((const char*)MD + (size_t)(t) * (64 * 768 * 2) + kro); } while (0)
#define AT_WRITE(sb) do { LAS unsigned char* s_ = lds + (sb); *(LAS u32x4*)(s_ + rowA * AT_KP + ccA * 16) = kn0; *(LAS u32x4*)(s_ + (rowA + 32) * AT_KP + ccA * 16) = kn1; \
        *(LAS u32x4*)(s_ + rowR * AT_KP + 256 + ccR * 16) = kr0; *(LAS u32x4*)(s_ + AT_KB + rowA * AT_VP + ccA * 16) = vv0; *(LAS u32x4*)(s_ + AT_KB + (rowA + 32) * AT_VP + ccA * 16) = vv1; } while (0)
#define AT_QK(sbv) do { _Pragma("unroll") for (int r = 0; r < 16; ++r) { p0[r] = 0.f; p1[r] = 0.f; } \
        LAS unsigned char* ka = lds + (sbv) + r32 * AT_KP + hi * 16; __builtin_amdgcn_s_setprio(1); \
        _Pragma("unroll") for (int s = 0; s < 12; ++s) { const bf16x8 a0 = *(const LAS bf16x8*)(ka + s * 32), a1 = *(const LAS bf16x8*)(ka + 32 * AT_KP + s * 32); \
            p0 = __builtin_amdgcn_mfma_f32_32x32x16_bf16(a0, qf[s], p0, 0, 0, 0); p1 = __builtin_amdgcn_mfma_f32_32x32x16_bf16(a1, qf[s], p1, 0, 0, 0); \
            if ((s & 3) == 3) asm volatile("" ::: "memory"); } \
        __builtin_amdgcn_s_setprio(0); } while (0)
#define AT_SM() do { float rm = fmaxf(p0[0], p1[0]); \
        _Pragma("unroll") for (int r = 1; r < 16; ++r) rm = fmaxf(rm, fmaxf(p0[r], p1[r])); \
        rm = fmaxf(rm, __shfl_xor(rm, 32)); \
        if (__any(rm > mrun + 8.f)) { const float mnew = fmaxf(mrun, rm), alpha = EX2(mrun - mnew); mrun = mnew; lrun *= alpha; \
            if (hi == 0) wsf[r32] = alpha; \
            _Pragma("unroll") for (int r = 0; r < 16; ++r) { const float a = wsf[crow(r, hi)]; _Pragma("unroll") for (int d = 0; d < 4; ++d) o[d][r] *= a; } } \
        float ls = 0.f; \
        _Pragma("unroll") for (int r = 0; r < 16; ++r) { p0[r] = EX2(p0[r] - mrun); p1[r] = EX2(p1[r] - mrun); ls += p0[r] + p1[r]; } \
        lrun += ls; \
        pa0 = pack8(p0[0], p0[1], p0[2], p0[3], p0[4], p0[5], p0[6], p0[7]); pa1 = pack8(p0[8], p0[9], p0[10], p0[11], p0[12], p0[13], p0[14], p0[15]); \
        pa2 = pack8(p1[0], p1[1], p1[2], p1[3], p1[4], p1[5], p1[6], p1[7]); pa3 = pack8(p1[8], p1[9], p1[10], p1[11], p1[12], p1[13], p1[14], p1[15]); } while (0)
#define AT_PV(sbv) do { LAS unsigned char* vp = lds + (sbv) + vb; __builtin_amdgcn_s_setprio(1); \
        _Pragma("unroll") for (int d = 0; d < 4; ++d) { \
            o[d] = __builtin_amdgcn_mfma_f32_32x32x16_bf16(pa0, tr2(vp + d * 64, vp + d * 64 + 8 * AT_VP), o[d], 0, 0, 0); \
            o[d] = __builtin_amdgcn_mfma_f32_32x32x16_bf16(pa1, tr2(vp + d * 64 + 16 * AT_VP, vp + d * 64 + 24 * AT_VP), o[d], 0, 0, 0); \
            o[d] = __builtin_amdgcn_mfma_f32_32x32x16_bf16(pa2, tr2(vp + d * 64 + 32 * AT_VP, vp + d * 64 + 40 * AT_VP), o[d], 0, 0, 0); \
            o[d] = __builtin_amdgcn_mfma_f32_32x32x16_bf16(pa3, tr2(vp + d * 64 + 48 * AT_VP, vp + d * 64 + 56 * AT_VP), o[d], 0, 0, 0); \
            asm volatile("" ::: "memory"); } \
        __builtin_amdgcn_s_setprio(0); } while (0)
        AT_LOAD(0); AT_WRITE(0);
        __syncthreads();
        bf16x8 pa0, pa1, pa2, pa3;
        if (wave < 4) {
            for (int t = 0; t < NT; ++t) {
                const int sb = (t & 1) * AT_STG;
                if (t + 1 < NT) AT_LOAD(t + 1);
                f32x16 p0, p1;
                AT_QK(sb);
                __syncthreads();
                if (t + 1 < NT) AT_WRITE(AT_STG - sb);
                AT_SM(); AT_PV(sb);
                __syncthreads();
            }
            __syncthreads(); __syncthreads();
        } else {
            for (int t = 0; t <= NT; ++t) {
                const int sb = (t & 1) * AT_STG;
                if (t + 1 < NT) AT_LOAD(t + 1);
                if (t > 0) AT_PV(AT_STG - sb);
                __syncthreads();
                if (t + 1 < NT) AT_WRITE(AT_STG - sb);
                if (t < NT) { f32x16 p0, p1; AT_QK(sb); AT_SM(); }
                __syncthreads();
            }
        }
#undef AT_QK
#undef AT_SM
#undef AT_PV
#undef AT_LOAD
#undef AT_WRITE
        const float ltot = lrun + __shfl_xor(lrun, 32);
        if (hi == 0) wsf[r32] = 1.f / ltot;
        bf16_t* op = QN + (m0 + 4 * hi) * 1024 + h * 128 + r32;
#pragma unroll
        for (int r = 0; r < 16; ++r) { const float inv = wsf[crow(r, hi)];
#pragma unroll
            for (int d = 0; d < 4; ++d) op[d * 32] = (bf16_t)f2bf(o[d][r] * inv);
            op += ((r & 3) == 3) ? 5 * 1024 : 1024; asm volatile("" : "+v"(op)); }
        __syncthreads();
    }
}

constexpr int RI_KP = 528, RI_VP = 576, RI_PTP = 272;
constexpr int RI_A = 0, RI_PT = 128 * RI_VP;
__device__ __forceinline__ void phase_ret_intra(Ctx& C, int l, const bf16_t* RQKV, bf16_t* OI) {
    const int lane = C.lane, r32 = lane & 31, hi = lane >> 5, wave = C.wave, tid = C.tid;
    LAS unsigned char* lds = C.lds;
    const int i16 = lane & 15, q4 = i16 >> 2, p4 = i16 & 3, g1 = (lane >> 4) & 1;
    const int nb = wave & 3, wh = wave >> 2;
    const int srow = tid >> 5, scc = tid & 31;
    for (int un = C.bid; un < NB * 4 * 34; un += C.G) {
        const int c = un % 34, bh = un / 34, b = bh >> 2, h = bh & 3;
        const size_t row0 = (size_t)b * SS + c * 128;
        const float lgf = C.ctl[CT_LG + (l * 2 + 0) * 4 + h], lgb = C.ctl[CT_LG + (l * 2 + 1) * 4 + h];
        const bf16_t* gk = RQKV + (row0 + srow) * 3072 + 1024 + h * 256 + scc * 8;
        u32x4 st[8];
        {   const bf16_t* gp = gk;
#pragma unroll
            for (int j = 0; j < 8; ++j) { st[j] = *(const u32x4*)gp; gp += 16 * 3072; asm volatile("" : "+v"(gp)); } }
#pragma unroll
        for (int j = 0; j < 8; ++j) *(LAS u32x4*)(lds + RI_A + (srow + 16 * j) * RI_KP + scc * 16) = st[j];
        __syncthreads();
        {   const bf16_t* gp = gk + 1024;
#pragma unroll
            for (int j = 0; j < 8; ++j) { st[j] = *(const u32x4*)gp; gp += 16 * 3072; asm volatile("" : "+v"(gp)); } }
        {
            f32x16 x0, x1;
#pragma unroll
            for (int r = 0; r < 16; ++r) { x0[r] = 0.f; x1[r] = 0.f; }
            const bf16_t* gq = RQKV + (row0 + nb * 32 + r32) * 3072 + h * 256 + hi * 8;
            LAS unsigned char* ka = lds + RI_A + (wh * 64 + r32) * RI_KP + hi * 16;
#pragma unroll
            for (int s = 0; s < 16; ++s) { const bf16x8 qf = *(const bf16x8*)(gq + s * 16);
                const bf16x8 a0 = *(const LAS bf16x8*)(ka + s * 32), a1 = *(const LAS bf16x8*)(ka + 32 * RI_KP + s * 32);
                x0 = __builtin_amdgcn_mfma_f32_32x32x16_bf16(a0, qf, x0, 0, 0, 0); x1 = __builtin_amdgcn_mfma_f32_32x32x16_bf16(a1, qf, x1, 0, 0, 0);
                if ((s & 3) == 3) asm volatile("" ::: "memory"); }
            const int n = nb * 32 + r32;
            LAS unsigned char* pt = lds + RI_PT + n * RI_PTP + (wh * 64 + 4 * hi) * 2;
#pragma unroll
            for (int g = 0; g < 4; ++g) { float w0[4], w1[4];
#pragma unroll
                for (int e = 0; e < 4; ++e) { const int m0 = wh * 64 + 8 * g + 4 * hi + e; const float d0 = (float)(n - m0), d1 = d0 - 32.f;
                    const float f0 = EX2(lgf * fmaxf(d0, 0.f)) * fminf(fmaxf(d0 + 1.f, 0.f), 1.f) + EX2(lgb * fmaxf(-d0, 0.f)) * fminf(fmaxf(1.f - d0, 0.f), 1.f);
                    const float f1 = EX2(lgf * fmaxf(d1, 0.f)) * fminf(fmaxf(d1 + 1.f, 0.f), 1.f) + EX2(lgb * fmaxf(-d1, 0.f)) * fminf(fmaxf(1.f - d1, 0.f), 1.f);
                    w0[e] = x0[4 * g + e] * f0; w1[e] = x1[4 * g + e] * f1; }
                u32x2 o0, o1; o0.x = pg8::cvt_pk_bf16(w0[0], w0[1]); o0.y = pg8::cvt_pk_bf16(w0[2], w0[3]); o1.x = pg8::cvt_pk_bf16(w1[0], w1[1]); o1.y = pg8::cvt_pk_bf16(w1[2], w1[3]);
                *(LAS u32x2*)(pt + g * 16) = o0; *(LAS u32x2*)(pt + 64 + g * 16) = o1; }
        }
        __syncthreads();
#pragma unroll
        for (int j = 0; j < 8; ++j) *(LAS u32x4*)(lds + RI_A + (srow + 16 * j) * RI_VP + scc * 16) = st[j];
        __syncthreads();
        {
            f32x16 o[4];
#pragma unroll
            for (int d = 0; d < 4; ++d)
#pragma unroll
                for (int r = 0; r < 16; ++r) o[d][r] = 0.f;
            bf16x8 pa[8];
            LAS unsigned char* pr = lds + RI_PT + (nb * 32 + r32) * RI_PTP + hi * 16;
#pragma unroll
            for (int s = 0; s < 8; ++s) pa[s] = *(const LAS bf16x8*)(pr + s * 32);
            LAS unsigned char* vp = lds + RI_A + (8 * hi + q4) * RI_VP + (wh * 128 + 16 * g1 + 4 * p4) * 2;
#pragma unroll
            for (int d = 0; d < 4; ++d) {
#pragma unroll
                for (int s = 0; s < 8; ++s) o[d] = __builtin_amdgcn_mfma_f32_32x32x16_bf16(pa[s], tr2(vp + d * 64 + s * 16 * RI_VP, vp + d * 64 + (s * 16 + 4) * RI_VP), o[d], 0, 0, 0);
                asm volatile("" ::: "memory"); }
            bf16_t* op = OI + (row0 + nb * 32 + 4 * hi) * 1024 + h * 256 + wh * 128 + r32;
#pragma unroll
            for (int r = 0; r < 16; ++r) {
#pragma unroll
                for (int d = 0; d < 4; ++d) op[d * 32] = (bf16_t)f2bf(o[d][r]);
                op += ((r & 3) == 3) ? 5 * 1024 : 1024; asm volatile("" : "+v"(op)); }
        }
        __syncthreads();
    }
}

constexpr int RC_KT = 0, RC_KTP = 576, RC_VT = 128 * 576, RC_VTP = 64, RC_ST = RC_VT + 128 * 64, RC_STP = 528, RC_XO = RC_ST + 32 * 528, RC_END = RC_XO + 16384;
static_assert(RC_END <= 131072, "R-chain LDS");
__device__ __forceinline__ void phase_ret_chain(Ctx& C, int l, const bf16_t* RQKV, bf16_t* OI, bf16_t* OB) {
    const int lane = C.lane, r32 = lane & 31, hi = lane >> 5, wave = C.wave, tid = C.tid;
    LAS unsigned char* lds = C.lds;
    const int i16 = lane & 15, q4 = i16 >> 2, p4 = i16 & 3, g1 = (lane >> 4) & 1;
    const int nb = wave & 3, dh = wave >> 2;
    const int srow = tid >> 5, scc = tid & 31, vrow = tid >> 2, vcc = tid & 3;
    for (int un = C.bid; un < 256; un += C.G) {
        const int x = un & 7, j8 = un >> 3, bhd = x * 4 + (j8 >> 3), sl = j8 & 7, b = bhd >> 3, h = (bhd >> 1) & 3, dir = bhd & 1;
        const float lg = C.ctl[CT_LG + (l * 2 + dir) * 4 + h];
        const float cdec = EX2(lg * 128.f);
        const float vdec = dir ? EX2(lg * (float)vrow) : EX2(lg * (float)(127 - vrow));
        f32x16 sacc;
#pragma unroll
        for (int r = 0; r < 16; ++r) sacc[r] = 0.f;
        for (int i = tid; i < 32 * RC_STP / 16; i += NTHR) *(LAS u32x4*)(lds + RC_ST + i * 16) = (u32x4){0u, 0u, 0u, 0u};
        u32x4 st[8]; u32x4 sv;
#define RC_LOAD(cc_) do { const size_t r0_ = (size_t)b * SS + (cc_) * 128; const bf16_t* gk_ = RQKV + (r0_ + srow) * 3072 + 1024 + h * 256 + scc * 8; \
        _Pragma("unroll") for (int j = 0; j < 8; ++j) { st[j] = *(const u32x4*)gk_; gk_ += 16 * 3072; asm volatile("" : "+v"(gk_)); } \
        sv = *(const u32x4*)(RQKV + (r0_ + vrow) * 3072 + 2048 + h * 256 + sl * 32 + vcc * 8); } while (0)
#define RC_WRITE() do { _Pragma("unroll") for (int j = 0; j < 8; ++j) *(LAS u32x4*)(lds + RC_KT + (srow + 16 * j) * RC_KTP + scc * 16) = st[j]; \
        u32x4 w_; w_.x = pg8::cvt_pk_bf16(lo_bf(sv.x) * vdec, hi_bf(sv.x) * vdec); w_.y = pg8::cvt_pk_bf16(lo_bf(sv.y) * vdec, hi_bf(sv.y) * vdec); \
        w_.z = pg8::cvt_pk_bf16(lo_bf(sv.z) * vdec, hi_bf(sv.z) * vdec); w_.w = pg8::cvt_pk_bf16(lo_bf(sv.w) * vdec, hi_bf(sv.w) * vdec); \
        *(LAS u32x4*)(lds + RC_VT + vrow * RC_VTP + vcc * 16) = w_; } while (0)
        bf16x8 qa[8];
#define RC_QLOAD(dst, cc_) do { const bf16_t* gq_ = RQKV + ((size_t)b * SS + (cc_) * 128 + nb * 32 + r32) * 3072 + h * 256 + dh * 128 + hi * 8; \
        _Pragma("unroll") for (int s = 0; s < 8; ++s) dst[s] = *(const bf16x8*)(gq_ + s * 16); } while (0)
        {   const int c0 = dir ? 1 : 0, c1 = dir ? 0 : 1; RC_LOAD(c0); RC_WRITE(); RC_QLOAD(qa, c0); RC_LOAD(c1); }
        __syncthreads();
        for (int i = 0; i < 34; ++i) {
            const int c = dir ? ((i < 2) ? (1 - i) : (35 - i)) : i;
            const size_t r0 = (size_t)b * SS + c * 128;
            const int cn = (i + 1 < 34) ? (dir ? ((i + 1 < 2) ? (1 - (i + 1)) : (35 - (i + 1))) : (i + 1)) : c;
            unsigned short oiv[16];
            if (dh == 0 && dir == 0) { const bf16_t* ip = OI + (r0 + nb * 32 + 4 * hi) * 1024 + h * 256 + sl * 32 + r32;
#pragma unroll
                for (int r = 0; r < 16; ++r) oiv[r] = ip[(size_t)((r & 3) + 8 * (r >> 2)) * 1024]; }
            f32x16 oacc;
#pragma unroll
            for (int r = 0; r < 16; ++r) oacc[r] = 0.f;
            {   LAS unsigned char* sb = lds + RC_ST + r32 * RC_STP + (dh * 128 + hi * 8) * 2;
#pragma unroll
                for (int s = 0; s < 8; ++s) { const bf16x8 sbf = *(const LAS bf16x8*)(sb + s * 32);
                    oacc = __builtin_amdgcn_mfma_f32_32x32x16_bf16(qa[s], sbf, oacc, 0, 0, 0); } }
            asm volatile("" ::: "memory");
            RC_QLOAD(qa, cn);
#pragma unroll
            for (int r = 0; r < 16; ++r) sacc[r] *= cdec;
            {   LAS unsigned char* kp = lds + RC_KT + (8 * hi + q4) * RC_KTP + (wave * 32 + 16 * g1 + 4 * p4) * 2;
                LAS unsigned char* vp = lds + RC_VT + (8 * hi + q4) * RC_VTP + (16 * g1 + 4 * p4) * 2;
#pragma unroll
                for (int s = 0; s < 8; ++s) sacc = __builtin_amdgcn_mfma_f32_32x32x16_bf16(tr2(kp + s * 16 * RC_KTP, kp + (s * 16 + 4) * RC_KTP), tr2(vp + s * 16 * RC_VTP, vp + (s * 16 + 4) * RC_VTP), sacc, 0, 0, 0); }
            if (dh == 1) {
#pragma unroll
                for (int r = 0; r < 16; ++r) *(LAS float*)(lds + RC_XO + nb * 4096 + r * 256 + lane * 4) = oacc[r]; }
            __syncthreads();
            if (dh == 0) {
                bf16_t* op = (dir ? OB : OI) + (r0 + nb * 32 + 4 * hi) * 1024 + h * 256 + sl * 32 + r32;
#pragma unroll
                for (int r = 0; r < 16; ++r) { const int n = nb * 32 + crow(r, hi);
                    const float qd = dir ? EX2(lg * (float)(128 - n)) : EX2(lg * (float)(n + 1));
                    float v = (oacc[r] + *(const LAS float*)(lds + RC_XO + nb * 4096 + r * 256 + lane * 4)) * qd;
                    if (dir == 0) v += bf2f(oiv[r]);
                    *op = (bf16_t)f2bf(v);
                    op += ((r & 3) == 3) ? 5 * 1024 : 1024; asm volatile("" : "+v"(op)); }
            }
            {   LAS unsigned char* sp = lds + RC_ST + r32 * RC_STP + (wave * 32 + 4 * hi) * 2;
#pragma unroll
                for (int g = 0; g < 4; ++g) { u32x2 o2; o2.x = pg8::cvt_pk_bf16(sacc[4 * g], sacc[4 * g + 1]); o2.y = pg8::cvt_pk_bf16(sacc[4 * g + 2], sacc[4 * g + 3]); *(LAS u32x2*)(sp + g * 16) = o2; } }
            if (i + 1 < 34) RC_WRITE();
            if (i + 2 < 34) { const int c2 = dir ? ((i + 2 < 2) ? (1 - (i + 2)) : (35 - (i + 2))) : (i + 2); RC_LOAD(c2); }
            __syncthreads();
        }
#undef RC_QLOAD
#undef RC_LOAD
#undef RC_WRITE
    }
}
__device__ __forceinline__ void phase_ret_ln2(Ctx& C, int l, bf16_t* OI, const bf16_t* OB) {
    const float* gain = INP(16) + l * 1024;
    for (int m = C.gw; m < MR; m += C.ngw) {
#pragma unroll
        for (int h = 0; h < 4; ++h) { bf16_t* p = OI + (size_t)m * 1024 + h * 256 + C.lane * 4;
            const u32x2 w = *(const u32x2*)p, w2 = *(const u32x2*)(OB + (size_t)m * 1024 + h * 256 + C.lane * 4);
            float x0 = lo_bf(w.x) + lo_bf(w2.x), x1 = hi_bf(w.x) + hi_bf(w2.x), x2 = lo_bf(w.y) + lo_bf(w2.y), x3 = hi_bf(w.y) + hi_bf(w2.y);
            const float mean = wave_sum((x0 + x1) + (x2 + x3)) * (1.f / 256.f);
            x0 -= mean; x1 -= mean; x2 -= mean; x3 -= mean;
            const float var = wave_sum((x0 * x0 + x1 * x1) + (x2 * x2 + x3 * x3)) * (1.f / 256.f);
            const float rstd = RSQ(var + EPS);
            const f32x4 g = *(const f32x4*)(gain + h * 256 + C.lane * 4);
            u32x2 o; o.x = pk2(x0 * rstd * g.x, x1 * rstd * g.y); o.y = pk2(x2 * rstd * g.z, x3 * rstd * g.w); *(u32x2*)p = o; }
    }
}

template <int W> __device__ __forceinline__ float group_sum(float v) {
#pragma unroll
    for (int o = 1; o < W; o <<= 1) v += __shfl_xor(v, o);
    return v;
}
__device__ __forceinline__ void unpack8(const u32x4& w, float (&x)[8]) { x[0] = lo_bf(w.x); x[1] = hi_bf(w.x); x[2] = lo_bf(w.y); x[3] = hi_bf(w.y); x[4] = lo_bf(w.z); x[5] = hi_bf(w.z); x[6] = lo_bf(w.w); x[7] = hi_bf(w.w); }
__device__ __forceinline__ u32x4 pack8u(const float (&x)[8]) { u32x4 w; w.x = pk2(x[0], x[1]); w.y = pk2(x[2], x[3]); w.z = pk2(x[4], x[5]); w.w = pk2(x[6], x[7]); return w; }
__device__ __forceinline__ float sumsq8(const float (&x)[8]) { return ((x[0] * x[0] + x[1] * x[1]) + (x[2] * x[2] + x[3] * x[3])) + ((x[4] * x[4] + x[5] * x[5]) + (x[6] * x[6] + x[7] * x[7])); }

__device__ __forceinline__ void phase_h2(Ctx& C, int l, bf16_t* H) {
    const float* gain = INP(6) + l * 1024;
    for (int m0 = C.gw * 2; m0 < MR; m0 += C.ngw * 2) {
        f32x4 v[2][4]; float ss[2];
#pragma unroll
        for (int q = 0; q < 2; ++q) { const float* xr = resid_row(C, l, m0 + q);
#pragma unroll
            for (int j = 0; j < 4; ++j) v[q][j] = *(const f32x4*)(xr + 4 * C.lane + 256 * j); }
        const int b = m0 / SS, s = m0 - b * SS, r = (s < LC) ? 4 : b;
        const float* mod = C.ctl + CT_MOD + (l * 5 + r) * 3072;
#pragma unroll
        for (int q = 0; q < 2; ++q) { float a = 0.f;
#pragma unroll
            for (int j = 0; j < 4; ++j) a += (v[q][j].x * v[q][j].x + v[q][j].y * v[q][j].y) + (v[q][j].z * v[q][j].z + v[q][j].w * v[q][j].w);
            ss[q] = a; }
        ss[0] = wave_sum(ss[0]); ss[1] = wave_sum(ss[1]);
#pragma unroll
        for (int j = 0; j < 4; ++j) { const int c = 4 * C.lane + 256 * j;
            const f32x4 g = *(const f32x4*)(gain + c), sh = *(const f32x4*)(mod + c), sc = *(const f32x4*)(mod + 1024 + c) + 1.0f;
#pragma unroll
            for (int q = 0; q < 2; ++q) { const float rstd = RSQ(ss[q] * (1.f / 1024.f) + EPS);
                const f32x4 o = ((v[q][j] * rstd) * g) * sc + sh;
                u32x2 w; w.x = pk2(o.x, o.y); w.y = pk2(o.z, o.w);
                *(u32x2*)(H + (size_t)(m0 + q) * 1024 + c) = w; } }
    }
}
__device__ __forceinline__ void phase_md_post2(Ctx& C, int l, bf16_t* MD) {
    const float* qn = INP(17) + l * 384; const float* kvn = INP(19) + l * 256; const float* gkr = INP(24) + l * 64;
    const float* cs = C.ctl + CT_ROPEM; const float* sn = cs + 1024;
    const int L = C.lane;
    for (int m0 = C.gw * 2; m0 < MR; m0 += C.ngw * 2) {
        u32x4 w0[2], w1[2];
#pragma unroll
        for (int q = 0; q < 2; ++q) { const bf16_t* row = MD + (size_t)(m0 + q) * 768; w0[q] = *(const u32x4*)(row + 8 * L); w1[q] = (L < 32) ? *(const u32x4*)(row + 512 + 8 * L) : (u32x4){0u, 0u, 0u, 0u}; }
#pragma unroll
        for (int q = 0; q < 2; ++q) { const int m = m0 + q, b = m / SS, s = m - b * SS; const bool lat = s >= LC; const int t = s - LC;
            bf16_t* row = MD + (size_t)m * 768;
            float x0[8], x1[8]; unpack8(w0[q], x0); unpack8(w1[q], x1);
            const float s0 = sumsq8(x0), s1 = sumsq8(x1);
            const float sq = wave_sum(L < 48 ? s0 : 0.f), skv = wave_sum((L >= 48 ? s0 : 0.f) + (L < 16 ? s1 : 0.f)), skr = wave_sum((L >= 16 && L < 24) ? s1 : 0.f);
            const float rq = RSQ(sq * (1.f / 384.f) + EPS), rkv = RSQ(skv * (1.f / 256.f) + EPS), rkr = RSQ(skr * (1.f / 64.f) + EPS);
            {   const float* g = (L < 48) ? (qn + 8 * L) : (kvn + 8 * (L - 48)); const float rs = (L < 48) ? rq : rkv;
#pragma unroll
                for (int e = 0; e < 8; ++e) x0[e] *= rs * g[e];
                *(u32x4*)(row + 8 * L) = pack8u(x0); }
            if (L < 16) {
#pragma unroll
                for (int e = 0; e < 8; ++e) x1[e] *= rkv * kvn[128 + 8 * L + e];
            } else if (L < 24) {
#pragma unroll
                for (int e = 0; e < 8; ++e) x1[e] *= rkr * gkr[8 * (L - 16) + e];
            }
            float pr[8];
#pragma unroll
            for (int e = 0; e < 8; ++e) pr[e] = __shfl_xor(x1[e], 2);
            if (lat && L >= 16 && L < 24) { const int qt = (L - 16) >> 1, f0 = ((L - 16) & 1) * 8, pos = (qt < 2) ? (t >> 6) : (t & 63); const float sg = (qt & 1) ? 1.f : -1.f;
#pragma unroll
                for (int e = 0; e < 8; ++e) x1[e] = x1[e] * cs[pos * 16 + f0 + e] + sg * pr[e] * sn[pos * 16 + f0 + e]; }
            if (L < 24) *(u32x4*)(row + 512 + 8 * L) = pack8u(x1);
        }
    }
}
__device__ __forceinline__ void phase_qk_post2(Ctx& C, int l, bf16_t* QN, bf16_t* QP, bf16_t* KV) {
    const float* gqn = INP(21) + l * 128; const float* gqr = INP(22) + l * 64; const float* gkn = INP(23) + l * 128;
    const float* cs = C.ctl + CT_ROPEM; const float* sn = cs + 1024;
    const int L = C.lane;
    for (int m0 = C.gw * 2; m0 < MR; m0 += C.ngw * 2) {
        u32x4 a[2][2], k[2][2], p[2];
#pragma unroll
        for (int q = 0; q < 2; ++q) { const size_t m = m0 + q;
            a[q][0] = *(const u32x4*)(QN + m * 1024 + 8 * L); a[q][1] = *(const u32x4*)(QN + m * 1024 + 512 + 8 * L);
            k[q][0] = *(const u32x4*)(KV + m * 2048 + 8 * L); k[q][1] = *(const u32x4*)(KV + m * 2048 + 512 + 8 * L);
            p[q] = *(const u32x4*)(QP + m * 512 + 8 * L); }
#pragma unroll
        for (int q = 0; q < 2; ++q) { const int m = m0 + q, b = m / SS, s = m - b * SS; const bool lat = s >= LC; const int t = s - LC;
#pragma unroll
            for (int c = 0; c < 2; ++c) {
                float x[8]; unpack8(a[q][c], x);
                const float rs = RSQ(group_sum<16>(sumsq8(x)) * (1.f / 128.f) + EPS) * QSCALE;
#pragma unroll
                for (int e = 0; e < 8; ++e) x[e] *= rs * gqn[8 * (L & 15) + e];
                *(u32x4*)(QN + (size_t)m * 1024 + c * 512 + 8 * L) = pack8u(x);
                float y[8]; unpack8(k[q][c], y);
                const float rk = RSQ(group_sum<16>(sumsq8(y)) * (1.f / 128.f) + EPS);
#pragma unroll
                for (int e = 0; e < 8; ++e) y[e] *= rk * gkn[8 * (L & 15) + e];
                *(u32x4*)(KV + (size_t)m * 2048 + c * 512 + 8 * L) = pack8u(y); }
            {   float x[8]; unpack8(p[q], x);
                const float rs = RSQ(group_sum<8>(sumsq8(x)) * (1.f / 64.f) + EPS);
#pragma unroll
                for (int e = 0; e < 8; ++e) x[e] *= rs * gqr[8 * (L & 7) + e];
                float pr[8];
#pragma unroll
                for (int e = 0; e < 8; ++e) pr[e] = __shfl_xor(x[e], 2);
                if (lat) { const int qt = (L >> 1) & 3, f0 = (L & 1) * 8, pos = (qt < 2) ? (t >> 6) : (t & 63); const float sg = (qt & 1) ? 1.f : -1.f;
#pragma unroll
                    for (int e = 0; e < 8; ++e) x[e] = x[e] * cs[pos * 16 + f0 + e] + sg * pr[e] * sn[pos * 16 + f0 + e]; }
#pragma unroll
                for (int e = 0; e < 8; ++e) x[e] *= QSCALE;
                *(u32x4*)(QP + (size_t)m * 512 + 8 * L) = pack8u(x); }
        }
    }
}
__device__ __forceinline__ void phase_ret_ln3(Ctx& C, int l, bf16_t* OI, const bf16_t* OB) {
    const float* gain = INP(16) + l * 1024;
    const int L = C.lane;
    for (int m0 = C.gw * 2; m0 < MR; m0 += C.ngw * 2) {
        u32x4 a[2][2], bb[2][2];
#pragma unroll
        for (int q = 0; q < 2; ++q)
#pragma unroll
            for (int c = 0; c < 2; ++c) { a[q][c] = *(const u32x4*)(OI + (size_t)(m0 + q) * 1024 + c * 512 + 8 * L); bb[q][c] = *(const u32x4*)(OB + (size_t)(m0 + q) * 1024 + c * 512 + 8 * L); }
#pragma unroll
        for (int q = 0; q < 2; ++q)
#pragma unroll
            for (int c = 0; c < 2; ++c) { float x[8], y[8]; unpack8(a[q][c], x); unpack8(bb[q][c], y);
                float s = 0.f;
#pragma unroll
                for (int e = 0; e < 8; ++e) { x[e] += y[e]; s += x[e]; }
                const float mean = group_sum<32>(s) * (1.f / 256.f);
                float v = 0.f;
#pragma unroll
                for (int e = 0; e < 8; ++e) { x[e] -= mean; v += x[e] * x[e]; }
                const float rstd = RSQ(group_sum<32>(v) * (1.f / 256.f) + EPS);
#pragma unroll
                for (int e = 0; e < 8; ++e) x[e] *= rstd * gain[c * 512 + 8 * L + e];
                *(u32x4*)(OI + (size_t)(m0 + q) * 1024 + c * 512 + 8 * L) = pack8u(x); }
    }
}

__device__ __forceinline__ void phase_zsum(Ctx& C, const bf16_t* ZP, bf16_t* Z) {
    const int gt = C.bid * NTHR + C.tid, ngt = C.G * NTHR;
    for (int it = gt; it < 1024 * 128; it += ngt) { const int r = it >> 7, c0 = (it & 127) * 8, b = r >> 8, s = r & 255;
        const u32x4 a = *(const u32x4*)(ZP + (size_t)r * 1024 + c0), bq = *(const u32x4*)(ZP + (size_t)(1024 + r) * 1024 + c0), cq = *(const u32x4*)(ZP + (size_t)(2048 + r) * 1024 + c0);
        float x[8], y[8], z[8]; unpack8(a, x); unpack8(bq, y); unpack8(cq, z);
#pragma unroll
        for (int e = 0; e < 8; ++e) x[e] += y[e] + z[e];
        *(u32x4*)(Z + (size_t)(b * SS + s) * 1024 + c0) = pack8u(x); }
}

constexpr int LR_UP = 272;
constexpr int LR_U = 0, LR_LA = 128 * LR_UP, LR_BC = LR_LA + 32768, LR_Y0 = LR_BC + 32768, LR_XS = LR_Y0 + 32768, LR_END = LR_XS + 4096;
static_assert(LR_END <= 147456 - 1024, "fused LRU LDS");
__device__ __forceinline__ void phase_lru_fused(Ctx& C, int l, const bf16_t* XA, const bf16_t* WTL, bf16_t* Y0, f16_t* CAF, f16_t* CAB, float* SUM) {
    const int lane = C.lane, r32 = lane & 31, hi = lane >> 5, wave = C.wave, tid = C.tid;
    LAS unsigned char* lds = C.lds;
    const float* cw = INP(8) + l * 4 * 1024; const float* cb = INP(9) + l * 1024;
    const int rb = wave & 3, cgp = wave >> 2;
    for (int un = C.bid; un < NB * 8 * 34; un += C.G) {
        const int sg = un % 34, bn = un / 34, b = bn >> 3, n = bn & 7;
        const int R0 = b * SS + sg * 128, lo = (sg < 2) ? b * SS : b * SS + LC, hi_ = (sg < 2) ? b * SS + LC : (b + 1) * SS;
#pragma unroll
        for (int j = 0; j < 4; ++j) { const int item = tid + 512 * j, row = item >> 4, cc = item & 15, ch0 = n * 128 + cc * 8;
            float a[8];
            {   const f32x4 c0 = *(const f32x4*)(cb + ch0), c1 = *(const f32x4*)(cb + ch0 + 4); a[0] = c0[0]; a[1] = c0[1]; a[2] = c0[2]; a[3] = c0[3]; a[4] = c1[0]; a[5] = c1[1]; a[6] = c1[2]; a[7] = c1[3]; }
#pragma unroll
            for (int t = 0; t < 4; ++t) { const int rr = R0 + row + t - 2;
                const f32x4 wA = *(const f32x4*)(cw + t * 1024 + ch0), wB = *(const f32x4*)(cw + t * 1024 + ch0 + 4);
                if (rr >= lo && rr < hi_) { const u32x4 xv = *(const u32x4*)(XA + (size_t)rr * 1024 + ch0);
                    a[0] += wA[0] * lo_bf(xv.x); a[1] += wA[1] * hi_bf(xv.x); a[2] += wA[2] * lo_bf(xv.y); a[3] += wA[3] * hi_bf(xv.y);
                    a[4] += wB[0] * lo_bf(xv.z); a[5] += wB[1] * hi_bf(xv.z); a[6] += wB[2] * lo_bf(xv.w); a[7] += wB[3] * hi_bf(xv.w); } }
            *(LAS u32x4*)(lds + LR_U + row * LR_UP + cc * 16) = pack8u(a); }
        __syncthreads();
        bf16x8 af[8];
        {   LAS unsigned char* ua = lds + LR_U + (rb * 32 + r32) * LR_UP + hi * 16;
#pragma unroll
            for (int s = 0; s < 8; ++s) af[s] = *(const LAS bf16x8*)(ua + s * 32); }
        for (int d = 0; d < 2; ++d) {
            f32x16 aR[2], aI[2];
#pragma unroll
            for (int q = 0; q < 2; ++q)
#pragma unroll
                for (int r = 0; r < 16; ++r) { aR[q][r] = 0.f; aI[q][r] = 0.f; }
            {   const bf16_t* wb = WTL + ((size_t)d * 2048 + n * 256 + cgp * 64 + r32) * 256 + (n & 1) * 128 + hi * 8;
#pragma unroll
                for (int s = 0; s < 8; ++s) {
                    const bf16x8 b0 = *(const bf16x8*)(wb + s * 16), b1 = *(const bf16x8*)(wb + 32 * 256 + s * 16), b2 = *(const bf16x8*)(wb + 128 * 256 + s * 16), b3 = *(const bf16x8*)(wb + 160 * 256 + s * 16);
                    aR[0] = __builtin_amdgcn_mfma_f32_32x32x16_bf16(af[s], b0, aR[0], 0, 0, 0); aR[1] = __builtin_amdgcn_mfma_f32_32x32x16_bf16(af[s], b1, aR[1], 0, 0, 0);
                    aI[0] = __builtin_amdgcn_mfma_f32_32x32x16_bf16(af[s], b2, aI[0], 0, 0, 0); aI[1] = __builtin_amdgcn_mfma_f32_32x32x16_bf16(af[s], b3, aI[1], 0, 0, 0);
                    if ((s & 3) == 3) asm volatile("" ::: "memory"); } }
#pragma unroll
            for (int q = 0; q < 2; ++q) { const int chl = cgp * 64 + q * 32 + r32, ch = n * 128 + chl;
                const float bav = INP(11)[(l * 2 + d) * 1024 + ch], bxv = INP(13)[(l * 2 + d) * 1024 + ch], spv = C.ctl[CT_SP + (l * 2 + d) * 1024 + ch] * (-8.f);
#pragma unroll
                for (int r = 0; r < 16; ++r) { const int t = rb * 32 + crow(r, hi);
                    const float uu = bf2f(*(const LAS bf16_t*)(lds + LR_U + t * LR_UP + chl * 2));
                    const float rg = sigmoidf_(aR[q][r] + bav), ig = sigmoidf_(aI[q][r] + bxv);
                    const float loga = rg * spv, y2 = 2.f * loga;
                    const float om = -y2 * (1.f + y2 * 0.5f * (1.f + y2 * (1.f / 3.f) * (1.f + y2 * 0.25f * (1.f + y2 * 0.2f))));
                    const float bb = SQRT(fmaxf(om, 0.f)) * (ig * uu);
                    *(LAS f16_t*)(lds + LR_LA + (t * 128 + chl) * 2) = (f16_t)(loga * LOG2E); *(LAS f16_t*)(lds + LR_BC + (t * 128 + chl) * 2) = (f16_t)bb; } }
            __syncthreads();
            const int chl = tid & 127, sub = tid >> 7;
            {   float A = 1.f, H = 0.f;
#pragma unroll 8
                for (int i = 0; i < 32; ++i) { const int p = sub * 32 + i, t = d ? (127 - p) : p;
                    const float a = EX2((float)*(const LAS f16_t*)(lds + LR_LA + (t * 128 + chl) * 2)), bc = (float)*(const LAS f16_t*)(lds + LR_BC + (t * 128 + chl) * 2);
                    H = a * H + bc; A *= a; }
                *(LAS f32x2*)(lds + LR_XS + (sub * 128 + chl) * 8) = (f32x2){A, H}; }
            __syncthreads();
            {   float A = 1.f, H = 0.f;
                for (int p = 0; p < sub; ++p) { const f32x2 v = *(const LAS f32x2*)(lds + LR_XS + (p * 128 + chl) * 8); H = v.x * H + v.y; A *= v.x; }
                f16_t* cap = (d ? CAB : CAF) + (size_t)R0 * 1024 + n * 128 + chl;
#pragma unroll 8
                for (int i = 0; i < 32; ++i) { const int p = sub * 32 + i, t = d ? (127 - p) : p;
                    const float a = EX2((float)*(const LAS f16_t*)(lds + LR_LA + (t * 128 + chl) * 2)), bc = (float)*(const LAS f16_t*)(lds + LR_BC + (t * 128 + chl) * 2);
                    H = a * H + bc; A *= a;
                    cap[(size_t)t * 1024] = (f16_t)A;
                    LAS bf16_t* yp = (LAS bf16_t*)(lds + LR_Y0 + (t * 128 + chl) * 2);
                    if (d == 0) *yp = (bf16_t)f2bf(H); else Y0[(size_t)(R0 + t) * 1024 + n * 128 + chl] = (bf16_t)f2bf(bf2f(*yp) + H); }
                if (sub == 3) *(f32x2*)(SUM + ((size_t)((d * NB + b) * 34 + sg) * 1024 + n * 128 + chl) * 2) = (f32x2){A, H}; }
            __syncthreads();
        }
    }
}
__device__ __forceinline__ void phase_lru_fix(Ctx& C, const bf16_t* Y0, const f16_t* CAF, const f16_t* CAB, const float* SUM, bf16_t* YA) {
    for (int un = C.gw; un < NB * 34 * 8; un += C.ngw) {
        const int cg_ = un & 7, sg = (un >> 3) % 34, b = (un >> 3) / 34, ch = cg_ * 128 + 2 * C.lane;
        float F0 = 0.f, F1 = 0.f, B0 = 0.f, B1 = 0.f;
#pragma unroll 4
        for (int p = 0; p < sg; ++p) { const f32x4 v = *(const f32x4*)(SUM + ((size_t)((0 * NB + b) * 34 + p) * 1024 + ch) * 2); F0 = v[0] * F0 + v[1]; F1 = v[2] * F1 + v[3]; }
        const int npre = (sg < 2) ? (1 - sg) : (35 - sg);
#pragma unroll 4
        for (int p = 0; p < npre; ++p) { const int ps = (p < 2) ? (1 - p) : (35 - p);
            const f32x4 v = *(const f32x4*)(SUM + ((size_t)((1 * NB + b) * 34 + ps) * 1024 + ch) * 2); B0 = v[0] * B0 + v[1]; B1 = v[2] * B1 + v[3]; }
        const size_t base = (size_t)(b * SS + sg * 128) * 1024 + ch;
        for (int t0 = 0; t0 < 128; t0 += 16) {
            unsigned y[16]; f16x2 cf[16], cbk[16];
#pragma unroll
            for (int i = 0; i < 16; ++i) { const size_t o = base + (size_t)(t0 + i) * 1024; y[i] = *(const unsigned*)(Y0 + o); cf[i] = *(const f16x2*)(CAF + o); cbk[i] = *(const f16x2*)(CAB + o); }
#pragma unroll
            for (int i = 0; i < 16; ++i) { const size_t o = base + (size_t)(t0 + i) * 1024;
                *(unsigned*)(YA + o) = pk2(lo_bf(y[i]) + (float)cf[i][0] * F0 + (float)cbk[i][0] * B0, hi_bf(y[i]) + (float)cf[i][1] * F1 + (float)cbk[i][1] * B1); }
        }
    }
}

#ifdef PROBE_TS
#define GSYNC(g) do { { unsigned char* w_ = prm.ws; asm volatile("" : "+s"(w_)); xcd_barrier((unsigned*)(w_ + WS_BAR), (volatile LAS unsigned*)(ldsb + LDS_ST)); } if (blockIdx.x == 0 && threadIdx.x == 0) { unsigned long long* ts_ = (unsigned long long*)(prm.ws + 8192); const unsigned long long now_ = __builtin_amdgcn_s_memrealtime(); \
    ts_[1 + (g)] += now_ - ts_[0]; ts_[0] = now_; } } while (0)
#else
#define GSYNC(g) do { unsigned char* w_ = prm.ws; asm volatile("" : "+s"(w_)); xcd_barrier((unsigned*)(w_ + WS_BAR), (volatile LAS unsigned*)(ldsb + LDS_ST)); } while (0)
#endif
#define CTX Ctx C = mkctx(ldsb)
#define WSB wsp_(C.ws)
#define bYB ((bf16_t*)(WSB + AR_YB))
#define bXA ((bf16_t*)(WSB + AR_XA))
#define bMD ((bf16_t*)(WSB + AR_MD))
#define bRQKV ((bf16_t*)(WSB + AR_RQKV))
#define bKV ((bf16_t*)(WSB + AR_KV))
#define bQN ((bf16_t*)(WSB + AR_QN))
#define bQP ((bf16_t*)(WSB + AR_QP))
#define bRI ((f16_t*)(WSB + AR_RI))
#define bSUM ((float*)(WSB + AR_SUM))
#define bOB ((bf16_t*)(WSB + AR_OB))
#define bZ ((bf16_t*)(WSB + AR_Z))
#define xc1 ((float*)(WSB + WS_XC1))
template <int l> __device__ __forceinline__ void run_layer(const Params& prm, LAS unsigned char* ldsb) {
        const bool with_ctx = (l == 0); const int lat_only = with_ctx ? 0 : 1;
        { CTX; phase_wconv_early(C, l); }
        if (l == 0) GSYNC(0);
        { CTX; phase_h2(C, l, bYB); }
        GSYNC(1);
        {   CTX;
            ProbPlain P{bYB, (const bf16_t*)(WSB + W_WT1), 1024, 1024, 1024};
            pg8::StaticOrder S; S.init(68, 19, C.G, C.bid, 0);
            EpiG1 E{WSB, C.ctl + CT_ROPER};
            pg8::gemm_phase<EpiG1, ProbPlain, pg8::StaticOrder, true>(C.lds, P, S, E);
        }
        GSYNC(2);
        { CTX; phase_ret_intra(C, l, bRQKV, bYB); }
        { CTX; phase_md_post2(C, l, bMD); }
        GSYNC(4);
        { CTX; phase_ret_chain(C, l, bRQKV, bYB, bOB); }
        GSYNC(5);
        { CTX; phase_ret_ln3(C, l, bYB, bOB); }
        {   CTX; ProbPlain P{bMD, (const bf16_t*)(WSB + W_WTQ), 768, 384, 384};
            pg8::StaticOrder S; S.init(68, 6, C.G, C.bid, 0);
            typedef EpiStore3<AR_QN, 1024, AR_QP, 512, AR_QP, 512, 4, 6> Ep; Ep E{WSB};
            pg8::gemm_phase<Ep, ProbPlain, pg8::StaticOrder, true>(C.lds, P, S, E);
        }
        {   CTX; ProbPlain P{bMD + 384, (const bf16_t*)(WSB + W_WTKV), 768, 256, 256};
            pg8::StaticOrder S; S.init(68, 8, C.G, C.bid, 0);
            typedef EpiStore3<AR_KV, 2048, AR_KV, 2048, AR_KV, 2048, 8, 8> Ep; Ep E{WSB};
            pg8::gemm_phase<Ep, ProbPlain, pg8::StaticOrder, true>(C.lds, P, S, E);
        }
        GSYNC(6);
        { CTX; phase_qk_post2(C, l, bQN, bQP, bKV); }
        GSYNC(7);
        { CTX; phase_attn(C, with_ctx, bQN, bQP, bKV, bMD); }
        GSYNC(8);
        { CTX; phase_lru_fused(C, l, bXA, (const bf16_t*)(WSB + W_WTL), (bf16_t*)(WSB + AR_Y0), (f16_t*)(WSB + AR_CAF), (f16_t*)(WSB + AR_CAB), bSUM); }
        GSYNC(9);
        { CTX; phase_lru_fix(C, (const bf16_t*)(WSB + AR_Y0), (const f16_t*)(WSB + AR_CAF), (const f16_t*)(WSB + AR_CAB), bSUM, bXA  ); }
        GSYNC(10);
        { CTX; phase_wconv_late(C, l); }
        { CTX; phase_h2(C, l, bMD  ); }
        GSYNC(13);
        {   CTX; ProbPlain P{bMD, (const bf16_t*)(WSB + W_WTG), 1024, 1024, 1024};
            pg8::StaticOrder S; S.init(lat_only ? 64 : 68, 12, C.G, C.bid, lat_only);
            EpiGate E{WSB};
            pg8::gemm_phase<EpiGate, ProbPlain, pg8::StaticOrder, true>(C.lds, P, S, E);
        }
        GSYNC(14);
        {   CTX; ProbD P{WSB, 1024, 1024};
            pg8::ChainOrder S; S.init(C.G, C.bid, with_ctx ? 1 : 0);
            EpiD E{bZ, WSB + AR_GS + (size_t)C.bid * 131072, (bf16_t*)(WSB + AR_ZP)};
            pg8::gemm_phase<EpiD, ProbD, pg8::ChainOrder, true>(C.lds, P, S, E);
        }
        GSYNC(15);
        if (with_ctx) { { CTX; phase_zsum(C, (const bf16_t*)(WSB + AR_ZP), bZ); } GSYNC(12); }
        {   CTX; ProbPlain P{bZ, (const bf16_t*)(WSB + W_WTO), 1024, 1024, 1024};
            pg8::StaticOrder S; S.init(lat_only ? 64 : 68, 4, C.G, C.bid, lat_only);
            EpiOut E{(l == 0) ? INP(0) : (const float*)C.out, INP(2), C.out, xc1, C.ctl + CT_MOD + l * 5 * 3072};
            pg8::gemm_phase<EpiOut, ProbPlain, pg8::StaticOrder, true>(C.lds, P, S, E);
        }
        GSYNC(16);
    }

__global__ void __launch_bounds__(NTHR) fwd_kernel(Params prm) {
    extern __shared__ __attribute__((aligned(16))) unsigned char lds_raw[];
    cg::grid_group grid = cg::this_grid();
    LAS unsigned char* const ldsb = (LAS unsigned char*)lds_raw;
    if (threadIdx.x < 16) ((LAS unsigned*)(ldsb + LDS_ST))[threadIdx.x] = 0u;
    __syncthreads();
    if (threadIdx.x == 0) (void)xb_add(&((unsigned*)(prm.ws + WS_BAR))[XB_XCNT(xb_xcc_id())], 1u);
    grid.sync();


#ifdef PROBE_TS
    if (blockIdx.x == 0 && threadIdx.x == 0) { unsigned long long* ts_ = (unsigned long long*)(prm.ws + 8192); for (int i = 1; i < 32; ++i) ts_[i] = 0ull; ts_[0] = __builtin_amdgcn_s_memrealtime(); }
#endif
    { CTX; phase_prep(C); }
    run_layer<0>(prm, ldsb);
    run_layer<1>(prm, ldsb);
#ifdef PROBE_TS
    if (blockIdx.x == 0 && threadIdx.x == 0) { const unsigned long long* ts_ = (const unsigned long long*)(prm.ws + 8192); unsigned long long tot = 0ull;
        for (int g = 0; g < 17; ++g) if ((PROBE_TS >> g) & 1u) tot += ts_[1 + g];
        prm.out[0] += (float)(((tot / 100ull) + PROBE_Q / 2) / PROBE_Q * PROBE_Q); }
#endif
}

#undef xc1
#undef bZ
extern "C" void kernel_launch(void* const* d_in, const int* in_sizes, int n_in, void* d_out, int out_size, void* d_ws, size_t ws_size, hipStream_t stream) {
    static int grid = 0;
    if (grid == 0) {
        if (n_in != 29 || out_size != NB * TT * DM || ws_size < WS_END) { fprintf(stderr, "kernel_launch: unexpected shapes (n_in %d out %d ws %zu)\n", n_in, out_size, ws_size); grid = -1; return; }
        int dev = 0, cus = 0, per_cu = 0;
        hipGetDevice(&dev);
        hipDeviceGetAttribute(&cus, hipDeviceAttributeMultiprocessorCount, dev);
        if (hipFuncSetAttribute((const void*)fwd_kernel, hipFuncAttributeMaxDynamicSharedMemorySize, LDS_BYTES) != hipSuccess) { fprintf(stderr, "kernel_launch: hipFuncSetAttribute failed\n"); grid = -1; return; }
        if (hipOccupancyMaxActiveBlocksPerMultiprocessor(&per_cu, (const void*)fwd_kernel, NTHR, LDS_BYTES) != hipSuccess || per_cu < 1) { fprintf(stderr, "kernel_launch: occupancy query failed (%d)\n", per_cu); (void)hipGetLastError(); per_cu = 1; }
        grid = cus;
        fprintf(stderr, "kernel_launch: cus %d per_cu %d grid %d\n", cus, per_cu, grid);
    }
    if (grid < 0) return;
    if (hipMemsetAsync((char*)d_ws + WS_BAR, 0, XCD_BAR_WORDS * 4, stream) != hipSuccess) { fprintf(stderr, "kernel_launch: memset failed\n"); return; }
    Params p{};
    for (int i = 0; i < 29; ++i) p.in[i] = (const float*)d_in[i];
    p.out = (float*)d_out; p.ws = (unsigned char*)d_ws;
    void* args[] = {&p};
    hipError_t e = hipLaunchCooperativeKernel((const void*)fwd_kernel, dim3(grid), dim3(NTHR), args, LDS_BYTES, stream);
    if (e != hipSuccess) fprintf(stderr, "cooperative launch failed: %s (grid %d)\n", hipGetErrorString(e), grid);
}
```

```cpp
#include <hip/hip_runtime.h>
#include <hip/hip_cooperative_groups.h>
#include <cstdio>
#include <cstdint>
namespace cg = cooperative_groups;

#define LAS __attribute__((address_space(3)))
typedef unsigned short bf16_t;
typedef short bf16x8 __attribute__((ext_vector_type(8)));
typedef float f32x4 __attribute__((ext_vector_type(4)));
typedef float f32x2 __attribute__((ext_vector_type(2)));
typedef unsigned u32x4 __attribute__((ext_vector_type(4)));
typedef unsigned u32x2 __attribute__((ext_vector_type(2)));
typedef _Float16 f16_t;

namespace pg8 {
constexpr int BM = 256, BK = 64, HALF = 128, HTB = HALF * BK * 2, STAGE_BYTES = 8 * HTB, NXCD = 8, WGM = 8;
__host__ __device__ __forceinline__ int lds_byte(int r, int c) { const int st = (r >> 4) * 2 + (c >> 5), rr = r & 15, cc = c & 31, ob = rr * 64 + cc * 2; return st * 1024 + (ob ^ (((ob >> 9) & 1) << 5)); }
__host__ __device__ __forceinline__ void stage_rc(int b, int& R, int& C) { const int st = b / 1024, sb = b % 1024, swz = sb ^ (((sb >> 9) & 1) << 5); R = (st >> 1) * 16 + swz / 64; C = (st & 1) * 32 + (swz % 64) / 2; }
__host__ __device__ __forceinline__ int perm32(int rho) { const int n = rho >> 4, i = rho & 15; return 8 * (i >> 2) + 4 * n + (i & 3); }

struct Unit { int pm, pn, z; };

struct StaticOrder {
    int nM, nN, nwg, G, c, latent_only;
    __device__ void init(int nM_, int nN_, int G_, int c_, int latent_only_) { nM = nM_; nN = nN_; nwg = nM * nN; G = G_; c = c_; latent_only = latent_only_; }
    __device__ bool next(int i, Unit& u) const {
        const long L = (long)i * G + c; if (L >= nwg) return false;
        int wgid = (int)L; { const int q = nwg / NXCD, r = nwg % NXCD, xcd = wgid % NXCD, off = wgid / NXCD; wgid = (xcd < r ? xcd * (q + 1) : r * (q + 1) + (xcd - r) * q) + off; }
        const int nig = WGM * nN, gid = wgid / nig, fm = gid * WGM, gsz = (nM - fm) < WGM ? (nM - fm) : WGM;
        int pm = fm + ((wgid % nig) % gsz); u.pn = (wgid % nig) / gsz; u.z = 0;
        if (latent_only) pm = (pm >> 4) * 17 + 1 + (pm & 15);
        u.pm = pm; return true;
    }
};
struct ChainOrder {
    int G, c, with_ctx;
    __device__ void init(int G_, int c_, int with_ctx_) { G = G_; c = c_; with_ctx = with_ctx_; }
    __device__ bool next(int i, Unit& u) const {
        if (i < 6) { const int T = c; if (T >= 256) return false; int pm = T >> 2; u.pn = T & 3; u.z = i; u.pm = (pm >> 4) * 17 + 1 + (pm & 15); return true; }
        if (i < 8 && with_ctx && c < 48) { const int ct = c / 3, br = c - ct * 3; u.pm = (ct >> 2) * 17; u.pn = ct & 3; u.z = 8 + 2 * br + (i - 6); return true; }
        return false;
    }
};

typedef __bf16 bf16x2_t __attribute__((ext_vector_type(2)));
__device__ __forceinline__ unsigned cvt_pk_bf16(float lo, float hi) { f32x2 v = {lo, hi}; bf16x2_t b = __builtin_convertvector(v, bf16x2_t); return __builtin_bit_cast(unsigned, b); }

template <class Epi, class Prob, class Sched, bool ALIGN_EPI>
__device__ __forceinline__ void gemm_phase(LAS unsigned char* lds, const Prob& P, const Sched& S, const Epi& E) {
    int tid_ = threadIdx.x; asm volatile("" : "+v"(tid_));
    const int tid = tid_, wid = __builtin_amdgcn_readfirstlane(tid >> 6), lane = tid & 63, wr = wid >> 2, wc = wid & 3, fr = lane & 15, fq = lane >> 4;
    const int K = P.K, nt = K / BK;
    int RA[2], CA[2]; unsigned voffB[2];
#pragma unroll
    for (int i = 0; i < 2; ++i) { int R, C; stage_rc(tid * 16 + i * 8192, R, C); const int Rb = Epi::PERM ? ((R & ~31) + perm32(R & 31)) : R;
        RA[i] = R; CA[i] = C; voffB[i] = (unsigned)(Rb * P.ldb + C) * 2u; }
    const unsigned kstep = (unsigned)(BK * 2);
    const unsigned hstepB = (unsigned)(HALF * P.ldb * 2);
    const unsigned ldsw = (unsigned)wid * 1024u;
    const int aoff = lds_byte(wr * 64 + fr, fq * 8), boff = lds_byte(wc * 32 + fr, fq * 8);
#define PG8_SA(b, h) (((b) * 2 + (h)) * HTB)
#define PG8_SB(b, h) ((4 + (b) * 2 + (h)) * HTB)
#define PG8_STAGE(bufoff, gbase, soff, voff) do { _Pragma("unroll") for (int _i = 0; _i < 2; ++_i) \
        __builtin_amdgcn_global_load_lds((const unsigned*)((const char*)(gbase) + (unsigned)((voff)[_i] + (soff))), (LAS unsigned*)(lds + (bufoff) + ldsw + _i * 8192), 16, 0, 0); } while (0)
#define PG8_LDA(dst, b, h) do { _Pragma("unroll") for (int m = 0; m < 4; ++m) _Pragma("unroll") for (int k = 0; k < 2; ++k) dst[m][k] = *(const LAS bf16x8*)(lds + PG8_SA(b, h) + aoff + m * 2048 + k * 1024); } while (0)
#define PG8_LDB(dst, b, h) do { _Pragma("unroll") for (int n = 0; n < 2; ++n) _Pragma("unroll") for (int k = 0; k < 2; ++k) dst[n][k] = *(const LAS bf16x8*)(lds + PG8_SB(b, h) + boff + n * 2048 + k * 1024); } while (0)
#define PG8_MMA(ai, bj, At, Bt) do { __builtin_amdgcn_s_setprio(1); _Pragma("unroll") for (int m = 0; m < 4; ++m) _Pragma("unroll") for (int n = 0; n < 2; ++n) _Pragma("unroll") for (int k = 0; k < 2; ++k) \
        acc[ai][bj][m][n] = __builtin_amdgcn_mfma_f32_16x16x32_bf16(Bt[n][k], At[m][k], acc[ai][bj][m][n], 0, 0, 0); __builtin_amdgcn_s_setprio(0); } while (0)
#define PG8_WAIT_V(n) asm volatile("s_waitcnt vmcnt(" #n ")" ::: "memory")
#define PG8_WAIT_L(n) asm volatile("s_waitcnt lgkmcnt(" #n ")" ::: "memory")
#define PG8_BAR __builtin_amdgcn_s_barrier()
#define PG8_SCHED __builtin_amdgcn_sched_barrier(0)
    Unit cur, nxt; int ui = 0;
    if (!S.next(0, cur)) return;
    f32x4 acc[2][2][4][2];
#pragma unroll
    for (int a = 0; a < 2; ++a)
#pragma unroll
        for (int b = 0; b < 2; ++b)
#pragma unroll
            for (int m = 0; m < 4; ++m)
#pragma unroll
                for (int n = 0; n < 2; ++n) acc[a][b][m][n] = (f32x4){0.f, 0.f, 0.f, 0.f};
    bf16x8 At[4][2], B0[2][2], B1[2][2];
    const char* cA; const char* cB; int ldaC; P.get(cur, cA, cB, ldaC);
    unsigned voffA[2] = {(unsigned)(RA[0] * ldaC + CA[0]) * 2u, (unsigned)(RA[1] * ldaC + CA[1]) * 2u};
    unsigned hstepA = (unsigned)(HALF * ldaC * 2);
    PG8_STAGE(PG8_SB(0, 0), cB, 0u, voffB); PG8_STAGE(PG8_SB(0, 1), cB, hstepB, voffB); PG8_STAGE(PG8_SA(0, 0), cA, 0u, voffA); PG8_STAGE(PG8_SA(0, 1), cA, hstepA, voffA);
    if (wr == 1) PG8_BAR;
    PG8_WAIT_V(2); PG8_BAR;
    PG8_STAGE(PG8_SB(1, 0), cB, kstep, voffB); PG8_STAGE(PG8_SA(1, 0), cA, kstep, voffA); PG8_STAGE(PG8_SB(1, 1), cB, hstepB + kstep, voffB);
    PG8_WAIT_V(6); PG8_BAR;
    for (;;) {
        const bool has_next = S.next(ui + 1, nxt);
        const char* nA = cA; const char* nB = cB; int ldaN = ldaC;
        if (has_next) P.get(nxt, nA, nB, ldaN);
        unsigned voffAn[2] = {(unsigned)(RA[0] * ldaN + CA[0]) * 2u, (unsigned)(RA[1] * ldaN + CA[1]) * 2u};
        const unsigned hstepAn = (unsigned)(HALF * ldaN * 2);
        for (int t = 0; t < nt; t += 2) {
            const bool last = (t == nt - 2);
            const unsigned o1 = (unsigned)(t + 1) * kstep;
            const char* a2b = last ? nA : cA; const char* b2b = last ? nB : cB;
            const unsigned o2 = last ? 0u : (unsigned)(t + 2) * kstep, o3 = o2 + kstep;
            unsigned vA2[2] = {last ? voffAn[0] : voffA[0], last ? voffAn[1] : voffA[1]};
            const unsigned hA2 = last ? hstepAn : hstepA;
            PG8_LDB(B0, 0, 0); PG8_LDB(B1, 0, 1); PG8_SCHED; PG8_LDA(At, 0, 0); PG8_STAGE(PG8_SA(1, 1), cA, o1 + hstepA, voffA);
            PG8_WAIT_V(8); PG8_WAIT_L(0); PG8_BAR; PG8_MMA(0, 0, At, B0); PG8_MMA(0, 1, At, B1); PG8_BAR; PG8_SCHED;
            PG8_LDA(At, 0, 1); PG8_STAGE(PG8_SB(0, 0), b2b, o2, voffB); PG8_STAGE(PG8_SB(0, 1), b2b, o2 + hstepB, voffB); PG8_STAGE(PG8_SA(0, 0), a2b, o2, vA2);
            PG8_WAIT_V(8); PG8_WAIT_L(0); PG8_BAR; PG8_MMA(1, 0, At, B0); PG8_MMA(1, 1, At, B1); PG8_BAR; PG8_SCHED;
            PG8_LDB(B0, 1, 0); PG8_LDB(B1, 1, 1); PG8_SCHED; PG8_LDA(At, 1, 0); PG8_STAGE(PG8_SA(0, 1), a2b, o2 + hA2, vA2);
            PG8_WAIT_V(8); PG8_WAIT_L(0); PG8_BAR; PG8_MMA(0, 0, At, B0); PG8_MMA(0, 1, At, B1); PG8_BAR; PG8_SCHED;
            PG8_LDA(At, 1, 1); PG8_STAGE(PG8_SB(1, 0), b2b, o3, voffB); PG8_STAGE(PG8_SB(1, 1), b2b, o3 + hstepB, voffB); PG8_STAGE(PG8_SA(1, 0), a2b, o3, vA2);
            PG8_WAIT_V(8); PG8_WAIT_L(0); PG8_BAR; PG8_MMA(1, 0, At, B0); PG8_MMA(1, 1, At, B1); PG8_BAR; PG8_SCHED;
        }
        if constexpr (ALIGN_EPI) { if (wr == 0) PG8_BAR; }
        E(acc, cur, wr, wc, fr, fq);
        if (!has_next) break;
#pragma unroll
        for (int a = 0; a < 2; ++a)
#pragma unroll
            for (int b = 0; b < 2; ++b)
#pragma unroll
                for (int m = 0; m < 4; ++m)
#pragma unroll
                    for (int n = 0; n < 2; ++n) acc[a][b][m][n] = (f32x4){0.f, 0.f, 0.f, 0.f};
        cur = nxt; cA = nA; cB = nB; ldaC = ldaN; voffA[0] = voffAn[0]; voffA[1] = voffAn[1]; hstepA = hstepAn; ++ui;
        if constexpr (ALIGN_EPI) { if (wr == 1) PG8_BAR; }
    }
    PG8_WAIT_V(0);
    if constexpr (!ALIGN_EPI) { if (wr == 0) PG8_BAR; }
    PG8_BAR;
#undef PG8_SA
#undef PG8_SB
#undef PG8_STAGE
#undef PG8_LDA
#undef PG8_LDB
#undef PG8_MMA
#undef PG8_WAIT_V
#undef PG8_WAIT_L
#undef PG8_BAR
#undef PG8_SCHED
}
}

constexpr int NB = 4, TT = 4096, LC = 256, SS = TT + LC  , DM = 1024, MR = NB * SS  ;
constexpr int INC = 10944;
constexpr float EPS = 1e-6f;
constexpr float LOG2E = 1.4426950408889634f;
constexpr float QSCALE = 0.07216878364870322f * 1.4426950408889634f;
constexpr int NWAVES = 8, NTHR = 512;

constexpr size_t MiB = 1u << 20;
constexpr size_t WS_CTL = 0;
constexpr size_t WS_XC1 = 1 * MiB;
constexpr size_t WS_W = 5 * MiB;
constexpr size_t WS_AR = 25 * MiB;
constexpr size_t AR_YB = WS_AR + 0 * MiB;
constexpr size_t AR_XA = WS_AR + 34 * MiB;
constexpr size_t AR_MD = WS_AR + 68 * MiB;
constexpr size_t AR_RQKV = WS_AR + 94 * MiB;
constexpr size_t AR_OB = WS_AR + 196 * MiB;
constexpr size_t AR_KV = WS_AR + 112 * MiB;
constexpr size_t AR_QN = WS_AR + 180 * MiB;
constexpr size_t AR_QP = WS_AR + 214 * MiB;
constexpr size_t AR_RI = WS_AR + 102 * MiB;
constexpr size_t AR_Y0 = WS_AR + 68 * MiB;
constexpr size_t AR_CAF = WS_AR + 102 * MiB;
constexpr size_t AR_CAB = WS_AR + 136 * MiB;
constexpr size_t AR_SUM = WS_AR + 170 * MiB;
constexpr size_t AR_Z = WS_AR + 102 * MiB;
constexpr size_t AR_ZP = WS_AR + 170 * MiB;
constexpr size_t AR_GS = WS_AR + 136 * MiB;
constexpr size_t WS_END = 256 * MiB;
constexpr size_t W_WT1 = WS_W;
constexpr size_t W_WTQ = WS_W + 10 * MiB;
constexpr size_t W_WTKV = WS_W + 12 * MiB;
constexpr size_t W_WTL = WS_W + 13 * MiB;
constexpr size_t W_WTG = WS_W;
constexpr size_t W_WTGM = WS_W + 6 * MiB;
constexpr size_t W_WTD = WS_W + 12 * MiB;
constexpr size_t W_WTO = WS_W + 18 * MiB;
constexpr int CT_MOD = 16384;
constexpr int CT_ROPER = CT_MOD + 2 * 5 * 3072;
constexpr int CT_ROPEM = CT_ROPER + 2 * 4096;
constexpr int CT_SP = CT_ROPEM + 2 * 1024;
constexpr int CT_LG = CT_SP + 4096;
constexpr int CT_END = CT_LG + 16;
static_assert(CT_END * 4 <= (int)MiB, "CTL");

constexpr int LDS_BYTES = 147456;


#define XB_TMO      128
#define XB_XCNT(j)  (256  + 64 * (j))
#define XB_XSUB(j)  (1280 + 64 * (j))
#define XB_XGEN(j)  (2304 + 64 * (j))
#define XB_TOP      3328
#define XB_TOPGEN   3392
#define XCD_BAR_WORDS 3456
#define XB_SPIN_CAP (1u << 18)
constexpr size_t WS_BAR = 16384;
constexpr int LDS_ST = LDS_BYTES - 64;
__device__ __forceinline__ unsigned xb_ld(unsigned* p)              { return __hip_atomic_load(p, __ATOMIC_RELAXED, __HIP_MEMORY_SCOPE_AGENT); }
__device__ __forceinline__ unsigned xb_add(unsigned* p, unsigned v) { return __hip_atomic_fetch_add(p, v, __ATOMIC_RELAXED, __HIP_MEMORY_SCOPE_AGENT); }
__device__ __forceinline__ unsigned xb_xcc_id() { return (unsigned)__builtin_amdgcn_s_getreg((3 << 11) | 20) & 0xFu; }
#define XB_SPIN(cond, bar) do { unsigned _sp = 0; while (cond) { __builtin_amdgcn_s_sleep(1); \
    if ((++_sp & 255u) == 0u) { if (xb_ld(&(bar)[XB_TMO])) break; if (_sp > XB_SPIN_CAP) { atomicAdd(&(bar)[XB_TMO], 1u); break; } } } } while (0)
__device__ __forceinline__ void xcd_barrier_complete(unsigned* bar, unsigned x, unsigned& nloc, unsigned& nx) {
    const unsigned G = gridDim.x * gridDim.y * gridDim.z;
    unsigned sum, cnt, mine, sp = 0u;
    for (;;) {
        sum = 0u; cnt = 0u; mine = 0u;
#pragma unroll
        for (unsigned j = 0; j < 16; ++j) { const unsigned c = xb_ld(&bar[XB_XCNT(j)]); sum += c; cnt += (c > 0u) ? 1u : 0u; mine = (j == x) ? c : mine; }
        if (sum == G) break;
        __builtin_amdgcn_s_sleep(1);
        if ((++sp & 255u) == 0u) { if (xb_ld(&bar[XB_TMO])) break; if (sp > XB_SPIN_CAP) { atomicAdd(&bar[XB_TMO], 1u); break; } }
    }
    nloc = mine > 0u ? mine : 1u; nx = cnt > 0u ? cnt : 1u;
}
__device__ __forceinline__ void xcd_barrier(unsigned* bar, volatile LAS unsigned* st) {
    asm volatile("s_waitcnt vmcnt(0)" ::: "memory");
    __syncthreads();
    if (threadIdx.x == 0) {
        const unsigned x = xb_xcc_id();
        __builtin_amdgcn_s_waitcnt(0);
        unsigned nloc = st[0], nx = st[1];
        if (nloc == 0u) { xcd_barrier_complete(bar, x, nloc, nx); st[0] = nloc; st[1] = nx; }
        const unsigned old = xb_add(&bar[XB_XSUB(x)], 1u);
        const unsigned gen = old / nloc;
        if (old + 1u == (gen + 1u) * nloc) {
            __builtin_amdgcn_fence(__ATOMIC_RELEASE, "agent");
            asm volatile("s_waitcnt vmcnt(0)" ::: "memory");
            const unsigned og = xb_add(&bar[XB_TOP], 1u);
            const unsigned tg = og / nx;
            if (og + 1u == (tg + 1u) * nx) xb_add(&bar[XB_TOPGEN], 1u);
            else XB_SPIN(xb_ld(&bar[XB_TOPGEN]) == tg, bar);
            __builtin_amdgcn_fence(__ATOMIC_ACQUIRE, "agent");
            xb_add(&bar[XB_XGEN(x)], 1u);
            asm volatile("s_waitcnt vmcnt(0)" ::: "memory");
        } else {
            XB_SPIN(xb_ld(&bar[XB_XGEN(x)]) == gen, bar);
            __builtin_amdgcn_fence(__ATOMIC_ACQUIRE, "agent");
            asm volatile("s_waitcnt vmcnt(0)" ::: "memory");
        }
    }
    __syncthreads();
}

struct Params {
    const float* in[29];
    float* out;
    unsigned char* ws;
};

#define EX2(x) __builtin_amdgcn_exp2f(x)
#define RSQ(x) __builtin_amdgcn_rsqf(x)
#define SQRT(x) __builtin_amdgcn_sqrtf(x)
__device__ __forceinline__ float bf2f(unsigned v) { return __uint_as_float(v << 16); }
__device__ __forceinline__ unsigned f2bf(float f) { unsigned u = __float_as_uint(f); return (u + 0x7fffu + ((u >> 16) & 1u)) >> 16; }
__device__ __forceinline__ unsigned pk2(float lo, float hi) { return f2bf(lo) | (f2bf(hi) << 16); }
__device__ __forceinline__ float lo_bf(unsigned w) { return __uint_as_float(w << 16); }
__device__ __forceinline__ float hi_bf(unsigned w) { return __uint_as_float(w & 0xffff0000u); }
__device__ __forceinline__ float wave_sum(float v) {
#pragma unroll
    for (int o = 1; o < 64; o <<= 1) v += __shfl_xor(v, o);
    return v;
}
__device__ __forceinline__ float wave_max(float v) {
#pragma unroll
    for (int o = 1; o < 64; o <<= 1) v = fmaxf(v, __shfl_xor(v, o));
    return v;
}
__device__ __forceinline__ float sigmoidf_(float x) { return __builtin_amdgcn_rcpf(1.f + __expf(-x)); }
__device__ __forceinline__ float siluf_(float x) { return x * __builtin_amdgcn_rcpf(1.f + __expf(-x)); }

__device__ __forceinline__ const float* inp_(int i) { asm volatile("" : "+s"(i)); const float* const* ka = (const float* const*)__builtin_amdgcn_kernarg_segment_ptr(); return ka[i]; }
#define INP(i) inp_(i)
__device__ __forceinline__ unsigned char* wsp_(unsigned char* p) { asm volatile("" : "+s"(p)); return p; }
struct Ctx {
    float* out; unsigned char* ws; LAS unsigned char* lds; int tid, lane, wave, G, bid;
    int gw, ngw;
    int rot;
    float* ctl;
};

__device__ __forceinline__ Ctx mkctx(LAS unsigned char* lds) {
    Ctx C; int t = threadIdx.x; asm volatile("" : "+v"(t)); int b = blockIdx.x; asm volatile("" : "+s"(b)); int g = gridDim.x; asm volatile("" : "+s"(g));
    C.tid = t; C.lane = t & 63; C.wave = __builtin_amdgcn_readfirstlane(t >> 6); C.bid = b; C.G = g; C.gw = b * NWAVES + C.wave; C.ngw = g * NWAVES; C.rot = 0;
    int io = 29, iw = 30; asm volatile("" : "+s"(io)); asm volatile("" : "+s"(iw));
    unsigned char* const* ka = (unsigned char* const*)__builtin_amdgcn_kernarg_segment_ptr();
    C.out = (float*)ka[io]; C.ws = ka[iw]; C.ctl = (float*)(C.ws + WS_CTL); C.lds = lds;
    return C;
}
__device__ __forceinline__ const float* resid_row(const Ctx& C, int l, int m) {
    const int b = m / SS, s = m - b * SS;
    if (s < LC) { const float* base = (l == 0) ? INP(2) : (const float*)(C.ws + WS_XC1); return base + (size_t)(b * LC + s) * DM; }
    const float* base = (l == 0) ? INP(0) : C.out; return base + (size_t)(b * TT + (s - LC)) * DM;
}

__device__ __forceinline__ void phase_prep(Ctx& C) {
    LAS float* sl = (LAS float*)C.lds;
    LAS float* red = (LAS float*)(C.lds + 32768);
    for (int i = C.tid; i < 5 * 1024; i += NTHR) { const int r = i >> 10, k = i & 1023; const float v = (r < 4) ? INP(1)[r * 1024 + k] : INP(3)[k]; sl[i] = siluf_(v); }
    __syncthreads();
    for (int it = C.bid; it < 2 * 96; it += C.G) {
        const int l = it / 96, grp = it % 96, kg = C.tid >> 5, cj = C.tid & 31, col = grp * 32 + cj;
        const float* w = INP(4) + (size_t)l * 1024 * 3072 + col;
        float a0 = 0.f, a1 = 0.f, a2 = 0.f, a3 = 0.f, a4 = 0.f;
#pragma unroll 8
        for (int k = kg * 64; k < kg * 64 + 64; ++k) { const float wv = w[(size_t)k * 3072]; a0 += sl[k] * wv; a1 += sl[1024 + k] * wv; a2 += sl[2048 + k] * wv; a3 += sl[3072 + k] * wv; a4 += sl[4096 + k] * wv; }
        red[(kg * 32 + cj) * 5 + 0] = a0; red[(kg * 32 + cj) * 5 + 1] = a1; red[(kg * 32 + cj) * 5 + 2] = a2; red[(kg * 32 + cj) * 5 + 3] = a3; red[(kg * 32 + cj) * 5 + 4] = a4;
        __syncthreads();
        if (C.tid < 160) { const int c2 = C.tid / 5, r = C.tid % 5; float s = 0.f;
            for (int g = 0; g < 16; ++g) s += red[(g * 32 + c2) * 5 + r];
            C.ctl[CT_MOD + (l * 5 + r) * 3072 + grp * 32 + c2] = s + INP(5)[l * 3072 + grp * 32 + c2]; }
        __syncthreads();
    }
    const int gt = C.bid * NTHR + C.tid, ngt = C.G * NTHR;
    for (int i = gt; i < 4096; i += ngt) { const int pos = i >> 6, f = i & 63; const float inv = powf(10000.f, -(float)f / 64.f), ang = (float)pos * inv;
        C.ctl[CT_ROPER + i] = cosf(ang); C.ctl[CT_ROPER + 4096 + i] = sinf(ang); }
    for (int i = gt; i < 1024; i += ngt) { const int pos = i >> 4, f = i & 15; const float inv = powf(10000.f, -(float)f / 16.f), ang = (float)pos * inv;
        C.ctl[CT_ROPEM + i] = cosf(ang); C.ctl[CT_ROPEM + 1024 + i] = sinf(ang); }
    for (int i = gt; i < 4096; i += ngt) C.ctl[CT_SP + i] = log1pf(expf(-INP(14)[i]));
    for (int i = gt; i < 16; i += ngt) C.ctl[CT_LG + i] = -log1pf(expf(-INP(15)[i])) * LOG2E;
}

__device__ __forceinline__ void tr_item(const float* W, int ldw, int k0, int n0, bf16_t* WT, int ldt, int drow0, int dk0, LAS float* scr, int lane) {
#pragma unroll 8
    for (int i = 0; i < 32; ++i) { const int kk = 2 * i + (lane >> 5); scr[kk * 33 + (lane & 31)] = W[(size_t)(k0 + kk) * ldw + n0 + (lane & 31)]; }
    asm volatile("s_waitcnt lgkmcnt(0)" ::: "memory");
    const int c = lane & 7;
#pragma unroll
    for (int j = 0; j < 4; ++j) { const int n = (lane >> 3) + 8 * j; const LAS float* s = scr + (8 * c) * 33 + n;
        u32x4 o; o.x = pk2(s[0 * 33], s[1 * 33]); o.y = pk2(s[2 * 33], s[3 * 33]); o.z = pk2(s[4 * 33], s[5 * 33]); o.w = pk2(s[6 * 33], s[7 * 33]);
        *(u32x4*)(WT + (size_t)(drow0 + n) * ldt + dk0 + 8 * c) = o; }
    asm volatile("s_waitcnt lgkmcnt(0)" ::: "memory");
}
__device__ __forceinline__ void conv_rows(Ctx& C, const float* W, int ldw, int K, int scol0, bf16_t* WT, int ldt, int drow0, int dk0, int nrows, LAS float* scr) {
    const int nkb = K / 64, items = nkb * (nrows / 32);
    int g0 = C.gw - C.rot; if (g0 < 0) g0 += C.ngw; C.rot = (C.rot + items) % C.ngw;
    for (int it = g0; it < items; it += C.ngw) { const int nb = it / nkb, kb = it - nb * nkb;
        tr_item(W, ldw, kb * 64, scol0 + nb * 32, WT, ldt, drow0 + nb * 32, dk0 + kb * 64, scr, C.lane); }
}
__device__ __forceinline__ int ropeperm(int j) { const int h = j >> 8, jj = j & 255, half = jj >> 7, g = (jj & 127) >> 3, r8 = jj & 7; return h * 256 + (half * 2 + (r8 >> 2)) * 64 + g * 4 + (r8 & 3); }
__device__ __forceinline__ void tr_item_rope(const float* W, int ldw, int k0, int scol0, int jbase, bf16_t* WT, int ldt, int drow0, int dk0, LAS float* scr, int lane) {
    const int sc = scol0 + ropeperm(jbase + (lane & 31));
#pragma unroll 8
    for (int i = 0; i < 32; ++i) { const int kk = 2 * i + (lane >> 5); scr[kk * 33 + (lane & 31)] = W[(size_t)(k0 + kk) * ldw + sc]; }
    asm volatile("s_waitcnt lgkmcnt(0)" ::: "memory");
    const int c = lane & 7;
#pragma unroll
    for (int j = 0; j < 4; ++j) { const int n = (lane >> 3) + 8 * j; const LAS float* s = scr + (8 * c) * 33 + n;
        u32x4 o; o.x = pk2(s[0 * 33], s[1 * 33]); o.y = pk2(s[2 * 33], s[3 * 33]); o.z = pk2(s[4 * 33], s[5 * 33]); o.w = pk2(s[6 * 33], s[7 * 33]);
        *(u32x4*)(WT + (size_t)(drow0 + n) * ldt + dk0 + 8 * c) = o; }
    asm volatile("s_waitcnt lgkmcnt(0)" ::: "memory");
}
__device__ __forceinline__ void conv_rows_rope(Ctx& C, const float* W, int ldw, int K, int scol0, bf16_t* WT, int ldt, int drow0, int nrows, LAS float* scr) {
    const int nkb = K / 64, items = nkb * (nrows / 32);
    int g0 = C.gw - C.rot; if (g0 < 0) g0 += C.ngw; C.rot = (C.rot + items) % C.ngw;
    for (int it = g0; it < items; it += C.ngw) { const int nb = it / nkb, kb = it - nb * nkb;
        tr_item_rope(W, ldw, kb * 64, scol0, nb * 32, WT, ldt, drow0 + nb * 32, kb * 64, scr, C.lane); }
}
__device__ __forceinline__ void zero_rows(Ctx& C, bf16_t* WT, int ldt, int drow0, int dk0, int nrows, int ncols) {
    const int per = ncols / 8, items = nrows * per;
    int g0 = C.gw - C.rot; if (g0 < 0) g0 += C.ngw; C.rot = (C.rot + (items + 63) / 64) % C.ngw;
    for (int it = g0 * 64 + C.lane; it < items; it += C.ngw * 64) { const int r = it / per, c = it - r * per; *(u32x4*)(WT + (size_t)(drow0 + r) * ldt + dk0 + c * 8) = (u32x4){0u, 0u, 0u, 0u}; }
}
__device__ __forceinline__ void phase_wconv_early(Ctx& C, int l) {
    LAS float* scr = (LAS float*)(C.lds + C.wave * 16384);
    unsigned char* ws = C.ws;
    const float* win = INP(7) + (size_t)l * 1024 * INC;
    bf16_t* WT1 = (bf16_t*)(ws + W_WT1);
    conv_rows(C, win, INC, 1024, 0, WT1, 1024, 0, 0, 1024, scr);
    conv_rows_rope(C, win, INC, 1024, 2048, WT1, 1024, 1024, 1024, scr);
    conv_rows_rope(C, win, INC, 1024, 3072, WT1, 1024, 2048, 1024, scr);
    conv_rows(C, win, INC, 1024, 4096, WT1, 1024, 3072, 0, 1024, scr);
    conv_rows(C, win, INC, 1024, 6144, WT1, 1024, 4096, 0, 704, scr);
    zero_rows(C, WT1, 1024, 4800, 0, 64, 1024);
    const float* wq = INP(18) + (size_t)l * 384 * 1536; bf16_t* WTQ = (bf16_t*)(ws + W_WTQ);
    for (int h = 0; h < 8; ++h) { conv_rows(C, wq, 1536, 384, h * 192, WTQ, 384, h * 128, 0, 128, scr); conv_rows(C, wq, 1536, 384, h * 192 + 128, WTQ, 384, 1024 + h * 64, 0, 64, scr); }
    const float* wkv = INP(20) + (size_t)l * 256 * 2048; bf16_t* WTKV = (bf16_t*)(ws + W_WTKV);
    for (int h = 0; h < 8; ++h) { conv_rows(C, wkv, 2048, 256, h * 256, WTKV, 256, h * 128, 0, 128, scr); conv_rows(C, wkv, 2048, 256, h * 256 + 128, WTKV, 256, 1024 + h * 128, 0, 128, scr); }
    bf16_t* WTL = (bf16_t*)(ws + W_WTL);
    for (int d = 0; d < 2; ++d) for (int n = 0; n < 8; ++n) for (int mat = 0; mat < 2; ++mat) {
        const float* w = INP(mat == 0 ? 10 : 12) + ((size_t)(l * 2 + d) * 8 + n) * 128 * 128;
        const int drow0 = d * 2048 + n * 256 + mat * 128;
        conv_rows(C, w, 128, 128, 0, WTL, 256, drow0, (n & 1) * 128, 128, scr);
        zero_rows(C, WTL, 256, drow0, ((n & 1) ^ 1) * 128, 128, 128);
    }
}
__device__ __forceinline__ void phase_wconv_late(Ctx& C, int l) {
    LAS float* scr = (LAS float*)(C.lds + C.wave * 16384);
    unsigned char* ws = C.ws;
    const float* win = INP(7) + (size_t)l * 1024 * INC;
    bf16_t* WTG = (bf16_t*)(ws + W_WTG);
    conv_rows(C, win, INC, 1024, 1024, WTG, 1024, 0, 0, 1024, scr);
    conv_rows(C, win, INC, 1024, 5120, WTG, 1024, 1024, 0, 1024, scr);
    conv_rows(C, win, INC, 1024, 6848, WTG, 1024, 2048, 0, 1024, scr);
    conv_rows(C, win, INC, 1024, 7872, (bf16_t*)(ws + W_WTGM), 1024, 0, 0, 3072, scr);
    for (int i = 0; i < 3; ++i) conv_rows(C, INP(25 + i) + (size_t)l * 1024 * 1024, 1024, 1024, 0, (bf16_t*)(ws + W_WTD) + (size_t)i * 1024 * 1024, 1024, 0, 0, 1024, scr);
    conv_rows(C, INP(28) + (size_t)l * 1024 * 1024, 1024, 1024, 0, (bf16_t*)(ws + W_WTO), 1024, 0, 0, 1024, scr);
}

__device__ __forceinline__ void phase_h(Ctx& C, int l, bf16_t* H) {
    const float* gain = INP(6) + l * 1024;
    for (int m = C.gw; m < MR; m += C.ngw) {
        const int b = m / SS, s = m - b * SS, r = (s < LC) ? 4 : b;
        const float* xr = resid_row(C, l, m);
        const float* mod = C.ctl + CT_MOD + (l * 5 + r) * 3072;
        f32x4 v[4]; float ss = 0.f;
#pragma unroll
        for (int j = 0; j < 4; ++j) { v[j] = *(const f32x4*)(xr + 4 * C.lane + 256 * j); ss += (v[j].x * v[j].x + v[j].y * v[j].y) + (v[j].z * v[j].z + v[j].w * v[j].w); }
        const float rstd = RSQ(wave_sum(ss) * (1.f / 1024.f) + EPS);
#pragma unroll
        for (int j = 0; j < 4; ++j) { const int c = 4 * C.lane + 256 * j;
            const f32x4 g = *(const f32x4*)(gain + c), sh = *(const f32x4*)(mod + c), sc = *(const f32x4*)(mod + 1024 + c);
            const f32x4 y = (v[j] * rstd) * g;
            const f32x4 o = y * (sc + 1.0f) + sh;
            u32x2 w; w.x = pk2(o.x, o.y); w.y = pk2(o.z, o.w);
            *(u32x2*)(H + (size_t)m * 1024 + c) = w; }
    }
}

using pg8::Unit;
struct ProbPlain {
    const bf16_t* A; const bf16_t* Bt; int lda, ldb, K;
    __device__ __forceinline__ void get(const Unit& u, const char*& a, const char*& b, int& lda_) const {
        a = (const char*)(A + (size_t)u.pm * 256 * lda); b = (const char*)(Bt + (size_t)u.pn * 256 * ldb); lda_ = lda; }
};
struct ProbLru {
    const bf16_t* A; const bf16_t* Bt; int ldb, K;
    __device__ __forceinline__ void get(const Unit& u, const char*& a, const char*& b, int& lda_) const {
        a = (const char*)(A + (size_t)u.pm * 256 * 1024 + (u.pn >> 1) * 256); b = (const char*)(Bt + (size_t)u.pn * 256 * 256); lda_ = 1024; }
};
struct ProbD {
    unsigned char* ws; int ldb, K;
    __device__ __forceinline__ void get(const Unit& u, const char*& a, const char*& b, int& lda_) const {
        const int i = (u.z & 7) >> 1;
        if ((u.z & 1) == 0) { a = (const char*)(ws + AR_MD + (size_t)u.pm * 256 * 1024 * 2); b = (const char*)(ws + W_WTGM + ((size_t)i * 1024 + u.pn * 256) * 1024 * 2); lda_ = 1024; }
        else { const size_t yo = (i == 0) ? AR_XA : (i == 1) ? AR_YB : AR_QN;
            a = (const char*)(ws + yo + (size_t)u.pm * 256 * 1024 * 2); b = (const char*)(ws + W_WTD + ((size_t)i * 1024 + u.pn * 256) * 1024 * 2); lda_ = 1024; }
    }
};

#define EPI_ARGS const f32x4 (&acc)[2][2][4][2], const Unit& u, int wr, int wc, int fr, int fq
template <size_t O0, int L0, size_t O1, int L1, size_t O2, int L2, int T1, int T2>
struct EpiStore3 {
    static constexpr bool PERM = true;
    unsigned char* ws;
    __device__ __forceinline__ void operator()(EPI_ARGS) const {
        bf16_t* bs; int ldc, ct;
        size_t off;
        if (u.pn < T1) { off = O0; ldc = L0; ct = u.pn; } else if (u.pn < T2) { off = O1; ldc = L1; ct = u.pn - T1; } else { off = O2; ldc = L2; ct = u.pn - T2; }
        bs = (bf16_t*)(ws + off);
        const int row0 = u.pm * 256 + wr * 64 + fr, col0 = ct * 256 + wc * 32 + 8 * fq;
#pragma unroll
        for (int ai = 0; ai < 2; ++ai)
#pragma unroll
            for (int m = 0; m < 4; ++m) { bf16_t* rowp = bs + (size_t)(row0 + ai * 128 + m * 16) * ldc + col0;
#pragma unroll
                for (int bj = 0; bj < 2; ++bj) { const f32x4 v0 = acc[ai][bj][m][0], v1 = acc[ai][bj][m][1];
                    u32x4 w; w.x = pg8::cvt_pk_bf16(v0[0], v0[1]); w.y = pg8::cvt_pk_bf16(v0[2], v0[3]); w.z = pg8::cvt_pk_bf16(v1[0], v1[1]); w.w = pg8::cvt_pk_bf16(v1[2], v1[3]);
                    *(u32x4*)(rowp + bj * 128) = w; } }
    }
};
struct EpiG1 {
    static constexpr bool PERM = true;
    unsigned char* ws; const float* cs;
    __device__ __forceinline__ void operator()(EPI_ARGS) const {
        bf16_t* bs; int ldc, ct;
        if (u.pn < 4) { bs = (bf16_t*)(ws + AR_XA); ldc = 1024; ct = u.pn; } else if (u.pn < 16) { bs = (bf16_t*)(ws + AR_RQKV); ldc = 3072; ct = u.pn - 4; } else { bs = (bf16_t*)(ws + AR_MD); ldc = 768; ct = u.pn - 16; }
        const int row0 = u.pm * 256 + wr * 64 + fr, col0 = ct * 256 + wc * 32 + 8 * fq;
        const bool rope = (u.pn >= 4) && (u.pn < 12), iskey = (u.pn >= 8);
        const int bq = u.pm / 17, s0 = (u.pm - bq * 17) * 256 + wr * 64 + fr;
        const int f0 = (wc * 4 + fq) * 4;
#pragma unroll
        for (int ai = 0; ai < 2; ++ai)
#pragma unroll
            for (int m = 0; m < 4; ++m) { bf16_t* rowp = bs + (size_t)(row0 + ai * 128 + m * 16) * ldc + col0;
                const int s = s0 + ai * 128 + m * 16, t = s - LC; const bool lat = s >= LC;
#pragma unroll
                for (int bj = 0; bj < 2; ++bj) { f32x4 v0 = acc[ai][bj][m][0], v1 = acc[ai][bj][m][1];
                    if (rope) {
                        if (lat) { const int pos = bj ? (t & 63) : (t >> 6); const f32x4 c = *(const f32x4*)(cs + pos * 64 + f0), sn = *(const f32x4*)(cs + 4096 + pos * 64 + f0);
                            const f32x4 a = v0 * c - v1 * sn, b = v1 * c + v0 * sn; v0 = a; v1 = b; }
                        if (iskey) { v0 = v0 * 0.0625f; v1 = v1 * 0.0625f; } }
                    u32x4 w; w.x = pg8::cvt_pk_bf16(v0[0], v0[1]); w.y = pg8::cvt_pk_bf16(v0[2], v0[3]); w.z = pg8::cvt_pk_bf16(v1[0], v1[1]); w.w = pg8::cvt_pk_bf16(v1[2], v1[3]);
                    *(u32x4*)(rowp + bj * 128) = w; }
                asm volatile("" ::: "memory"); }
    }
};
typedef f16_t f16x8 __attribute__((ext_vector_type(8)));
struct EpiLru {
    static constexpr bool PERM = true;
    const bf16_t* U; f16_t* RI; const float* ba; const float* bx; const float* sp;
    __device__ __forceinline__ void operator()(EPI_ARGS) const {
        const int row0 = u.pm * 256 + wr * 64 + fr, ch0 = u.pn * 128 + wc * 32 + 8 * fq;
        float bav[8], bxv[8], spv[8];
#pragma unroll
        for (int e = 0; e < 8; ++e) { bav[e] = ba[ch0 + e]; bxv[e] = bx[ch0 + e]; spv[e] = sp[ch0 + e] * (-8.f); }
#pragma unroll
        for (int ai = 0; ai < 2; ++ai)
#pragma unroll
            for (int m = 0; m < 4; ++m) { const int row = row0 + ai * 128 + m * 16;
                const u32x4 uw = *(const u32x4*)(U + (size_t)row * 1024 + ch0);
                float uv[8] = {lo_bf(uw.x), hi_bf(uw.x), lo_bf(uw.y), hi_bf(uw.y), lo_bf(uw.z), hi_bf(uw.z), lo_bf(uw.w), hi_bf(uw.w)};
                f16x8 la, bc;
#pragma unroll
                for (int e = 0; e < 8; ++e) { const float rp = acc[ai][0][m][e >> 2][e & 3] + bav[e], ip = acc[ai][1][m][e >> 2][e & 3] + bxv[e];
                    const float r = sigmoidf_(rp), ig = sigmoidf_(ip);
                    const float loga = r * spv[e];
                    const float bb = SQRT(fmaxf(-expm1f(2.f * loga), 0.f)) * (ig * uv[e]);
                    la[e] = (f16_t)(loga * LOG2E); bc[e] = (f16_t)bb; }
                *(f16x8*)(RI + (size_t)row * 2048 + ch0) = la; *(f16x8*)(RI + (size_t)row * 2048 + 1024 + ch0) = bc;
                asm volatile("" ::: "memory"); }
    }
};
struct EpiGate {
    static constexpr bool PERM = true;
    unsigned char* ws;
    __device__ __forceinline__ void operator()(EPI_ARGS) const {
        const int br = u.pn >> 2; const size_t yo = (br == 0) ? AR_XA : (br == 1) ? AR_YB : AR_QN; bf16_t* bs = (bf16_t*)(ws + yo); const int ldc = 1024;
        const int row0 = u.pm * 256 + wr * 64 + fr, col0 = (u.pn & 3) * 256 + wc * 32 + 8 * fq;
#pragma unroll
        for (int ai = 0; ai < 2; ++ai)
#pragma unroll
            for (int m = 0; m < 4; ++m) { bf16_t* rowp = bs + (size_t)(row0 + ai * 128 + m * 16) * ldc + col0;
#pragma unroll
                for (int bj = 0; bj < 2; ++bj) { const f32x4 v0 = acc[ai][bj][m][0], v1 = acc[ai][bj][m][1];
                    const u32x4 y = *(const u32x4*)(rowp + bj * 128);
                    u32x4 w; w.x = pg8::cvt_pk_bf16(lo_bf(y.x) * siluf_(v0[0]), hi_bf(y.x) * siluf_(v0[1])); w.y = pg8::cvt_pk_bf16(lo_bf(y.y) * siluf_(v0[2]), hi_bf(y.y) * siluf_(v0[3]));
                    w.z = pg8::cvt_pk_bf16(lo_bf(y.z) * siluf_(v1[0]), hi_bf(y.z) * siluf_(v1[1])); w.w = pg8::cvt_pk_bf16(lo_bf(y.w) * siluf_(v1[2]), hi_bf(y.w) * siluf_(v1[3]));
                    *(u32x4*)(rowp + bj * 128) = w; }
                asm volatile("" ::: "memory"); }
    }
};
struct EpiD {
    static constexpr bool PERM = true;
    bf16_t* Z; unsigned char* gs; bf16_t* ZP;
    __device__ __forceinline__ void operator()(EPI_ARGS) const {
        const int col0 = u.pn * 256 + wc * 32 + 8 * fq, i = (u.z & 7) >> 1; const bool part = u.z >= 8;
        const int row0 = part ? ((u.pm / 17) * 256 + wr * 64 + fr) : (u.pm * 256 + wr * 64 + fr);
        bf16_t* const zb = part ? (ZP + (size_t)i * 1024 * 1024) : Z;
        const unsigned tq = (unsigned)(((wr * 4 + wc) * 64 + fq * 16 + fr) * 64);
        if ((u.z & 1) == 0) {
#pragma unroll
            for (int ai = 0; ai < 2; ++ai)
#pragma unroll
                for (int m = 0; m < 4; ++m)
#pragma unroll
                    for (int bj = 0; bj < 2; ++bj) { const f32x4 v0 = acc[ai][bj][m][0], v1 = acc[ai][bj][m][1];
                        u32x4 w; w.x = pg8::cvt_pk_bf16(sigmoidf_(v0[0]), sigmoidf_(v0[1])); w.y = pg8::cvt_pk_bf16(sigmoidf_(v0[2]), sigmoidf_(v0[3]));
                        w.z = pg8::cvt_pk_bf16(sigmoidf_(v1[0]), sigmoidf_(v1[1])); w.w = pg8::cvt_pk_bf16(sigmoidf_(v1[2]), sigmoidf_(v1[3]));
                        *(u32x4*)(gs + (((ai * 4 + m) * 2 + bj) >> 2) * 32768 + tq + (((ai * 4 + m) * 2 + bj) & 3) * 16) = w; }
        } else {
#pragma unroll
            for (int ai = 0; ai < 2; ++ai)
#pragma unroll
                for (int m = 0; m < 4; ++m) { bf16_t* zrow = zb + (size_t)(row0 + ai * 128 + m * 16) * 1024 + col0;
#pragma unroll
                    for (int bj = 0; bj < 2; ++bj) { const f32x4 v0 = acc[ai][bj][m][0], v1 = acc[ai][bj][m][1];
                        const u32x4 g = *(const u32x4*)(gs + (((ai * 4 + m) * 2 + bj) >> 2) * 32768 + tq + (((ai * 4 + m) * 2 + bj) & 3) * 16); bf16_t* zp = zrow + bj * 128;
                        float o0 = lo_bf(g.x) * v0[0], o1 = hi_bf(g.x) * v0[1], o2 = lo_bf(g.y) * v0[2], o3 = hi_bf(g.y) * v0[3], o4 = lo_bf(g.z) * v1[0], o5 = hi_bf(g.z) * v1[1], o6 = lo_bf(g.w) * v1[2], o7 = hi_bf(g.w) * v1[3];
                        if (i > 0 && !part) { const u32x4 zo = *(const u32x4*)zp; o0 += lo_bf(zo.x); o1 += hi_bf(zo.x); o2 += lo_bf(zo.y); o3 += hi_bf(zo.y); o4 += lo_bf(zo.z); o5 += hi_bf(zo.z); o6 += lo_bf(zo.w); o7 += hi_bf(zo.w); }
                        u32x4 w; w.x = pg8::cvt_pk_bf16(o0, o1); w.y = pg8::cvt_pk_bf16(o2, o3); w.z = pg8::cvt_pk_bf16(o4, o5); w.w = pg8::cvt_pk_bf16(o6, o7); *(u32x4*)zp = w; }
                    asm volatile("" ::: "memory"); }
        }
    }
};
struct EpiOut {
    static constexpr bool PERM = false;
    const float* xlat; const float* xctx; float* olat; float* octx; const float* mod;
    __device__ __forceinline__ void operator()(EPI_ARGS) const {
        const int b = u.pm / 17, isctx = (u.pm - b * 17) == 0;
        const float* gate = mod + (isctx ? 4 : b) * 3072 + 2048;
        const int col0 = u.pn * 256 + wc * 32 + 4 * fq;
        f32x4 gv[2][2];
#pragma unroll
        for (int bj = 0; bj < 2; ++bj)
#pragma unroll
            for (int n = 0; n < 2; ++n) gv[bj][n] = *(const f32x4*)(gate + col0 + bj * 128 + n * 16);
#pragma unroll
        for (int ai = 0; ai < 2; ++ai)
#pragma unroll
            for (int m = 0; m < 4; ++m) { const int s = (u.pm - b * 17) * 256 + ai * 128 + wr * 64 + m * 16 + fr;
                const size_t off = isctx ? ((size_t)(b * LC + s) * 1024 + col0) : ((size_t)(b * TT + (s - LC)) * 1024 + col0);
                const float* xin = isctx ? xctx : xlat; float* xo = isctx ? octx : olat;
#pragma unroll
                for (int bj = 0; bj < 2; ++bj)
#pragma unroll
                    for (int n = 0; n < 2; ++n) { const f32x4 xv = *(const f32x4*)(xin + off + bj * 128 + n * 16);
                        *(f32x4*)(xo + off + bj * 128 + n * 16) = xv + gv[bj][n] * acc[ai][bj][m][n]; }
                asm volatile("" ::: "memory"); }
    }
};

__device__ __forceinline__ void phase_ret_rope(Ctx& C, bf16_t* RQKV) {
    const float* cs = C.ctl + CT_ROPER; const float* sn = cs + 4096;
    for (int m = C.gw; m < MR; m += C.ngw) {
        const int b = m / SS, s = m - b * SS; const bool lat = s >= LC; const int t = s - LC, prow = lat ? (t >> 6) : 0, pcol = lat ? (t & 63) : 0;
        bf16_t* row = RQKV + (size_t)m * 3072;
#pragma unroll
        for (int j = 0; j < 16; ++j) {
            const int idx = j * 64 + C.lane, f = idx & 63, half = (idx >> 6) & 1, h = (idx >> 7) & 3, tz = idx >> 9;
            bf16_t* p = row + tz * 1024 + h * 256 + half * 128 + f;
            const float x1 = bf2f(p[0]), x2 = bf2f(p[64]);
            float o1 = x1, o2 = x2;
            if (lat) { const int pos = half ? pcol : prow; const float c = cs[pos * 64 + f], sv = sn[pos * 64 + f]; o1 = x1 * c - x2 * sv; o2 = x2 * c + x1 * sv; }
            if (tz) { o1 *= 0.0625f; o2 *= 0.0625f; }
            p[0] = (bf16_t)f2bf(o1); p[64] = (bf16_t)f2bf(o2);
        }
    }
}

#define RS_STEP(o, cnt, st) do { const bool up_ = (C.lane & (st)) != 0; _Pragma("unroll") for (int e_ = 0; e_ < (cnt) / 2; ++e_) { \
        const float send_ = up_ ? o[e_] : o[e_ + (cnt) / 2]; const float keep_ = up_ ? o[e_ + (cnt) / 2] : o[e_]; o[e_] = keep_ + __shfl_xor(send_, (st)); } } while (0)

__device__ __forceinline__ void phase_ret_naive(Ctx& C, int l, const bf16_t* RQKV, bf16_t* OI) {
    LAS unsigned char* qs = C.lds + C.wave * 512;
    const int nbu = (MR / 8) * 16;
    for (int bu = C.bid; bu < nbu; bu += C.G) {
        const int hq = bu & 15, h = hq >> 2, qd = hq & 3, n = (bu >> 4) * 8 + C.wave;
        const int b = n / SS, sn_ = n - b * SS;
        const float lgf = C.ctl[CT_LG + (l * 2 + 0) * 4 + h], lgb = C.ctl[CT_LG + (l * 2 + 1) * 4 + h];
        const int pfn = sn_, pbn = (sn_ < LC) ? (LC - 1 - sn_) : (SS + LC - 1 - sn_);
        asm volatile("s_waitcnt lgkmcnt(0)" ::: "memory");
        *(LAS u32x2*)(qs + C.lane * 8) = *(const u32x2*)(RQKV + (size_t)n * 3072 + h * 256 + C.lane * 4);
        asm volatile("s_waitcnt lgkmcnt(0)" ::: "memory");
        float o[64];
#pragma unroll
        for (int e = 0; e < 64; ++e) o[e] = 0.f;
        for (int sm = C.lane; sm < SS; sm += 64) {
            const bf16_t* krow = RQKV + (size_t)(b * SS + sm) * 3072 + 1024 + h * 256;
            float dot = 0.f;
#pragma unroll 4
            for (int c = 0; c < 32; ++c) { const u32x4 kv = *(const u32x4*)(krow + c * 8); const u32x4 qv = *(const LAS u32x4*)(qs + c * 16);
                dot += lo_bf(kv.x) * lo_bf(qv.x) + hi_bf(kv.x) * hi_bf(qv.x) + lo_bf(kv.y) * lo_bf(qv.y) + hi_bf(kv.y) * hi_bf(qv.y)
                     + lo_bf(kv.z) * lo_bf(qv.z) + hi_bf(kv.z) * hi_bf(qv.z) + lo_bf(kv.w) * lo_bf(qv.w) + hi_bf(kv.w) * hi_bf(qv.w); }
            const int pfm = sm, pbm = (sm < LC) ? (LC - 1 - sm) : (SS + LC - 1 - sm);
            float w = 0.f;
            if (pfn >= pfm) w += EX2(lgf * (float)(pfn - pfm));
            if (pbn >= pbm) w += EX2(lgb * (float)(pbn - pbm));
            const float ws_ = w * dot;
            const bf16_t* vrow = krow + 1024 + qd * 64;
#pragma unroll
            for (int c = 0; c < 8; ++c) { const u32x4 vv = *(const u32x4*)(vrow + c * 8);
                o[c * 8 + 0] += ws_ * lo_bf(vv.x); o[c * 8 + 1] += ws_ * hi_bf(vv.x); o[c * 8 + 2] += ws_ * lo_bf(vv.y); o[c * 8 + 3] += ws_ * hi_bf(vv.y);
                o[c * 8 + 4] += ws_ * lo_bf(vv.z); o[c * 8 + 5] += ws_ * hi_bf(vv.z); o[c * 8 + 6] += ws_ * lo_bf(vv.w); o[c * 8 + 7] += ws_ * hi_bf(vv.w); }
        }
        RS_STEP(o, 64, 32); RS_STEP(o, 32, 16); RS_STEP(o, 16, 8); RS_STEP(o, 8, 4); RS_STEP(o, 4, 2); RS_STEP(o, 2, 1);
        OI[(size_t)n * 1024 + h * 256 + qd * 64 + C.lane] = (bf16_t)f2bf(o[0]);
    }
}
__device__ __forceinline__ void phase_ret_ln(Ctx& C, int l, bf16_t* OI) {
    const float* gain = INP(16) + l * 1024;
    for (int m = C.gw; m < MR; m += C.ngw) {
#pragma unroll
        for (int h = 0; h < 4; ++h) { bf16_t* p = OI + (size_t)m * 1024 + h * 256 + C.lane * 4;
            const u32x2 w = *(const u32x2*)p; float x0 = lo_bf(w.x), x1 = hi_bf(w.x), x2 = lo_bf(w.y), x3 = hi_bf(w.y);
            const float mean = wave_sum((x0 + x1) + (x2 + x3)) * (1.f / 256.f);
            x0 -= mean; x1 -= mean; x2 -= mean; x3 -= mean;
            const float var = wave_sum((x0 * x0 + x1 * x1) + (x2 * x2 + x3 * x3)) * (1.f / 256.f);
            const float rstd = RSQ(var + EPS);
            const f32x4 g = *(const f32x4*)(gain + h * 256 + C.lane * 4);
            u32x2 o; o.x = pk2(x0 * rstd * g.x, x1 * rstd * g.y); o.y = pk2(x2 * rstd * g.z, x3 * rstd * g.w); *(u32x2*)p = o; }
    }
}

__device__ __forceinline__ void phase_md_post(Ctx& C, int l, bf16_t* MD) {
    const float* qn = INP(17) + l * 384; const float* kvn = INP(19) + l * 256; const float* gkr = INP(24) + l * 64;
    const float* cs = C.ctl + CT_ROPEM; const float* sn = cs + 1024;
    for (int m = C.gw; m < MR; m += C.ngw) {
        const int b = m / SS, s = m - b * SS; const bool lat = s >= LC; const int t = s - LC;
        bf16_t* row = MD + (size_t)m * 768;
        {   float x[6]; float ss = 0.f;
#pragma unroll
            for (int j = 0; j < 3; ++j) { const unsigned w = *(const unsigned*)(row + 2 * C.lane + 128 * j); x[2 * j] = lo_bf(w); x[2 * j + 1] = hi_bf(w); ss += x[2 * j] * x[2 * j] + x[2 * j + 1] * x[2 * j + 1]; }
            const float rstd = RSQ(wave_sum(ss) * (1.f / 384.f) + EPS);
#pragma unroll
            for (int j = 0; j < 3; ++j) { const int c = 2 * C.lane + 128 * j; *(unsigned*)(row + c) = pk2(x[2 * j] * rstd * qn[c], x[2 * j + 1] * rstd * qn[c + 1]); } }
        {   float x[4]; float ss = 0.f;
#pragma unroll
            for (int j = 0; j < 2; ++j) { const unsigned w = *(const unsigned*)(row + 384 + 2 * C.lane + 128 * j); x[2 * j] = lo_bf(w); x[2 * j + 1] = hi_bf(w); ss += x[2 * j] * x[2 * j] + x[2 * j + 1] * x[2 * j + 1]; }
            const float rstd = RSQ(wave_sum(ss) * (1.f / 256.f) + EPS);
#pragma unroll
            for (int j = 0; j < 2; ++j) { const int c = 2 * C.lane + 128 * j; *(unsigned*)(row + 384 + c) = pk2(x[2 * j] * rstd * kvn[c], x[2 * j + 1] * rstd * kvn[c + 1]); } }
        {   const float x = bf2f(row[640 + C.lane]);
            const float rstd = RSQ(wave_sum(x * x) * (1.f / 64.f) + EPS);
            float y = x * rstd * gkr[C.lane];
            if (lat) { const float pr = __shfl_xor(y, 16); const float rot = (C.lane & 16) ? pr : -pr; const int f = C.lane & 15, pos = (C.lane < 32) ? (t >> 6) : (t & 63);
                y = y * cs[pos * 16 + f] + rot * sn[pos * 16 + f]; }
            row[640 + C.lane] = (bf16_t)f2bf(y); }
    }
}
__device__ __forceinline__ void phase_qk_post(Ctx& C, int l, bf16_t* QN, bf16_t* QP, bf16_t* KV) {
    const float* gqn = INP(21) + l * 128; const float* gqr = INP(22) + l * 64; const float* gkn = INP(23) + l * 128;
    const float* cs = C.ctl + CT_ROPEM; const float* sn = cs + 1024;
    for (int m = C.gw; m < MR; m += C.ngw) {
        const int b = m / SS, s = m - b * SS; const bool lat = s >= LC; const int t = s - LC;
        bf16_t* qrow = QN + (size_t)m * 1024; bf16_t* prow = QP + (size_t)m * 512; bf16_t* krow = KV + (size_t)m * 2048;
#pragma unroll
        for (int h = 0; h < 8; ++h) {
            {   unsigned* p = (unsigned*)(qrow + h * 128 + 2 * C.lane); const unsigned w = *p; const float x0 = lo_bf(w), x1 = hi_bf(w);
                const float rstd = RSQ(wave_sum(x0 * x0 + x1 * x1) * (1.f / 128.f) + EPS);
                *p = pk2(x0 * rstd * gqn[2 * C.lane] * QSCALE, x1 * rstd * gqn[2 * C.lane + 1] * QSCALE); }
            {   bf16_t* p = prow + h * 64 + C.lane; const float x = bf2f(*p);
                const float rstd = RSQ(wave_sum(x * x) * (1.f / 64.f) + EPS);
                float y = x * rstd * gqr[C.lane];
                if (lat) { const float pr = __shfl_xor(y, 16); const float rot = (C.lane & 16) ? pr : -pr; const int f = C.lane & 15, pos = (C.lane < 32) ? (t >> 6) : (t & 63);
                    y = y * cs[pos * 16 + f] + rot * sn[pos * 16 + f]; }
                *p = (bf16_t)f2bf(y * QSCALE); }
            {   unsigned* p = (unsigned*)(krow + h * 128 + 2 * C.lane); const unsigned w = *p; const float x0 = lo_bf(w), x1 = hi_bf(w);
                const float rstd = RSQ(wave_sum(x0 * x0 + x1 * x1) * (1.f / 128.f) + EPS);
                *p = pk2(x0 * rstd * gkn[2 * C.lane], x1 * rstd * gkn[2 * C.lane + 1]); }
        }
    }
}

__device__ __forceinline__ void phase_attn_naive(Ctx& C, bool with_ctx, bf16_t* QN, const bf16_t* QP, const bf16_t* KV, const bf16_t* MD) {
    LAS unsigned char* qs = C.lds + C.wave * 512;
    const int nlat = NB * 8 * (TT / 8), nctx = with_ctx ? NB * 8 * (LC / 8) : 0;
    for (int bu = C.bid; bu < nlat + nctx; bu += C.G) {
        int b, h, s, nkeys;
        if (bu < nlat) { const int tb = bu % (TT / 8), bh = bu / (TT / 8); b = bh >> 3; h = bh & 7; s = LC + tb * 8 + C.wave; nkeys = SS; }
        else { const int r = bu - nlat, tb = r % (LC / 8), bh = r / (LC / 8); b = bh >> 3; h = bh & 7; s = tb * 8 + C.wave; nkeys = LC; }
        const size_t m = (size_t)b * SS + s;
        asm volatile("s_waitcnt lgkmcnt(0)" ::: "memory");
        if (C.lane < 32) *(LAS u32x2*)(qs + C.lane * 8) = *(const u32x2*)(QN + m * 1024 + h * 128 + C.lane * 4);
        else if (C.lane < 48) *(LAS u32x2*)(qs + 256 + (C.lane - 32) * 8) = *(const u32x2*)(QP + m * 512 + h * 64 + (C.lane - 32) * 4);
        asm volatile("s_waitcnt lgkmcnt(0)" ::: "memory");
        float o[128];
#pragma unroll
        for (int e = 0; e < 128; ++e) o[e] = 0.f;
        float mrun = -1e30f, lrun = 0.f;
        for (int key = C.lane; key < nkeys; key += 64) {
            const size_t kr = (size_t)b * SS + key;
            const bf16_t* kn = KV + kr * 2048 + h * 128; const bf16_t* kro = MD + kr * 768 + 640;
            float dot = 0.f;
#pragma unroll 4
            for (int c = 0; c < 16; ++c) { const u32x4 kv = *(const u32x4*)(kn + c * 8); const u32x4 qv = *(const LAS u32x4*)(qs + c * 16);
                dot += lo_bf(kv.x) * lo_bf(qv.x) + hi_bf(kv.x) * hi_bf(qv.x) + lo_bf(kv.y) * lo_bf(qv.y) + hi_bf(kv.y) * hi_bf(qv.y)
                     + lo_bf(kv.z) * lo_bf(qv.z) + hi_bf(kv.z) * hi_bf(qv.z) + lo_bf(kv.w) * lo_bf(qv.w) + hi_bf(kv.w) * hi_bf(qv.w); }
#pragma unroll 4
            for (int c = 0; c < 8; ++c) { const u32x4 kv = *(const u32x4*)(kro + c * 8); const u32x4 qv = *(const LAS u32x4*)(qs + 256 + c * 16);
                dot += lo_bf(kv.x) * lo_bf(qv.x) + hi_bf(kv.x) * hi_bf(qv.x) + lo_bf(kv.y) * lo_bf(qv.y) + hi_bf(kv.y) * hi_bf(qv.y)
                     + lo_bf(kv.z) * lo_bf(qv.z) + hi_bf(kv.z) * hi_bf(qv.z) + lo_bf(kv.w) * lo_bf(qv.w) + hi_bf(kv.w) * hi_bf(qv.w); }
            const float mnew = fmaxf(mrun, dot), alpha = EX2(mrun - mnew), p = EX2(dot - mnew);
            lrun = lrun * alpha + p; mrun = mnew;
            const bf16_t* vrow = KV + kr * 2048 + 1024 + h * 128;
#pragma unroll
            for (int c = 0; c < 16; ++c) { const u32x4 vv = *(const u32x4*)(vrow + c * 8);
                o[c * 8 + 0] = o[c * 8 + 0] * alpha + p * lo_bf(vv.x); o[c * 8 + 1] = o[c * 8 + 1] * alpha + p * hi_bf(vv.x);
                o[c * 8 + 2] = o[c * 8 + 2] * alpha + p * lo_bf(vv.y); o[c * 8 + 3] = o[c * 8 + 3] * alpha + p * hi_bf(vv.y);
                o[c * 8 + 4] = o[c * 8 + 4] * alpha + p * lo_bf(vv.z); o[c * 8 + 5] = o[c * 8 + 5] * alpha + p * hi_bf(vv.z);
                o[c * 8 + 6] = o[c * 8 + 6] * alpha + p * lo_bf(vv.w); o[c * 8 + 7] = o[c * 8 + 7] * alpha + p * hi_bf(vv.w); }
        }
        const float mall = wave_max(mrun), fsc = EX2(mrun - mall);
        const float lall = wave_sum(lrun * fsc);
#pragma unroll
        for (int e = 0; e < 128; ++e) o[e] *= fsc;
        RS_STEP(o, 128, 32); RS_STEP(o, 64, 16); RS_STEP(o, 32, 8); RS_STEP(o, 16, 4); RS_STEP(o, 8, 2); RS_STEP(o, 4, 1);
        const float inv = 1.f / lall;
        *(unsigned*)(QN + m * 1024 + h * 128 + 2 * C.lane) = pk2(o[0] * inv, o[1] * inv);
    }
}

__device__ __forceinline__ void phase_conv(Ctx& C, int l, const bf16_t* XA, bf16_t* U) {
    const float* cw = INP(8) + l * 4 * 1024; const float* cb = INP(9) + l * 1024;
    const int gt = C.bid * NTHR + C.tid, ngt = C.G * NTHR;
    for (int it = gt; it < MR * 128; it += ngt) {
        const int m = it >> 7, c0 = (it & 127) * 8, b = m / SS, s = m - b * SS;
        const int lo = (s < LC) ? 0 : LC, hi = (s < LC) ? LC : SS;
        float a[8];
#pragma unroll
        for (int e = 0; e < 8; ++e) a[e] = cb[c0 + e];
#pragma unroll
        for (int j = 0; j < 4; ++j) { const int sj = s + j - 2;
            if (sj >= lo && sj < hi) { const u32x4 xv = *(const u32x4*)(XA + (size_t)(b * SS + sj) * 1024 + c0); const float* w = cw + j * 1024 + c0;
                a[0] += w[0] * lo_bf(xv.x); a[1] += w[1] * hi_bf(xv.x); a[2] += w[2] * lo_bf(xv.y); a[3] += w[3] * hi_bf(xv.y);
                a[4] += w[4] * lo_bf(xv.z); a[5] += w[5] * hi_bf(xv.z); a[6] += w[6] * lo_bf(xv.w); a[7] += w[7] * hi_bf(xv.w); } }
        u32x4 o; o.x = pk2(a[0], a[1]); o.y = pk2(a[2], a[3]); o.z = pk2(a[4], a[5]); o.w = pk2(a[6], a[7]);
        *(u32x4*)(U + (size_t)m * 1024 + c0) = o;
    }
}
typedef f16_t f16x2 __attribute__((ext_vector_type(2)));
__device__ __forceinline__ void phase_scan1(Ctx& C, int d, const f16_t* RI, float* SUM) {
    for (int un = C.gw; un < NB * 68 * 8; un += C.ngw) {
        const int cg_ = un & 7, sg = (un >> 3) % 68, b = (un >> 3) / 68, ch = cg_ * 128 + 2 * C.lane;
        float A0 = 1.f, A1 = 1.f, H0 = 0.f, H1 = 0.f;
        const f16_t* base = RI + (size_t)(b * SS + sg * 64) * 2048 + ch;
#pragma unroll 16
        for (int i = 0; i < 64; ++i) { const int r = d ? (63 - i) : i;
            const f16x2 la = *(const f16x2*)(base + (size_t)r * 2048), bc = *(const f16x2*)(base + (size_t)r * 2048 + 1024);
            const float a0 = EX2((float)la[0]), a1 = EX2((float)la[1]);
            H0 = a0 * H0 + (float)bc[0]; H1 = a1 * H1 + (float)bc[1]; A0 *= a0; A1 *= a1; }
        float* sp = SUM + ((size_t)(b * 68 + sg) * 1024 + ch) * 2;
        *(f32x4*)sp = (f32x4){A0, H0, A1, H1};
    }
}
__device__ __forceinline__ void phase_scan3(Ctx& C, int d, const f16_t* RI, const float* SUM, bf16_t* YA) {
    for (int un = C.gw; un < NB * 68 * 8; un += C.ngw) {
        const int cg_ = un & 7, sg = (un >> 3) % 68, b = (un >> 3) / 68, ch = cg_ * 128 + 2 * C.lane;
        float H0 = 0.f, H1 = 0.f;
        const int npre = d ? ((sg < 4) ? (3 - sg) : (71 - sg)) : sg;
#pragma unroll 4
        for (int p = 0; p < npre; ++p) { const int ps = d ? ((p < 4) ? (3 - p) : (71 - p)) : p;
            const f32x4 v = *(const f32x4*)(SUM + ((size_t)(b * 68 + ps) * 1024 + ch) * 2);
            H0 = v[0] * H0 + v[1]; H1 = v[2] * H1 + v[3]; }
        const f16_t* base = RI + (size_t)(b * SS + sg * 64) * 2048 + ch;
        bf16_t* yb = YA + (size_t)(b * SS + sg * 64) * 1024 + ch;
#pragma unroll 16
        for (int i = 0; i < 64; ++i) { const int r = d ? (63 - i) : i;
            const f16x2 la = *(const f16x2*)(base + (size_t)r * 2048), bc = *(const f16x2*)(base + (size_t)r * 2048 + 1024);
            const float a0 = EX2((float)la[0]), a1 = EX2((float)la[1]);
            H0 = a0 * H0 + (float)bc[0]; H1 = a1 * H1 + (float)bc[1];
            unsigned* yp = (unsigned*)(yb + (size_t)r * 1024);
            if (d == 0) *yp = pk2(H0, H1); else { const unsigned w = *yp; *yp = pk2(lo_bf(w) + H0, hi_bf(w) + H1); } }
    }
}

typedef float f32x16 __attribute__((ext_vector_type(16)));
typedef short v4i16_t __attribute__((ext_vector_type(4)));
constexpr int AT_KP = 400, AT_VP = 320;
constexpr int AT_KB = 64 * AT_KP, AT_VB = 64 * AT_VP, AT_STG = AT_KB + AT_VB, AT_WSF = 2 * AT_STG;
__device__ __forceinline__ int crow(int r, int hi) { return (r & 3) + 8 * (r >> 2) + 4 * hi; }
__device__ __forceinline__ bf16x8 pack8(float a, float b, float c, float d, float e, float f, float g, float h) {
    u32x4 w; w.x = pg8::cvt_pk_bf16(a, b); w.y = pg8::cvt_pk_bf16(c, d); w.z = pg8::cvt_pk_bf16(e, f); w.w = pg8::cvt_pk_bf16(g, h); return __builtin_bit_cast(bf16x8, w); }
__device__ __forceinline__ bf16x8 tr2(LAS unsigned char* p0, LAS unsigned char* p1) {
    const v4i16_t lo = __builtin_amdgcn_ds_read_tr16_b64_v4i16((LAS v4i16_t*)p0), hi = __builtin_amdgcn_ds_read_tr16_b64_v4i16((LAS v4i16_t*)p1);
    return (bf16x8){lo[0], lo[1], lo[2], lo[3], hi[0], hi[1], hi[2], hi[3]}; }

__device__ __forceinline__ void phase_attn(Ctx& C, bool with_ctx, bf16_t* QN, const bf16_t* QP, const bf16_t* KV, const bf16_t* MD) {
    const int lane = C.lane, r32 = lane & 31, hi = lane >> 5, wave = C.wave, tid = C.tid;
    LAS unsigned char* lds = C.lds;
    LAS float* wsf = (LAS float*)(lds + AT_WSF + wave * 128);
    const int nunits = 512 + (with_ctx ? 32 : 0);
    const int rowA = tid >> 4, ccA = tid & 15, rowR = tid >> 3, ccR = tid & 7;
    const int i16 = lane & 15, q4 = i16 >> 2, p4 = i16 & 3, g1 = (lane >> 4) & 1;
    const int vb = AT_KB + (4 * hi + q4) * AT_VP + (16 * g1 + 4 * p4) * 2;
    for (int un = C.bid; un < nunits; un += C.G) {
        int bh, qb, isctx;
        if (un < 512) { const int x = un & 7, jj = un >> 3; bh = x * 4 + (jj >> 4); qb = jj & 15; isctx = 0; } else { bh = un - 512; qb = 0; isctx = 1; }
        const int b = bh >> 3, h = bh & 7;
        const size_t kb0 = (size_t)b * SS;
        const size_t m0 = kb0 + (isctx ? 0 : LC + qb * 256) + wave * 32;
        const int NT = (isctx ? LC : SS) / 64;
        bf16x8 qf[12];
        {   const bf16_t* qn = QN + (m0 + r32) * 1024 + h * 128 + hi * 8; const bf16_t* qp = QP + (m0 + r32) * 512 + h * 64 + hi * 8;
#pragma unroll
            for (int s = 0; s < 8; ++s) qf[s] = *(const bf16x8*)(qn + s * 16);
#pragma unroll
            for (int s = 0; s < 4; ++s) qf[8 + s] = *(const bf16x8*)(qp + s * 16); }
        f32x16 o[4];
#pragma unroll
        for (int d = 0; d < 4; ++d)
#pragma unroll
            for (int r = 0; r < 16; ++r) o[d][r] = 0.f;
        float mrun = -1e30f, lrun = 0.f;
        u32x4 kn0, kn1, kr0, vv0, vv1;
        const unsigned kvo = (unsigned)(((kb0 + rowA) * 2048 + h * 128 + ccA * 8) * 2);
        const unsigned kro = (unsigned)(((kb0 + rowR) * 768 + 640 + ccR * 8) * 2);
#define AT_LOAD(t) do { const char* kp_ = (const char*)KV + (size_t)(t) * (64 * 2048 * 2); kn0 = *(const u32x4*)(kp_ + kvo); kn1 = *(const u32x4*)(kp_ + 32 * 2048 * 2 + kvo); vv0 = *(const u32x4*)(kp_ + 1024 * 2 + kvo); vv1 = *(const u32x4*)(kp_ + (32 * 2048 + 1024) * 2 + kvo); \
        kr0 = *(const u32x4*)((const char*)MD + (size_t)(t) * (64 * 768 * 2) + kro); } while (0)
#define AT_WRITE(sb) do { LAS unsigned char* s_ = lds + (sb); *(LAS u32x4*)(s_ + rowA * AT_KP + ccA * 16) = kn0; *(LAS u32x4*)(s_ + (rowA + 32) * AT_KP + ccA * 16) = kn1; \
        *(LAS u32x4*)(s_ + rowR * AT_KP + 256 + ccR * 16) = kr0; *(LAS u32x4*)(s_ + AT_KB + rowA * AT_VP + ccA * 16) = vv0; *(LAS u32x4*)(s_ + AT_KB + (rowA + 32) * AT_VP + ccA * 16) = vv1; } while (0)
#define AT_QK(sbv) do { _Pragma("unroll") for (int r = 0; r < 16; ++r) { p0[r] = 0.f; p1[r] = 0.f; } \
        LAS unsigned char* ka = lds + (sbv) + r32 * AT_KP + hi * 16; __builtin_amdgcn_s_setprio(1); \
        _Pragma("unroll") for (int s = 0; s < 12; ++s) { const bf16x8 a0 = *(const LAS bf16x8*)(ka + s * 32), a1 = *(const LAS bf16x8*)(ka + 32 * AT_KP + s * 32); \
            p0 = __builtin_amdgcn_mfma_f32_32x32x16_bf16(a0, qf[s], p0, 0, 0, 0); p1 = __builtin_amdgcn_mfma_f32_32x32x16_bf16(a1, qf[s], p1, 0, 0, 0); \
            if ((s & 3) == 3) asm volatile("" ::: "memory"); } \
        __builtin_amdgcn_s_setprio(0); } while (0)
#define AT_SM() do { float rm = fmaxf(p0[0], p1[0]); \
        _Pragma("unroll") for (int r = 1; r < 16; ++r) rm = fmaxf(rm, fmaxf(p0[r], p1[r])); \
        rm = fmaxf(rm, __shfl_xor(rm, 32)); \
        if (__any(rm > mrun + 8.f)) { const float mnew = fmaxf(mrun, rm), alpha = EX2(mrun - mnew); mrun = mnew; lrun *= alpha; \
            if (hi == 0) wsf[r32] = alpha; \
            _Pragma("unroll") for (int r = 0; r < 16; ++r) { const float a = wsf[crow(r, hi)]; _Pragma("unroll") for (int d = 0; d < 4; ++d) o[d][r] *= a; } } \
        float ls = 0.f; \
        _Pragma("unroll") for (int r = 0; r < 16; ++r) { p0[r] = EX2(p0[r] - mrun); p1[r] = EX2(p1[r] - mrun); ls += p0[r] + p1[r]; } \
        lrun += ls; \
        pa0 = pack8(p0[0], p0[1], p0[2], p0[3], p0[4], p0[5], p0[6], p0[7]); pa1 = pack8(p0[8], p0[9], p0[10], p0[11], p0[12], p0[13], p0[14], p0[15]); \
        pa2 = pack8(p1[0], p1[1], p1[2], p1[3], p1[4], p1[5], p1[6], p1[7]); pa3 = pack8(p1[8], p1[9], p1[10], p1[11], p1[12], p1[13], p1[14], p1[15]); } while (0)
#define AT_PV(sbv) do { LAS unsigned char* vp = lds + (sbv) + vb; __builtin_amdgcn_s_setprio(1); \
        _Pragma("unroll") for (int d = 0; d < 4; ++d) { \
            o[d] = __builtin_amdgcn_mfma_f32_32x32x16_bf16(pa0, tr2(vp + d * 64, vp + d * 64 + 8 * AT_VP), o[d], 0, 0, 0); \
            o[d] = __builtin_amdgcn_mfma_f32_32x32x16_bf16(pa1, tr2(vp + d * 64 + 16 * AT_VP, vp + d * 64 + 24 * AT_VP), o[d], 0, 0, 0); \
            o[d] = __builtin_amdgcn_mfma_f32_32x32x16_bf16(pa2, tr2(vp + d * 64 + 32 * AT_VP, vp + d * 64 + 40 * AT_VP), o[d], 0, 0, 0); \
            o[d] = __builtin_amdgcn_mfma_f32_32x32x16_bf16(pa3, tr2(vp + d * 64 + 48 * AT_VP, vp + d * 64 + 56 * AT_VP), o[d], 0, 0, 0); \
            asm volatile("" ::: "memory"); } \
        __builtin_amdgcn_s_setprio(0); } while (0)
        AT_LOAD(0); AT_WRITE(0);
        __syncthreads();
        bf16x8 pa0, pa1, pa2, pa3;
        if (wave < 4) {
            for (int t = 0; t < NT; ++t) {
                const int sb = (t & 1) * AT_STG;
                if (t + 1 < NT) AT_LOAD(t + 1);
                f32x16 p0, p1;
                AT_QK(sb);
                __syncthreads();
                if (t + 1 < NT) AT_WRITE(AT_STG - sb);
                AT_SM(); AT_PV(sb);
                __syncthreads();
            }
            __syncthreads(); __syncthreads();
        } else {
            for (int t = 0; t <= NT; ++t) {
                const int sb = (t & 1) * AT_STG;
                if (t + 1 < NT) AT_LOAD(t + 1);
                if (t > 0) AT_PV(AT_STG - sb);
                __syncthreads();
                if (t + 1 < NT) AT_WRITE(AT_STG - sb);
                if (t < NT) { f32x16 p0, p1; AT_QK(sb); AT_SM(); }
                __syncthreads();
            }
        }
#undef AT_QK
#undef AT_SM
#undef AT_PV
#undef AT_LOAD
#undef AT_WRITE
        const float ltot = lrun + __shfl_xor(lrun, 32);
        if (hi == 0) wsf[r32] = 1.f / ltot;
        bf16_t* op = QN + (m0 + 4 * hi) * 1024 + h * 128 + r32;
#pragma unroll
        for (int r = 0; r < 16; ++r) { const float inv = wsf[crow(r, hi)];
#pragma unroll
            for (int d = 0; d < 4; ++d) op[d * 32] = (bf16_t)f2bf(o[d][r] * inv);
            op += ((r & 3) == 3) ? 5 * 1024 : 1024; asm volatile("" : "+v"(op)); }
        __syncthreads();
    }
}

constexpr int RI_KP = 528, RI_VP = 576, RI_PTP = 272;
constexpr int RI_A = 0, RI_PT = 128 * RI_VP;
__device__ __forceinline__ void phase_ret_intra(Ctx& C, int l, const bf16_t* RQKV, bf16_t* OI) {
    const int lane = C.lane, r32 = lane & 31, hi = lane >> 5, wave = C.wave, tid = C.tid;
    LAS unsigned char* lds = C.lds;
    const int i16 = lane & 15, q4 = i16 >> 2, p4 = i16 & 3, g1 = (lane >> 4) & 1;
    const int nb = wave & 3, wh = wave >> 2;
    const int srow = tid >> 5, scc = tid & 31;
    for (int un = C.bid; un < NB * 4 * 34; un += C.G) {
        const int c = un % 34, bh = un / 34, b = bh >> 2, h = bh & 3;
        const size_t row0 = (size_t)b * SS + c * 128;
        const float lgf = C.ctl[CT_LG + (l * 2 + 0) * 4 + h], lgb = C.ctl[CT_LG + (l * 2 + 1) * 4 + h];
        const bf16_t* gk = RQKV + (row0 + srow) * 3072 + 1024 + h * 256 + scc * 8;
        u32x4 st[8];
        {   const bf16_t* gp = gk;
#pragma unroll
            for (int j = 0; j < 8; ++j) { st[j] = *(const u32x4*)gp; gp += 16 * 3072; asm volatile("" : "+v"(gp)); } }
#pragma unroll
        for (int j = 0; j < 8; ++j) *(LAS u32x4*)(lds + RI_A + (srow + 16 * j) * RI_KP + scc * 16) = st[j];
        __syncthreads();
        {   const bf16_t* gp = gk + 1024;
#pragma unroll
            for (int j = 0; j < 8; ++j) { st[j] = *(const u32x4*)gp; gp += 16 * 3072; asm volatile("" : "+v"(gp)); } }
        {
            f32x16 x0, x1;
#pragma unroll
            for (int r = 0; r < 16; ++r) { x0[r] = 0.f; x1[r] = 0.f; }
            const bf16_t* gq = RQKV + (row0 + nb * 32 + r32) * 3072 + h * 256 + hi * 8;
            LAS unsigned char* ka = lds + RI_A + (wh * 64 + r32) * RI_KP + hi * 16;
#pragma unroll
            for (int s = 0; s < 16; ++s) { const bf16x8 qf = *(const bf16x8*)(gq + s * 16);
                const bf16x8 a0 = *(const LAS bf16x8*)(ka + s * 32), a1 = *(const LAS bf16x8*)(ka + 32 * RI_KP + s * 32);
                x0 = __builtin_amdgcn_mfma_f32_32x32x16_bf16(a0, qf, x0, 0, 0, 0); x1 = __builtin_amdgcn_mfma_f32_32x32x16_bf16(a1, qf, x1, 0, 0, 0);
                if ((s & 3) == 3) asm volatile("" ::: "memory"); }
            const int n = nb * 32 + r32;
            LAS unsigned char* pt = lds + RI_PT + n * RI_PTP + (wh * 64 + 4 * hi) * 2;
#pragma unroll
            for (int g = 0; g < 4; ++g) { float w0[4], w1[4];
#pragma unroll
                for (int e = 0; e < 4; ++e) { const int m0 = wh * 64 + 8 * g + 4 * hi + e; const float d0 = (float)(n - m0), d1 = d0 - 32.f;
                    const float f0 = EX2(lgf * fmaxf(d0, 0.f)) * fminf(fmaxf(d0 + 1.f, 0.f), 1.f) + EX2(lgb * fmaxf(-d0, 0.f)) * fminf(fmaxf(1.f - d0, 0.f), 1.f);
                    const float f1 = EX2(lgf * fmaxf(d1, 0.f)) * fminf(fmaxf(d1 + 1.f, 0.f), 1.f) + EX2(lgb * fmaxf(-d1, 0.f)) * fminf(fmaxf(1.f - d1, 0.f), 1.f);
                    w0[e] = x0[4 * g + e] * f0; w1[e] = x1[4 * g + e] * f1; }
                u32x2 o0, o1; o0.x = pg8::cvt_pk_bf16(w0[0], w0[1]); o0.y = pg8::cvt_pk_bf16(w0[2], w0[3]); o1.x = pg8::cvt_pk_bf16(w1[0], w1[1]); o1.y = pg8::cvt_pk_bf16(w1[2], w1[3]);
                *(LAS u32x2*)(pt + g * 16) = o0; *(LAS u32x2*)(pt + 64 + g * 16) = o1; }
        }
        __syncthreads();
#pragma unroll
        for (int j = 0; j < 8; ++j) *(LAS u32x4*)(lds + RI_A + (srow + 16 * j) * RI_VP + scc * 16) = st[j];
        __syncthreads();
        {
            f32x16 o[4];
#pragma unroll
            for (int d = 0; d < 4; ++d)
#pragma unroll
                for (int r = 0; r < 16; ++r) o[d][r] = 0.f;
            bf16x8 pa[8];
            LAS unsigned char* pr = lds + RI_PT + (nb * 32 + r32) * RI_PTP + hi * 16;
#pragma unroll
            for (int s = 0; s < 8; ++s) pa[s] = *(const LAS bf16x8*)(pr + s * 32);
            LAS unsigned char* vp = lds + RI_A + (8 * hi + q4) * RI_VP + (wh * 128 + 16 * g1 + 4 * p4) * 2;
#pragma unroll
            for (int d = 0; d < 4; ++d) {
#pragma unroll
                for (int s = 0; s < 8; ++s) o[d] = __builtin_amdgcn_mfma_f32_32x32x16_bf16(pa[s], tr2(vp + d * 64 + s * 16 * RI_VP, vp + d * 64 + (s * 16 + 4) * RI_VP), o[d], 0, 0, 0);
                asm volatile("" ::: "memory"); }
            bf16_t* op = OI + (row0 + nb * 32 + 4 * hi) * 1024 + h * 256 + wh * 128 + r32;
#pragma unroll
            for (int r = 0; r < 16; ++r) {
#pragma unroll
                for (int d = 0; d < 4; ++d) op[d * 32] = (bf16_t)f2bf(o[d][r]);
                op += ((r & 3) == 3) ? 5 * 1024 : 1024; asm volatile("" : "+v"(op)); }
        }
        __syncthreads();
    }
}

constexpr int RC_KT = 0, RC_KTP = 576, RC_VT = 128 * 576, RC_VTP = 64, RC_ST = RC_VT + 128 * 64, RC_STP = 528, RC_XO = RC_ST + 32 * 528, RC_END = RC_XO + 16384;
static_assert(RC_END <= 131072, "R-chain LDS");
__device__ __forceinline__ void phase_ret_chain(Ctx& C, int l, const bf16_t* RQKV, bf16_t* OI, bf16_t* OB) {
    const int lane = C.lane, r32 = lane & 31, hi = lane >> 5, wave = C.wave, tid = C.tid;
    LAS unsigned char* lds = C.lds;
    const int i16 = lane & 15, q4 = i16 >> 2, p4 = i16 & 3, g1 = (lane >> 4) & 1;
    const int nb = wave & 3, dh = wave >> 2;
    const int srow = tid >> 5, scc = tid & 31, vrow = tid >> 2, vcc = tid & 3;
    for (int un = C.bid; un < 256; un += C.G) {
        const int x = un & 7, j8 = un >> 3, bhd = x * 4 + (j8 >> 3), sl = j8 & 7, b = bhd >> 3, h = (bhd >> 1) & 3, dir = bhd & 1;
        const float lg = C.ctl[CT_LG + (l * 2 + dir) * 4 + h];
        const float cdec = EX2(lg * 128.f);
        const float vdec = dir ? EX2(lg * (float)vrow) : EX2(lg * (float)(127 - vrow));
        f32x16 sacc;
#pragma unroll
        for (int r = 0; r < 16; ++r) sacc[r] = 0.f;
        for (int i = tid; i < 32 * RC_STP / 16; i += NTHR) *(LAS u32x4*)(lds + RC_ST + i * 16) = (u32x4){0u, 0u, 0u, 0u};
        u32x4 st[8]; u32x4 sv;
#define RC_LOAD(cc_) do { const size_t r0_ = (size_t)b * SS + (cc_) * 128; const bf16_t* gk_ = RQKV + (r0_ + srow) * 3072 + 1024 + h * 256 + scc * 8; \
        _Pragma("unroll") for (int j = 0; j < 8; ++j) { st[j] = *(const u32x4*)gk_; gk_ += 16 * 3072; asm volatile("" : "+v"(gk_)); } \
        sv = *(const u32x4*)(RQKV + (r0_ + vrow) * 3072 + 2048 + h * 256 + sl * 32 + vcc * 8); } while (0)
#define RC_WRITE() do { _Pragma("unroll") for (int j = 0; j < 8; ++j) *(LAS u32x4*)(lds + RC_KT + (srow + 16 * j) * RC_KTP + scc * 16) = st[j]; \
        u32x4 w_; w_.x = pg8::cvt_pk_bf16(lo_bf(sv.x) * vdec, hi_bf(sv.x) * vdec); w_.y = pg8::cvt_pk_bf16(lo_bf(sv.y) * vdec, hi_bf(sv.y) * vdec); \
        w_.z = pg8::cvt_pk_bf16(lo_bf(sv.z) * vdec, hi_bf(sv.z) * vdec); w_.w = pg8::cvt_pk_bf16(lo_bf(sv.w) * vdec, hi_bf(sv.w) * vdec); \
        *(LAS u32x4*)(lds + RC_VT + vrow * RC_VTP + vcc * 16) = w_; } while (0)
        bf16x8 qa[8];
#define RC_QLOAD(dst, cc_) do { const bf16_t* gq_ = RQKV + ((size_t)b * SS + (cc_) * 128 + nb * 32 + r32) * 3072 + h * 256 + dh * 128 + hi * 8; \
        _Pragma("unroll") for (int s = 0; s < 8; ++s) dst[s] = *(const bf16x8*)(gq_ + s * 16); } while (0)
        {   const int c0 = dir ? 1 : 0, c1 = dir ? 0 : 1; RC_LOAD(c0); RC_WRITE(); RC_QLOAD(qa, c0); RC_LOAD(c1); }
        __syncthreads();
        for (int i = 0; i < 34; ++i) {
            const int c = dir ? ((i < 2) ? (1 - i) : (35 - i)) : i;
            const size_t r0 = (size_t)b * SS + c * 128;
            const int cn = (i + 1 < 34) ? (dir ? ((i + 1 < 2) ? (1 - (i + 1)) : (35 - (i + 1))) : (i + 1)) : c;
            unsigned short oiv[16];
            if (dh == 0 && dir == 0) { const bf16_t* ip = OI + (r0 + nb * 32 + 4 * hi) * 1024 + h * 256 + sl * 32 + r32;
#pragma unroll
                for (int r = 0; r < 16; ++r) oiv[r] = ip[(size_t)((r & 3) + 8 * (r >> 2)) * 1024]; }
            f32x16 oacc;
#pragma unroll
            for (int r = 0; r < 16; ++r) oacc[r] = 0.f;
            {   LAS unsigned char* sb = lds + RC_ST + r32 * RC_STP + (dh * 128 + hi * 8) * 2;
#pragma unroll
                for (int s = 0; s < 8; ++s) { const bf16x8 sbf = *(const LAS bf16x8*)(sb + s * 32);
                    oacc = __builtin_amdgcn_mfma_f32_32x32x16_bf16(qa[s], sbf, oacc, 0, 0, 0); } }
            asm volatile("" ::: "memory");
            RC_QLOAD(qa, cn);
#pragma unroll
            for (int r = 0; r < 16; ++r) sacc[r] *= cdec;
            {   LAS unsigned char* kp = lds + RC_KT + (8 * hi + q4) * RC_KTP + (wave * 32 + 16 * g1 + 4 * p4) * 2;
                LAS unsigned char* vp = lds + RC_VT + (8 * hi + q4) * RC_VTP + (16 * g1 + 4 * p4) * 2;
#pragma unroll
                for (int s = 0; s < 8; ++s) sacc = __builtin_amdgcn_mfma_f32_32x32x16_bf16(tr2(kp + s * 16 * RC_KTP, kp + (s * 16 + 4) * RC_KTP), tr2(vp + s * 16 * RC_VTP, vp + (s * 16 + 4) * RC_VTP), sacc, 0, 0, 0); }
            if (dh == 1) {
#pragma unroll
                for (int r = 0; r < 16; ++r) *(LAS float*)(lds + RC_XO + nb * 4096 + r * 256 + lane * 4) = oacc[r]; }
            __syncthreads();
            if (dh == 0) {
                bf16_t* op = (dir ? OB : OI) + (r0 + nb * 32 + 4 * hi) * 1024 + h * 256 + sl * 32 + r32;
#pragma unroll
                for (int r = 0; r < 16; ++r) { const int n = nb * 32 + crow(r, hi);
                    const float qd = dir ? EX2(lg * (float)(128 - n)) : EX2(lg * (float)(n + 1));
                    float v = (oacc[r] + *(const LAS float*)(lds + RC_XO + nb * 4096 + r * 256 + lane * 4)) * qd;
                    if (dir == 0) v += bf2f(oiv[r]);
                    *op = (bf16_t)f2bf(v);
                    op += ((r & 3) == 3) ? 5 * 1024 : 1024; asm volatile("" : "+v"(op)); }
            }
            {   LAS unsigned char* sp = lds + RC_ST + r32 * RC_STP + (wave * 32 + 4 * hi) * 2;
#pragma unroll
                for (int g = 0; g < 4; ++g) { u32x2 o2; o2.x = pg8::cvt_pk_bf16(sacc[4 * g], sacc[4 * g + 1]); o2.y = pg8::cvt_pk_bf16(sacc[4 * g + 2], sacc[4 * g + 3]); *(LAS u32x2*)(sp + g * 16) = o2; } }
            if (i + 1 < 34) RC_WRITE();
            if (i + 2 < 34) { const int c2 = dir ? ((i + 2 < 2) ? (1 - (i + 2)) : (35 - (i + 2))) : (i + 2); RC_LOAD(c2); }
            __syncthreads();
        }
#undef RC_QLOAD
#undef RC_LOAD
#undef RC_WRITE
    }
}
__device__ __forceinline__ void phase_ret_ln2(Ctx& C, int l, bf16_t* OI, const bf16_t* OB) {
    const float* gain = INP(16) + l * 1024;
    for (int m = C.gw; m < MR; m += C.ngw) {
#pragma unroll
        for (int h = 0; h < 4; ++h) { bf16_t* p = OI + (size_t)m * 1024 + h * 256 + C.lane * 4;
            const u32x2 w = *(const u32x2*)p, w2 = *(const u32x2*)(OB + (size_t)m * 1024 + h * 256 + C.lane * 4);
            float x0 = lo_bf(w.x) + lo_bf(w2.x), x1 = hi_bf(w.x) + hi_bf(w2.x), x2 = lo_bf(w.y) + lo_bf(w2.y), x3 = hi_bf(w.y) + hi_bf(w2.y);
            const float mean = wave_sum((x0 + x1) + (x2 + x3)) * (1.f / 256.f);
            x0 -= mean; x1 -= mean; x2 -= mean; x3 -= mean;
            const float var = wave_sum((x0 * x0 + x1 * x1) + (x2 * x2 + x3 * x3)) * (1.f / 256.f);
            const float rstd = RSQ(var + EPS);
            const f32x4 g = *(const f32x4*)(gain + h * 256 + C.lane * 4);
            u32x2 o; o.x = pk2(x0 * rstd * g.x, x1 * rstd * g.y); o.y = pk2(x2 * rstd * g.z, x3 * rstd * g.w); *(u32x2*)p = o; }
    }
}

template <int W> __device__ __forceinline__ float group_sum(float v) {
#pragma unroll
    for (int o = 1; o < W; o <<= 1) v += __shfl_xor(v, o);
    return v;
}
__device__ __forceinline__ void unpack8(const u32x4& w, float (&x)[8]) { x[0] = lo_bf(w.x); x[1] = hi_bf(w.x); x[2] = lo_bf(w.y); x[3] = hi_bf(w.y); x[4] = lo_bf(w.z); x[5] = hi_bf(w.z); x[6] = lo_bf(w.w); x[7] = hi_bf(w.w); }
__device__ __forceinline__ u32x4 pack8u(const float (&x)[8]) { u32x4 w; w.x = pk2(x[0], x[1]); w.y = pk2(x[2], x[3]); w.z = pk2(x[4], x[5]); w.w = pk2(x[6], x[7]); return w; }
__device__ __forceinline__ float sumsq8(const float (&x)[8]) { return ((x[0] * x[0] + x[1] * x[1]) + (x[2] * x[2] + x[3] * x[3])) + ((x[4] * x[4] + x[5] * x[5]) + (x[6] * x[6] + x[7] * x[7])); }

__device__ __forceinline__ void phase_h2(Ctx& C, int l, bf16_t* H) {
    const float* gain = INP(6) + l * 1024;
    for (int m0 = C.gw * 2; m0 < MR; m0 += C.ngw * 2) {
        f32x4 v[2][4]; float ss[2];
#pragma unroll
        for (int q = 0; q < 2; ++q) { const float* xr = resid_row(C, l, m0 + q);
#pragma unroll
            for (int j = 0; j < 4; ++j) v[q][j] = *(const f32x4*)(xr + 4 * C.lane + 256 * j); }
        const int b = m0 / SS, s = m0 - b * SS, r = (s < LC) ? 4 : b;
        const float* mod = C.ctl + CT_MOD + (l * 5 + r) * 3072;
#pragma unroll
        for (int q = 0; q < 2; ++q) { float a = 0.f;
#pragma unroll
            for (int j = 0; j < 4; ++j) a += (v[q][j].x * v[q][j].x + v[q][j].y * v[q][j].y) + (v[q][j].z * v[q][j].z + v[q][j].w * v[q][j].w);
            ss[q] = a; }
        ss[0] = wave_sum(ss[0]); ss[1] = wave_sum(ss[1]);
#pragma unroll
        for (int j = 0; j < 4; ++j) { const int c = 4 * C.lane + 256 * j;
            const f32x4 g = *(const f32x4*)(gain + c), sh = *(const f32x4*)(mod + c), sc = *(const f32x4*)(mod + 1024 + c) + 1.0f;
#pragma unroll
            for (int q = 0; q < 2; ++q) { const float rstd = RSQ(ss[q] * (1.f / 1024.f) + EPS);
                const f32x4 o = ((v[q][j] * rstd) * g) * sc + sh;
                u32x2 w; w.x = pk2(o.x, o.y); w.y = pk2(o.z, o.w);
                *(u32x2*)(H + (size_t)(m0 + q) * 1024 + c) = w; } }
    }
}
__device__ __forceinline__ void phase_md_post2(Ctx& C, int l, bf16_t* MD) {
    const float* qn = INP(17) + l * 384; const float* kvn = INP(19) + l * 256; const float* gkr = INP(24) + l * 64;
    const float* cs = C.ctl + CT_ROPEM; const float* sn = cs + 1024;
    const int L = C.lane;
    for (int m0 = C.gw * 2; m0 < MR; m0 += C.ngw * 2) {
        u32x4 w0[2], w1[2];
#pragma unroll
        for (int q = 0; q < 2; ++q) { const bf16_t* row = MD + (size_t)(m0 + q) * 768; w0[q] = *(const u32x4*)(row + 8 * L); w1[q] = (L < 32) ? *(const u32x4*)(row + 512 + 8 * L) : (u32x4){0u, 0u, 0u, 0u}; }
#pragma unroll
        for (int q = 0; q < 2; ++q) { const int m = m0 + q, b = m / SS, s = m - b * SS; const bool lat = s >= LC; const int t = s - LC;
            bf16_t* row = MD + (size_t)m * 768;
            float x0[8], x1[8]; unpack8(w0[q], x0); unpack8(w1[q], x1);
            const float s0 = sumsq8(x0), s1 = sumsq8(x1);
            const float sq = wave_sum(L < 48 ? s0 : 0.f), skv = wave_sum((L >= 48 ? s0 : 0.f) + (L < 16 ? s1 : 0.f)), skr = wave_sum((L >= 16 && L < 24) ? s1 : 0.f);
            const float rq = RSQ(sq * (1.f / 384.f) + EPS), rkv = RSQ(skv * (1.f / 256.f) + EPS), rkr = RSQ(skr * (1.f / 64.f) + EPS);
            {   const float* g = (L < 48) ? (qn + 8 * L) : (kvn + 8 * (L - 48)); const float rs = (L < 48) ? rq : rkv;
#pragma unroll
                for (int e = 0; e < 8; ++e) x0[e] *= rs * g[e];
                *(u32x4*)(row + 8 * L) = pack8u(x0); }
            if (L < 16) {
#pragma unroll
                for (int e = 0; e < 8; ++e) x1[e] *= rkv * kvn[128 + 8 * L + e];
            } else if (L < 24) {
#pragma unroll
                for (int e = 0; e < 8; ++e) x1[e] *= rkr * gkr[8 * (L - 16) + e];
            }
            float pr[8];
#pragma unroll
            for (int e = 0; e < 8; ++e) pr[e] = __shfl_xor(x1[e], 2);
            if (lat && L >= 16 && L < 24) { const int qt = (L - 16) >> 1, f0 = ((L - 16) & 1) * 8, pos = (qt < 2) ? (t >> 6) : (t & 63); const float sg = (qt & 1) ? 1.f : -1.f;
#pragma unroll
                for (int e = 0; e < 8; ++e) x1[e] = x1[e] * cs[pos * 16 + f0 + e] + sg * pr[e] * sn[pos * 16 + f0 + e]; }
            if (L < 24) *(u32x4*)(row + 512 + 8 * L) = pack8u(x1);
        }
    }
}
__device__ __forceinline__ void phase_qk_post2(Ctx& C, int l, bf16_t* QN, bf16_t* QP, bf16_t* KV) {
    const float* gqn = INP(21) + l * 128; const float* gqr = INP(22) + l * 64; const float* gkn = INP(23) + l * 128;
    const float* cs = C.ctl + CT_ROPEM; const float* sn = cs + 1024;
    const int L = C.lane;
    for (int m0 = C.gw * 2; m0 < MR; m0 += C.ngw * 2) {
        u32x4 a[2][2], k[2][2], p[2];
#pragma unroll
        for (int q = 0; q < 2; ++q) { const size_t m = m0 + q;
            a[q][0] = *(const u32x4*)(QN + m * 1024 + 8 * L); a[q][1] = *(const u32x4*)(QN + m * 1024 + 512 + 8 * L);
            k[q][0] = *(const u32x4*)(KV + m * 2048 + 8 * L); k[q][1] = *(const u32x4*)(KV + m * 2048 + 512 + 8 * L);
            p[q] = *(const u32x4*)(QP + m * 512 + 8 * L); }
#pragma unroll
        for (int q = 0; q < 2; ++q) { const int m = m0 + q, b = m / SS, s = m - b * SS; const bool lat = s >= LC; const int t = s - LC;
#pragma unroll
            for (int c = 0; c < 2; ++c) {
                float x[8]; unpack8(a[q][c], x);
                const float rs = RSQ(group_sum<16>(sumsq8(x)) * (1.f / 128.f) + EPS) * QSCALE;
#pragma unroll
                for (int e = 0; e < 8; ++e) x[e] *= rs * gqn[8 * (L & 15) + e];
                *(u32x4*)(QN + (size_t)m * 1024 + c * 512 + 8 * L) = pack8u(x);
                float y[8]; unpack8(k[q][c], y);
                const float rk = RSQ(group_sum<16>(sumsq8(y)) * (1.f / 128.f) + EPS);
#pragma unroll
                for (int e = 0; e < 8; ++e) y[e] *= rk * gkn[8 * (L & 15) + e];
                *(u32x4*)(KV + (size_t)m * 2048 + c * 512 + 8 * L) = pack8u(y); }
            {   float x[8]; unpack8(p[q], x);
                const float rs = RSQ(group_sum<8>(sumsq8(x)) * (1.f / 64.f) + EPS);
#pragma unroll
                for (int e = 0; e < 8; ++e) x[e] *= rs * gqr[8 * (L & 7) + e];
                float pr[8];
#pragma unroll
                for (int e = 0; e < 8; ++e) pr[e] = __shfl_xor(x[e], 2);
                if (lat) { const int qt = (L >> 1) & 3, f0 = (L & 1) * 8, pos = (qt < 2) ? (t >> 6) : (t & 63); const float sg = (qt & 1) ? 1.f : -1.f;
#pragma unroll
                    for (int e = 0; e < 8; ++e) x[e] = x[e] * cs[pos * 16 + f0 + e] + sg * pr[e] * sn[pos * 16 + f0 + e]; }
#pragma unroll
                for (int e = 0; e < 8; ++e) x[e] *= QSCALE;
                *(u32x4*)(QP + (size_t)m * 512 + 8 * L) = pack8u(x); }
        }
    }
}
__device__ __forceinline__ void phase_ret_ln3(Ctx& C, int l, bf16_t* OI, const bf16_t* OB) {
    const float* gain = INP(16) + l * 1024;
    const int L = C.lane;
    for (int m0 = C.gw * 2; m0 < MR; m0 += C.ngw * 2) {
        u32x4 a[2][2], bb[2][2];
#pragma unroll
        for (int q = 0; q < 2; ++q)
#pragma unroll
            for (int c = 0; c < 2; ++c) { a[q][c] = *(const u32x4*)(OI + (size_t)(m0 + q) * 1024 + c * 512 + 8 * L); bb[q][c] = *(const u32x4*)(OB + (size_t)(m0 + q) * 1024 + c * 512 + 8 * L); }
#pragma unroll
        for (int q = 0; q < 2; ++q)
#pragma unroll
            for (int c = 0; c < 2; ++c) { float x[8], y[8]; unpack8(a[q][c], x); unpack8(bb[q][c], y);
                float s = 0.f;
#pragma unroll
                for (int e = 0; e < 8; ++e) { x[e] += y[e]; s += x[e]; }
                const float mean = group_sum<32>(s) * (1.f / 256.f);
                float v = 0.f;
#pragma unroll
                for (int e = 0; e < 8; ++e) { x[e] -= mean; v += x[e] * x[e]; }
                const float rstd = RSQ(group_sum<32>(v) * (1.f / 256.f) + EPS);
#pragma unroll
                for (int e = 0; e < 8; ++e) x[e] *= rstd * gain[c * 512 + 8 * L + e];
                *(u32x4*)(OI + (size_t)(m0 + q) * 1024 + c * 512 + 8 * L) = pack8u(x); }
    }
}

__device__ __forceinline__ void phase_zsum(Ctx& C, const bf16_t* ZP, bf16_t* Z) {
    const int gt = C.bid * NTHR + C.tid, ngt = C.G * NTHR;
    for (int it = gt; it < 1024 * 128; it += ngt) { const int r = it >> 7, c0 = (it & 127) * 8, b = r >> 8, s = r & 255;
        const u32x4 a = *(const u32x4*)(ZP + (size_t)r * 1024 + c0), bq = *(const u32x4*)(ZP + (size_t)(1024 + r) * 1024 + c0), cq = *(const u32x4*)(ZP + (size_t)(2048 + r) * 1024 + c0);
        float x[8], y[8], z[8]; unpack8(a, x); unpack8(bq, y); unpack8(cq, z);
#pragma unroll
        for (int e = 0; e < 8; ++e) x[e] += y[e] + z[e];
        *(u32x4*)(Z + (size_t)(b * SS + s) * 1024 + c0) = pack8u(x); }
}

constexpr int LR_UP = 272;
constexpr int LR_CP = 272;
constexpr int LR_U = 0, LR_LA = 128 * LR_UP, LR_BC = LR_LA + 128 * LR_CP, LR_Y0 = LR_BC + 128 * LR_CP, LR_XS = LR_Y0 + 128 * LR_CP, LR_END = LR_XS + 4096;
static_assert(LR_END <= 147456 - 1024, "fused LRU LDS");
__device__ __forceinline__ void phase_lru_fused(Ctx& C, int l, const bf16_t* XA, const bf16_t* WTL, bf16_t* Y0, f16_t* CAF, f16_t* CAB, float* SUM) {
    const int lane = C.lane, r32 = lane & 31, hi = lane >> 5, wave = C.wave, tid = C.tid;
    LAS unsigned char* lds = C.lds;
    const float* cw = INP(8) + l * 4 * 1024; const float* cb = INP(9) + l * 1024;
    const int rb = wave & 3, cgp = wave >> 2;
    for (int un = C.bid; un < NB * 8 * 34; un += C.G) {
        const int sg = un % 34, bn = un / 34, b = bn >> 3, n = bn & 7;
        const int R0 = b * SS + sg * 128, lo = (sg < 2) ? b * SS : b * SS + LC, hi_ = (sg < 2) ? b * SS + LC : (b + 1) * SS;
#pragma unroll
        for (int j = 0; j < 4; ++j) { const int item = tid + 512 * j, row = item >> 4, cc = item & 15, ch0 = n * 128 + cc * 8;
            float a[8];
            {   const f32x4 c0 = *(const f32x4*)(cb + ch0), c1 = *(const f32x4*)(cb + ch0 + 4); a[0] = c0[0]; a[1] = c0[1]; a[2] = c0[2]; a[3] = c0[3]; a[4] = c1[0]; a[5] = c1[1]; a[6] = c1[2]; a[7] = c1[3]; }
#pragma unroll
            for (int t = 0; t < 4; ++t) { const int rr = R0 + row + t - 2;
                const f32x4 wA = *(const f32x4*)(cw + t * 1024 + ch0), wB = *(const f32x4*)(cw + t * 1024 + ch0 + 4);
                if (rr >= lo && rr < hi_) { const u32x4 xv = *(const u32x4*)(XA + (size_t)rr * 1024 + ch0);
                    a[0] += wA[0] * lo_bf(xv.x); a[1] += wA[1] * hi_bf(xv.x); a[2] += wA[2] * lo_bf(xv.y); a[3] += wA[3] * hi_bf(xv.y);
                    a[4] += wB[0] * lo_bf(xv.z); a[5] += wB[1] * hi_bf(xv.z); a[6] += wB[2] * lo_bf(xv.w); a[7] += wB[3] * hi_bf(xv.w); } }
            *(LAS u32x4*)(lds + LR_U + row * LR_UP + cc * 16) = pack8u(a); }
        __syncthreads();
        bf16x8 af[8];
        {   LAS unsigned char* ua = lds + LR_U + (rb * 32 + r32) * LR_UP + hi * 16;
#pragma unroll
            for (int s = 0; s < 8; ++s) af[s] = *(const LAS bf16x8*)(ua + s * 32); }
        for (int d = 0; d < 2; ++d) {
            f32x16 aR[2], aI[2];
#pragma unroll
            for (int q = 0; q < 2; ++q)
#pragma unroll
                for (int r = 0; r < 16; ++r) { aR[q][r] = 0.f; aI[q][r] = 0.f; }
            {   const bf16_t* wb = WTL + ((size_t)d * 2048 + n * 256 + cgp * 64 + r32) * 256 + (n & 1) * 128 + hi * 8;
#pragma unroll
                for (int s = 0; s < 8; ++s) {
                    const bf16x8 b0 = *(const bf16x8*)(wb + s * 16), b1 = *(const bf16x8*)(wb + 32 * 256 + s * 16), b2 = *(const bf16x8*)(wb + 128 * 256 + s * 16), b3 = *(const bf16x8*)(wb + 160 * 256 + s * 16);
                    aR[0] = __builtin_amdgcn_mfma_f32_32x32x16_bf16(af[s], b0, aR[0], 0, 0, 0); aR[1] = __builtin_amdgcn_mfma_f32_32x32x16_bf16(af[s], b1, aR[1], 0, 0, 0);
                    aI[0] = __builtin_amdgcn_mfma_f32_32x32x16_bf16(af[s], b2, aI[0], 0, 0, 0); aI[1] = __builtin_amdgcn_mfma_f32_32x32x16_bf16(af[s], b3, aI[1], 0, 0, 0);
                    if ((s & 3) == 3) asm volatile("" ::: "memory"); } }
#pragma unroll
            for (int q = 0; q < 2; ++q) { const int chl = cgp * 64 + q * 32 + r32, ch = n * 128 + chl;
                const float bav = INP(11)[(l * 2 + d) * 1024 + ch], bxv = INP(13)[(l * 2 + d) * 1024 + ch], spv = C.ctl[CT_SP + (l * 2 + d) * 1024 + ch] * (-8.f);
#pragma unroll
                for (int g = 0; g < 4; ++g) { f16_t lav[4], bcv[4];
#pragma unroll
                    for (int e = 0; e < 4; ++e) { const int r = 4 * g + e, t = rb * 32 + crow(r, hi);
                        const float uu = bf2f(*(const LAS bf16_t*)(lds + LR_U + t * LR_UP + chl * 2));
                        const float rg = sigmoidf_(aR[q][r] + bav), ig = sigmoidf_(aI[q][r] + bxv);
                        const float loga = rg * spv, y2 = 2.f * loga;
                        const float om = -y2 * (1.f + y2 * 0.5f * (1.f + y2 * (1.f / 3.f) * (1.f + y2 * 0.25f * (1.f + y2 * 0.2f))));
                        const float bb = SQRT(fmaxf(om, 0.f)) * (ig * uu);
                        lav[e] = (f16_t)(loga * LOG2E); bcv[e] = (f16_t)bb; }
                    typedef f16_t f16x4 __attribute__((ext_vector_type(4)));
                    const int tb = rb * 32 + 8 * g + 4 * hi;
                    *(LAS f16x4*)(lds + LR_LA + chl * LR_CP + tb * 2) = (f16x4){lav[0], lav[1], lav[2], lav[3]};
                    *(LAS f16x4*)(lds + LR_BC + chl * LR_CP + tb * 2) = (f16x4){bcv[0], bcv[1], bcv[2], bcv[3]}; } }
            __syncthreads();
            const int chl = tid & 127, sub = tid >> 7;
            const int tlo = d ? (96 - sub * 32) : (sub * 32);
            f16x8 lv[4], bv[4];
#pragma unroll
            for (int k = 0; k < 4; ++k) { lv[k] = *(const LAS f16x8*)(lds + LR_LA + chl * LR_CP + tlo * 2 + k * 16); bv[k] = *(const LAS f16x8*)(lds + LR_BC + chl * LR_CP + tlo * 2 + k * 16); }
            float av[32], hv[32];
            float A = 1.f, H = 0.f;
#define LR_P1(DD) do { _Pragma("unroll") for (int i = 0; i < 32; ++i) { constexpr int dd_ = DD; const int j = dd_ ? (31 - i) : i; \
                av[j] = EX2((float)lv[j >> 3][j & 7]); H = av[j] * H + (float)bv[j >> 3][j & 7]; A *= av[j]; } } while (0)
            if (d) LR_P1(1); else LR_P1(0);
#undef LR_P1
            *(LAS f32x2*)(lds + LR_XS + (sub * 128 + chl) * 8) = (f32x2){A, H};
            __syncthreads();
            {   A = 1.f; H = 0.f;
                for (int p = 0; p < sub; ++p) { const f32x2 v = *(const LAS f32x2*)(lds + LR_XS + (p * 128 + chl) * 8); H = v.x * H + v.y; A *= v.x; }
                f16_t* cap = (d ? CAB : CAF) + (size_t)(R0 + tlo) * 1024 + n * 128 + chl;
                bf16_t* y0p = Y0 + (size_t)(R0 + tlo) * 1024 + n * 128 + chl;
                LAS unsigned char* ys = lds + LR_Y0 + chl * LR_CP + tlo * 2;
#define LR_P2(DD) do { _Pragma("unroll") for (int i = 0; i < 32; ++i) { constexpr int dd_ = DD; const int j = dd_ ? (31 - i) : i; \
                H = av[j] * H + (float)bv[j >> 3][j & 7]; A *= av[j]; cap[(size_t)j * 1024] = (f16_t)A; hv[j] = H; } } while (0)
                if (d == 0) { LR_P2(0);
#pragma unroll
                    for (int k = 0; k < 4; ++k) { u32x4 w; w.x = pk2(hv[8 * k], hv[8 * k + 1]); w.y = pk2(hv[8 * k + 2], hv[8 * k + 3]); w.z = pk2(hv[8 * k + 4], hv[8 * k + 5]); w.w = pk2(hv[8 * k + 6], hv[8 * k + 7]); *(LAS u32x4*)(ys + k * 16) = w; }
                } else { LR_P2(1);
#pragma unroll
                    for (int k = 0; k < 4; ++k) { const u32x4 yv = *(const LAS u32x4*)(ys + k * 16); float y[8]; unpack8(yv, y);
#pragma unroll
                        for (int e = 0; e < 8; ++e) y0p[(size_t)(8 * k + e) * 1024] = (bf16_t)f2bf(y[e] + hv[8 * k + e]); }
                }
#undef LR_P2
                if (sub == 3) *(f32x2*)(SUM + ((size_t)((d * NB + b) * 34 + sg) * 1024 + n * 128 + chl) * 2) = (f32x2){A, H}; }
            __syncthreads();
        }
    }
}
__device__ __forceinline__ void phase_lru_fix(Ctx& C, const bf16_t* Y0, const f16_t* CAF, const f16_t* CAB, const float* SUM, bf16_t* YA) {
    for (int un = C.gw; un < NB * 34 * 8; un += C.ngw) {
        const int cg_ = un & 7, sg = (un >> 3) % 34, b = (un >> 3) / 34, ch = cg_ * 128 + 2 * C.lane;
        float F0 = 0.f, F1 = 0.f, B0 = 0.f, B1 = 0.f;
#pragma unroll 4
        for (int p = 0; p < sg; ++p) { const f32x4 v = *(const f32x4*)(SUM + ((size_t)((0 * NB + b) * 34 + p) * 1024 + ch) * 2); F0 = v[0] * F0 + v[1]; F1 = v[2] * F1 + v[3]; }
        const int npre = (sg < 2) ? (1 - sg) : (35 - sg);
#pragma unroll 4
        for (int p = 0; p < npre; ++p) { const int ps = (p < 2) ? (1 - p) : (35 - p);
            const f32x4 v = *(const f32x4*)(SUM + ((size_t)((1 * NB + b) * 34 + ps) * 1024 + ch) * 2); B0 = v[0] * B0 + v[1]; B1 = v[2] * B1 + v[3]; }
        const size_t base = (size_t)(b * SS + sg * 128) * 1024 + ch;
        for (int t0 = 0; t0 < 128; t0 += 16) {
            unsigned y[16]; f16x2 cf[16], cbk[16];
#pragma unroll
            for (int i = 0; i < 16; ++i) { const size_t o = base + (size_t)(t0 + i) * 1024; y[i] = *(const unsigned*)(Y0 + o); cf[i] = *(const f16x2*)(CAF + o); cbk[i] = *(const f16x2*)(CAB + o); }
#pragma unroll
            for (int i = 0; i < 16; ++i) { const size_t o = base + (size_t)(t0 + i) * 1024;
                *(unsigned*)(YA + o) = pk2(lo_bf(y[i]) + (float)cf[i][0] * F0 + (float)cbk[i][0] * B0, hi_bf(y[i]) + (float)cf[i][1] * F1 + (float)cbk[i][1] * B1); }
        }
    }
}

#ifdef PROBE_TS
#define GSYNC(g) do { { unsigned char* w_ = prm.ws; asm volatile("" : "+s"(w_)); xcd_barrier((unsigned*)(w_ + WS_BAR), (volatile LAS unsigned*)(ldsb + LDS_ST)); } if (blockIdx.x == 0 && threadIdx.x == 0) { unsigned long long* ts_ = (unsigned long long*)(prm.ws + 8192); const unsigned long long now_ = __builtin_amdgcn_s_memrealtime(); \
    ts_[1 + (g)] += now_ - ts_[0]; ts_[0] = now_; } } while (0)
#else
#define GSYNC(g) do { unsigned char* w_ = prm.ws; asm volatile("" : "+s"(w_)); xcd_barrier((unsigned*)(w_ + WS_BAR), (volatile LAS unsigned*)(ldsb + LDS_ST)); } while (0)
#endif
#define CTX Ctx C = mkctx(ldsb)
#define WSB wsp_(C.ws)
#define bYB ((bf16_t*)(WSB + AR_YB))
#define bXA ((bf16_t*)(WSB + AR_XA))
#define bMD ((bf16_t*)(WSB + AR_MD))
#define bRQKV ((bf16_t*)(WSB + AR_RQKV))
#define bKV ((bf16_t*)(WSB + AR_KV))
#define bQN ((bf16_t*)(WSB + AR_QN))
#define bQP ((bf16_t*)(WSB + AR_QP))
#define bRI ((f16_t*)(WSB + AR_RI))
#define bSUM ((float*)(WSB + AR_SUM))
#define bOB ((bf16_t*)(WSB + AR_OB))
#define bZ ((bf16_t*)(WSB + AR_Z))
#define xc1 ((float*)(WSB + WS_XC1))
template <int l> __device__ __forceinline__ void run_layer(const Params& prm, LAS unsigned char* ldsb) {
        const bool with_ctx = (l == 0); const int lat_only = with_ctx ? 0 : 1;
        { CTX; phase_wconv_early(C, l); }
        if (l == 0) GSYNC(0);
        { CTX; phase_h2(C, l, bYB); }
        GSYNC(1);
        {   CTX;
            ProbPlain P{bYB, (const bf16_t*)(WSB + W_WT1), 1024, 1024, 1024};
            pg8::StaticOrder S; S.init(68, 19, C.G, C.bid, 0);
            EpiG1 E{WSB, C.ctl + CT_ROPER};
            pg8::gemm_phase<EpiG1, ProbPlain, pg8::StaticOrder, true>(C.lds, P, S, E);
        }
        GSYNC(2);
        { CTX; phase_ret_intra(C, l, bRQKV, bYB); }
        { CTX; phase_md_post2(C, l, bMD); }
        GSYNC(4);
        { CTX; phase_ret_chain(C, l, bRQKV, bYB, bOB); }
        GSYNC(5);
        { CTX; phase_ret_ln3(C, l, bYB, bOB); }
        {   CTX; ProbPlain P{bMD, (const bf16_t*)(WSB + W_WTQ), 768, 384, 384};
            pg8::StaticOrder S; S.init(68, 6, C.G, C.bid, 0);
            typedef EpiStore3<AR_QN, 1024, AR_QP, 512, AR_QP, 512, 4, 6> Ep; Ep E{WSB};
            pg8::gemm_phase<Ep, ProbPlain, pg8::StaticOrder, true>(C.lds, P, S, E);
        }
        {   CTX; ProbPlain P{bMD + 384, (const bf16_t*)(WSB + W_WTKV), 768, 256, 256};
            pg8::StaticOrder S; S.init(68, 8, C.G, C.bid, 0);
            typedef EpiStore3<AR_KV, 2048, AR_KV, 2048, AR_KV, 2048, 8, 8> Ep; Ep E{WSB};
            pg8::gemm_phase<Ep, ProbPlain, pg8::StaticOrder, true>(C.lds, P, S, E);
        }
        GSYNC(6);
        { CTX; phase_qk_post2(C, l, bQN, bQP, bKV); }
        GSYNC(7);
        { CTX; phase_attn(C, with_ctx, bQN, bQP, bKV, bMD); }
        GSYNC(8);
        { CTX; phase_lru_fused(C, l, bXA, (const bf16_t*)(WSB + W_WTL), (bf16_t*)(WSB + AR_Y0), (f16_t*)(WSB + AR_CAF), (f16_t*)(WSB + AR_CAB), bSUM); }
        GSYNC(9);
        { CTX; phase_lru_fix(C, (const bf16_t*)(WSB + AR_Y0), (const f16_t*)(WSB + AR_CAF), (const f16_t*)(WSB + AR_CAB), bSUM, bXA  ); }
        GSYNC(10);
        { CTX; phase_wconv_late(C, l); }
        { CTX; phase_h2(C, l, bMD  ); }
        GSYNC(13);
        {   CTX; ProbPlain P{bMD, (const bf16_t*)(WSB + W_WTG), 1024, 1024, 1024};
            pg8::StaticOrder S; S.init(lat_only ? 64 : 68, 12, C.G, C.bid, lat_only);
            EpiGate E{WSB};
            pg8::gemm_phase<EpiGate, ProbPlain, pg8::StaticOrder, true>(C.lds, P, S, E);
        }
        GSYNC(14);
        {   CTX; ProbD P{WSB, 1024, 1024};
            pg8::ChainOrder S; S.init(C.G, C.bid, with_ctx ? 1 : 0);
            EpiD E{bZ, WSB + AR_GS + (size_t)C.bid * 131072, (bf16_t*)(WSB + AR_ZP)};
            pg8::gemm_phase<EpiD, ProbD, pg8::ChainOrder, true>(C.lds, P, S, E);
        }
        GSYNC(15);
        if (with_ctx) { { CTX; phase_zsum(C, (const bf16_t*)(WSB + AR_ZP), bZ); } GSYNC(12); }
        {   CTX; ProbPlain P{bZ, (const bf16_t*)(WSB + W_WTO), 1024, 1024, 1024};
            pg8::StaticOrder S; S.init(lat_only ? 64 : 68, 4, C.G, C.bid, lat_only);
            EpiOut E{(l == 0) ? INP(0) : (const float*)C.out, INP(2), C.out, xc1, C.ctl + CT_MOD + l * 5 * 3072};
            pg8::gemm_phase<EpiOut, ProbPlain, pg8::StaticOrder, true>(C.lds, P, S, E);
        }
        GSYNC(16);
    }

__global__ void __launch_bounds__(NTHR) fwd_kernel(Params prm) {
    extern __shared__ __attribute__((aligned(16))) unsigned char lds_raw[];
    cg::grid_group grid = cg::this_grid();
    LAS unsigned char* const ldsb = (LAS unsigned char*)lds_raw;
    if (threadIdx.x < 16) ((LAS unsigned*)(ldsb + LDS_ST))[threadIdx.x] = 0u;
    __syncthreads();
    if (threadIdx.x == 0) (void)xb_add(&((unsigned*)(prm.ws + WS_BAR))[XB_XCNT(xb_xcc_id())], 1u);
    grid.sync();


#ifdef PROBE_TS
    if (blockIdx.x == 0 && threadIdx.x == 0) { unsigned long long* ts_ = (unsigned long long*)(prm.ws + 8192); for (int i = 1; i < 32; ++i) ts_[i] = 0ull; ts_[0] = __builtin_amdgcn_s_memrealtime(); }
#endif
    { CTX; phase_prep(C); }
    run_layer<0>(prm, ldsb);
    run_layer<1>(prm, ldsb);
#ifdef PROBE_TS
    if (blockIdx.x == 0 && threadIdx.x == 0) { const unsigned long long* ts_ = (const unsigned long long*)(prm.ws + 8192); unsigned long long tot = 0ull;
        for (int g = 0; g < 17; ++g) if ((PROBE_TS >> g) & 1u) tot += ts_[1 + g];
        prm.out[0] += (float)(((tot / 100ull) + PROBE_Q / 2) / PROBE_Q * PROBE_Q); }
#endif
}

#undef xc1
#undef bZ
extern "C" void kernel_launch(void* const* d_in, const int* in_sizes, int n_in, void* d_out, int out_size, void* d_ws, size_t ws_size, hipStream_t stream) {
    static int grid = 0;
    if (grid == 0) {
        if (n_in != 29 || out_size != NB * TT * DM || ws_size < WS_END) { fprintf(stderr, "kernel_launch: unexpected shapes (n_in %d out %d ws %zu)\n", n_in, out_size, ws_size); grid = -1; return; }
        int dev = 0, cus = 0, per_cu = 0;
        hipGetDevice(&dev);
        hipDeviceGetAttribute(&cus, hipDeviceAttributeMultiprocessorCount, dev);
        if (hipFuncSetAttribute((const void*)fwd_kernel, hipFuncAttributeMaxDynamicSharedMemorySize, LDS_BYTES) != hipSuccess) { fprintf(stderr, "kernel_launch: hipFuncSetAttribute failed\n"); grid = -1; return; }
        if (hipOccupancyMaxActiveBlocksPerMultiprocessor(&per_cu, (const void*)fwd_kernel, NTHR, LDS_BYTES) != hipSuccess || per_cu < 1) { fprintf(stderr, "kernel_launch: occupancy query failed (%d)\n", per_cu); (void)hipGetLastError(); per_cu = 1; }
        grid = cus;
        fprintf(stderr, "kernel_launch: cus %d per_cu %d grid %d\n", cus, per_cu, grid);
    }
    if (grid < 0) return;
    if (hipMemsetAsync((char*)d_ws + WS_BAR, 0, XCD_BAR_WORDS * 4, stream) != hipSuccess) { fprintf(stderr, "kernel_launch: memset failed\n"); return; }
    Params p{};
    for (int i = 0; i < 29; ++i) p.in[i] = (const float*)d_in[i];
    p.out = (float*)d_out; p.ws = (unsigned char*)d_ws;
    void* args[] = {&p};
    hipError_t e = hipLaunchCooperativeKernel((const void*)fwd_kernel, dim3(grid), dim3(NTHR), args, LDS_BYTES, stream);
    if (e != hipSuccess) fprintf(stderr, "cooperative launch failed: %s (grid %d)\n", hipGetErrorString(e), grid);
}
```

```cpp
#include <hip/hip_runtime.h>
#include <hip/hip_cooperative_groups.h>
#include <cstdio>
#include <cstdint>
namespace cg = cooperative_groups;

#define LAS __attribute__((address_space(3)))
typedef unsigned short bf16_t;
typedef short bf16x8 __attribute__((ext_vector_type(8)));
typedef float f32x4 __attribute__((ext_vector_type(4)));
typedef float f32x2 __attribute__((ext_vector_type(2)));
typedef unsigned u32x4 __attribute__((ext_vector_type(4)));
typedef unsigned u32x2 __attribute__((ext_vector_type(2)));
typedef _Float16 f16_t;

namespace pg8 {
constexpr int BM = 256, BK = 64, HALF = 128, HTB = HALF * BK * 2, STAGE_BYTES = 8 * HTB, NXCD = 8, WGM = 8;
__host__ __device__ __forceinline__ int lds_byte(int r, int c) { const int st = (r >> 4) * 2 + (c >> 5), rr = r & 15, cc = c & 31, ob = rr * 64 + cc * 2; return st * 1024 + (ob ^ (((ob >> 9) & 1) << 5)); }
__host__ __device__ __forceinline__ void stage_rc(int b, int& R, int& C) { const int st = b / 1024, sb = b % 1024, swz = sb ^ (((sb >> 9) & 1) << 5); R = (st >> 1) * 16 + swz / 64; C = (st & 1) * 32 + (swz % 64) / 2; }
__host__ __device__ __forceinline__ int perm32(int rho) { const int n = rho >> 4, i = rho & 15; return 8 * (i >> 2) + 4 * n + (i & 3); }

struct Unit { int pm, pn, z; };

struct StaticOrder {
    int nM, nN, nwg, G, c, latent_only;
    __device__ void init(int nM_, int nN_, int G_, int c_, int latent_only_) { nM = nM_; nN = nN_; nwg = nM * nN; G = G_; c = c_; latent_only = latent_only_; }
    __device__ bool next(int i, Unit& u) const {
        const long L = (long)i * G + c; if (L >= nwg) return false;
        int wgid = (int)L; { const int q = nwg / NXCD, r = nwg % NXCD, xcd = wgid % NXCD, off = wgid / NXCD; wgid = (xcd < r ? xcd * (q + 1) : r * (q + 1) + (xcd - r) * q) + off; }
        const int nig = WGM * nN, gid = wgid / nig, fm = gid * WGM, gsz = (nM - fm) < WGM ? (nM - fm) : WGM;
        int pm = fm + ((wgid % nig) % gsz); u.pn = (wgid % nig) / gsz; u.z = 0;
        if (latent_only) pm = (pm >> 4) * 17 + 1 + (pm & 15);
        u.pm = pm; return true;
    }
};
struct ChainOrder {
    int G, c, with_ctx;
    __device__ void init(int G_, int c_, int with_ctx_) { G = G_; c = c_; with_ctx = with_ctx_; }
    __device__ bool next(int i, Unit& u) const {
        if (i < 6) { const int T = c; if (T >= 256) return false; int pm = T >> 2; u.pn = T & 3; u.z = i; u.pm = (pm >> 4) * 17 + 1 + (pm & 15); return true; }
        if (i < 8 && with_ctx && c < 48) { const int ct = c / 3, br = c - ct * 3; u.pm = (ct >> 2) * 17; u.pn = ct & 3; u.z = 8 + 2 * br + (i - 6); return true; }
        return false;
    }
};

typedef __bf16 bf16x2_t __attribute__((ext_vector_type(2)));
__device__ __forceinline__ unsigned cvt_pk_bf16(float lo, float hi) { f32x2 v = {lo, hi}; bf16x2_t b = __builtin_convertvector(v, bf16x2_t); return __builtin_bit_cast(unsigned, b); }

template <class Epi, class Prob, class Sched, bool ALIGN_EPI>
__device__ __forceinline__ void gemm_phase(LAS unsigned char* lds, const Prob& P, const Sched& S, const Epi& E) {
    int tid_ = threadIdx.x; asm volatile("" : "+v"(tid_));
    const int tid = tid_, wid = __builtin_amdgcn_readfirstlane(tid >> 6), lane = tid & 63, wr = wid >> 2, wc = wid & 3, fr = lane & 15, fq = lane >> 4;
    const int K = P.K, nt = K / BK;
    int RA[2], CA[2]; unsigned voffB[2];
#pragma unroll
    for (int i = 0; i < 2; ++i) { int R, C; stage_rc(tid * 16 + i * 8192, R, C); const int Rb = Epi::PERM ? ((R & ~31) + perm32(R & 31)) : R;
        RA[i] = R; CA[i] = C; voffB[i] = (unsigned)(Rb * P.ldb + C) * 2u; }
    const unsigned kstep = (unsigned)(BK * 2);
    const unsigned hstepB = (unsigned)(HALF * P.ldb * 2);
    const unsigned ldsw = (unsigned)wid * 1024u;
    const int aoff = lds_byte(wr * 64 + fr, fq * 8), boff = lds_byte(wc * 32 + fr, fq * 8);
#define PG8_SA(b, h) (((b) * 2 + (h)) * HTB)
#define PG8_SB(b, h) ((4 + (b) * 2 + (h)) * HTB)
#define PG8_STAGE(bufoff, gbase, soff, voff) do { _Pragma("unroll") for (int _i = 0; _i < 2; ++_i) \
        __builtin_amdgcn_global_load_lds((const unsigned*)((const char*)(gbase) + (unsigned)((voff)[_i] + (soff))), (LAS unsigned*)(lds + (bufoff) + ldsw + _i * 8192), 16, 0, 0); } while (0)
#define PG8_LDA(dst, b, h) do { _Pragma("unroll") for (int m = 0; m < 4; ++m) _Pragma("unroll") for (int k = 0; k < 2; ++k) dst[m][k] = *(const LAS bf16x8*)(lds + PG8_SA(b, h) + aoff + m * 2048 + k * 1024); } while (0)
#define PG8_LDB(dst, b, h) do { _Pragma("unroll") for (int n = 0; n < 2; ++n) _Pragma("unroll") for (int k = 0; k < 2; ++k) dst[n][k] = *(const LAS bf16x8*)(lds + PG8_SB(b, h) + boff + n * 2048 + k * 1024); } while (0)
#define PG8_MMA(ai, bj, At, Bt) do { __builtin_amdgcn_s_setprio(1); _Pragma("unroll") for (int m = 0; m < 4; ++m) _Pragma("unroll") for (int n = 0; n < 2; ++n) _Pragma("unroll") for (int k = 0; k < 2; ++k) \
        acc[ai][bj][m][n] = __builtin_amdgcn_mfma_f32_16x16x32_bf16(Bt[n][k], At[m][k], acc[ai][bj][m][n], 0, 0, 0); __builtin_amdgcn_s_setprio(0); } while (0)
#define PG8_WAIT_V(n) asm volatile("s_waitcnt vmcnt(" #n ")" ::: "memory")
#define PG8_WAIT_L(n) asm volatile("s_waitcnt lgkmcnt(" #n ")" ::: "memory")
#define PG8_BAR __builtin_amdgcn_s_barrier()
#define PG8_SCHED __builtin_amdgcn_sched_barrier(0)
    Unit cur, nxt; int ui = 0;
    if (!S.next(0, cur)) return;
    f32x4 acc[2][2][4][2];
#pragma unroll
    for (int a = 0; a < 2; ++a)
#pragma unroll
        for (int b = 0; b < 2; ++b)
#pragma unroll
            for (int m = 0; m < 4; ++m)
#pragma unroll
                for (int n = 0; n < 2; ++n) acc[a][b][m][n] = (f32x4){0.f, 0.f, 0.f, 0.f};
    bf16x8 At[4][2], B0[2][2], B1[2][2];
    const char* cA; const char* cB; int ldaC; P.get(cur, cA, cB, ldaC);
    unsigned voffA[2] = {(unsigned)(RA[0] * ldaC + CA[0]) * 2u, (unsigned)(RA[1] * ldaC + CA[1]) * 2u};
    unsigned hstepA = (unsigned)(HALF * ldaC * 2);
    PG8_STAGE(PG8_SB(0, 0), cB, 0u, voffB); PG8_STAGE(PG8_SB(0, 1), cB, hstepB, voffB); PG8_STAGE(PG8_SA(0, 0), cA, 0u, voffA); PG8_STAGE(PG8_SA(0, 1), cA, hstepA, voffA);
    if (wr == 1) PG8_BAR;
    PG8_WAIT_V(2); PG8_BAR;
    PG8_STAGE(PG8_SB(1, 0), cB, kstep, voffB); PG8_STAGE(PG8_SA(1, 0), cA, kstep, voffA); PG8_STAGE(PG8_SB(1, 1), cB, hstepB + kstep, voffB);
    PG8_WAIT_V(6); PG8_BAR;
    for (;;) {
        const bool has_next = S.next(ui + 1, nxt);
        const char* nA = cA; const char* nB = cB; int ldaN = ldaC;
        if (has_next) P.get(nxt, nA, nB, ldaN);
        unsigned voffAn[2] = {(unsigned)(RA[0] * ldaN + CA[0]) * 2u, (unsigned)(RA[1] * ldaN + CA[1]) * 2u};
        const unsigned hstepAn = (unsigned)(HALF * ldaN * 2);
        for (int t = 0; t < nt; t += 2) {
            const bool last = (t == nt - 2);
            const unsigned o1 = (unsigned)(t + 1) * kstep;
            const char* a2b = last ? nA : cA; const char* b2b = last ? nB : cB;
            const unsigned o2 = last ? 0u : (unsigned)(t + 2) * kstep, o3 = o2 + kstep;
            unsigned vA2[2] = {last ? voffAn[0] : voffA[0], last ? voffAn[1] : voffA[1]};
            const unsigned hA2 = last ? hstepAn : hstepA;
            PG8_LDB(B0, 0, 0); PG8_LDB(B1, 0, 1); PG8_SCHED; PG8_LDA(At, 0, 0); PG8_STAGE(PG8_SA(1, 1), cA, o1 + hstepA, voffA);
            PG8_WAIT_V(8); PG8_WAIT_L(0); PG8_BAR; PG8_MMA(0, 0, At, B0); PG8_MMA(0, 1, At, B1); PG8_BAR; PG8_SCHED;
            PG8_LDA(At, 0, 1); PG8_STAGE(PG8_SB(0, 0), b2b, o2, voffB); PG8_STAGE(PG8_SB(0, 1), b2b, o2 + hstepB, voffB); PG8_STAGE(PG8_SA(0, 0), a2b, o2, vA2);
            PG8_WAIT_V(8); PG8_WAIT_L(0); PG8_BAR; PG8_MMA(1, 0, At, B0); PG8_MMA(1, 1, At, B1); PG8_BAR; PG8_SCHED;
            PG8_LDB(B0, 1, 0); PG8_LDB(B1, 1, 1); PG8_SCHED; PG8_LDA(At, 1, 0); PG8_STAGE(PG8_SA(0, 1), a2b, o2 + hA2, vA2);
            PG8_WAIT_V(8); PG8_WAIT_L(0); PG8_BAR; PG8_MMA(0, 0, At, B0); PG8_MMA(0, 1, At, B1); PG8_BAR; PG8_SCHED;
            PG8_LDA(At, 1, 1); PG8_STAGE(PG8_SB(1, 0), b2b, o3, voffB); PG8_STAGE(PG8_SB(1, 1), b2b, o3 + hstepB, voffB); PG8_STAGE(PG8_SA(1, 0), a2b, o3, vA2);
            PG8_WAIT_V(8); PG8_WAIT_L(0); PG8_BAR; PG8_MMA(1, 0, At, B0); PG8_MMA(1, 1, At, B1); PG8_BAR; PG8_SCHED;
        }
        if constexpr (ALIGN_EPI) { if (wr == 0) PG8_BAR; }
        E(acc, cur, wr, wc, fr, fq);
        if (!has_next) break;
#pragma unroll
        for (int a = 0; a < 2; ++a)
#pragma unroll
            for (int b = 0; b < 2; ++b)
#pragma unroll
                for (int m = 0; m < 4; ++m)
#pragma unroll
                    for (int n = 0; n < 2; ++n) acc[a][b][m][n] = (f32x4){0.f, 0.f, 0.f, 0.f};
        cur = nxt; cA = nA; cB = nB; ldaC = ldaN; voffA[0] = voffAn[0]; voffA[1] = voffAn[1]; hstepA = hstepAn; ++ui;
        if constexpr (ALIGN_EPI) { if (wr == 1) PG8_BAR; }
    }
    PG8_WAIT_V(0);
    if constexpr (!ALIGN_EPI) { if (wr == 0) PG8_BAR; }
    PG8_BAR;
#undef PG8_SA
#undef PG8_SB
#undef PG8_STAGE
#undef PG8_LDA
#undef PG8_LDB
#undef PG8_MMA
#undef PG8_WAIT_V
#undef PG8_WAIT_L
#undef PG8_BAR
#undef PG8_SCHED
}
}

constexpr int NB = 4, TT = 4096, LC = 256, SS = TT + LC  , DM = 1024, MR = NB * SS  ;
constexpr int INC = 10944;
constexpr float EPS = 1e-6f;
constexpr float LOG2E = 1.4426950408889634f;
constexpr float QSCALE = 0.07216878364870322f * 1.4426950408889634f;
constexpr int NWAVES = 8, NTHR = 512;

constexpr size_t MiB = 1u << 20;
constexpr size_t WS_CTL = 0;
constexpr size_t WS_XC1 = 1 * MiB;
constexpr size_t WS_W = 5 * MiB;
constexpr size_t WS_AR = 25 * MiB;
constexpr size_t AR_YB = WS_AR + 0 * MiB;
constexpr size_t AR_XA = WS_AR + 34 * MiB;
constexpr size_t AR_MD = WS_AR + 68 * MiB;
constexpr size_t AR_RQKV = WS_AR + 94 * MiB;
constexpr size_t AR_OB = WS_AR + 196 * MiB;
constexpr size_t AR_KV = WS_AR + 112 * MiB;
constexpr size_t AR_QN = WS_AR + 180 * MiB;
constexpr size_t AR_QP = WS_AR + 214 * MiB;
constexpr size_t AR_RI = WS_AR + 102 * MiB;
constexpr size_t AR_Y0 = WS_AR + 68 * MiB;
constexpr size_t AR_CAF = WS_AR + 102 * MiB;
constexpr size_t AR_CAB = WS_AR + 136 * MiB;
constexpr size_t AR_SUM = WS_AR + 170 * MiB;
constexpr size_t AR_Z = WS_AR + 102 * MiB;
constexpr size_t AR_ZP = WS_AR + 170 * MiB;
constexpr size_t AR_GS = WS_AR + 136 * MiB;
constexpr size_t WS_END = 256 * MiB;
constexpr size_t W_WT1 = WS_W;
constexpr size_t W_WTQ = WS_W + 10 * MiB;
constexpr size_t W_WTKV = WS_W + 12 * MiB;
constexpr size_t W_WTL = WS_W + 13 * MiB;
constexpr size_t W_WTG = WS_W;
constexpr size_t W_WTGM = WS_W + 6 * MiB;
constexpr size_t W_WTD = WS_W + 12 * MiB;
constexpr size_t W_WTO = WS_W + 18 * MiB;
constexpr int CT_MOD = 16384;
constexpr int CT_ROPER = CT_MOD + 2 * 5 * 3072;
constexpr int CT_ROPEM = CT_ROPER + 2 * 4096;
constexpr int CT_SP = CT_ROPEM + 2 * 1024;
constexpr int CT_LG = CT_SP + 4096;
constexpr int CT_END = CT_LG + 16;
static_assert(CT_END * 4 <= (int)MiB, "CTL");

constexpr int LDS_BYTES = 147456;


#define XB_TMO      128
#define XB_XCNT(j)  (256  + 64 * (j))
#define XB_XSUB(j)  (1280 + 64 * (j))
#define XB_XGEN(j)  (2304 + 64 * (j))
#define XB_TOP      3328
#define XB_TOPGEN   3392
#define XCD_BAR_WORDS 3456
#define XB_SPIN_CAP (1u << 18)
constexpr size_t WS_BAR = 16384;
constexpr int LDS_ST = LDS_BYTES - 64;
__device__ __forceinline__ unsigned xb_ld(unsigned* p)              { return __hip_atomic_load(p, __ATOMIC_RELAXED, __HIP_MEMORY_SCOPE_AGENT); }
__device__ __forceinline__ unsigned xb_add(unsigned* p, unsigned v) { return __hip_atomic_fetch_add(p, v, __ATOMIC_RELAXED, __HIP_MEMORY_SCOPE_AGENT); }
__device__ __forceinline__ unsigned xb_xcc_id() { return (unsigned)__builtin_amdgcn_s_getreg((3 << 11) | 20) & 0xFu; }
#define XB_SPIN(cond, bar) do { unsigned _sp = 0; while (cond) { __builtin_amdgcn_s_sleep(1); \
    if ((++_sp & 255u) == 0u) { if (xb_ld(&(bar)[XB_TMO])) break; if (_sp > XB_SPIN_CAP) { atomicAdd(&(bar)[XB_TMO], 1u); break; } } } } while (0)
__device__ __forceinline__ void xcd_barrier_complete(unsigned* bar, unsigned x, unsigned& nloc, unsigned& nx) {
    const unsigned G = gridDim.x * gridDim.y * gridDim.z;
    unsigned sum, cnt, mine, sp = 0u;
    for (;;) {
        sum = 0u; cnt = 0u; mine = 0u;
#pragma unroll
        for (unsigned j = 0; j < 16; ++j) { const unsigned c = xb_ld(&bar[XB_XCNT(j)]); sum += c; cnt += (c > 0u) ? 1u : 0u; mine = (j == x) ? c : mine; }
        if (sum == G) break;
        __builtin_amdgcn_s_sleep(1);
        if ((++sp & 255u) == 0u) { if (xb_ld(&bar[XB_TMO])) break; if (sp > XB_SPIN_CAP) { atomicAdd(&bar[XB_TMO], 1u); break; } }
    }
    nloc = mine > 0u ? mine : 1u; nx = cnt > 0u ? cnt : 1u;
}
__device__ __forceinline__ void xcd_barrier(unsigned* bar, volatile LAS unsigned* st) {
    asm volatile("s_waitcnt vmcnt(0)" ::: "memory");
    __syncthreads();
    if (threadIdx.x == 0) {
        const unsigned x = xb_xcc_id();
        __builtin_amdgcn_s_waitcnt(0);
        unsigned nloc = st[0], nx = st[1];
        if (nloc == 0u) { xcd_barrier_complete(bar, x, nloc, nx); st[0] = nloc; st[1] = nx; }
        const unsigned old = xb_add(&bar[XB_XSUB(x)], 1u);
        const unsigned gen = old / nloc;
        if (old + 1u == (gen + 1u) * nloc) {
            __builtin_amdgcn_fence(__ATOMIC_RELEASE, "agent");
            asm volatile("s_waitcnt vmcnt(0)" ::: "memory");
            const unsigned og = xb_add(&bar[XB_TOP], 1u);
            const unsigned tg = og / nx;
            if (og + 1u == (tg + 1u) * nx) xb_add(&bar[XB_TOPGEN], 1u);
            else XB_SPIN(xb_ld(&bar[XB_TOPGEN]) == tg, bar);
            __builtin_amdgcn_fence(__ATOMIC_ACQUIRE, "agent");
            xb_add(&bar[XB_XGEN(x)], 1u);
            asm volatile("s_waitcnt vmcnt(0)" ::: "memory");
        } else {
            XB_SPIN(xb_ld(&bar[XB_XGEN(x)]) == gen, bar);
            __builtin_amdgcn_fence(__ATOMIC_ACQUIRE, "agent");
            asm volatile("s_waitcnt vmcnt(0)" ::: "memory");
        }
    }
    __syncthreads();
}

struct Params {
    const float* in[29];
    float* out;
    unsigned char* ws;
};

#define EX2(x) __builtin_amdgcn_exp2f(x)
#define RSQ(x) __builtin_amdgcn_rsqf(x)
#define SQRT(x) __builtin_amdgcn_sqrtf(x)
__device__ __forceinline__ float bf2f(unsigned v) { return __uint_as_float(v << 16); }
__device__ __forceinline__ unsigned f2bf(float f) { unsigned u = __float_as_uint(f); return (u + 0x7fffu + ((u >> 16) & 1u)) >> 16; }
__device__ __forceinline__ unsigned pk2(float lo, float hi) { return f2bf(lo) | (f2bf(hi) << 16); }
__device__ __forceinline__ float lo_bf(unsigned w) { return __uint_as_float(w << 16); }
__device__ __forceinline__ float hi_bf(unsigned w) { return __uint_as_float(w & 0xffff0000u); }
__device__ __forceinline__ float wave_sum(float v) {
#pragma unroll
    for (int o = 1; o < 64; o <<= 1) v += __shfl_xor(v, o);
    return v;
}
__device__ __forceinline__ float wave_max(float v) {
#pragma unroll
    for (int o = 1; o < 64; o <<= 1) v = fmaxf(v, __shfl_xor(v, o));
    return v;
}
__device__ __forceinline__ float sigmoidf_(float x) { return __builtin_amdgcn_rcpf(1.f + __expf(-x)); }
__device__ __forceinline__ float siluf_(float x) { return x * __builtin_amdgcn_rcpf(1.f + __expf(-x)); }

__device__ __forceinline__ const float* inp_(int i) { asm volatile("" : "+s"(i)); const float* const* ka = (const float* const*)__builtin_amdgcn_kernarg_segment_ptr(); return ka[i]; }
#define INP(i) inp_(i)
__device__ __forceinline__ unsigned char* wsp_(unsigned char* p) { asm volatile("" : "+s"(p)); return p; }
struct Ctx {
    float* out; unsigned char* ws; LAS unsigned char* lds; int tid, lane, wave, G, bid;
    int gw, ngw;
    int rot;
    float* ctl;
};

__device__ __forceinline__ Ctx mkctx(LAS unsigned char* lds) {
    Ctx C; int t = threadIdx.x; asm volatile("" : "+v"(t)); int b = blockIdx.x; asm volatile("" : "+s"(b)); int g = gridDim.x; asm volatile("" : "+s"(g));
    C.tid = t; C.lane = t & 63; C.wave = __builtin_amdgcn_readfirstlane(t >> 6); C.bid = b; C.G = g; C.gw = b * NWAVES + C.wave; C.ngw = g * NWAVES; C.rot = 0;
    int io = 29, iw = 30; asm volatile("" : "+s"(io)); asm volatile("" : "+s"(iw));
    unsigned char* const* ka = (unsigned char* const*)__builtin_amdgcn_kernarg_segment_ptr();
    C.out = (float*)ka[io]; C.ws = ka[iw]; C.ctl = (float*)(C.ws + WS_CTL); C.lds = lds;
    return C;
}
__device__ __forceinline__ const float* resid_row(const Ctx& C, int l, int m) {
    const int b = m / SS, s = m - b * SS;
    if (s < LC) { const float* base = (l == 0) ? INP(2) : (const float*)(C.ws + WS_XC1); return base + (size_t)(b * LC + s) * DM; }
    const float* base = (l == 0) ? INP(0) : C.out; return base + (size_t)(b * TT + (s - LC)) * DM;
}

__device__ __forceinline__ void phase_prep(Ctx& C) {
    LAS float* sl = (LAS float*)C.lds;
    LAS float* red = (LAS float*)(C.lds + 32768);
    for (int i = C.tid; i < 5 * 1024; i += NTHR) { const int r = i >> 10, k = i & 1023; const float v = (r < 4) ? INP(1)[r * 1024 + k] : INP(3)[k]; sl[i] = siluf_(v); }
    __syncthreads();
    for (int it = C.bid; it < 2 * 96; it += C.G) {
        const int l = it / 96, grp = it % 96, kg = C.tid >> 5, cj = C.tid & 31, col = grp * 32 + cj;
        const float* w = INP(4) + (size_t)l * 1024 * 3072 + col;
        float a0 = 0.f, a1 = 0.f, a2 = 0.f, a3 = 0.f, a4 = 0.f;
#pragma unroll 8
        for (int k = kg * 64; k < kg * 64 + 64; ++k) { const float wv = w[(size_t)k * 3072]; a0 += sl[k] * wv; a1 += sl[1024 + k] * wv; a2 += sl[2048 + k] * wv; a3 += sl[3072 + k] * wv; a4 += sl[4096 + k] * wv; }
        red[(kg * 32 + cj) * 5 + 0] = a0; red[(kg * 32 + cj) * 5 + 1] = a1; red[(kg * 32 + cj) * 5 + 2] = a2; red[(kg * 32 + cj) * 5 + 3] = a3; red[(kg * 32 + cj) * 5 + 4] = a4;
        __syncthreads();
        if (C.tid < 160) { const int c2 = C.tid / 5, r = C.tid % 5; float s = 0.f;
            for (int g = 0; g < 16; ++g) s += red[(g * 32 + c2) * 5 + r];
            C.ctl[CT_MOD + (l * 5 + r) * 3072 + grp * 32 + c2] = s + INP(5)[l * 3072 + grp * 32 + c2]; }
        __syncthreads();
    }
    const int gt = C.bid * NTHR + C.tid, ngt = C.G * NTHR;
    for (int i = gt; i < 4096; i += ngt) { const int pos = i >> 6, f = i & 63; const float inv = powf(10000.f, -(float)f / 64.f), ang = (float)pos * inv;
        C.ctl[CT_ROPER + i] = cosf(ang); C.ctl[CT_ROPER + 4096 + i] = sinf(ang); }
    for (int i = gt; i < 1024; i += ngt) { const int pos = i >> 4, f = i & 15; const float inv = powf(10000.f, -(float)f / 16.f), ang = (float)pos * inv;
        C.ctl[CT_ROPEM + i] = cosf(ang); C.ctl[CT_ROPEM + 1024 + i] = sinf(ang); }
    for (int i = gt; i < 4096; i += ngt) C.ctl[CT_SP + i] = log1pf(expf(-INP(14)[i]));
    for (int i = gt; i < 16; i += ngt) C.ctl[CT_LG + i] = -log1pf(expf(-INP(15)[i])) * LOG2E;
}

__device__ __forceinline__ void tr_item(const float* W, int ldw, int k0, int n0, bf16_t* WT, int ldt, int drow0, int dk0, LAS float* scr, int lane) {
#pragma unroll 8
    for (int i = 0; i < 32; ++i) { const int kk = 2 * i + (lane >> 5); scr[kk * 33 + (lane & 31)] = W[(size_t)(k0 + kk) * ldw + n0 + (lane & 31)]; }
    asm volatile("s_waitcnt lgkmcnt(0)" ::: "memory");
    const int c = lane & 7;
#pragma unroll
    for (int j = 0; j < 4; ++j) { const int n = (lane >> 3) + 8 * j; const LAS float* s = scr + (8 * c) * 33 + n;
        u32x4 o; o.x = pk2(s[0 * 33], s[1 * 33]); o.y = pk2(s[2 * 33], s[3 * 33]); o.z = pk2(s[4 * 33], s[5 * 33]); o.w = pk2(s[6 * 33], s[7 * 33]);
        *(u32x4*)(WT + (size_t)(drow0 + n) * ldt + dk0 + 8 * c) = o; }
    asm volatile("s_waitcnt lgkmcnt(0)" ::: "memory");
}
__device__ __forceinline__ void conv_rows(Ctx& C, const float* W, int ldw, int K, int scol0, bf16_t* WT, int ldt, int drow0, int dk0, int nrows, LAS float* scr) {
    const int nkb = K / 64, items = nkb * (nrows / 32);
    int g0 = C.gw - C.rot; if (g0 < 0) g0 += C.ngw; C.rot = (C.rot + items) % C.ngw;
    for (int it = g0; it < items; it += C.ngw) { const int nb = it / nkb, kb = it - nb * nkb;
        tr_item(W, ldw, kb * 64, scol0 + nb * 32, WT, ldt, drow0 + nb * 32, dk0 + kb * 64, scr, C.lane); }
}
__device__ __forceinline__ int ropeperm(int j) { const int h = j >> 8, jj = j & 255, half = jj >> 7, g = (jj & 127) >> 3, r8 = jj & 7; return h * 256 + (half * 2 + (r8 >> 2)) * 64 + g * 4 + (r8 & 3); }
__device__ __forceinline__ void tr_item_rope(const float* W, int ldw, int k0, int scol0, int jbase, bf16_t* WT, int ldt, int drow0, int dk0, LAS float* scr, int lane) {
    const int sc = scol0 + ropeperm(jbase + (lane & 31));
#pragma unroll 8
    for (int i = 0; i < 32; ++i) { const int kk = 2 * i + (lane >> 5); scr[kk * 33 + (lane & 31)] = W[(size_t)(k0 + kk) * ldw + sc]; }
    asm volatile("s_waitcnt lgkmcnt(0)" ::: "memory");
    const int c = lane & 7;
#pragma unroll
    for (int j = 0; j < 4; ++j) { const int n = (lane >> 3) + 8 * j; const LAS float* s = scr + (8 * c) * 33 + n;
        u32x4 o; o.x = pk2(s[0 * 33], s[1 * 33]); o.y = pk2(s[2 * 33], s[3 * 33]); o.z = pk2(s[4 * 33], s[5 * 33]); o.w = pk2(s[6 * 33], s[7 * 33]);
        *(u32x4*)(WT + (size_t)(drow0 + n) * ldt + dk0 + 8 * c) = o; }
    asm volatile("s_waitcnt lgkmcnt(0)" ::: "memory");
}
__device__ __forceinline__ void conv_rows_rope(Ctx& C, const float* W, int ldw, int K, int scol0, bf16_t* WT, int ldt, int drow0, int nrows, LAS float* scr) {
    const int nkb = K / 64, items = nkb * (nrows / 32);
    int g0 = C.gw - C.rot; if (g0 < 0) g0 += C.ngw; C.rot = (C.rot + items) % C.ngw;
    for (int it = g0; it < items; it += C.ngw) { const int nb = it / nkb, kb = it - nb * nkb;
        tr_item_rope(W, ldw, kb * 64, scol0, nb * 32, WT, ldt, drow0 + nb * 32, kb * 64, scr, C.lane); }
}
__device__ __forceinline__ void zero_rows(Ctx& C, bf16_t* WT, int ldt, int drow0, int dk0, int nrows, int ncols) {
    const int per = ncols / 8, items = nrows * per;
    int g0 = C.gw - C.rot; if (g0 < 0) g0 += C.ngw; C.rot = (C.rot + (items + 63) / 64) % C.ngw;
    for (int it = g0 * 64 + C.lane; it < items; it += C.ngw * 64) { const int r = it / per, c = it - r * per; *(u32x4*)(WT + (size_t)(drow0 + r) * ldt + dk0 + c * 8) = (u32x4){0u, 0u, 0u, 0u}; }
}
__device__ __forceinline__ void phase_wconv_early(Ctx& C, int l) {
    LAS float* scr = (LAS float*)(C.lds + C.wave * 16384);
    unsigned char* ws = C.ws;
    const float* win = INP(7) + (size_t)l * 1024 * INC;
    bf16_t* WT1 = (bf16_t*)(ws + W_WT1);
    conv_rows(C, win, INC, 1024, 0, WT1, 1024, 0, 0, 1024, scr);
    conv_rows_rope(C, win, INC, 1024, 2048, WT1, 1024, 1024, 1024, scr);
    conv_rows_rope(C, win, INC, 1024, 3072, WT1, 1024, 2048, 1024, scr);
    conv_rows(C, win, INC, 1024, 4096, WT1, 1024, 3072, 0, 1024, scr);
    conv_rows(C, win, INC, 1024, 6144, WT1, 1024, 4096, 0, 704, scr);
    zero_rows(C, WT1, 1024, 4800, 0, 64, 1024);
    const float* wq = INP(18) + (size_t)l * 384 * 1536; bf16_t* WTQ = (bf16_t*)(ws + W_WTQ);
    for (int h = 0; h < 8; ++h) { conv_rows(C, wq, 1536, 384, h * 192, WTQ, 384, h * 128, 0, 128, scr); conv_rows(C, wq, 1536, 384, h * 192 + 128, WTQ, 384, 1024 + h * 64, 0, 64, scr); }
    const float* wkv = INP(20) + (size_t)l * 256 * 2048; bf16_t* WTKV = (bf16_t*)(ws + W_WTKV);
    for (int h = 0; h < 8; ++h) { conv_rows(C, wkv, 2048, 256, h * 256, WTKV, 256, h * 128, 0, 128, scr); conv_rows(C, wkv, 2048, 256, h * 256 + 128, WTKV, 256, 1024 + h * 128, 0, 128, scr); }
    bf16_t* WTL = (bf16_t*)(ws + W_WTL);
    for (int d = 0; d < 2; ++d) for (int n = 0; n < 8; ++n) for (int mat = 0; mat < 2; ++mat) {
        const float* w = INP(mat == 0 ? 10 : 12) + ((size_t)(l * 2 + d) * 8 + n) * 128 * 128;
        const int drow0 = d * 2048 + n * 256 + mat * 128;
        conv_rows(C, w, 128, 128, 0, WTL, 256, drow0, (n & 1) * 128, 128, scr);
        zero_rows(C, WTL, 256, drow0, ((n & 1) ^ 1) * 128, 128, 128);
    }
}
__device__ __forceinline__ void phase_wconv_late(Ctx& C, int l) {
    LAS float* scr = (LAS float*)(C.lds + C.wave * 16384);
    unsigned char* ws = C.ws;
    const float* win = INP(7) + (size_t)l * 1024 * INC;
    bf16_t* WTG = (bf16_t*)(ws + W_WTG);
    conv_rows(C, win, INC, 1024, 1024, WTG, 1024, 0, 0, 1024, scr);
    conv_rows(C, win, INC, 1024, 5120, WTG, 1024, 1024, 0, 1024, scr);
    conv_rows(C, win, INC, 1024, 6848, WTG, 1024, 2048, 0, 1024, scr);
    conv_rows(C, win, INC, 1024, 7872, (bf16_t*)(ws + W_WTGM), 1024, 0, 0, 3072, scr);
    for (int i = 0; i < 3; ++i) conv_rows(C, INP(25 + i) + (size_t)l * 1024 * 1024, 1024, 1024, 0, (bf16_t*)(ws + W_WTD) + (size_t)i * 1024 * 1024, 1024, 0, 0, 1024, scr);
    conv_rows(C, INP(28) + (size_t)l * 1024 * 1024, 1024, 1024, 0, (bf16_t*)(ws + W_WTO), 1024, 0, 0, 1024, scr);
}

__device__ __forceinline__ void phase_h(Ctx& C, int l, bf16_t* H) {
    const float* gain = INP(6) + l * 1024;
    for (int m = C.gw; m < MR; m += C.ngw) {
        const int b = m / SS, s = m - b * SS, r = (s < LC) ? 4 : b;
        const float* xr = resid_row(C, l, m);
        const float* mod = C.ctl + CT_MOD + (l * 5 + r) * 3072;
        f32x4 v[4]; float ss = 0.f;
#pragma unroll
        for (int j = 0; j < 4; ++j) { v[j] = *(const f32x4*)(xr + 4 * C.lane + 256 * j); ss += (v[j].x * v[j].x + v[j].y * v[j].y) + (v[j].z * v[j].z + v[j].w * v[j].w); }
        const float rstd = RSQ(wave_sum(ss) * (1.f / 1024.f) + EPS);
#pragma unroll
        for (int j = 0; j < 4; ++j) { const int c = 4 * C.lane + 256 * j;
            const f32x4 g = *(const f32x4*)(gain + c), sh = *(const f32x4*)(mod + c), sc = *(const f32x4*)(mod + 1024 + c);
            const f32x4 y = (v[j] * rstd) * g;
            const f32x4 o = y * (sc + 1.0f) + sh;
            u32x2 w; w.x = pk2(o.x, o.y); w.y = pk2(o.z, o.w);
            *(u32x2*)(H + (size_t)m * 1024 + c) = w; }
    }
}

using pg8::Unit;
struct ProbPlain {
    const bf16_t* A; const bf16_t* Bt; int lda, ldb, K;
    __device__ __forceinline__ void get(const Unit& u, const char*& a, const char*& b, int& lda_) const {
        a = (const char*)(A + (size_t)u.pm * 256 * lda); b = (const char*)(Bt + (size_t)u.pn * 256 * ldb); lda_ = lda; }
};
struct ProbLru {
    const bf16_t* A; const bf16_t* Bt; int ldb, K;
    __device__ __forceinline__ void get(const Unit& u, const char*& a, const char*& b, int& lda_) const {
        a = (const char*)(A + (size_t)u.pm * 256 * 1024 + (u.pn >> 1) * 256); b = (const char*)(Bt + (size_t)u.pn * 256 * 256); lda_ = 1024; }
};
struct ProbD {
    unsigned char* ws; int ldb, K;
    __device__ __forceinline__ void get(const Unit& u, const char*& a, const char*& b, int& lda_) const {
        const int i = (u.z & 7) >> 1;
        if ((u.z & 1) == 0) { a = (const char*)(ws + AR_MD + (size_t)u.pm * 256 * 1024 * 2); b = (const char*)(ws + W_WTGM + ((size_t)i * 1024 + u.pn * 256) * 1024 * 2); lda_ = 1024; }
        else { const size_t yo = (i == 0) ? AR_XA : (i == 1) ? AR_YB : AR_QN;
            a = (const char*)(ws + yo + (size_t)u.pm * 256 * 1024 * 2); b = (const char*)(ws + W_WTD + ((size_t)i * 1024 + u.pn * 256) * 1024 * 2); lda_ = 1024; }
    }
};

#define EPI_ARGS const f32x4 (&acc)[2][2][4][2], const Unit& u, int wr, int wc, int fr, int fq
template <size_t O0, int L0, size_t O1, int L1, size_t O2, int L2, int T1, int T2>
struct EpiStore3 {
    static constexpr bool PERM = true;
    unsigned char* ws;
    __device__ __forceinline__ void operator()(EPI_ARGS) const {
        bf16_t* bs; int ldc, ct;
        size_t off;
        if (u.pn < T1) { off = O0; ldc = L0; ct = u.pn; } else if (u.pn < T2) { off = O1; ldc = L1; ct = u.pn - T1; } else { off = O2; ldc = L2; ct = u.pn - T2; }
        bs = (bf16_t*)(ws + off);
        const int row0 = u.pm * 256 + wr * 64 + fr, col0 = ct * 256 + wc * 32 + 8 * fq;
#pragma unroll
        for (int ai = 0; ai < 2; ++ai)
#pragma unroll
            for (int m = 0; m < 4; ++m) { bf16_t* rowp = bs + (size_t)(row0 + ai * 128 + m * 16) * ldc + col0;
#pragma unroll
                for (int bj = 0; bj < 2; ++bj) { const f32x4 v0 = acc[ai][bj][m][0], v1 = acc[ai][bj][m][1];
                    u32x4 w; w.x = pg8::cvt_pk_bf16(v0[0], v0[1]); w.y = pg8::cvt_pk_bf16(v0[2], v0[3]); w.z = pg8::cvt_pk_bf16(v1[0], v1[1]); w.w = pg8::cvt_pk_bf16(v1[2], v1[3]);
                    *(u32x4*)(rowp + bj * 128) = w; } }
    }
};
struct EpiKV {
    static constexpr bool PERM = true;
    unsigned char* ws; const float* gkn; LAS float* red;
    __device__ __forceinline__ void operator()(EPI_ARGS) const {
        bf16_t* bs = (bf16_t*)(ws + AR_KV);
        const int row0 = u.pm * 256 + wr * 64 + fr, col0 = u.pn * 256 + wc * 32 + 8 * fq;
        const bool knope = u.pn < 4;
        float g[8];
#pragma unroll
        for (int e = 0; e < 8; ++e) g[e] = 1.f;
        if (knope) {
#pragma unroll
            for (int ai = 0; ai < 2; ++ai)
#pragma unroll
                for (int m = 0; m < 4; ++m)
#pragma unroll
                    for (int bj = 0; bj < 2; ++bj) { const f32x4 v0 = acc[ai][bj][m][0], v1 = acc[ai][bj][m][1];
                        float ss = ((v0[0] * v0[0] + v0[1] * v0[1]) + (v0[2] * v0[2] + v0[3] * v0[3])) + ((v1[0] * v1[0] + v1[1] * v1[1]) + (v1[2] * v1[2] + v1[3] * v1[3]));
                        ss += __shfl_xor(ss, 16); ss += __shfl_xor(ss, 32);
                        if (fq == 0) red[((ai * 128 + wr * 64 + m * 16 + fr) * 2 + bj) * 4 + wc] = ss; }
            asm volatile("s_waitcnt lgkmcnt(0)" ::: "memory"); __builtin_amdgcn_s_barrier(); asm volatile("" ::: "memory");
            const f32x4 ga = *(const f32x4*)(gkn + wc * 32 + 8 * fq), gb = *(const f32x4*)(gkn + wc * 32 + 8 * fq + 4);
            g[0] = ga[0]; g[1] = ga[1]; g[2] = ga[2]; g[3] = ga[3]; g[4] = gb[0]; g[5] = gb[1]; g[6] = gb[2]; g[7] = gb[3];
        }
#pragma unroll
        for (int ai = 0; ai < 2; ++ai)
#pragma unroll
            for (int m = 0; m < 4; ++m) { bf16_t* rowp = bs + (size_t)(row0 + ai * 128 + m * 16) * 2048 + col0;
#pragma unroll
                for (int bj = 0; bj < 2; ++bj) { f32x4 v0 = acc[ai][bj][m][0], v1 = acc[ai][bj][m][1];
                    float rs = 1.f;
                    if (knope) { const f32x4 t = *(const LAS f32x4*)(red + ((ai * 128 + wr * 64 + m * 16 + fr) * 2 + bj) * 4); rs = RSQ(((t[0] + t[1]) + (t[2] + t[3])) * (1.f / 128.f) + EPS); }
                    u32x4 w; w.x = pg8::cvt_pk_bf16(v0[0] * rs * g[0], v0[1] * rs * g[1]); w.y = pg8::cvt_pk_bf16(v0[2] * rs * g[2], v0[3] * rs * g[3]);
                    w.z = pg8::cvt_pk_bf16(v1[0] * rs * g[4], v1[1] * rs * g[5]); w.w = pg8::cvt_pk_bf16(v1[2] * rs * g[6], v1[3] * rs * g[7]);
                    *(u32x4*)(rowp + bj * 128) = w; }
                asm volatile("" ::: "memory"); }
    }
};
struct EpiG1 {
    static constexpr bool PERM = true;
    unsigned char* ws; const float* cs;
    __device__ __forceinline__ void operator()(EPI_ARGS) const {
        bf16_t* bs; int ldc, ct;
        if (u.pn < 4) { bs = (bf16_t*)(ws + AR_XA); ldc = 1024; ct = u.pn; } else if (u.pn < 16) { bs = (bf16_t*)(ws + AR_RQKV); ldc = 3072; ct = u.pn - 4; } else { bs = (bf16_t*)(ws + AR_MD); ldc = 768; ct = u.pn - 16; }
        const int row0 = u.pm * 256 + wr * 64 + fr, col0 = ct * 256 + wc * 32 + 8 * fq;
        const bool rope = (u.pn >= 4) && (u.pn < 12), iskey = (u.pn >= 8);
        const int bq = u.pm / 17, s0 = (u.pm - bq * 17) * 256 + wr * 64 + fr;
        const int f0 = (wc * 4 + fq) * 4;
#pragma unroll
        for (int ai = 0; ai < 2; ++ai)
#pragma unroll
            for (int m = 0; m < 4; ++m) { bf16_t* rowp = bs + (size_t)(row0 + ai * 128 + m * 16) * ldc + col0;
                const int s = s0 + ai * 128 + m * 16, t = s - LC; const bool lat = s >= LC;
#pragma unroll
                for (int bj = 0; bj < 2; ++bj) { f32x4 v0 = acc[ai][bj][m][0], v1 = acc[ai][bj][m][1];
                    if (rope) {
                        if (lat) { const int pos = bj ? (t & 63) : (t >> 6); const f32x4 c = *(const f32x4*)(cs + pos * 64 + f0), sn = *(const f32x4*)(cs + 4096 + pos * 64 + f0);
                            const f32x4 a = v0 * c - v1 * sn, b = v1 * c + v0 * sn; v0 = a; v1 = b; }
                        if (iskey) { v0 = v0 * 0.0625f; v1 = v1 * 0.0625f; } }
                    u32x4 w; w.x = pg8::cvt_pk_bf16(v0[0], v0[1]); w.y = pg8::cvt_pk_bf16(v0[2], v0[3]); w.z = pg8::cvt_pk_bf16(v1[0], v1[1]); w.w = pg8::cvt_pk_bf16(v1[2], v1[3]);
                    *(u32x4*)(rowp + bj * 128) = w; }
                asm volatile("" ::: "memory"); }
    }
};
typedef f16_t f16x8 __attribute__((ext_vector_type(8)));
struct EpiLru {
    static constexpr bool PERM = true;
    const bf16_t* U; f16_t* RI; const float* ba; const float* bx; const float* sp;
    __device__ __forceinline__ void operator()(EPI_ARGS) const {
        const int row0 = u.pm * 256 + wr * 64 + fr, ch0 = u.pn * 128 + wc * 32 + 8 * fq;
        float bav[8], bxv[8], spv[8];
#pragma unroll
        for (int e = 0; e < 8; ++e) { bav[e] = ba[ch0 + e]; bxv[e] = bx[ch0 + e]; spv[e] = sp[ch0 + e] * (-8.f); }
#pragma unroll
        for (int ai = 0; ai < 2; ++ai)
#pragma unroll
            for (int m = 0; m < 4; ++m) { const int row = row0 + ai * 128 + m * 16;
                const u32x4 uw = *(const u32x4*)(U + (size_t)row * 1024 + ch0);
                float uv[8] = {lo_bf(uw.x), hi_bf(uw.x), lo_bf(uw.y), hi_bf(uw.y), lo_bf(uw.z), hi_bf(uw.z), lo_bf(uw.w), hi_bf(uw.w)};
                f16x8 la, bc;
#pragma unroll
                for (int e = 0; e < 8; ++e) { const float rp = acc[ai][0][m][e >> 2][e & 3] + bav[e], ip = acc[ai][1][m][e >> 2][e & 3] + bxv[e];
                    const float r = sigmoidf_(rp), ig = sigmoidf_(ip);
                    const float loga = r * spv[e];
                    const float bb = SQRT(fmaxf(-expm1f(2.f * loga), 0.f)) * (ig * uv[e]);
                    la[e] = (f16_t)(loga * LOG2E); bc[e] = (f16_t)bb; }
                *(f16x8*)(RI + (size_t)row * 2048 + ch0) = la; *(f16x8*)(RI + (size_t)row * 2048 + 1024 + ch0) = bc;
                asm volatile("" ::: "memory"); }
    }
};
struct EpiGate {
    static constexpr bool PERM = true;
    unsigned char* ws;
    __device__ __forceinline__ void operator()(EPI_ARGS) const {
        const int br = u.pn >> 2; const size_t yo = (br == 0) ? AR_XA : (br == 1) ? AR_YB : AR_QN; bf16_t* bs = (bf16_t*)(ws + yo); const int ldc = 1024;
        const int row0 = u.pm * 256 + wr * 64 + fr, col0 = (u.pn & 3) * 256 + wc * 32 + 8 * fq;
#pragma unroll
        for (int ai = 0; ai < 2; ++ai)
#pragma unroll
            for (int m = 0; m < 4; ++m) { bf16_t* rowp = bs + (size_t)(row0 + ai * 128 + m * 16) * ldc + col0;
#pragma unroll
                for (int bj = 0; bj < 2; ++bj) { const f32x4 v0 = acc[ai][bj][m][0], v1 = acc[ai][bj][m][1];
                    const u32x4 y = *(const u32x4*)(rowp + bj * 128);
                    u32x4 w; w.x = pg8::cvt_pk_bf16(lo_bf(y.x) * siluf_(v0[0]), hi_bf(y.x) * siluf_(v0[1])); w.y = pg8::cvt_pk_bf16(lo_bf(y.y) * siluf_(v0[2]), hi_bf(y.y) * siluf_(v0[3]));
                    w.z = pg8::cvt_pk_bf16(lo_bf(y.z) * siluf_(v1[0]), hi_bf(y.z) * siluf_(v1[1])); w.w = pg8::cvt_pk_bf16(lo_bf(y.w) * siluf_(v1[2]), hi_bf(y.w) * siluf_(v1[3]));
                    *(u32x4*)(rowp + bj * 128) = w; }
                asm volatile("" ::: "memory"); }
    }
};
struct EpiD {
    static constexpr bool PERM = true;
    bf16_t* Z; unsigned char* gs; bf16_t* ZP;
    __device__ __forceinline__ void operator()(EPI_ARGS) const {
        const int col0 = u.pn * 256 + wc * 32 + 8 * fq, i = (u.z & 7) >> 1; const bool part = u.z >= 8;
        const int row0 = part ? ((u.pm / 17) * 256 + wr * 64 + fr) : (u.pm * 256 + wr * 64 + fr);
        bf16_t* const zb = part ? (ZP + (size_t)i * 1024 * 1024) : Z;
        const unsigned tq = (unsigned)(((wr * 4 + wc) * 64 + fq * 16 + fr) * 64);
        if ((u.z & 1) == 0) {
#pragma unroll
            for (int ai = 0; ai < 2; ++ai)
#pragma unroll
                for (int m = 0; m < 4; ++m)
#pragma unroll
                    for (int bj = 0; bj < 2; ++bj) { const f32x4 v0 = acc[ai][bj][m][0], v1 = acc[ai][bj][m][1];
                        u32x4 w; w.x = pg8::cvt_pk_bf16(sigmoidf_(v0[0]), sigmoidf_(v0[1])); w.y = pg8::cvt_pk_bf16(sigmoidf_(v0[2]), sigmoidf_(v0[3]));
                        w.z = pg8::cvt_pk_bf16(sigmoidf_(v1[0]), sigmoidf_(v1[1])); w.w = pg8::cvt_pk_bf16(sigmoidf_(v1[2]), sigmoidf_(v1[3]));
                        *(u32x4*)(gs + (((ai * 4 + m) * 2 + bj) >> 2) * 32768 + tq + (((ai * 4 + m) * 2 + bj) & 3) * 16) = w; }
        } else {
#pragma unroll
            for (int ai = 0; ai < 2; ++ai)
#pragma unroll
                for (int m = 0; m < 4; ++m) { bf16_t* zrow = zb + (size_t)(row0 + ai * 128 + m * 16) * 1024 + col0;
#pragma unroll
                    for (int bj = 0; bj < 2; ++bj) { const f32x4 v0 = acc[ai][bj][m][0], v1 = acc[ai][bj][m][1];
                        const u32x4 g = *(const u32x4*)(gs + (((ai * 4 + m) * 2 + bj) >> 2) * 32768 + tq + (((ai * 4 + m) * 2 + bj) & 3) * 16); bf16_t* zp = zrow + bj * 128;
                        float o0 = lo_bf(g.x) * v0[0], o1 = hi_bf(g.x) * v0[1], o2 = lo_bf(g.y) * v0[2], o3 = hi_bf(g.y) * v0[3], o4 = lo_bf(g.z) * v1[0], o5 = hi_bf(g.z) * v1[1], o6 = lo_bf(g.w) * v1[2], o7 = hi_bf(g.w) * v1[3];
                        if (i > 0 && !part) { const u32x4 zo = *(const u32x4*)zp; o0 += lo_bf(zo.x); o1 += hi_bf(zo.x); o2 += lo_bf(zo.y); o3 += hi_bf(zo.y); o4 += lo_bf(zo.z); o5 += hi_bf(zo.z); o6 += lo_bf(zo.w); o7 += hi_bf(zo.w); }
                        u32x4 w; w.x = pg8::cvt_pk_bf16(o0, o1); w.y = pg8::cvt_pk_bf16(o2, o3); w.z = pg8::cvt_pk_bf16(o4, o5); w.w = pg8::cvt_pk_bf16(o6, o7); *(u32x4*)zp = w; }
                    asm volatile("" ::: "memory"); }
        }
    }
};
struct EpiOut {
    static constexpr bool PERM = false;
    const float* xlat; const float* xctx; float* olat; float* octx; const float* mod;
    __device__ __forceinline__ void operator()(EPI_ARGS) const {
        const int b = u.pm / 17, isctx = (u.pm - b * 17) == 0;
        const float* gate = mod + (isctx ? 4 : b) * 3072 + 2048;
        const int col0 = u.pn * 256 + wc * 32 + 4 * fq;
        f32x4 gv[2][2];
#pragma unroll
        for (int bj = 0; bj < 2; ++bj)
#pragma unroll
            for (int n = 0; n < 2; ++n) gv[bj][n] = *(const f32x4*)(gate + col0 + bj * 128 + n * 16);
#pragma unroll
        for (int ai = 0; ai < 2; ++ai)
#pragma unroll
            for (int m = 0; m < 4; ++m) { const int s = (u.pm - b * 17) * 256 + ai * 128 + wr * 64 + m * 16 + fr;
                const size_t off = isctx ? ((size_t)(b * LC + s) * 1024 + col0) : ((size_t)(b * TT + (s - LC)) * 1024 + col0);
                const float* xin = isctx ? xctx : xlat; float* xo = isctx ? octx : olat;
#pragma unroll
                for (int bj = 0; bj < 2; ++bj)
#pragma unroll
                    for (int n = 0; n < 2; ++n) { const f32x4 xv = *(const f32x4*)(xin + off + bj * 128 + n * 16);
                        *(f32x4*)(xo + off + bj * 128 + n * 16) = xv + gv[bj][n] * acc[ai][bj][m][n]; }
                asm volatile("" ::: "memory"); }
    }
};

__device__ __forceinline__ void phase_ret_rope(Ctx& C, bf16_t* RQKV) {
    const float* cs = C.ctl + CT_ROPER; const float* sn = cs + 4096;
    for (int m = C.gw; m < MR; m += C.ngw) {
        const int b = m / SS, s = m - b * SS; const bool lat = s >= LC; const int t = s - LC, prow = lat ? (t >> 6) : 0, pcol = lat ? (t & 63) : 0;
        bf16_t* row = RQKV + (size_t)m * 3072;
#pragma unroll
        for (int j = 0; j < 16; ++j) {
            const int idx = j * 64 + C.lane, f = idx & 63, half = (idx >> 6) & 1, h = (idx >> 7) & 3, tz = idx >> 9;
            bf16_t* p = row + tz * 1024 + h * 256 + half * 128 + f;
            const float x1 = bf2f(p[0]), x2 = bf2f(p[64]);
            float o1 = x1, o2 = x2;
            if (lat) { const int pos = half ? pcol : prow; const float c = cs[pos * 64 + f], sv = sn[pos * 64 + f]; o1 = x1 * c - x2 * sv; o2 = x2 * c + x1 * sv; }
            if (tz) { o1 *= 0.0625f; o2 *= 0.0625f; }
            p[0] = (bf16_t)f2bf(o1); p[64] = (bf16_t)f2bf(o2);
        }
    }
}

#define RS_STEP(o, cnt, st) do { const bool up_ = (C.lane & (st)) != 0; _Pragma("unroll") for (int e_ = 0; e_ < (cnt) / 2; ++e_) { \
        const float send_ = up_ ? o[e_] : o[e_ + (cnt) / 2]; const float keep_ = up_ ? o[e_ + (cnt) / 2] : o[e_]; o[e_] = keep_ + __shfl_xor(send_, (st)); } } while (0)

__device__ __forceinline__ void phase_ret_naive(Ctx& C, int l, const bf16_t* RQKV, bf16_t* OI) {
    LAS unsigned char* qs = C.lds + C.wave * 512;
    const int nbu = (MR / 8) * 16;
    for (int bu = C.bid; bu < nbu; bu += C.G) {
        const int hq = bu & 15, h = hq >> 2, qd = hq & 3, n = (bu >> 4) * 8 + C.wave;
        const int b = n / SS, sn_ = n - b * SS;
        const float lgf = C.ctl[CT_LG + (l * 2 + 0) * 4 + h], lgb = C.ctl[CT_LG + (l * 2 + 1) * 4 + h];
        const int pfn = sn_, pbn = (sn_ < LC) ? (LC - 1 - sn_) : (SS + LC - 1 - sn_);
        asm volatile("s_waitcnt lgkmcnt(0)" ::: "memory");
        *(LAS u32x2*)(qs + C.lane * 8) = *(const u32x2*)(RQKV + (size_t)n * 3072 + h * 256 + C.lane * 4);
        asm volatile("s_waitcnt lgkmcnt(0)" ::: "memory");
        float o[64];
#pragma unroll
        for (int e = 0; e < 64; ++e) o[e] = 0.f;
        for (int sm = C.lane; sm < SS; sm += 64) {
            const bf16_t* krow = RQKV + (size_t)(b * SS + sm) * 3072 + 1024 + h * 256;
            float dot = 0.f;
#pragma unroll 4
            for (int c = 0; c < 32; ++c) { const u32x4 kv = *(const u32x4*)(krow + c * 8); const u32x4 qv = *(const LAS u32x4*)(qs + c * 16);
                dot += lo_bf(kv.x) * lo_bf(qv.x) + hi_bf(kv.x) * hi_bf(qv.x) + lo_bf(kv.y) * lo_bf(qv.y) + hi_bf(kv.y) * hi_bf(qv.y)
                     + lo_bf(kv.z) * lo_bf(qv.z) + hi_bf(kv.z) * hi_bf(qv.z) + lo_bf(kv.w) * lo_bf(qv.w) + hi_bf(kv.w) * hi_bf(qv.w); }
            const int pfm = sm, pbm = (sm < LC) ? (LC - 1 - sm) : (SS + LC - 1 - sm);
            float w = 0.f;
            if (pfn >= pfm) w += EX2(lgf * (float)(pfn - pfm));
            if (pbn >= pbm) w += EX2(lgb * (float)(pbn - pbm));
            const float ws_ = w * dot;
            const bf16_t* vrow = krow + 1024 + qd * 64;
#pragma unroll
            for (int c = 0; c < 8; ++c) { const u32x4 vv = *(const u32x4*)(vrow + c * 8);
                o[c * 8 + 0] += ws_ * lo_bf(vv.x); o[c * 8 + 1] += ws_ * hi_bf(vv.x); o[c * 8 + 2] += ws_ * lo_bf(vv.y); o[c * 8 + 3] += ws_ * hi_bf(vv.y);
                o[c * 8 + 4] += ws_ * lo_bf(vv.z); o[c * 8 + 5] += ws_ * hi_bf(vv.z); o[c * 8 + 6] += ws_ * lo_bf(vv.w); o[c * 8 + 7] += ws_ * hi_bf(vv.w); }
        }
        RS_STEP(o, 64, 32); RS_STEP(o, 32, 16); RS_STEP(o, 16, 8); RS_STEP(o, 8, 4); RS_STEP(o, 4, 2); RS_STEP(o, 2, 1);
        OI[(size_t)n * 1024 + h * 256 + qd * 64 + C.lane] = (bf16_t)f2bf(o[0]);
    }
}
__device__ __forceinline__ void phase_ret_ln(Ctx& C, int l, bf16_t* OI) {
    const float* gain = INP(16) + l * 1024;
    for (int m = C.gw; m < MR; m += C.ngw) {
#pragma unroll
        for (int h = 0; h < 4; ++h) { bf16_t* p = OI + (size_t)m * 1024 + h * 256 + C.lane * 4;
            const u32x2 w = *(const u32x2*)p; float x0 = lo_bf(w.x), x1 = hi_bf(w.x), x2 = lo_bf(w.y), x3 = hi_bf(w.y);
            const float mean = wave_sum((x0 + x1) + (x2 + x3)) * (1.f / 256.f);
            x0 -= mean; x1 -= mean; x2 -= mean; x3 -= mean;
            const float var = wave_sum((x0 * x0 + x1 * x1) + (x2 * x2 + x3 * x3)) * (1.f / 256.f);
            const float rstd = RSQ(var + EPS);
            const f32x4 g = *(const f32x4*)(gain + h * 256 + C.lane * 4);
            u32x2 o; o.x = pk2(x0 * rstd * g.x, x1 * rstd * g.y); o.y = pk2(x2 * rstd * g.z, x3 * rstd * g.w); *(u32x2*)p = o; }
    }
}

__device__ __forceinline__ void phase_md_post(Ctx& C, int l, bf16_t* MD) {
    const float* qn = INP(17) + l * 384; const float* kvn = INP(19) + l * 256; const float* gkr = INP(24) + l * 64;
    const float* cs = C.ctl + CT_ROPEM; const float* sn = cs + 1024;
    for (int m = C.gw; m < MR; m += C.ngw) {
        const int b = m / SS, s = m - b * SS; const bool lat = s >= LC; const int t = s - LC;
        bf16_t* row = MD + (size_t)m * 768;
        {   float x[6]; float ss = 0.f;
#pragma unroll
            for (int j = 0; j < 3; ++j) { const unsigned w = *(const unsigned*)(row + 2 * C.lane + 128 * j); x[2 * j] = lo_bf(w); x[2 * j + 1] = hi_bf(w); ss += x[2 * j] * x[2 * j] + x[2 * j + 1] * x[2 * j + 1]; }
            const float rstd = RSQ(wave_sum(ss) * (1.f / 384.f) + EPS);
#pragma unroll
            for (int j = 0; j < 3; ++j) { const int c = 2 * C.lane + 128 * j; *(unsigned*)(row + c) = pk2(x[2 * j] * rstd * qn[c], x[2 * j + 1] * rstd * qn[c + 1]); } }
        {   float x[4]; float ss = 0.f;
#pragma unroll
            for (int j = 0; j < 2; ++j) { const unsigned w = *(const unsigned*)(row + 384 + 2 * C.lane + 128 * j); x[2 * j] = lo_bf(w); x[2 * j + 1] = hi_bf(w); ss += x[2 * j] * x[2 * j] + x[2 * j + 1] * x[2 * j + 1]; }
            const float rstd = RSQ(wave_sum(ss) * (1.f / 256.f) + EPS);
#pragma unroll
            for (int j = 0; j < 2; ++j) { const int c = 2 * C.lane + 128 * j; *(unsigned*)(row + 384 + c) = pk2(x[2 * j] * rstd * kvn[c], x[2 * j + 1] * rstd * kvn[c + 1]); } }
        {   const float x = bf2f(row[640 + C.lane]);
            const float rstd = RSQ(wave_sum(x * x) * (1.f / 64.f) + EPS);
            float y = x * rstd * gkr[C.lane];
            if (lat) { const float pr = __shfl_xor(y, 16); const float rot = (C.lane & 16) ? pr : -pr; const int f = C.lane & 15, pos = (C.lane < 32) ? (t >> 6) : (t & 63);
                y = y * cs[pos * 16 + f] + rot * sn[pos * 16 + f]; }
            row[640 + C.lane] = (bf16_t)f2bf(y); }
    }
}
__device__ __forceinline__ void phase_qk_post(Ctx& C, int l, bf16_t* QN, bf16_t* QP, bf16_t* KV) {
    const float* gqn = INP(21) + l * 128; const float* gqr = INP(22) + l * 64; const float* gkn = INP(23) + l * 128;
    const float* cs = C.ctl + CT_ROPEM; const float* sn = cs + 1024;
    for (int m = C.gw; m < MR; m += C.ngw) {
        const int b = m / SS, s = m - b * SS; const bool lat = s >= LC; const int t = s - LC;
        bf16_t* qrow = QN + (size_t)m * 1024; bf16_t* prow = QP + (size_t)m * 512; bf16_t* krow = KV + (size_t)m * 2048;
#pragma unroll
        for (int h = 0; h < 8; ++h) {
            {   unsigned* p = (unsigned*)(qrow + h * 128 + 2 * C.lane); const unsigned w = *p; const float x0 = lo_bf(w), x1 = hi_bf(w);
                const float rstd = RSQ(wave_sum(x0 * x0 + x1 * x1) * (1.f / 128.f) + EPS);
                *p = pk2(x0 * rstd * gqn[2 * C.lane] * QSCALE, x1 * rstd * gqn[2 * C.lane + 1] * QSCALE); }
            {   bf16_t* p = prow + h * 64 + C.lane; const float x = bf2f(*p);
                const float rstd = RSQ(wave_sum(x * x) * (1.f / 64.f) + EPS);
                float y = x * rstd * gqr[C.lane];
                if (lat) { const float pr = __shfl_xor(y, 16); const float rot = (C.lane & 16) ? pr : -pr; const int f = C.lane & 15, pos = (C.lane < 32) ? (t >> 6) : (t & 63);
                    y = y * cs[pos * 16 + f] + rot * sn[pos * 16 + f]; }
                *p = (bf16_t)f2bf(y * QSCALE); }
            {   unsigned* p = (unsigned*)(krow + h * 128 + 2 * C.lane); const unsigned w = *p; const float x0 = lo_bf(w), x1 = hi_bf(w);
                const float rstd = RSQ(wave_sum(x0 * x0 + x1 * x1) * (1.f / 128.f) + EPS);
                *p = pk2(x0 * rstd * gkn[2 * C.lane], x1 * rstd * gkn[2 * C.lane + 1]); }
        }
    }
}

__device__ __forceinline__ void phase_attn_naive(Ctx& C, bool with_ctx, bf16_t* QN, const bf16_t* QP, const bf16_t* KV, const bf16_t* MD) {
    LAS unsigned char* qs = C.lds + C.wave * 512;
    const int nlat = NB * 8 * (TT / 8), nctx = with_ctx ? NB * 8 * (LC / 8) : 0;
    for (int bu = C.bid; bu < nlat + nctx; bu += C.G) {
        int b, h, s, nkeys;
        if (bu < nlat) { const int tb = bu % (TT / 8), bh = bu / (TT / 8); b = bh >> 3; h = bh & 7; s = LC + tb * 8 + C.wave; nkeys = SS; }
        else { const int r = bu - nlat, tb = r % (LC / 8), bh = r / (LC / 8); b = bh >> 3; h = bh & 7; s = tb * 8 + C.wave; nkeys = LC; }
        const size_t m = (size_t)b * SS + s;
        asm volatile("s_waitcnt lgkmcnt(0)" ::: "memory");
        if (C.lane < 32) *(LAS u32x2*)(qs + C.lane * 8) = *(const u32x2*)(QN + m * 1024 + h * 128 + C.lane * 4);
        else if (C.lane < 48) *(LAS u32x2*)(qs + 256 + (C.lane - 32) * 8) = *(const u32x2*)(QP + m * 512 + h * 64 + (C.lane - 32) * 4);
        asm volatile("s_waitcnt lgkmcnt(0)" ::: "memory");
        float o[128];
#pragma unroll
        for (int e = 0; e < 128; ++e) o[e] = 0.f;
        float mrun = -1e30f, lrun = 0.f;
        for (int key = C.lane; key < nkeys; key += 64) {
            const size_t kr = (size_t)b * SS + key;
            const bf16_t* kn = KV + kr * 2048 + h * 128; const bf16_t* kro = MD + kr * 768 + 640;
            float dot = 0.f;
#pragma unroll 4
            for (int c = 0; c < 16; ++c) { const u32x4 kv = *(const u32x4*)(kn + c * 8); const u32x4 qv = *(const LAS u32x4*)(qs + c * 16);
                dot += lo_bf(kv.x) * lo_bf(qv.x) + hi_bf(kv.x) * hi_bf(qv.x) + lo_bf(kv.y) * lo_bf(qv.y) + hi_bf(kv.y) * hi_bf(qv.y)
                     + lo_bf(kv.z) * lo_bf(qv.z) + hi_bf(kv.z) * hi_bf(qv.z) + lo_bf(kv.w) * lo_bf(qv.w) + hi_bf(kv.w) * hi_bf(qv.w); }
#pragma unroll 4
            for (int c = 0; c < 8; ++c) { const u32x4 kv = *(const u32x4*)(kro + c * 8); const u32x4 qv = *(const LAS u32x4*)(qs + 256 + c * 16);
                dot += lo_bf(kv.x) * lo_bf(qv.x) + hi_bf(kv.x) * hi_bf(qv.x) + lo_bf(kv.y) * lo_bf(qv.y) + hi_bf(kv.y) * hi_bf(qv.y)
                     + lo_bf(kv.z) * lo_bf(qv.z) + hi_bf(kv.z) * hi_bf(qv.z) + lo_bf(kv.w) * lo_bf(qv.w) + hi_bf(kv.w) * hi_bf(qv.w); }
            const float mnew = fmaxf(mrun, dot), alpha = EX2(mrun - mnew), p = EX2(dot - mnew);
            lrun = lrun * alpha + p; mrun = mnew;
            const bf16_t* vrow = KV + kr * 2048 + 1024 + h * 128;
#pragma unroll
            for (int c = 0; c < 16; ++c) { const u32x4 vv = *(const u32x4*)(vrow + c * 8);
                o[c * 8 + 0] = o[c * 8 + 0] * alpha + p * lo_bf(vv.x); o[c * 8 + 1] = o[c * 8 + 1] * alpha + p * hi_bf(vv.x);
                o[c * 8 + 2] = o[c * 8 + 2] * alpha + p * lo_bf(vv.y); o[c * 8 + 3] = o[c * 8 + 3] * alpha + p * hi_bf(vv.y);
                o[c * 8 + 4] = o[c * 8 + 4] * alpha + p * lo_bf(vv.z); o[c * 8 + 5] = o[c * 8 + 5] * alpha + p * hi_bf(vv.z);
                o[c * 8 + 6] = o[c * 8 + 6] * alpha + p * lo_bf(vv.w); o[c * 8 + 7] = o[c * 8 + 7] * alpha + p * hi_bf(vv.w); }
        }
        const float mall = wave_max(mrun), fsc = EX2(mrun - mall);
        const float lall = wave_sum(lrun * fsc);
#pragma unroll
        for (int e = 0; e < 128; ++e) o[e] *= fsc;
        RS_STEP(o, 128, 32); RS_STEP(o, 64, 16); RS_STEP(o, 32, 8); RS_STEP(o, 16, 4); RS_STEP(o, 8, 2); RS_STEP(o, 4, 1);
        const float inv = 1.f / lall;
        *(unsigned*)(QN + m * 1024 + h * 128 + 2 * C.lane) = pk2(o[0] * inv, o[1] * inv);
    }
}

__device__ __forceinline__ void phase_conv(Ctx& C, int l, const bf16_t* XA, bf16_t* U) {
    const float* cw = INP(8) + l * 4 * 1024; const float* cb = INP(9) + l * 1024;
    const int gt = C.bid * NTHR + C.tid, ngt = C.G * NTHR;
    for (int it = gt; it < MR * 128; it += ngt) {
        const int m = it >> 7, c0 = (it & 127) * 8, b = m / SS, s = m - b * SS;
        const int lo = (s < LC) ? 0 : LC, hi = (s < LC) ? LC : SS;
        float a[8];
#pragma unroll
        for (int e = 0; e < 8; ++e) a[e] = cb[c0 + e];
#pragma unroll
        for (int j = 0; j < 4; ++j) { const int sj = s + j - 2;
            if (sj >= lo && sj < hi) { const u32x4 xv = *(const u32x4*)(XA + (size_t)(b * SS + sj) * 1024 + c0); const float* w = cw + j * 1024 + c0;
                a[0] += w[0] * lo_bf(xv.x); a[1] += w[1] * hi_bf(xv.x); a[2] += w[2] * lo_bf(xv.y); a[3] += w[3] * hi_bf(xv.y);
                a[4] += w[4] * lo_bf(xv.z); a[5] += w[5] * hi_bf(xv.z); a[6] += w[6] * lo_bf(xv.w); a[7] += w[7] * hi_bf(xv.w); } }
        u32x4 o; o.x = pk2(a[0], a[1]); o.y = pk2(a[2], a[3]); o.z = pk2(a[4], a[5]); o.w = pk2(a[6], a[7]);
        *(u32x4*)(U + (size_t)m * 1024 + c0) = o;
    }
}
typedef f16_t f16x2 __attribute__((ext_vector_type(2)));
__device__ __forceinline__ void phase_scan1(Ctx& C, int d, const f16_t* RI, float* SUM) {
    for (int un = C.gw; un < NB * 68 * 8; un += C.ngw) {
        const int cg_ = un & 7, sg = (un >> 3) % 68, b = (un >> 3) / 68, ch = cg_ * 128 + 2 * C.lane;
        float A0 = 1.f, A1 = 1.f, H0 = 0.f, H1 = 0.f;
        const f16_t* base = RI + (size_t)(b * SS + sg * 64) * 2048 + ch;
#pragma unroll 16
        for (int i = 0; i < 64; ++i) { const int r = d ? (63 - i) : i;
            const f16x2 la = *(const f16x2*)(base + (size_t)r * 2048), bc = *(const f16x2*)(base + (size_t)r * 2048 + 1024);
            const float a0 = EX2((float)la[0]), a1 = EX2((float)la[1]);
            H0 = a0 * H0 + (float)bc[0]; H1 = a1 * H1 + (float)bc[1]; A0 *= a0; A1 *= a1; }
        float* sp = SUM + ((size_t)(b * 68 + sg) * 1024 + ch) * 2;
        *(f32x4*)sp = (f32x4){A0, H0, A1, H1};
    }
}
__device__ __forceinline__ void phase_scan3(Ctx& C, int d, const f16_t* RI, const float* SUM, bf16_t* YA) {
    for (int un = C.gw; un < NB * 68 * 8; un += C.ngw) {
        const int cg_ = un & 7, sg = (un >> 3) % 68, b = (un >> 3) / 68, ch = cg_ * 128 + 2 * C.lane;
        float H0 = 0.f, H1 = 0.f;
        const int npre = d ? ((sg < 4) ? (3 - sg) : (71 - sg)) : sg;
#pragma unroll 4
        for (int p = 0; p < npre; ++p) { const int ps = d ? ((p < 4) ? (3 - p) : (71 - p)) : p;
            const f32x4 v = *(const f32x4*)(SUM + ((size_t)(b * 68 + ps) * 1024 + ch) * 2);
            H0 = v[0] * H0 + v[1]; H1 = v[2] * H1 + v[3]; }
        const f16_t* base = RI + (size_t)(b * SS + sg * 64) * 2048 + ch;
        bf16_t* yb = YA + (size_t)(b * SS + sg * 64) * 1024 + ch;
#pragma unroll 16
        for (int i = 0; i < 64; ++i) { const int r = d ? (63 - i) : i;
            const f16x2 la = *(const f16x2*)(base + (size_t)r * 2048), bc = *(const f16x2*)(base + (size_t)r * 2048 + 1024);
            const float a0 = EX2((float)la[0]), a1 = EX2((float)la[1]);
            H0 = a0 * H0 + (float)bc[0]; H1 = a1 * H1 + (float)bc[1];
            unsigned* yp = (unsigned*)(yb + (size_t)r * 1024);
            if (d == 0) *yp = pk2(H0, H1); else { const unsigned w = *yp; *yp = pk2(lo_bf(w) + H0, hi_bf(w) + H1); } }
    }
}

template <int W> __device__ __forceinline__ float group_sum(float v) {
#pragma unroll
    for (int o = 1; o < W; o <<= 1) v += __shfl_xor(v, o);
    return v;
}
__device__ __forceinline__ void unpack8(const u32x4& w, float (&x)[8]) { x[0] = lo_bf(w.x); x[1] = hi_bf(w.x); x[2] = lo_bf(w.y); x[3] = hi_bf(w.y); x[4] = lo_bf(w.z); x[5] = hi_bf(w.z); x[6] = lo_bf(w.w); x[7] = hi_bf(w.w); }
__device__ __forceinline__ u32x4 pack8u(const float (&x)[8]) { u32x4 w; w.x = pk2(x[0], x[1]); w.y = pk2(x[2], x[3]); w.z = pk2(x[4], x[5]); w.w = pk2(x[6], x[7]); return w; }
__device__ __forceinline__ float sumsq8(const float (&x)[8]) { return ((x[0] * x[0] + x[1] * x[1]) + (x[2] * x[2] + x[3] * x[3])) + ((x[4] * x[4] + x[5] * x[5]) + (x[6] * x[6] + x[7] * x[7])); }

__device__ __forceinline__ void phase_h2(Ctx& C, int l, bf16_t* H) {
    const float* gain = INP(6) + l * 1024;
    for (int m0 = C.gw * 2; m0 < MR; m0 += C.ngw * 2) {
        f32x4 v[2][4]; float ss[2];
#pragma unroll
        for (int q = 0; q < 2; ++q) { const float* xr = resid_row(C, l, m0 + q);
#pragma unroll
            for (int j = 0; j < 4; ++j) v[q][j] = *(const f32x4*)(xr + 4 * C.lane + 256 * j); }
        const int b = m0 / SS, s = m0 - b * SS, r = (s < LC) ? 4 : b;
        const float* mod = C.ctl + CT_MOD + (l * 5 + r) * 3072;
#pragma unroll
        for (int q = 0; q < 2; ++q) { float a = 0.f;
#pragma unroll
            for (int j = 0; j < 4; ++j) a += (v[q][j].x * v[q][j].x + v[q][j].y * v[q][j].y) + (v[q][j].z * v[q][j].z + v[q][j].w * v[q][j].w);
            ss[q] = a; }
        ss[0] = wave_sum(ss[0]); ss[1] = wave_sum(ss[1]);
#pragma unroll
        for (int j = 0; j < 4; ++j) { const int c = 4 * C.lane + 256 * j;
            const f32x4 g = *(const f32x4*)(gain + c), sh = *(const f32x4*)(mod + c), sc = *(const f32x4*)(mod + 1024 + c) + 1.0f;
#pragma unroll
            for (int q = 0; q < 2; ++q) { const float rstd = RSQ(ss[q] * (1.f / 1024.f) + EPS);
                const f32x4 o = ((v[q][j] * rstd) * g) * sc + sh;
                u32x2 w; w.x = pk2(o.x, o.y); w.y = pk2(o.z, o.w);
                *(u32x2*)(H + (size_t)(m0 + q) * 1024 + c) = w; } }
    }
}
__device__ __forceinline__ void phase_md_post2(Ctx& C, int l, bf16_t* MD) {
    const float* qn = INP(17) + l * 384; const float* kvn = INP(19) + l * 256; const float* gkr = INP(24) + l * 64;
    const float* cs = C.ctl + CT_ROPEM; const float* sn = cs + 1024;
    const int L = C.lane;
    for (int m0 = C.gw * 2; m0 < MR; m0 += C.ngw * 2) {
        u32x4 w0[2], w1[2];
#pragma unroll
        for (int q = 0; q < 2; ++q) { const bf16_t* row = MD + (size_t)(m0 + q) * 768; w0[q] = *(const u32x4*)(row + 8 * L); w1[q] = (L < 32) ? *(const u32x4*)(row + 512 + 8 * L) : (u32x4){0u, 0u, 0u, 0u}; }
#pragma unroll
        for (int q = 0; q < 2; ++q) { const int m = m0 + q, b = m / SS, s = m - b * SS; const bool lat = s >= LC; const int t = s - LC;
            bf16_t* row = MD + (size_t)m * 768;
            float x0[8], x1[8]; unpack8(w0[q], x0); unpack8(w1[q], x1);
            const float s0 = sumsq8(x0), s1 = sumsq8(x1);
            const float sq = wave_sum(L < 48 ? s0 : 0.f), skv = wave_sum((L >= 48 ? s0 : 0.f) + (L < 16 ? s1 : 0.f)), skr = wave_sum((L >= 16 && L < 24) ? s1 : 0.f);
            const float rq = RSQ(sq * (1.f / 384.f) + EPS), rkv = RSQ(skv * (1.f / 256.f) + EPS), rkr = RSQ(skr * (1.f / 64.f) + EPS);
            {   const float* g = (L < 48) ? (qn + 8 * L) : (kvn + 8 * (L - 48)); const float rs = (L < 48) ? rq : rkv;
#pragma unroll
                for (int e = 0; e < 8; ++e) x0[e] *= rs * g[e];
                *(u32x4*)(row + 8 * L) = pack8u(x0); }
            if (L < 16) {
#pragma unroll
                for (int e = 0; e < 8; ++e) x1[e] *= rkv * kvn[128 + 8 * L + e];
            } else if (L < 24) {
#pragma unroll
                for (int e = 0; e < 8; ++e) x1[e] *= rkr * gkr[8 * (L - 16) + e];
            }
            float pr[8];
#pragma unroll
            for (int e = 0; e < 8; ++e) pr[e] = __shfl_xor(x1[e], 2);
            if (lat && L >= 16 && L < 24) { const int qt = (L - 16) >> 1, f0 = ((L - 16) & 1) * 8, pos = (qt < 2) ? (t >> 6) : (t & 63); const float sg = (qt & 1) ? 1.f : -1.f;
#pragma unroll
                for (int e = 0; e < 8; ++e) x1[e] = x1[e] * cs[pos * 16 + f0 + e] + sg * pr[e] * sn[pos * 16 + f0 + e]; }
            if (L < 24) *(u32x4*)(row + 512 + 8 * L) = pack8u(x1);
        }
    }
}
__device__ __forceinline__ void phase_qk_post2(Ctx& C, int l, bf16_t* QN, bf16_t* QP, bf16_t* KV) {
    const float* gqn = INP(21) + l * 128; const float* gqr = INP(22) + l * 64; const float* gkn = INP(23) + l * 128;
    const float* cs = C.ctl + CT_ROPEM; const float* sn = cs + 1024;
    const int L = C.lane;
    for (int m0 = C.gw * 2; m0 < MR; m0 += C.ngw * 2) {
        u32x4 a[2][2], k[2][2], p[2];
#pragma unroll
        for (int q = 0; q < 2; ++q) { const size_t m = m0 + q;
            a[q][0] = *(const u32x4*)(QN + m * 1024 + 8 * L); a[q][1] = *(const u32x4*)(QN + m * 1024 + 512 + 8 * L);
            k[q][0] = *(const u32x4*)(KV + m * 2048 + 8 * L); k[q][1] = *(const u32x4*)(KV + m * 2048 + 512 + 8 * L);
            p[q] = *(const u32x4*)(QP + m * 512 + 8 * L); }
#pragma unroll
        for (int q = 0; q < 2; ++q) { const int m = m0 + q, b = m / SS, s = m - b * SS; const bool lat = s >= LC; const int t = s - LC;
#pragma unroll
            for (int c = 0; c < 2; ++c) {
                float x[8]; unpack8(a[q][c], x);
                const float rs = RSQ(group_sum<16>(sumsq8(x)) * (1.f / 128.f) + EPS) * QSCALE;
#pragma unroll
                for (int e = 0; e < 8; ++e) x[e] *= rs * gqn[8 * (L & 15) + e];
                *(u32x4*)(QN + (size_t)m * 1024 + c * 512 + 8 * L) = pack8u(x);
                float y[8]; unpack8(k[q][c], y);
                const float rk = RSQ(group_sum<16>(sumsq8(y)) * (1.f / 128.f) + EPS);
#pragma unroll
                for (int e = 0; e < 8; ++e) y[e] *= rk * gkn[8 * (L & 15) + e];
                *(u32x4*)(KV + (size_t)m * 2048 + c * 512 + 8 * L) = pack8u(y); }
            {   float x[8]; unpack8(p[q], x);
                const float rs = RSQ(group_sum<8>(sumsq8(x)) * (1.f / 64.f) + EPS);
#pragma unroll
                for (int e = 0; e < 8; ++e) x[e] *= rs * gqr[8 * (L & 7) + e];
                float pr[8];
#pragma unroll
                for (int e = 0; e < 8; ++e) pr[e] = __shfl_xor(x[e], 2);
                if (lat) { const int qt = (L >> 1) & 3, f0 = (L & 1) * 8, pos = (qt < 2) ? (t >> 6) : (t & 63); const float sg = (qt & 1) ? 1.f : -1.f;
#pragma unroll
                    for (int e = 0; e < 8; ++e) x[e] = x[e] * cs[pos * 16 + f0 + e] + sg * pr[e] * sn[pos * 16 + f0 + e]; }
#pragma unroll
                for (int e = 0; e < 8; ++e) x[e] *= QSCALE;
                *(u32x4*)(QP + (size_t)m * 512 + 8 * L) = pack8u(x); }
        }
    }
}
__device__ __forceinline__ void phase_ret_ln3(Ctx& C, int l, bf16_t* OI, const bf16_t* OB) {
    const float* gain = INP(16) + l * 1024;
    const int L = C.lane;
    for (int m0 = C.gw * 2; m0 < MR; m0 += C.ngw * 2) {
        u32x4 a[2][2], bb[2][2];
#pragma unroll
        for (int q = 0; q < 2; ++q)
#pragma unroll
            for (int c = 0; c < 2; ++c) { a[q][c] = *(const u32x4*)(OI + (size_t)(m0 + q) * 1024 + c * 512 + 8 * L); bb[q][c] = *(const u32x4*)(OB + (size_t)(m0 + q) * 1024 + c * 512 + 8 * L); }
#pragma unroll
        for (int q = 0; q < 2; ++q)
#pragma unroll
            for (int c = 0; c < 2; ++c) { float x[8], y[8]; unpack8(a[q][c], x); unpack8(bb[q][c], y);
                float s = 0.f;
#pragma unroll
                for (int e = 0; e < 8; ++e) { x[e] += y[e]; s += x[e]; }
                const float mean = group_sum<32>(s) * (1.f / 256.f);
                float v = 0.f;
#pragma unroll
                for (int e = 0; e < 8; ++e) { x[e] -= mean; v += x[e] * x[e]; }
                const float rstd = RSQ(group_sum<32>(v) * (1.f / 256.f) + EPS);
#pragma unroll
                for (int e = 0; e < 8; ++e) x[e] *= rstd * gain[c * 512 + 8 * L + e];
                *(u32x4*)(OI + (size_t)(m0 + q) * 1024 + c * 512 + 8 * L) = pack8u(x); }
    }
}

__device__ __forceinline__ void phase_zsum(Ctx& C, const bf16_t* ZP, bf16_t* Z) {
    const int gt = C.bid * NTHR + C.tid, ngt = C.G * NTHR;
    for (int it = gt; it < 1024 * 128; it += ngt) { const int r = it >> 7, c0 = (it & 127) * 8, b = r >> 8, s = r & 255;
        const u32x4 a = *(const u32x4*)(ZP + (size_t)r * 1024 + c0), bq = *(const u32x4*)(ZP + (size_t)(1024 + r) * 1024 + c0), cq = *(const u32x4*)(ZP + (size_t)(2048 + r) * 1024 + c0);
        float x[8], y[8], z[8]; unpack8(a, x); unpack8(bq, y); unpack8(cq, z);
#pragma unroll
        for (int e = 0; e < 8; ++e) x[e] += y[e] + z[e];
        *(u32x4*)(Z + (size_t)(b * SS + s) * 1024 + c0) = pack8u(x); }
}

typedef float f32x16 __attribute__((ext_vector_type(16)));
typedef short v4i16_t __attribute__((ext_vector_type(4)));
constexpr int AT_KP = 400, AT_VP = 320;
constexpr int AT_KB = 64 * AT_KP, AT_VB = 64 * AT_VP, AT_STG = AT_KB + AT_VB, AT_WSF = 2 * AT_STG;
__device__ __forceinline__ int crow(int r, int hi) { return (r & 3) + 8 * (r >> 2) + 4 * hi; }
__device__ __forceinline__ bf16x8 pack8(float a, float b, float c, float d, float e, float f, float g, float h) {
    u32x4 w; w.x = pg8::cvt_pk_bf16(a, b); w.y = pg8::cvt_pk_bf16(c, d); w.z = pg8::cvt_pk_bf16(e, f); w.w = pg8::cvt_pk_bf16(g, h); return __builtin_bit_cast(bf16x8, w); }
__device__ __forceinline__ bf16x8 tr2(LAS unsigned char* p0, LAS unsigned char* p1) {
    const v4i16_t lo = __builtin_amdgcn_ds_read_tr16_b64_v4i16((LAS v4i16_t*)p0), hi = __builtin_amdgcn_ds_read_tr16_b64_v4i16((LAS v4i16_t*)p1);
    return (bf16x8){lo[0], lo[1], lo[2], lo[3], hi[0], hi[1], hi[2], hi[3]}; }

__device__ __forceinline__ void phase_attn(Ctx& C, int l, bool with_ctx, bf16_t* QN, const bf16_t* QP, const bf16_t* KV, const bf16_t* MD) {
    const float* gqn = INP(21) + l * 128; const float* gqr = INP(22) + l * 64; const float* csm = C.ctl + CT_ROPEM;
    const int lane = C.lane, r32 = lane & 31, hi = lane >> 5, wave = C.wave, tid = C.tid;
    LAS unsigned char* lds = C.lds;
    LAS float* wsf = (LAS float*)(lds + AT_WSF + wave * 128);
    const int nunits = 512 + (with_ctx ? 32 : 0);
    const int rowA = tid >> 4, ccA = tid & 15, rowR = tid >> 3, ccR = tid & 7;
    const int i16 = lane & 15, q4 = i16 >> 2, p4 = i16 & 3, g1 = (lane >> 4) & 1;
    const int vb = AT_KB + (4 * hi + q4) * AT_VP + (16 * g1 + 4 * p4) * 2;
    const int wK = rowA * AT_KP + ccA * 16, wR = rowR * AT_KP + 256 + ccR * 16, wV = AT_KB + rowA * AT_VP + ccA * 16;
    for (int un = C.bid; un < nunits; un += C.G) {
        int bh, qb, isctx;
        if (un < 512) { const int x = un & 7, jj = un >> 3; bh = x * 4 + (jj >> 4); qb = jj & 15; isctx = 0; } else { bh = un - 512; qb = 0; isctx = 1; }
        const int b = bh >> 3, h = bh & 7;
        const size_t kb0 = (size_t)b * SS;
        const size_t m0 = kb0 + (isctx ? 0 : LC + qb * 256) + wave * 32;
        const int NT = (isctx ? LC : SS) / 64;
        bf16x8 qf[12];
        {   const bf16_t* qn = QN + (m0 + r32) * 1024 + h * 128 + hi * 8; const bf16_t* qp = QP + (m0 + r32) * 512 + h * 64 + hi * 8;
#pragma unroll
            for (int s = 0; s < 8; ++s) qf[s] = *(const bf16x8*)(qn + s * 16);
#pragma unroll
            for (int s = 0; s < 4; ++s) qf[8 + s] = *(const bf16x8*)(qp + s * 16); }
        {
            int hq = hi; asm volatile("" : "+v"(hq));
            float ssn = 0.f, ssr = 0.f;
#pragma unroll
            for (int s = 0; s < 12; ++s) { float x[8]; unpack8(__builtin_bit_cast(u32x4, qf[s]), x); const float q = sumsq8(x); if (s < 8) ssn += q; else ssr += q; }
            ssn += __shfl_xor(ssn, 32); ssr += __shfl_xor(ssr, 32);
            const float rn = RSQ(ssn * (1.f / 128.f) + EPS) * QSCALE, rr = RSQ(ssr * (1.f / 64.f) + EPS);
#pragma unroll
            for (int s = 0; s < 8; ++s) { float x[8]; unpack8(__builtin_bit_cast(u32x4, qf[s]), x);
                const f32x4 ga = *(const f32x4*)(gqn + 16 * s + 8 * hq), gb = *(const f32x4*)(gqn + 16 * s + 8 * hq + 4);
                x[0] *= rn * ga[0]; x[1] *= rn * ga[1]; x[2] *= rn * ga[2]; x[3] *= rn * ga[3]; x[4] *= rn * gb[0]; x[5] *= rn * gb[1]; x[6] *= rn * gb[2]; x[7] *= rn * gb[3];
                qf[s] = __builtin_bit_cast(bf16x8, pack8u(x)); }
            const int tq = qb * 256 + wave * 32 + r32;
#pragma unroll
            for (int pr = 0; pr < 2; ++pr) {
                float xa[8], xb[8]; unpack8(__builtin_bit_cast(u32x4, qf[8 + 2 * pr]), xa); unpack8(__builtin_bit_cast(u32x4, qf[9 + 2 * pr]), xb);
#pragma unroll
                for (int j = 0; j < 8; ++j) { xa[j] *= rr * gqr[32 * pr + 8 * hq + j]; xb[j] *= rr * gqr[32 * pr + 16 + 8 * hq + j]; }
                if (!isctx) { const int pos = pr ? (tq & 63) : (tq >> 6);
#pragma unroll
                    for (int j = 0; j < 8; ++j) { const float c = csm[pos * 16 + 8 * hq + j], sv = csm[1024 + pos * 16 + 8 * hq + j]; const float a = xa[j] * c - xb[j] * sv, bq = xb[j] * c + xa[j] * sv; xa[j] = a; xb[j] = bq; } }
#pragma unroll
                for (int j = 0; j < 8; ++j) { xa[j] *= QSCALE; xb[j] *= QSCALE; }
                qf[8 + 2 * pr] = __builtin_bit_cast(bf16x8, pack8u(xa)); qf[9 + 2 * pr] = __builtin_bit_cast(bf16x8, pack8u(xb)); }
        }
        f32x16 o[4];
#pragma unroll
        for (int d = 0; d < 4; ++d)
#pragma unroll
            for (int r = 0; r < 16; ++r) o[d][r] = 0.f;
        float mrun = -1e30f, lrun = 0.f;
        u32x4 kn0, kn1, kr0, vv0, vv1;
        const unsigned kvo = (unsigned)(((kb0 + rowA) * 2048 + h * 128 + ccA * 8) * 2);
        const unsigned kro = (unsigned)(((kb0 + rowR) * 768 + 640 + ccR * 8) * 2);
#define AT_LOAD(t) do { const char* kp_ = (const char*)KV + (size_t)(t) * (64 * 2048 * 2); kn0 = *(const u32x4*)(kp_ + kvo); kn1 = *(const u32x4*)(kp_ + 32 * 2048 * 2 + kvo); vv0 = *(const u32x4*)(kp_ + 1024 * 2 + kvo); vv1 = *(const u32x4*)(kp_ + (32 * 2048 + 1024) * 2 + kvo); \
        kr0 = *(const u32x4*)((const char*)MD + (size_t)(t) * (64 * 768 * 2) + kro); } while (0)
#define AT_WRITE(sb) do { int sb_ = (sb); asm volatile("" : "+s"(sb_)); LAS unsigned char* s_ = lds + sb_;     \
        *(LAS u32x4*)(s_ + wK) = kn0; *(LAS u32x4*)(s_ + wK + 32 * AT_KP) = kn1; \
        *(LAS u32x4*)(s_ + wR) = kr0; *(LAS u32x4*)(s_ + wV) = vv0; *(LAS u32x4*)(s_ + wV + 32 * AT_VP) = vv1; } while (0)
#define AT_QK(sbv) do { _Pragma("unroll") for (int r = 0; r < 16; ++r) { p0[r] = 0.f; p1[r] = 0.f; } \
        LAS unsigned char* ka = lds + (sbv) + r32 * AT_KP + hi * 16; __builtin_amdgcn_s_setprio(1); \
        _Pragma("unroll") for (int s = 0; s < 12; ++s) { const bf16x8 a0 = *(const LAS bf16x8*)(ka + s * 32), a1 = *(const LAS bf16x8*)(ka + 32 * AT_KP + s * 32); \
            p0 = __builtin_amdgcn_mfma_f32_32x32x16_bf16(a0, qf[s], p0, 0, 0, 0); p1 = __builtin_amdgcn_mfma_f32_32x32x16_bf16(a1, qf[s], p1, 0, 0, 0); \
            if ((s & 3) == 3) asm volatile("" ::: "memory"); } \
        __builtin_amdgcn_s_setprio(0); } while (0)
#define AT_SM() do { float rm = fmaxf(p0[0], p1[0]); \
        _Pragma("unroll") for (int r = 1; r < 16; ++r) rm = fmaxf(rm, fmaxf(p0[r], p1[r])); \
        rm = fmaxf(rm, __shfl_xor(rm, 32)); \
        if (__any(rm > mrun + 8.f)) { const float mnew = fmaxf(mrun, rm), alpha = EX2(mrun - mnew); mrun = mnew; lrun *= alpha; \
            if (hi == 0) wsf[r32] = alpha; \
            _Pragma("unroll") for (int r = 0; r < 16; ++r) { const float a = wsf[crow(r, hi)]; _Pragma("unroll") for (int d = 0; d < 4; ++d) o[d][r] *= a; } } \
        float ls = 0.f; \
        _Pragma("unroll") for (int r = 0; r < 16; ++r) { p0[r] = EX2(p0[r] - mrun); p1[r] = EX2(p1[r] - mrun); ls += p0[r] + p1[r]; } \
        lrun += ls; \
        pa0 = pack8(p0[0], p0[1], p0[2], p0[3], p0[4], p0[5], p0[6], p0[7]); pa1 = pack8(p0[8], p0[9], p0[10], p0[11], p0[12], p0[13], p0[14], p0[15]); \
        pa2 = pack8(p1[0], p1[1], p1[2], p1[3], p1[4], p1[5], p1[6], p1[7]); pa3 = pack8(p1[8], p1[9], p1[10], p1[11], p1[12], p1[13], p1[14], p1[15]); } while (0)
#define AT_PV(sbv) do { LAS unsigned char* vp = lds + (sbv) + vb; __builtin_amdgcn_s_setprio(1); \
        _Pragma("unroll") for (int d = 0; d < 4; ++d) { \
            o[d] = __builtin_amdgcn_mfma_f32_32x32x16_bf16(pa0, tr2(vp + d * 64, vp + d * 64 + 8 * AT_VP), o[d], 0, 0, 0); \
            o[d] = __builtin_amdgcn_mfma_f32_32x32x16_bf16(pa1, tr2(vp + d * 64 + 16 * AT_VP, vp + d * 64 + 24 * AT_VP), o[d], 0, 0, 0); \
            o[d] = __builtin_amdgcn_mfma_f32_32x32x16_bf16(pa2, tr2(vp + d * 64 + 32 * AT_VP, vp + d * 64 + 40 * AT_VP), o[d], 0, 0, 0); \
            o[d] = __builtin_amdgcn_mfma_f32_32x32x16_bf16(pa3, tr2(vp + d * 64 + 48 * AT_VP, vp + d * 64 + 56 * AT_VP), o[d], 0, 0, 0); \
            asm volatile("" ::: "memory"); } \
        __builtin_amdgcn_s_setprio(0); } while (0)
        AT_LOAD(0); AT_WRITE(0);
        __syncthreads();
        bf16x8 pa0, pa1, pa2, pa3;
        if (wave < 4) {
            for (int t = 0; t < NT; ++t) {
                const int sb = (t & 1) * AT_STG;
                if (t + 1 < NT) AT_LOAD(t + 1);
                f32x16 p0, p1;
                AT_QK(sb);
                __syncthreads();
                if (t + 1 < NT) AT_WRITE(AT_STG - sb);
                AT_SM(); AT_PV(sb);
                __syncthreads();
            }
            __syncthreads(); __syncthreads();
        } else {
            for (int t = 0; t <= NT; ++t) {
                const int sb = (t & 1) * AT_STG;
                if (t + 1 < NT) AT_LOAD(t + 1);
                if (t > 0) AT_PV(AT_STG - sb);
                __syncthreads();
                if (t + 1 < NT) AT_WRITE(AT_STG - sb);
                if (t < NT) { f32x16 p0, p1; AT_QK(sb); AT_SM(); }
                __syncthreads();
            }
        }
#undef AT_QK
#undef AT_SM
#undef AT_PV
#undef AT_LOAD
#undef AT_WRITE
        const float ltot = lrun + __shfl_xor(lrun, 32);
        if (hi == 0) wsf[r32] = 1.f / ltot;
        bf16_t* op = QN + (m0 + 4 * hi) * 1024 + h * 128 + r32;
#pragma unroll
        for (int r = 0; r < 16; ++r) { const float inv = wsf[crow(r, hi)];
#pragma unroll
            for (int d = 0; d < 4; ++d) op[d * 32] = (bf16_t)f2bf(o[d][r] * inv);
            op += ((r & 3) == 3) ? 5 * 1024 : 1024; asm volatile("" : "+v"(op)); }
        __syncthreads();
    }
}

constexpr int RI_KP = 528, RI_VP = 576, RI_PTP = 272;
constexpr int RI_A = 0, RI_PT = 128 * RI_VP;
__device__ __forceinline__ void phase_ret_intra(Ctx& C, int l, const bf16_t* RQKV, bf16_t* OI) {
    const int lane = C.lane, r32 = lane & 31, hi = lane >> 5, wave = C.wave, tid = C.tid;
    LAS unsigned char* lds = C.lds;
    const int i16 = lane & 15, q4 = i16 >> 2, p4 = i16 & 3, g1 = (lane >> 4) & 1;
    const int nb = wave & 3, wh = wave >> 2;
    const int srow = tid >> 5, scc = tid & 31;
    for (int un = C.bid; un < NB * 4 * 34; un += C.G) {
        const int c = un % 34, bh = un / 34, b = bh >> 2, h = bh & 3;
        const size_t row0 = (size_t)b * SS + c * 128;
        const float lgf = C.ctl[CT_LG + (l * 2 + 0) * 4 + h], lgb = C.ctl[CT_LG + (l * 2 + 1) * 4 + h];
        const bf16_t* gk = RQKV + (row0 + srow) * 3072 + 1024 + h * 256 + scc * 8;
        u32x4 st[8];
        {   const bf16_t* gp = gk;
#pragma unroll
            for (int j = 0; j < 8; ++j) { st[j] = *(const u32x4*)gp; gp += 16 * 3072; asm volatile("" : "+v"(gp)); } }
#pragma unroll
        for (int j = 0; j < 8; ++j) *(LAS u32x4*)(lds + RI_A + (srow + 16 * j) * RI_KP + scc * 16) = st[j];
        __syncthreads();
        {   const bf16_t* gp = gk + 1024;
#pragma unroll
            for (int j = 0; j < 8; ++j) { st[j] = *(const u32x4*)gp; gp += 16 * 3072; asm volatile("" : "+v"(gp)); } }
        {
            f32x16 x0, x1;
#pragma unroll
            for (int r = 0; r < 16; ++r) { x0[r] = 0.f; x1[r] = 0.f; }
            const bf16_t* gq = RQKV + (row0 + nb * 32 + r32) * 3072 + h * 256 + hi * 8;
            LAS unsigned char* ka = lds + RI_A + (wh * 64 + r32) * RI_KP + hi * 16;
#pragma unroll
            for (int s = 0; s < 16; ++s) { const bf16x8 qf = *(const bf16x8*)(gq + s * 16);
                const bf16x8 a0 = *(const LAS bf16x8*)(ka + s * 32), a1 = *(const LAS bf16x8*)(ka + 32 * RI_KP + s * 32);
                x0 = __builtin_amdgcn_mfma_f32_32x32x16_bf16(a0, qf, x0, 0, 0, 0); x1 = __builtin_amdgcn_mfma_f32_32x32x16_bf16(a1, qf, x1, 0, 0, 0);
                if ((s & 3) == 3) asm volatile("" ::: "memory"); }
            const int n = nb * 32 + r32;
            LAS unsigned char* pt = lds + RI_PT + n * RI_PTP + (wh * 64 + 4 * hi) * 2;
#pragma unroll
            for (int g = 0; g < 4; ++g) { float w0[4], w1[4];
#pragma unroll
                for (int e = 0; e < 4; ++e) { const int m0 = wh * 64 + 8 * g + 4 * hi + e; const float d0 = (float)(n - m0), d1 = d0 - 32.f;
                    const float f0 = EX2(lgf * fmaxf(d0, 0.f)) * fminf(fmaxf(d0 + 1.f, 0.f), 1.f) + EX2(lgb * fmaxf(-d0, 0.f)) * fminf(fmaxf(1.f - d0, 0.f), 1.f);
                    const float f1 = EX2(lgf * fmaxf(d1, 0.f)) * fminf(fmaxf(d1 + 1.f, 0.f), 1.f) + EX2(lgb * fmaxf(-d1, 0.f)) * fminf(fmaxf(1.f - d1, 0.f), 1.f);
                    w0[e] = x0[4 * g + e] * f0; w1[e] = x1[4 * g + e] * f1; }
                u32x2 o0, o1; o0.x = pg8::cvt_pk_bf16(w0[0], w0[1]); o0.y = pg8::cvt_pk_bf16(w0[2], w0[3]); o1.x = pg8::cvt_pk_bf16(w1[0], w1[1]); o1.y = pg8::cvt_pk_bf16(w1[2], w1[3]);
                *(LAS u32x2*)(pt + g * 16) = o0; *(LAS u32x2*)(pt + 64 + g * 16) = o1; }
        }
        __syncthreads();
#pragma unroll
        for (int j = 0; j < 8; ++j) *(LAS u32x4*)(lds + RI_A + (srow + 16 * j) * RI_VP + scc * 16) = st[j];
        __syncthreads();
        {
            f32x16 o[4];
#pragma unroll
            for (int d = 0; d < 4; ++d)
#pragma unroll
                for (int r = 0; r < 16; ++r) o[d][r] = 0.f;
            bf16x8 pa[8];
            LAS unsigned char* pr = lds + RI_PT + (nb * 32 + r32) * RI_PTP + hi * 16;
#pragma unroll
            for (int s = 0; s < 8; ++s) pa[s] = *(const LAS bf16x8*)(pr + s * 32);
            LAS unsigned char* vp = lds + RI_A + (8 * hi + q4) * RI_VP + (wh * 128 + 16 * g1 + 4 * p4) * 2;
#pragma unroll
            for (int d = 0; d < 4; ++d) {
#pragma unroll
                for (int s = 0; s < 8; ++s) o[d] = __builtin_amdgcn_mfma_f32_32x32x16_bf16(pa[s], tr2(vp + d * 64 + s * 16 * RI_VP, vp + d * 64 + (s * 16 + 4) * RI_VP), o[d], 0, 0, 0);
                asm volatile("" ::: "memory"); }
            bf16_t* op = OI + (row0 + nb * 32 + 4 * hi) * 1024 + h * 256 + wh * 128 + r32;
#pragma unroll
            for (int r = 0; r < 16; ++r) {
#pragma unroll
                for (int d = 0; d < 4; ++d) op[d * 32] = (bf16_t)f2bf(o[d][r]);
                op += ((r & 3) == 3) ? 5 * 1024 : 1024; asm volatile("" : "+v"(op)); }
        }
        __syncthreads();
    }
}

constexpr int RC_KT = 0, RC_KTP = 576, RC_VT = 128 * 576, RC_VTP = 64, RC_ST = RC_VT + 128 * 64, RC_STP = 528, RC_XO = RC_ST + 32 * 528, RC_END = RC_XO + 16384;
static_assert(RC_END <= 131072, "R-chain LDS");
__device__ __forceinline__ void phase_ret_chain(Ctx& C, int l, const bf16_t* RQKV, bf16_t* OI, bf16_t* OB) {
    const int lane = C.lane, r32 = lane & 31, hi = lane >> 5, wave = C.wave, tid = C.tid;
    LAS unsigned char* lds = C.lds;
    const int i16 = lane & 15, q4 = i16 >> 2, p4 = i16 & 3, g1 = (lane >> 4) & 1;
    const int nb = wave & 3, dh = wave >> 2;
    const int srow = tid >> 5, scc = tid & 31, vrow = tid >> 2, vcc = tid & 3;
    for (int un = C.bid; un < 256; un += C.G) {
        const int x = un & 7, j8 = un >> 3, bhd = x * 4 + (j8 >> 3), sl = j8 & 7, b = bhd >> 3, h = (bhd >> 1) & 3, dir = bhd & 1;
        const float lg = C.ctl[CT_LG + (l * 2 + dir) * 4 + h];
        const float cdec = EX2(lg * 128.f);
        const float vdec = dir ? EX2(lg * (float)vrow) : EX2(lg * (float)(127 - vrow));
        f32x16 sacc;
#pragma unroll
        for (int r = 0; r < 16; ++r) sacc[r] = 0.f;
        for (int i = tid; i < 32 * RC_STP / 16; i += NTHR) *(LAS u32x4*)(lds + RC_ST + i * 16) = (u32x4){0u, 0u, 0u, 0u};
        u32x4 st[8]; u32x4 sv;
#define RC_LOAD(cc_) do { const size_t r0_ = (size_t)b * SS + (cc_) * 128; const bf16_t* gk_ = RQKV + (r0_ + srow) * 3072 + 1024 + h * 256 + scc * 8; \
        _Pragma("unroll") for (int j = 0; j < 8; ++j) { st[j] = *(const u32x4*)gk_; gk_ += 16 * 3072; asm volatile("" : "+v"(gk_)); } \
        sv = *(const u32x4*)(RQKV + (r0_ + vrow) * 3072 + 2048 + h * 256 + sl * 32 + vcc * 8); } while (0)
#define RC_WRITE() do { _Pragma("unroll") for (int j = 0; j < 8; ++j) *(LAS u32x4*)(lds + RC_KT + (srow + 16 * j) * RC_KTP + scc * 16) = st[j]; \
        u32x4 w_; w_.x = pg8::cvt_pk_bf16(lo_bf(sv.x) * vdec, hi_bf(sv.x) * vdec); w_.y = pg8::cvt_pk_bf16(lo_bf(sv.y) * vdec, hi_bf(sv.y) * vdec); \
        w_.z = pg8::cvt_pk_bf16(lo_bf(sv.z) * vdec, hi_bf(sv.z) * vdec); w_.w = pg8::cvt_pk_bf16(lo_bf(sv.w) * vdec, hi_bf(sv.w) * vdec); \
        *(LAS u32x4*)(lds + RC_VT + vrow * RC_VTP + vcc * 16) = w_; } while (0)
        bf16x8 qa[8];
#define RC_QLOAD(dst, cc_) do { const bf16_t* gq_ = RQKV + ((size_t)b * SS + (cc_) * 128 + nb * 32 + r32) * 3072 + h * 256 + dh * 128 + hi * 8; \
        _Pragma("unroll") for (int s = 0; s < 8; ++s) dst[s] = *(const bf16x8*)(gq_ + s * 16); } while (0)
        {   const int c0 = dir ? 1 : 0, c1 = dir ? 0 : 1; RC_LOAD(c0); RC_WRITE(); RC_QLOAD(qa, c0); RC_LOAD(c1); }
        __syncthreads();
        for (int i = 0; i < 34; ++i) {
            const int c = dir ? ((i < 2) ? (1 - i) : (35 - i)) : i;
            const size_t r0 = (size_t)b * SS + c * 128;
            const int cn = (i + 1 < 34) ? (dir ? ((i + 1 < 2) ? (1 - (i + 1)) : (35 - (i + 1))) : (i + 1)) : c;
            unsigned short oiv[16];
            if (dh == 0 && dir == 0) { const bf16_t* ip = OI + (r0 + nb * 32 + 4 * hi) * 1024 + h * 256 + sl * 32 + r32;
#pragma unroll
                for (int r = 0; r < 16; ++r) oiv[r] = ip[(size_t)((r & 3) + 8 * (r >> 2)) * 1024]; }
            f32x16 oacc;
#pragma unroll
            for (int r = 0; r < 16; ++r) oacc[r] = 0.f;
            {   LAS unsigned char* sb = lds + RC_ST + r32 * RC_STP + (dh * 128 + hi * 8) * 2;
#pragma unroll
                for (int s = 0; s < 8; ++s) { const bf16x8 sbf = *(const LAS bf16x8*)(sb + s * 32);
                    oacc = __builtin_amdgcn_mfma_f32_32x32x16_bf16(qa[s], sbf, oacc, 0, 0, 0); } }
            asm volatile("" ::: "memory");
            RC_QLOAD(qa, cn);
#pragma unroll
            for (int r = 0; r < 16; ++r) sacc[r] *= cdec;
            {   LAS unsigned char* kp = lds + RC_KT + (8 * hi + q4) * RC_KTP + (wave * 32 + 16 * g1 + 4 * p4) * 2;
                LAS unsigned char* vp = lds + RC_VT + (8 * hi + q4) * RC_VTP + (16 * g1 + 4 * p4) * 2;
#pragma unroll
                for (int s = 0; s < 8; ++s) sacc = __builtin_amdgcn_mfma_f32_32x32x16_bf16(tr2(kp + s * 16 * RC_KTP, kp + (s * 16 + 4) * RC_KTP), tr2(vp + s * 16 * RC_VTP, vp + (s * 16 + 4) * RC_VTP), sacc, 0, 0, 0); }
            if (dh == 1) {
#pragma unroll
                for (int r = 0; r < 16; ++r) *(LAS float*)(lds + RC_XO + nb * 4096 + r * 256 + lane * 4) = oacc[r]; }
            __syncthreads();
            if (dh == 0) {
                bf16_t* op = (dir ? OB : OI) + (r0 + nb * 32 + 4 * hi) * 1024 + h * 256 + sl * 32 + r32;
#pragma unroll
                for (int r = 0; r < 16; ++r) { const int n = nb * 32 + crow(r, hi);
                    const float qd = dir ? EX2(lg * (float)(128 - n)) : EX2(lg * (float)(n + 1));
                    float v = (oacc[r] + *(const LAS float*)(lds + RC_XO + nb * 4096 + r * 256 + lane * 4)) * qd;
                    if (dir == 0) v += bf2f(oiv[r]);
                    *op = (bf16_t)f2bf(v);
                    op += ((r & 3) == 3) ? 5 * 1024 : 1024; asm volatile("" : "+v"(op)); }
            }
            {   LAS unsigned char* sp = lds + RC_ST + r32 * RC_STP + (wave * 32 + 4 * hi) * 2;
#pragma unroll
                for (int g = 0; g < 4; ++g) { u32x2 o2; o2.x = pg8::cvt_pk_bf16(sacc[4 * g], sacc[4 * g + 1]); o2.y = pg8::cvt_pk_bf16(sacc[4 * g + 2], sacc[4 * g + 3]); *(LAS u32x2*)(sp + g * 16) = o2; } }
            if (i + 1 < 34) RC_WRITE();
            if (i + 2 < 34) { const int c2 = dir ? ((i + 2 < 2) ? (1 - (i + 2)) : (35 - (i + 2))) : (i + 2); RC_LOAD(c2); }
            __syncthreads();
        }
#undef RC_QLOAD
#undef RC_LOAD
#undef RC_WRITE
    }
}
__device__ __forceinline__ void phase_ret_ln2(Ctx& C, int l, bf16_t* OI, const bf16_t* OB) {
    const float* gain = INP(16) + l * 1024;
    for (int m = C.gw; m < MR; m += C.ngw) {
#pragma unroll
        for (int h = 0; h < 4; ++h) { bf16_t* p = OI + (size_t)m * 1024 + h * 256 + C.lane * 4;
            const u32x2 w = *(const u32x2*)p, w2 = *(const u32x2*)(OB + (size_t)m * 1024 + h * 256 + C.lane * 4);
            float x0 = lo_bf(w.x) + lo_bf(w2.x), x1 = hi_bf(w.x) + hi_bf(w2.x), x2 = lo_bf(w.y) + lo_bf(w2.y), x3 = hi_bf(w.y) + hi_bf(w2.y);
            const float mean = wave_sum((x0 + x1) + (x2 + x3)) * (1.f / 256.f);
            x0 -= mean; x1 -= mean; x2 -= mean; x3 -= mean;
            const float var = wave_sum((x0 * x0 + x1 * x1) + (x2 * x2 + x3 * x3)) * (1.f / 256.f);
            const float rstd = RSQ(var + EPS);
            const f32x4 g = *(const f32x4*)(gain + h * 256 + C.lane * 4);
            u32x2 o; o.x = pk2(x0 * rstd * g.x, x1 * rstd * g.y); o.y = pk2(x2 * rstd * g.z, x3 * rstd * g.w); *(u32x2*)p = o; }
    }
}

constexpr int LR_UP = 272;
constexpr int LR_CP = 272;
constexpr int LR_U = 0, LR_LA = 128 * LR_UP, LR_BC = LR_LA + 128 * LR_CP, LR_Y0 = LR_BC + 128 * LR_CP, LR_XS = LR_Y0 + 128 * LR_CP, LR_END = LR_XS + 4096;
static_assert(LR_END <= 147456 - 1024, "fused LRU LDS");
__device__ __forceinline__ void phase_lru_fused(Ctx& C, int l, const bf16_t* XA, const bf16_t* WTL, bf16_t* Y0, f16_t* CAF, f16_t* CAB, float* SUM) {
    const int lane = C.lane, r32 = lane & 31, hi = lane >> 5, wave = C.wave, tid = C.tid;
    LAS unsigned char* lds = C.lds;
    const float* cw = INP(8) + l * 4 * 1024; const float* cb = INP(9) + l * 1024;
    const int rb = wave & 3, cgp = wave >> 2;
    for (int un = C.bid; un < NB * 8 * 34; un += C.G) {
        const int sg = un % 34, bn = un / 34, b = bn >> 3, n = bn & 7;
        const int R0 = b * SS + sg * 128, lo = (sg < 2) ? b * SS : b * SS + LC, hi_ = (sg < 2) ? b * SS + LC : (b + 1) * SS;
#pragma unroll
        for (int j = 0; j < 4; ++j) { const int item = tid + 512 * j, row = item >> 4, cc = item & 15, ch0 = n * 128 + cc * 8;
            float a[8];
            {   const f32x4 c0 = *(const f32x4*)(cb + ch0), c1 = *(const f32x4*)(cb + ch0 + 4); a[0] = c0[0]; a[1] = c0[1]; a[2] = c0[2]; a[3] = c0[3]; a[4] = c1[0]; a[5] = c1[1]; a[6] = c1[2]; a[7] = c1[3]; }
#pragma unroll
            for (int t = 0; t < 4; ++t) { const int rr = R0 + row + t - 2;
                const f32x4 wA = *(const f32x4*)(cw + t * 1024 + ch0), wB = *(const f32x4*)(cw + t * 1024 + ch0 + 4);
                if (rr >= lo && rr < hi_) { const u32x4 xv = *(const u32x4*)(XA + (size_t)rr * 1024 + ch0);
                    a[0] += wA[0] * lo_bf(xv.x); a[1] += wA[1] * hi_bf(xv.x); a[2] += wA[2] * lo_bf(xv.y); a[3] += wA[3] * hi_bf(xv.y);
                    a[4] += wB[0] * lo_bf(xv.z); a[5] += wB[1] * hi_bf(xv.z); a[6] += wB[2] * lo_bf(xv.w); a[7] += wB[3] * hi_bf(xv.w); } }
            *(LAS u32x4*)(lds + LR_U + row * LR_UP + cc * 16) = pack8u(a); }
        __syncthreads();
        bf16x8 af[8];
        {   LAS unsigned char* ua = lds + LR_U + (rb * 32 + r32) * LR_UP + hi * 16;
#pragma unroll
            for (int s = 0; s < 8; ++s) af[s] = *(const LAS bf16x8*)(ua + s * 32); }
        for (int d = 0; d < 2; ++d) {
            f32x16 aR[2], aI[2];
#pragma unroll
            for (int q = 0; q < 2; ++q)
#pragma unroll
                for (int r = 0; r < 16; ++r) { aR[q][r] = 0.f; aI[q][r] = 0.f; }
            {   const bf16_t* wb = WTL + ((size_t)d * 2048 + n * 256 + cgp * 64 + r32) * 256 + (n & 1) * 128 + hi * 8;
#pragma unroll
                for (int s = 0; s < 8; ++s) {
                    const bf16x8 b0 = *(const bf16x8*)(wb + s * 16), b1 = *(const bf16x8*)(wb + 32 * 256 + s * 16), b2 = *(const bf16x8*)(wb + 128 * 256 + s * 16), b3 = *(const bf16x8*)(wb + 160 * 256 + s * 16);
                    aR[0] = __builtin_amdgcn_mfma_f32_32x32x16_bf16(af[s], b0, aR[0], 0, 0, 0); aR[1] = __builtin_amdgcn_mfma_f32_32x32x16_bf16(af[s], b1, aR[1], 0, 0, 0);
                    aI[0] = __builtin_amdgcn_mfma_f32_32x32x16_bf16(af[s], b2, aI[0], 0, 0, 0); aI[1] = __builtin_amdgcn_mfma_f32_32x32x16_bf16(af[s], b3, aI[1], 0, 0, 0);
                    if ((s & 3) == 3) asm volatile("" ::: "memory"); } }
#pragma unroll
            for (int q = 0; q < 2; ++q) { const int chl = cgp * 64 + q * 32 + r32, ch = n * 128 + chl;
                const float bav = INP(11)[(l * 2 + d) * 1024 + ch], bxv = INP(13)[(l * 2 + d) * 1024 + ch], spv = C.ctl[CT_SP + (l * 2 + d) * 1024 + ch] * (-8.f);
#pragma unroll
                for (int g = 0; g < 4; ++g) { f16_t lav[4], bcv[4];
#pragma unroll
                    for (int e = 0; e < 4; ++e) { const int r = 4 * g + e, t = rb * 32 + crow(r, hi);
                        const float uu = bf2f(*(const LAS bf16_t*)(lds + LR_U + t * LR_UP + chl * 2));
                        const float rg = sigmoidf_(aR[q][r] + bav), ig = sigmoidf_(aI[q][r] + bxv);
                        const float loga = rg * spv, y2 = 2.f * loga;
                        const float om = -y2 * (1.f + y2 * 0.5f * (1.f + y2 * (1.f / 3.f) * (1.f + y2 * 0.25f * (1.f + y2 * 0.2f))));
                        const float bb = SQRT(fmaxf(om, 0.f)) * (ig * uu);
                        lav[e] = (f16_t)(loga * LOG2E); bcv[e] = (f16_t)bb; }
                    typedef f16_t f16x4 __attribute__((ext_vector_type(4)));
                    const int tb = rb * 32 + 8 * g + 4 * hi;
                    *(LAS f16x4*)(lds + LR_LA + chl * LR_CP + tb * 2) = (f16x4){lav[0], lav[1], lav[2], lav[3]};
                    *(LAS f16x4*)(lds + LR_BC + chl * LR_CP + tb * 2) = (f16x4){bcv[0], bcv[1], bcv[2], bcv[3]}; } }
            __syncthreads();
            const int chl = tid & 127, sub = tid >> 7;
            const int tlo = d ? (96 - sub * 32) : (sub * 32);
            f16x8 lv[4], bv[4];
#pragma unroll
            for (int k = 0; k < 4; ++k) { lv[k] = *(const LAS f16x8*)(lds + LR_LA + chl * LR_CP + tlo * 2 + k * 16); bv[k] = *(const LAS f16x8*)(lds + LR_BC + chl * LR_CP + tlo * 2 + k * 16); }
            float av[32], hv[32];
            float A = 1.f, H = 0.f;
#define LR_P1(DD) do { _Pragma("unroll") for (int i = 0; i < 32; ++i) { constexpr int dd_ = DD; const int j = dd_ ? (31 - i) : i; \
                av[j] = EX2((float)lv[j >> 3][j & 7]); H = av[j] * H + (float)bv[j >> 3][j & 7]; A *= av[j]; } } while (0)
            if (d) LR_P1(1); else LR_P1(0);
#undef LR_P1
            *(LAS f32x2*)(lds + LR_XS + (sub * 128 + chl) * 8) = (f32x2){A, H};
            __syncthreads();
            {   A = 1.f; H = 0.f;
                for (int p = 0; p < sub; ++p) { const f32x2 v = *(const LAS f32x2*)(lds + LR_XS + (p * 128 + chl) * 8); H = v.x * H + v.y; A *= v.x; }
                f16_t* cap = (d ? CAB : CAF) + (size_t)(R0 + tlo) * 1024 + n * 128 + chl;
                bf16_t* y0p = Y0 + (size_t)(R0 + tlo) * 1024 + n * 128 + chl;
                LAS unsigned char* ys = lds + LR_Y0 + chl * LR_CP + tlo * 2;
#define LR_P2(DD) do { _Pragma("unroll") for (int i = 0; i < 32; ++i) { constexpr int dd_ = DD; const int j = dd_ ? (31 - i) : i; \
                H = av[j] * H + (float)bv[j >> 3][j & 7]; A *= av[j]; cap[(size_t)j * 1024] = (f16_t)A; hv[j] = H; } } while (0)
                if (d == 0) { LR_P2(0);
#pragma unroll
                    for (int k = 0; k < 4; ++k) { u32x4 w; w.x = pk2(hv[8 * k], hv[8 * k + 1]); w.y = pk2(hv[8 * k + 2], hv[8 * k + 3]); w.z = pk2(hv[8 * k + 4], hv[8 * k + 5]); w.w = pk2(hv[8 * k + 6], hv[8 * k + 7]); *(LAS u32x4*)(ys + k * 16) = w; }
                } else { LR_P2(1);
#pragma unroll
                    for (int k = 0; k < 4; ++k) { const u32x4 yv = *(const LAS u32x4*)(ys + k * 16); float y[8]; unpack8(yv, y);
#pragma unroll
                        for (int e = 0; e < 8; ++e) y0p[(size_t)(8 * k + e) * 1024] = (bf16_t)f2bf(y[e] + hv[8 * k + e]); }
                }
#undef LR_P2
                if (sub == 3) *(f32x2*)(SUM + ((size_t)((d * NB + b) * 34 + sg) * 1024 + n * 128 + chl) * 2) = (f32x2){A, H}; }
            __syncthreads();
        }
    }
}
__device__ __forceinline__ void phase_lru_fix(Ctx& C, const bf16_t* Y0, const f16_t* CAF, const f16_t* CAB, const float* SUM, bf16_t* YA) {
    for (int un = C.gw; un < NB * 34 * 8; un += C.ngw) {
        const int cg_ = un & 7, sg = (un >> 3) % 34, b = (un >> 3) / 34, ch = cg_ * 128 + 2 * C.lane;
        float F0 = 0.f, F1 = 0.f, B0 = 0.f, B1 = 0.f;
#pragma unroll 4
        for (int p = 0; p < sg; ++p) { const f32x4 v = *(const f32x4*)(SUM + ((size_t)((0 * NB + b) * 34 + p) * 1024 + ch) * 2); F0 = v[0] * F0 + v[1]; F1 = v[2] * F1 + v[3]; }
        const int npre = (sg < 2) ? (1 - sg) : (35 - sg);
#pragma unroll 4
        for (int p = 0; p < npre; ++p) { const int ps = (p < 2) ? (1 - p) : (35 - p);
            const f32x4 v = *(const f32x4*)(SUM + ((size_t)((1 * NB + b) * 34 + ps) * 1024 + ch) * 2); B0 = v[0] * B0 + v[1]; B1 = v[2] * B1 + v[3]; }
        const size_t base = (size_t)(b * SS + sg * 128) * 1024 + ch;
        for (int t0 = 0; t0 < 128; t0 += 16) {
            unsigned y[16]; f16x2 cf[16], cbk[16];
#pragma unroll
            for (int i = 0; i < 16; ++i) { const size_t o = base + (size_t)(t0 + i) * 1024; y[i] = *(const unsigned*)(Y0 + o); cf[i] = *(const f16x2*)(CAF + o); cbk[i] = *(const f16x2*)(CAB + o); }
#pragma unroll
            for (int i = 0; i < 16; ++i) { const size_t o = base + (size_t)(t0 + i) * 1024;
                *(unsigned*)(YA + o) = pk2(lo_bf(y[i]) + (float)cf[i][0] * F0 + (float)cbk[i][0] * B0, hi_bf(y[i]) + (float)cf[i][1] * F1 + (float)cbk[i][1] * B1); }
        }
    }
}

#ifdef PROBE_TS
#define GSYNC(g) do { { unsigned char* w_ = prm.ws; asm volatile("" : "+s"(w_)); xcd_barrier((unsigned*)(w_ + WS_BAR), (volatile LAS unsigned*)(ldsb + LDS_ST)); } if (blockIdx.x == 0 && threadIdx.x == 0) { unsigned long long* ts_ = (unsigned long long*)(prm.ws + 8192); const unsigned long long now_ = __builtin_amdgcn_s_memrealtime(); \
    ts_[1 + (g)] += now_ - ts_[0]; ts_[0] = now_; } } while (0)
#else
#define GSYNC(g) do { unsigned char* w_ = prm.ws; asm volatile("" : "+s"(w_)); xcd_barrier((unsigned*)(w_ + WS_BAR), (volatile LAS unsigned*)(ldsb + LDS_ST)); } while (0)
#endif
#define CTX Ctx C = mkctx(ldsb)
#define WSB wsp_(C.ws)
#define bYB ((bf16_t*)(WSB + AR_YB))
#define bXA ((bf16_t*)(WSB + AR_XA))
#define bMD ((bf16_t*)(WSB + AR_MD))
#define bRQKV ((bf16_t*)(WSB + AR_RQKV))
#define bKV ((bf16_t*)(WSB + AR_KV))
#define bQN ((bf16_t*)(WSB + AR_QN))
#define bQP ((bf16_t*)(WSB + AR_QP))
#define bRI ((f16_t*)(WSB + AR_RI))
#define bSUM ((float*)(WSB + AR_SUM))
#define bOB ((bf16_t*)(WSB + AR_OB))
#define bZ ((bf16_t*)(WSB + AR_Z))
#define xc1 ((float*)(WSB + WS_XC1))
template <int l> __device__ __forceinline__ void run_layer(const Params& prm, LAS unsigned char* ldsb) {
        const bool with_ctx = (l == 0); const int lat_only = with_ctx ? 0 : 1;
        { CTX; phase_wconv_early(C, l); }
        if (l == 0) GSYNC(0);
        { CTX; phase_h2(C, l, bYB); }
        GSYNC(1);
        {   CTX;
            ProbPlain P{bYB, (const bf16_t*)(WSB + W_WT1), 1024, 1024, 1024};
            pg8::StaticOrder S; S.init(68, 19, C.G, C.bid, 0);
            EpiG1 E{WSB, C.ctl + CT_ROPER};
            pg8::gemm_phase<EpiG1, ProbPlain, pg8::StaticOrder, true>(C.lds, P, S, E);
        }
        GSYNC(2);
        { CTX; phase_ret_intra(C, l, bRQKV, bYB); }
        { CTX; phase_md_post2(C, l, bMD); }
        GSYNC(4);
        { CTX; phase_ret_chain(C, l, bRQKV, bYB, bOB); }
        GSYNC(5);
        { CTX; phase_ret_ln3(C, l, bYB, bOB); }
        {   CTX; ProbPlain P{bMD, (const bf16_t*)(WSB + W_WTQ), 768, 384, 384};
            pg8::StaticOrder S; S.init(68, 6, C.G, C.bid, 0);
            typedef EpiStore3<AR_QN, 1024, AR_QP, 512, AR_QP, 512, 4, 6> Ep; Ep E{WSB};
            pg8::gemm_phase<Ep, ProbPlain, pg8::StaticOrder, true>(C.lds, P, S, E);
        }
        {   CTX; ProbPlain P{bMD + 384, (const bf16_t*)(WSB + W_WTKV), 768, 256, 256};
            pg8::StaticOrder S; S.init(68, 8, C.G, C.bid, 0);
            EpiKV E{WSB, INP(23) + l * 128, (LAS float*)(C.lds + 131072)};
            pg8::gemm_phase<EpiKV, ProbPlain, pg8::StaticOrder, true>(C.lds, P, S, E);
        }
        GSYNC(6);
        { CTX; phase_attn(C, l, with_ctx, bQN, bQP, bKV, bMD); }
        GSYNC(8);
        { CTX; phase_lru_fused(C, l, bXA, (const bf16_t*)(WSB + W_WTL), (bf16_t*)(WSB + AR_Y0), (f16_t*)(WSB + AR_CAF), (f16_t*)(WSB + AR_CAB), bSUM); }
        GSYNC(9);
        { CTX; phase_lru_fix(C, (const bf16_t*)(WSB + AR_Y0), (const f16_t*)(WSB + AR_CAF), (const f16_t*)(WSB + AR_CAB), bSUM, bXA  ); }
        GSYNC(10);
        { CTX; phase_wconv_late(C, l); }
        { CTX; phase_h2(C, l, bMD  ); }
        GSYNC(13);
        {   CTX; ProbPlain P{bMD, (const bf16_t*)(WSB + W_WTG), 1024, 1024, 1024};
            pg8::StaticOrder S; S.init(lat_only ? 64 : 68, 12, C.G, C.bid, lat_only);
            EpiGate E{WSB};
            pg8::gemm_phase<EpiGate, ProbPlain, pg8::StaticOrder, true>(C.lds, P, S, E);
        }
        GSYNC(14);
        {   CTX; ProbD P{WSB, 1024, 1024};
            pg8::ChainOrder S; S.init(C.G, C.bid, with_ctx ? 1 : 0);
            EpiD E{bZ, WSB + AR_GS + (size_t)C.bid * 131072, (bf16_t*)(WSB + AR_ZP)};
            pg8::gemm_phase<EpiD, ProbD, pg8::ChainOrder, true>(C.lds, P, S, E);
        }
        GSYNC(15);
        if (with_ctx) { { CTX; phase_zsum(C, (const bf16_t*)(WSB + AR_ZP), bZ); } GSYNC(12); }
        {   CTX; ProbPlain P{bZ, (const bf16_t*)(WSB + W_WTO), 1024, 1024, 1024};
            pg8::StaticOrder S; S.init(lat_only ? 64 : 68, 4, C.G, C.bid, lat_only);
            EpiOut E{(l == 0) ? INP(0) : (const float*)C.out, INP(2), C.out, xc1, C.ctl + CT_MOD + l * 5 * 3072};
            pg8::gemm_phase<EpiOut, ProbPlain, pg8::StaticOrder, true>(C.lds, P, S, E);
        }
        GSYNC(16);
    }

__global__ void __launch_bounds__(NTHR) fwd_kernel(Params prm) {
    extern __shared__ __attribute__((aligned(16))) unsigned char lds_raw[];
    cg::grid_group grid = cg::this_grid();
    LAS unsigned char* const ldsb = (LAS unsigned char*)lds_raw;
    if (threadIdx.x < 16) ((LAS unsigned*)(ldsb + LDS_ST))[threadIdx.x] = 0u;
    __syncthreads();
    if (threadIdx.x == 0) (void)xb_add(&((unsigned*)(prm.ws + WS_BAR))[XB_XCNT(xb_xcc_id())], 1u);
    grid.sync();


#ifdef PROBE_TS
    if (blockIdx.x == 0 && threadIdx.x == 0) { unsigned long long* ts_ = (unsigned long long*)(prm.ws + 8192); for (int i = 1; i < 32; ++i) ts_[i] = 0ull; ts_[0] = __builtin_amdgcn_s_memrealtime(); }
#endif
    { CTX; phase_prep(C); }
    run_layer<0>(prm, ldsb);
    run_layer<1>(prm, ldsb);
#ifdef PROBE_TS
    if (blockIdx.x == 0 && threadIdx.x == 0) { const unsigned long long* ts_ = (const unsigned long long*)(prm.ws + 8192); unsigned long long tot = 0ull;
        for (int g = 0; g < 17; ++g) if ((PROBE_TS >> g) & 1u) tot += ts_[1 + g];
        prm.out[0] += (float)(((tot / 100ull) + PROBE_Q / 2) / PROBE_Q * PROBE_Q); }
#endif
}

#undef xc1
#undef bZ
extern "C" void kernel_launch(void* const* d_in, const int* in_sizes, int n_in, void* d_out, int out_size, void* d_ws, size_t ws_size, hipStream_t stream) {
    static int grid = 0;
    if (grid == 0) {
        if (n_in != 29 || out_size != NB * TT * DM || ws_size < WS_END) { fprintf(stderr, "kernel_launch: unexpected shapes (n_in %d out %d ws %zu)\n", n_in, out_size, ws_size); grid = -1; return; }
        int dev = 0, cus = 0, per_cu = 0;
        hipGetDevice(&dev);
        hipDeviceGetAttribute(&cus, hipDeviceAttributeMultiprocessorCount, dev);
        if (hipFuncSetAttribute((const void*)fwd_kernel, hipFuncAttributeMaxDynamicSharedMemorySize, LDS_BYTES) != hipSuccess) { fprintf(stderr, "kernel_launch: hipFuncSetAttribute failed\n"); grid = -1; return; }
        if (hipOccupancyMaxActiveBlocksPerMultiprocessor(&per_cu, (const void*)fwd_kernel, NTHR, LDS_BYTES) != hipSuccess || per_cu < 1) { fprintf(stderr, "kernel_launch: occupancy query failed (%d)\n", per_cu); (void)hipGetLastError(); per_cu = 1; }
        grid = cus;
        fprintf(stderr, "kernel_launch: cus %d per_cu %d grid %d\n", cus, per_cu, grid);
    }
    if (grid < 0) return;
    if (hipMemsetAsync((char*)d_ws + WS_BAR, 0, XCD_BAR_WORDS * 4, stream) != hipSuccess) { fprintf(stderr, "kernel_launch: memset failed\n"); return; }
    Params p{};
    for (int i = 0; i < 29; ++i) p.in[i] = (const float*)d_in[i];
    p.out = (float*)d_out; p.ws = (unsigned char*)d_ws;
    void* args[] = {&p};
    hipError_t e = hipLaunchCooperativeKernel((const void*)fwd_kernel, dim3(grid), dim3(NTHR), args, LDS_BYTES, stream);
    if (e != hipSuccess) fprintf(stderr, "cooperative launch failed: %s (grid %d)\n", hipGetErrorString(e), grid);
}
```

```cpp
#include <hip/hip_runtime.h>
#include <hip/hip_cooperative_groups.h>
#include <cstdio>
#include <cstdint>
namespace cg = cooperative_groups;

#define LAS __attribute__((address_space(3)))
typedef unsigned short bf16_t;
typedef short bf16x8 __attribute__((ext_vector_type(8)));
typedef float f32x4 __attribute__((ext_vector_type(4)));
typedef float f32x2 __attribute__((ext_vector_type(2)));
typedef unsigned u32x4 __attribute__((ext_vector_type(4)));
typedef unsigned u32x2 __attribute__((ext_vector_type(2)));
typedef _Float16 f16_t;

namespace pg8 {
constexpr int BM = 256, BK = 64, HALF = 128, HTB = HALF * BK * 2, STAGE_BYTES = 8 * HTB, NXCD = 8, WGM = 8;
__host__ __device__ __forceinline__ int lds_byte(int r, int c) { const int st = (r >> 4) * 2 + (c >> 5), rr = r & 15, cc = c & 31, ob = rr * 64 + cc * 2; return st * 1024 + (ob ^ (((ob >> 9) & 1) << 5)); }
__host__ __device__ __forceinline__ void stage_rc(int b, int& R, int& C) { const int st = b / 1024, sb = b % 1024, swz = sb ^ (((sb >> 9) & 1) << 5); R = (st >> 1) * 16 + swz / 64; C = (st & 1) * 32 + (swz % 64) / 2; }
__host__ __device__ __forceinline__ int perm32(int rho) { const int n = rho >> 4, i = rho & 15; return 8 * (i >> 2) + 4 * n + (i & 3); }

struct Unit { int pm, pn, z; };

struct StaticOrder {
    int nM, nN, nwg, G, c, latent_only;
    __device__ void init(int nM_, int nN_, int G_, int c_, int latent_only_) { nM = nM_; nN = nN_; nwg = nM * nN; G = G_; c = c_; latent_only = latent_only_; }
    __device__ bool next(int i, Unit& u) const {
        const long L = (long)i * G + c; if (L >= nwg) return false;
        int wgid = (int)L; { const int q = nwg / NXCD, r = nwg % NXCD, xcd = wgid % NXCD, off = wgid / NXCD; wgid = (xcd < r ? xcd * (q + 1) : r * (q + 1) + (xcd - r) * q) + off; }
        const int nig = WGM * nN, gid = wgid / nig, fm = gid * WGM, gsz = (nM - fm) < WGM ? (nM - fm) : WGM;
        int pm = fm + ((wgid % nig) % gsz); u.pn = (wgid % nig) / gsz; u.z = 0;
        if (latent_only) pm = (pm >> 4) * 17 + 1 + (pm & 15);
        u.pm = pm; return true;
    }
};
struct ChainOrder {
    int G, c, with_ctx;
    __device__ void init(int G_, int c_, int with_ctx_) { G = G_; c = c_; with_ctx = with_ctx_; }
    __device__ bool next(int i, Unit& u) const {
        if (i < 6) { const int T = c; if (T >= 256) return false; int pm = T >> 2; u.pn = T & 3; u.z = i; u.pm = (pm >> 4) * 17 + 1 + (pm & 15); return true; }
        if (i < 8 && with_ctx && c < 48) { const int ct = c / 3, br = c - ct * 3; u.pm = (ct >> 2) * 17; u.pn = ct & 3; u.z = 8 + 2 * br + (i - 6); return true; }
        return false;
    }
};

typedef __bf16 bf16x2_t __attribute__((ext_vector_type(2)));
__device__ __forceinline__ unsigned cvt_pk_bf16(float lo, float hi) { f32x2 v = {lo, hi}; bf16x2_t b = __builtin_convertvector(v, bf16x2_t); return __builtin_bit_cast(unsigned, b); }

template <class Epi, class Prob, class Sched, bool ALIGN_EPI>
__device__ __forceinline__ void gemm_phase(LAS unsigned char* lds, const Prob& P, const Sched& S, const Epi& E) {
    int tid_ = threadIdx.x; asm volatile("" : "+v"(tid_));
    const int tid = tid_, wid = __builtin_amdgcn_readfirstlane(tid >> 6), lane = tid & 63, wr = wid >> 2, wc = wid & 3, fr = lane & 15, fq = lane >> 4;
    const int K = P.K, nt = K / BK;
    int RA[2], CA[2]; unsigned voffB[2];
#pragma unroll
    for (int i = 0; i < 2; ++i) { int R, C; stage_rc(tid * 16 + i * 8192, R, C); const int Rb = Epi::PERM ? ((R & ~31) + perm32(R & 31)) : R;
        RA[i] = R; CA[i] = C; voffB[i] = (unsigned)(Rb * P.ldb + C) * 2u; }
    const unsigned kstep = (unsigned)(BK * 2);
    const unsigned hstepB = (unsigned)(HALF * P.ldb * 2);
    const unsigned ldsw = (unsigned)wid * 1024u;
    const int aoff = lds_byte(wr * 64 + fr, fq * 8), boff = lds_byte(wc * 32 + fr, fq * 8);
#define PG8_SA(b, h) (((b) * 2 + (h)) * HTB)
#define PG8_SB(b, h) ((4 + (b) * 2 + (h)) * HTB)
#define PG8_STAGE(bufoff, gbase, soff, voff) do { _Pragma("unroll") for (int _i = 0; _i < 2; ++_i) \
        __builtin_amdgcn_global_load_lds((const unsigned*)((const char*)(gbase) + (unsigned)((voff)[_i] + (soff))), (LAS unsigned*)(lds + (bufoff) + ldsw + _i * 8192), 16, 0, 0); } while (0)
#define PG8_LDA(dst, b, h) do { _Pragma("unroll") for (int m = 0; m < 4; ++m) _Pragma("unroll") for (int k = 0; k < 2; ++k) dst[m][k] = *(const LAS bf16x8*)(lds + PG8_SA(b, h) + aoff + m * 2048 + k * 1024); } while (0)
#define PG8_LDB(dst, b, h) do { _Pragma("unroll") for (int n = 0; n < 2; ++n) _Pragma("unroll") for (int k = 0; k < 2; ++k) dst[n][k] = *(const LAS bf16x8*)(lds + PG8_SB(b, h) + boff + n * 2048 + k * 1024); } while (0)
#define PG8_MMA(ai, bj, At, Bt) do { __builtin_amdgcn_s_setprio(1); _Pragma("unroll") for (int m = 0; m < 4; ++m) _Pragma("unroll") for (int n = 0; n < 2; ++n) _Pragma("unroll") for (int k = 0; k < 2; ++k) \
        acc[ai][bj][m][n] = __builtin_amdgcn_mfma_f32_16x16x32_bf16(Bt[n][k], At[m][k], acc[ai][bj][m][n], 0, 0, 0); __builtin_amdgcn_s_setprio(0); } while (0)
#define PG8_WAIT_V(n) asm volatile("s_waitcnt vmcnt(" #n ")" ::: "memory")
#define PG8_WAIT_L(n) asm volatile("s_waitcnt lgkmcnt(" #n ")" ::: "memory")
#define PG8_BAR __builtin_amdgcn_s_barrier()
#define PG8_SCHED __builtin_amdgcn_sched_barrier(0)
    Unit cur, nxt; int ui = 0;
    if (!S.next(0, cur)) return;
    f32x4 acc[2][2][4][2];
#pragma unroll
    for (int a = 0; a < 2; ++a)
#pragma unroll
        for (int b = 0; b < 2; ++b)
#pragma unroll
            for (int m = 0; m < 4; ++m)
#pragma unroll
                for (int n = 0; n < 2; ++n) acc[a][b][m][n] = (f32x4){0.f, 0.f, 0.f, 0.f};
    bf16x8 At[4][2], B0[2][2], B1[2][2];
    const char* cA; const char* cB; int ldaC; P.get(cur, cA, cB, ldaC);
    unsigned voffA[2] = {(unsigned)(RA[0] * ldaC + CA[0]) * 2u, (unsigned)(RA[1] * ldaC + CA[1]) * 2u};
    unsigned hstepA = (unsigned)(HALF * ldaC * 2);
    PG8_STAGE(PG8_SB(0, 0), cB, 0u, voffB); PG8_STAGE(PG8_SB(0, 1), cB, hstepB, voffB); PG8_STAGE(PG8_SA(0, 0), cA, 0u, voffA); PG8_STAGE(PG8_SA(0, 1), cA, hstepA, voffA);
    if (wr == 1) PG8_BAR;
    PG8_WAIT_V(2); PG8_BAR;
    PG8_STAGE(PG8_SB(1, 0), cB, kstep, voffB); PG8_STAGE(PG8_SA(1, 0), cA, kstep, voffA); PG8_STAGE(PG8_SB(1, 1), cB, hstepB + kstep, voffB);
    PG8_WAIT_V(6); PG8_BAR;
    for (;;) {
        const bool has_next = S.next(ui + 1, nxt);
        const char* nA = cA; const char* nB = cB; int ldaN = ldaC;
        if (has_next) P.get(nxt, nA, nB, ldaN);
        unsigned voffAn[2] = {(unsigned)(RA[0] * ldaN + CA[0]) * 2u, (unsigned)(RA[1] * ldaN + CA[1]) * 2u};
        const unsigned hstepAn = (unsigned)(HALF * ldaN * 2);
        for (int t = 0; t < nt; t += 2) {
            const bool last = (t == nt - 2);
            const unsigned o1 = (unsigned)(t + 1) * kstep;
            const char* a2b = last ? nA : cA; const char* b2b = last ? nB : cB;
            const unsigned o2 = last ? 0u : (unsigned)(t + 2) * kstep, o3 = o2 + kstep;
            unsigned vA2[2] = {last ? voffAn[0] : voffA[0], last ? voffAn[1] : voffA[1]};
            const unsigned hA2 = last ? hstepAn : hstepA;
            PG8_LDB(B0, 0, 0); PG8_LDB(B1, 0, 1); PG8_SCHED; PG8_LDA(At, 0, 0); PG8_STAGE(PG8_SA(1, 1), cA, o1 + hstepA, voffA);
            PG8_WAIT_V(8); PG8_WAIT_L(0); PG8_BAR; PG8_MMA(0, 0, At, B0); PG8_MMA(0, 1, At, B1); PG8_BAR; PG8_SCHED;
            PG8_LDA(At, 0, 1); PG8_STAGE(PG8_SB(0, 0), b2b, o2, voffB); PG8_STAGE(PG8_SB(0, 1), b2b, o2 + hstepB, voffB); PG8_STAGE(PG8_SA(0, 0), a2b, o2, vA2);
            PG8_WAIT_V(8); PG8_WAIT_L(0); PG8_BAR; PG8_MMA(1, 0, At, B0); PG8_MMA(1, 1, At, B1); PG8_BAR; PG8_SCHED;
            PG8_LDB(B0, 1, 0); PG8_LDB(B1, 1, 1); PG8_SCHED; PG8_LDA(At, 1, 0); PG8_STAGE(PG8_SA(0, 1), a2b, o2 + hA2, vA2);
            PG8_WAIT_V(8); PG8_WAIT_L(0); PG8_BAR; PG8_MMA(0, 0, At, B0); PG8_MMA(0, 1, At, B1); PG8_BAR; PG8_SCHED;
            PG8_LDA(At, 1, 1); PG8_STAGE(PG8_SB(1, 0), b2b, o3, voffB); PG8_STAGE(PG8_SB(1, 1), b2b, o3 + hstepB, voffB); PG8_STAGE(PG8_SA(1, 0), a2b, o3, vA2);
            PG8_WAIT_V(8); PG8_WAIT_L(0); PG8_BAR; PG8_MMA(1, 0, At, B0); PG8_MMA(1, 1, At, B1); PG8_BAR; PG8_SCHED;
        }
        if constexpr (ALIGN_EPI) { if (wr == 0) PG8_BAR; }
        E(acc, cur, wr, wc, fr, fq);
        if (!has_next) break;
#pragma unroll
        for (int a = 0; a < 2; ++a)
#pragma unroll
            for (int b = 0; b < 2; ++b)
#pragma unroll
                for (int m = 0; m < 4; ++m)
#pragma unroll
                    for (int n = 0; n < 2; ++n) acc[a][b][m][n] = (f32x4){0.f, 0.f, 0.f, 0.f};
        cur = nxt; cA = nA; cB = nB; ldaC = ldaN; voffA[0] = voffAn[0]; voffA[1] = voffAn[1]; hstepA = hstepAn; ++ui;
        if constexpr (ALIGN_EPI) { if (wr == 1) PG8_BAR; }
    }
    PG8_WAIT_V(0);
    if constexpr (!ALIGN_EPI) { if (wr == 0) PG8_BAR; }
    PG8_BAR;
#undef PG8_SA
#undef PG8_SB
#undef PG8_STAGE
#undef PG8_LDA
#undef PG8_LDB
#undef PG8_MMA
#undef PG8_WAIT_V
#undef PG8_WAIT_L
#undef PG8_BAR
#undef PG8_SCHED
}
}

constexpr int NB = 4, TT = 4096, LC = 256, SS = TT + LC  , DM = 1024, MR = NB * SS  ;
constexpr int INC = 10944;
constexpr float EPS = 1e-6f;
constexpr float LOG2E = 1.4426950408889634f;
constexpr float QSCALE = 0.07216878364870322f * 1.4426950408889634f;
constexpr int NWAVES = 8, NTHR = 512;

constexpr size_t MiB = 1u << 20;
constexpr size_t WS_CTL = 0;
constexpr size_t WS_XC1 = 1 * MiB;
constexpr size_t WS_W = 5 * MiB;
constexpr size_t WS_AR = 25 * MiB;
constexpr size_t AR_YB = WS_AR + 0 * MiB;
constexpr size_t AR_XA = WS_AR + 34 * MiB;
constexpr size_t AR_MD = WS_AR + 68 * MiB;
constexpr size_t AR_RQKV = WS_AR + 94 * MiB;
constexpr size_t AR_OB = WS_AR + 196 * MiB;
constexpr size_t AR_KV = WS_AR + 112 * MiB;
constexpr size_t AR_QN = WS_AR + 180 * MiB;
constexpr size_t AR_QP = WS_AR + 214 * MiB;
constexpr size_t AR_RI = WS_AR + 102 * MiB;
constexpr size_t AR_Y0 = WS_AR + 68 * MiB;
constexpr size_t AR_CAF = WS_AR + 102 * MiB;
constexpr size_t AR_CAB = WS_AR + 136 * MiB;
constexpr size_t AR_SUM = WS_AR + 170 * MiB;
constexpr size_t AR_Z = WS_AR + 102 * MiB;
constexpr size_t AR_HIN = WS_AR + 176 * MiB;
constexpr size_t AR_ZP = WS_AR + 170 * MiB;
constexpr size_t AR_GS = WS_AR + 136 * MiB;
constexpr size_t WS_END = 256 * MiB;
constexpr size_t W_WT1 = WS_W;
constexpr size_t W_WTQ = WS_W + 10 * MiB;
constexpr size_t W_WTKV = WS_W + 12 * MiB;
constexpr size_t W_WTL = WS_W + 13 * MiB;
constexpr size_t W_WTG = WS_W;
constexpr size_t W_WTGM = WS_W + 6 * MiB;
constexpr size_t W_WTD = WS_W + 12 * MiB;
constexpr size_t W_WTO = WS_W + 18 * MiB;
constexpr int CT_MOD = 16384;
constexpr int CT_ROPER = CT_MOD + 2 * 5 * 3072;
constexpr int CT_ROPEM = CT_ROPER + 2 * 4096;
constexpr int CT_SP = CT_ROPEM + 2 * 1024;
constexpr int CT_LG = CT_SP + 4096;
constexpr int CT_END = CT_LG + 16;
static_assert(CT_END * 4 <= (int)MiB, "CTL");

constexpr int LDS_BYTES = 147456;


#define XB_TMO      128
#define XB_XCNT(j)  (256  + 64 * (j))
#define XB_XSUB(j)  (1280 + 64 * (j))
#define XB_XGEN(j)  (2304 + 64 * (j))
#define XB_TOP      3328
#define XB_TOPGEN   3392
#define XCD_BAR_WORDS 3456
#define XB_SPIN_CAP (1u << 18)
constexpr size_t WS_BAR = 16384;
constexpr int LDS_ST = LDS_BYTES - 64;
__device__ __forceinline__ unsigned xb_ld(unsigned* p)              { return __hip_atomic_load(p, __ATOMIC_RELAXED, __HIP_MEMORY_SCOPE_AGENT); }
__device__ __forceinline__ unsigned xb_add(unsigned* p, unsigned v) { return __hip_atomic_fetch_add(p, v, __ATOMIC_RELAXED, __HIP_MEMORY_SCOPE_AGENT); }
__device__ __forceinline__ unsigned xb_xcc_id() { return (unsigned)__builtin_amdgcn_s_getreg((3 << 11) | 20) & 0xFu; }
#define XB_SPIN(cond, bar) do { unsigned _sp = 0; while (cond) { __builtin_amdgcn_s_sleep(1); \
    if ((++_sp & 255u) == 0u) { if (xb_ld(&(bar)[XB_TMO])) break; if (_sp > XB_SPIN_CAP) { atomicAdd(&(bar)[XB_TMO], 1u); break; } } } } while (0)
__device__ __forceinline__ void xcd_barrier_complete(unsigned* bar, unsigned x, unsigned& nloc, unsigned& nx) {
    const unsigned G = gridDim.x * gridDim.y * gridDim.z;
    unsigned sum, cnt, mine, sp = 0u;
    for (;;) {
        sum = 0u; cnt = 0u; mine = 0u;
#pragma unroll
        for (unsigned j = 0; j < 16; ++j) { const unsigned c = xb_ld(&bar[XB_XCNT(j)]); sum += c; cnt += (c > 0u) ? 1u : 0u; mine = (j == x) ? c : mine; }
        if (sum == G) break;
        __builtin_amdgcn_s_sleep(1);
        if ((++sp & 255u) == 0u) { if (xb_ld(&bar[XB_TMO])) break; if (sp > XB_SPIN_CAP) { atomicAdd(&bar[XB_TMO], 1u); break; } }
    }
    nloc = mine > 0u ? mine : 1u; nx = cnt > 0u ? cnt : 1u;
}
__device__ __forceinline__ void xcd_barrier(unsigned* bar, volatile LAS unsigned* st) {
    asm volatile("s_waitcnt vmcnt(0)" ::: "memory");
    __syncthreads();
    if (threadIdx.x == 0) {
        const unsigned x = xb_xcc_id();
        __builtin_amdgcn_s_waitcnt(0);
        unsigned nloc = st[0], nx = st[1];
        if (nloc == 0u) { xcd_barrier_complete(bar, x, nloc, nx); st[0] = nloc; st[1] = nx; }
        const unsigned old = xb_add(&bar[XB_XSUB(x)], 1u);
        const unsigned gen = old / nloc;
        if (old + 1u == (gen + 1u) * nloc) {
            __builtin_amdgcn_fence(__ATOMIC_RELEASE, "agent");
            asm volatile("s_waitcnt vmcnt(0)" ::: "memory");
            const unsigned og = xb_add(&bar[XB_TOP], 1u);
            const unsigned tg = og / nx;
            if (og + 1u == (tg + 1u) * nx) xb_add(&bar[XB_TOPGEN], 1u);
            else XB_SPIN(xb_ld(&bar[XB_TOPGEN]) == tg, bar);
            __builtin_amdgcn_fence(__ATOMIC_ACQUIRE, "agent");
            xb_add(&bar[XB_XGEN(x)], 1u);
            asm volatile("s_waitcnt vmcnt(0)" ::: "memory");
        } else {
            XB_SPIN(xb_ld(&bar[XB_XGEN(x)]) == gen, bar);
            __builtin_amdgcn_fence(__ATOMIC_ACQUIRE, "agent");
            asm volatile("s_waitcnt vmcnt(0)" ::: "memory");
        }
    }
    __syncthreads();
}

struct Params {
    const float* in[29];
    float* out;
    unsigned char* ws;
};

#define EX2(x) __builtin_amdgcn_exp2f(x)
#define RSQ(x) __builtin_amdgcn_rsqf(x)
#define SQRT(x) __builtin_amdgcn_sqrtf(x)
__device__ __forceinline__ float bf2f(unsigned v) { return __uint_as_float(v << 16); }
__device__ __forceinline__ unsigned f2bf(float f) { unsigned u = __float_as_uint(f); return (u + 0x7fffu + ((u >> 16) & 1u)) >> 16; }
__device__ __forceinline__ unsigned pk2(float lo, float hi) { return f2bf(lo) | (f2bf(hi) << 16); }
__device__ __forceinline__ float lo_bf(unsigned w) { return __uint_as_float(w << 16); }
__device__ __forceinline__ float hi_bf(unsigned w) { return __uint_as_float(w & 0xffff0000u); }
__device__ __forceinline__ float wave_sum(float v) {
#pragma unroll
    for (int o = 1; o < 64; o <<= 1) v += __shfl_xor(v, o);
    return v;
}
__device__ __forceinline__ float wave_max(float v) {
#pragma unroll
    for (int o = 1; o < 64; o <<= 1) v = fmaxf(v, __shfl_xor(v, o));
    return v;
}
__device__ __forceinline__ float sigmoidf_(float x) { return __builtin_amdgcn_rcpf(1.f + __expf(-x)); }
__device__ __forceinline__ float siluf_(float x) { return x * __builtin_amdgcn_rcpf(1.f + __expf(-x)); }

#define GASP __attribute__((address_space(1)))
__device__ __forceinline__ const float* inp_(int i) { asm volatile("" : "+s"(i)); const float* const* ka = (const float* const*)__builtin_amdgcn_kernarg_segment_ptr(); return (const float*)(const GASP float*)ka[i]; }
#define INP(i) inp_(i)
template <class T> __device__ __forceinline__ T* opaq_g_(T* p) { GASP T* g = (GASP T*)p; asm volatile("" : "+v"(g)); return (T*)g; }
#define OPAQ_G(p) ((p) = opaq_g_(p))
__device__ __forceinline__ unsigned char* wsp_(unsigned char* p) { GASP unsigned char* g = (GASP unsigned char*)p; asm volatile("" : "+s"(g)); return (unsigned char*)g; }
__device__ __forceinline__ void unpack8(const u32x4& w, float (&x)[8]) { x[0] = lo_bf(w.x); x[1] = hi_bf(w.x); x[2] = lo_bf(w.y); x[3] = hi_bf(w.y); x[4] = lo_bf(w.z); x[5] = hi_bf(w.z); x[6] = lo_bf(w.w); x[7] = hi_bf(w.w); }
__device__ __forceinline__ u32x4 pack8u(const float (&x)[8]) { u32x4 w; w.x = pk2(x[0], x[1]); w.y = pk2(x[2], x[3]); w.z = pk2(x[4], x[5]); w.w = pk2(x[6], x[7]); return w; }
__device__ __forceinline__ float sumsq8(const float (&x)[8]) { return ((x[0] * x[0] + x[1] * x[1]) + (x[2] * x[2] + x[3] * x[3])) + ((x[4] * x[4] + x[5] * x[5]) + (x[6] * x[6] + x[7] * x[7])); }

struct Ctx {
    float* out; unsigned char* ws; LAS unsigned char* lds; int tid, lane, wave, G, bid;
    int gw, ngw;
    int rot;
    float* ctl;
};

__device__ __forceinline__ Ctx mkctx(LAS unsigned char* lds) {
    Ctx C; int t = threadIdx.x; asm volatile("" : "+v"(t)); int b = blockIdx.x; asm volatile("" : "+s"(b)); int g = gridDim.x; asm volatile("" : "+s"(g));
    C.tid = t; C.lane = t & 63; C.wave = __builtin_amdgcn_readfirstlane(t >> 6); C.bid = b; C.G = g; C.gw = b * NWAVES + C.wave; C.ngw = g * NWAVES; C.rot = 0;
    int io = 29, iw = 30; asm volatile("" : "+s"(io)); asm volatile("" : "+s"(iw));
    unsigned char* const* ka = (unsigned char* const*)__builtin_amdgcn_kernarg_segment_ptr();
    C.out = (float*)(GASP float*)ka[io]; C.ws = (unsigned char*)(GASP unsigned char*)ka[iw]; C.ctl = (float*)(C.ws + WS_CTL); C.lds = lds;
    return C;
}
__device__ __forceinline__ const float* resid_row(const Ctx& C, int l, int m) {
    const int b = m / SS, s = m - b * SS;
    if (s < LC) { const float* base = (l == 0) ? INP(2) : (const float*)(C.ws + WS_XC1); return base + (size_t)(b * LC + s) * DM; }
    const float* base = (l == 0) ? INP(0) : C.out; return base + (size_t)(b * TT + (s - LC)) * DM;
}

__device__ __forceinline__ void phase_prep(Ctx& C) {
    LAS float* sl = (LAS float*)C.lds;
    LAS float* red = (LAS float*)(C.lds + 32768);
    for (int i = C.tid; i < 5 * 1024; i += NTHR) { const int r = i >> 10, k = i & 1023; const float v = (r < 4) ? INP(1)[r * 1024 + k] : INP(3)[k]; sl[i] = siluf_(v); }
    __syncthreads();
    for (int it = C.bid; it < 2 * 96; it += C.G) {
        const int l = it / 96, grp = it % 96, kg = C.tid >> 5, cj = C.tid & 31, col = grp * 32 + cj;
        const float* w = INP(4) + (size_t)l * 1024 * 3072 + col;
        float a0 = 0.f, a1 = 0.f, a2 = 0.f, a3 = 0.f, a4 = 0.f;
#pragma unroll 8
        for (int k = kg * 64; k < kg * 64 + 64; ++k) { const float wv = w[(size_t)k * 3072]; a0 += sl[k] * wv; a1 += sl[1024 + k] * wv; a2 += sl[2048 + k] * wv; a3 += sl[3072 + k] * wv; a4 += sl[4096 + k] * wv; }
        red[(kg * 32 + cj) * 5 + 0] = a0; red[(kg * 32 + cj) * 5 + 1] = a1; red[(kg * 32 + cj) * 5 + 2] = a2; red[(kg * 32 + cj) * 5 + 3] = a3; red[(kg * 32 + cj) * 5 + 4] = a4;
        __syncthreads();
        if (C.tid < 160) { const int c2 = C.tid / 5, r = C.tid % 5; float s = 0.f;
            for (int g = 0; g < 16; ++g) s += red[(g * 32 + c2) * 5 + r];
            C.ctl[CT_MOD + (l * 5 + r) * 3072 + grp * 32 + c2] = s + INP(5)[l * 3072 + grp * 32 + c2]; }
        __syncthreads();
    }
    const int gt = C.bid * NTHR + C.tid, ngt = C.G * NTHR;
    for (int i = gt; i < 4096; i += ngt) { const int pos = i >> 6, f = i & 63; const float inv = powf(10000.f, -(float)f / 64.f), ang = (float)pos * inv;
        C.ctl[CT_ROPER + i] = cosf(ang); C.ctl[CT_ROPER + 4096 + i] = sinf(ang); }
    for (int i = gt; i < 1024; i += ngt) { const int pos = i >> 4, f = i & 15; const float inv = powf(10000.f, -(float)f / 16.f), ang = (float)pos * inv;
        C.ctl[CT_ROPEM + i] = cosf(ang); C.ctl[CT_ROPEM + 1024 + i] = sinf(ang); }
    for (int i = gt; i < 4096; i += ngt) C.ctl[CT_SP + i] = log1pf(expf(-INP(14)[i]));
    for (int i = gt; i < 16; i += ngt) C.ctl[CT_LG + i] = -log1pf(expf(-INP(15)[i])) * LOG2E;
}

__device__ __forceinline__ void tr_item(const float* W, int ldw, int k0, int n0, bf16_t* WT, int ldt, int drow0, int dk0, LAS float* scr, int lane) {
#pragma unroll 8
    for (int i = 0; i < 32; ++i) { const int kk = 2 * i + (lane >> 5); scr[kk * 33 + (lane & 31)] = W[(size_t)(k0 + kk) * ldw + n0 + (lane & 31)]; }
    asm volatile("s_waitcnt lgkmcnt(0)" ::: "memory");
    const int c = lane & 7;
#pragma unroll
    for (int j = 0; j < 4; ++j) { const int n = (lane >> 3) + 8 * j; const LAS float* s = scr + (8 * c) * 33 + n;
        u32x4 o; o.x = pk2(s[0 * 33], s[1 * 33]); o.y = pk2(s[2 * 33], s[3 * 33]); o.z = pk2(s[4 * 33], s[5 * 33]); o.w = pk2(s[6 * 33], s[7 * 33]);
        *(u32x4*)(WT + (size_t)(drow0 + n) * ldt + dk0 + 8 * c) = o; }
    asm volatile("s_waitcnt lgkmcnt(0)" ::: "memory");
}
__device__ __forceinline__ void conv_rows(Ctx& C, const float* W, int ldw, int K, int scol0, bf16_t* WT, int ldt, int drow0, int dk0, int nrows, LAS float* scr) {
    const int nkb = K / 64, items = nkb * (nrows / 32);
    int g0 = C.gw - C.rot; if (g0 < 0) g0 += C.ngw; C.rot = (C.rot + items) % C.ngw;
    for (int it = g0; it < items; it += C.ngw) { const int nb = it / nkb, kb = it - nb * nkb;
        tr_item(W, ldw, kb * 64, scol0 + nb * 32, WT, ldt, drow0 + nb * 32, dk0 + kb * 64, scr, C.lane); }
}
__device__ __forceinline__ int ropeperm(int j) { const int h = j >> 8, jj = j & 255, half = jj >> 7, g = (jj & 127) >> 3, r8 = jj & 7; return h * 256 + (half * 2 + (r8 >> 2)) * 64 + g * 4 + (r8 & 3); }
__device__ __forceinline__ void tr_item_rope(const float* W, int ldw, int k0, int scol0, int jbase, bf16_t* WT, int ldt, int drow0, int dk0, LAS float* scr, int lane) {
    const int sc = scol0 + ropeperm(jbase + (lane & 31));
#pragma unroll 8
    for (int i = 0; i < 32; ++i) { const int kk = 2 * i + (lane >> 5); scr[kk * 33 + (lane & 31)] = W[(size_t)(k0 + kk) * ldw + sc]; }
    asm volatile("s_waitcnt lgkmcnt(0)" ::: "memory");
    const int c = lane & 7;
#pragma unroll
    for (int j = 0; j < 4; ++j) { const int n = (lane >> 3) + 8 * j; const LAS float* s = scr + (8 * c) * 33 + n;
        u32x4 o; o.x = pk2(s[0 * 33], s[1 * 33]); o.y = pk2(s[2 * 33], s[3 * 33]); o.z = pk2(s[4 * 33], s[5 * 33]); o.w = pk2(s[6 * 33], s[7 * 33]);
        *(u32x4*)(WT + (size_t)(drow0 + n) * ldt + dk0 + 8 * c) = o; }
    asm volatile("s_waitcnt lgkmcnt(0)" ::: "memory");
}
__device__ __forceinline__ void conv_rows_rope(Ctx& C, const float* W, int ldw, int K, int scol0, bf16_t* WT, int ldt, int drow0, int nrows, LAS float* scr) {
    const int nkb = K / 64, items = nkb * (nrows / 32);
    int g0 = C.gw - C.rot; if (g0 < 0) g0 += C.ngw; C.rot = (C.rot + items) % C.ngw;
    for (int it = g0; it < items; it += C.ngw) { const int nb = it / nkb, kb = it - nb * nkb;
        tr_item_rope(W, ldw, kb * 64, scol0, nb * 32, WT, ldt, drow0 + nb * 32, kb * 64, scr, C.lane); }
}
__device__ __forceinline__ void zero_rows(Ctx& C, bf16_t* WT, int ldt, int drow0, int dk0, int nrows, int ncols) {
    const int per = ncols / 8, items = nrows * per;
    int g0 = C.gw - C.rot; if (g0 < 0) g0 += C.ngw; C.rot = (C.rot + (items + 63) / 64) % C.ngw;
    for (int it = g0 * 64 + C.lane; it < items; it += C.ngw * 64) { const int r = it / per, c = it - r * per; *(u32x4*)(WT + (size_t)(drow0 + r) * ldt + dk0 + c * 8) = (u32x4){0u, 0u, 0u, 0u}; }
}
__device__ __forceinline__ void phase_wconv_early(Ctx& C, int l) {
    LAS float* scr = (LAS float*)(C.lds + C.wave * 16384);
    unsigned char* ws = C.ws;
    const float* win = INP(7) + (size_t)l * 1024 * INC;
    bf16_t* WT1 = (bf16_t*)(ws + W_WT1);
    conv_rows(C, win, INC, 1024, 0, WT1, 1024, 0, 0, 1024, scr);
    conv_rows_rope(C, win, INC, 1024, 2048, WT1, 1024, 1024, 1024, scr);
    conv_rows_rope(C, win, INC, 1024, 3072, WT1, 1024, 2048, 1024, scr);
    conv_rows(C, win, INC, 1024, 4096, WT1, 1024, 3072, 0, 1024, scr);
    conv_rows(C, win, INC, 1024, 6144, WT1, 1024, 4096, 0, 704, scr);
    zero_rows(C, WT1, 1024, 4800, 0, 64, 1024);
    const float* wq = INP(18) + (size_t)l * 384 * 1536; bf16_t* WTQ = (bf16_t*)(ws + W_WTQ);
    for (int h = 0; h < 8; ++h) { conv_rows(C, wq, 1536, 384, h * 192, WTQ, 384, h * 128, 0, 128, scr); conv_rows(C, wq, 1536, 384, h * 192 + 128, WTQ, 384, 1024 + h * 64, 0, 64, scr); }
    const float* wkv = INP(20) + (size_t)l * 256 * 2048; bf16_t* WTKV = (bf16_t*)(ws + W_WTKV);
    for (int h = 0; h < 8; ++h) { conv_rows(C, wkv, 2048, 256, h * 256, WTKV, 256, h * 128, 0, 128, scr); conv_rows(C, wkv, 2048, 256, h * 256 + 128, WTKV, 256, 1024 + h * 128, 0, 128, scr); }
    bf16_t* WTL = (bf16_t*)(ws + W_WTL);
    for (int d = 0; d < 2; ++d) for (int n = 0; n < 8; ++n) for (int mat = 0; mat < 2; ++mat) {
        const float* w = INP(mat == 0 ? 10 : 12) + ((size_t)(l * 2 + d) * 8 + n) * 128 * 128;
        const int drow0 = d * 2048 + n * 256 + mat * 128;
        conv_rows(C, w, 128, 128, 0, WTL, 256, drow0, (n & 1) * 128, 128, scr);
        zero_rows(C, WTL, 256, drow0, ((n & 1) ^ 1) * 128, 128, 128);
    }
}
__device__ __forceinline__ void phase_wconv_late(Ctx& C, int l) {
    LAS float* scr = (LAS float*)(C.lds + C.wave * 16384);
    unsigned char* ws = C.ws;
    const float* win = INP(7) + (size_t)l * 1024 * INC;
    bf16_t* WTG = (bf16_t*)(ws + W_WTG);
    conv_rows(C, win, INC, 1024, 1024, WTG, 1024, 0, 0, 1024, scr);
    conv_rows(C, win, INC, 1024, 5120, WTG, 1024, 1024, 0, 1024, scr);
    conv_rows(C, win, INC, 1024, 6848, WTG, 1024, 2048, 0, 1024, scr);
    conv_rows(C, win, INC, 1024, 7872, (bf16_t*)(ws + W_WTGM), 1024, 0, 0, 3072, scr);
    for (int i = 0; i < 3; ++i) conv_rows(C, INP(25 + i) + (size_t)l * 1024 * 1024, 1024, 1024, 0, (bf16_t*)(ws + W_WTD) + (size_t)i * 1024 * 1024, 1024, 0, 0, 1024, scr);
    conv_rows(C, INP(28) + (size_t)l * 1024 * 1024, 1024, 1024, 0, (bf16_t*)(ws + W_WTO), 1024, 0, 0, 1024, scr);
}

__device__ __forceinline__ void phase_h(Ctx& C, int l, bf16_t* H) {
    const float* gain = INP(6) + l * 1024;
    for (int m = C.gw; m < MR; m += C.ngw) {
        const int b = m / SS, s = m - b * SS, r = (s < LC) ? 4 : b;
        const float* xr = resid_row(C, l, m);
        const float* mod = C.ctl + CT_MOD + (l * 5 + r) * 3072;
        f32x4 v[4]; float ss = 0.f;
#pragma unroll
        for (int j = 0; j < 4; ++j) { v[j] = *(const f32x4*)(xr + 4 * C.lane + 256 * j); ss += (v[j].x * v[j].x + v[j].y * v[j].y) + (v[j].z * v[j].z + v[j].w * v[j].w); }
        const float rstd = RSQ(wave_sum(ss) * (1.f / 1024.f) + EPS);
#pragma unroll
        for (int j = 0; j < 4; ++j) { const int c = 4 * C.lane + 256 * j;
            const f32x4 g = *(const f32x4*)(gain + c), sh = *(const f32x4*)(mod + c), sc = *(const f32x4*)(mod + 1024 + c);
            const f32x4 y = (v[j] * rstd) * g;
            const f32x4 o = y * (sc + 1.0f) + sh;
            u32x2 w; w.x = pk2(o.x, o.y); w.y = pk2(o.z, o.w);
            *(u32x2*)(H + (size_t)m * 1024 + c) = w; }
    }
}

using pg8::Unit;
struct ProbPlain {
    const bf16_t* A; const bf16_t* Bt; int lda, ldb, K;
    __device__ __forceinline__ void get(const Unit& u, const char*& a, const char*& b, int& lda_) const {
        a = (const char*)(A + (size_t)u.pm * 256 * lda); b = (const char*)(Bt + (size_t)u.pn * 256 * ldb); lda_ = lda; }
};
struct ProbLru {
    const bf16_t* A; const bf16_t* Bt; int ldb, K;
    __device__ __forceinline__ void get(const Unit& u, const char*& a, const char*& b, int& lda_) const {
        a = (const char*)(A + (size_t)u.pm * 256 * 1024 + (u.pn >> 1) * 256); b = (const char*)(Bt + (size_t)u.pn * 256 * 256); lda_ = 1024; }
};
struct ProbD {
    unsigned char* ws; int ldb, K;
    __device__ __forceinline__ void get(const Unit& u, const char*& a, const char*& b, int& lda_) const {
        const int i = (u.z & 7) >> 1;
        if ((u.z & 1) == 0) { a = (const char*)(ws + AR_XA + (size_t)u.pm * 256 * 1024 * 2); b = (const char*)(ws + W_WTGM + ((size_t)i * 1024 + u.pn * 256) * 1024 * 2); lda_ = 1024; }
        else { const size_t yo = (i == 0) ? AR_Y0 : (i == 1) ? AR_YB : AR_QN;
            a = (const char*)(ws + yo + (size_t)u.pm * 256 * 1024 * 2); b = (const char*)(ws + W_WTD + ((size_t)i * 1024 + u.pn * 256) * 1024 * 2); lda_ = 1024; }
    }
};

#define EPI_ARGS const f32x4 (&acc)[2][2][4][2], const Unit& u, int wr, int wc, int fr, int fq
template <size_t O0, int L0, size_t O1, int L1, size_t O2, int L2, int T1, int T2>
struct EpiStore3 {
    static constexpr bool PERM = true;
    unsigned char* ws;
    __device__ __forceinline__ void operator()(EPI_ARGS) const {
        bf16_t* bs; int ldc, ct;
        size_t off;
        if (u.pn < T1) { off = O0; ldc = L0; ct = u.pn; } else if (u.pn < T2) { off = O1; ldc = L1; ct = u.pn - T1; } else { off = O2; ldc = L2; ct = u.pn - T2; }
        bs = (bf16_t*)(ws + off);
        const int row0 = u.pm * 256 + wr * 64 + fr, col0 = ct * 256 + wc * 32 + 8 * fq;
#pragma unroll
        for (int ai = 0; ai < 2; ++ai)
#pragma unroll
            for (int m = 0; m < 4; ++m) { bf16_t* rowp = bs + (size_t)(row0 + ai * 128 + m * 16) * ldc + col0;
#pragma unroll
                for (int bj = 0; bj < 2; ++bj) { const f32x4 v0 = acc[ai][bj][m][0], v1 = acc[ai][bj][m][1];
                    u32x4 w; w.x = pg8::cvt_pk_bf16(v0[0], v0[1]); w.y = pg8::cvt_pk_bf16(v0[2], v0[3]); w.z = pg8::cvt_pk_bf16(v1[0], v1[1]); w.w = pg8::cvt_pk_bf16(v1[2], v1[3]);
                    *(u32x4*)(rowp + bj * 128) = w; } }
    }
};
struct EpiKV {
    static constexpr bool PERM = true;
    unsigned char* ws; const float* gkn; LAS float* red;
    __device__ __forceinline__ void operator()(EPI_ARGS) const {
        bf16_t* bs = (bf16_t*)(ws + AR_KV);
        const int row0 = u.pm * 256 + wr * 64 + fr, col0 = u.pn * 256 + wc * 32 + 8 * fq;
        const bool knope = u.pn < 4;
        float g[8];
#pragma unroll
        for (int e = 0; e < 8; ++e) g[e] = 1.f;
        if (knope) {
#pragma unroll
            for (int ai = 0; ai < 2; ++ai)
#pragma unroll
                for (int m = 0; m < 4; ++m)
#pragma unroll
                    for (int bj = 0; bj < 2; ++bj) { const f32x4 v0 = acc[ai][bj][m][0], v1 = acc[ai][bj][m][1];
                        float ss = ((v0[0] * v0[0] + v0[1] * v0[1]) + (v0[2] * v0[2] + v0[3] * v0[3])) + ((v1[0] * v1[0] + v1[1] * v1[1]) + (v1[2] * v1[2] + v1[3] * v1[3]));
                        ss += __shfl_xor(ss, 16); ss += __shfl_xor(ss, 32);
                        if (fq == 0) red[((ai * 128 + wr * 64 + m * 16 + fr) * 2 + bj) * 4 + wc] = ss; }
            asm volatile("s_waitcnt lgkmcnt(0)" ::: "memory"); __builtin_amdgcn_s_barrier(); asm volatile("" ::: "memory");
            const f32x4 ga = *(const f32x4*)(gkn + wc * 32 + 8 * fq), gb = *(const f32x4*)(gkn + wc * 32 + 8 * fq + 4);
            g[0] = ga[0]; g[1] = ga[1]; g[2] = ga[2]; g[3] = ga[3]; g[4] = gb[0]; g[5] = gb[1]; g[6] = gb[2]; g[7] = gb[3];
        }
#pragma unroll
        for (int ai = 0; ai < 2; ++ai)
#pragma unroll
            for (int m = 0; m < 4; ++m) { bf16_t* rowp = bs + (size_t)(row0 + ai * 128 + m * 16) * 2048 + col0;
#pragma unroll
                for (int bj = 0; bj < 2; ++bj) { f32x4 v0 = acc[ai][bj][m][0], v1 = acc[ai][bj][m][1];
                    float rs = 1.f;
                    if (knope) { const f32x4 t = *(const LAS f32x4*)(red + ((ai * 128 + wr * 64 + m * 16 + fr) * 2 + bj) * 4); rs = RSQ(((t[0] + t[1]) + (t[2] + t[3])) * (1.f / 128.f) + EPS); }
                    u32x4 w; w.x = pg8::cvt_pk_bf16(v0[0] * rs * g[0], v0[1] * rs * g[1]); w.y = pg8::cvt_pk_bf16(v0[2] * rs * g[2], v0[3] * rs * g[3]);
                    w.z = pg8::cvt_pk_bf16(v1[0] * rs * g[4], v1[1] * rs * g[5]); w.w = pg8::cvt_pk_bf16(v1[2] * rs * g[6], v1[3] * rs * g[7]);
                    *(u32x4*)(rowp + bj * 128) = w; }
                asm volatile("" ::: "memory"); }
    }
};
struct EpiG1 {
    static constexpr bool PERM = true;
    unsigned char* ws; const float* cs;
    __device__ __forceinline__ void operator()(EPI_ARGS) const {
        bf16_t* bs; int ldc, ct;
        if (u.pn < 4) { bs = (bf16_t*)(ws + AR_XA); ldc = 1024; ct = u.pn; } else if (u.pn < 16) { bs = (bf16_t*)(ws + AR_RQKV); ldc = 3072; ct = u.pn - 4; } else { bs = (bf16_t*)(ws + AR_MD); ldc = 768; ct = u.pn - 16; }
        const int row0 = u.pm * 256 + wr * 64 + fr, col0 = ct * 256 + wc * 32 + 8 * fq;
        const bool rope = (u.pn >= 4) && (u.pn < 12), iskey = (u.pn >= 8);
        const int bq = u.pm / 17, s0 = (u.pm - bq * 17) * 256 + wr * 64 + fr;
        const int f0 = (wc * 4 + fq) * 4;
#pragma unroll
        for (int ai = 0; ai < 2; ++ai)
#pragma unroll
            for (int m = 0; m < 4; ++m) { bf16_t* rowp = bs + (size_t)(row0 + ai * 128 + m * 16) * ldc + col0;
                const int s = s0 + ai * 128 + m * 16, t = s - LC; const bool lat = s >= LC;
#pragma unroll
                for (int bj = 0; bj < 2; ++bj) { f32x4 v0 = acc[ai][bj][m][0], v1 = acc[ai][bj][m][1];
                    if (rope) {
                        if (lat) { const int pos = bj ? (t & 63) : (t >> 6); const f32x4 c = *(const f32x4*)(cs + pos * 64 + f0), sn = *(const f32x4*)(cs + 4096 + pos * 64 + f0);
                            const f32x4 a = v0 * c - v1 * sn, b = v1 * c + v0 * sn; v0 = a; v1 = b; }
                        if (iskey) { v0 = v0 * 0.0625f; v1 = v1 * 0.0625f; } }
                    u32x4 w; w.x = pg8::cvt_pk_bf16(v0[0], v0[1]); w.y = pg8::cvt_pk_bf16(v0[2], v0[3]); w.z = pg8::cvt_pk_bf16(v1[0], v1[1]); w.w = pg8::cvt_pk_bf16(v1[2], v1[3]);
                    *(u32x4*)(rowp + bj * 128) = w; }
                asm volatile("" ::: "memory"); }
    }
};
typedef f16_t f16x8 __attribute__((ext_vector_type(8)));
struct EpiLru {
    static constexpr bool PERM = true;
    const bf16_t* U; f16_t* RI; const float* ba; const float* bx; const float* sp;
    __device__ __forceinline__ void operator()(EPI_ARGS) const {
        const int row0 = u.pm * 256 + wr * 64 + fr, ch0 = u.pn * 128 + wc * 32 + 8 * fq;
        float bav[8], bxv[8], spv[8];
#pragma unroll
        for (int e = 0; e < 8; ++e) { bav[e] = ba[ch0 + e]; bxv[e] = bx[ch0 + e]; spv[e] = sp[ch0 + e] * (-8.f); }
#pragma unroll
        for (int ai = 0; ai < 2; ++ai)
#pragma unroll
            for (int m = 0; m < 4; ++m) { const int row = row0 + ai * 128 + m * 16;
                const u32x4 uw = *(const u32x4*)(U + (size_t)row * 1024 + ch0);
                float uv[8] = {lo_bf(uw.x), hi_bf(uw.x), lo_bf(uw.y), hi_bf(uw.y), lo_bf(uw.z), hi_bf(uw.z), lo_bf(uw.w), hi_bf(uw.w)};
                f16x8 la, bc;
#pragma unroll
                for (int e = 0; e < 8; ++e) { const float rp = acc[ai][0][m][e >> 2][e & 3] + bav[e], ip = acc[ai][1][m][e >> 2][e & 3] + bxv[e];
                    const float r = sigmoidf_(rp), ig = sigmoidf_(ip);
                    const float loga = r * spv[e];
                    const float bb = SQRT(fmaxf(-expm1f(2.f * loga), 0.f)) * (ig * uv[e]);
                    la[e] = (f16_t)(loga * LOG2E); bc[e] = (f16_t)bb; }
                *(f16x8*)(RI + (size_t)row * 2048 + ch0) = la; *(f16x8*)(RI + (size_t)row * 2048 + 1024 + ch0) = bc;
                asm volatile("" ::: "memory"); }
    }
};
struct EpiGate {
    static constexpr bool PERM = true;
    unsigned char* ws;
    __device__ __forceinline__ void operator()(EPI_ARGS) const {
        const int br = u.pn >> 2; const size_t yo = (br == 0) ? AR_Y0 : (br == 1) ? AR_YB : AR_QN; bf16_t* bs = (bf16_t*)(ws + yo);
        const int row0 = u.pm * 256 + wr * 64 + fr, col0 = (u.pn & 3) * 256 + wc * 32 + 8 * fq;
        if (br == 0) {
            const int b = u.pm / 17, sg0 = (u.pm - b * 17) * 2;
#pragma unroll
            for (int ai = 0; ai < 2; ++ai) {
                const float* hfp = (const float*)(ws + AR_HIN) + ((size_t)(0 * NB + b) * 34 + sg0 + ai) * 1024 + col0;
                const float* hbp = (const float*)(ws + AR_HIN) + ((size_t)(1 * NB + b) * 34 + sg0 + ai) * 1024 + col0;
#pragma unroll
                for (int bj = 0; bj < 2; ++bj) {
                    const f32x4 hf0 = *(const f32x4*)(hfp + bj * 128), hf1 = *(const f32x4*)(hfp + bj * 128 + 4), hb0 = *(const f32x4*)(hbp + bj * 128), hb1 = *(const f32x4*)(hbp + bj * 128 + 4);
#pragma unroll
                    for (int m = 0; m < 4; ++m) { const size_t ro = (size_t)(row0 + ai * 128 + m * 16) * 1024 + col0 + bj * 128;
                        const f32x4 v0 = acc[ai][bj][m][0], v1 = acc[ai][bj][m][1];
                        const u32x4 y = *(const u32x4*)(bs + ro);
                        const f16x8 cf = *(const f16x8*)((const f16_t*)(ws + AR_CAF) + ro), cb = *(const f16x8*)((const f16_t*)(ws + AR_CAB) + ro);
                        float yy[8]; unpack8(y, yy);
                        yy[0] += (float)cf[0] * hf0[0] + (float)cb[0] * hb0[0]; yy[1] += (float)cf[1] * hf0[1] + (float)cb[1] * hb0[1]; yy[2] += (float)cf[2] * hf0[2] + (float)cb[2] * hb0[2]; yy[3] += (float)cf[3] * hf0[3] + (float)cb[3] * hb0[3];
                        yy[4] += (float)cf[4] * hf1[0] + (float)cb[4] * hb1[0]; yy[5] += (float)cf[5] * hf1[1] + (float)cb[5] * hb1[1]; yy[6] += (float)cf[6] * hf1[2] + (float)cb[6] * hb1[2]; yy[7] += (float)cf[7] * hf1[3] + (float)cb[7] * hb1[3];
                        u32x4 w; w.x = pg8::cvt_pk_bf16(yy[0] * siluf_(v0[0]), yy[1] * siluf_(v0[1])); w.y = pg8::cvt_pk_bf16(yy[2] * siluf_(v0[2]), yy[3] * siluf_(v0[3]));
                        w.z = pg8::cvt_pk_bf16(yy[4] * siluf_(v1[0]), yy[5] * siluf_(v1[1])); w.w = pg8::cvt_pk_bf16(yy[6] * siluf_(v1[2]), yy[7] * siluf_(v1[3]));
                        *(u32x4*)(bs + ro) = w;
                        asm volatile("" ::: "memory"); } } }
            return;
        }
#pragma unroll
        for (int ai = 0; ai < 2; ++ai)
#pragma unroll
            for (int m = 0; m < 4; ++m) { bf16_t* rowp = bs + (size_t)(row0 + ai * 128 + m * 16) * 1024 + col0;
#pragma unroll
                for (int bj = 0; bj < 2; ++bj) { const f32x4 v0 = acc[ai][bj][m][0], v1 = acc[ai][bj][m][1];
                    const u32x4 y = *(const u32x4*)(rowp + bj * 128);
                    u32x4 w; w.x = pg8::cvt_pk_bf16(lo_bf(y.x) * siluf_(v0[0]), hi_bf(y.x) * siluf_(v0[1])); w.y = pg8::cvt_pk_bf16(lo_bf(y.y) * siluf_(v0[2]), hi_bf(y.y) * siluf_(v0[3]));
                    w.z = pg8::cvt_pk_bf16(lo_bf(y.z) * siluf_(v1[0]), hi_bf(y.z) * siluf_(v1[1])); w.w = pg8::cvt_pk_bf16(lo_bf(y.w) * siluf_(v1[2]), hi_bf(y.w) * siluf_(v1[3]));
                    *(u32x4*)(rowp + bj * 128) = w; }
                asm volatile("" ::: "memory"); }
    }
};
struct EpiD {
    static constexpr bool PERM = true;
    bf16_t* Z; unsigned char* gs; bf16_t* ZP;
    __device__ __forceinline__ void operator()(EPI_ARGS) const {
        const int col0 = u.pn * 256 + wc * 32 + 8 * fq, i = (u.z & 7) >> 1; const bool part = u.z >= 8;
        const int row0 = part ? ((u.pm / 17) * 256 + wr * 64 + fr) : (u.pm * 256 + wr * 64 + fr);
        bf16_t* const zb = part ? (ZP + (size_t)i * 1024 * 1024) : Z;
        const unsigned tq = (unsigned)(((wr * 4 + wc) * 64 + fq * 16 + fr) * 64);
        if ((u.z & 1) == 0) {
#pragma unroll
            for (int ai = 0; ai < 2; ++ai)
#pragma unroll
                for (int m = 0; m < 4; ++m)
#pragma unroll
                    for (int bj = 0; bj < 2; ++bj) { const f32x4 v0 = acc[ai][bj][m][0], v1 = acc[ai][bj][m][1];
                        u32x4 w; w.x = pg8::cvt_pk_bf16(sigmoidf_(v0[0]), sigmoidf_(v0[1])); w.y = pg8::cvt_pk_bf16(sigmoidf_(v0[2]), sigmoidf_(v0[3]));
                        w.z = pg8::cvt_pk_bf16(sigmoidf_(v1[0]), sigmoidf_(v1[1])); w.w = pg8::cvt_pk_bf16(sigmoidf_(v1[2]), sigmoidf_(v1[3]));
                        *(u32x4*)(gs + (((ai * 4 + m) * 2 + bj) >> 2) * 32768 + tq + (((ai * 4 + m) * 2 + bj) & 3) * 16) = w; }
        } else {
#pragma unroll
            for (int ai = 0; ai < 2; ++ai)
#pragma unroll
                for (int m = 0; m < 4; ++m) { bf16_t* zrow = zb + (size_t)(row0 + ai * 128 + m * 16) * 1024 + col0;
#pragma unroll
                    for (int bj = 0; bj < 2; ++bj) { const f32x4 v0 = acc[ai][bj][m][0], v1 = acc[ai][bj][m][1];
                        const u32x4 g = *(const u32x4*)(gs + (((ai * 4 + m) * 2 + bj) >> 2) * 32768 + tq + (((ai * 4 + m) * 2 + bj) & 3) * 16); bf16_t* zp = zrow + bj * 128;
                        float o0 = lo_bf(g.x) * v0[0], o1 = hi_bf(g.x) * v0[1], o2 = lo_bf(g.y) * v0[2], o3 = hi_bf(g.y) * v0[3], o4 = lo_bf(g.z) * v1[0], o5 = hi_bf(g.z) * v1[1], o6 = lo_bf(g.w) * v1[2], o7 = hi_bf(g.w) * v1[3];
                        if (i > 0 && !part) { const u32x4 zo = *(const u32x4*)zp; o0 += lo_bf(zo.x); o1 += hi_bf(zo.x); o2 += lo_bf(zo.y); o3 += hi_bf(zo.y); o4 += lo_bf(zo.z); o5 += hi_bf(zo.z); o6 += lo_bf(zo.w); o7 += hi_bf(zo.w); }
                        u32x4 w; w.x = pg8::cvt_pk_bf16(o0, o1); w.y = pg8::cvt_pk_bf16(o2, o3); w.z = pg8::cvt_pk_bf16(o4, o5); w.w = pg8::cvt_pk_bf16(o6, o7); *(u32x4*)zp = w; }
                    asm volatile("" ::: "memory"); }
        }
    }
};
struct EpiOut {
    static constexpr bool PERM = false;
    const float* xlat; const float* xctx; float* olat; float* octx; const float* mod;
    __device__ __forceinline__ void operator()(EPI_ARGS) const {
        const int b = u.pm / 17, isctx = (u.pm - b * 17) == 0;
        const float* gate = mod + (isctx ? 4 : b) * 3072 + 2048;
        const int col0 = u.pn * 256 + wc * 32 + 4 * fq;
        f32x4 gv[2][2];
#pragma unroll
        for (int bj = 0; bj < 2; ++bj)
#pragma unroll
            for (int n = 0; n < 2; ++n) gv[bj][n] = *(const f32x4*)(gate + col0 + bj * 128 + n * 16);
#pragma unroll
        for (int ai = 0; ai < 2; ++ai)
#pragma unroll
            for (int m = 0; m < 4; ++m) { const int s = (u.pm - b * 17) * 256 + ai * 128 + wr * 64 + m * 16 + fr;
                const size_t off = isctx ? ((size_t)(b * LC + s) * 1024 + col0) : ((size_t)(b * TT + (s - LC)) * 1024 + col0);
                const float* xin = isctx ? xctx : xlat; float* xo = isctx ? octx : olat;
#pragma unroll
                for (int bj = 0; bj < 2; ++bj)
#pragma unroll
                    for (int n = 0; n < 2; ++n) { const f32x4 xv = *(const f32x4*)(xin + off + bj * 128 + n * 16);
                        *(f32x4*)(xo + off + bj * 128 + n * 16) = xv + gv[bj][n] * acc[ai][bj][m][n]; }
                asm volatile("" ::: "memory"); }
    }
};

__device__ __forceinline__ void phase_ret_rope(Ctx& C, bf16_t* RQKV) {
    const float* cs = C.ctl + CT_ROPER; const float* sn = cs + 4096;
    for (int m = C.gw; m < MR; m += C.ngw) {
        const int b = m / SS, s = m - b * SS; const bool lat = s >= LC; const int t = s - LC, prow = lat ? (t >> 6) : 0, pcol = lat ? (t & 63) : 0;
        bf16_t* row = RQKV + (size_t)m * 3072;
#pragma unroll
        for (int j = 0; j < 16; ++j) {
            const int idx = j * 64 + C.lane, f = idx & 63, half = (idx >> 6) & 1, h = (idx >> 7) & 3, tz = idx >> 9;
            bf16_t* p = row + tz * 1024 + h * 256 + half * 128 + f;
            const float x1 = bf2f(p[0]), x2 = bf2f(p[64]);
            float o1 = x1, o2 = x2;
            if (lat) { const int pos = half ? pcol : prow; const float c = cs[pos * 64 + f], sv = sn[pos * 64 + f]; o1 = x1 * c - x2 * sv; o2 = x2 * c + x1 * sv; }
            if (tz) { o1 *= 0.0625f; o2 *= 0.0625f; }
            p[0] = (bf16_t)f2bf(o1); p[64] = (bf16_t)f2bf(o2);
        }
    }
}

#define RS_STEP(o, cnt, st) do { const bool up_ = (C.lane & (st)) != 0; _Pragma("unroll") for (int e_ = 0; e_ < (cnt) / 2; ++e_) { \
        const float send_ = up_ ? o[e_] : o[e_ + (cnt) / 2]; const float keep_ = up_ ? o[e_ + (cnt) / 2] : o[e_]; o[e_] = keep_ + __shfl_xor(send_, (st)); } } while (0)

__device__ __forceinline__ void phase_ret_naive(Ctx& C, int l, const bf16_t* RQKV, bf16_t* OI) {
    LAS unsigned char* qs = C.lds + C.wave * 512;
    const int nbu = (MR / 8) * 16;
    for (int bu = C.bid; bu < nbu; bu += C.G) {
        const int hq = bu & 15, h = hq >> 2, qd = hq & 3, n = (bu >> 4) * 8 + C.wave;
        const int b = n / SS, sn_ = n - b * SS;
        const float lgf = C.ctl[CT_LG + (l * 2 + 0) * 4 + h], lgb = C.ctl[CT_LG + (l * 2 + 1) * 4 + h];
        const int pfn = sn_, pbn = (sn_ < LC) ? (LC - 1 - sn_) : (SS + LC - 1 - sn_);
        asm volatile("s_waitcnt lgkmcnt(0)" ::: "memory");
        *(LAS u32x2*)(qs + C.lane * 8) = *(const u32x2*)(RQKV + (size_t)n * 3072 + h * 256 + C.lane * 4);
        asm volatile("s_waitcnt lgkmcnt(0)" ::: "memory");
        float o[64];
#pragma unroll
        for (int e = 0; e < 64; ++e) o[e] = 0.f;
        for (int sm = C.lane; sm < SS; sm += 64) {
            const bf16_t* krow = RQKV + (size_t)(b * SS + sm) * 3072 + 1024 + h * 256;
            float dot = 0.f;
#pragma unroll 4
            for (int c = 0; c < 32; ++c) { const u32x4 kv = *(const u32x4*)(krow + c * 8); const u32x4 qv = *(const LAS u32x4*)(qs + c * 16);
                dot += lo_bf(kv.x) * lo_bf(qv.x) + hi_bf(kv.x) * hi_bf(qv.x) + lo_bf(kv.y) * lo_bf(qv.y) + hi_bf(kv.y) * hi_bf(qv.y)
                     + lo_bf(kv.z) * lo_bf(qv.z) + hi_bf(kv.z) * hi_bf(qv.z) + lo_bf(kv.w) * lo_bf(qv.w) + hi_bf(kv.w) * hi_bf(qv.w); }
            const int pfm = sm, pbm = (sm < LC) ? (LC - 1 - sm) : (SS + LC - 1 - sm);
            float w = 0.f;
            if (pfn >= pfm) w += EX2(lgf * (float)(pfn - pfm));
            if (pbn >= pbm) w += EX2(lgb * (float)(pbn - pbm));
            const float ws_ = w * dot;
            const bf16_t* vrow = krow + 1024 + qd * 64;
#pragma unroll
            for (int c = 0; c < 8; ++c) { const u32x4 vv = *(const u32x4*)(vrow + c * 8);
                o[c * 8 + 0] += ws_ * lo_bf(vv.x); o[c * 8 + 1] += ws_ * hi_bf(vv.x); o[c * 8 + 2] += ws_ * lo_bf(vv.y); o[c * 8 + 3] += ws_ * hi_bf(vv.y);
                o[c * 8 + 4] += ws_ * lo_bf(vv.z); o[c * 8 + 5] += ws_ * hi_bf(vv.z); o[c * 8 + 6] += ws_ * lo_bf(vv.w); o[c * 8 + 7] += ws_ * hi_bf(vv.w); }
        }
        RS_STEP(o, 64, 32); RS_STEP(o, 32, 16); RS_STEP(o, 16, 8); RS_STEP(o, 8, 4); RS_STEP(o, 4, 2); RS_STEP(o, 2, 1);
        OI[(size_t)n * 1024 + h * 256 + qd * 64 + C.lane] = (bf16_t)f2bf(o[0]);
    }
}
__device__ __forceinline__ void phase_ret_ln(Ctx& C, int l, bf16_t* OI) {
    const float* gain = INP(16) + l * 1024;
    for (int m = C.gw; m < MR; m += C.ngw) {
#pragma unroll
        for (int h = 0; h < 4; ++h) { bf16_t* p = OI + (size_t)m * 1024 + h * 256 + C.lane * 4;
            const u32x2 w = *(const u32x2*)p; float x0 = lo_bf(w.x), x1 = hi_bf(w.x), x2 = lo_bf(w.y), x3 = hi_bf(w.y);
            const float mean = wave_sum((x0 + x1) + (x2 + x3)) * (1.f / 256.f);
            x0 -= mean; x1 -= mean; x2 -= mean; x3 -= mean;
            const float var = wave_sum((x0 * x0 + x1 * x1) + (x2 * x2 + x3 * x3)) * (1.f / 256.f);
            const float rstd = RSQ(var + EPS);
            const f32x4 g = *(const f32x4*)(gain + h * 256 + C.lane * 4);
            u32x2 o; o.x = pk2(x0 * rstd * g.x, x1 * rstd * g.y); o.y = pk2(x2 * rstd * g.z, x3 * rstd * g.w); *(u32x2*)p = o; }
    }
}

__device__ __forceinline__ void phase_md_post(Ctx& C, int l, bf16_t* MD) {
    const float* qn = INP(17) + l * 384; const float* kvn = INP(19) + l * 256; const float* gkr = INP(24) + l * 64;
    const float* cs = C.ctl + CT_ROPEM; const float* sn = cs + 1024;
    for (int m = C.gw; m < MR; m += C.ngw) {
        const int b = m / SS, s = m - b * SS; const bool lat = s >= LC; const int t = s - LC;
        bf16_t* row = MD + (size_t)m * 768;
        {   float x[6]; float ss = 0.f;
#pragma unroll
            for (int j = 0; j < 3; ++j) { const unsigned w = *(const unsigned*)(row + 2 * C.lane + 128 * j); x[2 * j] = lo_bf(w); x[2 * j + 1] = hi_bf(w); ss += x[2 * j] * x[2 * j] + x[2 * j + 1] * x[2 * j + 1]; }
            const float rstd = RSQ(wave_sum(ss) * (1.f / 384.f) + EPS);
#pragma unroll
            for (int j = 0; j < 3; ++j) { const int c = 2 * C.lane + 128 * j; *(unsigned*)(row + c) = pk2(x[2 * j] * rstd * qn[c], x[2 * j + 1] * rstd * qn[c + 1]); } }
        {   float x[4]; float ss = 0.f;
#pragma unroll
            for (int j = 0; j < 2; ++j) { const unsigned w = *(const unsigned*)(row + 384 + 2 * C.lane + 128 * j); x[2 * j] = lo_bf(w); x[2 * j + 1] = hi_bf(w); ss += x[2 * j] * x[2 * j] + x[2 * j + 1] * x[2 * j + 1]; }
            const float rstd = RSQ(wave_sum(ss) * (1.f / 256.f) + EPS);
#pragma unroll
            for (int j = 0; j < 2; ++j) { const int c = 2 * C.lane + 128 * j; *(unsigned*)(row + 384 + c) = pk2(x[2 * j] * rstd * kvn[c], x[2 * j + 1] * rstd * kvn[c + 1]); } }
        {   const float x = bf2f(row[640 + C.lane]);
            const float rstd = RSQ(wave_sum(x * x) * (1.f / 64.f) + EPS);
            float y = x * rstd * gkr[C.lane];
            if (lat) { const float pr = __shfl_xor(y, 16); const float rot = (C.lane & 16) ? pr : -pr; const int f = C.lane & 15, pos = (C.lane < 32) ? (t >> 6) : (t & 63);
                y = y * cs[pos * 16 + f] + rot * sn[pos * 16 + f]; }
            row[640 + C.lane] = (bf16_t)f2bf(y); }
    }
}
__device__ __forceinline__ void phase_qk_post(Ctx& C, int l, bf16_t* QN, bf16_t* QP, bf16_t* KV) {
    const float* gqn = INP(21) + l * 128; const float* gqr = INP(22) + l * 64; const float* gkn = INP(23) + l * 128;
    const float* cs = C.ctl + CT_ROPEM; const float* sn = cs + 1024;
    for (int m = C.gw; m < MR; m += C.ngw) {
        const int b = m / SS, s = m - b * SS; const bool lat = s >= LC; const int t = s - LC;
        bf16_t* qrow = QN + (size_t)m * 1024; bf16_t* prow = QP + (size_t)m * 512; bf16_t* krow = KV + (size_t)m * 2048;
#pragma unroll
        for (int h = 0; h < 8; ++h) {
            {   unsigned* p = (unsigned*)(qrow + h * 128 + 2 * C.lane); const unsigned w = *p; const float x0 = lo_bf(w), x1 = hi_bf(w);
                const float rstd = RSQ(wave_sum(x0 * x0 + x1 * x1) * (1.f / 128.f) + EPS);
                *p = pk2(x0 * rstd * gqn[2 * C.lane] * QSCALE, x1 * rstd * gqn[2 * C.lane + 1] * QSCALE); }
            {   bf16_t* p = prow + h * 64 + C.lane; const float x = bf2f(*p);
                const float rstd = RSQ(wave_sum(x * x) * (1.f / 64.f) + EPS);
                float y = x * rstd * gqr[C.lane];
                if (lat) { const float pr = __shfl_xor(y, 16); const float rot = (C.lane & 16) ? pr : -pr; const int f = C.lane & 15, pos = (C.lane < 32) ? (t >> 6) : (t & 63);
                    y = y * cs[pos * 16 + f] + rot * sn[pos * 16 + f]; }
                *p = (bf16_t)f2bf(y * QSCALE); }
            {   unsigned* p = (unsigned*)(krow + h * 128 + 2 * C.lane); const unsigned w = *p; const float x0 = lo_bf(w), x1 = hi_bf(w);
                const float rstd = RSQ(wave_sum(x0 * x0 + x1 * x1) * (1.f / 128.f) + EPS);
                *p = pk2(x0 * rstd * gkn[2 * C.lane], x1 * rstd * gkn[2 * C.lane + 1]); }
        }
    }
}

__device__ __forceinline__ void phase_attn_naive(Ctx& C, bool with_ctx, bf16_t* QN, const bf16_t* QP, const bf16_t* KV, const bf16_t* MD) {
    LAS unsigned char* qs = C.lds + C.wave * 512;
    const int nlat = NB * 8 * (TT / 8), nctx = with_ctx ? NB * 8 * (LC / 8) : 0;
    for (int bu = C.bid; bu < nlat + nctx; bu += C.G) {
        int b, h, s, nkeys;
        if (bu < nlat) { const int tb = bu % (TT / 8), bh = bu / (TT / 8); b = bh >> 3; h = bh & 7; s = LC + tb * 8 + C.wave; nkeys = SS; }
        else { const int r = bu - nlat, tb = r % (LC / 8), bh = r / (LC / 8); b = bh >> 3; h = bh & 7; s = tb * 8 + C.wave; nkeys = LC; }
        const size_t m = (size_t)b * SS + s;
        asm volatile("s_waitcnt lgkmcnt(0)" ::: "memory");
        if (C.lane < 32) *(LAS u32x2*)(qs + C.lane * 8) = *(const u32x2*)(QN + m * 1024 + h * 128 + C.lane * 4);
        else if (C.lane < 48) *(LAS u32x2*)(qs + 256 + (C.lane - 32) * 8) = *(const u32x2*)(QP + m * 512 + h * 64 + (C.lane - 32) * 4);
        asm volatile("s_waitcnt lgkmcnt(0)" ::: "memory");
        float o[128];
#pragma unroll
        for (int e = 0; e < 128; ++e) o[e] = 0.f;
        float mrun = -1e30f, lrun = 0.f;
        for (int key = C.lane; key < nkeys; key += 64) {
            const size_t kr = (size_t)b * SS + key;
            const bf16_t* kn = KV + kr * 2048 + h * 128; const bf16_t* kro = MD + kr * 768 + 640;
            float dot = 0.f;
#pragma unroll 4
            for (int c = 0; c < 16; ++c) { const u32x4 kv = *(const u32x4*)(kn + c * 8); const u32x4 qv = *(const LAS u32x4*)(qs + c * 16);
                dot += lo_bf(kv.x) * lo_bf(qv.x) + hi_bf(kv.x) * hi_bf(qv.x) + lo_bf(kv.y) * lo_bf(qv.y) + hi_bf(kv.y) * hi_bf(qv.y)
                     + lo_bf(kv.z) * lo_bf(qv.z) + hi_bf(kv.z) * hi_bf(qv.z) + lo_bf(kv.w) * lo_bf(qv.w) + hi_bf(kv.w) * hi_bf(qv.w); }
#pragma unroll 4
            for (int c = 0; c < 8; ++c) { const u32x4 kv = *(const u32x4*)(kro + c * 8); const u32x4 qv = *(const LAS u32x4*)(qs + 256 + c * 16);
                dot += lo_bf(kv.x) * lo_bf(qv.x) + hi_bf(kv.x) * hi_bf(qv.x) + lo_bf(kv.y) * lo_bf(qv.y) + hi_bf(kv.y) * hi_bf(qv.y)
                     + lo_bf(kv.z) * lo_bf(qv.z) + hi_bf(kv.z) * hi_bf(qv.z) + lo_bf(kv.w) * lo_bf(qv.w) + hi_bf(kv.w) * hi_bf(qv.w); }
            const float mnew = fmaxf(mrun, dot), alpha = EX2(mrun - mnew), p = EX2(dot - mnew);
            lrun = lrun * alpha + p; mrun = mnew;
            const bf16_t* vrow = KV + kr * 2048 + 1024 + h * 128;
#pragma unroll
            for (int c = 0; c < 16; ++c) { const u32x4 vv = *(const u32x4*)(vrow + c * 8);
                o[c * 8 + 0] = o[c * 8 + 0] * alpha + p * lo_bf(vv.x); o[c * 8 + 1] = o[c * 8 + 1] * alpha + p * hi_bf(vv.x);
                o[c * 8 + 2] = o[c * 8 + 2] * alpha + p * lo_bf(vv.y); o[c * 8 + 3] = o[c * 8 + 3] * alpha + p * hi_bf(vv.y);
                o[c * 8 + 4] = o[c * 8 + 4] * alpha + p * lo_bf(vv.z); o[c * 8 + 5] = o[c * 8 + 5] * alpha + p * hi_bf(vv.z);
                o[c * 8 + 6] = o[c * 8 + 6] * alpha + p * lo_bf(vv.w); o[c * 8 + 7] = o[c * 8 + 7] * alpha + p * hi_bf(vv.w); }
        }
        const float mall = wave_max(mrun), fsc = EX2(mrun - mall);
        const float lall = wave_sum(lrun * fsc);
#pragma unroll
        for (int e = 0; e < 128; ++e) o[e] *= fsc;
        RS_STEP(o, 128, 32); RS_STEP(o, 64, 16); RS_STEP(o, 32, 8); RS_STEP(o, 16, 4); RS_STEP(o, 8, 2); RS_STEP(o, 4, 1);
        const float inv = 1.f / lall;
        *(unsigned*)(QN + m * 1024 + h * 128 + 2 * C.lane) = pk2(o[0] * inv, o[1] * inv);
    }
}

__device__ __forceinline__ void phase_conv(Ctx& C, int l, const bf16_t* XA, bf16_t* U) {
    const float* cw = INP(8) + l * 4 * 1024; const float* cb = INP(9) + l * 1024;
    const int gt = C.bid * NTHR + C.tid, ngt = C.G * NTHR;
    for (int it = gt; it < MR * 128; it += ngt) {
        const int m = it >> 7, c0 = (it & 127) * 8, b = m / SS, s = m - b * SS;
        const int lo = (s < LC) ? 0 : LC, hi = (s < LC) ? LC : SS;
        float a[8];
#pragma unroll
        for (int e = 0; e < 8; ++e) a[e] = cb[c0 + e];
#pragma unroll
        for (int j = 0; j < 4; ++j) { const int sj = s + j - 2;
            if (sj >= lo && sj < hi) { const u32x4 xv = *(const u32x4*)(XA + (size_t)(b * SS + sj) * 1024 + c0); const float* w = cw + j * 1024 + c0;
                a[0] += w[0] * lo_bf(xv.x); a[1] += w[1] * hi_bf(xv.x); a[2] += w[2] * lo_bf(xv.y); a[3] += w[3] * hi_bf(xv.y);
                a[4] += w[4] * lo_bf(xv.z); a[5] += w[5] * hi_bf(xv.z); a[6] += w[6] * lo_bf(xv.w); a[7] += w[7] * hi_bf(xv.w); } }
        u32x4 o; o.x = pk2(a[0], a[1]); o.y = pk2(a[2], a[3]); o.z = pk2(a[4], a[5]); o.w = pk2(a[6], a[7]);
        *(u32x4*)(U + (size_t)m * 1024 + c0) = o;
    }
}
typedef f16_t f16x2 __attribute__((ext_vector_type(2)));
__device__ __forceinline__ void phase_scan1(Ctx& C, int d, const f16_t* RI, float* SUM) {
    for (int un = C.gw; un < NB * 68 * 8; un += C.ngw) {
        const int cg_ = un & 7, sg = (un >> 3) % 68, b = (un >> 3) / 68, ch = cg_ * 128 + 2 * C.lane;
        float A0 = 1.f, A1 = 1.f, H0 = 0.f, H1 = 0.f;
        const f16_t* base = RI + (size_t)(b * SS + sg * 64) * 2048 + ch;
#pragma unroll 16
        for (int i = 0; i < 64; ++i) { const int r = d ? (63 - i) : i;
            const f16x2 la = *(const f16x2*)(base + (size_t)r * 2048), bc = *(const f16x2*)(base + (size_t)r * 2048 + 1024);
            const float a0 = EX2((float)la[0]), a1 = EX2((float)la[1]);
            H0 = a0 * H0 + (float)bc[0]; H1 = a1 * H1 + (float)bc[1]; A0 *= a0; A1 *= a1; }
        float* sp = SUM + ((size_t)(b * 68 + sg) * 1024 + ch) * 2;
        *(f32x4*)sp = (f32x4){A0, H0, A1, H1};
    }
}
__device__ __forceinline__ void phase_scan3(Ctx& C, int d, const f16_t* RI, const float* SUM, bf16_t* YA) {
    for (int un = C.gw; un < NB * 68 * 8; un += C.ngw) {
        const int cg_ = un & 7, sg = (un >> 3) % 68, b = (un >> 3) / 68, ch = cg_ * 128 + 2 * C.lane;
        float H0 = 0.f, H1 = 0.f;
        const int npre = d ? ((sg < 4) ? (3 - sg) : (71 - sg)) : sg;
#pragma unroll 4
        for (int p = 0; p < npre; ++p) { const int ps = d ? ((p < 4) ? (3 - p) : (71 - p)) : p;
            const f32x4 v = *(const f32x4*)(SUM + ((size_t)(b * 68 + ps) * 1024 + ch) * 2);
            H0 = v[0] * H0 + v[1]; H1 = v[2] * H1 + v[3]; }
        const f16_t* base = RI + (size_t)(b * SS + sg * 64) * 2048 + ch;
        bf16_t* yb = YA + (size_t)(b * SS + sg * 64) * 1024 + ch;
#pragma unroll 16
        for (int i = 0; i < 64; ++i) { const int r = d ? (63 - i) : i;
            const f16x2 la = *(const f16x2*)(base + (size_t)r * 2048), bc = *(const f16x2*)(base + (size_t)r * 2048 + 1024);
            const float a0 = EX2((float)la[0]), a1 = EX2((float)la[1]);
            H0 = a0 * H0 + (float)bc[0]; H1 = a1 * H1 + (float)bc[1];
            unsigned* yp = (unsigned*)(yb + (size_t)r * 1024);
            if (d == 0) *yp = pk2(H0, H1); else { const unsigned w = *yp; *yp = pk2(lo_bf(w) + H0, hi_bf(w) + H1); } }
    }
}

template <int W> __device__ __forceinline__ float group_sum(float v) {
#pragma unroll
    for (int o = 1; o < W; o <<= 1) v += __shfl_xor(v, o);
    return v;
}
__device__ __forceinline__ void phase_h2(Ctx& C, int l, bf16_t* H) {
    const float* gain = INP(6) + l * 1024;
    for (int m0 = C.gw * 2; m0 < MR; m0 += C.ngw * 2) {
        f32x4 v[2][4]; float ss[2];
#pragma unroll
        for (int q = 0; q < 2; ++q) { const float* xr = resid_row(C, l, m0 + q);
#pragma unroll
            for (int j = 0; j < 4; ++j) v[q][j] = *(const f32x4*)(xr + 4 * C.lane + 256 * j); }
        const int b = m0 / SS, s = m0 - b * SS, r = (s < LC) ? 4 : b;
        const float* mod = C.ctl + CT_MOD + (l * 5 + r) * 3072;
#pragma unroll
        for (int q = 0; q < 2; ++q) { float a = 0.f;
#pragma unroll
            for (int j = 0; j < 4; ++j) a += (v[q][j].x * v[q][j].x + v[q][j].y * v[q][j].y) + (v[q][j].z * v[q][j].z + v[q][j].w * v[q][j].w);
            ss[q] = a; }
        ss[0] = wave_sum(ss[0]); ss[1] = wave_sum(ss[1]);
#pragma unroll
        for (int j = 0; j < 4; ++j) { const int c = 4 * C.lane + 256 * j;
            const f32x4 g = *(const f32x4*)(gain + c), sh = *(const f32x4*)(mod + c), sc = *(const f32x4*)(mod + 1024 + c) + 1.0f;
#pragma unroll
            for (int q = 0; q < 2; ++q) { const float rstd = RSQ(ss[q] * (1.f / 1024.f) + EPS);
                const f32x4 o = ((v[q][j] * rstd) * g) * sc + sh;
                u32x2 w; w.x = pk2(o.x, o.y); w.y = pk2(o.z, o.w);
                *(u32x2*)(H + (size_t)(m0 + q) * 1024 + c) = w; } }
    }
}
__device__ __forceinline__ void phase_md_post2(Ctx& C, int l, bf16_t* MD) {
    const float* qn = INP(17) + l * 384; const float* kvn = INP(19) + l * 256; const float* gkr = INP(24) + l * 64;
    const float* cs = C.ctl + CT_ROPEM; const float* sn = cs + 1024;
    const int L = C.lane;
    for (int m0 = C.gw * 2; m0 < MR; m0 += C.ngw * 2) {
        u32x4 w0[2], w1[2];
#pragma unroll
        for (int q = 0; q < 2; ++q) { const bf16_t* row = MD + (size_t)(m0 + q) * 768; w0[q] = *(const u32x4*)(row + 8 * L); w1[q] = (L < 32) ? *(const u32x4*)(row + 512 + 8 * L) : (u32x4){0u, 0u, 0u, 0u}; }
#pragma unroll
        for (int q = 0; q < 2; ++q) { const int m = m0 + q, b = m / SS, s = m - b * SS; const bool lat = s >= LC; const int t = s - LC;
            bf16_t* row = MD + (size_t)m * 768;
            float x0[8], x1[8]; unpack8(w0[q], x0); unpack8(w1[q], x1);
            const float s0 = sumsq8(x0), s1 = sumsq8(x1);
            const float sq = wave_sum(L < 48 ? s0 : 0.f), skv = wave_sum((L >= 48 ? s0 : 0.f) + (L < 16 ? s1 : 0.f)), skr = wave_sum((L >= 16 && L < 24) ? s1 : 0.f);
            const float rq = RSQ(sq * (1.f / 384.f) + EPS), rkv = RSQ(skv * (1.f / 256.f) + EPS), rkr = RSQ(skr * (1.f / 64.f) + EPS);
            {   const float* g = (L < 48) ? (qn + 8 * L) : (kvn + 8 * (L - 48)); const float rs = (L < 48) ? rq : rkv;
#pragma unroll
                for (int e = 0; e < 8; ++e) x0[e] *= rs * g[e];
                *(u32x4*)(row + 8 * L) = pack8u(x0); }
            if (L < 16) {
#pragma unroll
                for (int e = 0; e < 8; ++e) x1[e] *= rkv * kvn[128 + 8 * L + e];
            } else if (L < 24) {
#pragma unroll
                for (int e = 0; e < 8; ++e) x1[e] *= rkr * gkr[8 * (L - 16) + e];
            }
            float pr[8];
#pragma unroll
            for (int e = 0; e < 8; ++e) pr[e] = __shfl_xor(x1[e], 2);
            if (lat && L >= 16 && L < 24) { const int qt = (L - 16) >> 1, f0 = ((L - 16) & 1) * 8, pos = (qt < 2) ? (t >> 6) : (t & 63); const float sg = (qt & 1) ? 1.f : -1.f;
#pragma unroll
                for (int e = 0; e < 8; ++e) x1[e] = x1[e] * cs[pos * 16 + f0 + e] + sg * pr[e] * sn[pos * 16 + f0 + e]; }
            if (L < 24) *(u32x4*)(row + 512 + 8 * L) = pack8u(x1);
        }
    }
}
__device__ __forceinline__ void phase_qk_post2(Ctx& C, int l, bf16_t* QN, bf16_t* QP, bf16_t* KV) {
    const float* gqn = INP(21) + l * 128; const float* gqr = INP(22) + l * 64; const float* gkn = INP(23) + l * 128;
    const float* cs = C.ctl + CT_ROPEM; const float* sn = cs + 1024;
    const int L = C.lane;
    for (int m0 = C.gw * 2; m0 < MR; m0 += C.ngw * 2) {
        u32x4 a[2][2], k[2][2], p[2];
#pragma unroll
        for (int q = 0; q < 2; ++q) { const size_t m = m0 + q;
            a[q][0] = *(const u32x4*)(QN + m * 1024 + 8 * L); a[q][1] = *(const u32x4*)(QN + m * 1024 + 512 + 8 * L);
            k[q][0] = *(const u32x4*)(KV + m * 2048 + 8 * L); k[q][1] = *(const u32x4*)(KV + m * 2048 + 512 + 8 * L);
            p[q] = *(const u32x4*)(QP + m * 512 + 8 * L); }
#pragma unroll
        for (int q = 0; q < 2; ++q) { const int m = m0 + q, b = m / SS, s = m - b * SS; const bool lat = s >= LC; const int t = s - LC;
#pragma unroll
            for (int c = 0; c < 2; ++c) {
                float x[8]; unpack8(a[q][c], x);
                const float rs = RSQ(group_sum<16>(sumsq8(x)) * (1.f / 128.f) + EPS) * QSCALE;
#pragma unroll
                for (int e = 0; e < 8; ++e) x[e] *= rs * gqn[8 * (L & 15) + e];
                *(u32x4*)(QN + (size_t)m * 1024 + c * 512 + 8 * L) = pack8u(x);
                float y[8]; unpack8(k[q][c], y);
                const float rk = RSQ(group_sum<16>(sumsq8(y)) * (1.f / 128.f) + EPS);
#pragma unroll
                for (int e = 0; e < 8; ++e) y[e] *= rk * gkn[8 * (L & 15) + e];
                *(u32x4*)(KV + (size_t)m * 2048 + c * 512 + 8 * L) = pack8u(y); }
            {   float x[8]; unpack8(p[q], x);
                const float rs = RSQ(group_sum<8>(sumsq8(x)) * (1.f / 64.f) + EPS);
#pragma unroll
                for (int e = 0; e < 8; ++e) x[e] *= rs * gqr[8 * (L & 7) + e];
                float pr[8];
#pragma unroll
                for (int e = 0; e < 8; ++e) pr[e] = __shfl_xor(x[e], 2);
                if (lat) { const int qt = (L >> 1) & 3, f0 = (L & 1) * 8, pos = (qt < 2) ? (t >> 6) : (t & 63); const float sg = (qt & 1) ? 1.f : -1.f;
#pragma unroll
                    for (int e = 0; e < 8; ++e) x[e] = x[e] * cs[pos * 16 + f0 + e] + sg * pr[e] * sn[pos * 16 + f0 + e]; }
#pragma unroll
                for (int e = 0; e < 8; ++e) x[e] *= QSCALE;
                *(u32x4*)(QP + (size_t)m * 512 + 8 * L) = pack8u(x); }
        }
    }
}
__device__ __forceinline__ void phase_ret_ln3(Ctx& C, int l, bf16_t* OI, const bf16_t* OB) {
    const float* gain = INP(16) + l * 1024;
    const int L = C.lane;
    for (int m0 = C.gw * 2; m0 < MR; m0 += C.ngw * 2) {
        u32x4 a[2][2], bb[2][2];
#pragma unroll
        for (int q = 0; q < 2; ++q)
#pragma unroll
            for (int c = 0; c < 2; ++c) { a[q][c] = *(const u32x4*)(OI + (size_t)(m0 + q) * 1024 + c * 512 + 8 * L); bb[q][c] = *(const u32x4*)(OB + (size_t)(m0 + q) * 1024 + c * 512 + 8 * L); }
#pragma unroll
        for (int q = 0; q < 2; ++q)
#pragma unroll
            for (int c = 0; c < 2; ++c) { float x[8], y[8]; unpack8(a[q][c], x); unpack8(bb[q][c], y);
                float s = 0.f;
#pragma unroll
                for (int e = 0; e < 8; ++e) { x[e] += y[e]; s += x[e]; }
                const float mean = group_sum<32>(s) * (1.f / 256.f);
                float v = 0.f;
#pragma unroll
                for (int e = 0; e < 8; ++e) { x[e] -= mean; v += x[e] * x[e]; }
                const float rstd = RSQ(group_sum<32>(v) * (1.f / 256.f) + EPS);
#pragma unroll
                for (int e = 0; e < 8; ++e) x[e] *= rstd * gain[c * 512 + 8 * L + e];
                *(u32x4*)(OI + (size_t)(m0 + q) * 1024 + c * 512 + 8 * L) = pack8u(x); }
    }
}

__device__ __forceinline__ void phase_zsum(Ctx& C, const bf16_t* ZP, bf16_t* Z) {
    const int gt = C.bid * NTHR + C.tid, ngt = C.G * NTHR;
    for (int it = gt; it < 1024 * 128; it += ngt) { const int r = it >> 7, c0 = (it & 127) * 8, b = r >> 8, s = r & 255;
        const u32x4 a = *(const u32x4*)(ZP + (size_t)r * 1024 + c0), bq = *(const u32x4*)(ZP + (size_t)(1024 + r) * 1024 + c0), cq = *(const u32x4*)(ZP + (size_t)(2048 + r) * 1024 + c0);
        float x[8], y[8], z[8]; unpack8(a, x); unpack8(bq, y); unpack8(cq, z);
#pragma unroll
        for (int e = 0; e < 8; ++e) x[e] += y[e] + z[e];
        *(u32x4*)(Z + (size_t)(b * SS + s) * 1024 + c0) = pack8u(x); }
}

typedef float f32x16 __attribute__((ext_vector_type(16)));
typedef short v4i16_t __attribute__((ext_vector_type(4)));
constexpr int AT_KP = 400, AT_VP = 320;
constexpr int AT_KB = 64 * AT_KP, AT_VB = 64 * AT_VP, AT_STG = AT_KB + AT_VB, AT_WSF = 2 * AT_STG;
__device__ __forceinline__ int crow(int r, int hi) { return (r & 3) + 8 * (r >> 2) + 4 * hi; }
__device__ __forceinline__ bf16x8 pack8(float a, float b, float c, float d, float e, float f, float g, float h) {
    u32x4 w; w.x = pg8::cvt_pk_bf16(a, b); w.y = pg8::cvt_pk_bf16(c, d); w.z = pg8::cvt_pk_bf16(e, f); w.w = pg8::cvt_pk_bf16(g, h); return __builtin_bit_cast(bf16x8, w); }
__device__ __forceinline__ bf16x8 tr2(LAS unsigned char* p0, LAS unsigned char* p1) {
    const v4i16_t lo = __builtin_amdgcn_ds_read_tr16_b64_v4i16((LAS v4i16_t*)p0), hi = __builtin_amdgcn_ds_read_tr16_b64_v4i16((LAS v4i16_t*)p1);
    return (bf16x8){lo[0], lo[1], lo[2], lo[3], hi[0], hi[1], hi[2], hi[3]}; }

__device__ __forceinline__ void phase_attn(Ctx& C, int l, bool with_ctx, bf16_t* QN, const bf16_t* QP, const bf16_t* KV, const bf16_t* MD) {
    const float* gqn = INP(21) + l * 128; const float* gqr = INP(22) + l * 64; const float* csm = C.ctl + CT_ROPEM;
    const int lane = C.lane, r32 = lane & 31, hi = lane >> 5, wave = C.wave, tid = C.tid;
    LAS unsigned char* lds = C.lds;
    LAS float* wsf = (LAS float*)(lds + AT_WSF + wave * 128);
    const int nunits = 512 + (with_ctx ? 32 : 0);
    const int rowA = tid >> 4, ccA = tid & 15, rowR = tid >> 3, ccR = tid & 7;
    const int i16 = lane & 15, q4 = i16 >> 2, p4 = i16 & 3, g1 = (lane >> 4) & 1;
    const int vb = AT_KB + (4 * hi + q4) * AT_VP + (16 * g1 + 4 * p4) * 2;
    const int wK = rowA * AT_KP + ccA * 16, wR = rowR * AT_KP + 256 + ccR * 16, wV = AT_KB + rowA * AT_VP + ccA * 16;
    for (int un = C.bid; un < nunits; un += C.G) {
        int bh, qb, isctx;
        if (un < 512) { const int x = un & 7, jj = un >> 3; bh = x * 4 + (jj >> 4); qb = jj & 15; isctx = 0; } else { bh = un - 512; qb = 0; isctx = 1; }
        const int b = bh >> 3, h = bh & 7;
        const size_t kb0 = (size_t)b * SS;
        const size_t m0 = kb0 + (isctx ? 0 : LC + qb * 256) + wave * 32;
        const int NT = (isctx ? LC : SS) / 64;
        bf16x8 qf[12];
        {   const bf16_t* qn = QN + (m0 + r32) * 1024 + h * 128 + hi * 8; const bf16_t* qp = QP + (m0 + r32) * 512 + h * 64 + hi * 8;
#pragma unroll
            for (int s = 0; s < 8; ++s) qf[s] = *(const bf16x8*)(qn + s * 16);
#pragma unroll
            for (int s = 0; s < 4; ++s) qf[8 + s] = *(const bf16x8*)(qp + s * 16); }
        {
            int hq = hi; asm volatile("" : "+v"(hq));
            float ssn = 0.f, ssr = 0.f;
#pragma unroll
            for (int s = 0; s < 12; ++s) { float x[8]; unpack8(__builtin_bit_cast(u32x4, qf[s]), x); const float q = sumsq8(x); if (s < 8) ssn += q; else ssr += q; }
            ssn += __shfl_xor(ssn, 32); ssr += __shfl_xor(ssr, 32);
            const float rn = RSQ(ssn * (1.f / 128.f) + EPS) * QSCALE, rr = RSQ(ssr * (1.f / 64.f) + EPS);
#pragma unroll
            for (int s = 0; s < 8; ++s) { float x[8]; unpack8(__builtin_bit_cast(u32x4, qf[s]), x);
                const f32x4 ga = *(const f32x4*)(gqn + 16 * s + 8 * hq), gb = *(const f32x4*)(gqn + 16 * s + 8 * hq + 4);
                x[0] *= rn * ga[0]; x[1] *= rn * ga[1]; x[2] *= rn * ga[2]; x[3] *= rn * ga[3]; x[4] *= rn * gb[0]; x[5] *= rn * gb[1]; x[6] *= rn * gb[2]; x[7] *= rn * gb[3];
                qf[s] = __builtin_bit_cast(bf16x8, pack8u(x)); }
            const int tq = qb * 256 + wave * 32 + r32;
#pragma unroll
            for (int pr = 0; pr < 2; ++pr) {
                float xa[8], xb[8]; unpack8(__builtin_bit_cast(u32x4, qf[8 + 2 * pr]), xa); unpack8(__builtin_bit_cast(u32x4, qf[9 + 2 * pr]), xb);
#pragma unroll
                for (int j = 0; j < 8; ++j) { xa[j] *= rr * gqr[32 * pr + 8 * hq + j]; xb[j] *= rr * gqr[32 * pr + 16 + 8 * hq + j]; }
                if (!isctx) { const int pos = pr ? (tq & 63) : (tq >> 6);
#pragma unroll
                    for (int j = 0; j < 8; ++j) { const float c = csm[pos * 16 + 8 * hq + j], sv = csm[1024 + pos * 16 + 8 * hq + j]; const float a = xa[j] * c - xb[j] * sv, bq = xb[j] * c + xa[j] * sv; xa[j] = a; xb[j] = bq; } }
#pragma unroll
                for (int j = 0; j < 8; ++j) { xa[j] *= QSCALE; xb[j] *= QSCALE; }
                qf[8 + 2 * pr] = __builtin_bit_cast(bf16x8, pack8u(xa)); qf[9 + 2 * pr] = __builtin_bit_cast(bf16x8, pack8u(xb)); }
        }
        f32x16 o[4];
#pragma unroll
        for (int d = 0; d < 4; ++d)
#pragma unroll
            for (int r = 0; r < 16; ++r) o[d][r] = 0.f;
        float mrun = -1e30f, lrun = 0.f;
        u32x4 kn0, kn1, kr0, vv0, vv1;
        const unsigned kvo = (unsigned)(((kb0 + rowA) * 2048 + h * 128 + ccA * 8) * 2);
        const unsigned kro = (unsigned)(((kb0 + rowR) * 768 + 640 + ccR * 8) * 2);
#define AT_LOAD(t) do { const char* kp_ = (const char*)KV + (size_t)(t) * (64 * 2048 * 2); kn0 = *(const u32x4*)(kp_ + kvo); kn1 = *(const u32x4*)(kp_ + 32 * 2048 * 2 + kvo); vv0 = *(const u32x4*)(kp_ + 1024 * 2 + kvo); vv1 = *(const u32x4*)(kp_ + (32 * 2048 + 1024) * 2 + kvo); \
        kr0 = *(const u32x4*)((const char*)MD + (size_t)(t) * (64 * 768 * 2) + kro); } while (0)
#define AT_WRITE(sb) do { int sb_ = (sb); asm volatile("" : "+s"(sb_)); LAS unsigned char* s_ = lds + sb_;     \
        *(LAS u32x4*)(s_ + wK) = kn0; *(LAS u32x4*)(s_ + wK + 32 * AT_KP) = kn1; \
        *(LAS u32x4*)(s_ + wR) = kr0; *(LAS u32x4*)(s_ + wV) = vv0; *(LAS u32x4*)(s_ + wV + 32 * AT_VP) = vv1; } while (0)
#define AT_QK(sbv) do { _Pragma("unroll") for (int r = 0; r < 16; ++r) { p0[r] = 0.f; p1[r] = 0.f; } \
        LAS unsigned char* ka = lds + (sbv) + r32 * AT_KP + hi * 16; __builtin_amdgcn_s_setprio(1); \
        _Pragma("unroll") for (int s = 0; s < 12; ++s) { const bf16x8 a0 = *(const LAS bf16x8*)(ka + s * 32), a1 = *(const LAS bf16x8*)(ka + 32 * AT_KP + s * 32); \
            p0 = __builtin_amdgcn_mfma_f32_32x32x16_bf16(a0, qf[s], p0, 0, 0, 0); p1 = __builtin_amdgcn_mfma_f32_32x32x16_bf16(a1, qf[s], p1, 0, 0, 0); \
            if ((s & 3) == 3) asm volatile("" ::: "memory"); } \
        __builtin_amdgcn_s_setprio(0); } while (0)
#define AT_SM() do { float rm = fmaxf(p0[0], p1[0]); \
        _Pragma("unroll") for (int r = 1; r < 16; ++r) rm = fmaxf(rm, fmaxf(p0[r], p1[r])); \
        rm = fmaxf(rm, __shfl_xor(rm, 32)); \
        if (__any(rm > mrun + 8.f)) { const float mnew = fmaxf(mrun, rm), alpha = EX2(mrun - mnew); mrun = mnew; lrun *= alpha; \
            if (hi == 0) wsf[r32] = alpha; \
            _Pragma("unroll") for (int r = 0; r < 16; ++r) { const float a = wsf[crow(r, hi)]; _Pragma("unroll") for (int d = 0; d < 4; ++d) o[d][r] *= a; } } \
        float ls = 0.f; \
        _Pragma("unroll") for (int r = 0; r < 16; ++r) { p0[r] = EX2(p0[r] - mrun); p1[r] = EX2(p1[r] - mrun); ls += p0[r] + p1[r]; } \
        lrun += ls; \
        pa0 = pack8(p0[0], p0[1], p0[2], p0[3], p0[4], p0[5], p0[6], p0[7]); pa1 = pack8(p0[8], p0[9], p0[10], p0[11], p0[12], p0[13], p0[14], p0[15]); \
        pa2 = pack8(p1[0], p1[1], p1[2], p1[3], p1[4], p1[5], p1[6], p1[7]); pa3 = pack8(p1[8], p1[9], p1[10], p1[11], p1[12], p1[13], p1[14], p1[15]); } while (0)
#define AT_PV(sbv) do { LAS unsigned char* vp = lds + (sbv) + vb; __builtin_amdgcn_s_setprio(1); \
        _Pragma("unroll") for (int d = 0; d < 4; ++d) { \
            o[d] = __builtin_amdgcn_mfma_f32_32x32x16_bf16(pa0, tr2(vp + d * 64, vp + d * 64 + 8 * AT_VP), o[d], 0, 0, 0); \
            o[d] = __builtin_amdgcn_mfma_f32_32x32x16_bf16(pa1, tr2(vp + d * 64 + 16 * AT_VP, vp + d * 64 + 24 * AT_VP), o[d], 0, 0, 0); \
            o[d] = __builtin_amdgcn_mfma_f32_32x32x16_bf16(pa2, tr2(vp + d * 64 + 32 * AT_VP, vp + d * 64 + 40 * AT_VP), o[d], 0, 0, 0); \
            o[d] = __builtin_amdgcn_mfma_f32_32x32x16_bf16(pa3, tr2(vp + d * 64 + 48 * AT_VP, vp + d * 64 + 56 * AT_VP), o[d], 0, 0, 0); \
            asm volatile("" ::: "memory"); } \
        __builtin_amdgcn_s_setprio(0); } while (0)
        AT_LOAD(0); AT_WRITE(0);
        __syncthreads();
        bf16x8 pa0, pa1, pa2, pa3;
        if (wave < 4) {
            for (int t = 0; t < NT; ++t) {
                const int sb = (t & 1) * AT_STG;
                if (t + 1 < NT) AT_LOAD(t + 1);
                f32x16 p0, p1;
                AT_QK(sb);
                __syncthreads();
                if (t + 1 < NT) AT_WRITE(AT_STG - sb);
                AT_SM(); AT_PV(sb);
                __syncthreads();
            }
            __syncthreads(); __syncthreads();
        } else {
            for (int t = 0; t <= NT; ++t) {
                const int sb = (t & 1) * AT_STG;
                if (t + 1 < NT) AT_LOAD(t + 1);
                if (t > 0) AT_PV(AT_STG - sb);
                __syncthreads();
                if (t + 1 < NT) AT_WRITE(AT_STG - sb);
                if (t < NT) { f32x16 p0, p1; AT_QK(sb); AT_SM(); }
                __syncthreads();
            }
        }
#undef AT_QK
#undef AT_SM
#undef AT_PV
#undef AT_LOAD
#undef AT_WRITE
        const float ltot = lrun + __shfl_xor(lrun, 32);
        if (hi == 0) wsf[r32] = 1.f / ltot;
        bf16_t* op = QN + (m0 + 4 * hi) * 1024 + h * 128 + r32;
#pragma unroll
        for (int r = 0; r < 16; ++r) { const float inv = wsf[crow(r, hi)];
#pragma unroll
            for (int d = 0; d < 4; ++d) op[d * 32] = (bf16_t)f2bf(o[d][r] * inv);
            op += ((r & 3) == 3) ? 5 * 1024 : 1024; OPAQ_G(op); }
        __syncthreads();
    }
}

constexpr int RI_KP = 528, RI_VP = 576, RI_PTP = 272;
constexpr int RI_A = 0, RI_PT = 128 * RI_VP;
__device__ __forceinline__ void phase_ret_intra(Ctx& C, int l, const bf16_t* RQKV, bf16_t* OI) {
    const int lane = C.lane, r32 = lane & 31, hi = lane >> 5, wave = C.wave, tid = C.tid;
    LAS unsigned char* lds = C.lds;
    const int i16 = lane & 15, q4 = i16 >> 2, p4 = i16 & 3, g1 = (lane >> 4) & 1;
    const int nb = wave & 3, wh = wave >> 2;
    const int srow = tid >> 5, scc = tid & 31;
    for (int un = C.bid; un < NB * 4 * 34; un += C.G) {
        const int c = un % 34, bh = un / 34, b = bh >> 2, h = bh & 3;
        const size_t row0 = (size_t)b * SS + c * 128;
        const float lgf = C.ctl[CT_LG + (l * 2 + 0) * 4 + h], lgb = C.ctl[CT_LG + (l * 2 + 1) * 4 + h];
        const bf16_t* gk = RQKV + (row0 + srow) * 3072 + 1024 + h * 256 + scc * 8;
        u32x4 st[8];
        {   const bf16_t* gp = gk;
#pragma unroll
            for (int j = 0; j < 8; ++j) { st[j] = *(const u32x4*)gp; gp += 16 * 3072; OPAQ_G(gp); } }
#pragma unroll
        for (int j = 0; j < 8; ++j) *(LAS u32x4*)(lds + RI_A + (srow + 16 * j) * RI_KP + scc * 16) = st[j];
        __syncthreads();
        {   const bf16_t* gp = gk + 1024;
#pragma unroll
            for (int j = 0; j < 8; ++j) { st[j] = *(const u32x4*)gp; gp += 16 * 3072; OPAQ_G(gp); } }
        {
            f32x16 x0, x1;
#pragma unroll
            for (int r = 0; r < 16; ++r) { x0[r] = 0.f; x1[r] = 0.f; }
            const bf16_t* gq = RQKV + (row0 + nb * 32 + r32) * 3072 + h * 256 + hi * 8;
            LAS unsigned char* ka = lds + RI_A + (wh * 64 + r32) * RI_KP + hi * 16;
#pragma unroll
            for (int s = 0; s < 16; ++s) { const bf16x8 qf = *(const bf16x8*)(gq + s * 16);
                const bf16x8 a0 = *(const LAS bf16x8*)(ka + s * 32), a1 = *(const LAS bf16x8*)(ka + 32 * RI_KP + s * 32);
                x0 = __builtin_amdgcn_mfma_f32_32x32x16_bf16(a0, qf, x0, 0, 0, 0); x1 = __builtin_amdgcn_mfma_f32_32x32x16_bf16(a1, qf, x1, 0, 0, 0);
                if ((s & 3) == 3) asm volatile("" ::: "memory"); }
            const int n = nb * 32 + r32;
            LAS unsigned char* pt = lds + RI_PT + n * RI_PTP + (wh * 64 + 4 * hi) * 2;
#pragma unroll
            for (int g = 0; g < 4; ++g) { float w0[4], w1[4];
#pragma unroll
                for (int e = 0; e < 4; ++e) { const int m0 = wh * 64 + 8 * g + 4 * hi + e; const float d0 = (float)(n - m0), d1 = d0 - 32.f;
                    const float f0 = EX2(lgf * fmaxf(d0, 0.f)) * fminf(fmaxf(d0 + 1.f, 0.f), 1.f) + EX2(lgb * fmaxf(-d0, 0.f)) * fminf(fmaxf(1.f - d0, 0.f), 1.f);
                    const float f1 = EX2(lgf * fmaxf(d1, 0.f)) * fminf(fmaxf(d1 + 1.f, 0.f), 1.f) + EX2(lgb * fmaxf(-d1, 0.f)) * fminf(fmaxf(1.f - d1, 0.f), 1.f);
                    w0[e] = x0[4 * g + e] * f0; w1[e] = x1[4 * g + e] * f1; }
                u32x2 o0, o1; o0.x = pg8::cvt_pk_bf16(w0[0], w0[1]); o0.y = pg8::cvt_pk_bf16(w0[2], w0[3]); o1.x = pg8::cvt_pk_bf16(w1[0], w1[1]); o1.y = pg8::cvt_pk_bf16(w1[2], w1[3]);
                *(LAS u32x2*)(pt + g * 16) = o0; *(LAS u32x2*)(pt + 64 + g * 16) = o1; }
        }
        __syncthreads();
#pragma unroll
        for (int j = 0; j < 8; ++j) *(LAS u32x4*)(lds + RI_A + (srow + 16 * j) * RI_VP + scc * 16) = st[j];
        __syncthreads();
        {
            f32x16 o[4];
#pragma unroll
            for (int d = 0; d < 4; ++d)
#pragma unroll
                for (int r = 0; r < 16; ++r) o[d][r] = 0.f;
            bf16x8 pa[8];
            LAS unsigned char* pr = lds + RI_PT + (nb * 32 + r32) * RI_PTP + hi * 16;
#pragma unroll
            for (int s = 0; s < 8; ++s) pa[s] = *(const LAS bf16x8*)(pr + s * 32);
            LAS unsigned char* vp = lds + RI_A + (8 * hi + q4) * RI_VP + (wh * 128 + 16 * g1 + 4 * p4) * 2;
#pragma unroll
            for (int d = 0; d < 4; ++d) {
#pragma unroll
                for (int s = 0; s < 8; ++s) o[d] = __builtin_amdgcn_mfma_f32_32x32x16_bf16(pa[s], tr2(vp + d * 64 + s * 16 * RI_VP, vp + d * 64 + (s * 16 + 4) * RI_VP), o[d], 0, 0, 0);
                asm volatile("" ::: "memory"); }
            bf16_t* op = OI + (row0 + nb * 32 + 4 * hi) * 1024 + h * 256 + wh * 128 + r32;
#pragma unroll
            for (int r = 0; r < 16; ++r) {
#pragma unroll
                for (int d = 0; d < 4; ++d) op[d * 32] = (bf16_t)f2bf(o[d][r]);
                op += ((r & 3) == 3) ? 5 * 1024 : 1024; OPAQ_G(op); }
        }
        __syncthreads();
    }
}

constexpr int RC_KT = 0, RC_KTP = 576, RC_VT = 128 * 576, RC_VTP = 64, RC_ST = RC_VT + 128 * 64, RC_STP = 528, RC_XO = RC_ST + 32 * 528, RC_END = RC_XO + 16384;
static_assert(RC_END <= 131072, "R-chain LDS");
__device__ __forceinline__ void phase_ret_chain(Ctx& C, int l, const bf16_t* RQKV, bf16_t* OI, bf16_t* OB) {
    const int lane = C.lane, r32 = lane & 31, hi = lane >> 5, wave = C.wave, tid = C.tid;
    LAS unsigned char* lds = C.lds;
    const int i16 = lane & 15, q4 = i16 >> 2, p4 = i16 & 3, g1 = (lane >> 4) & 1;
    const int nb = wave & 3, dh = wave >> 2;
    const int srow = tid >> 5, scc = tid & 31, vrow = tid >> 2, vcc = tid & 3;
    for (int un = C.bid; un < 256; un += C.G) {
        const int x = un & 7, j8 = un >> 3, bhd = x * 4 + (j8 >> 3), sl = j8 & 7, b = bhd >> 3, h = (bhd >> 1) & 3, dir = bhd & 1;
        const float lg = C.ctl[CT_LG + (l * 2 + dir) * 4 + h];
        const float cdec = EX2(lg * 128.f);
        const float vdec = dir ? EX2(lg * (float)vrow) : EX2(lg * (float)(127 - vrow));
        f32x16 sacc;
#pragma unroll
        for (int r = 0; r < 16; ++r) sacc[r] = 0.f;
        for (int i = tid; i < 32 * RC_STP / 16; i += NTHR) *(LAS u32x4*)(lds + RC_ST + i * 16) = (u32x4){0u, 0u, 0u, 0u};
        u32x4 st[8]; u32x4 sv;
#define RC_LOAD(cc_) do { const size_t r0_ = (size_t)b * SS + (cc_) * 128; const bf16_t* gk_ = RQKV + (r0_ + srow) * 3072 + 1024 + h * 256 + scc * 8; \
        _Pragma("unroll") for (int j = 0; j < 8; ++j) { st[j] = *(const u32x4*)gk_; gk_ += 16 * 3072; OPAQ_G(gk_); } \
        sv = *(const u32x4*)(RQKV + (r0_ + vrow) * 3072 + 2048 + h * 256 + sl * 32 + vcc * 8); } while (0)
#define RC_WRITE() do { _Pragma("unroll") for (int j = 0; j < 8; ++j) *(LAS u32x4*)(lds + RC_KT + (srow + 16 * j) * RC_KTP + scc * 16) = st[j]; \
        u32x4 w_; w_.x = pg8::cvt_pk_bf16(lo_bf(sv.x) * vdec, hi_bf(sv.x) * vdec); w_.y = pg8::cvt_pk_bf16(lo_bf(sv.y) * vdec, hi_bf(sv.y) * vdec); \
        w_.z = pg8::cvt_pk_bf16(lo_bf(sv.z) * vdec, hi_bf(sv.z) * vdec); w_.w = pg8::cvt_pk_bf16(lo_bf(sv.w) * vdec, hi_bf(sv.w) * vdec); \
        *(LAS u32x4*)(lds + RC_VT + vrow * RC_VTP + vcc * 16) = w_; } while (0)
        bf16x8 qa[8];
#define RC_QLOAD(dst, cc_) do { const bf16_t* gq_ = RQKV + ((size_t)b * SS + (cc_) * 128 + nb * 32 + r32) * 3072 + h * 256 + dh * 128 + hi * 8; \
        _Pragma("unroll") for (int s = 0; s < 8; ++s) dst[s] = *(const bf16x8*)(gq_ + s * 16); } while (0)
        {   const int c0 = dir ? 1 : 0, c1 = dir ? 0 : 1; RC_LOAD(c0); RC_WRITE(); RC_QLOAD(qa, c0); RC_LOAD(c1); }
        __syncthreads();
        for (int i = 0; i < 34; ++i) {
            const int c = dir ? ((i < 2) ? (1 - i) : (35 - i)) : i;
            const size_t r0 = (size_t)b * SS + c * 128;
            const int cn = (i + 1 < 34) ? (dir ? ((i + 1 < 2) ? (1 - (i + 1)) : (35 - (i + 1))) : (i + 1)) : c;
            unsigned short oiv[16];
            if (dh == 0 && dir == 0) { const bf16_t* ip = OI + (r0 + nb * 32 + 4 * hi) * 1024 + h * 256 + sl * 32 + r32;
#pragma unroll
                for (int r = 0; r < 16; ++r) oiv[r] = ip[(size_t)((r & 3) + 8 * (r >> 2)) * 1024]; }
            f32x16 oacc;
#pragma unroll
            for (int r = 0; r < 16; ++r) oacc[r] = 0.f;
            {   LAS unsigned char* sb = lds + RC_ST + r32 * RC_STP + (dh * 128 + hi * 8) * 2;
#pragma unroll
                for (int s = 0; s < 8; ++s) { const bf16x8 sbf = *(const LAS bf16x8*)(sb + s * 32);
                    oacc = __builtin_amdgcn_mfma_f32_32x32x16_bf16(qa[s], sbf, oacc, 0, 0, 0); } }
            asm volatile("" ::: "memory");
            RC_QLOAD(qa, cn);
#pragma unroll
            for (int r = 0; r < 16; ++r) sacc[r] *= cdec;
            {   LAS unsigned char* kp = lds + RC_KT + (8 * hi + q4) * RC_KTP + (wave * 32 + 16 * g1 + 4 * p4) * 2;
                LAS unsigned char* vp = lds + RC_VT + (8 * hi + q4) * RC_VTP + (16 * g1 + 4 * p4) * 2;
#pragma unroll
                for (int s = 0; s < 8; ++s) sacc = __builtin_amdgcn_mfma_f32_32x32x16_bf16(tr2(kp + s * 16 * RC_KTP, kp + (s * 16 + 4) * RC_KTP), tr2(vp + s * 16 * RC_VTP, vp + (s * 16 + 4) * RC_VTP), sacc, 0, 0, 0); }
            if (dh == 1) {
#pragma unroll
                for (int r = 0; r < 16; ++r) *(LAS float*)(lds + RC_XO + nb * 4096 + r * 256 + lane * 4) = oacc[r]; }
            __syncthreads();
            if (dh == 0) {
                bf16_t* op = (dir ? OB : OI) + (r0 + nb * 32 + 4 * hi) * 1024 + h * 256 + sl * 32 + r32;
#pragma unroll
                for (int r = 0; r < 16; ++r) { const int n = nb * 32 + crow(r, hi);
                    const float qd = dir ? EX2(lg * (float)(128 - n)) : EX2(lg * (float)(n + 1));
                    float v = (oacc[r] + *(const LAS float*)(lds + RC_XO + nb * 4096 + r * 256 + lane * 4)) * qd;
                    if (dir == 0) v += bf2f(oiv[r]);
                    *op = (bf16_t)f2bf(v);
                    op += ((r & 3) == 3) ? 5 * 1024 : 1024; OPAQ_G(op); }
            }
            {   LAS unsigned char* sp = lds + RC_ST + r32 * RC_STP + (wave * 32 + 4 * hi) * 2;
#pragma unroll
                for (int g = 0; g < 4; ++g) { u32x2 o2; o2.x = pg8::cvt_pk_bf16(sacc[4 * g], sacc[4 * g + 1]); o2.y = pg8::cvt_pk_bf16(sacc[4 * g + 2], sacc[4 * g + 3]); *(LAS u32x2*)(sp + g * 16) = o2; } }
            if (i + 1 < 34) RC_WRITE();
            if (i + 2 < 34) { const int c2 = dir ? ((i + 2 < 2) ? (1 - (i + 2)) : (35 - (i + 2))) : (i + 2); RC_LOAD(c2); }
            __syncthreads();
        }
#undef RC_QLOAD
#undef RC_LOAD
#undef RC_WRITE
    }
}
__device__ __forceinline__ void phase_ret_ln2(Ctx& C, int l, bf16_t* OI, const bf16_t* OB) {
    const float* gain = INP(16) + l * 1024;
    for (int m = C.gw; m < MR; m += C.ngw) {
#pragma unroll
        for (int h = 0; h < 4; ++h) { bf16_t* p = OI + (size_t)m * 1024 + h * 256 + C.lane * 4;
            const u32x2 w = *(const u32x2*)p, w2 = *(const u32x2*)(OB + (size_t)m * 1024 + h * 256 + C.lane * 4);
            float x0 = lo_bf(w.x) + lo_bf(w2.x), x1 = hi_bf(w.x) + hi_bf(w2.x), x2 = lo_bf(w.y) + lo_bf(w2.y), x3 = hi_bf(w.y) + hi_bf(w2.y);
            const float mean = wave_sum((x0 + x1) + (x2 + x3)) * (1.f / 256.f);
            x0 -= mean; x1 -= mean; x2 -= mean; x3 -= mean;
            const float var = wave_sum((x0 * x0 + x1 * x1) + (x2 * x2 + x3 * x3)) * (1.f / 256.f);
            const float rstd = RSQ(var + EPS);
            const f32x4 g = *(const f32x4*)(gain + h * 256 + C.lane * 4);
            u32x2 o; o.x = pk2(x0 * rstd * g.x, x1 * rstd * g.y); o.y = pk2(x2 * rstd * g.z, x3 * rstd * g.w); *(u32x2*)p = o; }
    }
}

constexpr int LR_UP = 272;
constexpr int LR_CP = 272;
constexpr int LR_U = 0, LR_LA = 128 * LR_UP, LR_BC = LR_LA + 128 * LR_CP, LR_Y0 = LR_BC + 128 * LR_CP, LR_XS = LR_Y0 + 128 * LR_CP, LR_END = LR_XS + 4096;
static_assert(LR_END <= 147456 - 1024, "fused LRU LDS");
__device__ __forceinline__ void phase_lru_fused(Ctx& C, int l, const bf16_t* XA, const bf16_t* WTL, bf16_t* Y0, f16_t* CAF, f16_t* CAB, float* SUM) {
    const int lane = C.lane, r32 = lane & 31, hi = lane >> 5, wave = C.wave, tid = C.tid;
    LAS unsigned char* lds = C.lds;
    const float* cw = INP(8) + l * 4 * 1024; const float* cb = INP(9) + l * 1024;
    const int rb = wave & 3, cgp = wave >> 2;
    for (int un = C.bid; un < NB * 8 * 34; un += C.G) {
        const int sg = un % 34, bn = un / 34, b = bn >> 3, n = bn & 7;
        const int R0 = b * SS + sg * 128, lo = (sg < 2) ? b * SS : b * SS + LC, hi_ = (sg < 2) ? b * SS + LC : (b + 1) * SS;
#pragma unroll
        for (int j = 0; j < 4; ++j) { const int item = tid + 512 * j, row = item >> 4, cc = item & 15, ch0 = n * 128 + cc * 8;
            float a[8];
            {   const f32x4 c0 = *(const f32x4*)(cb + ch0), c1 = *(const f32x4*)(cb + ch0 + 4); a[0] = c0[0]; a[1] = c0[1]; a[2] = c0[2]; a[3] = c0[3]; a[4] = c1[0]; a[5] = c1[1]; a[6] = c1[2]; a[7] = c1[3]; }
#pragma unroll
            for (int t = 0; t < 4; ++t) { const int rr = R0 + row + t - 2;
                const f32x4 wA = *(const f32x4*)(cw + t * 1024 + ch0), wB = *(const f32x4*)(cw + t * 1024 + ch0 + 4);
                if (rr >= lo && rr < hi_) { const u32x4 xv = *(const u32x4*)(XA + (size_t)rr * 1024 + ch0);
                    a[0] += wA[0] * lo_bf(xv.x); a[1] += wA[1] * hi_bf(xv.x); a[2] += wA[2] * lo_bf(xv.y); a[3] += wA[3] * hi_bf(xv.y);
                    a[4] += wB[0] * lo_bf(xv.z); a[5] += wB[1] * hi_bf(xv.z); a[6] += wB[2] * lo_bf(xv.w); a[7] += wB[3] * hi_bf(xv.w); } }
            *(LAS u32x4*)(lds + LR_U + row * LR_UP + cc * 16) = pack8u(a); }
        __syncthreads();
        bf16x8 af[8];
        {   LAS unsigned char* ua = lds + LR_U + (rb * 32 + r32) * LR_UP + hi * 16;
#pragma unroll
            for (int s = 0; s < 8; ++s) af[s] = *(const LAS bf16x8*)(ua + s * 32); }
        for (int d = 0; d < 2; ++d) {
            f32x16 aR[2], aI[2];
#pragma unroll
            for (int q = 0; q < 2; ++q)
#pragma unroll
                for (int r = 0; r < 16; ++r) { aR[q][r] = 0.f; aI[q][r] = 0.f; }
            {   const bf16_t* wb = WTL + ((size_t)d * 2048 + n * 256 + cgp * 64 + r32) * 256 + (n & 1) * 128 + hi * 8;
#pragma unroll
                for (int s = 0; s < 8; ++s) {
                    const bf16x8 b0 = *(const bf16x8*)(wb + s * 16), b1 = *(const bf16x8*)(wb + 32 * 256 + s * 16), b2 = *(const bf16x8*)(wb + 128 * 256 + s * 16), b3 = *(const bf16x8*)(wb + 160 * 256 + s * 16);
                    aR[0] = __builtin_amdgcn_mfma_f32_32x32x16_bf16(af[s], b0, aR[0], 0, 0, 0); aR[1] = __builtin_amdgcn_mfma_f32_32x32x16_bf16(af[s], b1, aR[1], 0, 0, 0);
                    aI[0] = __builtin_amdgcn_mfma_f32_32x32x16_bf16(af[s], b2, aI[0], 0, 0, 0); aI[1] = __builtin_amdgcn_mfma_f32_32x32x16_bf16(af[s], b3, aI[1], 0, 0, 0);
                    if ((s & 3) == 3) asm volatile("" ::: "memory"); } }
#pragma unroll
            for (int q = 0; q < 2; ++q) { const int chl = cgp * 64 + q * 32 + r32, ch = n * 128 + chl;
                const float bav = INP(11)[(l * 2 + d) * 1024 + ch], bxv = INP(13)[(l * 2 + d) * 1024 + ch], spv = C.ctl[CT_SP + (l * 2 + d) * 1024 + ch] * (-8.f);
#pragma unroll
                for (int g = 0; g < 4; ++g) { f16_t lav[4], bcv[4];
#pragma unroll
                    for (int e = 0; e < 4; ++e) { const int r = 4 * g + e, t = rb * 32 + crow(r, hi);
                        const float uu = bf2f(*(const LAS bf16_t*)(lds + LR_U + t * LR_UP + chl * 2));
                        const float rg = sigmoidf_(aR[q][r] + bav), ig = sigmoidf_(aI[q][r] + bxv);
                        const float loga = rg * spv, y2 = 2.f * loga;
                        const float om = -y2 * (1.f + y2 * 0.5f * (1.f + y2 * (1.f / 3.f) * (1.f + y2 * 0.25f * (1.f + y2 * 0.2f))));
                        const float bb = SQRT(fmaxf(om, 0.f)) * (ig * uu);
                        lav[e] = (f16_t)(loga * LOG2E); bcv[e] = (f16_t)bb; }
                    typedef f16_t f16x4 __attribute__((ext_vector_type(4)));
                    const int tb = rb * 32 + 8 * g + 4 * hi;
                    *(LAS f16x4*)(lds + LR_LA + chl * LR_CP + tb * 2) = (f16x4){lav[0], lav[1], lav[2], lav[3]};
                    *(LAS f16x4*)(lds + LR_BC + chl * LR_CP + tb * 2) = (f16x4){bcv[0], bcv[1], bcv[2], bcv[3]}; } }
            __syncthreads();
            const int chl = tid & 127, sub = tid >> 7;
            const int tlo = d ? (96 - sub * 32) : (sub * 32);
            f16x8 lv[4], bv[4];
#pragma unroll
            for (int k = 0; k < 4; ++k) { lv[k] = *(const LAS f16x8*)(lds + LR_LA + chl * LR_CP + tlo * 2 + k * 16); bv[k] = *(const LAS f16x8*)(lds + LR_BC + chl * LR_CP + tlo * 2 + k * 16); }
            float av[32], hv[32];
            float A = 1.f, H = 0.f;
#define LR_P1(DD) do { _Pragma("unroll") for (int i = 0; i < 32; ++i) { constexpr int dd_ = DD; const int j = dd_ ? (31 - i) : i; \
                av[j] = EX2((float)lv[j >> 3][j & 7]); H = av[j] * H + (float)bv[j >> 3][j & 7]; A *= av[j]; } } while (0)
            if (d) LR_P1(1); else LR_P1(0);
#undef LR_P1
            *(LAS f32x2*)(lds + LR_XS + (sub * 128 + chl) * 8) = (f32x2){A, H};
            __syncthreads();
            {   A = 1.f; H = 0.f;
                for (int p = 0; p < sub; ++p) { const f32x2 v = *(const LAS f32x2*)(lds + LR_XS + (p * 128 + chl) * 8); H = v.x * H + v.y; A *= v.x; }
                f16_t* cap = (d ? CAB : CAF) + (size_t)(R0 + tlo) * 1024 + n * 128 + chl;
                bf16_t* y0p = Y0 + (size_t)(R0 + tlo) * 1024 + n * 128 + chl;
                LAS unsigned char* ys = lds + LR_Y0 + chl * LR_CP + tlo * 2;
#define LR_P2(DD) do { _Pragma("unroll") for (int i = 0; i < 32; ++i) { constexpr int dd_ = DD; const int j = dd_ ? (31 - i) : i; \
                H = av[j] * H + (float)bv[j >> 3][j & 7]; A *= av[j]; cap[(size_t)j * 1024] = (f16_t)A; hv[j] = H; } } while (0)
                if (d == 0) { LR_P2(0);
#pragma unroll
                    for (int k = 0; k < 4; ++k) { u32x4 w; w.x = pk2(hv[8 * k], hv[8 * k + 1]); w.y = pk2(hv[8 * k + 2], hv[8 * k + 3]); w.z = pk2(hv[8 * k + 4], hv[8 * k + 5]); w.w = pk2(hv[8 * k + 6], hv[8 * k + 7]); *(LAS u32x4*)(ys + k * 16) = w; }
                } else { LR_P2(1);
#pragma unroll
                    for (int k = 0; k < 4; ++k) { const u32x4 yv = *(const LAS u32x4*)(ys + k * 16); float y[8]; unpack8(yv, y);
#pragma unroll
                        for (int e = 0; e < 8; ++e) y0p[(size_t)(8 * k + e) * 1024] = (bf16_t)f2bf(y[e] + hv[8 * k + e]); }
                }
#undef LR_P2
                if (sub == 3) *(f32x2*)(SUM + ((size_t)((d * NB + b) * 34 + sg) * 1024 + n * 128 + chl) * 2) = (f32x2){A, H}; }
            __syncthreads();
        }
    }
}
__device__ __forceinline__ void phase_lru_carry(Ctx& C, const float* SUM, float* HIN) {
    const int gt = C.bid * NTHR + C.tid, ngt = C.G * NTHR;
    for (int it = gt; it < 2 * NB * 1024; it += ngt) { const int ch = it & 1023, b = (it >> 10) & 3, d = it >> 12;
        const float* sp = SUM + ((size_t)((d * NB + b) * 34) * 1024 + ch) * 2; float* hp = HIN + (size_t)((d * NB + b) * 34) * 1024 + ch;
        f32x2 v[34];
#pragma unroll
        for (int p = 0; p < 34; ++p) v[p] = *(const f32x2*)(sp + (size_t)p * 2048);
        float h = 0.f;
        if (d == 0) {
#pragma unroll
            for (int p = 0; p < 34; ++p) { hp[(size_t)p * 1024] = h; h = v[p].x * h + v[p].y; }
        } else {
#pragma unroll
            for (int p = 0; p < 34; ++p) { const int ps = (p < 2) ? (1 - p) : (35 - p); hp[(size_t)ps * 1024] = h; h = v[ps].x * h + v[ps].y; }
        }
    }
}

#ifdef PROBE_TS
#define GSYNC(g) do { { GASP unsigned char* w_ = (GASP unsigned char*)prm.ws; asm volatile("" : "+s"(w_)); xcd_barrier((unsigned*)(unsigned char*)(w_ + WS_BAR), (volatile LAS unsigned*)(ldsb + LDS_ST)); } if (blockIdx.x == 0 && threadIdx.x == 0) { unsigned long long* ts_ = (unsigned long long*)(prm.ws + 8192); const unsigned long long now_ = __builtin_amdgcn_s_memrealtime(); \
    ts_[1 + (g)] += now_ - ts_[0]; ts_[0] = now_; } } while (0)
#else
#define GSYNC(g) do { GASP unsigned char* w_ = (GASP unsigned char*)prm.ws; asm volatile("" : "+s"(w_)); xcd_barrier((unsigned*)(unsigned char*)(w_ + WS_BAR), (volatile LAS unsigned*)(ldsb + LDS_ST)); } while (0)
#endif
#define CTX Ctx C = mkctx(ldsb)
#define WSB wsp_(C.ws)
#define bYB ((bf16_t*)(WSB + AR_YB))
#define bXA ((bf16_t*)(WSB + AR_XA))
#define bMD ((bf16_t*)(WSB + AR_MD))
#define bRQKV ((bf16_t*)(WSB + AR_RQKV))
#define bKV ((bf16_t*)(WSB + AR_KV))
#define bQN ((bf16_t*)(WSB + AR_QN))
#define bQP ((bf16_t*)(WSB + AR_QP))
#define bRI ((f16_t*)(WSB + AR_RI))
#define bSUM ((float*)(WSB + AR_SUM))
#define bOB ((bf16_t*)(WSB + AR_OB))
#define bZ ((bf16_t*)(WSB + AR_Z))
#define xc1 ((float*)(WSB + WS_XC1))
template <int l> __device__ __forceinline__ void run_layer(const Params& prm, LAS unsigned char* ldsb) {
        const bool with_ctx = (l == 0); const int lat_only = with_ctx ? 0 : 1;
        { CTX; phase_wconv_early(C, l); }
        if (l == 0) GSYNC(0);
        { CTX; phase_h2(C, l, bYB); }
        GSYNC(1);
        {   CTX;
            ProbPlain P{bYB, (const bf16_t*)(WSB + W_WT1), 1024, 1024, 1024};
            pg8::StaticOrder S; S.init(68, 19, C.G, C.bid, 0);
            EpiG1 E{WSB, C.ctl + CT_ROPER};
            pg8::gemm_phase<EpiG1, ProbPlain, pg8::StaticOrder, true>(C.lds, P, S, E);
        }
        GSYNC(2);
        { CTX; phase_ret_intra(C, l, bRQKV, bYB); }
        { CTX; phase_md_post2(C, l, bMD); }
        GSYNC(4);
        { CTX; phase_ret_chain(C, l, bRQKV, bYB, bOB); }
        GSYNC(5);
        { CTX; phase_ret_ln3(C, l, bYB, bOB); }
        {   CTX; ProbPlain P{bMD, (const bf16_t*)(WSB + W_WTQ), 768, 384, 384};
            pg8::StaticOrder S; S.init(68, 6, C.G, C.bid, 0);
            typedef EpiStore3<AR_QN, 1024, AR_QP, 512, AR_QP, 512, 4, 6> Ep; Ep E{WSB};
            pg8::gemm_phase<Ep, ProbPlain, pg8::StaticOrder, true>(C.lds, P, S, E);
        }
        {   CTX; ProbPlain P{bMD + 384, (const bf16_t*)(WSB + W_WTKV), 768, 256, 256};
            pg8::StaticOrder S; S.init(68, 8, C.G, C.bid, 0);
            EpiKV E{WSB, INP(23) + l * 128, (LAS float*)(C.lds + 131072)};
            pg8::gemm_phase<EpiKV, ProbPlain, pg8::StaticOrder, true>(C.lds, P, S, E);
        }
        GSYNC(6);
        { CTX; phase_attn(C, l, with_ctx, bQN, bQP, bKV, bMD); }
        GSYNC(8);
        { CTX; phase_lru_fused(C, l, bXA, (const bf16_t*)(WSB + W_WTL), (bf16_t*)(WSB + AR_Y0), (f16_t*)(WSB + AR_CAF), (f16_t*)(WSB + AR_CAB), bSUM); }
        GSYNC(9);
        { CTX; phase_lru_carry(C, bSUM, (float*)(WSB + AR_HIN)); }
        { CTX; phase_wconv_late(C, l); }
        { CTX; phase_h2(C, l, bXA  ); }
        GSYNC(13);
        {   CTX; ProbPlain P{bXA, (const bf16_t*)(WSB + W_WTG), 1024, 1024, 1024};
            pg8::StaticOrder S; S.init(lat_only ? 64 : 68, 12, C.G, C.bid, lat_only);
            EpiGate E{WSB};
            pg8::gemm_phase<EpiGate, ProbPlain, pg8::StaticOrder, true>(C.lds, P, S, E);
        }
        GSYNC(14);
        {   CTX; ProbD P{WSB, 1024, 1024};
            pg8::ChainOrder S; S.init(C.G, C.bid, with_ctx ? 1 : 0);
            EpiD E{bZ, WSB + AR_GS + (size_t)C.bid * 131072, (bf16_t*)(WSB + AR_ZP)};
            pg8::gemm_phase<EpiD, ProbD, pg8::ChainOrder, true>(C.lds, P, S, E);
        }
        GSYNC(15);
        if (with_ctx) { { CTX; phase_zsum(C, (const bf16_t*)(WSB + AR_ZP), bZ); } GSYNC(12); }
        {   CTX; ProbPlain P{bZ, (const bf16_t*)(WSB + W_WTO), 1024, 1024, 1024};
            pg8::StaticOrder S; S.init(lat_only ? 64 : 68, 4, C.G, C.bid, lat_only);
            EpiOut E{(l == 0) ? INP(0) : (const float*)C.out, INP(2), C.out, xc1, C.ctl + CT_MOD + l * 5 * 3072};
            pg8::gemm_phase<EpiOut, ProbPlain, pg8::StaticOrder, true>(C.lds, P, S, E);
        }
        GSYNC(16);
    }

__global__ void __launch_bounds__(NTHR) fwd_kernel(Params prm) {
    extern __shared__ __attribute__((aligned(16))) unsigned char lds_raw[];
    cg::grid_group grid = cg::this_grid();
    LAS unsigned char* const ldsb = (LAS unsigned char*)lds_raw;
    if (threadIdx.x < 16) ((LAS unsigned*)(ldsb + LDS_ST))[threadIdx.x] = 0u;
    __syncthreads();
    if (threadIdx.x == 0) (void)xb_add(&((unsigned*)(prm.ws + WS_BAR))[XB_XCNT(xb_xcc_id())], 1u);
    grid.sync();


#ifdef PROBE_TS
    if (blockIdx.x == 0 && threadIdx.x == 0) { unsigned long long* ts_ = (unsigned long long*)(prm.ws + 8192); for (int i = 1; i < 32; ++i) ts_[i] = 0ull; ts_[0] = __builtin_amdgcn_s_memrealtime(); }
#endif
    { CTX; phase_prep(C); }
    run_layer<0>(prm, ldsb);
    run_layer<1>(prm, ldsb);
#ifdef PROBE_TS
    if (blockIdx.x == 0 && threadIdx.x == 0) { const unsigned long long* ts_ = (const unsigned long long*)(prm.ws + 8192); unsigned long long tot = 0ull;
        for (int g = 0; g < 17; ++g) if ((PROBE_TS >> g) & 1u) tot += ts_[1 + g];
        prm.out[0] += (float)(((tot / 100ull) + PROBE_Q / 2) / PROBE_Q * PROBE_Q); }
#endif
}

#undef xc1
#undef bZ
extern "C" void kernel_launch(void* const* d_in, const int* in_sizes, int n_in, void* d_out, int out_size, void* d_ws, size_t ws_size, hipStream_t stream) {
    static int grid = 0;
    if (grid == 0) {
        if (n_in != 29 || out_size != NB * TT * DM || ws_size < WS_END) { fprintf(stderr, "kernel_launch: unexpected shapes (n_in %d out %d ws %zu)\n", n_in, out_size, ws_size); grid = -1; return; }
        int dev = 0, cus = 0, per_cu = 0;
        hipGetDevice(&dev);
        hipDeviceGetAttribute(&cus, hipDeviceAttributeMultiprocessorCount, dev);
        if (hipFuncSetAttribute((const void*)fwd_kernel, hipFuncAttributeMaxDynamicSharedMemorySize, LDS_BYTES) != hipSuccess) { fprintf(stderr, "kernel_launch: hipFuncSetAttribute failed\n"); grid = -1; return; }
        if (hipOccupancyMaxActiveBlocksPerMultiprocessor(&per_cu, (const void*)fwd_kernel, NTHR, LDS_BYTES) != hipSuccess || per_cu < 1) { fprintf(stderr, "kernel_launch: occupancy query failed (%d)\n", per_cu); (void)hipGetLastError(); per_cu = 1; }
        grid = cus;
        fprintf(stderr, "kernel_launch: cus %d per_cu %d grid %d\n", cus, per_cu, grid);
    }
    if (grid < 0) return;
    if (hipMemsetAsync((char*)d_ws + WS_BAR, 0, XCD_BAR_WORDS * 4, stream) != hipSuccess) { fprintf(stderr, "kernel_launch: memset failed\n"); return; }
    Params p{};
    for (int i = 0; i < 29; ++i) p.in[i] = (const float*)d_in[i];
    p.out = (float*)d_out; p.ws = (unsigned char*)d_ws;
    void* args[] = {&p};
    hipError_t e = hipLaunchCooperativeKernel((const void*)fwd_kernel, dim3(grid), dim3(NTHR), args, LDS_BYTES, stream);
    if (e != hipSuccess) fprintf(stderr, "cooperative launch failed: %s (grid %d)\n", hipGetErrorString(e), grid);
}
```

```cpp
#include <hip/hip_runtime.h>
#include <hip/hip_cooperative_groups.h>
#include <cstdio>
#include <cstdint>
namespace cg = cooperative_groups;

#define LAS __attribute__((address_space(3)))
typedef unsigned short bf16_t;
typedef short bf16x8 __attribute__((ext_vector_type(8)));
typedef float f32x4 __attribute__((ext_vector_type(4)));
typedef float f32x2 __attribute__((ext_vector_type(2)));
typedef unsigned u32x4 __attribute__((ext_vector_type(4)));
typedef unsigned u32x2 __attribute__((ext_vector_type(2)));
typedef _Float16 f16_t;

namespace pg8 {
constexpr int BM = 256, BK = 64, HALF = 128, HTB = HALF * BK * 2, STAGE_BYTES = 8 * HTB, NXCD = 8, WGM = 8;
__host__ __device__ __forceinline__ int lds_byte(int r, int c) { const int st = (r >> 4) * 2 + (c >> 5), rr = r & 15, cc = c & 31, ob = rr * 64 + cc * 2; return st * 1024 + (ob ^ (((ob >> 9) & 1) << 5)); }
__host__ __device__ __forceinline__ void stage_rc(int b, int& R, int& C) { const int st = b / 1024, sb = b % 1024, swz = sb ^ (((sb >> 9) & 1) << 5); R = (st >> 1) * 16 + swz / 64; C = (st & 1) * 32 + (swz % 64) / 2; }
__host__ __device__ __forceinline__ int perm32(int rho) { const int n = rho >> 4, i = rho & 15; return 8 * (i >> 2) + 4 * n + (i & 3); }

struct Unit { int pm, pn, z; };

struct StaticOrder {
    int nM, nN, nwg, G, c, latent_only;
    __device__ void init(int nM_, int nN_, int G_, int c_, int latent_only_) { nM = nM_; nN = nN_; nwg = nM * nN; G = G_; c = c_; latent_only = latent_only_; }
    __device__ bool next(int i, Unit& u) const {
        const long L = (long)i * G + c; if (L >= nwg) return false;
        int wgid = (int)L; { const int q = nwg / NXCD, r = nwg % NXCD, xcd = wgid % NXCD, off = wgid / NXCD; wgid = (xcd < r ? xcd * (q + 1) : r * (q + 1) + (xcd - r) * q) + off; }
        const int nig = WGM * nN, gid = wgid / nig, fm = gid * WGM, gsz = (nM - fm) < WGM ? (nM - fm) : WGM;
        int pm = fm + ((wgid % nig) % gsz); u.pn = (wgid % nig) / gsz; u.z = 0;
        if (latent_only) pm = (pm >> 4) * 17 + 1 + (pm & 15);
        u.pm = pm; return true;
    }
};
struct ChainOrder {
    int G, c, with_ctx;
    __device__ void init(int G_, int c_, int with_ctx_) { G = G_; c = c_; with_ctx = with_ctx_; }
    __device__ bool next(int i, Unit& u) const {
        if (i < 6) { const int T = c; if (T >= 256) return false; int pm = T >> 2; u.pn = T & 3; u.z = i; u.pm = (pm >> 4) * 17 + 1 + (pm & 15); return true; }
        if (i < 8 && with_ctx && c < 48) { const int ct = c / 3, br = c - ct * 3; u.pm = (ct >> 2) * 17; u.pn = ct & 3; u.z = 8 + 2 * br + (i - 6); return true; }
        return false;
    }
};

typedef __bf16 bf16x2_t __attribute__((ext_vector_type(2)));
__device__ __forceinline__ unsigned cvt_pk_bf16(float lo, float hi) { f32x2 v = {lo, hi}; bf16x2_t b = __builtin_convertvector(v, bf16x2_t); return __builtin_bit_cast(unsigned, b); }

template <class Epi, class Prob, class Sched, bool ALIGN_EPI>
__device__ __forceinline__ void gemm_phase(LAS unsigned char* lds, const Prob& P, const Sched& S, const Epi& E) {
    int tid_ = threadIdx.x; asm volatile("" : "+v"(tid_));
    const int tid = tid_, wid = __builtin_amdgcn_readfirstlane(tid >> 6), lane = tid & 63, wr = wid >> 2, wc = wid & 3, fr = lane & 15, fq = lane >> 4;
    const int K = P.K, nt = K / BK;
    int RA[2], CA[2]; unsigned voffB[2];
#pragma unroll
    for (int i = 0; i < 2; ++i) { int R, C; stage_rc(tid * 16 + i * 8192, R, C); const int Rb = Epi::PERM ? ((R & ~31) + perm32(R & 31)) : R;
        RA[i] = R; CA[i] = C; voffB[i] = (unsigned)(Rb * P.ldb + C) * 2u; }
    const unsigned kstep = (unsigned)(BK * 2);
    const unsigned hstepB = (unsigned)(HALF * P.ldb * 2);
    const unsigned ldsw = (unsigned)wid * 1024u;
    const int aoff = lds_byte(wr * 64 + fr, fq * 8), boff = lds_byte(wc * 32 + fr, fq * 8);
#define PG8_SA(b, h) (((b) * 2 + (h)) * HTB)
#define PG8_SB(b, h) ((4 + (b) * 2 + (h)) * HTB)
#define PG8_STAGE(bufoff, gbase, soff, voff) do { _Pragma("unroll") for (int _i = 0; _i < 2; ++_i) \
        __builtin_amdgcn_global_load_lds((const unsigned*)((const char*)(gbase) + (unsigned)((voff)[_i] + (soff))), (LAS unsigned*)(lds + (bufoff) + ldsw + _i * 8192), 16, 0, 0); } while (0)
#define PG8_LDA(dst, b, h) do { _Pragma("unroll") for (int m = 0; m < 4; ++m) _Pragma("unroll") for (int k = 0; k < 2; ++k) dst[m][k] = *(const LAS bf16x8*)(lds + PG8_SA(b, h) + aoff + m * 2048 + k * 1024); } while (0)
#define PG8_LDB(dst, b, h) do { _Pragma("unroll") for (int n = 0; n < 2; ++n) _Pragma("unroll") for (int k = 0; k < 2; ++k) dst[n][k] = *(const LAS bf16x8*)(lds + PG8_SB(b, h) + boff + n * 2048 + k * 1024); } while (0)
#define PG8_MMA(ai, bj, At, Bt) do { __builtin_amdgcn_s_setprio(1); _Pragma("unroll") for (int m = 0; m < 4; ++m) _Pragma("unroll") for (int n = 0; n < 2; ++n) _Pragma("unroll") for (int k = 0; k < 2; ++k) \
        acc[ai][bj][m][n] = __builtin_amdgcn_mfma_f32_16x16x32_bf16(Bt[n][k], At[m][k], acc[ai][bj][m][n], 0, 0, 0); __builtin_amdgcn_s_setprio(0); } while (0)
#define PG8_WAIT_V(n) asm volatile("s_waitcnt vmcnt(" #n ")" ::: "memory")
#define PG8_WAIT_L(n) asm volatile("s_waitcnt lgkmcnt(" #n ")" ::: "memory")
#define PG8_BAR __builtin_amdgcn_s_barrier()
#define PG8_SCHED __builtin_amdgcn_sched_barrier(0)
    Unit cur, nxt; int ui = 0;
    if (!S.next(0, cur)) return;
    f32x4 acc[2][2][4][2];
#pragma unroll
    for (int a = 0; a < 2; ++a)
#pragma unroll
        for (int b = 0; b < 2; ++b)
#pragma unroll
            for (int m = 0; m < 4; ++m)
#pragma unroll
                for (int n = 0; n < 2; ++n) acc[a][b][m][n] = (f32x4){0.f, 0.f, 0.f, 0.f};
    bf16x8 At[4][2], B0[2][2], B1[2][2];
    const char* cA; const char* cB; int ldaC; P.get(cur, cA, cB, ldaC);
    unsigned voffA[2] = {(unsigned)(RA[0] * ldaC + CA[0]) * 2u, (unsigned)(RA[1] * ldaC + CA[1]) * 2u};
    unsigned hstepA = (unsigned)(HALF * ldaC * 2);
    PG8_STAGE(PG8_SB(0, 0), cB, 0u, voffB); PG8_STAGE(PG8_SB(0, 1), cB, hstepB, voffB); PG8_STAGE(PG8_SA(0, 0), cA, 0u, voffA); PG8_STAGE(PG8_SA(0, 1), cA, hstepA, voffA);
    if (wr == 1) PG8_BAR;
    PG8_WAIT_V(2); PG8_BAR;
    PG8_STAGE(PG8_SB(1, 0), cB, kstep, voffB); PG8_STAGE(PG8_SA(1, 0), cA, kstep, voffA); PG8_STAGE(PG8_SB(1, 1), cB, hstepB + kstep, voffB);
    PG8_WAIT_V(6); PG8_BAR;
    for (;;) {
        const bool has_next = S.next(ui + 1, nxt);
        const char* nA = cA; const char* nB = cB; int ldaN = ldaC;
        if (has_next) P.get(nxt, nA, nB, ldaN);
        unsigned voffAn[2] = {(unsigned)(RA[0] * ldaN + CA[0]) * 2u, (unsigned)(RA[1] * ldaN + CA[1]) * 2u};
        const unsigned hstepAn = (unsigned)(HALF * ldaN * 2);
        for (int t = 0; t < nt; t += 2) {
            const bool last = (t == nt - 2);
            const unsigned o1 = (unsigned)(t + 1) * kstep;
            const char* a2b = last ? nA : cA; const char* b2b = last ? nB : cB;
            const unsigned o2 = last ? 0u : (unsigned)(t + 2) * kstep, o3 = o2 + kstep;
            unsigned vA2[2] = {last ? voffAn[0] : voffA[0], last ? voffAn[1] : voffA[1]};
            const unsigned hA2 = last ? hstepAn : hstepA;
            PG8_LDB(B0, 0, 0); PG8_LDB(B1, 0, 1); PG8_SCHED; PG8_LDA(At, 0, 0); PG8_STAGE(PG8_SA(1, 1), cA, o1 + hstepA, voffA);
            PG8_WAIT_V(8); PG8_WAIT_L(0); PG8_BAR; PG8_MMA(0, 0, At, B0); PG8_MMA(0, 1, At, B1); PG8_BAR; PG8_SCHED;
            PG8_LDA(At, 0, 1); PG8_STAGE(PG8_SB(0, 0), b2b, o2, voffB); PG8_STAGE(PG8_SB(0, 1), b2b, o2 + hstepB, voffB); PG8_STAGE(PG8_SA(0, 0), a2b, o2, vA2);
            PG8_WAIT_V(8); PG8_WAIT_L(0); PG8_BAR; PG8_MMA(1, 0, At, B0); PG8_MMA(1, 1, At, B1); PG8_BAR; PG8_SCHED;
            PG8_LDB(B0, 1, 0); PG8_LDB(B1, 1, 1); PG8_SCHED; PG8_LDA(At, 1, 0); PG8_STAGE(PG8_SA(0, 1), a2b, o2 + hA2, vA2);
            PG8_WAIT_V(8); PG8_WAIT_L(0); PG8_BAR; PG8_MMA(0, 0, At, B0); PG8_MMA(0, 1, At, B1); PG8_BAR; PG8_SCHED;
            PG8_LDA(At, 1, 1); PG8_STAGE(PG8_SB(1, 0), b2b, o3, voffB); PG8_STAGE(PG8_SB(1, 1), b2b, o3 + hstepB, voffB); PG8_STAGE(PG8_SA(1, 0), a2b, o3, vA2);
            PG8_WAIT_V(8); PG8_WAIT_L(0); PG8_BAR; PG8_MMA(1, 0, At, B0); PG8_MMA(1, 1, At, B1); PG8_BAR; PG8_SCHED;
        }
        if constexpr (ALIGN_EPI) { if (wr == 0) PG8_BAR; }
        E(acc, cur, wr, wc, fr, fq);
        if (!has_next) break;
#pragma unroll
        for (int a = 0; a < 2; ++a)
#pragma unroll
            for (int b = 0; b < 2; ++b)
#pragma unroll
                for (int m = 0; m < 4; ++m)
#pragma unroll
                    for (int n = 0; n < 2; ++n) acc[a][b][m][n] = (f32x4){0.f, 0.f, 0.f, 0.f};
        cur = nxt; cA = nA; cB = nB; ldaC = ldaN; voffA[0] = voffAn[0]; voffA[1] = voffAn[1]; hstepA = hstepAn; ++ui;
        if constexpr (ALIGN_EPI) { if (wr == 1) PG8_BAR; }
    }
    PG8_WAIT_V(0);
    if constexpr (!ALIGN_EPI) { if (wr == 0) PG8_BAR; }
    PG8_BAR;
#undef PG8_SA
#undef PG8_SB
#undef PG8_STAGE
#undef PG8_LDA
#undef PG8_LDB
#undef PG8_MMA
#undef PG8_WAIT_V
#undef PG8_WAIT_L
#undef PG8_BAR
#undef PG8_SCHED
}
}

constexpr int NB = 4, TT = 4096, LC = 256, SS = TT + LC  , DM = 1024, MR = NB * SS  ;
constexpr int INC = 10944;
constexpr float EPS = 1e-6f;
constexpr float LOG2E = 1.4426950408889634f;
constexpr float QSCALE = 0.07216878364870322f * 1.4426950408889634f;
constexpr int NWAVES = 8, NTHR = 512;

constexpr size_t MiB = 1u << 20;
constexpr size_t WS_CTL = 0;
constexpr size_t WS_XC1 = 1 * MiB;
constexpr size_t WS_W = 5 * MiB;
constexpr size_t WS_AR = 25 * MiB;
constexpr size_t AR_YB = WS_AR + 0 * MiB;
constexpr size_t AR_XA = WS_AR + 34 * MiB;
constexpr size_t AR_MD = WS_AR + 68 * MiB;
constexpr size_t AR_RQKV = WS_AR + 94 * MiB;
constexpr size_t AR_OB = WS_AR + 196 * MiB;
constexpr size_t AR_KV = WS_AR + 112 * MiB;
constexpr size_t AR_QN = WS_AR + 180 * MiB;
constexpr size_t AR_QP = WS_AR + 214 * MiB;
constexpr size_t AR_RI = WS_AR + 102 * MiB;
constexpr size_t AR_Y0 = WS_AR + 68 * MiB;
constexpr size_t AR_CAF = WS_AR + 102 * MiB;
constexpr size_t AR_CAB = WS_AR + 136 * MiB;
constexpr size_t AR_SUM = WS_AR + 170 * MiB;
constexpr size_t AR_Z = WS_AR + 102 * MiB;
constexpr size_t AR_HIN = WS_AR + 176 * MiB;
constexpr size_t AR_ZP = WS_AR + 170 * MiB;
constexpr size_t AR_GS = WS_AR + 136 * MiB;
constexpr size_t WS_END = 256 * MiB;
constexpr size_t W_WT1 = WS_W;
constexpr size_t W_WTQ = WS_W + 10 * MiB;
constexpr size_t W_WTKV = WS_W + 12 * MiB;
constexpr size_t W_WTL = WS_W + 18 * MiB;
constexpr size_t W_WTG = WS_W;
constexpr size_t W_WTGM = WS_W + 6 * MiB;
constexpr size_t W_WTD = WS_W + 12 * MiB;
constexpr size_t W_WTO = WS_AR + 178 * MiB;
constexpr int CT_MOD = 16384;
constexpr int CT_ROPER = CT_MOD + 2 * 5 * 3072;
constexpr int CT_ROPEM = CT_ROPER + 2 * 4096;
constexpr int CT_SP = CT_ROPEM + 2 * 1024;
constexpr int CT_LG = CT_SP + 4096;
constexpr int CT_END = CT_LG + 16;
static_assert(CT_END * 4 <= (int)MiB, "CTL");

constexpr int LDS_BYTES = 147456;


#define XB_TMO      128
#define XB_XCNT(j)  (256  + 64 * (j))
#define XB_XSUB(j)  (1280 + 64 * (j))
#define XB_XGEN(j)  (2304 + 64 * (j))
#define XB_TOP      3328
#define XB_TOPGEN   3392
#define XCD_BAR_WORDS 3456
#define XB_SPIN_CAP (1u << 18)
constexpr size_t WS_BAR = 16384;
constexpr int LDS_ST = LDS_BYTES - 64;
__device__ __forceinline__ unsigned xb_ld(unsigned* p)              { return __hip_atomic_load(p, __ATOMIC_RELAXED, __HIP_MEMORY_SCOPE_AGENT); }
__device__ __forceinline__ unsigned xb_add(unsigned* p, unsigned v) { return __hip_atomic_fetch_add(p, v, __ATOMIC_RELAXED, __HIP_MEMORY_SCOPE_AGENT); }
__device__ __forceinline__ unsigned xb_xcc_id() { return (unsigned)__builtin_amdgcn_s_getreg((3 << 11) | 20) & 0xFu; }
#define XB_SPIN(cond, bar) do { unsigned _sp = 0; while (cond) { __builtin_amdgcn_s_sleep(1); \
    if ((++_sp & 255u) == 0u) { if (xb_ld(&(bar)[XB_TMO])) break; if (_sp > XB_SPIN_CAP) { atomicAdd(&(bar)[XB_TMO], 1u); break; } } } } while (0)
__device__ __forceinline__ void xcd_barrier_complete(unsigned* bar, unsigned x, unsigned& nloc, unsigned& nx) {
    const unsigned G = gridDim.x * gridDim.y * gridDim.z;
    unsigned sum, cnt, mine, sp = 0u;
    for (;;) {
        sum = 0u; cnt = 0u; mine = 0u;
#pragma unroll
        for (unsigned j = 0; j < 16; ++j) { const unsigned c = xb_ld(&bar[XB_XCNT(j)]); sum += c; cnt += (c > 0u) ? 1u : 0u; mine = (j == x) ? c : mine; }
        if (sum == G) break;
        __builtin_amdgcn_s_sleep(1);
        if ((++sp & 255u) == 0u) { if (xb_ld(&bar[XB_TMO])) break; if (sp > XB_SPIN_CAP) { atomicAdd(&bar[XB_TMO], 1u); break; } }
    }
    nloc = mine > 0u ? mine : 1u; nx = cnt > 0u ? cnt : 1u;
}
__device__ __forceinline__ void xcd_barrier(unsigned* bar, volatile LAS unsigned* st) {
    asm volatile("s_waitcnt vmcnt(0)" ::: "memory");
    __syncthreads();
    if (threadIdx.x == 0) {
        const unsigned x = xb_xcc_id();
        __builtin_amdgcn_s_waitcnt(0);
        unsigned nloc = st[0], nx = st[1];
        if (nloc == 0u) { xcd_barrier_complete(bar, x, nloc, nx); st[0] = nloc; st[1] = nx; }
        const unsigned old = xb_add(&bar[XB_XSUB(x)], 1u);
        const unsigned gen = old / nloc;
        if (old + 1u == (gen + 1u) * nloc) {
            __builtin_amdgcn_fence(__ATOMIC_RELEASE, "agent");
            asm volatile("s_waitcnt vmcnt(0)" ::: "memory");
            const unsigned og = xb_add(&bar[XB_TOP], 1u);
            const unsigned tg = og / nx;
            if (og + 1u == (tg + 1u) * nx) xb_add(&bar[XB_TOPGEN], 1u);
            else XB_SPIN(xb_ld(&bar[XB_TOPGEN]) == tg, bar);
            __builtin_amdgcn_fence(__ATOMIC_ACQUIRE, "agent");
            xb_add(&bar[XB_XGEN(x)], 1u);
            asm volatile("s_waitcnt vmcnt(0)" ::: "memory");
        } else {
            XB_SPIN(xb_ld(&bar[XB_XGEN(x)]) == gen, bar);
            __builtin_amdgcn_fence(__ATOMIC_ACQUIRE, "agent");
            asm volatile("s_waitcnt vmcnt(0)" ::: "memory");
        }
    }
    __syncthreads();
}

struct Params {
    const float* in[29];
    float* out;
    unsigned char* ws;
};

#define EX2(x) __builtin_amdgcn_exp2f(x)
#define RSQ(x) __builtin_amdgcn_rsqf(x)
#define SQRT(x) __builtin_amdgcn_sqrtf(x)
__device__ __forceinline__ float bf2f(unsigned v) { return __uint_as_float(v << 16); }
__device__ __forceinline__ unsigned f2bf(float f) { unsigned u = __float_as_uint(f); return (u + 0x7fffu + ((u >> 16) & 1u)) >> 16; }
__device__ __forceinline__ unsigned pk2(float lo, float hi) { return f2bf(lo) | (f2bf(hi) << 16); }
__device__ __forceinline__ float lo_bf(unsigned w) { return __uint_as_float(w << 16); }
__device__ __forceinline__ float hi_bf(unsigned w) { return __uint_as_float(w & 0xffff0000u); }
__device__ __forceinline__ float wave_sum(float v) {
#pragma unroll
    for (int o = 1; o < 64; o <<= 1) v += __shfl_xor(v, o);
    return v;
}
__device__ __forceinline__ float wave_max(float v) {
#pragma unroll
    for (int o = 1; o < 64; o <<= 1) v = fmaxf(v, __shfl_xor(v, o));
    return v;
}
__device__ __forceinline__ float sigmoidf_(float x) { return __builtin_amdgcn_rcpf(1.f + __expf(-x)); }
__device__ __forceinline__ float siluf_(float x) { return x * __builtin_amdgcn_rcpf(1.f + __expf(-x)); }

#define GASP __attribute__((address_space(1)))
__device__ __forceinline__ const float* inp_(int i) { asm volatile("" : "+s"(i)); const float* const* ka = (const float* const*)__builtin_amdgcn_kernarg_segment_ptr(); return (const float*)(const GASP float*)ka[i]; }
#define INP(i) inp_(i)
template <class T> __device__ __forceinline__ T* opaq_g_(T* p) { GASP T* g = (GASP T*)p; asm volatile("" : "+v"(g)); return (T*)g; }
#define OPAQ_G(p) ((p) = opaq_g_(p))
__device__ __forceinline__ unsigned char* wsp_(unsigned char* p) { GASP unsigned char* g = (GASP unsigned char*)p; asm volatile("" : "+s"(g)); return (unsigned char*)g; }
__device__ __forceinline__ void unpack8(const u32x4& w, float (&x)[8]) { x[0] = lo_bf(w.x); x[1] = hi_bf(w.x); x[2] = lo_bf(w.y); x[3] = hi_bf(w.y); x[4] = lo_bf(w.z); x[5] = hi_bf(w.z); x[6] = lo_bf(w.w); x[7] = hi_bf(w.w); }
__device__ __forceinline__ u32x4 pack8u(const float (&x)[8]) { u32x4 w; w.x = pk2(x[0], x[1]); w.y = pk2(x[2], x[3]); w.z = pk2(x[4], x[5]); w.w = pk2(x[6], x[7]); return w; }
__device__ __forceinline__ float sumsq8(const float (&x)[8]) { return ((x[0] * x[0] + x[1] * x[1]) + (x[2] * x[2] + x[3] * x[3])) + ((x[4] * x[4] + x[5] * x[5]) + (x[6] * x[6] + x[7] * x[7])); }

struct Ctx {
    float* out; unsigned char* ws; LAS unsigned char* lds; int tid, lane, wave, G, bid;
    int gw, ngw;
    int rot;
    float* ctl;
};

__device__ __forceinline__ Ctx mkctx(LAS unsigned char* lds) {
    Ctx C; int t = threadIdx.x; asm volatile("" : "+v"(t)); int b = blockIdx.x; asm volatile("" : "+s"(b)); int g = gridDim.x; asm volatile("" : "+s"(g));
    C.tid = t; C.lane = t & 63; C.wave = __builtin_amdgcn_readfirstlane(t >> 6); C.bid = b; C.G = g; C.gw = b * NWAVES + C.wave; C.ngw = g * NWAVES; C.rot = 0;
    int io = 29, iw = 30; asm volatile("" : "+s"(io)); asm volatile("" : "+s"(iw));
    unsigned char* const* ka = (unsigned char* const*)__builtin_amdgcn_kernarg_segment_ptr();
    C.out = (float*)(GASP float*)ka[io]; C.ws = (unsigned char*)(GASP unsigned char*)ka[iw]; C.ctl = (float*)(C.ws + WS_CTL); C.lds = lds;
    return C;
}
__device__ __forceinline__ const float* resid_row(const Ctx& C, int l, int m) {
    const int b = m / SS, s = m - b * SS;
    if (s < LC) { const float* base = (l == 0) ? INP(2) : (const float*)(C.ws + WS_XC1); return base + (size_t)(b * LC + s) * DM; }
    const float* base = (l == 0) ? INP(0) : C.out; return base + (size_t)(b * TT + (s - LC)) * DM;
}

__device__ __forceinline__ void phase_prep(Ctx& C) {
    LAS float* sl = (LAS float*)C.lds;
    LAS float* red = (LAS float*)(C.lds + 32768);
    for (int i = C.tid; i < 5 * 1024; i += NTHR) { const int r = i >> 10, k = i & 1023; const float v = (r < 4) ? INP(1)[r * 1024 + k] : INP(3)[k]; sl[i] = siluf_(v); }
    __syncthreads();
    for (int it = C.bid; it < 2 * 96; it += C.G) {
        const int l = it / 96, grp = it % 96, kg = C.tid >> 5, cj = C.tid & 31, col = grp * 32 + cj;
        const float* w = INP(4) + (size_t)l * 1024 * 3072 + col;
        float a0 = 0.f, a1 = 0.f, a2 = 0.f, a3 = 0.f, a4 = 0.f;
#pragma unroll 8
        for (int k = kg * 64; k < kg * 64 + 64; ++k) { const float wv = w[(size_t)k * 3072]; a0 += sl[k] * wv; a1 += sl[1024 + k] * wv; a2 += sl[2048 + k] * wv; a3 += sl[3072 + k] * wv; a4 += sl[4096 + k] * wv; }
        red[(kg * 32 + cj) * 5 + 0] = a0; red[(kg * 32 + cj) * 5 + 1] = a1; red[(kg * 32 + cj) * 5 + 2] = a2; red[(kg * 32 + cj) * 5 + 3] = a3; red[(kg * 32 + cj) * 5 + 4] = a4;
        __syncthreads();
        if (C.tid < 160) { const int c2 = C.tid / 5, r = C.tid % 5; float s = 0.f;
            for (int g = 0; g < 16; ++g) s += red[(g * 32 + c2) * 5 + r];
            C.ctl[CT_MOD + (l * 5 + r) * 3072 + grp * 32 + c2] = s + INP(5)[l * 3072 + grp * 32 + c2]; }
        __syncthreads();
    }
    const int gt = C.bid * NTHR + C.tid, ngt = C.G * NTHR;
    for (int i = gt; i < 4096; i += ngt) { const int pos = i >> 6, f = i & 63; const float inv = powf(10000.f, -(float)f / 64.f), ang = (float)pos * inv;
        C.ctl[CT_ROPER + i] = cosf(ang); C.ctl[CT_ROPER + 4096 + i] = sinf(ang); }
    for (int i = gt; i < 1024; i += ngt) { const int pos = i >> 4, f = i & 15; const float inv = powf(10000.f, -(float)f / 16.f), ang = (float)pos * inv;
        C.ctl[CT_ROPEM + i] = cosf(ang); C.ctl[CT_ROPEM + 1024 + i] = sinf(ang); }
    for (int i = gt; i < 4096; i += ngt) C.ctl[CT_SP + i] = log1pf(expf(-INP(14)[i]));
    for (int i = gt; i < 16; i += ngt) C.ctl[CT_LG + i] = -log1pf(expf(-INP(15)[i])) * LOG2E;
}

__device__ __forceinline__ void tr_item(const float* W, int ldw, int k0, int n0, bf16_t* WT, int ldt, int drow0, int dk0, LAS float* scr, int lane) {
#pragma unroll 8
    for (int i = 0; i < 32; ++i) { const int kk = 2 * i + (lane >> 5); scr[kk * 33 + (lane & 31)] = W[(size_t)(k0 + kk) * ldw + n0 + (lane & 31)]; }
    asm volatile("s_waitcnt lgkmcnt(0)" ::: "memory");
    const int c = lane & 7;
#pragma unroll
    for (int j = 0; j < 4; ++j) { const int n = (lane >> 3) + 8 * j; const LAS float* s = scr + (8 * c) * 33 + n;
        u32x4 o; o.x = pk2(s[0 * 33], s[1 * 33]); o.y = pk2(s[2 * 33], s[3 * 33]); o.z = pk2(s[4 * 33], s[5 * 33]); o.w = pk2(s[6 * 33], s[7 * 33]);
        *(u32x4*)(WT + (size_t)(drow0 + n) * ldt + dk0 + 8 * c) = o; }
    asm volatile("s_waitcnt lgkmcnt(0)" ::: "memory");
}
__device__ __forceinline__ void conv_rows(Ctx& C, const float* W, int ldw, int K, int scol0, bf16_t* WT, int ldt, int drow0, int dk0, int nrows, LAS float* scr) {
    const int nkb = K / 64, items = nkb * (nrows / 32);
    int g0 = C.gw - C.rot; if (g0 < 0) g0 += C.ngw; C.rot = (C.rot + items) % C.ngw;
    for (int it = g0; it < items; it += C.ngw) { const int nb = it / nkb, kb = it - nb * nkb;
        tr_item(W, ldw, kb * 64, scol0 + nb * 32, WT, ldt, drow0 + nb * 32, dk0 + kb * 64, scr, C.lane); }
}
__device__ __forceinline__ int ropeperm(int j) { const int h = j >> 8, jj = j & 255, half = jj >> 7, g = (jj & 127) >> 3, r8 = jj & 7; return h * 256 + (half * 2 + (r8 >> 2)) * 64 + g * 4 + (r8 & 3); }
__device__ __forceinline__ void tr_item_rope(const float* W, int ldw, int k0, int scol0, int jbase, bf16_t* WT, int ldt, int drow0, int dk0, LAS float* scr, int lane) {
    const int sc = scol0 + ropeperm(jbase + (lane & 31));
#pragma unroll 8
    for (int i = 0; i < 32; ++i) { const int kk = 2 * i + (lane >> 5); scr[kk * 33 + (lane & 31)] = W[(size_t)(k0 + kk) * ldw + sc]; }
    asm volatile("s_waitcnt lgkmcnt(0)" ::: "memory");
    const int c = lane & 7;
#pragma unroll
    for (int j = 0; j < 4; ++j) { const int n = (lane >> 3) + 8 * j; const LAS float* s = scr + (8 * c) * 33 + n;
        u32x4 o; o.x = pk2(s[0 * 33], s[1 * 33]); o.y = pk2(s[2 * 33], s[3 * 33]); o.z = pk2(s[4 * 33], s[5 * 33]); o.w = pk2(s[6 * 33], s[7 * 33]);
        *(u32x4*)(WT + (size_t)(drow0 + n) * ldt + dk0 + 8 * c) = o; }
    asm volatile("s_waitcnt lgkmcnt(0)" ::: "memory");
}
__device__ __forceinline__ void conv_rows_rope(Ctx& C, const float* W, int ldw, int K, int scol0, bf16_t* WT, int ldt, int drow0, int nrows, LAS float* scr) {
    const int nkb = K / 64, items = nkb * (nrows / 32);
    int g0 = C.gw - C.rot; if (g0 < 0) g0 += C.ngw; C.rot = (C.rot + items) % C.ngw;
    for (int it = g0; it < items; it += C.ngw) { const int nb = it / nkb, kb = it - nb * nkb;
        tr_item_rope(W, ldw, kb * 64, scol0, nb * 32, WT, ldt, drow0 + nb * 32, kb * 64, scr, C.lane); }
}
__device__ __forceinline__ void zero_rows(Ctx& C, bf16_t* WT, int ldt, int drow0, int dk0, int nrows, int ncols) {
    const int per = ncols / 8, items = nrows * per;
    int g0 = C.gw - C.rot; if (g0 < 0) g0 += C.ngw; C.rot = (C.rot + (items + 63) / 64) % C.ngw;
    for (int it = g0 * 64 + C.lane; it < items; it += C.ngw * 64) { const int r = it / per, c = it - r * per; *(u32x4*)(WT + (size_t)(drow0 + r) * ldt + dk0 + c * 8) = (u32x4){0u, 0u, 0u, 0u}; }
}
__device__ __forceinline__ void phase_wconv_early(Ctx& C, int l) {
    LAS float* scr = (LAS float*)(C.lds + C.wave * 16384);
    unsigned char* ws = C.ws;
    const float* win = INP(7) + (size_t)l * 1024 * INC;
    bf16_t* WT1 = (bf16_t*)(ws + W_WT1);
    conv_rows(C, win, INC, 1024, 0, WT1, 1024, 0, 0, 1024, scr);
    conv_rows_rope(C, win, INC, 1024, 2048, WT1, 1024, 1024, 1024, scr);
    conv_rows_rope(C, win, INC, 1024, 3072, WT1, 1024, 2048, 1024, scr);
    conv_rows(C, win, INC, 1024, 4096, WT1, 1024, 3072, 0, 1024, scr);
    conv_rows(C, win, INC, 1024, 6144, WT1, 1024, 4096, 0, 704, scr);
    zero_rows(C, WT1, 1024, 4800, 0, 64, 1024);
    const float* wq = INP(18) + (size_t)l * 384 * 1536; bf16_t* WTQ = (bf16_t*)(ws + W_WTQ);
    for (int h = 0; h < 8; ++h) { conv_rows(C, wq, 1536, 384, h * 192, WTQ, 384, h * 128, 0, 128, scr); conv_rows(C, wq, 1536, 384, h * 192 + 128, WTQ, 384, 1024 + h * 64, 0, 64, scr); }
    const float* wkv = INP(20) + (size_t)l * 256 * 2048; bf16_t* WTKV = (bf16_t*)(ws + W_WTKV);
    for (int h = 0; h < 8; ++h) { conv_rows(C, wkv, 2048, 256, h * 256, WTKV, 256, h * 128, 0, 128, scr); conv_rows(C, wkv, 2048, 256, h * 256 + 128, WTKV, 256, 1024 + h * 128, 0, 128, scr); }
    bf16_t* WTL = (bf16_t*)(ws + W_WTL);
    for (int d = 0; d < 2; ++d) for (int n = 0; n < 8; ++n) for (int mat = 0; mat < 2; ++mat) {
        const float* w = INP(mat == 0 ? 10 : 12) + ((size_t)(l * 2 + d) * 8 + n) * 128 * 128;
        const int drow0 = d * 2048 + n * 256 + mat * 128;
        conv_rows(C, w, 128, 128, 0, WTL, 256, drow0, (n & 1) * 128, 128, scr);
        zero_rows(C, WTL, 256, drow0, ((n & 1) ^ 1) * 128, 128, 128);
    }
}
__device__ __forceinline__ void phase_wconv_late(Ctx& C, int l) {
    LAS float* scr = (LAS float*)(C.lds + C.wave * 16384);
    unsigned char* ws = C.ws;
    const float* win = INP(7) + (size_t)l * 1024 * INC;
    bf16_t* WTG = (bf16_t*)(ws + W_WTG);
    conv_rows(C, win, INC, 1024, 1024, WTG, 1024, 0, 0, 1024, scr);
    conv_rows(C, win, INC, 1024, 5120, WTG, 1024, 1024, 0, 1024, scr);
    conv_rows(C, win, INC, 1024, 6848, WTG, 1024, 2048, 0, 1024, scr);
    conv_rows(C, win, INC, 1024, 7872, (bf16_t*)(ws + W_WTGM), 1024, 0, 0, 3072, scr);
    for (int i = 0; i < 3; ++i) conv_rows(C, INP(25 + i) + (size_t)l * 1024 * 1024, 1024, 1024, 0, (bf16_t*)(ws + W_WTD) + (size_t)i * 1024 * 1024, 1024, 0, 0, 1024, scr);
    conv_rows(C, INP(28) + (size_t)l * 1024 * 1024, 1024, 1024, 0, (bf16_t*)(ws + W_WTO), 1024, 0, 0, 1024, scr);
}

__device__ __forceinline__ void phase_h(Ctx& C, int l, bf16_t* H) {
    const float* gain = INP(6) + l * 1024;
    for (int m = C.gw; m < MR; m += C.ngw) {
        const int b = m / SS, s = m - b * SS, r = (s < LC) ? 4 : b;
        const float* xr = resid_row(C, l, m);
        const float* mod = C.ctl + CT_MOD + (l * 5 + r) * 3072;
        f32x4 v[4]; float ss = 0.f;
#pragma unroll
        for (int j = 0; j < 4; ++j) { v[j] = *(const f32x4*)(xr + 4 * C.lane + 256 * j); ss += (v[j].x * v[j].x + v[j].y * v[j].y) + (v[j].z * v[j].z + v[j].w * v[j].w); }
        const float rstd = RSQ(wave_sum(ss) * (1.f / 1024.f) + EPS);
#pragma unroll
        for (int j = 0; j < 4; ++j) { const int c = 4 * C.lane + 256 * j;
            const f32x4 g = *(const f32x4*)(gain + c), sh = *(const f32x4*)(mod + c), sc = *(const f32x4*)(mod + 1024 + c);
            const f32x4 y = (v[j] * rstd) * g;
            const f32x4 o = y * (sc + 1.0f) + sh;
            u32x2 w; w.x = pk2(o.x, o.y); w.y = pk2(o.z, o.w);
            *(u32x2*)(H + (size_t)m * 1024 + c) = w; }
    }
}

using pg8::Unit;
struct ProbPlain {
    const bf16_t* A; const bf16_t* Bt; int lda, ldb, K;
    __device__ __forceinline__ void get(const Unit& u, const char*& a, const char*& b, int& lda_) const {
        a = (const char*)(A + (size_t)u.pm * 256 * lda); b = (const char*)(Bt + (size_t)u.pn * 256 * ldb); lda_ = lda; }
};
struct ProbLru {
    const bf16_t* A; const bf16_t* Bt; int ldb, K;
    __device__ __forceinline__ void get(const Unit& u, const char*& a, const char*& b, int& lda_) const {
        a = (const char*)(A + (size_t)u.pm * 256 * 1024 + (u.pn >> 1) * 256); b = (const char*)(Bt + (size_t)u.pn * 256 * 256); lda_ = 1024; }
};
struct ProbD {
    unsigned char* ws; int ldb, K;
    __device__ __forceinline__ void get(const Unit& u, const char*& a, const char*& b, int& lda_) const {
        const int i = (u.z & 7) >> 1;
        if ((u.z & 1) == 0) { a = (const char*)(ws + AR_XA + (size_t)u.pm * 256 * 1024 * 2); b = (const char*)(ws + W_WTGM + ((size_t)i * 1024 + u.pn * 256) * 1024 * 2); lda_ = 1024; }
        else { const size_t yo = (i == 0) ? AR_Y0 : (i == 1) ? AR_YB : AR_QN;
            a = (const char*)(ws + yo + (size_t)u.pm * 256 * 1024 * 2); b = (const char*)(ws + W_WTD + ((size_t)i * 1024 + u.pn * 256) * 1024 * 2); lda_ = 1024; }
    }
};

#define EPI_ARGS const f32x4 (&acc)[2][2][4][2], const Unit& u, int wr, int wc, int fr, int fq
template <size_t O0, int L0, size_t O1, int L1, size_t O2, int L2, int T1, int T2>
struct EpiStore3 {
    static constexpr bool PERM = true;
    unsigned char* ws;
    __device__ __forceinline__ void operator()(EPI_ARGS) const {
        bf16_t* bs; int ldc, ct;
        size_t off;
        if (u.pn < T1) { off = O0; ldc = L0; ct = u.pn; } else if (u.pn < T2) { off = O1; ldc = L1; ct = u.pn - T1; } else { off = O2; ldc = L2; ct = u.pn - T2; }
        bs = (bf16_t*)(ws + off);
        const int row0 = u.pm * 256 + wr * 64 + fr, col0 = ct * 256 + wc * 32 + 8 * fq;
#pragma unroll
        for (int ai = 0; ai < 2; ++ai)
#pragma unroll
            for (int m = 0; m < 4; ++m) { bf16_t* rowp = bs + (size_t)(row0 + ai * 128 + m * 16) * ldc + col0;
#pragma unroll
                for (int bj = 0; bj < 2; ++bj) { const f32x4 v0 = acc[ai][bj][m][0], v1 = acc[ai][bj][m][1];
                    u32x4 w; w.x = pg8::cvt_pk_bf16(v0[0], v0[1]); w.y = pg8::cvt_pk_bf16(v0[2], v0[3]); w.z = pg8::cvt_pk_bf16(v1[0], v1[1]); w.w = pg8::cvt_pk_bf16(v1[2], v1[3]);
                    *(u32x4*)(rowp + bj * 128) = w; } }
    }
};
struct EpiKV {
    static constexpr bool PERM = true;
    unsigned char* ws; const float* gkn; LAS float* red;
    __device__ __forceinline__ void operator()(EPI_ARGS) const {
        bf16_t* bs = (bf16_t*)(ws + AR_KV);
        const int row0 = u.pm * 256 + wr * 64 + fr, col0 = u.pn * 256 + wc * 32 + 8 * fq;
        const bool knope = u.pn < 4;
        float g[8];
#pragma unroll
        for (int e = 0; e < 8; ++e) g[e] = 1.f;
        if (knope) {
#pragma unroll
            for (int ai = 0; ai < 2; ++ai)
#pragma unroll
                for (int m = 0; m < 4; ++m)
#pragma unroll
                    for (int bj = 0; bj < 2; ++bj) { const f32x4 v0 = acc[ai][bj][m][0], v1 = acc[ai][bj][m][1];
                        float ss = ((v0[0] * v0[0] + v0[1] * v0[1]) + (v0[2] * v0[2] + v0[3] * v0[3])) + ((v1[0] * v1[0] + v1[1] * v1[1]) + (v1[2] * v1[2] + v1[3] * v1[3]));
                        ss += __shfl_xor(ss, 16); ss += __shfl_xor(ss, 32);
                        if (fq == 0) red[((ai * 128 + wr * 64 + m * 16 + fr) * 2 + bj) * 4 + wc] = ss; }
            asm volatile("s_waitcnt lgkmcnt(0)" ::: "memory"); __builtin_amdgcn_s_barrier(); asm volatile("" ::: "memory");
            const f32x4 ga = *(const f32x4*)(gkn + wc * 32 + 8 * fq), gb = *(const f32x4*)(gkn + wc * 32 + 8 * fq + 4);
            g[0] = ga[0]; g[1] = ga[1]; g[2] = ga[2]; g[3] = ga[3]; g[4] = gb[0]; g[5] = gb[1]; g[6] = gb[2]; g[7] = gb[3];
        }
#pragma unroll
        for (int ai = 0; ai < 2; ++ai)
#pragma unroll
            for (int m = 0; m < 4; ++m) { bf16_t* rowp = bs + (size_t)(row0 + ai * 128 + m * 16) * 2048 + col0;
#pragma unroll
                for (int bj = 0; bj < 2; ++bj) { f32x4 v0 = acc[ai][bj][m][0], v1 = acc[ai][bj][m][1];
                    float rs = 1.f;
                    if (knope) { const f32x4 t = *(const LAS f32x4*)(red + ((ai * 128 + wr * 64 + m * 16 + fr) * 2 + bj) * 4); rs = RSQ(((t[0] + t[1]) + (t[2] + t[3])) * (1.f / 128.f) + EPS); }
                    u32x4 w; w.x = pg8::cvt_pk_bf16(v0[0] * rs * g[0], v0[1] * rs * g[1]); w.y = pg8::cvt_pk_bf16(v0[2] * rs * g[2], v0[3] * rs * g[3]);
                    w.z = pg8::cvt_pk_bf16(v1[0] * rs * g[4], v1[1] * rs * g[5]); w.w = pg8::cvt_pk_bf16(v1[2] * rs * g[6], v1[3] * rs * g[7]);
                    *(u32x4*)(rowp + bj * 128) = w; }
                asm volatile("" ::: "memory"); }
    }
};
struct EpiG1 {
    static constexpr bool PERM = true;
    unsigned char* ws; const float* cs;
    __device__ __forceinline__ void operator()(EPI_ARGS) const {
        bf16_t* bs; int ldc, ct;
        if (u.pn < 4) { bs = (bf16_t*)(ws + AR_XA); ldc = 1024; ct = u.pn; } else if (u.pn < 16) { bs = (bf16_t*)(ws + AR_RQKV); ldc = 3072; ct = u.pn - 4; } else { bs = (bf16_t*)(ws + AR_MD); ldc = 768; ct = u.pn - 16; }
        const int row0 = u.pm * 256 + wr * 64 + fr, col0 = ct * 256 + wc * 32 + 8 * fq;
        const bool rope = (u.pn >= 4) && (u.pn < 12), iskey = (u.pn >= 8);
        const int bq = u.pm / 17, s0 = (u.pm - bq * 17) * 256 + wr * 64 + fr;
        const int f0 = (wc * 4 + fq) * 4;
#pragma unroll
        for (int ai = 0; ai < 2; ++ai)
#pragma unroll
            for (int m = 0; m < 4; ++m) { bf16_t* rowp = bs + (size_t)(row0 + ai * 128 + m * 16) * ldc + col0;
                const int s = s0 + ai * 128 + m * 16, t = s - LC; const bool lat = s >= LC;
#pragma unroll
                for (int bj = 0; bj < 2; ++bj) { f32x4 v0 = acc[ai][bj][m][0], v1 = acc[ai][bj][m][1];
                    if (rope) {
                        if (lat) { const int pos = bj ? (t & 63) : (t >> 6); const f32x4 c = *(const f32x4*)(cs + pos * 64 + f0), sn = *(const f32x4*)(cs + 4096 + pos * 64 + f0);
                            const f32x4 a = v0 * c - v1 * sn, b = v1 * c + v0 * sn; v0 = a; v1 = b; }
                        if (iskey) { v0 = v0 * 0.0625f; v1 = v1 * 0.0625f; } }
                    u32x4 w; w.x = pg8::cvt_pk_bf16(v0[0], v0[1]); w.y = pg8::cvt_pk_bf16(v0[2], v0[3]); w.z = pg8::cvt_pk_bf16(v1[0], v1[1]); w.w = pg8::cvt_pk_bf16(v1[2], v1[3]);
                    *(u32x4*)(rowp + bj * 128) = w; }
                asm volatile("" ::: "memory"); }
    }
};
typedef f16_t f16x8 __attribute__((ext_vector_type(8)));
struct EpiLru {
    static constexpr bool PERM = true;
    const bf16_t* U; f16_t* RI; const float* ba; const float* bx; const float* sp;
    __device__ __forceinline__ void operator()(EPI_ARGS) const {
        const int row0 = u.pm * 256 + wr * 64 + fr, ch0 = u.pn * 128 + wc * 32 + 8 * fq;
        float bav[8], bxv[8], spv[8];
#pragma unroll
        for (int e = 0; e < 8; ++e) { bav[e] = ba[ch0 + e]; bxv[e] = bx[ch0 + e]; spv[e] = sp[ch0 + e] * (-8.f); }
#pragma unroll
        for (int ai = 0; ai < 2; ++ai)
#pragma unroll
            for (int m = 0; m < 4; ++m) { const int row = row0 + ai * 128 + m * 16;
                const u32x4 uw = *(const u32x4*)(U + (size_t)row * 1024 + ch0);
                float uv[8] = {lo_bf(uw.x), hi_bf(uw.x), lo_bf(uw.y), hi_bf(uw.y), lo_bf(uw.z), hi_bf(uw.z), lo_bf(uw.w), hi_bf(uw.w)};
                f16x8 la, bc;
#pragma unroll
                for (int e = 0; e < 8; ++e) { const float rp = acc[ai][0][m][e >> 2][e & 3] + bav[e], ip = acc[ai][1][m][e >> 2][e & 3] + bxv[e];
                    const float r = sigmoidf_(rp), ig = sigmoidf_(ip);
                    const float loga = r * spv[e];
                    const float bb = SQRT(fmaxf(-expm1f(2.f * loga), 0.f)) * (ig * uv[e]);
                    la[e] = (f16_t)(loga * LOG2E); bc[e] = (f16_t)bb; }
                *(f16x8*)(RI + (size_t)row * 2048 + ch0) = la; *(f16x8*)(RI + (size_t)row * 2048 + 1024 + ch0) = bc;
                asm volatile("" ::: "memory"); }
    }
};
struct EpiGate {
    static constexpr bool PERM = true;
    unsigned char* ws;
    __device__ __forceinline__ void operator()(EPI_ARGS) const {
        const int br = u.pn >> 2; const size_t yo = (br == 0) ? AR_Y0 : (br == 1) ? AR_YB : AR_QN; bf16_t* bs = (bf16_t*)(ws + yo);
        const int row0 = u.pm * 256 + wr * 64 + fr, col0 = (u.pn & 3) * 256 + wc * 32 + 8 * fq;
        if (br == 0) {
            const int b = u.pm / 17, sg0 = (u.pm - b * 17) * 2;
#pragma unroll
            for (int ai = 0; ai < 2; ++ai) {
                const float* hfp = (const float*)(ws + AR_HIN) + ((size_t)(0 * NB + b) * 34 + sg0 + ai) * 1024 + col0;
                const float* hbp = (const float*)(ws + AR_HIN) + ((size_t)(1 * NB + b) * 34 + sg0 + ai) * 1024 + col0;
#pragma unroll
                for (int bj = 0; bj < 2; ++bj) {
                    const f32x4 hf0 = *(const f32x4*)(hfp + bj * 128), hf1 = *(const f32x4*)(hfp + bj * 128 + 4), hb0 = *(const f32x4*)(hbp + bj * 128), hb1 = *(const f32x4*)(hbp + bj * 128 + 4);
#pragma unroll
                    for (int m = 0; m < 4; ++m) { const size_t ro = (size_t)(row0 + ai * 128 + m * 16) * 1024 + col0 + bj * 128;
                        const f32x4 v0 = acc[ai][bj][m][0], v1 = acc[ai][bj][m][1];
                        const u32x4 y = *(const u32x4*)(bs + ro);
                        const f16x8 cf = *(const f16x8*)((const f16_t*)(ws + AR_CAF) + ro), cb = *(const f16x8*)((const f16_t*)(ws + AR_CAB) + ro);
                        float yy[8]; unpack8(y, yy);
                        yy[0] += (float)cf[0] * hf0[0] + (float)cb[0] * hb0[0]; yy[1] += (float)cf[1] * hf0[1] + (float)cb[1] * hb0[1]; yy[2] += (float)cf[2] * hf0[2] + (float)cb[2] * hb0[2]; yy[3] += (float)cf[3] * hf0[3] + (float)cb[3] * hb0[3];
                        yy[4] += (float)cf[4] * hf1[0] + (float)cb[4] * hb1[0]; yy[5] += (float)cf[5] * hf1[1] + (float)cb[5] * hb1[1]; yy[6] += (float)cf[6] * hf1[2] + (float)cb[6] * hb1[2]; yy[7] += (float)cf[7] * hf1[3] + (float)cb[7] * hb1[3];
                        u32x4 w; w.x = pg8::cvt_pk_bf16(yy[0] * siluf_(v0[0]), yy[1] * siluf_(v0[1])); w.y = pg8::cvt_pk_bf16(yy[2] * siluf_(v0[2]), yy[3] * siluf_(v0[3]));
                        w.z = pg8::cvt_pk_bf16(yy[4] * siluf_(v1[0]), yy[5] * siluf_(v1[1])); w.w = pg8::cvt_pk_bf16(yy[6] * siluf_(v1[2]), yy[7] * siluf_(v1[3]));
                        *(u32x4*)(bs + ro) = w;
                        asm volatile("" ::: "memory"); } } }
            return;
        }
#pragma unroll
        for (int ai = 0; ai < 2; ++ai)
#pragma unroll
            for (int mh = 0; mh < 2; ++mh) {
                u32x4 yq[2][2];
#pragma unroll
                for (int mm = 0; mm < 2; ++mm)
#pragma unroll
                    for (int bj = 0; bj < 2; ++bj) yq[mm][bj] = *(const u32x4*)(bs + (size_t)(row0 + ai * 128 + (2 * mh + mm) * 16) * 1024 + col0 + bj * 128);
#pragma unroll
                for (int mm = 0; mm < 2; ++mm) { const int m = 2 * mh + mm; bf16_t* rowp = bs + (size_t)(row0 + ai * 128 + m * 16) * 1024 + col0;
#pragma unroll
                    for (int bj = 0; bj < 2; ++bj) { const f32x4 v0 = acc[ai][bj][m][0], v1 = acc[ai][bj][m][1];
                        const u32x4 y = yq[mm][bj];
                        u32x4 w; w.x = pg8::cvt_pk_bf16(lo_bf(y.x) * siluf_(v0[0]), hi_bf(y.x) * siluf_(v0[1])); w.y = pg8::cvt_pk_bf16(lo_bf(y.y) * siluf_(v0[2]), hi_bf(y.y) * siluf_(v0[3]));
                        w.z = pg8::cvt_pk_bf16(lo_bf(y.z) * siluf_(v1[0]), hi_bf(y.z) * siluf_(v1[1])); w.w = pg8::cvt_pk_bf16(lo_bf(y.w) * siluf_(v1[2]), hi_bf(y.w) * siluf_(v1[3]));
                        *(u32x4*)(rowp + bj * 128) = w; } }
                asm volatile("" ::: "memory"); }
    }
};
struct EpiD {
    static constexpr bool PERM = true;
    bf16_t* Z; unsigned char* gs; bf16_t* ZP;
    __device__ __forceinline__ void operator()(EPI_ARGS) const {
        const int col0 = u.pn * 256 + wc * 32 + 8 * fq, i = (u.z & 7) >> 1; const bool part = u.z >= 8;
        const int row0 = part ? ((u.pm / 17) * 256 + wr * 64 + fr) : (u.pm * 256 + wr * 64 + fr);
        bf16_t* const zb = part ? (ZP + (size_t)i * 1024 * 1024) : Z;
        const unsigned tq = (unsigned)(((wr * 4 + wc) * 64 + fq * 16 + fr) * 64);
        if ((u.z & 1) == 0) {
#pragma unroll
            for (int ai = 0; ai < 2; ++ai)
#pragma unroll
                for (int m = 0; m < 4; ++m)
#pragma unroll
                    for (int bj = 0; bj < 2; ++bj) { const f32x4 v0 = acc[ai][bj][m][0], v1 = acc[ai][bj][m][1];
                        u32x4 w; w.x = pg8::cvt_pk_bf16(sigmoidf_(v0[0]), sigmoidf_(v0[1])); w.y = pg8::cvt_pk_bf16(sigmoidf_(v0[2]), sigmoidf_(v0[3]));
                        w.z = pg8::cvt_pk_bf16(sigmoidf_(v1[0]), sigmoidf_(v1[1])); w.w = pg8::cvt_pk_bf16(sigmoidf_(v1[2]), sigmoidf_(v1[3]));
                        *(u32x4*)(gs + (((ai * 4 + m) * 2 + bj) >> 2) * 32768 + tq + (((ai * 4 + m) * 2 + bj) & 3) * 16) = w; }
        } else {
            const bool rmw = (i > 0) && !part;
#pragma unroll
            for (int ai = 0; ai < 2; ++ai) {
                u32x4 gq[4][2], zq[4][2];
#pragma unroll
                for (int m = 0; m < 4; ++m)
#pragma unroll
                    for (int bj = 0; bj < 2; ++bj) { gq[m][bj] = *(const u32x4*)(gs + (((ai * 4 + m) * 2 + bj) >> 2) * 32768 + tq + (((ai * 4 + m) * 2 + bj) & 3) * 16);
                        zq[m][bj] = rmw ? *(const u32x4*)(zb + (size_t)(row0 + ai * 128 + m * 16) * 1024 + col0 + bj * 128) : (u32x4){0u, 0u, 0u, 0u}; }
#pragma unroll
                for (int m = 0; m < 4; ++m) { bf16_t* zrow = zb + (size_t)(row0 + ai * 128 + m * 16) * 1024 + col0;
#pragma unroll
                    for (int bj = 0; bj < 2; ++bj) { const f32x4 v0 = acc[ai][bj][m][0], v1 = acc[ai][bj][m][1];
                        const u32x4 g = gq[m][bj], zo = zq[m][bj]; bf16_t* zp = zrow + bj * 128;
                        const float o0 = lo_bf(g.x) * v0[0] + lo_bf(zo.x), o1 = hi_bf(g.x) * v0[1] + hi_bf(zo.x), o2 = lo_bf(g.y) * v0[2] + lo_bf(zo.y), o3 = hi_bf(g.y) * v0[3] + hi_bf(zo.y);
                        const float o4 = lo_bf(g.z) * v1[0] + lo_bf(zo.z), o5 = hi_bf(g.z) * v1[1] + hi_bf(zo.z), o6 = lo_bf(g.w) * v1[2] + lo_bf(zo.w), o7 = hi_bf(g.w) * v1[3] + hi_bf(zo.w);
                        u32x4 w; w.x = pg8::cvt_pk_bf16(o0, o1); w.y = pg8::cvt_pk_bf16(o2, o3); w.z = pg8::cvt_pk_bf16(o4, o5); w.w = pg8::cvt_pk_bf16(o6, o7); *(u32x4*)zp = w; } }
                asm volatile("" ::: "memory"); }
        }
    }
};
struct EpiOut {
    static constexpr bool PERM = false;
    const float* xlat; const float* xctx; float* olat; float* octx; const float* mod;
    __device__ __forceinline__ void operator()(EPI_ARGS) const {
        const int b = u.pm / 17, isctx = (u.pm - b * 17) == 0;
        const float* gate = mod + (isctx ? 4 : b) * 3072 + 2048;
        const int col0 = u.pn * 256 + wc * 32 + 4 * fq;
        f32x4 gv[2][2];
#pragma unroll
        for (int bj = 0; bj < 2; ++bj)
#pragma unroll
            for (int n = 0; n < 2; ++n) gv[bj][n] = *(const f32x4*)(gate + col0 + bj * 128 + n * 16);
        const float* xin = isctx ? xctx : xlat; float* xo = isctx ? octx : olat;
#pragma unroll
        for (int ai = 0; ai < 2; ++ai) {
            f32x4 xq[4][2][2];
#pragma unroll
            for (int m = 0; m < 4; ++m) { const int s = (u.pm - b * 17) * 256 + ai * 128 + wr * 64 + m * 16 + fr;
                const size_t off = isctx ? ((size_t)(b * LC + s) * 1024 + col0) : ((size_t)(b * TT + (s - LC)) * 1024 + col0);
#pragma unroll
                for (int bj = 0; bj < 2; ++bj)
#pragma unroll
                    for (int n = 0; n < 2; ++n) xq[m][bj][n] = *(const f32x4*)(xin + off + bj * 128 + n * 16); }
#pragma unroll
            for (int m = 0; m < 4; ++m) { const int s = (u.pm - b * 17) * 256 + ai * 128 + wr * 64 + m * 16 + fr;
                const size_t off = isctx ? ((size_t)(b * LC + s) * 1024 + col0) : ((size_t)(b * TT + (s - LC)) * 1024 + col0);
#pragma unroll
                for (int bj = 0; bj < 2; ++bj)
#pragma unroll
                    for (int n = 0; n < 2; ++n) *(f32x4*)(xo + off + bj * 128 + n * 16) = xq[m][bj][n] + gv[bj][n] * acc[ai][bj][m][n]; }
            asm volatile("" ::: "memory"); }
    }
};

__device__ __forceinline__ void phase_ret_rope(Ctx& C, bf16_t* RQKV) {
    const float* cs = C.ctl + CT_ROPER; const float* sn = cs + 4096;
    for (int m = C.gw; m < MR; m += C.ngw) {
        const int b = m / SS, s = m - b * SS; const bool lat = s >= LC; const int t = s - LC, prow = lat ? (t >> 6) : 0, pcol = lat ? (t & 63) : 0;
        bf16_t* row = RQKV + (size_t)m * 3072;
#pragma unroll
        for (int j = 0; j < 16; ++j) {
            const int idx = j * 64 + C.lane, f = idx & 63, half = (idx >> 6) & 1, h = (idx >> 7) & 3, tz = idx >> 9;
            bf16_t* p = row + tz * 1024 + h * 256 + half * 128 + f;
            const float x1 = bf2f(p[0]), x2 = bf2f(p[64]);
            float o1 = x1, o2 = x2;
            if (lat) { const int pos = half ? pcol : prow; const float c = cs[pos * 64 + f], sv = sn[pos * 64 + f]; o1 = x1 * c - x2 * sv; o2 = x2 * c + x1 * sv; }
            if (tz) { o1 *= 0.0625f; o2 *= 0.0625f; }
            p[0] = (bf16_t)f2bf(o1); p[64] = (bf16_t)f2bf(o2);
        }
    }
}

#define RS_STEP(o, cnt, st) do { const bool up_ = (C.lane & (st)) != 0; _Pragma("unroll") for (int e_ = 0; e_ < (cnt) / 2; ++e_) { \
        const float send_ = up_ ? o[e_] : o[e_ + (cnt) / 2]; const float keep_ = up_ ? o[e_ + (cnt) / 2] : o[e_]; o[e_] = keep_ + __shfl_xor(send_, (st)); } } while (0)

__device__ __forceinline__ void phase_ret_naive(Ctx& C, int l, const bf16_t* RQKV, bf16_t* OI) {
    LAS unsigned char* qs = C.lds + C.wave * 512;
    const int nbu = (MR / 8) * 16;
    for (int bu = C.bid; bu < nbu; bu += C.G) {
        const int hq = bu & 15, h = hq >> 2, qd = hq & 3, n = (bu >> 4) * 8 + C.wave;
        const int b = n / SS, sn_ = n - b * SS;
        const float lgf = C.ctl[CT_LG + (l * 2 + 0) * 4 + h], lgb = C.ctl[CT_LG + (l * 2 + 1) * 4 + h];
        const int pfn = sn_, pbn = (sn_ < LC) ? (LC - 1 - sn_) : (SS + LC - 1 - sn_);
        asm volatile("s_waitcnt lgkmcnt(0)" ::: "memory");
        *(LAS u32x2*)(qs + C.lane * 8) = *(const u32x2*)(RQKV + (size_t)n * 3072 + h * 256 + C.lane * 4);
        asm volatile("s_waitcnt lgkmcnt(0)" ::: "memory");
        float o[64];
#pragma unroll
        for (int e = 0; e < 64; ++e) o[e] = 0.f;
        for (int sm = C.lane; sm < SS; sm += 64) {
            const bf16_t* krow = RQKV + (size_t)(b * SS + sm) * 3072 + 1024 + h * 256;
            float dot = 0.f;
#pragma unroll 4
            for (int c = 0; c < 32; ++c) { const u32x4 kv = *(const u32x4*)(krow + c * 8); const u32x4 qv = *(const LAS u32x4*)(qs + c * 16);
                dot += lo_bf(kv.x) * lo_bf(qv.x) + hi_bf(kv.x) * hi_bf(qv.x) + lo_bf(kv.y) * lo_bf(qv.y) + hi_bf(kv.y) * hi_bf(qv.y)
                     + lo_bf(kv.z) * lo_bf(qv.z) + hi_bf(kv.z) * hi_bf(qv.z) + lo_bf(kv.w) * lo_bf(qv.w) + hi_bf(kv.w) * hi_bf(qv.w); }
            const int pfm = sm, pbm = (sm < LC) ? (LC - 1 - sm) : (SS + LC - 1 - sm);
            float w = 0.f;
            if (pfn >= pfm) w += EX2(lgf * (float)(pfn - pfm));
            if (pbn >= pbm) w += EX2(lgb * (float)(pbn - pbm));
            const float ws_ = w * dot;
            const bf16_t* vrow = krow + 1024 + qd * 64;
#pragma unroll
            for (int c = 0; c < 8; ++c) { const u32x4 vv = *(const u32x4*)(vrow + c * 8);
                o[c * 8 + 0] += ws_ * lo_bf(vv.x); o[c * 8 + 1] += ws_ * hi_bf(vv.x); o[c * 8 + 2] += ws_ * lo_bf(vv.y); o[c * 8 + 3] += ws_ * hi_bf(vv.y);
                o[c * 8 + 4] += ws_ * lo_bf(vv.z); o[c * 8 + 5] += ws_ * hi_bf(vv.z); o[c * 8 + 6] += ws_ * lo_bf(vv.w); o[c * 8 + 7] += ws_ * hi_bf(vv.w); }
        }
        RS_STEP(o, 64, 32); RS_STEP(o, 32, 16); RS_STEP(o, 16, 8); RS_STEP(o, 8, 4); RS_STEP(o, 4, 2); RS_STEP(o, 2, 1);
        OI[(size_t)n * 1024 + h * 256 + qd * 64 + C.lane] = (bf16_t)f2bf(o[0]);
    }
}
__device__ __forceinline__ void phase_ret_ln(Ctx& C, int l, bf16_t* OI) {
    const float* gain = INP(16) + l * 1024;
    for (int m = C.gw; m < MR; m += C.ngw) {
#pragma unroll
        for (int h = 0; h < 4; ++h) { bf16_t* p = OI + (size_t)m * 1024 + h * 256 + C.lane * 4;
            const u32x2 w = *(const u32x2*)p; float x0 = lo_bf(w.x), x1 = hi_bf(w.x), x2 = lo_bf(w.y), x3 = hi_bf(w.y);
            const float mean = wave_sum((x0 + x1) + (x2 + x3)) * (1.f / 256.f);
            x0 -= mean; x1 -= mean; x2 -= mean; x3 -= mean;
            const float var = wave_sum((x0 * x0 + x1 * x1) + (x2 * x2 + x3 * x3)) * (1.f / 256.f);
            const float rstd = RSQ(var + EPS);
            const f32x4 g = *(const f32x4*)(gain + h * 256 + C.lane * 4);
            u32x2 o; o.x = pk2(x0 * rstd * g.x, x1 * rstd * g.y); o.y = pk2(x2 * rstd * g.z, x3 * rstd * g.w); *(u32x2*)p = o; }
    }
}

__device__ __forceinline__ void phase_md_post(Ctx& C, int l, bf16_t* MD) {
    const float* qn = INP(17) + l * 384; const float* kvn = INP(19) + l * 256; const float* gkr = INP(24) + l * 64;
    const float* cs = C.ctl + CT_ROPEM; const float* sn = cs + 1024;
    for (int m = C.gw; m < MR; m += C.ngw) {
        const int b = m / SS, s = m - b * SS; const bool lat = s >= LC; const int t = s - LC;
        bf16_t* row = MD + (size_t)m * 768;
        {   float x[6]; float ss = 0.f;
#pragma unroll
            for (int j = 0; j < 3; ++j) { const unsigned w = *(const unsigned*)(row + 2 * C.lane + 128 * j); x[2 * j] = lo_bf(w); x[2 * j + 1] = hi_bf(w); ss += x[2 * j] * x[2 * j] + x[2 * j + 1] * x[2 * j + 1]; }
            const float rstd = RSQ(wave_sum(ss) * (1.f / 384.f) + EPS);
#pragma unroll
            for (int j = 0; j < 3; ++j) { const int c = 2 * C.lane + 128 * j; *(unsigned*)(row + c) = pk2(x[2 * j] * rstd * qn[c], x[2 * j + 1] * rstd * qn[c + 1]); } }
        {   float x[4]; float ss = 0.f;
#pragma unroll
            for (int j = 0; j < 2; ++j) { const unsigned w = *(const unsigned*)(row + 384 + 2 * C.lane + 128 * j); x[2 * j] = lo_bf(w); x[2 * j + 1] = hi_bf(w); ss += x[2 * j] * x[2 * j] + x[2 * j + 1] * x[2 * j + 1]; }
            const float rstd = RSQ(wave_sum(ss) * (1.f / 256.f) + EPS);
#pragma unroll
            for (int j = 0; j < 2; ++j) { const int c = 2 * C.lane + 128 * j; *(unsigned*)(row + 384 + c) = pk2(x[2 * j] * rstd * kvn[c], x[2 * j + 1] * rstd * kvn[c + 1]); } }
        {   const float x = bf2f(row[640 + C.lane]);
            const float rstd = RSQ(wave_sum(x * x) * (1.f / 64.f) + EPS);
            float y = x * rstd * gkr[C.lane];
            if (lat) { const float pr = __shfl_xor(y, 16); const float rot = (C.lane & 16) ? pr : -pr; const int f = C.lane & 15, pos = (C.lane < 32) ? (t >> 6) : (t & 63);
                y = y * cs[pos * 16 + f] + rot * sn[pos * 16 + f]; }
            row[640 + C.lane] = (bf16_t)f2bf(y); }
    }
}
__device__ __forceinline__ void phase_qk_post(Ctx& C, int l, bf16_t* QN, bf16_t* QP, bf16_t* KV) {
    const float* gqn = INP(21) + l * 128; const float* gqr = INP(22) + l * 64; const float* gkn = INP(23) + l * 128;
    const float* cs = C.ctl + CT_ROPEM; const float* sn = cs + 1024;
    for (int m = C.gw; m < MR; m += C.ngw) {
        const int b = m / SS, s = m - b * SS; const bool lat = s >= LC; const int t = s - LC;
        bf16_t* qrow = QN + (size_t)m * 1024; bf16_t* prow = QP + (size_t)m * 512; bf16_t* krow = KV + (size_t)m * 2048;
#pragma unroll
        for (int h = 0; h < 8; ++h) {
            {   unsigned* p = (unsigned*)(qrow + h * 128 + 2 * C.lane); const unsigned w = *p; const float x0 = lo_bf(w), x1 = hi_bf(w);
                const float rstd = RSQ(wave_sum(x0 * x0 + x1 * x1) * (1.f / 128.f) + EPS);
                *p = pk2(x0 * rstd * gqn[2 * C.lane] * QSCALE, x1 * rstd * gqn[2 * C.lane + 1] * QSCALE); }
            {   bf16_t* p = prow + h * 64 + C.lane; const float x = bf2f(*p);
                const float rstd = RSQ(wave_sum(x * x) * (1.f / 64.f) + EPS);
                float y = x * rstd * gqr[C.lane];
                if (lat) { const float pr = __shfl_xor(y, 16); const float rot = (C.lane & 16) ? pr : -pr; const int f = C.lane & 15, pos = (C.lane < 32) ? (t >> 6) : (t & 63);
                    y = y * cs[pos * 16 + f] + rot * sn[pos * 16 + f]; }
                *p = (bf16_t)f2bf(y * QSCALE); }
            {   unsigned* p = (unsigned*)(krow + h * 128 + 2 * C.lane); const unsigned w = *p; const float x0 = lo_bf(w), x1 = hi_bf(w);
                const float rstd = RSQ(wave_sum(x0 * x0 + x1 * x1) * (1.f / 128.f) + EPS);
                *p = pk2(x0 * rstd * gkn[2 * C.lane], x1 * rstd * gkn[2 * C.lane + 1]); }
        }
    }
}

__device__ __forceinline__ void phase_attn_naive(Ctx& C, bool with_ctx, bf16_t* QN, const bf16_t* QP, const bf16_t* KV, const bf16_t* MD) {
    LAS unsigned char* qs = C.lds + C.wave * 512;
    const int nlat = NB * 8 * (TT / 8), nctx = with_ctx ? NB * 8 * (LC / 8) : 0;
    for (int bu = C.bid; bu < nlat + nctx; bu += C.G) {
        int b, h, s, nkeys;
        if (bu < nlat) { const int tb = bu % (TT / 8), bh = bu / (TT / 8); b = bh >> 3; h = bh & 7; s = LC + tb * 8 + C.wave; nkeys = SS; }
        else { const int r = bu - nlat, tb = r % (LC / 8), bh = r / (LC / 8); b = bh >> 3; h = bh & 7; s = tb * 8 + C.wave; nkeys = LC; }
        const size_t m = (size_t)b * SS + s;
        asm volatile("s_waitcnt lgkmcnt(0)" ::: "memory");
        if (C.lane < 32) *(LAS u32x2*)(qs + C.lane * 8) = *(const u32x2*)(QN + m * 1024 + h * 128 + C.lane * 4);
        else if (C.lane < 48) *(LAS u32x2*)(qs + 256 + (C.lane - 32) * 8) = *(const u32x2*)(QP + m * 512 + h * 64 + (C.lane - 32) * 4);
        asm volatile("s_waitcnt lgkmcnt(0)" ::: "memory");
        float o[128];
#pragma unroll
        for (int e = 0; e < 128; ++e) o[e] = 0.f;
        float mrun = -1e30f, lrun = 0.f;
        for (int key = C.lane; key < nkeys; key += 64) {
            const size_t kr = (size_t)b * SS + key;
            const bf16_t* kn = KV + kr * 2048 + h * 128; const bf16_t* kro = MD + kr * 768 + 640;
            float dot = 0.f;
#pragma unroll 4
            for (int c = 0; c < 16; ++c) { const u32x4 kv = *(const u32x4*)(kn + c * 8); const u32x4 qv = *(const LAS u32x4*)(qs + c * 16);
                dot += lo_bf(kv.x) * lo_bf(qv.x) + hi_bf(kv.x) * hi_bf(qv.x) + lo_bf(kv.y) * lo_bf(qv.y) + hi_bf(kv.y) * hi_bf(qv.y)
                     + lo_bf(kv.z) * lo_bf(qv.z) + hi_bf(kv.z) * hi_bf(qv.z) + lo_bf(kv.w) * lo_bf(qv.w) + hi_bf(kv.w) * hi_bf(qv.w); }
#pragma unroll 4
            for (int c = 0; c < 8; ++c) { const u32x4 kv = *(const u32x4*)(kro + c * 8); const u32x4 qv = *(const LAS u32x4*)(qs + 256 + c * 16);
                dot += lo_bf(kv.x) * lo_bf(qv.x) + hi_bf(kv.x) * hi_bf(qv.x) + lo_bf(kv.y) * lo_bf(qv.y) + hi_bf(kv.y) * hi_bf(qv.y)
                     + lo_bf(kv.z) * lo_bf(qv.z) + hi_bf(kv.z) * hi_bf(qv.z) + lo_bf(kv.w) * lo_bf(qv.w) + hi_bf(kv.w) * hi_bf(qv.w); }
            const float mnew = fmaxf(mrun, dot), alpha = EX2(mrun - mnew), p = EX2(dot - mnew);
            lrun = lrun * alpha + p; mrun = mnew;
            const bf16_t* vrow = KV + kr * 2048 + 1024 + h * 128;
#pragma unroll
            for (int c = 0; c < 16; ++c) { const u32x4 vv = *(const u32x4*)(vrow + c * 8);
                o[c * 8 + 0] = o[c * 8 + 0] * alpha + p * lo_bf(vv.x); o[c * 8 + 1] = o[c * 8 + 1] * alpha + p * hi_bf(vv.x);
                o[c * 8 + 2] = o[c * 8 + 2] * alpha + p * lo_bf(vv.y); o[c * 8 + 3] = o[c * 8 + 3] * alpha + p * hi_bf(vv.y);
                o[c * 8 + 4] = o[c * 8 + 4] * alpha + p * lo_bf(vv.z); o[c * 8 + 5] = o[c * 8 + 5] * alpha + p * hi_bf(vv.z);
                o[c * 8 + 6] = o[c * 8 + 6] * alpha + p * lo_bf(vv.w); o[c * 8 + 7] = o[c * 8 + 7] * alpha + p * hi_bf(vv.w); }
        }
        const float mall = wave_max(mrun), fsc = EX2(mrun - mall);
        const float lall = wave_sum(lrun * fsc);
#pragma unroll
        for (int e = 0; e < 128; ++e) o[e] *= fsc;
        RS_STEP(o, 128, 32); RS_STEP(o, 64, 16); RS_STEP(o, 32, 8); RS_STEP(o, 16, 4); RS_STEP(o, 8, 2); RS_STEP(o, 4, 1);
        const float inv = 1.f / lall;
        *(unsigned*)(QN + m * 1024 + h * 128 + 2 * C.lane) = pk2(o[0] * inv, o[1] * inv);
    }
}

__device__ __forceinline__ void phase_conv(Ctx& C, int l, const bf16_t* XA, bf16_t* U) {
    const float* cw = INP(8) + l * 4 * 1024; const float* cb = INP(9) + l * 1024;
    const int gt = C.bid * NTHR + C.tid, ngt = C.G * NTHR;
    for (int it = gt; it < MR * 128; it += ngt) {
        const int m = it >> 7, c0 = (it & 127) * 8, b = m / SS, s = m - b * SS;
        const int lo = (s < LC) ? 0 : LC, hi = (s < LC) ? LC : SS;
        float a[8];
#pragma unroll
        for (int e = 0; e < 8; ++e) a[e] = cb[c0 + e];
#pragma unroll
        for (int j = 0; j < 4; ++j) { const int sj = s + j - 2;
            if (sj >= lo && sj < hi) { const u32x4 xv = *(const u32x4*)(XA + (size_t)(b * SS + sj) * 1024 + c0); const float* w = cw + j * 1024 + c0;
                a[0] += w[0] * lo_bf(xv.x); a[1] += w[1] * hi_bf(xv.x); a[2] += w[2] * lo_bf(xv.y); a[3] += w[3] * hi_bf(xv.y);
                a[4] += w[4] * lo_bf(xv.z); a[5] += w[5] * hi_bf(xv.z); a[6] += w[6] * lo_bf(xv.w); a[7] += w[7] * hi_bf(xv.w); } }
        u32x4 o; o.x = pk2(a[0], a[1]); o.y = pk2(a[2], a[3]); o.z = pk2(a[4], a[5]); o.w = pk2(a[6], a[7]);
        *(u32x4*)(U + (size_t)m * 1024 + c0) = o;
    }
}
typedef f16_t f16x2 __attribute__((ext_vector_type(2)));
__device__ __forceinline__ void phase_scan1(Ctx& C, int d, const f16_t* RI, float* SUM) {
    for (int un = C.gw; un < NB * 68 * 8; un += C.ngw) {
        const int cg_ = un & 7, sg = (un >> 3) % 68, b = (un >> 3) / 68, ch = cg_ * 128 + 2 * C.lane;
        float A0 = 1.f, A1 = 1.f, H0 = 0.f, H1 = 0.f;
        const f16_t* base = RI + (size_t)(b * SS + sg * 64) * 2048 + ch;
#pragma unroll 16
        for (int i = 0; i < 64; ++i) { const int r = d ? (63 - i) : i;
            const f16x2 la = *(const f16x2*)(base + (size_t)r * 2048), bc = *(const f16x2*)(base + (size_t)r * 2048 + 1024);
            const float a0 = EX2((float)la[0]), a1 = EX2((float)la[1]);
            H0 = a0 * H0 + (float)bc[0]; H1 = a1 * H1 + (float)bc[1]; A0 *= a0; A1 *= a1; }
        float* sp = SUM + ((size_t)(b * 68 + sg) * 1024 + ch) * 2;
        *(f32x4*)sp = (f32x4){A0, H0, A1, H1};
    }
}
__device__ __forceinline__ void phase_scan3(Ctx& C, int d, const f16_t* RI, const float* SUM, bf16_t* YA) {
    for (int un = C.gw; un < NB * 68 * 8; un += C.ngw) {
        const int cg_ = un & 7, sg = (un >> 3) % 68, b = (un >> 3) / 68, ch = cg_ * 128 + 2 * C.lane;
        float H0 = 0.f, H1 = 0.f;
        const int npre = d ? ((sg < 4) ? (3 - sg) : (71 - sg)) : sg;
#pragma unroll 4
        for (int p = 0; p < npre; ++p) { const int ps = d ? ((p < 4) ? (3 - p) : (71 - p)) : p;
            const f32x4 v = *(const f32x4*)(SUM + ((size_t)(b * 68 + ps) * 1024 + ch) * 2);
            H0 = v[0] * H0 + v[1]; H1 = v[2] * H1 + v[3]; }
        const f16_t* base = RI + (size_t)(b * SS + sg * 64) * 2048 + ch;
        bf16_t* yb = YA + (size_t)(b * SS + sg * 64) * 1024 + ch;
#pragma unroll 16
        for (int i = 0; i < 64; ++i) { const int r = d ? (63 - i) : i;
            const f16x2 la = *(const f16x2*)(base + (size_t)r * 2048), bc = *(const f16x2*)(base + (size_t)r * 2048 + 1024);
            const float a0 = EX2((float)la[0]), a1 = EX2((float)la[1]);
            H0 = a0 * H0 + (float)bc[0]; H1 = a1 * H1 + (float)bc[1];
            unsigned* yp = (unsigned*)(yb + (size_t)r * 1024);
            if (d == 0) *yp = pk2(H0, H1); else { const unsigned w = *yp; *yp = pk2(lo_bf(w) + H0, hi_bf(w) + H1); } }
    }
}

template <int W> __device__ __forceinline__ float group_sum(float v) {
#pragma unroll
    for (int o = 1; o < W; o <<= 1) v += __shfl_xor(v, o);
    return v;
}
__device__ __forceinline__ void phase_h2(Ctx& C, int l, bf16_t* H) {
    const float* gain = INP(6) + l * 1024;
    for (int m0 = C.gw * 2; m0 < MR; m0 += C.ngw * 2) {
        f32x4 v[2][4]; float ss[2];
#pragma unroll
        for (int q = 0; q < 2; ++q) { const float* xr = resid_row(C, l, m0 + q);
#pragma unroll
            for (int j = 0; j < 4; ++j) v[q][j] = *(const f32x4*)(xr + 4 * C.lane + 256 * j); }
        const int b = m0 / SS, s = m0 - b * SS, r = (s < LC) ? 4 : b;
        const float* mod = C.ctl + CT_MOD + (l * 5 + r) * 3072;
#pragma unroll
        for (int q = 0; q < 2; ++q) { float a = 0.f;
#pragma unroll
            for (int j = 0; j < 4; ++j) a += (v[q][j].x * v[q][j].x + v[q][j].y * v[q][j].y) + (v[q][j].z * v[q][j].z + v[q][j].w * v[q][j].w);
            ss[q] = a; }
        ss[0] = wave_sum(ss[0]); ss[1] = wave_sum(ss[1]);
#pragma unroll
        for (int j = 0; j < 4; ++j) { const int c = 4 * C.lane + 256 * j;
            const f32x4 g = *(const f32x4*)(gain + c), sh = *(const f32x4*)(mod + c), sc = *(const f32x4*)(mod + 1024 + c) + 1.0f;
#pragma unroll
            for (int q = 0; q < 2; ++q) { const float rstd = RSQ(ss[q] * (1.f / 1024.f) + EPS);
                const f32x4 o = ((v[q][j] * rstd) * g) * sc + sh;
                u32x2 w; w.x = pk2(o.x, o.y); w.y = pk2(o.z, o.w);
                *(u32x2*)(H + (size_t)(m0 + q) * 1024 + c) = w; } }
    }
}
__device__ __forceinline__ void phase_md_post2(Ctx& C, int l, bf16_t* MD) {
    const float* qn = INP(17) + l * 384; const float* kvn = INP(19) + l * 256; const float* gkr = INP(24) + l * 64;
    const float* cs = C.ctl + CT_ROPEM; const float* sn = cs + 1024;
    const int L = C.lane;
    for (int m0 = C.gw * 2; m0 < MR; m0 += C.ngw * 2) {
        u32x4 w0[2], w1[2];
#pragma unroll
        for (int q = 0; q < 2; ++q) { const bf16_t* row = MD + (size_t)(m0 + q) * 768; w0[q] = *(const u32x4*)(row + 8 * L); w1[q] = (L < 32) ? *(const u32x4*)(row + 512 + 8 * L) : (u32x4){0u, 0u, 0u, 0u}; }
#pragma unroll
        for (int q = 0; q < 2; ++q) { const int m = m0 + q, b = m / SS, s = m - b * SS; const bool lat = s >= LC; const int t = s - LC;
            bf16_t* row = MD + (size_t)m * 768;
            float x0[8], x1[8]; unpack8(w0[q], x0); unpack8(w1[q], x1);
            const float s0 = sumsq8(x0), s1 = sumsq8(x1);
            const float sq = wave_sum(L < 48 ? s0 : 0.f), skv = wave_sum((L >= 48 ? s0 : 0.f) + (L < 16 ? s1 : 0.f)), skr = wave_sum((L >= 16 && L < 24) ? s1 : 0.f);
            const float rq = RSQ(sq * (1.f / 384.f) + EPS), rkv = RSQ(skv * (1.f / 256.f) + EPS), rkr = RSQ(skr * (1.f / 64.f) + EPS);
            {   const float* g = (L < 48) ? (qn + 8 * L) : (kvn + 8 * (L - 48)); const float rs = (L < 48) ? rq : rkv;
#pragma unroll
                for (int e = 0; e < 8; ++e) x0[e] *= rs * g[e];
                *(u32x4*)(row + 8 * L) = pack8u(x0); }
            if (L < 16) {
#pragma unroll
                for (int e = 0; e < 8; ++e) x1[e] *= rkv * kvn[128 + 8 * L + e];
            } else if (L < 24) {
#pragma unroll
                for (int e = 0; e < 8; ++e) x1[e] *= rkr * gkr[8 * (L - 16) + e];
            }
            float pr[8];
#pragma unroll
            for (int e = 0; e < 8; ++e) pr[e] = __shfl_xor(x1[e], 2);
            if (lat && L >= 16 && L < 24) { const int qt = (L - 16) >> 1, f0 = ((L - 16) & 1) * 8, pos = (qt < 2) ? (t >> 6) : (t & 63); const float sg = (qt & 1) ? 1.f : -1.f;
#pragma unroll
                for (int e = 0; e < 8; ++e) x1[e] = x1[e] * cs[pos * 16 + f0 + e] + sg * pr[e] * sn[pos * 16 + f0 + e]; }
            if (L < 24) *(u32x4*)(row + 512 + 8 * L) = pack8u(x1);
        }
    }
}
__device__ __forceinline__ void phase_qk_post2(Ctx& C, int l, bf16_t* QN, bf16_t* QP, bf16_t* KV) {
    const float* gqn = INP(21) + l * 128; const float* gqr = INP(22) + l * 64; const float* gkn = INP(23) + l * 128;
    const float* cs = C.ctl + CT_ROPEM; const float* sn = cs + 1024;
    const int L = C.lane;
    for (int m0 = C.gw * 2; m0 < MR; m0 += C.ngw * 2) {
        u32x4 a[2][2], k[2][2], p[2];
#pragma unroll
        for (int q = 0; q < 2; ++q) { const size_t m = m0 + q;
            a[q][0] = *(const u32x4*)(QN + m * 1024 + 8 * L); a[q][1] = *(const u32x4*)(QN + m * 1024 + 512 + 8 * L);
            k[q][0] = *(const u32x4*)(KV + m * 2048 + 8 * L); k[q][1] = *(const u32x4*)(KV + m * 2048 + 512 + 8 * L);
            p[q] = *(const u32x4*)(QP + m * 512 + 8 * L); }
#pragma unroll
        for (int q = 0; q < 2; ++q) { const int m = m0 + q, b = m / SS, s = m - b * SS; const bool lat = s >= LC; const int t = s - LC;
#pragma unroll
            for (int c = 0; c < 2; ++c) {
                float x[8]; unpack8(a[q][c], x);
                const float rs = RSQ(group_sum<16>(sumsq8(x)) * (1.f / 128.f) + EPS) * QSCALE;
#pragma unroll
                for (int e = 0; e < 8; ++e) x[e] *= rs * gqn[8 * (L & 15) + e];
                *(u32x4*)(QN + (size_t)m * 1024 + c * 512 + 8 * L) = pack8u(x);
                float y[8]; unpack8(k[q][c], y);
                const float rk = RSQ(group_sum<16>(sumsq8(y)) * (1.f / 128.f) + EPS);
#pragma unroll
                for (int e = 0; e < 8; ++e) y[e] *= rk * gkn[8 * (L & 15) + e];
                *(u32x4*)(KV + (size_t)m * 2048 + c * 512 + 8 * L) = pack8u(y); }
            {   float x[8]; unpack8(p[q], x);
                const float rs = RSQ(group_sum<8>(sumsq8(x)) * (1.f / 64.f) + EPS);
#pragma unroll
                for (int e = 0; e < 8; ++e) x[e] *= rs * gqr[8 * (L & 7) + e];
                float pr[8];
#pragma unroll
                for (int e = 0; e < 8; ++e) pr[e] = __shfl_xor(x[e], 2);
                if (lat) { const int qt = (L >> 1) & 3, f0 = (L & 1) * 8, pos = (qt < 2) ? (t >> 6) : (t & 63); const float sg = (qt & 1) ? 1.f : -1.f;
#pragma unroll
                    for (int e = 0; e < 8; ++e) x[e] = x[e] * cs[pos * 16 + f0 + e] + sg * pr[e] * sn[pos * 16 + f0 + e]; }
#pragma unroll
                for (int e = 0; e < 8; ++e) x[e] *= QSCALE;
                *(u32x4*)(QP + (size_t)m * 512 + 8 * L) = pack8u(x); }
        }
    }
}
__device__ __forceinline__ void phase_ret_ln3(Ctx& C, int l, bf16_t* OI, const bf16_t* OB) {
    const float* gain = INP(16) + l * 1024;
    const int L = C.lane;
    for (int m0 = C.gw * 2; m0 < MR; m0 += C.ngw * 2) {
        u32x4 a[2][2], bb[2][2];
#pragma unroll
        for (int q = 0; q < 2; ++q)
#pragma unroll
            for (int c = 0; c < 2; ++c) { a[q][c] = *(const u32x4*)(OI + (size_t)(m0 + q) * 1024 + c * 512 + 8 * L); bb[q][c] = *(const u32x4*)(OB + (size_t)(m0 + q) * 1024 + c * 512 + 8 * L); }
#pragma unroll
        for (int q = 0; q < 2; ++q)
#pragma unroll
            for (int c = 0; c < 2; ++c) { float x[8], y[8]; unpack8(a[q][c], x); unpack8(bb[q][c], y);
                float s = 0.f;
#pragma unroll
                for (int e = 0; e < 8; ++e) { x[e] += y[e]; s += x[e]; }
                const float mean = group_sum<32>(s) * (1.f / 256.f);
                float v = 0.f;
#pragma unroll
                for (int e = 0; e < 8; ++e) { x[e] -= mean; v += x[e] * x[e]; }
                const float rstd = RSQ(group_sum<32>(v) * (1.f / 256.f) + EPS);
#pragma unroll
                for (int e = 0; e < 8; ++e) x[e] *= rstd * gain[c * 512 + 8 * L + e];
                *(u32x4*)(OI + (size_t)(m0 + q) * 1024 + c * 512 + 8 * L) = pack8u(x); }
    }
}

__device__ __forceinline__ void phase_zsum(Ctx& C, const bf16_t* ZP, bf16_t* Z) {
    const int gt = C.bid * NTHR + C.tid, ngt = C.G * NTHR;
    for (int it = gt; it < 1024 * 128; it += ngt) { const int r = it >> 7, c0 = (it & 127) * 8, b = r >> 8, s = r & 255;
        const u32x4 a = *(const u32x4*)(ZP + (size_t)r * 1024 + c0), bq = *(const u32x4*)(ZP + (size_t)(1024 + r) * 1024 + c0), cq = *(const u32x4*)(ZP + (size_t)(2048 + r) * 1024 + c0);
        float x[8], y[8], z[8]; unpack8(a, x); unpack8(bq, y); unpack8(cq, z);
#pragma unroll
        for (int e = 0; e < 8; ++e) x[e] += y[e] + z[e];
        *(u32x4*)(Z + (size_t)(b * SS + s) * 1024 + c0) = pack8u(x); }
}

typedef float f32x16 __attribute__((ext_vector_type(16)));
typedef short v4i16_t __attribute__((ext_vector_type(4)));
constexpr int AT_KP = 400, AT_VP = 320;
constexpr int AT_KB = 64 * AT_KP, AT_VB = 64 * AT_VP, AT_STG = AT_KB + AT_VB, AT_WSF = 2 * AT_STG;
__device__ __forceinline__ int crow(int r, int hi) { return (r & 3) + 8 * (r >> 2) + 4 * hi; }
__device__ __forceinline__ bf16x8 pack8(float a, float b, float c, float d, float e, float f, float g, float h) {
    u32x4 w; w.x = pg8::cvt_pk_bf16(a, b); w.y = pg8::cvt_pk_bf16(c, d); w.z = pg8::cvt_pk_bf16(e, f); w.w = pg8::cvt_pk_bf16(g, h); return __builtin_bit_cast(bf16x8, w); }
__device__ __forceinline__ bf16x8 tr2(LAS unsigned char* p0, LAS unsigned char* p1) {
    const v4i16_t lo = __builtin_amdgcn_ds_read_tr16_b64_v4i16((LAS v4i16_t*)p0), hi = __builtin_amdgcn_ds_read_tr16_b64_v4i16((LAS v4i16_t*)p1);
    return (bf16x8){lo[0], lo[1], lo[2], lo[3], hi[0], hi[1], hi[2], hi[3]}; }

__device__ __forceinline__ void phase_attn(Ctx& C, int l, bool with_ctx, bf16_t* QN, const bf16_t* QP, const bf16_t* KV, const bf16_t* MD) {
    const float* gqn = INP(21) + l * 128; const float* gqr = INP(22) + l * 64; const float* csm = C.ctl + CT_ROPEM;
    const int lane = C.lane, r32 = lane & 31, hi = lane >> 5, wave = C.wave, tid = C.tid;
    LAS unsigned char* lds = C.lds;
    LAS float* wsf = (LAS float*)(lds + AT_WSF + wave * 128);
    const int nunits = 512 + (with_ctx ? 32 : 0);
    const int rowA = tid >> 4, ccA = tid & 15, rowR = tid >> 3, ccR = tid & 7;
    const int i16 = lane & 15, q4 = i16 >> 2, p4 = i16 & 3, g1 = (lane >> 4) & 1;
    const int vb = AT_KB + (4 * hi + q4) * AT_VP + (16 * g1 + 4 * p4) * 2;
    const int wK = rowA * AT_KP + ccA * 16, wR = rowR * AT_KP + 256 + ccR * 16, wV = AT_KB + rowA * AT_VP + ccA * 16;
    for (int un = C.bid; un < nunits; un += C.G) {
        int bh, qb, isctx;
        if (un < 512) { const int x = un & 7, jj = un >> 3; bh = x * 4 + (jj >> 4); qb = jj & 15; isctx = 0; } else { bh = un - 512; qb = 0; isctx = 1; }
        const int b = bh >> 3, h = bh & 7;
        const size_t kb0 = (size_t)b * SS;
        const size_t m0 = kb0 + (isctx ? 0 : LC + qb * 256) + wave * 32;
        const int NT = (isctx ? LC : SS) / 64;
        bf16x8 qf[12];
        {   const bf16_t* qn = QN + (m0 + r32) * 1024 + h * 128 + hi * 8; const bf16_t* qp = QP + (m0 + r32) * 512 + h * 64 + hi * 8;
#pragma unroll
            for (int s = 0; s < 8; ++s) qf[s] = *(const bf16x8*)(qn + s * 16);
#pragma unroll
            for (int s = 0; s < 4; ++s) qf[8 + s] = *(const bf16x8*)(qp + s * 16); }
        {
            int hq = hi; asm volatile("" : "+v"(hq));
            float ssn = 0.f, ssr = 0.f;
#pragma unroll
            for (int s = 0; s < 12; ++s) { float x[8]; unpack8(__builtin_bit_cast(u32x4, qf[s]), x); const float q = sumsq8(x); if (s < 8) ssn += q; else ssr += q; }
            ssn += __shfl_xor(ssn, 32); ssr += __shfl_xor(ssr, 32);
            const float rn = RSQ(ssn * (1.f / 128.f) + EPS) * QSCALE, rr = RSQ(ssr * (1.f / 64.f) + EPS);
#pragma unroll
            for (int s = 0; s < 8; ++s) { float x[8]; unpack8(__builtin_bit_cast(u32x4, qf[s]), x);
                const f32x4 ga = *(const f32x4*)(gqn + 16 * s + 8 * hq), gb = *(const f32x4*)(gqn + 16 * s + 8 * hq + 4);
                x[0] *= rn * ga[0]; x[1] *= rn * ga[1]; x[2] *= rn * ga[2]; x[3] *= rn * ga[3]; x[4] *= rn * gb[0]; x[5] *= rn * gb[1]; x[6] *= rn * gb[2]; x[7] *= rn * gb[3];
                qf[s] = __builtin_bit_cast(bf16x8, pack8u(x)); }
            const int tq = qb * 256 + wave * 32 + r32;
#pragma unroll
            for (int pr = 0; pr < 2; ++pr) {
                float xa[8], xb[8]; unpack8(__builtin_bit_cast(u32x4, qf[8 + 2 * pr]), xa); unpack8(__builtin_bit_cast(u32x4, qf[9 + 2 * pr]), xb);
#pragma unroll
                for (int j = 0; j < 8; ++j) { xa[j] *= rr * gqr[32 * pr + 8 * hq + j]; xb[j] *= rr * gqr[32 * pr + 16 + 8 * hq + j]; }
                if (!isctx) { const int pos = pr ? (tq & 63) : (tq >> 6);
#pragma unroll
                    for (int j = 0; j < 8; ++j) { const float c = csm[pos * 16 + 8 * hq + j], sv = csm[1024 + pos * 16 + 8 * hq + j]; const float a = xa[j] * c - xb[j] * sv, bq = xb[j] * c + xa[j] * sv; xa[j] = a; xb[j] = bq; } }
#pragma unroll
                for (int j = 0; j < 8; ++j) { xa[j] *= QSCALE; xb[j] *= QSCALE; }
                qf[8 + 2 * pr] = __builtin_bit_cast(bf16x8, pack8u(xa)); qf[9 + 2 * pr] = __builtin_bit_cast(bf16x8, pack8u(xb)); }
        }
        f32x16 o[4];
#pragma unroll
        for (int d = 0; d < 4; ++d)
#pragma unroll
            for (int r = 0; r < 16; ++r) o[d][r] = 0.f;
        float mrun = -1e30f, lrun = 0.f;
        u32x4 kn0, kn1, kr0, vv0, vv1;
        const unsigned kvo = (unsigned)(((kb0 + rowA) * 2048 + h * 128 + ccA * 8) * 2);
        const unsigned kro = (unsigned)(((kb0 + rowR) * 768 + 640 + ccR * 8) * 2);
#define AT_LOAD(t) do { const char* kp_ = (const char*)KV + (size_t)(t) * (64 * 2048 * 2); kn0 = *(const u32x4*)(kp_ + kvo); kn1 = *(const u32x4*)(kp_ + 32 * 2048 * 2 + kvo); vv0 = *(const u32x4*)(kp_ + 1024 * 2 + kvo); vv1 = *(const u32x4*)(kp_ + (32 * 2048 + 1024) * 2 + kvo); \
        kr0 = *(const u32x4*)((const char*)MD + (size_t)(t) * (64 * 768 * 2) + kro); } while (0)
#define AT_WRITE(sb) do { int sb_ = (sb); asm volatile("" : "+s"(sb_)); LAS unsigned char* s_ = lds + sb_;     \
        *(LAS u32x4*)(s_ + wK) = kn0; *(LAS u32x4*)(s_ + wK + 32 * AT_KP) = kn1; \
        *(LAS u32x4*)(s_ + wR) = kr0; *(LAS u32x4*)(s_ + wV) = vv0; *(LAS u32x4*)(s_ + wV + 32 * AT_VP) = vv1; } while (0)
#define AT_QK(sbv) do { _Pragma("unroll") for (int r = 0; r < 16; ++r) { p0[r] = 0.f; p1[r] = 0.f; } \
        LAS unsigned char* ka = lds + (sbv) + r32 * AT_KP + hi * 16; __builtin_amdgcn_s_setprio(1); \
        _Pragma("unroll") for (int s = 0; s < 12; ++s) { const bf16x8 a0 = *(const LAS bf16x8*)(ka + s * 32), a1 = *(const LAS bf16x8*)(ka + 32 * AT_KP + s * 32); \
            p0 = __builtin_amdgcn_mfma_f32_32x32x16_bf16(a0, qf[s], p0, 0, 0, 0); p1 = __builtin_amdgcn_mfma_f32_32x32x16_bf16(a1, qf[s], p1, 0, 0, 0); \
            if ((s & 3) == 3) asm volatile("" ::: "memory"); } \
        __builtin_amdgcn_s_setprio(0); } while (0)
#define AT_SM() do { float rm = fmaxf(p0[0], p1[0]); \
        _Pragma("unroll") for (int r = 1; r < 16; ++r) rm = fmaxf(rm, fmaxf(p0[r], p1[r])); \
        rm = fmaxf(rm, __shfl_xor(rm, 32)); \
        if (__any(rm > mrun + 8.f)) { const float mnew = fmaxf(mrun, rm), alpha = EX2(mrun - mnew); mrun = mnew; lrun *= alpha; \
            if (hi == 0) wsf[r32] = alpha; \
            _Pragma("unroll") for (int r = 0; r < 16; ++r) { const float a = wsf[crow(r, hi)]; _Pragma("unroll") for (int d = 0; d < 4; ++d) o[d][r] *= a; } } \
        float ls = 0.f; \
        _Pragma("unroll") for (int r = 0; r < 16; ++r) { p0[r] = EX2(p0[r] - mrun); p1[r] = EX2(p1[r] - mrun); ls += p0[r] + p1[r]; } \
        lrun += ls; \
        pa0 = pack8(p0[0], p0[1], p0[2], p0[3], p0[4], p0[5], p0[6], p0[7]); pa1 = pack8(p0[8], p0[9], p0[10], p0[11], p0[12], p0[13], p0[14], p0[15]); \
        pa2 = pack8(p1[0], p1[1], p1[2], p1[3], p1[4], p1[5], p1[6], p1[7]); pa3 = pack8(p1[8], p1[9], p1[10], p1[11], p1[12], p1[13], p1[14], p1[15]); } while (0)
#define AT_PV(sbv) do { LAS unsigned char* vp = lds + (sbv) + vb; __builtin_amdgcn_s_setprio(1); \
        _Pragma("unroll") for (int d = 0; d < 4; ++d) o[d] = __builtin_amdgcn_mfma_f32_32x32x16_bf16(pa0, tr2(vp + d * 64, vp + d * 64 + 8 * AT_VP), o[d], 0, 0, 0); \
        asm volatile("" ::: "memory"); \
        _Pragma("unroll") for (int d = 0; d < 4; ++d) o[d] = __builtin_amdgcn_mfma_f32_32x32x16_bf16(pa1, tr2(vp + d * 64 + 16 * AT_VP, vp + d * 64 + 24 * AT_VP), o[d], 0, 0, 0); \
        asm volatile("" ::: "memory"); \
        _Pragma("unroll") for (int d = 0; d < 4; ++d) o[d] = __builtin_amdgcn_mfma_f32_32x32x16_bf16(pa2, tr2(vp + d * 64 + 32 * AT_VP, vp + d * 64 + 40 * AT_VP), o[d], 0, 0, 0); \
        asm volatile("" ::: "memory"); \
        _Pragma("unroll") for (int d = 0; d < 4; ++d) o[d] = __builtin_amdgcn_mfma_f32_32x32x16_bf16(pa3, tr2(vp + d * 64 + 48 * AT_VP, vp + d * 64 + 56 * AT_VP), o[d], 0, 0, 0); \
        asm volatile("" ::: "memory"); \
        __builtin_amdgcn_s_setprio(0); } while (0)
        AT_LOAD(0); AT_WRITE(0);
        __syncthreads();
        bf16x8 pa0, pa1, pa2, pa3;
        if (wave < 4) {
            for (int t = 0; t < NT; ++t) {
                const int sb = (t & 1) * AT_STG;
                if (t + 1 < NT) AT_LOAD(t + 1);
                f32x16 p0, p1;
                AT_QK(sb);
                __syncthreads();
                if (t + 1 < NT) AT_WRITE(AT_STG - sb);
                AT_SM(); AT_PV(sb);
                __syncthreads();
            }
            __syncthreads(); __syncthreads();
        } else {
            for (int t = 0; t <= NT; ++t) {
                const int sb = (t & 1) * AT_STG;
                if (t + 1 < NT) AT_LOAD(t + 1);
                if (t > 0) AT_PV(AT_STG - sb);
                __syncthreads();
                if (t + 1 < NT) AT_WRITE(AT_STG - sb);
                if (t < NT) { f32x16 p0, p1; AT_QK(sb); AT_SM(); }
                __syncthreads();
            }
        }
#undef AT_QK
#undef AT_SM
#undef AT_PV
#undef AT_LOAD
#undef AT_WRITE
        const float ltot = lrun + __shfl_xor(lrun, 32);
        if (hi == 0) wsf[r32] = 1.f / ltot;
        bf16_t* op = QN + (m0 + 4 * hi) * 1024 + h * 128 + r32;
#pragma unroll
        for (int r = 0; r < 16; ++r) { const float inv = wsf[crow(r, hi)];
#pragma unroll
            for (int d = 0; d < 4; ++d) op[d * 32] = (bf16_t)f2bf(o[d][r] * inv);
            op += ((r & 3) == 3) ? 5 * 1024 : 1024; OPAQ_G(op); }
        __syncthreads();
    }
}

constexpr int RI_KP = 528, RI_VP = 576, RI_PTP = 272;
constexpr int RI_A = 0, RI_PT = 128 * RI_VP;
__device__ __forceinline__ void phase_ret_intra(Ctx& C, int l, const bf16_t* RQKV, bf16_t* OI) {
    const int lane = C.lane, r32 = lane & 31, hi = lane >> 5, wave = C.wave, tid = C.tid;
    LAS unsigned char* lds = C.lds;
    const int i16 = lane & 15, q4 = i16 >> 2, p4 = i16 & 3, g1 = (lane >> 4) & 1;
    const int nb = wave & 3, wh = wave >> 2;
    const int srow = tid >> 5, scc = tid & 31;
    for (int un = C.bid; un < NB * 4 * 34; un += C.G) {
        const int c = un % 34, bh = un / 34, b = bh >> 2, h = bh & 3;
        const size_t row0 = (size_t)b * SS + c * 128;
        const float lgf = C.ctl[CT_LG + (l * 2 + 0) * 4 + h], lgb = C.ctl[CT_LG + (l * 2 + 1) * 4 + h];
        const bf16_t* gk = RQKV + (row0 + srow) * 3072 + 1024 + h * 256 + scc * 8;
        u32x4 st[8];
        {   const bf16_t* gp = gk;
#pragma unroll
            for (int j = 0; j < 8; ++j) { st[j] = *(const u32x4*)gp; gp += 16 * 3072; OPAQ_G(gp); } }
#pragma unroll
        for (int j = 0; j < 8; ++j) *(LAS u32x4*)(lds + RI_A + (srow + 16 * j) * RI_KP + scc * 16) = st[j];
        __syncthreads();
        {   const bf16_t* gp = gk + 1024;
#pragma unroll
            for (int j = 0; j < 8; ++j) { st[j] = *(const u32x4*)gp; gp += 16 * 3072; OPAQ_G(gp); } }
        {
            f32x16 x0, x1;
#pragma unroll
            for (int r = 0; r < 16; ++r) { x0[r] = 0.f; x1[r] = 0.f; }
            const bf16_t* gq = RQKV + (row0 + nb * 32 + r32) * 3072 + h * 256 + hi * 8;
            LAS unsigned char* ka = lds + RI_A + (wh * 64 + r32) * RI_KP + hi * 16;
#pragma unroll
            for (int s = 0; s < 16; ++s) { const bf16x8 qf = *(const bf16x8*)(gq + s * 16);
                const bf16x8 a0 = *(const LAS bf16x8*)(ka + s * 32), a1 = *(const LAS bf16x8*)(ka + 32 * RI_KP + s * 32);
                x0 = __builtin_amdgcn_mfma_f32_32x32x16_bf16(a0, qf, x0, 0, 0, 0); x1 = __builtin_amdgcn_mfma_f32_32x32x16_bf16(a1, qf, x1, 0, 0, 0);
                if ((s & 3) == 3) asm volatile("" ::: "memory"); }
            const int n = nb * 32 + r32;
            LAS unsigned char* pt = lds + RI_PT + n * RI_PTP + (wh * 64 + 4 * hi) * 2;
#pragma unroll
            for (int g = 0; g < 4; ++g) { float w0[4], w1[4];
#pragma unroll
                for (int e = 0; e < 4; ++e) { const int m0 = wh * 64 + 8 * g + 4 * hi + e; const float d0 = (float)(n - m0), d1 = d0 - 32.f;
                    const float f0 = EX2(lgf * fmaxf(d0, 0.f)) * fminf(fmaxf(d0 + 1.f, 0.f), 1.f) + EX2(lgb * fmaxf(-d0, 0.f)) * fminf(fmaxf(1.f - d0, 0.f), 1.f);
                    const float f1 = EX2(lgf * fmaxf(d1, 0.f)) * fminf(fmaxf(d1 + 1.f, 0.f), 1.f) + EX2(lgb * fmaxf(-d1, 0.f)) * fminf(fmaxf(1.f - d1, 0.f), 1.f);
                    w0[e] = x0[4 * g + e] * f0; w1[e] = x1[4 * g + e] * f1; }
                u32x2 o0, o1; o0.x = pg8::cvt_pk_bf16(w0[0], w0[1]); o0.y = pg8::cvt_pk_bf16(w0[2], w0[3]); o1.x = pg8::cvt_pk_bf16(w1[0], w1[1]); o1.y = pg8::cvt_pk_bf16(w1[2], w1[3]);
                *(LAS u32x2*)(pt + g * 16) = o0; *(LAS u32x2*)(pt + 64 + g * 16) = o1; }
        }
        __syncthreads();
#pragma unroll
        for (int j = 0; j < 8; ++j) *(LAS u32x4*)(lds + RI_A + (srow + 16 * j) * RI_VP + scc * 16) = st[j];
        __syncthreads();
        {
            f32x16 o[4];
#pragma unroll
            for (int d = 0; d < 4; ++d)
#pragma unroll
                for (int r = 0; r < 16; ++r) o[d][r] = 0.f;
            bf16x8 pa[8];
            LAS unsigned char* pr = lds + RI_PT + (nb * 32 + r32) * RI_PTP + hi * 16;
#pragma unroll
            for (int s = 0; s < 8; ++s) pa[s] = *(const LAS bf16x8*)(pr + s * 32);
            LAS unsigned char* vp = lds + RI_A + (8 * hi + q4) * RI_VP + (wh * 128 + 16 * g1 + 4 * p4) * 2;
#pragma unroll
            for (int d = 0; d < 4; ++d) {
#pragma unroll
                for (int s = 0; s < 8; ++s) o[d] = __builtin_amdgcn_mfma_f32_32x32x16_bf16(pa[s], tr2(vp + d * 64 + s * 16 * RI_VP, vp + d * 64 + (s * 16 + 4) * RI_VP), o[d], 0, 0, 0);
                asm volatile("" ::: "memory"); }
            bf16_t* op = OI + (row0 + nb * 32 + 4 * hi) * 1024 + h * 256 + wh * 128 + r32;
#pragma unroll
            for (int r = 0; r < 16; ++r) {
#pragma unroll
                for (int d = 0; d < 4; ++d) op[d * 32] = (bf16_t)f2bf(o[d][r]);
                op += ((r & 3) == 3) ? 5 * 1024 : 1024; OPAQ_G(op); }
        }
        __syncthreads();
    }
}

constexpr int RC_KT = 0, RC_KTP = 576, RC_VT = 128 * 576, RC_VTP = 64, RC_ST = RC_VT + 128 * 64, RC_STP = 528, RC_XO = RC_ST + 32 * 528, RC_END = RC_XO + 16384;
static_assert(RC_END <= 131072, "R-chain LDS");
__device__ __forceinline__ void phase_ret_chain(Ctx& C, int l, const bf16_t* RQKV, bf16_t* OI, bf16_t* OB) {
    const int lane = C.lane, r32 = lane & 31, hi = lane >> 5, wave = C.wave, tid = C.tid;
    LAS unsigned char* lds = C.lds;
    const int i16 = lane & 15, q4 = i16 >> 2, p4 = i16 & 3, g1 = (lane >> 4) & 1;
    const int nb = wave & 3, dh = wave >> 2;
    const int srow = tid >> 5, scc = tid & 31, vrow = tid >> 2, vcc = tid & 3;
    for (int un = C.bid; un < 256; un += C.G) {
        const int x = un & 7, j8 = un >> 3, bhd = x * 4 + (j8 >> 3), sl = j8 & 7, b = bhd >> 3, h = (bhd >> 1) & 3, dir = bhd & 1;
        const float lg = C.ctl[CT_LG + (l * 2 + dir) * 4 + h];
        const float cdec = EX2(lg * 128.f);
        const float vdec = dir ? EX2(lg * (float)vrow) : EX2(lg * (float)(127 - vrow));
        f32x16 sacc;
#pragma unroll
        for (int r = 0; r < 16; ++r) sacc[r] = 0.f;
        for (int i = tid; i < 32 * RC_STP / 16; i += NTHR) *(LAS u32x4*)(lds + RC_ST + i * 16) = (u32x4){0u, 0u, 0u, 0u};
        u32x4 st[8]; u32x4 sv;
#define RC_LOAD(cc_) do { const size_t r0_ = (size_t)b * SS + (cc_) * 128; const bf16_t* gk_ = RQKV + (r0_ + srow) * 3072 + 1024 + h * 256 + scc * 8; \
        _Pragma("unroll") for (int j = 0; j < 8; ++j) { st[j] = *(const u32x4*)gk_; gk_ += 16 * 3072; OPAQ_G(gk_); } \
        sv = *(const u32x4*)(RQKV + (r0_ + vrow) * 3072 + 2048 + h * 256 + sl * 32 + vcc * 8); } while (0)
#define RC_WRITE() do { _Pragma("unroll") for (int j = 0; j < 8; ++j) *(LAS u32x4*)(lds + RC_KT + (srow + 16 * j) * RC_KTP + scc * 16) = st[j]; \
        u32x4 w_; w_.x = pg8::cvt_pk_bf16(lo_bf(sv.x) * vdec, hi_bf(sv.x) * vdec); w_.y = pg8::cvt_pk_bf16(lo_bf(sv.y) * vdec, hi_bf(sv.y) * vdec); \
        w_.z = pg8::cvt_pk_bf16(lo_bf(sv.z) * vdec, hi_bf(sv.z) * vdec); w_.w = pg8::cvt_pk_bf16(lo_bf(sv.w) * vdec, hi_bf(sv.w) * vdec); \
        *(LAS u32x4*)(lds + RC_VT + vrow * RC_VTP + vcc * 16) = w_; } while (0)
        bf16x8 qa[8];
#define RC_QLOAD(dst, cc_) do { const bf16_t* gq_ = RQKV + ((size_t)b * SS + (cc_) * 128 + nb * 32 + r32) * 3072 + h * 256 + dh * 128 + hi * 8; \
        _Pragma("unroll") for (int s = 0; s < 8; ++s) dst[s] = *(const bf16x8*)(gq_ + s * 16); } while (0)
        {   const int c0 = dir ? 1 : 0, c1 = dir ? 0 : 1; RC_LOAD(c0); RC_WRITE(); RC_QLOAD(qa, c0); RC_LOAD(c1); }
        __syncthreads();
        for (int i = 0; i < 34; ++i) {
            const int c = dir ? ((i < 2) ? (1 - i) : (35 - i)) : i;
            const size_t r0 = (size_t)b * SS + c * 128;
            const int cn = (i + 1 < 34) ? (dir ? ((i + 1 < 2) ? (1 - (i + 1)) : (35 - (i + 1))) : (i + 1)) : c;
            unsigned short oiv[16];
            if (dh == 0 && dir == 0) { const bf16_t* ip = OI + (r0 + nb * 32 + 4 * hi) * 1024 + h * 256 + sl * 32 + r32;
#pragma unroll
                for (int r = 0; r < 16; ++r) oiv[r] = ip[(size_t)((r & 3) + 8 * (r >> 2)) * 1024]; }
            f32x16 oacc;
#pragma unroll
            for (int r = 0; r < 16; ++r) oacc[r] = 0.f;
            {   LAS unsigned char* sb = lds + RC_ST + r32 * RC_STP + (dh * 128 + hi * 8) * 2;
#pragma unroll
                for (int s = 0; s < 8; ++s) { const bf16x8 sbf = *(const LAS bf16x8*)(sb + s * 32);
                    oacc = __builtin_amdgcn_mfma_f32_32x32x16_bf16(qa[s], sbf, oacc, 0, 0, 0); } }
            asm volatile("" ::: "memory");
            RC_QLOAD(qa, cn);
#pragma unroll
            for (int r = 0; r < 16; ++r) sacc[r] *= cdec;
            {   LAS unsigned char* kp = lds + RC_KT + (8 * hi + q4) * RC_KTP + (wave * 32 + 16 * g1 + 4 * p4) * 2;
                LAS unsigned char* vp = lds + RC_VT + (8 * hi + q4) * RC_VTP + (16 * g1 + 4 * p4) * 2;
#pragma unroll
                for (int s = 0; s < 8; ++s) sacc = __builtin_amdgcn_mfma_f32_32x32x16_bf16(tr2(kp + s * 16 * RC_KTP, kp + (s * 16 + 4) * RC_KTP), tr2(vp + s * 16 * RC_VTP, vp + (s * 16 + 4) * RC_VTP), sacc, 0, 0, 0); }
            if (dh == 1) {
#pragma unroll
                for (int r = 0; r < 16; ++r) *(LAS float*)(lds + RC_XO + nb * 4096 + r * 256 + lane * 4) = oacc[r]; }
            __syncthreads();
            if (dh == 0) {
                bf16_t* op = (dir ? OB : OI) + (r0 + nb * 32 + 4 * hi) * 1024 + h * 256 + sl * 32 + r32;
#pragma unroll
                for (int r = 0; r < 16; ++r) { const int n = nb * 32 + crow(r, hi);
                    const float qd = dir ? EX2(lg * (float)(128 - n)) : EX2(lg * (float)(n + 1));
                    float v = (oacc[r] + *(const LAS float*)(lds + RC_XO + nb * 4096 + r * 256 + lane * 4)) * qd;
                    if (dir == 0) v += bf2f(oiv[r]);
                    *op = (bf16_t)f2bf(v);
                    op += ((r & 3) == 3) ? 5 * 1024 : 1024; OPAQ_G(op); }
            }
            {   LAS unsigned char* sp = lds + RC_ST + r32 * RC_STP + (wave * 32 + 4 * hi) * 2;
#pragma unroll
                for (int g = 0; g < 4; ++g) { u32x2 o2; o2.x = pg8::cvt_pk_bf16(sacc[4 * g], sacc[4 * g + 1]); o2.y = pg8::cvt_pk_bf16(sacc[4 * g + 2], sacc[4 * g + 3]); *(LAS u32x2*)(sp + g * 16) = o2; } }
            if (i + 1 < 34) RC_WRITE();
            if (i + 2 < 34) { const int c2 = dir ? ((i + 2 < 2) ? (1 - (i + 2)) : (35 - (i + 2))) : (i + 2); RC_LOAD(c2); }
            __syncthreads();
        }
#undef RC_QLOAD
#undef RC_LOAD
#undef RC_WRITE
    }
}
__device__ __forceinline__ void phase_ret_ln2(Ctx& C, int l, bf16_t* OI, const bf16_t* OB) {
    const float* gain = INP(16) + l * 1024;
    for (int m = C.gw; m < MR; m += C.ngw) {
#pragma unroll
        for (int h = 0; h < 4; ++h) { bf16_t* p = OI + (size_t)m * 1024 + h * 256 + C.lane * 4;
            const u32x2 w = *(const u32x2*)p, w2 = *(const u32x2*)(OB + (size_t)m * 1024 + h * 256 + C.lane * 4);
            float x0 = lo_bf(w.x) + lo_bf(w2.x), x1 = hi_bf(w.x) + hi_bf(w2.x), x2 = lo_bf(w.y) + lo_bf(w2.y), x3 = hi_bf(w.y) + hi_bf(w2.y);
            const float mean = wave_sum((x0 + x1) + (x2 + x3)) * (1.f / 256.f);
            x0 -= mean; x1 -= mean; x2 -= mean; x3 -= mean;
            const float var = wave_sum((x0 * x0 + x1 * x1) + (x2 * x2 + x3 * x3)) * (1.f / 256.f);
            const float rstd = RSQ(var + EPS);
            const f32x4 g = *(const f32x4*)(gain + h * 256 + C.lane * 4);
            u32x2 o; o.x = pk2(x0 * rstd * g.x, x1 * rstd * g.y); o.y = pk2(x2 * rstd * g.z, x3 * rstd * g.w); *(u32x2*)p = o; }
    }
}

constexpr int LR_UP = 272;
constexpr int LR_CP = 272;
constexpr int LR_U = 0, LR_LA = 128 * LR_UP, LR_BC = LR_LA + 128 * LR_CP, LR_Y0 = LR_BC + 128 * LR_CP, LR_XS = LR_Y0 + 128 * LR_CP, LR_END = LR_XS + 4096;
static_assert(LR_END <= 147456 - 1024, "fused LRU LDS");
__device__ __forceinline__ void phase_lru_fused(Ctx& C, int l, const bf16_t* XA, const bf16_t* WTL, bf16_t* Y0, f16_t* CAF, f16_t* CAB, float* SUM) {
    const int lane = C.lane, r32 = lane & 31, hi = lane >> 5, wave = C.wave, tid = C.tid;
    LAS unsigned char* lds = C.lds;
    const float* cw = INP(8) + l * 4 * 1024; const float* cb = INP(9) + l * 1024;
    const int rb = wave & 3, cgp = wave >> 2;
    for (int un = C.bid; un < NB * 8 * 34; un += C.G) {
        const int sg = un % 34, bn = un / 34, b = bn >> 3, n = bn & 7;
        const int R0 = b * SS + sg * 128, lo = (sg < 2) ? b * SS : b * SS + LC, hi_ = (sg < 2) ? b * SS + LC : (b + 1) * SS;
#pragma unroll
        for (int j = 0; j < 4; ++j) { const int item = tid + 512 * j, row = item >> 4, cc = item & 15, ch0 = n * 128 + cc * 8;
            float a[8];
            {   const f32x4 c0 = *(const f32x4*)(cb + ch0), c1 = *(const f32x4*)(cb + ch0 + 4); a[0] = c0[0]; a[1] = c0[1]; a[2] = c0[2]; a[3] = c0[3]; a[4] = c1[0]; a[5] = c1[1]; a[6] = c1[2]; a[7] = c1[3]; }
#pragma unroll
            for (int t = 0; t < 4; ++t) { const int rr = R0 + row + t - 2;
                const f32x4 wA = *(const f32x4*)(cw + t * 1024 + ch0), wB = *(const f32x4*)(cw + t * 1024 + ch0 + 4);
                if (rr >= lo && rr < hi_) { const u32x4 xv = *(const u32x4*)(XA + (size_t)rr * 1024 + ch0);
                    a[0] += wA[0] * lo_bf(xv.x); a[1] += wA[1] * hi_bf(xv.x); a[2] += wA[2] * lo_bf(xv.y); a[3] += wA[3] * hi_bf(xv.y);
                    a[4] += wB[0] * lo_bf(xv.z); a[5] += wB[1] * hi_bf(xv.z); a[6] += wB[2] * lo_bf(xv.w); a[7] += wB[3] * hi_bf(xv.w); } }
            *(LAS u32x4*)(lds + LR_U + row * LR_UP + cc * 16) = pack8u(a); }
        __syncthreads();
        bf16x8 af[8];
        {   LAS unsigned char* ua = lds + LR_U + (rb * 32 + r32) * LR_UP + hi * 16;
#pragma unroll
            for (int s = 0; s < 8; ++s) af[s] = *(const LAS bf16x8*)(ua + s * 32); }
        for (int d = 0; d < 2; ++d) {
            f32x16 aR[2], aI[2];
#pragma unroll
            for (int q = 0; q < 2; ++q)
#pragma unroll
                for (int r = 0; r < 16; ++r) { aR[q][r] = 0.f; aI[q][r] = 0.f; }
            {   const bf16_t* wb = WTL + ((size_t)d * 2048 + n * 256 + cgp * 64 + r32) * 256 + (n & 1) * 128 + hi * 8;
#pragma unroll
                for (int s = 0; s < 8; ++s) {
                    const bf16x8 b0 = *(const bf16x8*)(wb + s * 16), b1 = *(const bf16x8*)(wb + 32 * 256 + s * 16), b2 = *(const bf16x8*)(wb + 128 * 256 + s * 16), b3 = *(const bf16x8*)(wb + 160 * 256 + s * 16);
                    aR[0] = __builtin_amdgcn_mfma_f32_32x32x16_bf16(af[s], b0, aR[0], 0, 0, 0); aR[1] = __builtin_amdgcn_mfma_f32_32x32x16_bf16(af[s], b1, aR[1], 0, 0, 0);
                    aI[0] = __builtin_amdgcn_mfma_f32_32x32x16_bf16(af[s], b2, aI[0], 0, 0, 0); aI[1] = __builtin_amdgcn_mfma_f32_32x32x16_bf16(af[s], b3, aI[1], 0, 0, 0);
                    if ((s & 3) == 3) asm volatile("" ::: "memory"); } }
#pragma unroll
            for (int q = 0; q < 2; ++q) { const int chl = cgp * 64 + q * 32 + r32, ch = n * 128 + chl;
                const float bav = INP(11)[(l * 2 + d) * 1024 + ch], bxv = INP(13)[(l * 2 + d) * 1024 + ch], spv = C.ctl[CT_SP + (l * 2 + d) * 1024 + ch] * (-8.f);
#pragma unroll
                for (int g = 0; g < 4; ++g) { f16_t lav[4], bcv[4];
#pragma unroll
                    for (int e = 0; e < 4; ++e) { const int r = 4 * g + e, t = rb * 32 + crow(r, hi);
                        const float uu = bf2f(*(const LAS bf16_t*)(lds + LR_U + t * LR_UP + chl * 2));
                        const float rg = sigmoidf_(aR[q][r] + bav), ig = sigmoidf_(aI[q][r] + bxv);
                        const float loga = rg * spv, y2 = 2.f * loga;
                        const float om = -y2 * (1.f + y2 * 0.5f * (1.f + y2 * (1.f / 3.f) * (1.f + y2 * 0.25f * (1.f + y2 * 0.2f))));
                        const float bb = SQRT(fmaxf(om, 0.f)) * (ig * uu);
                        lav[e] = (f16_t)(loga * LOG2E); bcv[e] = (f16_t)bb; }
                    typedef f16_t f16x4 __attribute__((ext_vector_type(4)));
                    const int tb = rb * 32 + 8 * g + 4 * hi;
                    *(LAS f16x4*)(lds + LR_LA + chl * LR_CP + tb * 2) = (f16x4){lav[0], lav[1], lav[2], lav[3]};
                    *(LAS f16x4*)(lds + LR_BC + chl * LR_CP + tb * 2) = (f16x4){bcv[0], bcv[1], bcv[2], bcv[3]}; } }
            __syncthreads();
            const int chl = tid & 127, sub = tid >> 7;
            const int tlo = d ? (96 - sub * 32) : (sub * 32);
            f16x8 lv[4], bv[4];
#pragma unroll
            for (int k = 0; k < 4; ++k) { lv[k] = *(const LAS f16x8*)(lds + LR_LA + chl * LR_CP + tlo * 2 + k * 16); bv[k] = *(const LAS f16x8*)(lds + LR_BC + chl * LR_CP + tlo * 2 + k * 16); }
            float av[32], hv[32];
            float A = 1.f, H = 0.f;
#define LR_P1(DD) do { _Pragma("unroll") for (int i = 0; i < 32; ++i) { constexpr int dd_ = DD; const int j = dd_ ? (31 - i) : i; \
                av[j] = EX2((float)lv[j >> 3][j & 7]); H = av[j] * H + (float)bv[j >> 3][j & 7]; A *= av[j]; } } while (0)
            if (d) LR_P1(1); else LR_P1(0);
#undef LR_P1
            *(LAS f32x2*)(lds + LR_XS + (sub * 128 + chl) * 8) = (f32x2){A, H};
            __syncthreads();
            {   A = 1.f; H = 0.f;
                for (int p = 0; p < sub; ++p) { const f32x2 v = *(const LAS f32x2*)(lds + LR_XS + (p * 128 + chl) * 8); H = v.x * H + v.y; A *= v.x; }
                f16_t* cap = (d ? CAB : CAF) + (size_t)(R0 + tlo) * 1024 + n * 128 + chl;
                bf16_t* y0p = Y0 + (size_t)(R0 + tlo) * 1024 + n * 128 + chl;
                LAS unsigned char* ys = lds + LR_Y0 + chl * LR_CP + tlo * 2;
#define LR_P2(DD) do { _Pragma("unroll") for (int i = 0; i < 32; ++i) { constexpr int dd_ = DD; const int j = dd_ ? (31 - i) : i; \
                H = av[j] * H + (float)bv[j >> 3][j & 7]; A *= av[j]; cap[(size_t)j * 1024] = (f16_t)A; hv[j] = H; } } while (0)
                if (d == 0) { LR_P2(0);
#pragma unroll
                    for (int k = 0; k < 4; ++k) { u32x4 w; w.x = pk2(hv[8 * k], hv[8 * k + 1]); w.y = pk2(hv[8 * k + 2], hv[8 * k + 3]); w.z = pk2(hv[8 * k + 4], hv[8 * k + 5]); w.w = pk2(hv[8 * k + 6], hv[8 * k + 7]); *(LAS u32x4*)(ys + k * 16) = w; }
                } else { LR_P2(1);
#pragma unroll
                    for (int k = 0; k < 4; ++k) { const u32x4 yv = *(const LAS u32x4*)(ys + k * 16); float y[8]; unpack8(yv, y);
#pragma unroll
                        for (int e = 0; e < 8; ++e) y0p[(size_t)(8 * k + e) * 1024] = (bf16_t)f2bf(y[e] + hv[8 * k + e]); }
                }
#undef LR_P2
                if (sub == 3) *(f32x2*)(SUM + ((size_t)((d * NB + b) * 34 + sg) * 1024 + n * 128 + chl) * 2) = (f32x2){A, H}; }
            __syncthreads();
        }
    }
    {   const int first = (C.G > 64) ? 64 : 0;
        if (C.bid >= first) { Ctx C2 = C; C2.gw = (C.bid - first) * NWAVES + C.wave; C2.ngw = (C.G - first) * NWAVES; C2.rot = 0; phase_wconv_late(C2, l); } }
}
__device__ __forceinline__ void phase_lru_carry(Ctx& C, const float* SUM, float* HIN) {
    const int gt = C.bid * NTHR + C.tid, ngt = C.G * NTHR;
    for (int it = gt; it < 2 * NB * 1024; it += ngt) { const int ch = it & 1023, b = (it >> 10) & 3, d = it >> 12;
        const float* sp = SUM + ((size_t)((d * NB + b) * 34) * 1024 + ch) * 2; float* hp = HIN + (size_t)((d * NB + b) * 34) * 1024 + ch;
        f32x2 v[34];
#pragma unroll
        for (int p = 0; p < 34; ++p) v[p] = *(const f32x2*)(sp + (size_t)p * 2048);
        float h = 0.f;
        if (d == 0) {
#pragma unroll
            for (int p = 0; p < 34; ++p) { hp[(size_t)p * 1024] = h; h = v[p].x * h + v[p].y; }
        } else {
#pragma unroll
            for (int p = 0; p < 34; ++p) { const int ps = (p < 2) ? (1 - p) : (35 - p); hp[(size_t)ps * 1024] = h; h = v[ps].x * h + v[ps].y; }
        }
    }
}

#ifdef PROBE_TS
#define GSYNC(g) do { { GASP unsigned char* w_ = (GASP unsigned char*)prm.ws; asm volatile("" : "+s"(w_)); xcd_barrier((unsigned*)(unsigned char*)(w_ + WS_BAR), (volatile LAS unsigned*)(ldsb + LDS_ST)); } if (blockIdx.x == 0 && threadIdx.x == 0) { unsigned long long* ts_ = (unsigned long long*)(prm.ws + 8192); const unsigned long long now_ = __builtin_amdgcn_s_memrealtime(); \
    ts_[1 + (g)] += now_ - ts_[0]; ts_[0] = now_; } } while (0)
#else
#define GSYNC(g) do { GASP unsigned char* w_ = (GASP unsigned char*)prm.ws; asm volatile("" : "+s"(w_)); xcd_barrier((unsigned*)(unsigned char*)(w_ + WS_BAR), (volatile LAS unsigned*)(ldsb + LDS_ST)); } while (0)
#endif
#define CTX Ctx C = mkctx(ldsb)
#define WSB wsp_(C.ws)
#define bYB ((bf16_t*)(WSB + AR_YB))
#define bXA ((bf16_t*)(WSB + AR_XA))
#define bMD ((bf16_t*)(WSB + AR_MD))
#define bRQKV ((bf16_t*)(WSB + AR_RQKV))
#define bKV ((bf16_t*)(WSB + AR_KV))
#define bQN ((bf16_t*)(WSB + AR_QN))
#define bQP ((bf16_t*)(WSB + AR_QP))
#define bRI ((f16_t*)(WSB + AR_RI))
#define bSUM ((float*)(WSB + AR_SUM))
#define bOB ((bf16_t*)(WSB + AR_OB))
#define bZ ((bf16_t*)(WSB + AR_Z))
#define xc1 ((float*)(WSB + WS_XC1))
template <int l> __device__ __forceinline__ void run_layer(const Params& prm, LAS unsigned char* ldsb) {
        const bool with_ctx = (l == 0); const int lat_only = with_ctx ? 0 : 1;
        { CTX; phase_wconv_early(C, l); }
        if (l == 0) GSYNC(0);
        { CTX; phase_h2(C, l, bYB); }
        GSYNC(1);
        {   CTX;
            ProbPlain P{bYB, (const bf16_t*)(WSB + W_WT1), 1024, 1024, 1024};
            pg8::StaticOrder S; S.init(68, 19, C.G, C.bid, 0);
            EpiG1 E{WSB, C.ctl + CT_ROPER};
            pg8::gemm_phase<EpiG1, ProbPlain, pg8::StaticOrder, true>(C.lds, P, S, E);
        }
        GSYNC(2);
        { CTX; phase_ret_intra(C, l, bRQKV, bYB); }
        { CTX; phase_md_post2(C, l, bMD); }
        GSYNC(4);
        { CTX; phase_ret_chain(C, l, bRQKV, bYB, bOB); }
        GSYNC(5);
        { CTX; phase_ret_ln3(C, l, bYB, bOB); }
        {   CTX; ProbPlain P{bMD, (const bf16_t*)(WSB + W_WTQ), 768, 384, 384};
            pg8::StaticOrder S; S.init(68, 6, C.G, C.bid, 0);
            typedef EpiStore3<AR_QN, 1024, AR_QP, 512, AR_QP, 512, 4, 6> Ep; Ep E{WSB};
            pg8::gemm_phase<Ep, ProbPlain, pg8::StaticOrder, true>(C.lds, P, S, E);
        }
        {   CTX; ProbPlain P{bMD + 384, (const bf16_t*)(WSB + W_WTKV), 768, 256, 256};
            pg8::StaticOrder S; S.init(68, 8, C.G, C.bid, 0);
            EpiKV E{WSB, INP(23) + l * 128, (LAS float*)(C.lds + 131072)};
            pg8::gemm_phase<EpiKV, ProbPlain, pg8::StaticOrder, true>(C.lds, P, S, E);
        }
        GSYNC(6);
        { CTX; phase_attn(C, l, with_ctx, bQN, bQP, bKV, bMD); }
        GSYNC(8);
        { CTX; phase_lru_fused(C, l, bXA, (const bf16_t*)(WSB + W_WTL), (bf16_t*)(WSB + AR_Y0), (f16_t*)(WSB + AR_CAF), (f16_t*)(WSB + AR_CAB), bSUM); }
        GSYNC(9);
        { CTX; phase_lru_carry(C, bSUM, (float*)(WSB + AR_HIN)); }
        { CTX; phase_h2(C, l, bXA  ); }
        GSYNC(13);
        {   CTX; ProbPlain P{bXA, (const bf16_t*)(WSB + W_WTG), 1024, 1024, 1024};
            pg8::StaticOrder S; S.init(lat_only ? 64 : 68, 12, C.G, C.bid, lat_only);
            EpiGate E{WSB};
            pg8::gemm_phase<EpiGate, ProbPlain, pg8::StaticOrder, true>(C.lds, P, S, E);
        }
        GSYNC(14);
        {   CTX; ProbD P{WSB, 1024, 1024};
            pg8::ChainOrder S; S.init(C.G, C.bid, with_ctx ? 1 : 0);
            EpiD E{bZ, WSB + AR_GS + (size_t)C.bid * 131072, (bf16_t*)(WSB + AR_ZP)};
            pg8::gemm_phase<EpiD, ProbD, pg8::ChainOrder, true>(C.lds, P, S, E);
        }
        GSYNC(15);
        if (with_ctx) { { CTX; phase_zsum(C, (const bf16_t*)(WSB + AR_ZP), bZ); } GSYNC(12); }
        {   CTX; ProbPlain P{bZ, (const bf16_t*)(WSB + W_WTO), 1024, 1024, 1024};
            pg8::StaticOrder S; S.init(lat_only ? 64 : 68, 4, C.G, C.bid, lat_only);
            EpiOut E{(l == 0) ? INP(0) : (const float*)C.out, INP(2), C.out, xc1, C.ctl + CT_MOD + l * 5 * 3072};
            pg8::gemm_phase<EpiOut, ProbPlain, pg8::StaticOrder, true>(C.lds, P, S, E);
        }
        GSYNC(16);
    }

__global__ void __launch_bounds__(NTHR) fwd_kernel(Params prm) {
    extern __shared__ __attribute__((aligned(16))) unsigned char lds_raw[];
    cg::grid_group grid = cg::this_grid();
    LAS unsigned char* const ldsb = (LAS unsigned char*)lds_raw;
    if (threadIdx.x < 16) ((LAS unsigned*)(ldsb + LDS_ST))[threadIdx.x] = 0u;
    __syncthreads();
    if (threadIdx.x == 0) (void)xb_add(&((unsigned*)(prm.ws + WS_BAR))[XB_XCNT(xb_xcc_id())], 1u);
    grid.sync();


#ifdef PROBE_TS
    if (blockIdx.x == 0 && threadIdx.x == 0) { unsigned long long* ts_ = (unsigned long long*)(prm.ws + 8192); for (int i = 1; i < 32; ++i) ts_[i] = 0ull; ts_[0] = __builtin_amdgcn_s_memrealtime(); }
#endif
    { CTX; phase_prep(C); }
    run_layer<0>(prm, ldsb);
    run_layer<1>(prm, ldsb);
#ifdef PROBE_TS
    if (blockIdx.x == 0 && threadIdx.x == 0) { const unsigned long long* ts_ = (const unsigned long long*)(prm.ws + 8192); unsigned long long tot = 0ull;
        for (int g = 0; g < 17; ++g) if ((PROBE_TS >> g) & 1u) tot += ts_[1 + g];
        prm.out[0] += (float)(((tot / 100ull) + PROBE_Q / 2) / PROBE_Q * PROBE_Q); }
#endif
}

#undef xc1
#undef bZ
extern "C" void kernel_launch(void* const* d_in, const int* in_sizes, int n_in, void* d_out, int out_size, void* d_ws, size_t ws_size, hipStream_t stream) {
    static int grid = 0;
    if (grid == 0) {
        if (n_in != 29 || out_size != NB * TT * DM || ws_size < WS_END) { fprintf(stderr, "kernel_launch: unexpected shapes (n_in %d out %d ws %zu)\n", n_in, out_size, ws_size); grid = -1; return; }
        int dev = 0, cus = 0, per_cu = 0;
        hipGetDevice(&dev);
        hipDeviceGetAttribute(&cus, hipDeviceAttributeMultiprocessorCount, dev);
        if (hipFuncSetAttribute((const void*)fwd_kernel, hipFuncAttributeMaxDynamicSharedMemorySize, LDS_BYTES) != hipSuccess) { fprintf(stderr, "kernel_launch: hipFuncSetAttribute failed\n"); grid = -1; return; }
        if (hipOccupancyMaxActiveBlocksPerMultiprocessor(&per_cu, (const void*)fwd_kernel, NTHR, LDS_BYTES) != hipSuccess || per_cu < 1) { fprintf(stderr, "kernel_launch: occupancy query failed (%d)\n", per_cu); (void)hipGetLastError(); per_cu = 1; }
        grid = cus;
        fprintf(stderr, "kernel_launch: cus %d per_cu %d grid %d\n", cus, per_cu, grid);
    }
    if (grid < 0) return;
    if (hipMemsetAsync((char*)d_ws + WS_BAR, 0, XCD_BAR_WORDS * 4, stream) != hipSuccess) { fprintf(stderr, "kernel_launch: memset failed\n"); return; }
    Params p{};
    for (int i = 0; i < 29; ++i) p.in[i] = (const float*)d_in[i];
    p.out = (float*)d_out; p.ws = (unsigned char*)d_ws;
    void* args[] = {&p};
    hipError_t e = hipLaunchCooperativeKernel((const void*)fwd_kernel, dim3(grid), dim3(NTHR), args, LDS_BYTES, stream);
    if (e != hipSuccess) fprintf(stderr, "cooperative launch failed: %s (grid %d)\n", hipGetErrorString(e), grid);
}
```

```cpp
#include <hip/hip_runtime.h>
#include <hip/hip_cooperative_groups.h>
#include <cstdio>
#include <cstdint>
namespace cg = cooperative_groups;

#define LAS __attribute__((address_space(3)))
typedef unsigned short bf16_t;
typedef short bf16x8 __attribute__((ext_vector_type(8)));
typedef float f32x4 __attribute__((ext_vector_type(4)));
typedef float f32x2 __attribute__((ext_vector_type(2)));
typedef unsigned u32x4 __attribute__((ext_vector_type(4)));
typedef unsigned u32x2 __attribute__((ext_vector_type(2)));
typedef _Float16 f16_t;

namespace pg8 {
constexpr int BM = 256, BK = 64, HALF = 128, HTB = HALF * BK * 2, STAGE_BYTES = 8 * HTB, NXCD = 8, WGM = 8;
__host__ __device__ __forceinline__ int lds_byte(int r, int c) { const int st = (r >> 4) * 2 + (c >> 5), rr = r & 15, cc = c & 31, ob = rr * 64 + cc * 2; return st * 1024 + (ob ^ (((ob >> 9) & 1) << 5)); }
__host__ __device__ __forceinline__ void stage_rc(int b, int& R, int& C) { const int st = b / 1024, sb = b % 1024, swz = sb ^ (((sb >> 9) & 1) << 5); R = (st >> 1) * 16 + swz / 64; C = (st & 1) * 32 + (swz % 64) / 2; }
__host__ __device__ __forceinline__ int perm32(int rho) { const int n = rho >> 4, i = rho & 15; return 8 * (i >> 2) + 4 * n + (i & 3); }

struct Unit { int pm, pn, z; };

struct StaticOrder {
    int nM, nN, nwg, G, c, latent_only;
    __device__ void init(int nM_, int nN_, int G_, int c_, int latent_only_) { nM = nM_; nN = nN_; nwg = nM * nN; G = G_; c = c_; latent_only = latent_only_; }
    __device__ bool next(int i, Unit& u) const {
        const long L = (long)i * G + c; if (L >= nwg) return false;
        int wgid = (int)L; { const int q = nwg / NXCD, r = nwg % NXCD, xcd = wgid % NXCD, off = wgid / NXCD; wgid = (xcd < r ? xcd * (q + 1) : r * (q + 1) + (xcd - r) * q) + off; }
        const int nig = WGM * nN, gid = wgid / nig, fm = gid * WGM, gsz = (nM - fm) < WGM ? (nM - fm) : WGM;
        int pm = fm + ((wgid % nig) % gsz); u.pn = (wgid % nig) / gsz; u.z = 0;
        if (latent_only) pm = (pm >> 4) * 17 + 1 + (pm & 15);
        u.pm = pm; return true;
    }
};
struct ChainOrder {
    int G, c, with_ctx;
    __device__ void init(int G_, int c_, int with_ctx_) { G = G_; c = c_; with_ctx = with_ctx_; }
    __device__ bool next(int i, Unit& u) const {
        if (i < 6) { const int T = c; if (T >= 256) return false; int pm = T >> 2; u.pn = T & 3; u.z = i; u.pm = (pm >> 4) * 17 + 1 + (pm & 15); return true; }
        if (i < 8 && with_ctx && c < 48) { const int ct = c / 3, br = c - ct * 3; u.pm = (ct >> 2) * 17; u.pn = ct & 3; u.z = 8 + 2 * br + (i - 6); return true; }
        return false;
    }
};

typedef __bf16 bf16x2_t __attribute__((ext_vector_type(2)));
__device__ __forceinline__ unsigned cvt_pk_bf16(float lo, float hi) { f32x2 v = {lo, hi}; bf16x2_t b = __builtin_convertvector(v, bf16x2_t); return __builtin_bit_cast(unsigned, b); }

template <class Epi, class Prob, class Sched, bool ALIGN_EPI>
__device__ __forceinline__ void gemm_phase(LAS unsigned char* lds, const Prob& P, const Sched& S, const Epi& E) {
    int tid_ = threadIdx.x; asm volatile("" : "+v"(tid_));
    const int tid = tid_, wid = __builtin_amdgcn_readfirstlane(tid >> 6), lane = tid & 63, wr = wid >> 2, wc = wid & 3, fr = lane & 15, fq = lane >> 4;
    const int K = P.K, nt = K / BK;
    int RA[2], CA[2]; unsigned voffB[2];
#pragma unroll
    for (int i = 0; i < 2; ++i) { int R, C; stage_rc(tid * 16 + i * 8192, R, C); const int Rb = Epi::PERM ? ((R & ~31) + perm32(R & 31)) : R;
        RA[i] = R; CA[i] = C; voffB[i] = (unsigned)(Rb * P.ldb + C) * 2u; }
    const unsigned kstep = (unsigned)(BK * 2);
    const unsigned hstepB = (unsigned)(HALF * P.ldb * 2);
    const unsigned ldsw = (unsigned)wid * 1024u;
    const int aoff = lds_byte(wr * 64 + fr, fq * 8), boff = lds_byte(wc * 32 + fr, fq * 8);
#define PG8_SA(b, h) (((b) * 2 + (h)) * HTB)
#define PG8_SB(b, h) ((4 + (b) * 2 + (h)) * HTB)
#define PG8_STAGE(bufoff, gbase, soff, voff) do { _Pragma("unroll") for (int _i = 0; _i < 2; ++_i) \
        __builtin_amdgcn_global_load_lds((const unsigned*)((const char*)(gbase) + (unsigned)((voff)[_i] + (soff))), (LAS unsigned*)(lds + (bufoff) + ldsw + _i * 8192), 16, 0, 0); } while (0)
#define PG8_LDA(dst, b, h) do { _Pragma("unroll") for (int m = 0; m < 4; ++m) _Pragma("unroll") for (int k = 0; k < 2; ++k) dst[m][k] = *(const LAS bf16x8*)(lds + PG8_SA(b, h) + aoff + m * 2048 + k * 1024); } while (0)
#define PG8_LDB(dst, b, h) do { _Pragma("unroll") for (int n = 0; n < 2; ++n) _Pragma("unroll") for (int k = 0; k < 2; ++k) dst[n][k] = *(const LAS bf16x8*)(lds + PG8_SB(b, h) + boff + n * 2048 + k * 1024); } while (0)
#define PG8_MMA(ai, bj, At, Bt) do { __builtin_amdgcn_s_setprio(1); _Pragma("unroll") for (int m = 0; m < 4; ++m) _Pragma("unroll") for (int n = 0; n < 2; ++n) _Pragma("unroll") for (int k = 0; k < 2; ++k) \
        acc[ai][bj][m][n] = __builtin_amdgcn_mfma_f32_16x16x32_bf16(Bt[n][k], At[m][k], acc[ai][bj][m][n], 0, 0, 0); __builtin_amdgcn_s_setprio(0); } while (0)
#define PG8_WAIT_V(n) asm volatile("s_waitcnt vmcnt(" #n ")" ::: "memory")
#define PG8_WAIT_L(n) asm volatile("s_waitcnt lgkmcnt(" #n ")" ::: "memory")
#define PG8_BAR __builtin_amdgcn_s_barrier()
#define PG8_SCHED __builtin_amdgcn_sched_barrier(0)
    Unit cur, nxt; int ui = 0;
    if (!S.next(0, cur)) return;
    f32x4 acc[2][2][4][2];
#pragma unroll
    for (int a = 0; a < 2; ++a)
#pragma unroll
        for (int b = 0; b < 2; ++b)
#pragma unroll
            for (int m = 0; m < 4; ++m)
#pragma unroll
                for (int n = 0; n < 2; ++n) acc[a][b][m][n] = (f32x4){0.f, 0.f, 0.f, 0.f};
    bf16x8 At[4][2], B0[2][2], B1[2][2];
    const char* cA; const char* cB; int ldaC; P.get(cur, cA, cB, ldaC);
    unsigned voffA[2] = {(unsigned)(RA[0] * ldaC + CA[0]) * 2u, (unsigned)(RA[1] * ldaC + CA[1]) * 2u};
    unsigned hstepA = (unsigned)(HALF * ldaC * 2);
    PG8_STAGE(PG8_SB(0, 0), cB, 0u, voffB); PG8_STAGE(PG8_SB(0, 1), cB, hstepB, voffB); PG8_STAGE(PG8_SA(0, 0), cA, 0u, voffA); PG8_STAGE(PG8_SA(0, 1), cA, hstepA, voffA);
    if (wr == 1) PG8_BAR;
    PG8_WAIT_V(2); PG8_BAR;
    PG8_STAGE(PG8_SB(1, 0), cB, kstep, voffB); PG8_STAGE(PG8_SA(1, 0), cA, kstep, voffA); PG8_STAGE(PG8_SB(1, 1), cB, hstepB + kstep, voffB);
    PG8_WAIT_V(6); PG8_BAR;
    for (;;) {
        const bool has_next = S.next(ui + 1, nxt);
        const char* nA = cA; const char* nB = cB; int ldaN = ldaC;
        if (has_next) P.get(nxt, nA, nB, ldaN);
        unsigned voffAn[2] = {(unsigned)(RA[0] * ldaN + CA[0]) * 2u, (unsigned)(RA[1] * ldaN + CA[1]) * 2u};
        const unsigned hstepAn = (unsigned)(HALF * ldaN * 2);
        for (int t = 0; t < nt; t += 2) {
            const bool last = (t == nt - 2);
            const unsigned o1 = (unsigned)(t + 1) * kstep;
            const char* a2b = last ? nA : cA; const char* b2b = last ? nB : cB;
            const unsigned o2 = last ? 0u : (unsigned)(t + 2) * kstep, o3 = o2 + kstep;
            unsigned vA2[2] = {last ? voffAn[0] : voffA[0], last ? voffAn[1] : voffA[1]};
            const unsigned hA2 = last ? hstepAn : hstepA;
            PG8_LDB(B0, 0, 0); PG8_LDB(B1, 0, 1); PG8_SCHED; PG8_LDA(At, 0, 0); PG8_STAGE(PG8_SA(1, 1), cA, o1 + hstepA, voffA);
            PG8_WAIT_V(8); PG8_WAIT_L(0); PG8_BAR; PG8_MMA(0, 0, At, B0); PG8_MMA(0, 1, At, B1); PG8_BAR; PG8_SCHED;
            PG8_LDA(At, 0, 1); PG8_STAGE(PG8_SB(0, 0), b2b, o2, voffB); PG8_STAGE(PG8_SB(0, 1), b2b, o2 + hstepB, voffB); PG8_STAGE(PG8_SA(0, 0), a2b, o2, vA2);
            PG8_WAIT_V(8); PG8_WAIT_L(0); PG8_BAR; PG8_MMA(1, 0, At, B0); PG8_MMA(1, 1, At, B1); PG8_BAR; PG8_SCHED;
            PG8_LDB(B0, 1, 0); PG8_LDB(B1, 1, 1); PG8_SCHED; PG8_LDA(At, 1, 0); PG8_STAGE(PG8_SA(0, 1), a2b, o2 + hA2, vA2);
            PG8_WAIT_V(8); PG8_WAIT_L(0); PG8_BAR; PG8_MMA(0, 0, At, B0); PG8_MMA(0, 1, At, B1); PG8_BAR; PG8_SCHED;
            PG8_LDA(At, 1, 1); PG8_STAGE(PG8_SB(1, 0), b2b, o3, voffB); PG8_STAGE(PG8_SB(1, 1), b2b, o3 + hstepB, voffB); PG8_STAGE(PG8_SA(1, 0), a2b, o3, vA2);
            PG8_WAIT_V(8); PG8_WAIT_L(0); PG8_BAR; PG8_MMA(1, 0, At, B0); PG8_MMA(1, 1, At, B1); PG8_BAR; PG8_SCHED;
        }
        if constexpr (ALIGN_EPI) { if (wr == 0) PG8_BAR; }
        E(acc, cur, wr, wc, fr, fq);
        if (!has_next) break;
#pragma unroll
        for (int a = 0; a < 2; ++a)
#pragma unroll
            for (int b = 0; b < 2; ++b)
#pragma unroll
                for (int m = 0; m < 4; ++m)
#pragma unroll
                    for (int n = 0; n < 2; ++n) acc[a][b][m][n] = (f32x4){0.f, 0.f, 0.f, 0.f};
        cur = nxt; cA = nA; cB = nB; ldaC = ldaN; voffA[0] = voffAn[0]; voffA[1] = voffAn[1]; hstepA = hstepAn; ++ui;
        if constexpr (ALIGN_EPI) { if (wr == 1) PG8_BAR; }
    }
    PG8_WAIT_V(0);
    if constexpr (!ALIGN_EPI) { if (wr == 0) PG8_BAR; }
    PG8_BAR;
#undef PG8_SA
#undef PG8_SB
#undef PG8_STAGE
#undef PG8_LDA
#undef PG8_LDB
#undef PG8_MMA
#undef PG8_WAIT_V
#undef PG8_WAIT_L
#undef PG8_BAR
#undef PG8_SCHED
}
}

constexpr int NB = 4, TT = 4096, LC = 256, SS = TT + LC  , DM = 1024, MR = NB * SS  ;
constexpr int INC = 10944;
constexpr float EPS = 1e-6f;
constexpr float LOG2E = 1.4426950408889634f;
constexpr float QSCALE = 0.07216878364870322f * 1.4426950408889634f;
constexpr int NWAVES = 8, NTHR = 512;

constexpr size_t MiB = 1u << 20;
constexpr size_t WS_CTL = 0;
constexpr size_t WS_XC1 = 1 * MiB;
constexpr size_t WS_W = 5 * MiB;
constexpr size_t WS_AR = 25 * MiB;
constexpr size_t AR_YB = WS_AR + 0 * MiB;
constexpr size_t AR_XA = WS_AR + 34 * MiB;
constexpr size_t AR_MD = WS_AR + 68 * MiB;
constexpr size_t AR_RQKV = WS_AR + 94 * MiB;
constexpr size_t AR_OB = WS_AR + 196 * MiB;
constexpr size_t AR_KV = WS_AR + 112 * MiB;
constexpr size_t AR_QN = WS_AR + 180 * MiB;
constexpr size_t AR_QP = WS_AR + 214 * MiB;
constexpr size_t AR_RI = WS_AR + 102 * MiB;
constexpr size_t AR_Y0 = WS_AR + 68 * MiB;
constexpr size_t AR_CAF = WS_AR + 102 * MiB;
constexpr size_t AR_CAB = WS_AR + 136 * MiB;
constexpr size_t AR_SUM = WS_AR + 170 * MiB;
constexpr size_t AR_Z = WS_AR + 102 * MiB;
constexpr size_t AR_HIN = WS_AR + 176 * MiB;
constexpr size_t AR_ZP = WS_AR + 170 * MiB;
constexpr size_t AR_GS = WS_AR + 136 * MiB;
constexpr size_t WS_END = 256 * MiB;
constexpr size_t W_WT1 = WS_W;
constexpr size_t W_WTQ = WS_W + 10 * MiB;
constexpr size_t W_WTKV = WS_W + 12 * MiB;
constexpr size_t W_WTL = WS_W + 18 * MiB;
constexpr size_t W_WTG = WS_W;
constexpr size_t W_WTGM = WS_W + 6 * MiB;
constexpr size_t W_WTD = WS_W + 12 * MiB;
constexpr size_t W_WTO = WS_AR + 178 * MiB;
constexpr int CT_MOD = 16384;
constexpr int CT_ROPER = CT_MOD + 2 * 5 * 3072;
constexpr int CT_ROPEM = CT_ROPER + 2 * 4096;
constexpr int CT_SP = CT_ROPEM + 2 * 1024;
constexpr int CT_LG = CT_SP + 4096;
constexpr int CT_END = CT_LG + 16;
static_assert(CT_END * 4 <= (int)MiB, "CTL");

constexpr int LDS_BYTES = 147456;


#define XB_TMO      128
#define XB_XCNT(j)  (256  + 64 * (j))
#define XB_XSUB(j)  (1280 + 64 * (j))
#define XB_XGEN(j)  (2304 + 64 * (j))
#define XB_TOP      3328
#define XB_TOPGEN   3392
#define XCD_BAR_WORDS 3456
#define XB_SPIN_CAP (1u << 18)
constexpr size_t WS_BAR = 16384;
constexpr int LDS_ST = LDS_BYTES - 64;
__device__ __forceinline__ unsigned xb_ld(unsigned* p)              { return __hip_atomic_load(p, __ATOMIC_RELAXED, __HIP_MEMORY_SCOPE_AGENT); }
__device__ __forceinline__ unsigned xb_add(unsigned* p, unsigned v) { return __hip_atomic_fetch_add(p, v, __ATOMIC_RELAXED, __HIP_MEMORY_SCOPE_AGENT); }
__device__ __forceinline__ unsigned xb_xcc_id() { return (unsigned)__builtin_amdgcn_s_getreg((3 << 11) | 20) & 0xFu; }
#define XB_SPIN(cond, bar) do { unsigned _sp = 0; while (cond) { __builtin_amdgcn_s_sleep(1); \
    if ((++_sp & 255u) == 0u) { if (xb_ld(&(bar)[XB_TMO])) break; if (_sp > XB_SPIN_CAP) { atomicAdd(&(bar)[XB_TMO], 1u); break; } } } } while (0)
__device__ __forceinline__ void xcd_barrier_complete(unsigned* bar, unsigned x, unsigned& nloc, unsigned& nx) {
    const unsigned G = gridDim.x * gridDim.y * gridDim.z;
    unsigned sum, cnt, mine, sp = 0u;
    for (;;) {
        sum = 0u; cnt = 0u; mine = 0u;
#pragma unroll
        for (unsigned j = 0; j < 16; ++j) { const unsigned c = xb_ld(&bar[XB_XCNT(j)]); sum += c; cnt += (c > 0u) ? 1u : 0u; mine = (j == x) ? c : mine; }
        if (sum == G) break;
        __builtin_amdgcn_s_sleep(1);
        if ((++sp & 255u) == 0u) { if (xb_ld(&bar[XB_TMO])) break; if (sp > XB_SPIN_CAP) { atomicAdd(&bar[XB_TMO], 1u); break; } }
    }
    nloc = mine > 0u ? mine : 1u; nx = cnt > 0u ? cnt : 1u;
}
__device__ __forceinline__ void xcd_barrier(unsigned* bar, volatile LAS unsigned* st) {
    asm volatile("s_waitcnt vmcnt(0)" ::: "memory");
    __syncthreads();
    if (threadIdx.x == 0) {
        const unsigned x = xb_xcc_id();
        __builtin_amdgcn_s_waitcnt(0);
        unsigned nloc = st[0], nx = st[1];
        if (nloc == 0u) { xcd_barrier_complete(bar, x, nloc, nx); st[0] = nloc; st[1] = nx; }
        const unsigned old = xb_add(&bar[XB_XSUB(x)], 1u);
        const unsigned gen = old / nloc;
        if (old + 1u == (gen + 1u) * nloc) {
            __builtin_amdgcn_fence(__ATOMIC_RELEASE, "agent");
            asm volatile("s_waitcnt vmcnt(0)" ::: "memory");
            const unsigned og = xb_add(&bar[XB_TOP], 1u);
            const unsigned tg = og / nx;
            if (og + 1u == (tg + 1u) * nx) xb_add(&bar[XB_TOPGEN], 1u);
            else XB_SPIN(xb_ld(&bar[XB_TOPGEN]) == tg, bar);
            __builtin_amdgcn_fence(__ATOMIC_ACQUIRE, "agent");
            xb_add(&bar[XB_XGEN(x)], 1u);
            asm volatile("s_waitcnt vmcnt(0)" ::: "memory");
        } else {
            XB_SPIN(xb_ld(&bar[XB_XGEN(x)]) == gen, bar);
            __builtin_amdgcn_fence(__ATOMIC_ACQUIRE, "agent");
            asm volatile("s_waitcnt vmcnt(0)" ::: "memory");
        }
    }
    __syncthreads();
}

struct Params {
    const float* in[29];
    float* out;
    unsigned char* ws;
};

#define EX2(x) __builtin_amdgcn_exp2f(x)
#define RSQ(x) __builtin_amdgcn_rsqf(x)
#define SQRT(x) __builtin_amdgcn_sqrtf(x)
__device__ __forceinline__ float bf2f(unsigned v) { return __uint_as_float(v << 16); }
__device__ __forceinline__ unsigned f2bf(float f) { unsigned u = __float_as_uint(f); return (u + 0x7fffu + ((u >> 16) & 1u)) >> 16; }
__device__ __forceinline__ unsigned pk2(float lo, float hi) { return f2bf(lo) | (f2bf(hi) << 16); }
__device__ __forceinline__ float lo_bf(unsigned w) { return __uint_as_float(w << 16); }
__device__ __forceinline__ float hi_bf(unsigned w) { return __uint_as_float(w & 0xffff0000u); }
__device__ __forceinline__ float wave_sum(float v) {
#pragma unroll
    for (int o = 1; o < 64; o <<= 1) v += __shfl_xor(v, o);
    return v;
}
__device__ __forceinline__ float wave_max(float v) {
#pragma unroll
    for (int o = 1; o < 64; o <<= 1) v = fmaxf(v, __shfl_xor(v, o));
    return v;
}
__device__ __forceinline__ float sigmoidf_(float x) { return __builtin_amdgcn_rcpf(1.f + __expf(-x)); }
__device__ __forceinline__ float siluf_(float x) { return x * __builtin_amdgcn_rcpf(1.f + __expf(-x)); }

#define GASP __attribute__((address_space(1)))
__device__ __forceinline__ const float* inp_(int i) { asm volatile("" : "+s"(i)); const float* const* ka = (const float* const*)__builtin_amdgcn_kernarg_segment_ptr(); return (const float*)(const GASP float*)ka[i]; }
#define INP(i) inp_(i)
template <class T> __device__ __forceinline__ T* opaq_g_(T* p) { GASP T* g = (GASP T*)p; asm volatile("" : "+v"(g)); return (T*)g; }
#define OPAQ_G(p) ((p) = opaq_g_(p))
__device__ __forceinline__ unsigned char* wsp_(unsigned char* p) { GASP unsigned char* g = (GASP unsigned char*)p; asm volatile("" : "+s"(g)); return (unsigned char*)g; }
__device__ __forceinline__ void unpack8(const u32x4& w, float (&x)[8]) { x[0] = lo_bf(w.x); x[1] = hi_bf(w.x); x[2] = lo_bf(w.y); x[3] = hi_bf(w.y); x[4] = lo_bf(w.z); x[5] = hi_bf(w.z); x[6] = lo_bf(w.w); x[7] = hi_bf(w.w); }
__device__ __forceinline__ u32x4 pack8u(const float (&x)[8]) { u32x4 w; w.x = pk2(x[0], x[1]); w.y = pk2(x[2], x[3]); w.z = pk2(x[4], x[5]); w.w = pk2(x[6], x[7]); return w; }
__device__ __forceinline__ float sumsq8(const float (&x)[8]) { return ((x[0] * x[0] + x[1] * x[1]) + (x[2] * x[2] + x[3] * x[3])) + ((x[4] * x[4] + x[5] * x[5]) + (x[6] * x[6] + x[7] * x[7])); }

struct Ctx {
    float* out; unsigned char* ws; LAS unsigned char* lds; int tid, lane, wave, G, bid;
    int gw, ngw;
    int rot;
    float* ctl;
};

__device__ __forceinline__ Ctx mkctx(LAS unsigned char* lds) {
    Ctx C; int t = threadIdx.x; asm volatile("" : "+v"(t)); int b = blockIdx.x; asm volatile("" : "+s"(b)); int g = gridDim.x; asm volatile("" : "+s"(g));
    C.tid = t; C.lane = t & 63; C.wave = __builtin_amdgcn_readfirstlane(t >> 6); C.bid = b; C.G = g; C.gw = b * NWAVES + C.wave; C.ngw = g * NWAVES; C.rot = 0;
    int io = 29, iw = 30; asm volatile("" : "+s"(io)); asm volatile("" : "+s"(iw));
    unsigned char* const* ka = (unsigned char* const*)__builtin_amdgcn_kernarg_segment_ptr();
    C.out = (float*)(GASP float*)ka[io]; C.ws = (unsigned char*)(GASP unsigned char*)ka[iw]; C.ctl = (float*)(C.ws + WS_CTL); C.lds = lds;
    return C;
}
__device__ __forceinline__ const float* resid_row(const Ctx& C, int l, int m) {
    const int b = m / SS, s = m - b * SS;
    if (s < LC) { const float* base = (l == 0) ? INP(2) : (const float*)(C.ws + WS_XC1); return base + (size_t)(b * LC + s) * DM; }
    const float* base = (l == 0) ? INP(0) : C.out; return base + (size_t)(b * TT + (s - LC)) * DM;
}

__device__ __forceinline__ void phase_prep(Ctx& C) {
    LAS float* sl = (LAS float*)C.lds;
    LAS float* red = (LAS float*)(C.lds + 32768);
    for (int i = C.tid; i < 5 * 1024; i += NTHR) { const int r = i >> 10, k = i & 1023; const float v = (r < 4) ? INP(1)[r * 1024 + k] : INP(3)[k]; sl[i] = siluf_(v); }
    __syncthreads();
    for (int it = C.bid; it < 2 * 96; it += C.G) {
        const int l = it / 96, grp = it % 96, kg = C.tid >> 5, cj = C.tid & 31, col = grp * 32 + cj;
        const float* w = INP(4) + (size_t)l * 1024 * 3072 + col;
        float a0 = 0.f, a1 = 0.f, a2 = 0.f, a3 = 0.f, a4 = 0.f;
#pragma unroll 8
        for (int k = kg * 64; k < kg * 64 + 64; ++k) { const float wv = w[(size_t)k * 3072]; a0 += sl[k] * wv; a1 += sl[1024 + k] * wv; a2 += sl[2048 + k] * wv; a3 += sl[3072 + k] * wv; a4 += sl[4096 + k] * wv; }
        red[(kg * 32 + cj) * 5 + 0] = a0; red[(kg * 32 + cj) * 5 + 1] = a1; red[(kg * 32 + cj) * 5 + 2] = a2; red[(kg * 32 + cj) * 5 + 3] = a3; red[(kg * 32 + cj) * 5 + 4] = a4;
        __syncthreads();
        if (C.tid < 160) { const int c2 = C.tid / 5, r = C.tid % 5; float s = 0.f;
            for (int g = 0; g < 16; ++g) s += red[(g * 32 + c2) * 5 + r];
            C.ctl[CT_MOD + (l * 5 + r) * 3072 + grp * 32 + c2] = s + INP(5)[l * 3072 + grp * 32 + c2]; }
        __syncthreads();
    }
    const int gt = C.bid * NTHR + C.tid, ngt = C.G * NTHR;
    for (int i = gt; i < 4096; i += ngt) { const int pos = i >> 6, f = i & 63; const float inv = powf(10000.f, -(float)f / 64.f), ang = (float)pos * inv;
        C.ctl[CT_ROPER + i] = cosf(ang); C.ctl[CT_ROPER + 4096 + i] = sinf(ang); }
    for (int i = gt; i < 1024; i += ngt) { const int pos = i >> 4, f = i & 15; const float inv = powf(10000.f, -(float)f / 16.f), ang = (float)pos * inv;
        C.ctl[CT_ROPEM + i] = cosf(ang); C.ctl[CT_ROPEM + 1024 + i] = sinf(ang); }
    for (int i = gt; i < 4096; i += ngt) C.ctl[CT_SP + i] = log1pf(expf(-INP(14)[i]));
    for (int i = gt; i < 16; i += ngt) C.ctl[CT_LG + i] = -log1pf(expf(-INP(15)[i])) * LOG2E;
}

__device__ __forceinline__ void tr_item(const float* W, int ldw, int k0, int n0, bf16_t* WT, int ldt, int drow0, int dk0, LAS float* scr, int lane) {
#pragma unroll 8
    for (int i = 0; i < 32; ++i) { const int kk = 2 * i + (lane >> 5); scr[kk * 33 + (lane & 31)] = W[(size_t)(k0 + kk) * ldw + n0 + (lane & 31)]; }
    asm volatile("s_waitcnt lgkmcnt(0)" ::: "memory");
    const int c = lane & 7;
#pragma unroll
    for (int j = 0; j < 4; ++j) { const int n = (lane >> 3) + 8 * j; const LAS float* s = scr + (8 * c) * 33 + n;
        u32x4 o; o.x = pk2(s[0 * 33], s[1 * 33]); o.y = pk2(s[2 * 33], s[3 * 33]); o.z = pk2(s[4 * 33], s[5 * 33]); o.w = pk2(s[6 * 33], s[7 * 33]);
        *(u32x4*)(WT + (size_t)(drow0 + n) * ldt + dk0 + 8 * c) = o; }
    asm volatile("s_waitcnt lgkmcnt(0)" ::: "memory");
}
__device__ __forceinline__ void conv_rows(Ctx& C, const float* W, int ldw, int K, int scol0, bf16_t* WT, int ldt, int drow0, int dk0, int nrows, LAS float* scr) {
    const int nkb = K / 64, items = nkb * (nrows / 32);
    int g0 = C.gw - C.rot; if (g0 < 0) g0 += C.ngw; C.rot = (C.rot + items) % C.ngw;
    for (int it = g0; it < items; it += C.ngw) { const int nb = it / nkb, kb = it - nb * nkb;
        tr_item(W, ldw, kb * 64, scol0 + nb * 32, WT, ldt, drow0 + nb * 32, dk0 + kb * 64, scr, C.lane); }
}
__device__ __forceinline__ int ropeperm(int j) { const int h = j >> 8, jj = j & 255, half = jj >> 7, g = (jj & 127) >> 3, r8 = jj & 7; return h * 256 + (half * 2 + (r8 >> 2)) * 64 + g * 4 + (r8 & 3); }
__device__ __forceinline__ void tr_item_rope(const float* W, int ldw, int k0, int scol0, int jbase, bf16_t* WT, int ldt, int drow0, int dk0, LAS float* scr, int lane) {
    const int sc = scol0 + ropeperm(jbase + (lane & 31));
#pragma unroll 8
    for (int i = 0; i < 32; ++i) { const int kk = 2 * i + (lane >> 5); scr[kk * 33 + (lane & 31)] = W[(size_t)(k0 + kk) * ldw + sc]; }
    asm volatile("s_waitcnt lgkmcnt(0)" ::: "memory");
    const int c = lane & 7;
#pragma unroll
    for (int j = 0; j < 4; ++j) { const int n = (lane >> 3) + 8 * j; const LAS float* s = scr + (8 * c) * 33 + n;
        u32x4 o; o.x = pk2(s[0 * 33], s[1 * 33]); o.y = pk2(s[2 * 33], s[3 * 33]); o.z = pk2(s[4 * 33], s[5 * 33]); o.w = pk2(s[6 * 33], s[7 * 33]);
        *(u32x4*)(WT + (size_t)(drow0 + n) * ldt + dk0 + 8 * c) = o; }
    asm volatile("s_waitcnt lgkmcnt(0)" ::: "memory");
}
__device__ __forceinline__ void conv_rows_rope(Ctx& C, const float* W, int ldw, int K, int scol0, bf16_t* WT, int ldt, int drow0, int nrows, LAS float* scr) {
    const int nkb = K / 64, items = nkb * (nrows / 32);
    int g0 = C.gw - C.rot; if (g0 < 0) g0 += C.ngw; C.rot = (C.rot + items) % C.ngw;
    for (int it = g0; it < items; it += C.ngw) { const int nb = it / nkb, kb = it - nb * nkb;
        tr_item_rope(W, ldw, kb * 64, scol0, nb * 32, WT, ldt, drow0 + nb * 32, kb * 64, scr, C.lane); }
}
__device__ __forceinline__ void zero_rows(Ctx& C, bf16_t* WT, int ldt, int drow0, int dk0, int nrows, int ncols) {
    const int per = ncols / 8, items = nrows * per;
    int g0 = C.gw - C.rot; if (g0 < 0) g0 += C.ngw; C.rot = (C.rot + (items + 63) / 64) % C.ngw;
    for (int it = g0 * 64 + C.lane; it < items; it += C.ngw * 64) { const int r = it / per, c = it - r * per; *(u32x4*)(WT + (size_t)(drow0 + r) * ldt + dk0 + c * 8) = (u32x4){0u, 0u, 0u, 0u}; }
}
__device__ __forceinline__ void phase_wconv_early(Ctx& C, int l) {
    LAS float* scr = (LAS float*)(C.lds + C.wave * 16384);
    unsigned char* ws = C.ws;
    const float* win = INP(7) + (size_t)l * 1024 * INC;
    bf16_t* WT1 = (bf16_t*)(ws + W_WT1);
    conv_rows(C, win, INC, 1024, 0, WT1, 1024, 0, 0, 1024, scr);
    conv_rows_rope(C, win, INC, 1024, 2048, WT1, 1024, 1024, 1024, scr);
    conv_rows_rope(C, win, INC, 1024, 3072, WT1, 1024, 2048, 1024, scr);
    conv_rows(C, win, INC, 1024, 4096, WT1, 1024, 3072, 0, 1024, scr);
    conv_rows(C, win, INC, 1024, 6144, WT1, 1024, 4096, 0, 704, scr);
    zero_rows(C, WT1, 1024, 4800, 0, 64, 1024);
    const float* wq = INP(18) + (size_t)l * 384 * 1536; bf16_t* WTQ = (bf16_t*)(ws + W_WTQ);
    for (int h = 0; h < 8; ++h) { conv_rows(C, wq, 1536, 384, h * 192, WTQ, 384, h * 128, 0, 128, scr); conv_rows(C, wq, 1536, 384, h * 192 + 128, WTQ, 384, 1024 + h * 64, 0, 64, scr); }
    const float* wkv = INP(20) + (size_t)l * 256 * 2048; bf16_t* WTKV = (bf16_t*)(ws + W_WTKV);
    for (int h = 0; h < 8; ++h) { conv_rows(C, wkv, 2048, 256, h * 256, WTKV, 256, h * 128, 0, 128, scr); conv_rows(C, wkv, 2048, 256, h * 256 + 128, WTKV, 256, 1024 + h * 128, 0, 128, scr); }
    bf16_t* WTL = (bf16_t*)(ws + W_WTL);
    for (int d = 0; d < 2; ++d) for (int n = 0; n < 8; ++n) for (int mat = 0; mat < 2; ++mat) {
        const float* w = INP(mat == 0 ? 10 : 12) + ((size_t)(l * 2 + d) * 8 + n) * 128 * 128;
        const int drow0 = d * 2048 + n * 256 + mat * 128;
        conv_rows(C, w, 128, 128, 0, WTL, 256, drow0, (n & 1) * 128, 128, scr);
        zero_rows(C, WTL, 256, drow0, ((n & 1) ^ 1) * 128, 128, 128);
    }
}
__device__ __forceinline__ void phase_wconv_late(Ctx& C, int l) {
    LAS float* scr = (LAS float*)(C.lds + C.wave * 16384);
    unsigned char* ws = C.ws;
    const float* win = INP(7) + (size_t)l * 1024 * INC;
    bf16_t* WTG = (bf16_t*)(ws + W_WTG);
    conv_rows(C, win, INC, 1024, 1024, WTG, 1024, 0, 0, 1024, scr);
    conv_rows(C, win, INC, 1024, 5120, WTG, 1024, 1024, 0, 1024, scr);
    conv_rows(C, win, INC, 1024, 6848, WTG, 1024, 2048, 0, 1024, scr);
    conv_rows(C, win, INC, 1024, 7872, (bf16_t*)(ws + W_WTGM), 1024, 0, 0, 3072, scr);
    for (int i = 0; i < 3; ++i) conv_rows(C, INP(25 + i) + (size_t)l * 1024 * 1024, 1024, 1024, 0, (bf16_t*)(ws + W_WTD) + (size_t)i * 1024 * 1024, 1024, 0, 0, 1024, scr);
    conv_rows(C, INP(28) + (size_t)l * 1024 * 1024, 1024, 1024, 0, (bf16_t*)(ws + W_WTO), 1024, 0, 0, 1024, scr);
}

__device__ __forceinline__ void phase_h(Ctx& C, int l, bf16_t* H) {
    const float* gain = INP(6) + l * 1024;
    for (int m = C.gw; m < MR; m += C.ngw) {
        const int b = m / SS, s = m - b * SS, r = (s < LC) ? 4 : b;
        const float* xr = resid_row(C, l, m);
        const float* mod = C.ctl + CT_MOD + (l * 5 + r) * 3072;
        f32x4 v[4]; float ss = 0.f;
#pragma unroll
        for (int j = 0; j < 4; ++j) { v[j] = *(const f32x4*)(xr + 4 * C.lane + 256 * j); ss += (v[j].x * v[j].x + v[j].y * v[j].y) + (v[j].z * v[j].z + v[j].w * v[j].w); }
        const float rstd = RSQ(wave_sum(ss) * (1.f / 1024.f) + EPS);
#pragma unroll
        for (int j = 0; j < 4; ++j) { const int c = 4 * C.lane + 256 * j;
            const f32x4 g = *(const f32x4*)(gain + c), sh = *(const f32x4*)(mod + c), sc = *(const f32x4*)(mod + 1024 + c);
            const f32x4 y = (v[j] * rstd) * g;
            const f32x4 o = y * (sc + 1.0f) + sh;
            u32x2 w; w.x = pk2(o.x, o.y); w.y = pk2(o.z, o.w);
            *(u32x2*)(H + (size_t)m * 1024 + c) = w; }
    }
}

using pg8::Unit;
struct ProbPlain {
    const bf16_t* A; const bf16_t* Bt; int lda, ldb, K;
    __device__ __forceinline__ void get(const Unit& u, const char*& a, const char*& b, int& lda_) const {
        a = (const char*)(A + (size_t)u.pm * 256 * lda); b = (const char*)(Bt + (size_t)u.pn * 256 * ldb); lda_ = lda; }
};
struct ProbLru {
    const bf16_t* A; const bf16_t* Bt; int ldb, K;
    __device__ __forceinline__ void get(const Unit& u, const char*& a, const char*& b, int& lda_) const {
        a = (const char*)(A + (size_t)u.pm * 256 * 1024 + (u.pn >> 1) * 256); b = (const char*)(Bt + (size_t)u.pn * 256 * 256); lda_ = 1024; }
};
struct ProbD {
    unsigned char* ws; int ldb, K;
    __device__ __forceinline__ void get(const Unit& u, const char*& a, const char*& b, int& lda_) const {
        const int i = (u.z & 7) >> 1;
        if ((u.z & 1) == 0) { a = (const char*)(ws + AR_XA + (size_t)u.pm * 256 * 1024 * 2); b = (const char*)(ws + W_WTGM + ((size_t)i * 1024 + u.pn * 256) * 1024 * 2); lda_ = 1024; }
        else { const size_t yo = (i == 0) ? AR_Y0 : (i == 1) ? AR_YB : AR_QN;
            a = (const char*)(ws + yo + (size_t)u.pm * 256 * 1024 * 2); b = (const char*)(ws + W_WTD + ((size_t)i * 1024 + u.pn * 256) * 1024 * 2); lda_ = 1024; }
    }
};

#define EPI_ARGS const f32x4 (&acc)[2][2][4][2], const Unit& u, int wr, int wc, int fr, int fq
template <size_t O0, int L0, size_t O1, int L1, size_t O2, int L2, int T1, int T2>
struct EpiStore3 {
    static constexpr bool PERM = true;
    unsigned char* ws;
    __device__ __forceinline__ void operator()(EPI_ARGS) const {
        bf16_t* bs; int ldc, ct;
        size_t off;
        if (u.pn < T1) { off = O0; ldc = L0; ct = u.pn; } else if (u.pn < T2) { off = O1; ldc = L1; ct = u.pn - T1; } else { off = O2; ldc = L2; ct = u.pn - T2; }
        bs = (bf16_t*)(ws + off);
        const int row0 = u.pm * 256 + wr * 64 + fr, col0 = ct * 256 + wc * 32 + 8 * fq;
#pragma unroll
        for (int ai = 0; ai < 2; ++ai)
#pragma unroll
            for (int m = 0; m < 4; ++m) { bf16_t* rowp = bs + (size_t)(row0 + ai * 128 + m * 16) * ldc + col0;
#pragma unroll
                for (int bj = 0; bj < 2; ++bj) { const f32x4 v0 = acc[ai][bj][m][0], v1 = acc[ai][bj][m][1];
                    u32x4 w; w.x = pg8::cvt_pk_bf16(v0[0], v0[1]); w.y = pg8::cvt_pk_bf16(v0[2], v0[3]); w.z = pg8::cvt_pk_bf16(v1[0], v1[1]); w.w = pg8::cvt_pk_bf16(v1[2], v1[3]);
                    *(u32x4*)(rowp + bj * 128) = w; } }
    }
};
struct EpiKV {
    static constexpr bool PERM = true;
    unsigned char* ws; const float* gkn; LAS float* red;
    __device__ __forceinline__ void operator()(EPI_ARGS) const {
        bf16_t* bs = (bf16_t*)(ws + AR_KV);
        const int row0 = u.pm * 256 + wr * 64 + fr, col0 = u.pn * 256 + wc * 32 + 8 * fq;
        const bool knope = u.pn < 4;
        float g[8];
#pragma unroll
        for (int e = 0; e < 8; ++e) g[e] = 1.f;
        if (knope) {
#pragma unroll
            for (int ai = 0; ai < 2; ++ai)
#pragma unroll
                for (int m = 0; m < 4; ++m)
#pragma unroll
                    for (int bj = 0; bj < 2; ++bj) { const f32x4 v0 = acc[ai][bj][m][0], v1 = acc[ai][bj][m][1];
                        float ss = ((v0[0] * v0[0] + v0[1] * v0[1]) + (v0[2] * v0[2] + v0[3] * v0[3])) + ((v1[0] * v1[0] + v1[1] * v1[1]) + (v1[2] * v1[2] + v1[3] * v1[3]));
                        ss += __shfl_xor(ss, 16); ss += __shfl_xor(ss, 32);
                        if (fq == 0) red[((ai * 128 + wr * 64 + m * 16 + fr) * 2 + bj) * 4 + wc] = ss; }
            asm volatile("s_waitcnt lgkmcnt(0)" ::: "memory"); __builtin_amdgcn_s_barrier(); asm volatile("" ::: "memory");
            const f32x4 ga = *(const f32x4*)(gkn + wc * 32 + 8 * fq), gb = *(const f32x4*)(gkn + wc * 32 + 8 * fq + 4);
            g[0] = ga[0]; g[1] = ga[1]; g[2] = ga[2]; g[3] = ga[3]; g[4] = gb[0]; g[5] = gb[1]; g[6] = gb[2]; g[7] = gb[3];
        }
#pragma unroll
        for (int ai = 0; ai < 2; ++ai)
#pragma unroll
            for (int m = 0; m < 4; ++m) { bf16_t* rowp = bs + (size_t)(row0 + ai * 128 + m * 16) * 2048 + col0;
#pragma unroll
                for (int bj = 0; bj < 2; ++bj) { f32x4 v0 = acc[ai][bj][m][0], v1 = acc[ai][bj][m][1];
                    float rs = 1.f;
                    if (knope) { const f32x4 t = *(const LAS f32x4*)(red + ((ai * 128 + wr * 64 + m * 16 + fr) * 2 + bj) * 4); rs = RSQ(((t[0] + t[1]) + (t[2] + t[3])) * (1.f / 128.f) + EPS); }
                    u32x4 w; w.x = pg8::cvt_pk_bf16(v0[0] * rs * g[0], v0[1] * rs * g[1]); w.y = pg8::cvt_pk_bf16(v0[2] * rs * g[2], v0[3] * rs * g[3]);
                    w.z = pg8::cvt_pk_bf16(v1[0] * rs * g[4], v1[1] * rs * g[5]); w.w = pg8::cvt_pk_bf16(v1[2] * rs * g[6], v1[3] * rs * g[7]);
                    *(u32x4*)(rowp + bj * 128) = w; }
                asm volatile("" ::: "memory"); }
    }
};
struct EpiG1 {
    static constexpr bool PERM = true;
    unsigned char* ws; const float* cs;
    __device__ __forceinline__ void operator()(EPI_ARGS) const {
        bf16_t* bs; int ldc, ct;
        if (u.pn < 4) { bs = (bf16_t*)(ws + AR_XA); ldc = 1024; ct = u.pn; } else if (u.pn < 16) { bs = (bf16_t*)(ws + AR_RQKV); ldc = 3072; ct = u.pn - 4; } else { bs = (bf16_t*)(ws + AR_MD); ldc = 768; ct = u.pn - 16; }
        const int row0 = u.pm * 256 + wr * 64 + fr, col0 = ct * 256 + wc * 32 + 8 * fq;
        const bool rope = (u.pn >= 4) && (u.pn < 12), iskey = (u.pn >= 8);
        const int bq = u.pm / 17, s0 = (u.pm - bq * 17) * 256 + wr * 64 + fr;
        const int f0 = (wc * 4 + fq) * 4;
#pragma unroll
        for (int ai = 0; ai < 2; ++ai)
#pragma unroll
            for (int m = 0; m < 4; ++m) { bf16_t* rowp = bs + (size_t)(row0 + ai * 128 + m * 16) * ldc + col0;
                const int s = s0 + ai * 128 + m * 16, t = s - LC; const bool lat = s >= LC;
#pragma unroll
                for (int bj = 0; bj < 2; ++bj) { f32x4 v0 = acc[ai][bj][m][0], v1 = acc[ai][bj][m][1];
                    if (rope) {
                        if (lat) { const int pos = bj ? (t & 63) : (t >> 6); const f32x4 c = *(const f32x4*)(cs + pos * 64 + f0), sn = *(const f32x4*)(cs + 4096 + pos * 64 + f0);
                            const f32x4 a = v0 * c - v1 * sn, b = v1 * c + v0 * sn; v0 = a; v1 = b; }
                        if (iskey) { v0 = v0 * 0.0625f; v1 = v1 * 0.0625f; } }
                    u32x4 w; w.x = pg8::cvt_pk_bf16(v0[0], v0[1]); w.y = pg8::cvt_pk_bf16(v0[2], v0[3]); w.z = pg8::cvt_pk_bf16(v1[0], v1[1]); w.w = pg8::cvt_pk_bf16(v1[2], v1[3]);
                    *(u32x4*)(rowp + bj * 128) = w; }
                asm volatile("" ::: "memory"); }
    }
};
typedef f16_t f16x8 __attribute__((ext_vector_type(8)));
struct EpiLru {
    static constexpr bool PERM = true;
    const bf16_t* U; f16_t* RI; const float* ba; const float* bx; const float* sp;
    __device__ __forceinline__ void operator()(EPI_ARGS) const {
        const int row0 = u.pm * 256 + wr * 64 + fr, ch0 = u.pn * 128 + wc * 32 + 8 * fq;
        float bav[8], bxv[8], spv[8];
#pragma unroll
        for (int e = 0; e < 8; ++e) { bav[e] = ba[ch0 + e]; bxv[e] = bx[ch0 + e]; spv[e] = sp[ch0 + e] * (-8.f); }
#pragma unroll
        for (int ai = 0; ai < 2; ++ai)
#pragma unroll
            for (int m = 0; m < 4; ++m) { const int row = row0 + ai * 128 + m * 16;
                const u32x4 uw = *(const u32x4*)(U + (size_t)row * 1024 + ch0);
                float uv[8] = {lo_bf(uw.x), hi_bf(uw.x), lo_bf(uw.y), hi_bf(uw.y), lo_bf(uw.z), hi_bf(uw.z), lo_bf(uw.w), hi_bf(uw.w)};
                f16x8 la, bc;
#pragma unroll
                for (int e = 0; e < 8; ++e) { const float rp = acc[ai][0][m][e >> 2][e & 3] + bav[e], ip = acc[ai][1][m][e >> 2][e & 3] + bxv[e];
                    const float r = sigmoidf_(rp), ig = sigmoidf_(ip);
                    const float loga = r * spv[e];
                    const float bb = SQRT(fmaxf(-expm1f(2.f * loga), 0.f)) * (ig * uv[e]);
                    la[e] = (f16_t)(loga * LOG2E); bc[e] = (f16_t)bb; }
                *(f16x8*)(RI + (size_t)row * 2048 + ch0) = la; *(f16x8*)(RI + (size_t)row * 2048 + 1024 + ch0) = bc;
                asm volatile("" ::: "memory"); }
    }
};
struct EpiGate {
    static constexpr bool PERM = true;
    unsigned char* ws;
    __device__ __forceinline__ void operator()(EPI_ARGS) const {
        const int br = u.pn >> 2; const size_t yo = (br == 0) ? AR_Y0 : (br == 1) ? AR_YB : AR_QN; bf16_t* bs = (bf16_t*)(ws + yo);
        const int row0 = u.pm * 256 + wr * 64 + fr, col0 = (u.pn & 3) * 256 + wc * 32 + 8 * fq;
        if (br == 0) {
            const int b = u.pm / 17, sg0 = (u.pm - b * 17) * 2;
#pragma unroll
            for (int ai = 0; ai < 2; ++ai) {
                const float* hfp = (const float*)(ws + AR_HIN) + ((size_t)(0 * NB + b) * 34 + sg0 + ai) * 1024 + col0;
                const float* hbp = (const float*)(ws + AR_HIN) + ((size_t)(1 * NB + b) * 34 + sg0 + ai) * 1024 + col0;
#pragma unroll
                for (int bj = 0; bj < 2; ++bj) {
                    const f32x4 hf0 = *(const f32x4*)(hfp + bj * 128), hf1 = *(const f32x4*)(hfp + bj * 128 + 4), hb0 = *(const f32x4*)(hbp + bj * 128), hb1 = *(const f32x4*)(hbp + bj * 128 + 4);
#pragma unroll
                    for (int m = 0; m < 4; ++m) { const size_t ro = (size_t)(row0 + ai * 128 + m * 16) * 1024 + col0 + bj * 128;
                        const f32x4 v0 = acc[ai][bj][m][0], v1 = acc[ai][bj][m][1];
                        const u32x4 y = *(const u32x4*)(bs + ro);
                        const f16x8 cf = *(const f16x8*)((const f16_t*)(ws + AR_CAF) + ro), cb = *(const f16x8*)((const f16_t*)(ws + AR_CAB) + ro);
                        float yy[8]; unpack8(y, yy);
                        yy[0] += (float)cf[0] * hf0[0] + (float)cb[0] * hb0[0]; yy[1] += (float)cf[1] * hf0[1] + (float)cb[1] * hb0[1]; yy[2] += (float)cf[2] * hf0[2] + (float)cb[2] * hb0[2]; yy[3] += (float)cf[3] * hf0[3] + (float)cb[3] * hb0[3];
                        yy[4] += (float)cf[4] * hf1[0] + (float)cb[4] * hb1[0]; yy[5] += (float)cf[5] * hf1[1] + (float)cb[5] * hb1[1]; yy[6] += (float)cf[6] * hf1[2] + (float)cb[6] * hb1[2]; yy[7] += (float)cf[7] * hf1[3] + (float)cb[7] * hb1[3];
                        u32x4 w; w.x = pg8::cvt_pk_bf16(yy[0] * siluf_(v0[0]), yy[1] * siluf_(v0[1])); w.y = pg8::cvt_pk_bf16(yy[2] * siluf_(v0[2]), yy[3] * siluf_(v0[3]));
                        w.z = pg8::cvt_pk_bf16(yy[4] * siluf_(v1[0]), yy[5] * siluf_(v1[1])); w.w = pg8::cvt_pk_bf16(yy[6] * siluf_(v1[2]), yy[7] * siluf_(v1[3]));
                        *(u32x4*)(bs + ro) = w;
                        asm volatile("" ::: "memory"); } } }
            return;
        }
#pragma unroll
        for (int ai = 0; ai < 2; ++ai)
#pragma unroll
            for (int mh = 0; mh < 2; ++mh) {
                u32x4 yq[2][2];
#pragma unroll
                for (int mm = 0; mm < 2; ++mm)
#pragma unroll
                    for (int bj = 0; bj < 2; ++bj) yq[mm][bj] = *(const u32x4*)(bs + (size_t)(row0 + ai * 128 + (2 * mh + mm) * 16) * 1024 + col0 + bj * 128);
#pragma unroll
                for (int mm = 0; mm < 2; ++mm) { const int m = 2 * mh + mm; bf16_t* rowp = bs + (size_t)(row0 + ai * 128 + m * 16) * 1024 + col0;
#pragma unroll
                    for (int bj = 0; bj < 2; ++bj) { const f32x4 v0 = acc[ai][bj][m][0], v1 = acc[ai][bj][m][1];
                        const u32x4 y = yq[mm][bj];
                        u32x4 w; w.x = pg8::cvt_pk_bf16(lo_bf(y.x) * siluf_(v0[0]), hi_bf(y.x) * siluf_(v0[1])); w.y = pg8::cvt_pk_bf16(lo_bf(y.y) * siluf_(v0[2]), hi_bf(y.y) * siluf_(v0[3]));
                        w.z = pg8::cvt_pk_bf16(lo_bf(y.z) * siluf_(v1[0]), hi_bf(y.z) * siluf_(v1[1])); w.w = pg8::cvt_pk_bf16(lo_bf(y.w) * siluf_(v1[2]), hi_bf(y.w) * siluf_(v1[3]));
                        *(u32x4*)(rowp + bj * 128) = w; } }
                asm volatile("" ::: "memory"); }
    }
};
struct EpiD {
    static constexpr bool PERM = true;
    bf16_t* Z; unsigned char* gs; bf16_t* ZP;
    __device__ __forceinline__ void operator()(EPI_ARGS) const {
        const int col0 = u.pn * 256 + wc * 32 + 8 * fq, i = (u.z & 7) >> 1; const bool part = u.z >= 8;
        const int row0 = part ? ((u.pm / 17) * 256 + wr * 64 + fr) : (u.pm * 256 + wr * 64 + fr);
        bf16_t* const zb = part ? (ZP + (size_t)i * 1024 * 1024) : Z;
        const unsigned tq = (unsigned)(((wr * 4 + wc) * 64 + fq * 16 + fr) * 64);
        if ((u.z & 1) == 0) {
#pragma unroll
            for (int ai = 0; ai < 2; ++ai)
#pragma unroll
                for (int m = 0; m < 4; ++m)
#pragma unroll
                    for (int bj = 0; bj < 2; ++bj) { const f32x4 v0 = acc[ai][bj][m][0], v1 = acc[ai][bj][m][1];
                        u32x4 w; w.x = pg8::cvt_pk_bf16(sigmoidf_(v0[0]), sigmoidf_(v0[1])); w.y = pg8::cvt_pk_bf16(sigmoidf_(v0[2]), sigmoidf_(v0[3]));
                        w.z = pg8::cvt_pk_bf16(sigmoidf_(v1[0]), sigmoidf_(v1[1])); w.w = pg8::cvt_pk_bf16(sigmoidf_(v1[2]), sigmoidf_(v1[3]));
                        *(u32x4*)(gs + (((ai * 4 + m) * 2 + bj) >> 2) * 32768 + tq + (((ai * 4 + m) * 2 + bj) & 3) * 16) = w; }
        } else {
            const bool rmw = (i > 0) && !part;
#pragma unroll
            for (int ai = 0; ai < 2; ++ai) {
                u32x4 gq[4][2], zq[4][2];
#pragma unroll
                for (int m = 0; m < 4; ++m)
#pragma unroll
                    for (int bj = 0; bj < 2; ++bj) { gq[m][bj] = *(const u32x4*)(gs + (((ai * 4 + m) * 2 + bj) >> 2) * 32768 + tq + (((ai * 4 + m) * 2 + bj) & 3) * 16);
                        zq[m][bj] = rmw ? *(const u32x4*)(zb + (size_t)(row0 + ai * 128 + m * 16) * 1024 + col0 + bj * 128) : (u32x4){0u, 0u, 0u, 0u}; }
#pragma unroll
                for (int m = 0; m < 4; ++m) { bf16_t* zrow = zb + (size_t)(row0 + ai * 128 + m * 16) * 1024 + col0;
#pragma unroll
                    for (int bj = 0; bj < 2; ++bj) { const f32x4 v0 = acc[ai][bj][m][0], v1 = acc[ai][bj][m][1];
                        const u32x4 g = gq[m][bj], zo = zq[m][bj]; bf16_t* zp = zrow + bj * 128;
                        const float o0 = lo_bf(g.x) * v0[0] + lo_bf(zo.x), o1 = hi_bf(g.x) * v0[1] + hi_bf(zo.x), o2 = lo_bf(g.y) * v0[2] + lo_bf(zo.y), o3 = hi_bf(g.y) * v0[3] + hi_bf(zo.y);
                        const float o4 = lo_bf(g.z) * v1[0] + lo_bf(zo.z), o5 = hi_bf(g.z) * v1[1] + hi_bf(zo.z), o6 = lo_bf(g.w) * v1[2] + lo_bf(zo.w), o7 = hi_bf(g.w) * v1[3] + hi_bf(zo.w);
                        u32x4 w; w.x = pg8::cvt_pk_bf16(o0, o1); w.y = pg8::cvt_pk_bf16(o2, o3); w.z = pg8::cvt_pk_bf16(o4, o5); w.w = pg8::cvt_pk_bf16(o6, o7); *(u32x4*)zp = w; } }
                asm volatile("" ::: "memory"); }
        }
    }
};
struct EpiOut {
    static constexpr bool PERM = false;
    const float* xlat; const float* xctx; float* olat; float* octx; const float* mod;
    __device__ __forceinline__ void operator()(EPI_ARGS) const {
        const int b = u.pm / 17, isctx = (u.pm - b * 17) == 0;
        const float* gate = mod + (isctx ? 4 : b) * 3072 + 2048;
        const int col0 = u.pn * 256 + wc * 32 + 4 * fq;
        f32x4 gv[2][2];
#pragma unroll
        for (int bj = 0; bj < 2; ++bj)
#pragma unroll
            for (int n = 0; n < 2; ++n) gv[bj][n] = *(const f32x4*)(gate + col0 + bj * 128 + n * 16);
        const float* xin = isctx ? xctx : xlat; float* xo = isctx ? octx : olat;
#pragma unroll
        for (int ai = 0; ai < 2; ++ai) {
            f32x4 xq[4][2][2];
#pragma unroll
            for (int m = 0; m < 4; ++m) { const int s = (u.pm - b * 17) * 256 + ai * 128 + wr * 64 + m * 16 + fr;
                const size_t off = isctx ? ((size_t)(b * LC + s) * 1024 + col0) : ((size_t)(b * TT + (s - LC)) * 1024 + col0);
#pragma unroll
                for (int bj = 0; bj < 2; ++bj)
#pragma unroll
                    for (int n = 0; n < 2; ++n) xq[m][bj][n] = *(const f32x4*)(xin + off + bj * 128 + n * 16); }
#pragma unroll
            for (int m = 0; m < 4; ++m) { const int s = (u.pm - b * 17) * 256 + ai * 128 + wr * 64 + m * 16 + fr;
                const size_t off = isctx ? ((size_t)(b * LC + s) * 1024 + col0) : ((size_t)(b * TT + (s - LC)) * 1024 + col0);
#pragma unroll
                for (int bj = 0; bj < 2; ++bj)
#pragma unroll
                    for (int n = 0; n < 2; ++n) *(f32x4*)(xo + off + bj * 128 + n * 16) = xq[m][bj][n] + gv[bj][n] * acc[ai][bj][m][n]; }
            asm volatile("" ::: "memory"); }
    }
};

__device__ __forceinline__ void phase_ret_rope(Ctx& C, bf16_t* RQKV) {
    const float* cs = C.ctl + CT_ROPER; const float* sn = cs + 4096;
    for (int m = C.gw; m < MR; m += C.ngw) {
        const int b = m / SS, s = m - b * SS; const bool lat = s >= LC; const int t = s - LC, prow = lat ? (t >> 6) : 0, pcol = lat ? (t & 63) : 0;
        bf16_t* row = RQKV + (size_t)m * 3072;
#pragma unroll
        for (int j = 0; j < 16; ++j) {
            const int idx = j * 64 + C.lane, f = idx & 63, half = (idx >> 6) & 1, h = (idx >> 7) & 3, tz = idx >> 9;
            bf16_t* p = row + tz * 1024 + h * 256 + half * 128 + f;
            const float x1 = bf2f(p[0]), x2 = bf2f(p[64]);
            float o1 = x1, o2 = x2;
            if (lat) { const int pos = half ? pcol : prow; const float c = cs[pos * 64 + f], sv = sn[pos * 64 + f]; o1 = x1 * c - x2 * sv; o2 = x2 * c + x1 * sv; }
            if (tz) { o1 *= 0.0625f; o2 *= 0.0625f; }
            p[0] = (bf16_t)f2bf(o1); p[64] = (bf16_t)f2bf(o2);
        }
    }
}

#define RS_STEP(o, cnt, st) do { const bool up_ = (C.lane & (st)) != 0; _Pragma("unroll") for (int e_ = 0; e_ < (cnt) / 2; ++e_) { \
        const float send_ = up_ ? o[e_] : o[e_ + (cnt) / 2]; const float keep_ = up_ ? o[e_ + (cnt) / 2] : o[e_]; o[e_] = keep_ + __shfl_xor(send_, (st)); } } while (0)

__device__ __forceinline__ void phase_ret_naive(Ctx& C, int l, const bf16_t* RQKV, bf16_t* OI) {
    LAS unsigned char* qs = C.lds + C.wave * 512;
    const int nbu = (MR / 8) * 16;
    for (int bu = C.bid; bu < nbu; bu += C.G) {
        const int hq = bu & 15, h = hq >> 2, qd = hq & 3, n = (bu >> 4) * 8 + C.wave;
        const int b = n / SS, sn_ = n - b * SS;
        const float lgf = C.ctl[CT_LG + (l * 2 + 0) * 4 + h], lgb = C.ctl[CT_LG + (l * 2 + 1) * 4 + h];
        const int pfn = sn_, pbn = (sn_ < LC) ? (LC - 1 - sn_) : (SS + LC - 1 - sn_);
        asm volatile("s_waitcnt lgkmcnt(0)" ::: "memory");
        *(LAS u32x2*)(qs + C.lane * 8) = *(const u32x2*)(RQKV + (size_t)n * 3072 + h * 256 + C.lane * 4);
        asm volatile("s_waitcnt lgkmcnt(0)" ::: "memory");
        float o[64];
#pragma unroll
        for (int e = 0; e < 64; ++e) o[e] = 0.f;
        for (int sm = C.lane; sm < SS; sm += 64) {
            const bf16_t* krow = RQKV + (size_t)(b * SS + sm) * 3072 + 1024 + h * 256;
            float dot = 0.f;
#pragma unroll 4
            for (int c = 0; c < 32; ++c) { const u32x4 kv = *(const u32x4*)(krow + c * 8); const u32x4 qv = *(const LAS u32x4*)(qs + c * 16);
                dot += lo_bf(kv.x) * lo_bf(qv.x) + hi_bf(kv.x) * hi_bf(qv.x) + lo_bf(kv.y) * lo_bf(qv.y) + hi_bf(kv.y) * hi_bf(qv.y)
                     + lo_bf(kv.z) * lo_bf(qv.z) + hi_bf(kv.z) * hi_bf(qv.z) + lo_bf(kv.w) * lo_bf(qv.w) + hi_bf(kv.w) * hi_bf(qv.w); }
            const int pfm = sm, pbm = (sm < LC) ? (LC - 1 - sm) : (SS + LC - 1 - sm);
            float w = 0.f;
            if (pfn >= pfm) w += EX2(lgf * (float)(pfn - pfm));
            if (pbn >= pbm) w += EX2(lgb * (float)(pbn - pbm));
            const float ws_ = w * dot;
            const bf16_t* vrow = krow + 1024 + qd * 64;
#pragma unroll
            for (int c = 0; c < 8; ++c) { const u32x4 vv = *(const u32x4*)(vrow + c * 8);
                o[c * 8 + 0] += ws_ * lo_bf(vv.x); o[c * 8 + 1] += ws_ * hi_bf(vv.x); o[c * 8 + 2] += ws_ * lo_bf(vv.y); o[c * 8 + 3] += ws_ * hi_bf(vv.y);
                o[c * 8 + 4] += ws_ * lo_bf(vv.z); o[c * 8 + 5] += ws_ * hi_bf(vv.z); o[c * 8 + 6] += ws_ * lo_bf(vv.w); o[c * 8 + 7] += ws_ * hi_bf(vv.w); }
        }
        RS_STEP(o, 64, 32); RS_STEP(o, 32, 16); RS_STEP(o, 16, 8); RS_STEP(o, 8, 4); RS_STEP(o, 4, 2); RS_STEP(o, 2, 1);
        OI[(size_t)n * 1024 + h * 256 + qd * 64 + C.lane] = (bf16_t)f2bf(o[0]);
    }
}
__device__ __forceinline__ void phase_ret_ln(Ctx& C, int l, bf16_t* OI) {
    const float* gain = INP(16) + l * 1024;
    for (int m = C.gw; m < MR; m += C.ngw) {
#pragma unroll
        for (int h = 0; h < 4; ++h) { bf16_t* p = OI + (size_t)m * 1024 + h * 256 + C.lane * 4;
            const u32x2 w = *(const u32x2*)p; float x0 = lo_bf(w.x), x1 = hi_bf(w.x), x2 = lo_bf(w.y), x3 = hi_bf(w.y);
            const float mean = wave_sum((x0 + x1) + (x2 + x3)) * (1.f / 256.f);
            x0 -= mean; x1 -= mean; x2 -= mean; x3 -= mean;
            const float var = wave_sum((x0 * x0 + x1 * x1) + (x2 * x2 + x3 * x3)) * (1.f / 256.f);
            const float rstd = RSQ(var + EPS);
            const f32x4 g = *(const f32x4*)(gain + h * 256 + C.lane * 4);
            u32x2 o; o.x = pk2(x0 * rstd * g.x, x1 * rstd * g.y); o.y = pk2(x2 * rstd * g.z, x3 * rstd * g.w); *(u32x2*)p = o; }
    }
}

__device__ __forceinline__ void phase_md_post(Ctx& C, int l, bf16_t* MD) {
    const float* qn = INP(17) + l * 384; const float* kvn = INP(19) + l * 256; const float* gkr = INP(24) + l * 64;
    const float* cs = C.ctl + CT_ROPEM; const float* sn = cs + 1024;
    for (int m = C.gw; m < MR; m += C.ngw) {
        const int b = m / SS, s = m - b * SS; const bool lat = s >= LC; const int t = s - LC;
        bf16_t* row = MD + (size_t)m * 768;
        {   float x[6]; float ss = 0.f;
#pragma unroll
            for (int j = 0; j < 3; ++j) { const unsigned w = *(const unsigned*)(row + 2 * C.lane + 128 * j); x[2 * j] = lo_bf(w); x[2 * j + 1] = hi_bf(w); ss += x[2 * j] * x[2 * j] + x[2 * j + 1] * x[2 * j + 1]; }
            const float rstd = RSQ(wave_sum(ss) * (1.f / 384.f) + EPS);
#pragma unroll
            for (int j = 0; j < 3; ++j) { const int c = 2 * C.lane + 128 * j; *(unsigned*)(row + c) = pk2(x[2 * j] * rstd * qn[c], x[2 * j + 1] * rstd * qn[c + 1]); } }
        {   float x[4]; float ss = 0.f;
#pragma unroll
            for (int j = 0; j < 2; ++j) { const unsigned w = *(const unsigned*)(row + 384 + 2 * C.lane + 128 * j); x[2 * j] = lo_bf(w); x[2 * j + 1] = hi_bf(w); ss += x[2 * j] * x[2 * j] + x[2 * j + 1] * x[2 * j + 1]; }
            const float rstd = RSQ(wave_sum(ss) * (1.f / 256.f) + EPS);
#pragma unroll
            for (int j = 0; j < 2; ++j) { const int c = 2 * C.lane + 128 * j; *(unsigned*)(row + 384 + c) = pk2(x[2 * j] * rstd * kvn[c], x[2 * j + 1] * rstd * kvn[c + 1]); } }
        {   const float x = bf2f(row[640 + C.lane]);
            const float rstd = RSQ(wave_sum(x * x) * (1.f / 64.f) + EPS);
            float y = x * rstd * gkr[C.lane];
            if (lat) { const float pr = __shfl_xor(y, 16); const float rot = (C.lane & 16) ? pr : -pr; const int f = C.lane & 15, pos = (C.lane < 32) ? (t >> 6) : (t & 63);
                y = y * cs[pos * 16 + f] + rot * sn[pos * 16 + f]; }
            row[640 + C.lane] = (bf16_t)f2bf(y); }
    }
}
__device__ __forceinline__ void phase_qk_post(Ctx& C, int l, bf16_t* QN, bf16_t* QP, bf16_t* KV) {
    const float* gqn = INP(21) + l * 128; const float* gqr = INP(22) + l * 64; const float* gkn = INP(23) + l * 128;
    const float* cs = C.ctl + CT_ROPEM; const float* sn = cs + 1024;
    for (int m = C.gw; m < MR; m += C.ngw) {
        const int b = m / SS, s = m - b * SS; const bool lat = s >= LC; const int t = s - LC;
        bf16_t* qrow = QN + (size_t)m * 1024; bf16_t* prow = QP + (size_t)m * 512; bf16_t* krow = KV + (size_t)m * 2048;
#pragma unroll
        for (int h = 0; h < 8; ++h) {
            {   unsigned* p = (unsigned*)(qrow + h * 128 + 2 * C.lane); const unsigned w = *p; const float x0 = lo_bf(w), x1 = hi_bf(w);
                const float rstd = RSQ(wave_sum(x0 * x0 + x1 * x1) * (1.f / 128.f) + EPS);
                *p = pk2(x0 * rstd * gqn[2 * C.lane] * QSCALE, x1 * rstd * gqn[2 * C.lane + 1] * QSCALE); }
            {   bf16_t* p = prow + h * 64 + C.lane; const float x = bf2f(*p);
                const float rstd = RSQ(wave_sum(x * x) * (1.f / 64.f) + EPS);
                float y = x * rstd * gqr[C.lane];
                if (lat) { const float pr = __shfl_xor(y, 16); const float rot = (C.lane & 16) ? pr : -pr; const int f = C.lane & 15, pos = (C.lane < 32) ? (t >> 6) : (t & 63);
                    y = y * cs[pos * 16 + f] + rot * sn[pos * 16 + f]; }
                *p = (bf16_t)f2bf(y * QSCALE); }
            {   unsigned* p = (unsigned*)(krow + h * 128 + 2 * C.lane); const unsigned w = *p; const float x0 = lo_bf(w), x1 = hi_bf(w);
                const float rstd = RSQ(wave_sum(x0 * x0 + x1 * x1) * (1.f / 128.f) + EPS);
                *p = pk2(x0 * rstd * gkn[2 * C.lane], x1 * rstd * gkn[2 * C.lane + 1]); }
        }
    }
}

__device__ __forceinline__ void phase_attn_naive(Ctx& C, bool with_ctx, bf16_t* QN, const bf16_t* QP, const bf16_t* KV, const bf16_t* MD) {
    LAS unsigned char* qs = C.lds + C.wave * 512;
    const int nlat = NB * 8 * (TT / 8), nctx = with_ctx ? NB * 8 * (LC / 8) : 0;
    for (int bu = C.bid; bu < nlat + nctx; bu += C.G) {
        int b, h, s, nkeys;
        if (bu < nlat) { const int tb = bu % (TT / 8), bh = bu / (TT / 8); b = bh >> 3; h = bh & 7; s = LC + tb * 8 + C.wave; nkeys = SS; }
        else { const int r = bu - nlat, tb = r % (LC / 8), bh = r / (LC / 8); b = bh >> 3; h = bh & 7; s = tb * 8 + C.wave; nkeys = LC; }
        const size_t m = (size_t)b * SS + s;
        asm volatile("s_waitcnt lgkmcnt(0)" ::: "memory");
        if (C.lane < 32) *(LAS u32x2*)(qs + C.lane * 8) = *(const u32x2*)(QN + m * 1024 + h * 128 + C.lane * 4);
        else if (C.lane < 48) *(LAS u32x2*)(qs + 256 + (C.lane - 32) * 8) = *(const u32x2*)(QP + m * 512 + h * 64 + (C.lane - 32) * 4);
        asm volatile("s_waitcnt lgkmcnt(0)" ::: "memory");
        float o[128];
#pragma unroll
        for (int e = 0; e < 128; ++e) o[e] = 0.f;
        float mrun = -1e30f, lrun = 0.f;
        for (int key = C.lane; key < nkeys; key += 64) {
            const size_t kr = (size_t)b * SS + key;
            const bf16_t* kn = KV + kr * 2048 + h * 128; const bf16_t* kro = MD + kr * 768 + 640;
            float dot = 0.f;
#pragma unroll 4
            for (int c = 0; c < 16; ++c) { const u32x4 kv = *(const u32x4*)(kn + c * 8); const u32x4 qv = *(const LAS u32x4*)(qs + c * 16);
                dot += lo_bf(kv.x) * lo_bf(qv.x) + hi_bf(kv.x) * hi_bf(qv.x) + lo_bf(kv.y) * lo_bf(qv.y) + hi_bf(kv.y) * hi_bf(qv.y)
                     + lo_bf(kv.z) * lo_bf(qv.z) + hi_bf(kv.z) * hi_bf(qv.z) + lo_bf(kv.w) * lo_bf(qv.w) + hi_bf(kv.w) * hi_bf(qv.w); }
#pragma unroll 4
            for (int c = 0; c < 8; ++c) { const u32x4 kv = *(const u32x4*)(kro + c * 8); const u32x4 qv = *(const LAS u32x4*)(qs + 256 + c * 16);
                dot += lo_bf(kv.x) * lo_bf(qv.x) + hi_bf(kv.x) * hi_bf(qv.x) + lo_bf(kv.y) * lo_bf(qv.y) + hi_bf(kv.y) * hi_bf(qv.y)
                     + lo_bf(kv.z) * lo_bf(qv.z) + hi_bf(kv.z) * hi_bf(qv.z) + lo_bf(kv.w) * lo_bf(qv.w) + hi_bf(kv.w) * hi_bf(qv.w); }
            const float mnew = fmaxf(mrun, dot), alpha = EX2(mrun - mnew), p = EX2(dot - mnew);
            lrun = lrun * alpha + p; mrun = mnew;
            const bf16_t* vrow = KV + kr * 2048 + 1024 + h * 128;
#pragma unroll
            for (int c = 0; c < 16; ++c) { const u32x4 vv = *(const u32x4*)(vrow + c * 8);
                o[c * 8 + 0] = o[c * 8 + 0] * alpha + p * lo_bf(vv.x); o[c * 8 + 1] = o[c * 8 + 1] * alpha + p * hi_bf(vv.x);
                o[c * 8 + 2] = o[c * 8 + 2] * alpha + p * lo_bf(vv.y); o[c * 8 + 3] = o[c * 8 + 3] * alpha + p * hi_bf(vv.y);
                o[c * 8 + 4] = o[c * 8 + 4] * alpha + p * lo_bf(vv.z); o[c * 8 + 5] = o[c * 8 + 5] * alpha + p * hi_bf(vv.z);
                o[c * 8 + 6] = o[c * 8 + 6] * alpha + p * lo_bf(vv.w); o[c * 8 + 7] = o[c * 8 + 7] * alpha + p * hi_bf(vv.w); }
        }
        const float mall = wave_max(mrun), fsc = EX2(mrun - mall);
        const float lall = wave_sum(lrun * fsc);
#pragma unroll
        for (int e = 0; e < 128; ++e) o[e] *= fsc;
        RS_STEP(o, 128, 32); RS_STEP(o, 64, 16); RS_STEP(o, 32, 8); RS_STEP(o, 16, 4); RS_STEP(o, 8, 2); RS_STEP(o, 4, 1);
        const float inv = 1.f / lall;
        *(unsigned*)(QN + m * 1024 + h * 128 + 2 * C.lane) = pk2(o[0] * inv, o[1] * inv);
    }
}

__device__ __forceinline__ void phase_conv(Ctx& C, int l, const bf16_t* XA, bf16_t* U) {
    const float* cw = INP(8) + l * 4 * 1024; const float* cb = INP(9) + l * 1024;
    const int gt = C.bid * NTHR + C.tid, ngt = C.G * NTHR;
    for (int it = gt; it < MR * 128; it += ngt) {
        const int m = it >> 7, c0 = (it & 127) * 8, b = m / SS, s = m - b * SS;
        const int lo = (s < LC) ? 0 : LC, hi = (s < LC) ? LC : SS;
        float a[8];
#pragma unroll
        for (int e = 0; e < 8; ++e) a[e] = cb[c0 + e];
#pragma unroll
        for (int j = 0; j < 4; ++j) { const int sj = s + j - 2;
            if (sj >= lo && sj < hi) { const u32x4 xv = *(const u32x4*)(XA + (size_t)(b * SS + sj) * 1024 + c0); const float* w = cw + j * 1024 + c0;
                a[0] += w[0] * lo_bf(xv.x); a[1] += w[1] * hi_bf(xv.x); a[2] += w[2] * lo_bf(xv.y); a[3] += w[3] * hi_bf(xv.y);
                a[4] += w[4] * lo_bf(xv.z); a[5] += w[5] * hi_bf(xv.z); a[6] += w[6] * lo_bf(xv.w); a[7] += w[7] * hi_bf(xv.w); } }
        u32x4 o; o.x = pk2(a[0], a[1]); o.y = pk2(a[2], a[3]); o.z = pk2(a[4], a[5]); o.w = pk2(a[6], a[7]);
        *(u32x4*)(U + (size_t)m * 1024 + c0) = o;
    }
}
typedef f16_t f16x2 __attribute__((ext_vector_type(2)));
__device__ __forceinline__ void phase_scan1(Ctx& C, int d, const f16_t* RI, float* SUM) {
    for (int un = C.gw; un < NB * 68 * 8; un += C.ngw) {
        const int cg_ = un & 7, sg = (un >> 3) % 68, b = (un >> 3) / 68, ch = cg_ * 128 + 2 * C.lane;
        float A0 = 1.f, A1 = 1.f, H0 = 0.f, H1 = 0.f;
        const f16_t* base = RI + (size_t)(b * SS + sg * 64) * 2048 + ch;
#pragma unroll 16
        for (int i = 0; i < 64; ++i) { const int r = d ? (63 - i) : i;
            const f16x2 la = *(const f16x2*)(base + (size_t)r * 2048), bc = *(const f16x2*)(base + (size_t)r * 2048 + 1024);
            const float a0 = EX2((float)la[0]), a1 = EX2((float)la[1]);
            H0 = a0 * H0 + (float)bc[0]; H1 = a1 * H1 + (float)bc[1]; A0 *= a0; A1 *= a1; }
        float* sp = SUM + ((size_t)(b * 68 + sg) * 1024 + ch) * 2;
        *(f32x4*)sp = (f32x4){A0, H0, A1, H1};
    }
}
__device__ __forceinline__ void phase_scan3(Ctx& C, int d, const f16_t* RI, const float* SUM, bf16_t* YA) {
    for (int un = C.gw; un < NB * 68 * 8; un += C.ngw) {
        const int cg_ = un & 7, sg = (un >> 3) % 68, b = (un >> 3) / 68, ch = cg_ * 128 + 2 * C.lane;
        float H0 = 0.f, H1 = 0.f;
        const int npre = d ? ((sg < 4) ? (3 - sg) : (71 - sg)) : sg;
#pragma unroll 4
        for (int p = 0; p < npre; ++p) { const int ps = d ? ((p < 4) ? (3 - p) : (71 - p)) : p;
            const f32x4 v = *(const f32x4*)(SUM + ((size_t)(b * 68 + ps) * 1024 + ch) * 2);
            H0 = v[0] * H0 + v[1]; H1 = v[2] * H1 + v[3]; }
        const f16_t* base = RI + (size_t)(b * SS + sg * 64) * 2048 + ch;
        bf16_t* yb = YA + (size_t)(b * SS + sg * 64) * 1024 + ch;
#pragma unroll 16
        for (int i = 0; i < 64; ++i) { const int r = d ? (63 - i) : i;
            const f16x2 la = *(const f16x2*)(base + (size_t)r * 2048), bc = *(const f16x2*)(base + (size_t)r * 2048 + 1024);
            const float a0 = EX2((float)la[0]), a1 = EX2((float)la[1]);
            H0 = a0 * H0 + (float)bc[0]; H1 = a1 * H1 + (float)bc[1];
            unsigned* yp = (unsigned*)(yb + (size_t)r * 1024);
            if (d == 0) *yp = pk2(H0, H1); else { const unsigned w = *yp; *yp = pk2(lo_bf(w) + H0, hi_bf(w) + H1); } }
    }
}

template <int W> __device__ __forceinline__ float group_sum(float v) {
#pragma unroll
    for (int o = 1; o < W; o <<= 1) v += __shfl_xor(v, o);
    return v;
}
__device__ __forceinline__ void phase_h2(Ctx& C, int l, bf16_t* H) {
    const float* gain = INP(6) + l * 1024;
    for (int m0 = C.gw * 2; m0 < MR; m0 += C.ngw * 2) {
        f32x4 v[2][4]; float ss[2];
#pragma unroll
        for (int q = 0; q < 2; ++q) { const float* xr = resid_row(C, l, m0 + q);
#pragma unroll
            for (int j = 0; j < 4; ++j) v[q][j] = *(const f32x4*)(xr + 4 * C.lane + 256 * j); }
        const int b = m0 / SS, s = m0 - b * SS, r = (s < LC) ? 4 : b;
        const float* mod = C.ctl + CT_MOD + (l * 5 + r) * 3072;
#pragma unroll
        for (int q = 0; q < 2; ++q) { float a = 0.f;
#pragma unroll
            for (int j = 0; j < 4; ++j) a += (v[q][j].x * v[q][j].x + v[q][j].y * v[q][j].y) + (v[q][j].z * v[q][j].z + v[q][j].w * v[q][j].w);
            ss[q] = a; }
        ss[0] = wave_sum(ss[0]); ss[1] = wave_sum(ss[1]);
#pragma unroll
        for (int j = 0; j < 4; ++j) { const int c = 4 * C.lane + 256 * j;
            const f32x4 g = *(const f32x4*)(gain + c), sh = *(const f32x4*)(mod + c), sc = *(const f32x4*)(mod + 1024 + c) + 1.0f;
#pragma unroll
            for (int q = 0; q < 2; ++q) { const float rstd = RSQ(ss[q] * (1.f / 1024.f) + EPS);
                const f32x4 o = ((v[q][j] * rstd) * g) * sc + sh;
                u32x2 w; w.x = pk2(o.x, o.y); w.y = pk2(o.z, o.w);
                *(u32x2*)(H + (size_t)(m0 + q) * 1024 + c) = w; } }
    }
}
__device__ __forceinline__ void phase_md_post2(Ctx& C, int l, bf16_t* MD) {
    const float* qn = INP(17) + l * 384; const float* kvn = INP(19) + l * 256; const float* gkr = INP(24) + l * 64;
    const float* cs = C.ctl + CT_ROPEM; const float* sn = cs + 1024;
    const int L = C.lane;
    for (int m0 = C.gw * 2; m0 < MR; m0 += C.ngw * 2) {
        u32x4 w0[2], w1[2];
#pragma unroll
        for (int q = 0; q < 2; ++q) { const bf16_t* row = MD + (size_t)(m0 + q) * 768; w0[q] = *(const u32x4*)(row + 8 * L); w1[q] = (L < 32) ? *(const u32x4*)(row + 512 + 8 * L) : (u32x4){0u, 0u, 0u, 0u}; }
#pragma unroll
        for (int q = 0; q < 2; ++q) { const int m = m0 + q, b = m / SS, s = m - b * SS; const bool lat = s >= LC; const int t = s - LC;
            bf16_t* row = MD + (size_t)m * 768;
            float x0[8], x1[8]; unpack8(w0[q], x0); unpack8(w1[q], x1);
            const float s0 = sumsq8(x0), s1 = sumsq8(x1);
            const float sq = wave_sum(L < 48 ? s0 : 0.f), skv = wave_sum((L >= 48 ? s0 : 0.f) + (L < 16 ? s1 : 0.f)), skr = wave_sum((L >= 16 && L < 24) ? s1 : 0.f);
            const float rq = RSQ(sq * (1.f / 384.f) + EPS), rkv = RSQ(skv * (1.f / 256.f) + EPS), rkr = RSQ(skr * (1.f / 64.f) + EPS);
            {   const float* g = (L < 48) ? (qn + 8 * L) : (kvn + 8 * (L - 48)); const float rs = (L < 48) ? rq : rkv;
#pragma unroll
                for (int e = 0; e < 8; ++e) x0[e] *= rs * g[e];
                *(u32x4*)(row + 8 * L) = pack8u(x0); }
            if (L < 16) {
#pragma unroll
                for (int e = 0; e < 8; ++e) x1[e] *= rkv * kvn[128 + 8 * L + e];
            } else if (L < 24) {
#pragma unroll
                for (int e = 0; e < 8; ++e) x1[e] *= rkr * gkr[8 * (L - 16) + e];
            }
            float pr[8];
#pragma unroll
            for (int e = 0; e < 8; ++e) pr[e] = __shfl_xor(x1[e], 2);
            if (lat && L >= 16 && L < 24) { const int qt = (L - 16) >> 1, f0 = ((L - 16) & 1) * 8, pos = (qt < 2) ? (t >> 6) : (t & 63); const float sg = (qt & 1) ? 1.f : -1.f;
#pragma unroll
                for (int e = 0; e < 8; ++e) x1[e] = x1[e] * cs[pos * 16 + f0 + e] + sg * pr[e] * sn[pos * 16 + f0 + e]; }
            if (L < 24) *(u32x4*)(row + 512 + 8 * L) = pack8u(x1);
        }
    }
}
__device__ __forceinline__ void phase_qk_post2(Ctx& C, int l, bf16_t* QN, bf16_t* QP, bf16_t* KV) {
    const float* gqn = INP(21) + l * 128; const float* gqr = INP(22) + l * 64; const float* gkn = INP(23) + l * 128;
    const float* cs = C.ctl + CT_ROPEM; const float* sn = cs + 1024;
    const int L = C.lane;
    for (int m0 = C.gw * 2; m0 < MR; m0 += C.ngw * 2) {
        u32x4 a[2][2], k[2][2], p[2];
#pragma unroll
        for (int q = 0; q < 2; ++q) { const size_t m = m0 + q;
            a[q][0] = *(const u32x4*)(QN + m * 1024 + 8 * L); a[q][1] = *(const u32x4*)(QN + m * 1024 + 512 + 8 * L);
            k[q][0] = *(const u32x4*)(KV + m * 2048 + 8 * L); k[q][1] = *(const u32x4*)(KV + m * 2048 + 512 + 8 * L);
            p[q] = *(const u32x4*)(QP + m * 512 + 8 * L); }
#pragma unroll
        for (int q = 0; q < 2; ++q) { const int m = m0 + q, b = m / SS, s = m - b * SS; const bool lat = s >= LC; const int t = s - LC;
#pragma unroll
            for (int c = 0; c < 2; ++c) {
                float x[8]; unpack8(a[q][c], x);
                const float rs = RSQ(group_sum<16>(sumsq8(x)) * (1.f / 128.f) + EPS) * QSCALE;
#pragma unroll
                for (int e = 0; e < 8; ++e) x[e] *= rs * gqn[8 * (L & 15) + e];
                *(u32x4*)(QN + (size_t)m * 1024 + c * 512 + 8 * L) = pack8u(x);
                float y[8]; unpack8(k[q][c], y);
                const float rk = RSQ(group_sum<16>(sumsq8(y)) * (1.f / 128.f) + EPS);
#pragma unroll
                for (int e = 0; e < 8; ++e) y[e] *= rk * gkn[8 * (L & 15) + e];
                *(u32x4*)(KV + (size_t)m * 2048 + c * 512 + 8 * L) = pack8u(y); }
            {   float x[8]; unpack8(p[q], x);
                const float rs = RSQ(group_sum<8>(sumsq8(x)) * (1.f / 64.f) + EPS);
#pragma unroll
                for (int e = 0; e < 8; ++e) x[e] *= rs * gqr[8 * (L & 7) + e];
                float pr[8];
#pragma unroll
                for (int e = 0; e < 8; ++e) pr[e] = __shfl_xor(x[e], 2);
                if (lat) { const int qt = (L >> 1) & 3, f0 = (L & 1) * 8, pos = (qt < 2) ? (t >> 6) : (t & 63); const float sg = (qt & 1) ? 1.f : -1.f;
#pragma unroll
                    for (int e = 0; e < 8; ++e) x[e] = x[e] * cs[pos * 16 + f0 + e] + sg * pr[e] * sn[pos * 16 + f0 + e]; }
#pragma unroll
                for (int e = 0; e < 8; ++e) x[e] *= QSCALE;
                *(u32x4*)(QP + (size_t)m * 512 + 8 * L) = pack8u(x); }
        }
    }
}
__device__ __forceinline__ void phase_ret_ln3(Ctx& C, int l, bf16_t* OI, const bf16_t* OB) {
    const float* gain = INP(16) + l * 1024;
    const int L = C.lane;
    for (int m0 = C.gw * 2; m0 < MR; m0 += C.ngw * 2) {
        u32x4 a[2][2], bb[2][2];
#pragma unroll
        for (int q = 0; q < 2; ++q)
#pragma unroll
            for (int c = 0; c < 2; ++c) { a[q][c] = *(const u32x4*)(OI + (size_t)(m0 + q) * 1024 + c * 512 + 8 * L); bb[q][c] = *(const u32x4*)(OB + (size_t)(m0 + q) * 1024 + c * 512 + 8 * L); }
#pragma unroll
        for (int q = 0; q < 2; ++q)
#pragma unroll
            for (int c = 0; c < 2; ++c) { float x[8], y[8]; unpack8(a[q][c], x); unpack8(bb[q][c], y);
                float s = 0.f;
#pragma unroll
                for (int e = 0; e < 8; ++e) { x[e] += y[e]; s += x[e]; }
                const float mean = group_sum<32>(s) * (1.f / 256.f);
                float v = 0.f;
#pragma unroll
                for (int e = 0; e < 8; ++e) { x[e] -= mean; v += x[e] * x[e]; }
                const float rstd = RSQ(group_sum<32>(v) * (1.f / 256.f) + EPS);
#pragma unroll
                for (int e = 0; e < 8; ++e) x[e] *= rstd * gain[c * 512 + 8 * L + e];
                *(u32x4*)(OI + (size_t)(m0 + q) * 1024 + c * 512 + 8 * L) = pack8u(x); }
    }
}

__device__ __forceinline__ void phase_zsum(Ctx& C, const bf16_t* ZP, bf16_t* Z) {
    const int gt = C.bid * NTHR + C.tid, ngt = C.G * NTHR;
    for (int it = gt; it < 1024 * 128; it += ngt) { const int r = it >> 7, c0 = (it & 127) * 8, b = r >> 8, s = r & 255;
        const u32x4 a = *(const u32x4*)(ZP + (size_t)r * 1024 + c0), bq = *(const u32x4*)(ZP + (size_t)(1024 + r) * 1024 + c0), cq = *(const u32x4*)(ZP + (size_t)(2048 + r) * 1024 + c0);
        float x[8], y[8], z[8]; unpack8(a, x); unpack8(bq, y); unpack8(cq, z);
#pragma unroll
        for (int e = 0; e < 8; ++e) x[e] += y[e] + z[e];
        *(u32x4*)(Z + (size_t)(b * SS + s) * 1024 + c0) = pack8u(x); }
}

typedef float f32x16 __attribute__((ext_vector_type(16)));
typedef short v4i16_t __attribute__((ext_vector_type(4)));
constexpr int AT_KP = 400, AT_VP = 320;
constexpr int AT_KB = 64 * AT_KP, AT_VB = 64 * AT_VP, AT_STG = AT_KB + AT_VB, AT_WSF = 2 * AT_STG;
__device__ __forceinline__ int crow(int r, int hi) { return (r & 3) + 8 * (r >> 2) + 4 * hi; }
__device__ __forceinline__ bf16x8 pack8(float a, float b, float c, float d, float e, float f, float g, float h) {
    u32x4 w; w.x = pg8::cvt_pk_bf16(a, b); w.y = pg8::cvt_pk_bf16(c, d); w.z = pg8::cvt_pk_bf16(e, f); w.w = pg8::cvt_pk_bf16(g, h); return __builtin_bit_cast(bf16x8, w); }
__device__ __forceinline__ bf16x8 tr2(LAS unsigned char* p0, LAS unsigned char* p1) {
    const v4i16_t lo = __builtin_amdgcn_ds_read_tr16_b64_v4i16((LAS v4i16_t*)p0), hi = __builtin_amdgcn_ds_read_tr16_b64_v4i16((LAS v4i16_t*)p1);
    return (bf16x8){lo[0], lo[1], lo[2], lo[3], hi[0], hi[1], hi[2], hi[3]}; }

__device__ __forceinline__ void phase_attn(Ctx& C, int l, bool with_ctx, bf16_t* QN, const bf16_t* QP, const bf16_t* KV, const bf16_t* MD) {
    const float* gqn = INP(21) + l * 128; const float* gqr = INP(22) + l * 64; const float* csm = C.ctl + CT_ROPEM;
    const int lane = C.lane, r32 = lane & 31, hi = lane >> 5, wave = C.wave, tid = C.tid;
    LAS unsigned char* lds = C.lds;
    LAS float* wsf = (LAS float*)(lds + AT_WSF + wave * 128);
    const int nunits = 512 + (with_ctx ? 32 : 0);
    const int rowA = tid >> 4, ccA = tid & 15, rowR = tid >> 3, ccR = tid & 7;
    const int i16 = lane & 15, q4 = i16 >> 2, p4 = i16 & 3, g1 = (lane >> 4) & 1;
    const int vb = AT_KB + (4 * hi + q4) * AT_VP + (16 * g1 + 4 * p4) * 2;
    const int wK = rowA * AT_KP + ccA * 16, wR = rowR * AT_KP + 256 + ccR * 16, wV = AT_KB + rowA * AT_VP + ccA * 16;
    for (int un = C.bid; un < nunits; un += C.G) {
        int bh, qb, isctx;
        if (un < 512) { const int x = un & 7, jj = un >> 3; bh = x * 4 + (jj >> 4); qb = jj & 15; isctx = 0; } else { bh = un - 512; qb = 0; isctx = 1; }
        const int b = bh >> 3, h = bh & 7;
        const size_t kb0 = (size_t)b * SS;
        const size_t m0 = kb0 + (isctx ? 0 : LC + qb * 256) + wave * 32;
        const int NT = (isctx ? LC : SS) / 64;
        bf16x8 qf[12];
        {   const bf16_t* qn = QN + (m0 + r32) * 1024 + h * 128 + hi * 8; const bf16_t* qp = QP + (m0 + r32) * 512 + h * 64 + hi * 8;
#pragma unroll
            for (int s = 0; s < 8; ++s) qf[s] = *(const bf16x8*)(qn + s * 16);
#pragma unroll
            for (int s = 0; s < 4; ++s) qf[8 + s] = *(const bf16x8*)(qp + s * 16); }
        {
            int hq = hi; asm volatile("" : "+v"(hq));
            float ssn = 0.f, ssr = 0.f;
#pragma unroll
            for (int s = 0; s < 12; ++s) { float x[8]; unpack8(__builtin_bit_cast(u32x4, qf[s]), x); const float q = sumsq8(x); if (s < 8) ssn += q; else ssr += q; }
            ssn += __shfl_xor(ssn, 32); ssr += __shfl_xor(ssr, 32);
            const float rn = RSQ(ssn * (1.f / 128.f) + EPS) * QSCALE, rr = RSQ(ssr * (1.f / 64.f) + EPS);
#pragma unroll
            for (int s = 0; s < 8; ++s) { float x[8]; unpack8(__builtin_bit_cast(u32x4, qf[s]), x);
                const f32x4 ga = *(const f32x4*)(gqn + 16 * s + 8 * hq), gb = *(const f32x4*)(gqn + 16 * s + 8 * hq + 4);
                x[0] *= rn * ga[0]; x[1] *= rn * ga[1]; x[2] *= rn * ga[2]; x[3] *= rn * ga[3]; x[4] *= rn * gb[0]; x[5] *= rn * gb[1]; x[6] *= rn * gb[2]; x[7] *= rn * gb[3];
                qf[s] = __builtin_bit_cast(bf16x8, pack8u(x)); }
            const int tq = qb * 256 + wave * 32 + r32;
#pragma unroll
            for (int pr = 0; pr < 2; ++pr) {
                float xa[8], xb[8]; unpack8(__builtin_bit_cast(u32x4, qf[8 + 2 * pr]), xa); unpack8(__builtin_bit_cast(u32x4, qf[9 + 2 * pr]), xb);
#pragma unroll
                for (int j = 0; j < 8; ++j) { xa[j] *= rr * gqr[32 * pr + 8 * hq + j]; xb[j] *= rr * gqr[32 * pr + 16 + 8 * hq + j]; }
                if (!isctx) { const int pos = pr ? (tq & 63) : (tq >> 6);
#pragma unroll
                    for (int j = 0; j < 8; ++j) { const float c = csm[pos * 16 + 8 * hq + j], sv = csm[1024 + pos * 16 + 8 * hq + j]; const float a = xa[j] * c - xb[j] * sv, bq = xb[j] * c + xa[j] * sv; xa[j] = a; xb[j] = bq; } }
#pragma unroll
                for (int j = 0; j < 8; ++j) { xa[j] *= QSCALE; xb[j] *= QSCALE; }
                qf[8 + 2 * pr] = __builtin_bit_cast(bf16x8, pack8u(xa)); qf[9 + 2 * pr] = __builtin_bit_cast(bf16x8, pack8u(xb)); }
        }
        f32x16 o[4];
#pragma unroll
        for (int d = 0; d < 4; ++d)
#pragma unroll
            for (int r = 0; r < 16; ++r) o[d][r] = 0.f;
        float mrun = -1e30f, lrun = 0.f;
        u32x4 kn0, kn1, kr0, vv0, vv1;
        const unsigned kvo = (unsigned)(((kb0 + rowA) * 2048 + h * 128 + ccA * 8) * 2);
        const unsigned kro = (unsigned)(((kb0 + rowR) * 768 + 640 + ccR * 8) * 2);
#define AT_LOAD(t) do { const char* kp_ = (const char*)KV + (size_t)(t) * (64 * 2048 * 2); kn0 = *(const u32x4*)(kp_ + kvo); kn1 = *(const u32x4*)(kp_ + 32 * 2048 * 2 + kvo); vv0 = *(const u32x4*)(kp_ + 1024 * 2 + kvo); vv1 = *(const u32x4*)(kp_ + (32 * 2048 + 1024) * 2 + kvo); \
        kr0 = *(const u32x4*)((const char*)MD + (size_t)(t) * (64 * 768 * 2) + kro); } while (0)
#define AT_WRITE(sb) do { int sb_ = (sb); asm volatile("" : "+s"(sb_)); LAS unsigned char* s_ = lds + sb_;     \
        *(LAS u32x4*)(s_ + wK) = kn0; *(LAS u32x4*)(s_ + wK + 32 * AT_KP) = kn1; \
        *(LAS u32x4*)(s_ + wR) = kr0; *(LAS u32x4*)(s_ + wV) = vv0; *(LAS u32x4*)(s_ + wV + 32 * AT_VP) = vv1; } while (0)
#define AT_QK(sbv) do { _Pragma("unroll") for (int r = 0; r < 16; ++r) { p0[r] = 0.f; p1[r] = 0.f; } \
        LAS unsigned char* ka = lds + (sbv) + r32 * AT_KP + hi * 16; __builtin_amdgcn_s_setprio(1); \
        _Pragma("unroll") for (int s = 0; s < 12; ++s) { const bf16x8 a0 = *(const LAS bf16x8*)(ka + s * 32), a1 = *(const LAS bf16x8*)(ka + 32 * AT_KP + s * 32); \
            p0 = __builtin_amdgcn_mfma_f32_32x32x16_bf16(a0, qf[s], p0, 0, 0, 0); p1 = __builtin_amdgcn_mfma_f32_32x32x16_bf16(a1, qf[s], p1, 0, 0, 0); \
            if ((s & 3) == 3) asm volatile("" ::: "memory"); } \
        __builtin_amdgcn_s_setprio(0); } while (0)
#define AT_SM() do { float rm = fmaxf(p0[0], p1[0]); \
        _Pragma("unroll") for (int r = 1; r < 16; ++r) rm = fmaxf(rm, fmaxf(p0[r], p1[r])); \
        rm = fmaxf(rm, __shfl_xor(rm, 32)); \
        if (__any(rm > mrun + 8.f)) { const float mnew = fmaxf(mrun, rm), alpha = EX2(mrun - mnew); mrun = mnew; lrun *= alpha; \
            if (hi == 0) wsf[r32] = alpha; \
            _Pragma("unroll") for (int r = 0; r < 16; ++r) { const float a = wsf[crow(r, hi)]; _Pragma("unroll") for (int d = 0; d < 4; ++d) o[d][r] *= a; } } \
        float ls = 0.f; \
        _Pragma("unroll") for (int r = 0; r < 16; ++r) { p0[r] = EX2(p0[r] - mrun); p1[r] = EX2(p1[r] - mrun); ls += p0[r] + p1[r]; } \
        lrun += ls; \
        pa0 = pack8(p0[0], p0[1], p0[2], p0[3], p0[4], p0[5], p0[6], p0[7]); pa1 = pack8(p0[8], p0[9], p0[10], p0[11], p0[12], p0[13], p0[14], p0[15]); \
        pa2 = pack8(p1[0], p1[1], p1[2], p1[3], p1[4], p1[5], p1[6], p1[7]); pa3 = pack8(p1[8], p1[9], p1[10], p1[11], p1[12], p1[13], p1[14], p1[15]); } while (0)
#define AT_PV(sbv) do { LAS unsigned char* vp = lds + (sbv) + vb; __builtin_amdgcn_s_setprio(1); \
        _Pragma("unroll") for (int d = 0; d < 4; ++d) o[d] = __builtin_amdgcn_mfma_f32_32x32x16_bf16(pa0, tr2(vp + d * 64, vp + d * 64 + 8 * AT_VP), o[d], 0, 0, 0); \
        asm volatile("" ::: "memory"); \
        _Pragma("unroll") for (int d = 0; d < 4; ++d) o[d] = __builtin_amdgcn_mfma_f32_32x32x16_bf16(pa1, tr2(vp + d * 64 + 16 * AT_VP, vp + d * 64 + 24 * AT_VP), o[d], 0, 0, 0); \
        asm volatile("" ::: "memory"); \
        _Pragma("unroll") for (int d = 0; d < 4; ++d) o[d] = __builtin_amdgcn_mfma_f32_32x32x16_bf16(pa2, tr2(vp + d * 64 + 32 * AT_VP, vp + d * 64 + 40 * AT_VP), o[d], 0, 0, 0); \
        asm volatile("" ::: "memory"); \
        _Pragma("unroll") for (int d = 0; d < 4; ++d) o[d] = __builtin_amdgcn_mfma_f32_32x32x16_bf16(pa3, tr2(vp + d * 64 + 48 * AT_VP, vp + d * 64 + 56 * AT_VP), o[d], 0, 0, 0); \
        asm volatile("" ::: "memory"); \
        __builtin_amdgcn_s_setprio(0); } while (0)
        AT_LOAD(0); AT_WRITE(0);
        __syncthreads();
        bf16x8 pa0, pa1, pa2, pa3;
        if (wave < 4) {
            for (int t = 0; t < NT; ++t) {
                const int sb = (t & 1) * AT_STG;
                if (t + 1 < NT) AT_LOAD(t + 1);
                f32x16 p0, p1;
                AT_QK(sb);
                __syncthreads();
                if (t + 1 < NT) AT_WRITE(AT_STG - sb);
                AT_SM(); AT_PV(sb);
                __syncthreads();
            }
            __syncthreads(); __syncthreads();
        } else {
            for (int t = 0; t <= NT; ++t) {
                const int sb = (t & 1) * AT_STG;
                if (t + 1 < NT) AT_LOAD(t + 1);
                if (t > 0) AT_PV(AT_STG - sb);
                __syncthreads();
                if (t + 1 < NT) AT_WRITE(AT_STG - sb);
                if (t < NT) { f32x16 p0, p1; AT_QK(sb); AT_SM(); }
                __syncthreads();
            }
        }
#undef AT_QK
#undef AT_SM
#undef AT_PV
#undef AT_LOAD
#undef AT_WRITE
        const float ltot = lrun + __shfl_xor(lrun, 32);
        if (hi == 0) wsf[r32] = 1.f / ltot;
        bf16_t* op = QN + (m0 + 4 * hi) * 1024 + h * 128 + r32;
#pragma unroll
        for (int r = 0; r < 16; ++r) { const float inv = wsf[crow(r, hi)];
#pragma unroll
            for (int d = 0; d < 4; ++d) op[d * 32] = (bf16_t)f2bf(o[d][r] * inv);
            op += ((r & 3) == 3) ? 5 * 1024 : 1024; OPAQ_G(op); }
        __syncthreads();
    }
}

constexpr int RI_KP = 528, RI_VP = 576, RI_PTP = 272;
constexpr int RI_A = 0, RI_PT = 128 * RI_VP;
__device__ __forceinline__ void phase_ret_intra(Ctx& C, int l, const bf16_t* RQKV, bf16_t* OI) {
    const int lane = C.lane, r32 = lane & 31, hi = lane >> 5, wave = C.wave, tid = C.tid;
    LAS unsigned char* lds = C.lds;
    const int i16 = lane & 15, q4 = i16 >> 2, p4 = i16 & 3, g1 = (lane >> 4) & 1;
    const int nb = wave & 3, wh = wave >> 2;
    const int srow = tid >> 5, scc = tid & 31;
    for (int un = C.bid; un < NB * 4 * 34; un += C.G) {
        const int c = un % 34, bh = un / 34, b = bh >> 2, h = bh & 3;
        const size_t row0 = (size_t)b * SS + c * 128;
        const float lgf = C.ctl[CT_LG + (l * 2 + 0) * 4 + h], lgb = C.ctl[CT_LG + (l * 2 + 1) * 4 + h];
        const bf16_t* gk = RQKV + (row0 + srow) * 3072 + 1024 + h * 256 + scc * 8;
        u32x4 st[8];
        {   const bf16_t* gp = gk;
#pragma unroll
            for (int j = 0; j < 8; ++j) { st[j] = *(const u32x4*)gp; gp += 16 * 3072; OPAQ_G(gp); } }
#pragma unroll
        for (int j = 0; j < 8; ++j) *(LAS u32x4*)(lds + RI_A + (srow + 16 * j) * RI_KP + scc * 16) = st[j];
        __syncthreads();
        {   const bf16_t* gp = gk + 1024;
#pragma unroll
            for (int j = 0; j < 8; ++j) { st[j] = *(const u32x4*)gp; gp += 16 * 3072; OPAQ_G(gp); } }
        {
            f32x16 x0, x1;
#pragma unroll
            for (int r = 0; r < 16; ++r) { x0[r] = 0.f; x1[r] = 0.f; }
            const bf16_t* gq = RQKV + (row0 + nb * 32 + r32) * 3072 + h * 256 + hi * 8;
            LAS unsigned char* ka = lds + RI_A + (wh * 64 + r32) * RI_KP + hi * 16;
#pragma unroll
            for (int s = 0; s < 16; ++s) { const bf16x8 qf = *(const bf16x8*)(gq + s * 16);
                const bf16x8 a0 = *(const LAS bf16x8*)(ka + s * 32), a1 = *(const LAS bf16x8*)(ka + 32 * RI_KP + s * 32);
                x0 = __builtin_amdgcn_mfma_f32_32x32x16_bf16(a0, qf, x0, 0, 0, 0); x1 = __builtin_amdgcn_mfma_f32_32x32x16_bf16(a1, qf, x1, 0, 0, 0);
                if ((s & 3) == 3) asm volatile("" ::: "memory"); }
            const int n = nb * 32 + r32;
            LAS unsigned char* pt = lds + RI_PT + n * RI_PTP + (wh * 64 + 4 * hi) * 2;
#pragma unroll
            for (int g = 0; g < 4; ++g) { float w0[4], w1[4];
#pragma unroll
                for (int e = 0; e < 4; ++e) { const int m0 = wh * 64 + 8 * g + 4 * hi + e; const float d0 = (float)(n - m0), d1 = d0 - 32.f;
                    const float f0 = EX2(lgf * fmaxf(d0, 0.f)) * fminf(fmaxf(d0 + 1.f, 0.f), 1.f) + EX2(lgb * fmaxf(-d0, 0.f)) * fminf(fmaxf(1.f - d0, 0.f), 1.f);
                    const float f1 = EX2(lgf * fmaxf(d1, 0.f)) * fminf(fmaxf(d1 + 1.f, 0.f), 1.f) + EX2(lgb * fmaxf(-d1, 0.f)) * fminf(fmaxf(1.f - d1, 0.f), 1.f);
                    w0[e] = x0[4 * g + e] * f0; w1[e] = x1[4 * g + e] * f1; }
                u32x2 o0, o1; o0.x = pg8::cvt_pk_bf16(w0[0], w0[1]); o0.y = pg8::cvt_pk_bf16(w0[2], w0[3]); o1.x = pg8::cvt_pk_bf16(w1[0], w1[1]); o1.y = pg8::cvt_pk_bf16(w1[2], w1[3]);
                *(LAS u32x2*)(pt + g * 16) = o0; *(LAS u32x2*)(pt + 64 + g * 16) = o1; }
        }
        __syncthreads();
#pragma unroll
        for (int j = 0; j < 8; ++j) *(LAS u32x4*)(lds + RI_A + (srow + 16 * j) * RI_VP + scc * 16) = st[j];
        __syncthreads();
        {
            f32x16 o[4];
#pragma unroll
            for (int d = 0; d < 4; ++d)
#pragma unroll
                for (int r = 0; r < 16; ++r) o[d][r] = 0.f;
            bf16x8 pa[8];
            LAS unsigned char* pr = lds + RI_PT + (nb * 32 + r32) * RI_PTP + hi * 16;
#pragma unroll
            for (int s = 0; s < 8; ++s) pa[s] = *(const LAS bf16x8*)(pr + s * 32);
            LAS unsigned char* vp = lds + RI_A + (8 * hi + q4) * RI_VP + (wh * 128 + 16 * g1 + 4 * p4) * 2;
#pragma unroll
            for (int d = 0; d < 4; ++d) {
#pragma unroll
                for (int s = 0; s < 8; ++s) o[d] = __builtin_amdgcn_mfma_f32_32x32x16_bf16(pa[s], tr2(vp + d * 64 + s * 16 * RI_VP, vp + d * 64 + (s * 16 + 4) * RI_VP), o[d], 0, 0, 0);
                asm volatile("" ::: "memory"); }
            bf16_t* op = OI + (row0 + nb * 32 + 4 * hi) * 1024 + h * 256 + wh * 128 + r32;
#pragma unroll
            for (int r = 0; r < 16; ++r) {
#pragma unroll
                for (int d = 0; d < 4; ++d) op[d * 32] = (bf16_t)f2bf(o[d][r]);
                op += ((r & 3) == 3) ? 5 * 1024 : 1024; OPAQ_G(op); }
        }
        __syncthreads();
    }
}

constexpr int RC_KT = 0, RC_KTP = 576, RC_VT = 128 * 576, RC_VTP = 64, RC_ST = RC_VT + 128 * 64, RC_STP = 528, RC_XO = RC_ST + 32 * 528, RC_END = RC_XO + 16384;
static_assert(RC_END <= 131072, "R-chain LDS");
__device__ __forceinline__ void phase_ret_chain(Ctx& C, int l, const bf16_t* RQKV, bf16_t* OI, bf16_t* OB) {
    const int lane = C.lane, r32 = lane & 31, hi = lane >> 5, wave = C.wave, tid = C.tid;
    LAS unsigned char* lds = C.lds;
    const int i16 = lane & 15, q4 = i16 >> 2, p4 = i16 & 3, g1 = (lane >> 4) & 1;
    const int nb = wave & 3, dh = wave >> 2;
    const int srow = tid >> 5, scc = tid & 31, vrow = tid >> 2, vcc = tid & 3;
    for (int un = C.bid; un < 256; un += C.G) {
        const int x = un & 7, j8 = un >> 3, bhd = x * 4 + (j8 >> 3), sl = j8 & 7, b = bhd >> 3, h = (bhd >> 1) & 3, dir = bhd & 1;
        const float lg = C.ctl[CT_LG + (l * 2 + dir) * 4 + h];
        const float cdec = EX2(lg * 128.f);
        const float vdec = dir ? EX2(lg * (float)vrow) : EX2(lg * (float)(127 - vrow));
        f32x16 sacc;
#pragma unroll
        for (int r = 0; r < 16; ++r) sacc[r] = 0.f;
        for (int i = tid; i < 32 * RC_STP / 16; i += NTHR) *(LAS u32x4*)(lds + RC_ST + i * 16) = (u32x4){0u, 0u, 0u, 0u};
        u32x4 st[8]; u32x4 sv;
#define RC_LOAD(cc_) do { const size_t r0_ = (size_t)b * SS + (cc_) * 128; const bf16_t* gk_ = RQKV + (r0_ + srow) * 3072 + 1024 + h * 256 + scc * 8; \
        _Pragma("unroll") for (int j = 0; j < 8; ++j) { st[j] = *(const u32x4*)gk_; gk_ += 16 * 3072; OPAQ_G(gk_); } \
        sv = *(const u32x4*)(RQKV + (r0_ + vrow) * 3072 + 2048 + h * 256 + sl * 32 + vcc * 8); } while (0)
#define RC_WRITE() do { _Pragma("unroll") for (int j = 0; j < 8; ++j) *(LAS u32x4*)(lds + RC_KT + (srow + 16 * j) * RC_KTP + scc * 16) = st[j]; \
        u32x4 w_; w_.x = pg8::cvt_pk_bf16(lo_bf(sv.x) * vdec, hi_bf(sv.x) * vdec); w_.y = pg8::cvt_pk_bf16(lo_bf(sv.y) * vdec, hi_bf(sv.y) * vdec); \
        w_.z = pg8::cvt_pk_bf16(lo_bf(sv.z) * vdec, hi_bf(sv.z) * vdec); w_.w = pg8::cvt_pk_bf16(lo_bf(sv.w) * vdec, hi_bf(sv.w) * vdec); \
        *(LAS u32x4*)(lds + RC_VT + vrow * RC_VTP + vcc * 16) = w_; } while (0)
        bf16x8 qa[8];
#define RC_QLOAD(dst, cc_) do { const bf16_t* gq_ = RQKV + ((size_t)b * SS + (cc_) * 128 + nb * 32 + r32) * 3072 + h * 256 + dh * 128 + hi * 8; \
        _Pragma("unroll") for (int s = 0; s < 8; ++s) dst[s] = *(const bf16x8*)(gq_ + s * 16); } while (0)
        {   const int c0 = dir ? 1 : 0, c1 = dir ? 0 : 1; RC_LOAD(c0); RC_WRITE(); RC_QLOAD(qa, c0); RC_LOAD(c1); }
        __syncthreads();
        for (int i = 0; i < 34; ++i) {
            const int c = dir ? ((i < 2) ? (1 - i) : (35 - i)) : i;
            const size_t r0 = (size_t)b * SS + c * 128;
            const int cn = (i + 1 < 34) ? (dir ? ((i + 1 < 2) ? (1 - (i + 1)) : (35 - (i + 1))) : (i + 1)) : c;
            unsigned short oiv[8];
            if (dir == 0) { const bf16_t* ip = OI + (r0 + nb * 32 + 16 * dh + 4 * hi) * 1024 + h * 256 + sl * 32 + r32;
#pragma unroll
                for (int r = 0; r < 8; ++r) oiv[r] = ip[(size_t)((r & 3) + 8 * (r >> 2)) * 1024]; }
            f32x16 oacc;
#pragma unroll
            for (int r = 0; r < 16; ++r) oacc[r] = 0.f;
            {   LAS unsigned char* sb = lds + RC_ST + r32 * RC_STP + (dh * 128 + hi * 8) * 2;
#pragma unroll
                for (int s = 0; s < 8; ++s) { const bf16x8 sbf = *(const LAS bf16x8*)(sb + s * 32);
                    oacc = __builtin_amdgcn_mfma_f32_32x32x16_bf16(qa[s], sbf, oacc, 0, 0, 0); } }
            asm volatile("" ::: "memory");
            RC_QLOAD(qa, cn);
#pragma unroll
            for (int r = 0; r < 16; ++r) sacc[r] *= cdec;
            {   LAS unsigned char* kp = lds + RC_KT + (8 * hi + q4) * RC_KTP + (wave * 32 + 16 * g1 + 4 * p4) * 2;
                LAS unsigned char* vp = lds + RC_VT + (8 * hi + q4) * RC_VTP + (16 * g1 + 4 * p4) * 2;
#pragma unroll
                for (int s = 0; s < 8; ++s) sacc = __builtin_amdgcn_mfma_f32_32x32x16_bf16(tr2(kp + s * 16 * RC_KTP, kp + (s * 16 + 4) * RC_KTP), tr2(vp + s * 16 * RC_VTP, vp + (s * 16 + 4) * RC_VTP), sacc, 0, 0, 0); }
            if (dh) {
#pragma unroll
                for (int r = 0; r < 8; ++r) *(LAS float*)(lds + RC_XO + nb * 4096 + r * 256 + lane * 4) = oacc[r];
            } else {
#pragma unroll
                for (int r = 0; r < 8; ++r) *(LAS float*)(lds + RC_XO + nb * 4096 + (r + 8) * 256 + lane * 4) = oacc[r + 8];
            }
            __syncthreads();
#define RC_OUT(O0, X0) do { bf16_t* op = (dir ? OB : OI) + (r0 + nb * 32 + (O0) + 4 * hi) * 1024 + h * 256 + sl * 32 + r32; \
                float xo[8]; \
                _Pragma("unroll") for (int r = 0; r < 8; ++r) xo[r] = *(const LAS float*)(lds + RC_XO + nb * 4096 + (r + (X0)) * 256 + lane * 4); \
                _Pragma("unroll") for (int r = 0; r < 8; ++r) { const int n = nb * 32 + (O0) + (r & 3) + 8 * (r >> 2) + 4 * hi; \
                    const float qd = dir ? EX2(lg * (float)(128 - n)) : EX2(lg * (float)(n + 1)); \
                    float v = (oacc[r + (X0)] + xo[r]) * qd; \
                    if (dir == 0) v += bf2f(oiv[r]); \
                    *op = (bf16_t)f2bf(v); \
                    op += ((r & 3) == 3) ? 5 * 1024 : 1024; OPAQ_G(op); } } while (0)
            if (dh) RC_OUT(16, 8); else RC_OUT(0, 0);
#undef RC_OUT
            {   LAS unsigned char* sp = lds + RC_ST + r32 * RC_STP + (wave * 32 + 4 * hi) * 2;
#pragma unroll
                for (int g = 0; g < 4; ++g) { u32x2 o2; o2.x = pg8::cvt_pk_bf16(sacc[4 * g], sacc[4 * g + 1]); o2.y = pg8::cvt_pk_bf16(sacc[4 * g + 2], sacc[4 * g + 3]); *(LAS u32x2*)(sp + g * 16) = o2; } }
            if (i + 1 < 34) RC_WRITE();
            if (i + 2 < 34) { const int c2 = dir ? ((i + 2 < 2) ? (1 - (i + 2)) : (35 - (i + 2))) : (i + 2); RC_LOAD(c2); }
            __syncthreads();
        }
#undef RC_QLOAD
#undef RC_LOAD
#undef RC_WRITE
    }
}
__device__ __forceinline__ void phase_ret_ln2(Ctx& C, int l, bf16_t* OI, const bf16_t* OB) {
    const float* gain = INP(16) + l * 1024;
    for (int m = C.gw; m < MR; m += C.ngw) {
#pragma unroll
        for (int h = 0; h < 4; ++h) { bf16_t* p = OI + (size_t)m * 1024 + h * 256 + C.lane * 4;
            const u32x2 w = *(const u32x2*)p, w2 = *(const u32x2*)(OB + (size_t)m * 1024 + h * 256 + C.lane * 4);
            float x0 = lo_bf(w.x) + lo_bf(w2.x), x1 = hi_bf(w.x) + hi_bf(w2.x), x2 = lo_bf(w.y) + lo_bf(w2.y), x3 = hi_bf(w.y) + hi_bf(w2.y);
            const float mean = wave_sum((x0 + x1) + (x2 + x3)) * (1.f / 256.f);
            x0 -= mean; x1 -= mean; x2 -= mean; x3 -= mean;
            const float var = wave_sum((x0 * x0 + x1 * x1) + (x2 * x2 + x3 * x3)) * (1.f / 256.f);
            const float rstd = RSQ(var + EPS);
            const f32x4 g = *(const f32x4*)(gain + h * 256 + C.lane * 4);
            u32x2 o; o.x = pk2(x0 * rstd * g.x, x1 * rstd * g.y); o.y = pk2(x2 * rstd * g.z, x3 * rstd * g.w); *(u32x2*)p = o; }
    }
}

constexpr int LR_UP = 272;
constexpr int LR_CP = 272;
constexpr int LR_U = 0, LR_LA = 128 * LR_UP, LR_BC = LR_LA + 128 * LR_CP, LR_Y0 = LR_BC + 128 * LR_CP, LR_XS = LR_Y0 + 128 * LR_CP, LR_END = LR_XS + 4096;
static_assert(LR_END <= 147456 - 1024, "fused LRU LDS");
__device__ __forceinline__ void phase_lru_fused(Ctx& C, int l, const bf16_t* XA, const bf16_t* WTL, bf16_t* Y0, f16_t* CAF, f16_t* CAB, float* SUM) {
    const int lane = C.lane, r32 = lane & 31, hi = lane >> 5, wave = C.wave, tid = C.tid;
    LAS unsigned char* lds = C.lds;
    const float* cw = INP(8) + l * 4 * 1024; const float* cb = INP(9) + l * 1024;
    const int rb = wave & 3, cgp = wave >> 2;
    for (int un = C.bid; un < NB * 8 * 34; un += C.G) {
        const int sg = un % 34, bn = un / 34, b = bn >> 3, n = bn & 7;
        const int R0 = b * SS + sg * 128, lo = (sg < 2) ? b * SS : b * SS + LC, hi_ = (sg < 2) ? b * SS + LC : (b + 1) * SS;
#pragma unroll
        for (int j = 0; j < 4; ++j) { const int item = tid + 512 * j, row = item >> 4, cc = item & 15, ch0 = n * 128 + cc * 8;
            float a[8];
            {   const f32x4 c0 = *(const f32x4*)(cb + ch0), c1 = *(const f32x4*)(cb + ch0 + 4); a[0] = c0[0]; a[1] = c0[1]; a[2] = c0[2]; a[3] = c0[3]; a[4] = c1[0]; a[5] = c1[1]; a[6] = c1[2]; a[7] = c1[3]; }
#pragma unroll
            for (int t = 0; t < 4; ++t) { const int rr = R0 + row + t - 2;
                const f32x4 wA = *(const f32x4*)(cw + t * 1024 + ch0), wB = *(const f32x4*)(cw + t * 1024 + ch0 + 4);
                if (rr >= lo && rr < hi_) { const u32x4 xv = *(const u32x4*)(XA + (size_t)rr * 1024 + ch0);
                    a[0] += wA[0] * lo_bf(xv.x); a[1] += wA[1] * hi_bf(xv.x); a[2] += wA[2] * lo_bf(xv.y); a[3] += wA[3] * hi_bf(xv.y);
                    a[4] += wB[0] * lo_bf(xv.z); a[5] += wB[1] * hi_bf(xv.z); a[6] += wB[2] * lo_bf(xv.w); a[7] += wB[3] * hi_bf(xv.w); } }
            *(LAS u32x4*)(lds + LR_U + row * LR_UP + cc * 16) = pack8u(a); }
        __syncthreads();
        bf16x8 af[8];
        {   LAS unsigned char* ua = lds + LR_U + (rb * 32 + r32) * LR_UP + hi * 16;
#pragma unroll
            for (int s = 0; s < 8; ++s) af[s] = *(const LAS bf16x8*)(ua + s * 32); }
        for (int d = 0; d < 2; ++d) {
            f32x16 aR[2], aI[2];
#pragma unroll
            for (int q = 0; q < 2; ++q)
#pragma unroll
                for (int r = 0; r < 16; ++r) { aR[q][r] = 0.f; aI[q][r] = 0.f; }
            {   const bf16_t* wb = WTL + ((size_t)d * 2048 + n * 256 + cgp * 64 + r32) * 256 + (n & 1) * 128 + hi * 8;
#pragma unroll
                for (int s = 0; s < 8; ++s) {
                    const bf16x8 b0 = *(const bf16x8*)(wb + s * 16), b1 = *(const bf16x8*)(wb + 32 * 256 + s * 16), b2 = *(const bf16x8*)(wb + 128 * 256 + s * 16), b3 = *(const bf16x8*)(wb + 160 * 256 + s * 16);
                    aR[0] = __builtin_amdgcn_mfma_f32_32x32x16_bf16(af[s], b0, aR[0], 0, 0, 0); aR[1] = __builtin_amdgcn_mfma_f32_32x32x16_bf16(af[s], b1, aR[1], 0, 0, 0);
                    aI[0] = __builtin_amdgcn_mfma_f32_32x32x16_bf16(af[s], b2, aI[0], 0, 0, 0); aI[1] = __builtin_amdgcn_mfma_f32_32x32x16_bf16(af[s], b3, aI[1], 0, 0, 0);
                    if ((s & 3) == 3) asm volatile("" ::: "memory"); } }
#pragma unroll
            for (int q = 0; q < 2; ++q) { const int chl = cgp * 64 + q * 32 + r32, ch = n * 128 + chl;
                const float bav = INP(11)[(l * 2 + d) * 1024 + ch], bxv = INP(13)[(l * 2 + d) * 1024 + ch], spv = C.ctl[CT_SP + (l * 2 + d) * 1024 + ch] * (-8.f);
#pragma unroll
                for (int g = 0; g < 4; ++g) { f16_t lav[4], bcv[4];
#pragma unroll
                    for (int e = 0; e < 4; ++e) { const int r = 4 * g + e, t = rb * 32 + crow(r, hi);
                        const float uu = bf2f(*(const LAS bf16_t*)(lds + LR_U + t * LR_UP + chl * 2));
                        const float rg = sigmoidf_(aR[q][r] + bav), ig = sigmoidf_(aI[q][r] + bxv);
                        const float loga = rg * spv, y2 = 2.f * loga;
                        const float om = -y2 * (1.f + y2 * 0.5f * (1.f + y2 * (1.f / 3.f) * (1.f + y2 * 0.25f * (1.f + y2 * 0.2f))));
                        const float bb = SQRT(fmaxf(om, 0.f)) * (ig * uu);
                        lav[e] = (f16_t)(loga * LOG2E); bcv[e] = (f16_t)bb; }
                    typedef f16_t f16x4 __attribute__((ext_vector_type(4)));
                    const int tb = rb * 32 + 8 * g + 4 * hi;
                    *(LAS f16x4*)(lds + LR_LA + chl * LR_CP + tb * 2) = (f16x4){lav[0], lav[1], lav[2], lav[3]};
                    *(LAS f16x4*)(lds + LR_BC + chl * LR_CP + tb * 2) = (f16x4){bcv[0], bcv[1], bcv[2], bcv[3]}; } }
            __syncthreads();
            const int chl = tid & 127, sub = tid >> 7;
            const int tlo = d ? (96 - sub * 32) : (sub * 32);
            f16x8 lv[4], bv[4];
#pragma unroll
            for (int k = 0; k < 4; ++k) { lv[k] = *(const LAS f16x8*)(lds + LR_LA + chl * LR_CP + tlo * 2 + k * 16); bv[k] = *(const LAS f16x8*)(lds + LR_BC + chl * LR_CP + tlo * 2 + k * 16); }
            float av[32], hv[32];
            float A = 1.f, H = 0.f;
#define LR_P1(DD) do { _Pragma("unroll") for (int i = 0; i < 32; ++i) { constexpr int dd_ = DD; const int j = dd_ ? (31 - i) : i; \
                av[j] = EX2((float)lv[j >> 3][j & 7]); H = av[j] * H + (float)bv[j >> 3][j & 7]; A *= av[j]; } } while (0)
            if (d) LR_P1(1); else LR_P1(0);
#undef LR_P1
            *(LAS f32x2*)(lds + LR_XS + (sub * 128 + chl) * 8) = (f32x2){A, H};
            __syncthreads();
            {   A = 1.f; H = 0.f;
                for (int p = 0; p < sub; ++p) { const f32x2 v = *(const LAS f32x2*)(lds + LR_XS + (p * 128 + chl) * 8); H = v.x * H + v.y; A *= v.x; }
                f16_t* cap = (d ? CAB : CAF) + (size_t)(R0 + tlo) * 1024 + n * 128 + chl;
                bf16_t* y0p = Y0 + (size_t)(R0 + tlo) * 1024 + n * 128 + chl;
                LAS unsigned char* ys = lds + LR_Y0 + chl * LR_CP + tlo * 2;
#define LR_P2(DD) do { _Pragma("unroll") for (int i = 0; i < 32; ++i) { constexpr int dd_ = DD; const int j = dd_ ? (31 - i) : i; \
                H = av[j] * H + (float)bv[j >> 3][j & 7]; A *= av[j]; cap[(size_t)j * 1024] = (f16_t)A; hv[j] = H; } } while (0)
                if (d == 0) { LR_P2(0);
#pragma unroll
                    for (int k = 0; k < 4; ++k) { u32x4 w; w.x = pk2(hv[8 * k], hv[8 * k + 1]); w.y = pk2(hv[8 * k + 2], hv[8 * k + 3]); w.z = pk2(hv[8 * k + 4], hv[8 * k + 5]); w.w = pk2(hv[8 * k + 6], hv[8 * k + 7]); *(LAS u32x4*)(ys + k * 16) = w; }
                } else { LR_P2(1);
#pragma unroll
                    for (int k = 0; k < 4; ++k) { const u32x4 yv = *(const LAS u32x4*)(ys + k * 16); float y[8]; unpack8(yv, y);
#pragma unroll
                        for (int e = 0; e < 8; ++e) y0p[(size_t)(8 * k + e) * 1024] = (bf16_t)f2bf(y[e] + hv[8 * k + e]); }
                }
#undef LR_P2
                if (sub == 3) *(f32x2*)(SUM + ((size_t)((d * NB + b) * 34 + sg) * 1024 + n * 128 + chl) * 2) = (f32x2){A, H}; }
            __syncthreads();
        }
    }
    {   const int first = (C.G > 64) ? 64 : 0;
        if (C.bid >= first) { Ctx C2 = C; C2.gw = (C.bid - first) * NWAVES + C.wave; C2.ngw = (C.G - first) * NWAVES; C2.rot = 0; phase_wconv_late(C2, l); } }
}
__device__ __forceinline__ void phase_lru_carry(Ctx& C, const float* SUM, float* HIN) {
    const int gt = C.bid * NTHR + C.tid, ngt = C.G * NTHR;
    for (int it = gt; it < 2 * NB * 1024; it += ngt) { const int ch = it & 1023, b = (it >> 10) & 3, d = it >> 12;
        const float* sp = SUM + ((size_t)((d * NB + b) * 34) * 1024 + ch) * 2; float* hp = HIN + (size_t)((d * NB + b) * 34) * 1024 + ch;
        f32x2 v[34];
#pragma unroll
        for (int p = 0; p < 34; ++p) v[p] = *(const f32x2*)(sp + (size_t)p * 2048);
        float h = 0.f;
        if (d == 0) {
#pragma unroll
            for (int p = 0; p < 34; ++p) { hp[(size_t)p * 1024] = h; h = v[p].x * h + v[p].y; }
        } else {
#pragma unroll
            for (int p = 0; p < 34; ++p) { const int ps = (p < 2) ? (1 - p) : (35 - p); hp[(size_t)ps * 1024] = h; h = v[ps].x * h + v[ps].y; }
        }
    }
}

#ifdef PROBE_TS
#define GSYNC(g) do { { GASP unsigned char* w_ = (GASP unsigned char*)prm.ws; asm volatile("" : "+s"(w_)); xcd_barrier((unsigned*)(unsigned char*)(w_ + WS_BAR), (volatile LAS unsigned*)(ldsb + LDS_ST)); } if (blockIdx.x == 0 && threadIdx.x == 0) { unsigned long long* ts_ = (unsigned long long*)(prm.ws + 8192); const unsigned long long now_ = __builtin_amdgcn_s_memrealtime(); \
    ts_[1 + (g)] += now_ - ts_[0]; ts_[0] = now_; } } while (0)
#else
#define GSYNC(g) do { GASP unsigned char* w_ = (GASP unsigned char*)prm.ws; asm volatile("" : "+s"(w_)); xcd_barrier((unsigned*)(unsigned char*)(w_ + WS_BAR), (volatile LAS unsigned*)(ldsb + LDS_ST)); } while (0)
#endif
#define CTX Ctx C = mkctx(ldsb)
#define WSB wsp_(C.ws)
#define bYB ((bf16_t*)(WSB + AR_YB))
#define bXA ((bf16_t*)(WSB + AR_XA))
#define bMD ((bf16_t*)(WSB + AR_MD))
#define bRQKV ((bf16_t*)(WSB + AR_RQKV))
#define bKV ((bf16_t*)(WSB + AR_KV))
#define bQN ((bf16_t*)(WSB + AR_QN))
#define bQP ((bf16_t*)(WSB + AR_QP))
#define bRI ((f16_t*)(WSB + AR_RI))
#define bSUM ((float*)(WSB + AR_SUM))
#define bOB ((bf16_t*)(WSB + AR_OB))
#define bZ ((bf16_t*)(WSB + AR_Z))
#define xc1 ((float*)(WSB + WS_XC1))
template <int l> __device__ __forceinline__ void run_layer(const Params& prm, LAS unsigned char* ldsb) {
        const bool with_ctx = (l == 0); const int lat_only = with_ctx ? 0 : 1;
        { CTX; phase_wconv_early(C, l); }
        if (l == 0) GSYNC(0);
        { CTX; phase_h2(C, l, bYB); }
        GSYNC(1);
        {   CTX;
            ProbPlain P{bYB, (const bf16_t*)(WSB + W_WT1), 1024, 1024, 1024};
            pg8::StaticOrder S; S.init(68, 19, C.G, C.bid, 0);
            EpiG1 E{WSB, C.ctl + CT_ROPER};
            pg8::gemm_phase<EpiG1, ProbPlain, pg8::StaticOrder, true>(C.lds, P, S, E);
        }
        GSYNC(2);
        { CTX; phase_ret_intra(C, l, bRQKV, bYB); }
        {   CTX;
            const int first = (C.G > 64) ? 32 : 0;
            if (C.bid >= first) { C.gw = (C.bid - first) * NWAVES + C.wave; C.ngw = (C.G - first) * NWAVES; phase_md_post2(C, l, bMD); } }
        GSYNC(4);
        { CTX; phase_ret_chain(C, l, bRQKV, bYB, bOB); }
        GSYNC(5);
        { CTX; phase_ret_ln3(C, l, bYB, bOB); }
        {   CTX; ProbPlain P{bMD, (const bf16_t*)(WSB + W_WTQ), 768, 384, 384};
            pg8::StaticOrder S; S.init(68, 6, C.G, C.bid, 0);
            typedef EpiStore3<AR_QN, 1024, AR_QP, 512, AR_QP, 512, 4, 6> Ep; Ep E{WSB};
            pg8::gemm_phase<Ep, ProbPlain, pg8::StaticOrder, true>(C.lds, P, S, E);
        }
        {   CTX; ProbPlain P{bMD + 384, (const bf16_t*)(WSB + W_WTKV), 768, 256, 256};
            pg8::StaticOrder S; S.init(68, 8, C.G, (C.G == 256) ? ((C.bid + 104) & 255) : C.bid, 0);
            EpiKV E{WSB, INP(23) + l * 128, (LAS float*)(C.lds + 131072)};
            pg8::gemm_phase<EpiKV, ProbPlain, pg8::StaticOrder, true>(C.lds, P, S, E);
        }
        GSYNC(6);
        { CTX; phase_attn(C, l, with_ctx, bQN, bQP, bKV, bMD); }
        GSYNC(8);
        { CTX; phase_lru_fused(C, l, bXA, (const bf16_t*)(WSB + W_WTL), (bf16_t*)(WSB + AR_Y0), (f16_t*)(WSB + AR_CAF), (f16_t*)(WSB + AR_CAB), bSUM); }
        GSYNC(9);
        { CTX; phase_lru_carry(C, bSUM, (float*)(WSB + AR_HIN)); }
        { CTX; phase_h2(C, l, bXA  ); }
        GSYNC(13);
        {   CTX; ProbPlain P{bXA, (const bf16_t*)(WSB + W_WTG), 1024, 1024, 1024};
            pg8::StaticOrder S; S.init(lat_only ? 64 : 68, 12, C.G, C.bid, lat_only);
            EpiGate E{WSB};
            pg8::gemm_phase<EpiGate, ProbPlain, pg8::StaticOrder, true>(C.lds, P, S, E);
        }
        GSYNC(14);
        {   CTX; ProbD P{WSB, 1024, 1024};
            pg8::ChainOrder S; S.init(C.G, C.bid, with_ctx ? 1 : 0);
            EpiD E{bZ, WSB + AR_GS + (size_t)C.bid * 131072, (bf16_t*)(WSB + AR_ZP)};
            pg8::gemm_phase<EpiD, ProbD, pg8::ChainOrder, true>(C.lds, P, S, E);
        }
        GSYNC(15);
        if (with_ctx) { { CTX; phase_zsum(C, (const bf16_t*)(WSB + AR_ZP), bZ); } GSYNC(12); }
        {   CTX; ProbPlain P{bZ, (const bf16_t*)(WSB + W_WTO), 1024, 1024, 1024};
            pg8::StaticOrder S; S.init(lat_only ? 64 : 68, 4, C.G, C.bid, lat_only);
            EpiOut E{(l == 0) ? INP(0) : (const float*)C.out, INP(2), C.out, xc1, C.ctl + CT_MOD + l * 5 * 3072};
            pg8::gemm_phase<EpiOut, ProbPlain, pg8::StaticOrder, true>(C.lds, P, S, E);
        }
        GSYNC(16);
    }

__global__ void __launch_bounds__(NTHR) fwd_kernel(Params prm) {
    extern __shared__ __attribute__((aligned(16))) unsigned char lds_raw[];
    cg::grid_group grid = cg::this_grid();
    LAS unsigned char* const ldsb = (LAS unsigned char*)lds_raw;
    if (threadIdx.x < 16) ((LAS unsigned*)(ldsb + LDS_ST))[threadIdx.x] = 0u;
    __syncthreads();
    if (threadIdx.x == 0) (void)xb_add(&((unsigned*)(prm.ws + WS_BAR))[XB_XCNT(xb_xcc_id())], 1u);
    grid.sync();


#ifdef PROBE_TS
    if (blockIdx.x == 0 && threadIdx.x == 0) { unsigned long long* ts_ = (unsigned long long*)(prm.ws + 8192); for (int i = 1; i < 32; ++i) ts_[i] = 0ull; ts_[0] = __builtin_amdgcn_s_memrealtime(); }
#endif
    { CTX; phase_prep(C); }
    run_layer<0>(prm, ldsb);
    run_layer<1>(prm, ldsb);
#ifdef PROBE_TS
    if (blockIdx.x == 0 && threadIdx.x == 0) { const unsigned long long* ts_ = (const unsigned long long*)(prm.ws + 8192); unsigned long long tot = 0ull;
        for (int g = 0; g < 17; ++g) if ((PROBE_TS >> g) & 1u) tot += ts_[1 + g];
        prm.out[0] += (float)(((tot / 100ull) + PROBE_Q / 2) / PROBE_Q * PROBE_Q); }
#endif
}

#undef xc1
#undef bZ
extern "C" void kernel_launch(void* const* d_in, const int* in_sizes, int n_in, void* d_out, int out_size, void* d_ws, size_t ws_size, hipStream_t stream) {
    static int grid = 0;
    if (grid == 0) {
        if (n_in != 29 || out_size != NB * TT * DM || ws_size < WS_END) { fprintf(stderr, "kernel_launch: unexpected shapes (n_in %d out %d ws %zu)\n", n_in, out_size, ws_size); grid = -1; return; }
        int dev = 0, cus = 0, per_cu = 0;
        hipGetDevice(&dev);
        hipDeviceGetAttribute(&cus, hipDeviceAttributeMultiprocessorCount, dev);
        if (hipFuncSetAttribute((const void*)fwd_kernel, hipFuncAttributeMaxDynamicSharedMemorySize, LDS_BYTES) != hipSuccess) { fprintf(stderr, "kernel_launch: hipFuncSetAttribute failed\n"); grid = -1; return; }
        if (hipOccupancyMaxActiveBlocksPerMultiprocessor(&per_cu, (const void*)fwd_kernel, NTHR, LDS_BYTES) != hipSuccess || per_cu < 1) { fprintf(stderr, "kernel_launch: occupancy query failed (%d)\n", per_cu); (void)hipGetLastError(); per_cu = 1; }
        grid = cus;
        fprintf(stderr, "kernel_launch: cus %d per_cu %d grid %d\n", cus, per_cu, grid);
    }
    if (grid < 0) return;
    if (hipMemsetAsync((char*)d_ws + WS_BAR, 0, XCD_BAR_WORDS * 4, stream) != hipSuccess) { fprintf(stderr, "kernel_launch: memset failed\n"); return; }
    Params p{};
    for (int i = 0; i < 29; ++i) p.in[i] = (const float*)d_in[i];
    p.out = (float*)d_out; p.ws = (unsigned char*)d_ws;
    void* args[] = {&p};
    hipError_t e = hipLaunchCooperativeKernel((const void*)fwd_kernel, dim3(grid), dim3(NTHR), args, LDS_BYTES, stream);
    if (e != hipSuccess) fprintf(stderr, "cooperative launch failed: %s (grid %d)\n", hipGetErrorString(e), grid);
}
```

```cpp
#include <hip/hip_runtime.h>
#include <hip/hip_cooperative_groups.h>
#include <cstdio>
#include <cstdint>
namespace cg = cooperative_groups;

#define LAS __attribute__((address_space(3)))
typedef unsigned short bf16_t;
typedef short bf16x8 __attribute__((ext_vector_type(8)));
typedef float f32x4 __attribute__((ext_vector_type(4)));
typedef float f32x2 __attribute__((ext_vector_type(2)));
typedef unsigned u32x4 __attribute__((ext_vector_type(4)));
typedef unsigned u32x2 __attribute__((ext_vector_type(2)));
typedef _Float16 f16_t;

namespace pg8 {
constexpr int BM = 256, BK = 64, HALF = 128, HTB = HALF * BK * 2, STAGE_BYTES = 8 * HTB, NXCD = 8, WGM = 8;
__host__ __device__ __forceinline__ int lds_byte(int r, int c) { const int st = (r >> 4) * 2 + (c >> 5), rr = r & 15, cc = c & 31, ob = rr * 64 + cc * 2; return st * 1024 + (ob ^ (((ob >> 9) & 1) << 5)); }
__host__ __device__ __forceinline__ void stage_rc(int b, int& R, int& C) { const int st = b / 1024, sb = b % 1024, swz = sb ^ (((sb >> 9) & 1) << 5); R = (st >> 1) * 16 + swz / 64; C = (st & 1) * 32 + (swz % 64) / 2; }
__host__ __device__ __forceinline__ int perm32(int rho) { const int n = rho >> 4, i = rho & 15; return 8 * (i >> 2) + 4 * n + (i & 3); }

struct Unit { int pm, pn, z; };

struct StaticOrder {
    int nM, nN, nwg, G, c, latent_only, extra;
    __device__ void init(int nM_, int nN_, int G_, int c_, int latent_only_, int extra_ = 0) { nM = nM_; nN = nN_; nwg = nM * nN; G = G_; c = c_; latent_only = latent_only_; extra = extra_; }
    __device__ bool next(int i, Unit& u) const {
        const long L = (long)i * G + c;
        if (L >= nwg) { if (extra && L < nwg + 48) { const int e = (int)(L - nwg), ct = e / 3; u.pm = (ct >> 2) * 17; u.pn = ct & 3; u.z = 1 + (e - ct * 3); return true; }
            return false; }
        int wgid = (int)L; { const int q = nwg / NXCD, r = nwg % NXCD, xcd = wgid % NXCD, off = wgid / NXCD; wgid = (xcd < r ? xcd * (q + 1) : r * (q + 1) + (xcd - r) * q) + off; }
        const int nig = WGM * nN, gid = wgid / nig, fm = gid * WGM, gsz = (nM - fm) < WGM ? (nM - fm) : WGM;
        int pm = fm + ((wgid % nig) % gsz); u.pn = (wgid % nig) / gsz; u.z = 0;
        if (latent_only) pm = (pm >> 4) * 17 + 1 + (pm & 15);
        u.pm = pm; return true;
    }
};
struct ChainOrder {
    int G, c, with_ctx;
    __device__ void init(int G_, int c_, int with_ctx_) { G = G_; c = c_; with_ctx = with_ctx_; }
    __device__ bool next(int i, Unit& u) const {
        if (i < 6) { const int T = c; if (T >= 256) return false; int pm = T >> 2; u.pn = T & 3; u.z = i; u.pm = (pm >> 4) * 17 + 1 + (pm & 15); return true; }
        if (i == 6 && with_ctx && c < 48) { const int ct = c / 3, br = c - ct * 3; u.pm = (ct >> 2) * 17; u.pn = ct & 3; u.z = 8 + 2 * br + 1; return true; }
        return false;
    }
};

typedef __bf16 bf16x2_t __attribute__((ext_vector_type(2)));
__device__ __forceinline__ unsigned cvt_pk_bf16(float lo, float hi) { f32x2 v = {lo, hi}; bf16x2_t b = __builtin_convertvector(v, bf16x2_t); return __builtin_bit_cast(unsigned, b); }

template <class Epi, class Prob, class Sched, bool ALIGN_EPI>
__device__ __forceinline__ void gemm_phase(LAS unsigned char* lds, const Prob& P, const Sched& S, const Epi& E) {
    int tid_ = threadIdx.x; asm volatile("" : "+v"(tid_));
    const int tid = tid_, wid = __builtin_amdgcn_readfirstlane(tid >> 6), lane = tid & 63, wr = wid >> 2, wc = wid & 3, fr = lane & 15, fq = lane >> 4;
    const int K = P.K, nt = K / BK;
    int RA[2], CA[2]; unsigned voffB[2];
#pragma unroll
    for (int i = 0; i < 2; ++i) { int R, C; stage_rc(tid * 16 + i * 8192, R, C); const int Rb = Epi::PERM ? ((R & ~31) + perm32(R & 31)) : R;
        RA[i] = R; CA[i] = C; voffB[i] = (unsigned)(Rb * P.ldb + C) * 2u; }
    const unsigned kstep = (unsigned)(BK * 2);
    const unsigned hstepB = (unsigned)(HALF * P.ldb * 2);
    const unsigned ldsw = (unsigned)wid * 1024u;
    const int aoff = lds_byte(wr * 64 + fr, fq * 8), boff = lds_byte(wc * 32 + fr, fq * 8);
#define PG8_SA(b, h) (((b) * 2 + (h)) * HTB)
#define PG8_SB(b, h) ((4 + (b) * 2 + (h)) * HTB)
#define PG8_STAGE(bufoff, gbase, soff, voff) do { _Pragma("unroll") for (int _i = 0; _i < 2; ++_i) \
        __builtin_amdgcn_global_load_lds((const unsigned*)((const char*)(gbase) + (unsigned)((voff)[_i] + (soff))), (LAS unsigned*)(lds + (bufoff) + ldsw + _i * 8192), 16, 0, 0); } while (0)
#define PG8_LDA(dst, b, h) do { _Pragma("unroll") for (int m = 0; m < 4; ++m) _Pragma("unroll") for (int k = 0; k < 2; ++k) dst[m][k] = *(const LAS bf16x8*)(lds + PG8_SA(b, h) + aoff + m * 2048 + k * 1024); } while (0)
#define PG8_LDB(dst, b, h) do { _Pragma("unroll") for (int n = 0; n < 2; ++n) _Pragma("unroll") for (int k = 0; k < 2; ++k) dst[n][k] = *(const LAS bf16x8*)(lds + PG8_SB(b, h) + boff + n * 2048 + k * 1024); } while (0)
#define PG8_MMA(ai, bj, At, Bt) do { __builtin_amdgcn_s_setprio(1); _Pragma("unroll") for (int m = 0; m < 4; ++m) _Pragma("unroll") for (int n = 0; n < 2; ++n) _Pragma("unroll") for (int k = 0; k < 2; ++k) \
        acc[ai][bj][m][n] = __builtin_amdgcn_mfma_f32_16x16x32_bf16(Bt[n][k], At[m][k], acc[ai][bj][m][n], 0, 0, 0); __builtin_amdgcn_s_setprio(0); } while (0)
#define PG8_WAIT_V(n) asm volatile("s_waitcnt vmcnt(" #n ")" ::: "memory")
#define PG8_WAIT_L(n) asm volatile("s_waitcnt lgkmcnt(" #n ")" ::: "memory")
#define PG8_BAR __builtin_amdgcn_s_barrier()
#define PG8_SCHED __builtin_amdgcn_sched_barrier(0)
    Unit cur, nxt; int ui = 0;
    if (!S.next(0, cur)) return;
    f32x4 acc[2][2][4][2];
#pragma unroll
    for (int a = 0; a < 2; ++a)
#pragma unroll
        for (int b = 0; b < 2; ++b)
#pragma unroll
            for (int m = 0; m < 4; ++m)
#pragma unroll
                for (int n = 0; n < 2; ++n) acc[a][b][m][n] = (f32x4){0.f, 0.f, 0.f, 0.f};
    bf16x8 At[4][2], B0[2][2], B1[2][2];
    const char* cA; const char* cB; int ldaC; P.get(cur, cA, cB, ldaC);
    unsigned voffA[2] = {(unsigned)(RA[0] * ldaC + CA[0]) * 2u, (unsigned)(RA[1] * ldaC + CA[1]) * 2u};
    unsigned hstepA = (unsigned)(HALF * ldaC * 2);
    PG8_STAGE(PG8_SB(0, 0), cB, 0u, voffB); PG8_STAGE(PG8_SB(0, 1), cB, hstepB, voffB); PG8_STAGE(PG8_SA(0, 0), cA, 0u, voffA); PG8_STAGE(PG8_SA(0, 1), cA, hstepA, voffA);
    if (wr == 1) PG8_BAR;
    PG8_WAIT_V(2); PG8_BAR;
    PG8_STAGE(PG8_SB(1, 0), cB, kstep, voffB); PG8_STAGE(PG8_SA(1, 0), cA, kstep, voffA); PG8_STAGE(PG8_SB(1, 1), cB, hstepB + kstep, voffB);
    PG8_WAIT_V(6); PG8_BAR;
    for (;;) {
        const bool has_next = S.next(ui + 1, nxt);
        const char* nA = cA; const char* nB = cB; int ldaN = ldaC;
        if (has_next) P.get(nxt, nA, nB, ldaN);
        unsigned voffAn[2] = {(unsigned)(RA[0] * ldaN + CA[0]) * 2u, (unsigned)(RA[1] * ldaN + CA[1]) * 2u};
        const unsigned hstepAn = (unsigned)(HALF * ldaN * 2);
        for (int t = 0; t < nt; t += 2) {
            const bool last = (t == nt - 2);
            const unsigned o1 = (unsigned)(t + 1) * kstep;
            const char* a2b = last ? nA : cA; const char* b2b = last ? nB : cB;
            const unsigned o2 = last ? 0u : (unsigned)(t + 2) * kstep, o3 = o2 + kstep;
            unsigned vA2[2] = {last ? voffAn[0] : voffA[0], last ? voffAn[1] : voffA[1]};
            const unsigned hA2 = last ? hstepAn : hstepA;
            PG8_LDB(B0, 0, 0); PG8_LDB(B1, 0, 1); PG8_SCHED; PG8_LDA(At, 0, 0); PG8_STAGE(PG8_SA(1, 1), cA, o1 + hstepA, voffA);
            PG8_WAIT_V(8); PG8_WAIT_L(0); PG8_BAR; PG8_MMA(0, 0, At, B0); PG8_MMA(0, 1, At, B1); PG8_BAR; PG8_SCHED;
            PG8_LDA(At, 0, 1); PG8_STAGE(PG8_SB(0, 0), b2b, o2, voffB); PG8_STAGE(PG8_SB(0, 1), b2b, o2 + hstepB, voffB); PG8_STAGE(PG8_SA(0, 0), a2b, o2, vA2);
            PG8_WAIT_V(8); PG8_WAIT_L(0); PG8_BAR; PG8_MMA(1, 0, At, B0); PG8_MMA(1, 1, At, B1); PG8_BAR; PG8_SCHED;
            PG8_LDB(B0, 1, 0); PG8_LDB(B1, 1, 1); PG8_SCHED; PG8_LDA(At, 1, 0); PG8_STAGE(PG8_SA(0, 1), a2b, o2 + hA2, vA2);
            PG8_WAIT_V(8); PG8_WAIT_L(0); PG8_BAR; PG8_MMA(0, 0, At, B0); PG8_MMA(0, 1, At, B1); PG8_BAR; PG8_SCHED;
            PG8_LDA(At, 1, 1); PG8_STAGE(PG8_SB(1, 0), b2b, o3, voffB); PG8_STAGE(PG8_SB(1, 1), b2b, o3 + hstepB, voffB); PG8_STAGE(PG8_SA(1, 0), a2b, o3, vA2);
            PG8_WAIT_V(8); PG8_WAIT_L(0); PG8_BAR; PG8_MMA(1, 0, At, B0); PG8_MMA(1, 1, At, B1); PG8_BAR; PG8_SCHED;
        }
        if constexpr (ALIGN_EPI) { if (wr == 0) PG8_BAR; }
        E(acc, cur, wr, wc, fr, fq);
        if (!has_next) break;
#pragma unroll
        for (int a = 0; a < 2; ++a)
#pragma unroll
            for (int b = 0; b < 2; ++b)
#pragma unroll
                for (int m = 0; m < 4; ++m)
#pragma unroll
                    for (int n = 0; n < 2; ++n) acc[a][b][m][n] = (f32x4){0.f, 0.f, 0.f, 0.f};
        cur = nxt; cA = nA; cB = nB; ldaC = ldaN; voffA[0] = voffAn[0]; voffA[1] = voffAn[1]; hstepA = hstepAn; ++ui;
        if constexpr (ALIGN_EPI) { if (wr == 1) PG8_BAR; }
    }
    PG8_WAIT_V(0);
    if constexpr (!ALIGN_EPI) { if (wr == 0) PG8_BAR; }
    PG8_BAR;
#undef PG8_SA
#undef PG8_SB
#undef PG8_STAGE
#undef PG8_LDA
#undef PG8_LDB
#undef PG8_MMA
#undef PG8_WAIT_V
#undef PG8_WAIT_L
#undef PG8_BAR
#undef PG8_SCHED
}
}

constexpr int NB = 4, TT = 4096, LC = 256, SS = TT + LC  , DM = 1024, MR = NB * SS  ;
constexpr int INC = 10944;
constexpr float EPS = 1e-6f;
constexpr float LOG2E = 1.4426950408889634f;
constexpr float QSCALE = 0.07216878364870322f * 1.4426950408889634f;
constexpr int NWAVES = 8, NTHR = 512;

constexpr size_t MiB = 1u << 20;
constexpr size_t WS_CTL = 0;
constexpr size_t WS_XC1 = 1 * MiB;
constexpr size_t WS_W = 5 * MiB;
constexpr size_t WS_AR = 25 * MiB;
constexpr size_t AR_YB = WS_AR + 0 * MiB;
constexpr size_t AR_XA = WS_AR + 34 * MiB;
constexpr size_t AR_MD = WS_AR + 68 * MiB;
constexpr size_t AR_RQKV = WS_AR + 94 * MiB;
constexpr size_t AR_OB = WS_AR + 196 * MiB;
constexpr size_t AR_KV = WS_AR + 112 * MiB;
constexpr size_t AR_QN = WS_AR + 180 * MiB;
constexpr size_t AR_QP = WS_AR + 214 * MiB;
constexpr size_t AR_RI = WS_AR + 102 * MiB;
constexpr size_t AR_Y0 = WS_AR + 68 * MiB;
constexpr size_t AR_CAF = WS_AR + 102 * MiB;
constexpr size_t AR_CAB = WS_AR + 136 * MiB;
constexpr size_t AR_SUM = WS_AR + 170 * MiB;
constexpr size_t AR_Z = WS_AR + 102 * MiB;
constexpr size_t AR_HIN = WS_AR + 176 * MiB;
constexpr size_t AR_GMC = WS_AR + 214 * MiB;
constexpr size_t AR_ZP = WS_AR + 170 * MiB;
constexpr size_t AR_GS = WS_AR + 136 * MiB;
constexpr size_t WS_END = 256 * MiB;
constexpr size_t W_WT1 = WS_W;
constexpr size_t W_WTQ = WS_W + 10 * MiB;
constexpr size_t W_WTKV = WS_W + 12 * MiB;
constexpr size_t W_WTL = WS_W + 18 * MiB;
constexpr size_t W_WTG = WS_W;
constexpr size_t W_WTGM = WS_W + 6 * MiB;
constexpr size_t W_WTD = WS_W + 12 * MiB;
constexpr size_t W_WTO = WS_AR + 178 * MiB;
constexpr int CT_MOD = 16384;
constexpr int CT_ROPER = CT_MOD + 2 * 5 * 3072;
constexpr int CT_ROPEM = CT_ROPER + 2 * 4096;
constexpr int CT_SP = CT_ROPEM + 2 * 1024;
constexpr int CT_LG = CT_SP + 4096;
constexpr int CT_END = CT_LG + 16;
static_assert(CT_END * 4 <= (int)MiB, "CTL");

constexpr int LDS_BYTES = 147456;


#define XB_TMO      128
#define XB_XCNT(j)  (256  + 64 * (j))
#define XB_XSUB(j)  (1280 + 64 * (j))
#define XB_XGEN(j)  (2304 + 64 * (j))
#define XB_TOP      3328
#define XB_TOPGEN   3392
#define XCD_BAR_WORDS 3456
#define XB_SPIN_CAP (1u << 18)
constexpr size_t WS_BAR = 16384;
constexpr int LDS_ST = LDS_BYTES - 64;
__device__ __forceinline__ unsigned xb_ld(unsigned* p)              { return __hip_atomic_load(p, __ATOMIC_RELAXED, __HIP_MEMORY_SCOPE_AGENT); }
__device__ __forceinline__ unsigned xb_add(unsigned* p, unsigned v) { return __hip_atomic_fetch_add(p, v, __ATOMIC_RELAXED, __HIP_MEMORY_SCOPE_AGENT); }
__device__ __forceinline__ unsigned xb_xcc_id() { return (unsigned)__builtin_amdgcn_s_getreg((3 << 11) | 20) & 0xFu; }
#define XB_SPIN(cond, bar) do { unsigned _sp = 0; while (cond) { __builtin_amdgcn_s_sleep(1); \
    if ((++_sp & 255u) == 0u) { if (xb_ld(&(bar)[XB_TMO])) break; if (_sp > XB_SPIN_CAP) { atomicAdd(&(bar)[XB_TMO], 1u); break; } } } } while (0)
__device__ __forceinline__ void xcd_barrier_complete(unsigned* bar, unsigned x, unsigned& nloc, unsigned& nx) {
    const unsigned G = gridDim.x * gridDim.y * gridDim.z;
    unsigned sum, cnt, mine, sp = 0u;
    for (;;) {
        sum = 0u; cnt = 0u; mine = 0u;
#pragma unroll
        for (unsigned j = 0; j < 16; ++j) { const unsigned c = xb_ld(&bar[XB_XCNT(j)]); sum += c; cnt += (c > 0u) ? 1u : 0u; mine = (j == x) ? c : mine; }
        if (sum == G) break;
        __builtin_amdgcn_s_sleep(1);
        if ((++sp & 255u) == 0u) { if (xb_ld(&bar[XB_TMO])) break; if (sp > XB_SPIN_CAP) { atomicAdd(&bar[XB_TMO], 1u); break; } }
    }
    nloc = mine > 0u ? mine : 1u; nx = cnt > 0u ? cnt : 1u;
}
__device__ __forceinline__ void xcd_barrier(unsigned* bar, volatile LAS unsigned* st) {
    asm volatile("s_waitcnt vmcnt(0)" ::: "memory");
    __syncthreads();
    if (threadIdx.x == 0) {
        const unsigned x = xb_xcc_id();
        __builtin_amdgcn_s_waitcnt(0);
        unsigned nloc = st[0], nx = st[1];
        if (nloc == 0u) { xcd_barrier_complete(bar, x, nloc, nx); st[0] = nloc; st[1] = nx; }
        const unsigned old = xb_add(&bar[XB_XSUB(x)], 1u);
        const unsigned gen = old / nloc;
        if (old + 1u == (gen + 1u) * nloc) {
            __builtin_amdgcn_fence(__ATOMIC_RELEASE, "agent");
            asm volatile("s_waitcnt vmcnt(0)" ::: "memory");
            const unsigned og = xb_add(&bar[XB_TOP], 1u);
            const unsigned tg = og / nx;
            if (og + 1u == (tg + 1u) * nx) xb_add(&bar[XB_TOPGEN], 1u);
            else XB_SPIN(xb_ld(&bar[XB_TOPGEN]) == tg, bar);
            __builtin_amdgcn_fence(__ATOMIC_ACQUIRE, "agent");
            xb_add(&bar[XB_XGEN(x)], 1u);
            asm volatile("s_waitcnt vmcnt(0)" ::: "memory");
        } else {
            XB_SPIN(xb_ld(&bar[XB_XGEN(x)]) == gen, bar);
            __builtin_amdgcn_fence(__ATOMIC_ACQUIRE, "agent");
            asm volatile("s_waitcnt vmcnt(0)" ::: "memory");
        }
    }
    __syncthreads();
}

struct Params {
    const float* in[29];
    float* out;
    unsigned char* ws;
};

#define EX2(x) __builtin_amdgcn_exp2f(x)
#define RSQ(x) __builtin_amdgcn_rsqf(x)
#define SQRT(x) __builtin_amdgcn_sqrtf(x)
__device__ __forceinline__ float bf2f(unsigned v) { return __uint_as_float(v << 16); }
__device__ __forceinline__ unsigned f2bf(float f) { unsigned u = __float_as_uint(f); return (u + 0x7fffu + ((u >> 16) & 1u)) >> 16; }
__device__ __forceinline__ unsigned pk2(float lo, float hi) { return f2bf(lo) | (f2bf(hi) << 16); }
__device__ __forceinline__ float lo_bf(unsigned w) { return __uint_as_float(w << 16); }
__device__ __forceinline__ float hi_bf(unsigned w) { return __uint_as_float(w & 0xffff0000u); }
__device__ __forceinline__ float wave_sum(float v) {
#pragma unroll
    for (int o = 1; o < 64; o <<= 1) v += __shfl_xor(v, o);
    return v;
}
__device__ __forceinline__ float wave_max(float v) {
#pragma unroll
    for (int o = 1; o < 64; o <<= 1) v = fmaxf(v, __shfl_xor(v, o));
    return v;
}
__device__ __forceinline__ float sigmoidf_(float x) { return __builtin_amdgcn_rcpf(1.f + __expf(-x)); }
__device__ __forceinline__ float siluf_(float x) { return x * __builtin_amdgcn_rcpf(1.f + __expf(-x)); }

#define GASP __attribute__((address_space(1)))
__device__ __forceinline__ const float* inp_(int i) { asm volatile("" : "+s"(i)); const float* const* ka = (const float* const*)__builtin_amdgcn_kernarg_segment_ptr(); return (const float*)(const GASP float*)ka[i]; }
#define INP(i) inp_(i)
template <class T> __device__ __forceinline__ T* opaq_g_(T* p) { GASP T* g = (GASP T*)p; asm volatile("" : "+v"(g)); return (T*)g; }
#define OPAQ_G(p) ((p) = opaq_g_(p))
__device__ __forceinline__ unsigned char* wsp_(unsigned char* p) { GASP unsigned char* g = (GASP unsigned char*)p; asm volatile("" : "+s"(g)); return (unsigned char*)g; }
__device__ __forceinline__ void unpack8(const u32x4& w, float (&x)[8]) { x[0] = lo_bf(w.x); x[1] = hi_bf(w.x); x[2] = lo_bf(w.y); x[3] = hi_bf(w.y); x[4] = lo_bf(w.z); x[5] = hi_bf(w.z); x[6] = lo_bf(w.w); x[7] = hi_bf(w.w); }
__device__ __forceinline__ u32x4 pack8u(const float (&x)[8]) { u32x4 w; w.x = pk2(x[0], x[1]); w.y = pk2(x[2], x[3]); w.z = pk2(x[4], x[5]); w.w = pk2(x[6], x[7]); return w; }
__device__ __forceinline__ float sumsq8(const float (&x)[8]) { return ((x[0] * x[0] + x[1] * x[1]) + (x[2] * x[2] + x[3] * x[3])) + ((x[4] * x[4] + x[5] * x[5]) + (x[6] * x[6] + x[7] * x[7])); }

struct Ctx {
    float* out; unsigned char* ws; LAS unsigned char* lds; int tid, lane, wave, G, bid;
    int gw, ngw;
    int rot;
    float* ctl;
};

__device__ __forceinline__ Ctx mkctx(LAS unsigned char* lds) {
    Ctx C; int t = threadIdx.x; asm volatile("" : "+v"(t)); int b = blockIdx.x; asm volatile("" : "+s"(b)); int g = gridDim.x; asm volatile("" : "+s"(g));
    C.tid = t; C.lane = t & 63; C.wave = __builtin_amdgcn_readfirstlane(t >> 6); C.bid = b; C.G = g; C.gw = b * NWAVES + C.wave; C.ngw = g * NWAVES; C.rot = 0;
    int io = 29, iw = 30; asm volatile("" : "+s"(io)); asm volatile("" : "+s"(iw));
    unsigned char* const* ka = (unsigned char* const*)__builtin_amdgcn_kernarg_segment_ptr();
    C.out = (float*)(GASP float*)ka[io]; C.ws = (unsigned char*)(GASP unsigned char*)ka[iw]; C.ctl = (float*)(C.ws + WS_CTL); C.lds = lds;
    return C;
}
__device__ __forceinline__ const float* resid_row(const Ctx& C, int l, int m) {
    const int b = m / SS, s = m - b * SS;
    if (s < LC) { const float* base = (l == 0) ? INP(2) : (const float*)(C.ws + WS_XC1); return base + (size_t)(b * LC + s) * DM; }
    const float* base = (l == 0) ? INP(0) : C.out; return base + (size_t)(b * TT + (s - LC)) * DM;
}

__device__ __forceinline__ void phase_prep(Ctx& C) {
    LAS float* sl = (LAS float*)C.lds;
    LAS float* red = (LAS float*)(C.lds + 32768);
    for (int i = C.tid; i < 5 * 1024; i += NTHR) { const int r = i >> 10, k = i & 1023; const float v = (r < 4) ? INP(1)[r * 1024 + k] : INP(3)[k]; sl[i] = siluf_(v); }
    __syncthreads();
    for (int it = C.bid; it < 2 * 96; it += C.G) {
        const int l = it / 96, grp = it % 96, kg = C.tid >> 5, cj = C.tid & 31, col = grp * 32 + cj;
        const float* w = INP(4) + (size_t)l * 1024 * 3072 + col;
        float a0 = 0.f, a1 = 0.f, a2 = 0.f, a3 = 0.f, a4 = 0.f;
#pragma unroll 8
        for (int k = kg * 64; k < kg * 64 + 64; ++k) { const float wv = w[(size_t)k * 3072]; a0 += sl[k] * wv; a1 += sl[1024 + k] * wv; a2 += sl[2048 + k] * wv; a3 += sl[3072 + k] * wv; a4 += sl[4096 + k] * wv; }
        red[(kg * 32 + cj) * 5 + 0] = a0; red[(kg * 32 + cj) * 5 + 1] = a1; red[(kg * 32 + cj) * 5 + 2] = a2; red[(kg * 32 + cj) * 5 + 3] = a3; red[(kg * 32 + cj) * 5 + 4] = a4;
        __syncthreads();
        if (C.tid < 160) { const int c2 = C.tid / 5, r = C.tid % 5; float s = 0.f;
            for (int g = 0; g < 16; ++g) s += red[(g * 32 + c2) * 5 + r];
            C.ctl[CT_MOD + (l * 5 + r) * 3072 + grp * 32 + c2] = s + INP(5)[l * 3072 + grp * 32 + c2]; }
        __syncthreads();
    }
    const int gt = C.bid * NTHR + C.tid, ngt = C.G * NTHR;
    for (int i = gt; i < 4096; i += ngt) { const int pos = i >> 6, f = i & 63; const float inv = powf(10000.f, -(float)f / 64.f), ang = (float)pos * inv;
        C.ctl[CT_ROPER + i] = cosf(ang); C.ctl[CT_ROPER + 4096 + i] = sinf(ang); }
    for (int i = gt; i < 1024; i += ngt) { const int pos = i >> 4, f = i & 15; const float inv = powf(10000.f, -(float)f / 16.f), ang = (float)pos * inv;
        C.ctl[CT_ROPEM + i] = cosf(ang); C.ctl[CT_ROPEM + 1024 + i] = sinf(ang); }
    for (int i = gt; i < 4096; i += ngt) C.ctl[CT_SP + i] = log1pf(expf(-INP(14)[i]));
    for (int i = gt; i < 16; i += ngt) C.ctl[CT_LG + i] = -log1pf(expf(-INP(15)[i])) * LOG2E;
}

__device__ __forceinline__ void tr_item(const float* W, int ldw, int k0, int n0, bf16_t* WT, int ldt, int drow0, int dk0, LAS float* scr, int lane) {
#pragma unroll 8
    for (int i = 0; i < 32; ++i) { const int kk = 2 * i + (lane >> 5); scr[kk * 33 + (lane & 31)] = W[(size_t)(k0 + kk) * ldw + n0 + (lane & 31)]; }
    asm volatile("s_waitcnt lgkmcnt(0)" ::: "memory");
    const int c = lane & 7;
#pragma unroll
    for (int j = 0; j < 4; ++j) { const int n = (lane >> 3) + 8 * j; const LAS float* s = scr + (8 * c) * 33 + n;
        u32x4 o; o.x = pk2(s[0 * 33], s[1 * 33]); o.y = pk2(s[2 * 33], s[3 * 33]); o.z = pk2(s[4 * 33], s[5 * 33]); o.w = pk2(s[6 * 33], s[7 * 33]);
        *(u32x4*)(WT + (size_t)(drow0 + n) * ldt + dk0 + 8 * c) = o; }
    asm volatile("s_waitcnt lgkmcnt(0)" ::: "memory");
}
__device__ __forceinline__ void conv_rows(Ctx& C, const float* W, int ldw, int K, int scol0, bf16_t* WT, int ldt, int drow0, int dk0, int nrows, LAS float* scr) {
    const int nkb = K / 64, items = nkb * (nrows / 32);
    int g0 = C.gw - C.rot; if (g0 < 0) g0 += C.ngw; C.rot = (C.rot + items) % C.ngw;
    for (int it = g0; it < items; it += C.ngw) { const int nb = it / nkb, kb = it - nb * nkb;
        tr_item(W, ldw, kb * 64, scol0 + nb * 32, WT, ldt, drow0 + nb * 32, dk0 + kb * 64, scr, C.lane); }
}
__device__ __forceinline__ int ropeperm(int j) { const int h = j >> 8, jj = j & 255, half = jj >> 7, g = (jj & 127) >> 3, r8 = jj & 7; return h * 256 + (half * 2 + (r8 >> 2)) * 64 + g * 4 + (r8 & 3); }
__device__ __forceinline__ void tr_item_rope(const float* W, int ldw, int k0, int scol0, int jbase, bf16_t* WT, int ldt, int drow0, int dk0, LAS float* scr, int lane) {
    const int sc = scol0 + ropeperm(jbase + (lane & 31));
#pragma unroll 8
    for (int i = 0; i < 32; ++i) { const int kk = 2 * i + (lane >> 5); scr[kk * 33 + (lane & 31)] = W[(size_t)(k0 + kk) * ldw + sc]; }
    asm volatile("s_waitcnt lgkmcnt(0)" ::: "memory");
    const int c = lane & 7;
#pragma unroll
    for (int j = 0; j < 4; ++j) { const int n = (lane >> 3) + 8 * j; const LAS float* s = scr + (8 * c) * 33 + n;
        u32x4 o; o.x = pk2(s[0 * 33], s[1 * 33]); o.y = pk2(s[2 * 33], s[3 * 33]); o.z = pk2(s[4 * 33], s[5 * 33]); o.w = pk2(s[6 * 33], s[7 * 33]);
        *(u32x4*)(WT + (size_t)(drow0 + n) * ldt + dk0 + 8 * c) = o; }
    asm volatile("s_waitcnt lgkmcnt(0)" ::: "memory");
}
__device__ __forceinline__ void conv_rows_rope(Ctx& C, const float* W, int ldw, int K, int scol0, bf16_t* WT, int ldt, int drow0, int nrows, LAS float* scr) {
    const int nkb = K / 64, items = nkb * (nrows / 32);
    int g0 = C.gw - C.rot; if (g0 < 0) g0 += C.ngw; C.rot = (C.rot + items) % C.ngw;
    for (int it = g0; it < items; it += C.ngw) { const int nb = it / nkb, kb = it - nb * nkb;
        tr_item_rope(W, ldw, kb * 64, scol0, nb * 32, WT, ldt, drow0 + nb * 32, kb * 64, scr, C.lane); }
}
__device__ __forceinline__ void zero_rows(Ctx& C, bf16_t* WT, int ldt, int drow0, int dk0, int nrows, int ncols) {
    const int per = ncols / 8, items = nrows * per;
    int g0 = C.gw - C.rot; if (g0 < 0) g0 += C.ngw; C.rot = (C.rot + (items + 63) / 64) % C.ngw;
    for (int it = g0 * 64 + C.lane; it < items; it += C.ngw * 64) { const int r = it / per, c = it - r * per; *(u32x4*)(WT + (size_t)(drow0 + r) * ldt + dk0 + c * 8) = (u32x4){0u, 0u, 0u, 0u}; }
}
__device__ __forceinline__ void phase_wconv_early(Ctx& C, int l) {
    LAS float* scr = (LAS float*)(C.lds + C.wave * 16384);
    unsigned char* ws = C.ws;
    const float* win = INP(7) + (size_t)l * 1024 * INC;
    bf16_t* WT1 = (bf16_t*)(ws + W_WT1);
    conv_rows(C, win, INC, 1024, 0, WT1, 1024, 0, 0, 1024, scr);
    conv_rows_rope(C, win, INC, 1024, 2048, WT1, 1024, 1024, 1024, scr);
    conv_rows_rope(C, win, INC, 1024, 3072, WT1, 1024, 2048, 1024, scr);
    conv_rows(C, win, INC, 1024, 4096, WT1, 1024, 3072, 0, 1024, scr);
    conv_rows(C, win, INC, 1024, 6144, WT1, 1024, 4096, 0, 704, scr);
    zero_rows(C, WT1, 1024, 4800, 0, 64, 1024);
    const float* wq = INP(18) + (size_t)l * 384 * 1536; bf16_t* WTQ = (bf16_t*)(ws + W_WTQ);
    for (int h = 0; h < 8; ++h) { conv_rows(C, wq, 1536, 384, h * 192, WTQ, 384, h * 128, 0, 128, scr); conv_rows(C, wq, 1536, 384, h * 192 + 128, WTQ, 384, 1024 + h * 64, 0, 64, scr); }
    const float* wkv = INP(20) + (size_t)l * 256 * 2048; bf16_t* WTKV = (bf16_t*)(ws + W_WTKV);
    for (int h = 0; h < 8; ++h) { conv_rows(C, wkv, 2048, 256, h * 256, WTKV, 256, h * 128, 0, 128, scr); conv_rows(C, wkv, 2048, 256, h * 256 + 128, WTKV, 256, 1024 + h * 128, 0, 128, scr); }
    bf16_t* WTL = (bf16_t*)(ws + W_WTL);
    for (int d = 0; d < 2; ++d) for (int n = 0; n < 8; ++n) for (int mat = 0; mat < 2; ++mat) {
        const float* w = INP(mat == 0 ? 10 : 12) + ((size_t)(l * 2 + d) * 8 + n) * 128 * 128;
        const int drow0 = d * 2048 + n * 256 + mat * 128;
        conv_rows(C, w, 128, 128, 0, WTL, 256, drow0, (n & 1) * 128, 128, scr);
        zero_rows(C, WTL, 256, drow0, ((n & 1) ^ 1) * 128, 128, 128);
    }
}
__device__ __forceinline__ void phase_wconv_late(Ctx& C, int l) {
    LAS float* scr = (LAS float*)(C.lds + C.wave * 16384);
    unsigned char* ws = C.ws;
    const float* win = INP(7) + (size_t)l * 1024 * INC;
    bf16_t* WTG = (bf16_t*)(ws + W_WTG);
    conv_rows(C, win, INC, 1024, 1024, WTG, 1024, 0, 0, 1024, scr);
    conv_rows(C, win, INC, 1024, 5120, WTG, 1024, 1024, 0, 1024, scr);
    conv_rows(C, win, INC, 1024, 6848, WTG, 1024, 2048, 0, 1024, scr);
    conv_rows(C, win, INC, 1024, 7872, (bf16_t*)(ws + W_WTGM), 1024, 0, 0, 3072, scr);
    for (int i = 0; i < 3; ++i) conv_rows(C, INP(25 + i) + (size_t)l * 1024 * 1024, 1024, 1024, 0, (bf16_t*)(ws + W_WTD) + (size_t)i * 1024 * 1024, 1024, 0, 0, 1024, scr);
    conv_rows(C, INP(28) + (size_t)l * 1024 * 1024, 1024, 1024, 0, (bf16_t*)(ws + W_WTO), 1024, 0, 0, 1024, scr);
}

__device__ __forceinline__ void phase_h(Ctx& C, int l, bf16_t* H) {
    const float* gain = INP(6) + l * 1024;
    for (int m = C.gw; m < MR; m += C.ngw) {
        const int b = m / SS, s = m - b * SS, r = (s < LC) ? 4 : b;
        const float* xr = resid_row(C, l, m);
        const float* mod = C.ctl + CT_MOD + (l * 5 + r) * 3072;
        f32x4 v[4]; float ss = 0.f;
#pragma unroll
        for (int j = 0; j < 4; ++j) { v[j] = *(const f32x4*)(xr + 4 * C.lane + 256 * j); ss += (v[j].x * v[j].x + v[j].y * v[j].y) + (v[j].z * v[j].z + v[j].w * v[j].w); }
        const float rstd = RSQ(wave_sum(ss) * (1.f / 1024.f) + EPS);
#pragma unroll
        for (int j = 0; j < 4; ++j) { const int c = 4 * C.lane + 256 * j;
            const f32x4 g = *(const f32x4*)(gain + c), sh = *(const f32x4*)(mod + c), sc = *(const f32x4*)(mod + 1024 + c);
            const f32x4 y = (v[j] * rstd) * g;
            const f32x4 o = y * (sc + 1.0f) + sh;
            u32x2 w; w.x = pk2(o.x, o.y); w.y = pk2(o.z, o.w);
            *(u32x2*)(H + (size_t)m * 1024 + c) = w; }
    }
}

using pg8::Unit;
struct ProbPlain {
    const bf16_t* A; const bf16_t* Bt; int lda, ldb, K;
    __device__ __forceinline__ void get(const Unit& u, const char*& a, const char*& b, int& lda_) const {
        a = (const char*)(A + (size_t)u.pm * 256 * lda); b = (const char*)(Bt + (size_t)u.pn * 256 * ldb); lda_ = lda; }
};
struct ProbG {
    unsigned char* ws; int ldb, K;
    __device__ __forceinline__ void get(const Unit& u, const char*& a, const char*& b, int& lda_) const {
        a = (const char*)(ws + AR_XA + (size_t)u.pm * 256 * 1024 * 2); lda_ = 1024;
        b = (u.z == 0) ? (const char*)(ws + W_WTG + (size_t)u.pn * 256 * 1024 * 2) : (const char*)(ws + W_WTGM + ((size_t)(u.z - 1) * 1024 + u.pn * 256) * 1024 * 2); }
};
struct ProbLru {
    const bf16_t* A; const bf16_t* Bt; int ldb, K;
    __device__ __forceinline__ void get(const Unit& u, const char*& a, const char*& b, int& lda_) const {
        a = (const char*)(A + (size_t)u.pm * 256 * 1024 + (u.pn >> 1) * 256); b = (const char*)(Bt + (size_t)u.pn * 256 * 256); lda_ = 1024; }
};
struct ProbD {
    unsigned char* ws; int ldb, K;
    __device__ __forceinline__ void get(const Unit& u, const char*& a, const char*& b, int& lda_) const {
        const int i = (u.z & 7) >> 1;
        if ((u.z & 1) == 0) { a = (const char*)(ws + AR_XA + (size_t)u.pm * 256 * 1024 * 2); b = (const char*)(ws + W_WTGM + ((size_t)i * 1024 + u.pn * 256) * 1024 * 2); lda_ = 1024; }
        else { const size_t yo = (i == 0) ? AR_Y0 : (i == 1) ? AR_YB : AR_QN;
            a = (const char*)(ws + yo + (size_t)u.pm * 256 * 1024 * 2); b = (const char*)(ws + W_WTD + ((size_t)i * 1024 + u.pn * 256) * 1024 * 2); lda_ = 1024; }
    }
};

#define EPI_ARGS const f32x4 (&acc)[2][2][4][2], const Unit& u, int wr, int wc, int fr, int fq
template <size_t O0, int L0, size_t O1, int L1, size_t O2, int L2, int T1, int T2>
struct EpiStore3 {
    static constexpr bool PERM = true;
    unsigned char* ws;
    __device__ __forceinline__ void operator()(EPI_ARGS) const {
        bf16_t* bs; int ldc, ct;
        size_t off;
        if (u.pn < T1) { off = O0; ldc = L0; ct = u.pn; } else if (u.pn < T2) { off = O1; ldc = L1; ct = u.pn - T1; } else { off = O2; ldc = L2; ct = u.pn - T2; }
        bs = (bf16_t*)(ws + off);
        const int row0 = u.pm * 256 + wr * 64 + fr, col0 = ct * 256 + wc * 32 + 8 * fq;
#pragma unroll
        for (int ai = 0; ai < 2; ++ai)
#pragma unroll
            for (int m = 0; m < 4; ++m) { bf16_t* rowp = bs + (size_t)(row0 + ai * 128 + m * 16) * ldc + col0;
#pragma unroll
                for (int bj = 0; bj < 2; ++bj) { const f32x4 v0 = acc[ai][bj][m][0], v1 = acc[ai][bj][m][1];
                    u32x4 w; w.x = pg8::cvt_pk_bf16(v0[0], v0[1]); w.y = pg8::cvt_pk_bf16(v0[2], v0[3]); w.z = pg8::cvt_pk_bf16(v1[0], v1[1]); w.w = pg8::cvt_pk_bf16(v1[2], v1[3]);
                    *(u32x4*)(rowp + bj * 128) = w; } }
    }
};
struct EpiKV {
    static constexpr bool PERM = true;
    unsigned char* ws; const float* gkn; LAS float* red;
    __device__ __forceinline__ void operator()(EPI_ARGS) const {
        bf16_t* bs = (bf16_t*)(ws + AR_KV);
        const int row0 = u.pm * 256 + wr * 64 + fr, col0 = u.pn * 256 + wc * 32 + 8 * fq;
        const bool knope = u.pn < 4;
        float g[8];
#pragma unroll
        for (int e = 0; e < 8; ++e) g[e] = 1.f;
        if (knope) {
#pragma unroll
            for (int ai = 0; ai < 2; ++ai)
#pragma unroll
                for (int m = 0; m < 4; ++m)
#pragma unroll
                    for (int bj = 0; bj < 2; ++bj) { const f32x4 v0 = acc[ai][bj][m][0], v1 = acc[ai][bj][m][1];
                        float ss = ((v0[0] * v0[0] + v0[1] * v0[1]) + (v0[2] * v0[2] + v0[3] * v0[3])) + ((v1[0] * v1[0] + v1[1] * v1[1]) + (v1[2] * v1[2] + v1[3] * v1[3]));
                        ss += __shfl_xor(ss, 16); ss += __shfl_xor(ss, 32);
                        if (fq == 0) red[((ai * 128 + wr * 64 + m * 16 + fr) * 2 + bj) * 4 + wc] = ss; }
            asm volatile("s_waitcnt lgkmcnt(0)" ::: "memory"); __builtin_amdgcn_s_barrier(); asm volatile("" ::: "memory");
            const f32x4 ga = *(const f32x4*)(gkn + wc * 32 + 8 * fq), gb = *(const f32x4*)(gkn + wc * 32 + 8 * fq + 4);
            g[0] = ga[0]; g[1] = ga[1]; g[2] = ga[2]; g[3] = ga[3]; g[4] = gb[0]; g[5] = gb[1]; g[6] = gb[2]; g[7] = gb[3];
        }
#pragma unroll
        for (int ai = 0; ai < 2; ++ai)
#pragma unroll
            for (int m = 0; m < 4; ++m) { bf16_t* rowp = bs + (size_t)(row0 + ai * 128 + m * 16) * 2048 + col0;
#pragma unroll
                for (int bj = 0; bj < 2; ++bj) { f32x4 v0 = acc[ai][bj][m][0], v1 = acc[ai][bj][m][1];
                    float rs = 1.f;
                    if (knope) { const f32x4 t = *(const LAS f32x4*)(red + ((ai * 128 + wr * 64 + m * 16 + fr) * 2 + bj) * 4); rs = RSQ(((t[0] + t[1]) + (t[2] + t[3])) * (1.f / 128.f) + EPS); }
                    u32x4 w; w.x = pg8::cvt_pk_bf16(v0[0] * rs * g[0], v0[1] * rs * g[1]); w.y = pg8::cvt_pk_bf16(v0[2] * rs * g[2], v0[3] * rs * g[3]);
                    w.z = pg8::cvt_pk_bf16(v1[0] * rs * g[4], v1[1] * rs * g[5]); w.w = pg8::cvt_pk_bf16(v1[2] * rs * g[6], v1[3] * rs * g[7]);
                    *(u32x4*)(rowp + bj * 128) = w; }
                asm volatile("" ::: "memory"); }
    }
};
struct EpiG1 {
    static constexpr bool PERM = true;
    unsigned char* ws; const float* cs;
    __device__ __forceinline__ void operator()(EPI_ARGS) const {
        bf16_t* bs; int ldc, ct;
        if (u.pn < 4) { bs = (bf16_t*)(ws + AR_XA); ldc = 1024; ct = u.pn; } else if (u.pn < 16) { bs = (bf16_t*)(ws + AR_RQKV); ldc = 3072; ct = u.pn - 4; } else { bs = (bf16_t*)(ws + AR_MD); ldc = 768; ct = u.pn - 16; }
        const int row0 = u.pm * 256 + wr * 64 + fr, col0 = ct * 256 + wc * 32 + 8 * fq;
        const bool rope = (u.pn >= 4) && (u.pn < 12), iskey = (u.pn >= 8);
        const int bq = u.pm / 17, s0 = (u.pm - bq * 17) * 256 + wr * 64 + fr;
        const int f0 = (wc * 4 + fq) * 4;
#pragma unroll
        for (int ai = 0; ai < 2; ++ai)
#pragma unroll
            for (int m = 0; m < 4; ++m) { bf16_t* rowp = bs + (size_t)(row0 + ai * 128 + m * 16) * ldc + col0;
                const int s = s0 + ai * 128 + m * 16, t = s - LC; const bool lat = s >= LC;
#pragma unroll
                for (int bj = 0; bj < 2; ++bj) { f32x4 v0 = acc[ai][bj][m][0], v1 = acc[ai][bj][m][1];
                    if (rope) {
                        if (lat) { const int pos = bj ? (t & 63) : (t >> 6); const f32x4 c = *(const f32x4*)(cs + pos * 64 + f0), sn = *(const f32x4*)(cs + 4096 + pos * 64 + f0);
                            const f32x4 a = v0 * c - v1 * sn, b = v1 * c + v0 * sn; v0 = a; v1 = b; }
                        if (iskey) { v0 = v0 * 0.0625f; v1 = v1 * 0.0625f; } }
                    u32x4 w; w.x = pg8::cvt_pk_bf16(v0[0], v0[1]); w.y = pg8::cvt_pk_bf16(v0[2], v0[3]); w.z = pg8::cvt_pk_bf16(v1[0], v1[1]); w.w = pg8::cvt_pk_bf16(v1[2], v1[3]);
                    *(u32x4*)(rowp + bj * 128) = w; }
                asm volatile("" ::: "memory"); }
    }
};
typedef f16_t f16x8 __attribute__((ext_vector_type(8)));
struct EpiLru {
    static constexpr bool PERM = true;
    const bf16_t* U; f16_t* RI; const float* ba; const float* bx; const float* sp;
    __device__ __forceinline__ void operator()(EPI_ARGS) const {
        const int row0 = u.pm * 256 + wr * 64 + fr, ch0 = u.pn * 128 + wc * 32 + 8 * fq;
        float bav[8], bxv[8], spv[8];
#pragma unroll
        for (int e = 0; e < 8; ++e) { bav[e] = ba[ch0 + e]; bxv[e] = bx[ch0 + e]; spv[e] = sp[ch0 + e] * (-8.f); }
#pragma unroll
        for (int ai = 0; ai < 2; ++ai)
#pragma unroll
            for (int m = 0; m < 4; ++m) { const int row = row0 + ai * 128 + m * 16;
                const u32x4 uw = *(const u32x4*)(U + (size_t)row * 1024 + ch0);
                float uv[8] = {lo_bf(uw.x), hi_bf(uw.x), lo_bf(uw.y), hi_bf(uw.y), lo_bf(uw.z), hi_bf(uw.z), lo_bf(uw.w), hi_bf(uw.w)};
                f16x8 la, bc;
#pragma unroll
                for (int e = 0; e < 8; ++e) { const float rp = acc[ai][0][m][e >> 2][e & 3] + bav[e], ip = acc[ai][1][m][e >> 2][e & 3] + bxv[e];
                    const float r = sigmoidf_(rp), ig = sigmoidf_(ip);
                    const float loga = r * spv[e];
                    const float bb = SQRT(fmaxf(-expm1f(2.f * loga), 0.f)) * (ig * uv[e]);
                    la[e] = (f16_t)(loga * LOG2E); bc[e] = (f16_t)bb; }
                *(f16x8*)(RI + (size_t)row * 2048 + ch0) = la; *(f16x8*)(RI + (size_t)row * 2048 + 1024 + ch0) = bc;
                asm volatile("" ::: "memory"); }
    }
};
struct EpiGate {
    static constexpr bool PERM = true;
    unsigned char* ws;
    __device__ __forceinline__ void operator()(EPI_ARGS) const {
        if (u.z) {
            bf16_t* gm = (bf16_t*)(ws + AR_GMC) + ((size_t)(u.z - 1) * 1024 + (u.pm / 17) * 256 + wr * 64 + fr) * 1024 + u.pn * 256 + wc * 32 + 8 * fq;
#pragma unroll
            for (int ai = 0; ai < 2; ++ai)
#pragma unroll
                for (int m = 0; m < 4; ++m)
#pragma unroll
                    for (int bj = 0; bj < 2; ++bj) { const f32x4 v0 = acc[ai][bj][m][0], v1 = acc[ai][bj][m][1];
                        u32x4 w; w.x = pg8::cvt_pk_bf16(sigmoidf_(v0[0]), sigmoidf_(v0[1])); w.y = pg8::cvt_pk_bf16(sigmoidf_(v0[2]), sigmoidf_(v0[3]));
                        w.z = pg8::cvt_pk_bf16(sigmoidf_(v1[0]), sigmoidf_(v1[1])); w.w = pg8::cvt_pk_bf16(sigmoidf_(v1[2]), sigmoidf_(v1[3]));
                        *(u32x4*)(gm + (size_t)(ai * 128 + m * 16) * 1024 + bj * 128) = w; }
            return;
        }
        const int br = u.pn >> 2; const size_t yo = (br == 0) ? AR_Y0 : (br == 1) ? AR_YB : AR_QN; bf16_t* bs = (bf16_t*)(ws + yo);
        const int row0 = u.pm * 256 + wr * 64 + fr, col0 = (u.pn & 3) * 256 + wc * 32 + 8 * fq;
        if (br == 0) {
            const int b = u.pm / 17, sg0 = (u.pm - b * 17) * 2;
#pragma unroll
            for (int ai = 0; ai < 2; ++ai) {
                const float* hfp = (const float*)(ws + AR_HIN) + ((size_t)(0 * NB + b) * 34 + sg0 + ai) * 1024 + col0;
                const float* hbp = (const float*)(ws + AR_HIN) + ((size_t)(1 * NB + b) * 34 + sg0 + ai) * 1024 + col0;
#pragma unroll
                for (int bj = 0; bj < 2; ++bj) {
                    const f32x4 hf0 = *(const f32x4*)(hfp + bj * 128), hf1 = *(const f32x4*)(hfp + bj * 128 + 4), hb0 = *(const f32x4*)(hbp + bj * 128), hb1 = *(const f32x4*)(hbp + bj * 128 + 4);
#pragma unroll
                    for (int m = 0; m < 4; ++m) { const size_t ro = (size_t)(row0 + ai * 128 + m * 16) * 1024 + col0 + bj * 128;
                        const f32x4 v0 = acc[ai][bj][m][0], v1 = acc[ai][bj][m][1];
                        const u32x4 y = *(const u32x4*)(bs + ro);
                        const f16x8 cf = *(const f16x8*)((const f16_t*)(ws + AR_CAF) + ro), cb = *(const f16x8*)((const f16_t*)(ws + AR_CAB) + ro);
                        float yy[8]; unpack8(y, yy);
                        yy[0] += (float)cf[0] * hf0[0] + (float)cb[0] * hb0[0]; yy[1] += (float)cf[1] * hf0[1] + (float)cb[1] * hb0[1]; yy[2] += (float)cf[2] * hf0[2] + (float)cb[2] * hb0[2]; yy[3] += (float)cf[3] * hf0[3] + (float)cb[3] * hb0[3];
                        yy[4] += (float)cf[4] * hf1[0] + (float)cb[4] * hb1[0]; yy[5] += (float)cf[5] * hf1[1] + (float)cb[5] * hb1[1]; yy[6] += (float)cf[6] * hf1[2] + (float)cb[6] * hb1[2]; yy[7] += (float)cf[7] * hf1[3] + (float)cb[7] * hb1[3];
                        u32x4 w; w.x = pg8::cvt_pk_bf16(yy[0] * siluf_(v0[0]), yy[1] * siluf_(v0[1])); w.y = pg8::cvt_pk_bf16(yy[2] * siluf_(v0[2]), yy[3] * siluf_(v0[3]));
                        w.z = pg8::cvt_pk_bf16(yy[4] * siluf_(v1[0]), yy[5] * siluf_(v1[1])); w.w = pg8::cvt_pk_bf16(yy[6] * siluf_(v1[2]), yy[7] * siluf_(v1[3]));
                        *(u32x4*)(bs + ro) = w;
                        asm volatile("" ::: "memory"); } } }
            return;
        }
#pragma unroll
        for (int ai = 0; ai < 2; ++ai)
#pragma unroll
            for (int mh = 0; mh < 2; ++mh) {
                u32x4 yq[2][2];
#pragma unroll
                for (int mm = 0; mm < 2; ++mm)
#pragma unroll
                    for (int bj = 0; bj < 2; ++bj) yq[mm][bj] = *(const u32x4*)(bs + (size_t)(row0 + ai * 128 + (2 * mh + mm) * 16) * 1024 + col0 + bj * 128);
#pragma unroll
                for (int mm = 0; mm < 2; ++mm) { const int m = 2 * mh + mm; bf16_t* rowp = bs + (size_t)(row0 + ai * 128 + m * 16) * 1024 + col0;
#pragma unroll
                    for (int bj = 0; bj < 2; ++bj) { const f32x4 v0 = acc[ai][bj][m][0], v1 = acc[ai][bj][m][1];
                        const u32x4 y = yq[mm][bj];
                        u32x4 w; w.x = pg8::cvt_pk_bf16(lo_bf(y.x) * siluf_(v0[0]), hi_bf(y.x) * siluf_(v0[1])); w.y = pg8::cvt_pk_bf16(lo_bf(y.y) * siluf_(v0[2]), hi_bf(y.y) * siluf_(v0[3]));
                        w.z = pg8::cvt_pk_bf16(lo_bf(y.z) * siluf_(v1[0]), hi_bf(y.z) * siluf_(v1[1])); w.w = pg8::cvt_pk_bf16(lo_bf(y.w) * siluf_(v1[2]), hi_bf(y.w) * siluf_(v1[3]));
                        *(u32x4*)(rowp + bj * 128) = w; } }
                asm volatile("" ::: "memory"); }
    }
};
struct EpiD {
    static constexpr bool PERM = true;
    bf16_t* Z; unsigned char* gs; bf16_t* ZP; const bf16_t* GMC;
    __device__ __forceinline__ void operator()(EPI_ARGS) const {
        const int col0 = u.pn * 256 + wc * 32 + 8 * fq, i = (u.z & 7) >> 1; const bool part = u.z >= 8;
        const int row0 = part ? ((u.pm / 17) * 256 + wr * 64 + fr) : (u.pm * 256 + wr * 64 + fr);
        bf16_t* const zb = part ? (ZP + (size_t)i * 1024 * 1024) : Z;
        const unsigned tq = (unsigned)(((wr * 4 + wc) * 64 + fq * 16 + fr) * 64);
        if ((u.z & 1) == 0) {
#pragma unroll
            for (int ai = 0; ai < 2; ++ai)
#pragma unroll
                for (int m = 0; m < 4; ++m)
#pragma unroll
                    for (int bj = 0; bj < 2; ++bj) { const f32x4 v0 = acc[ai][bj][m][0], v1 = acc[ai][bj][m][1];
                        u32x4 w; w.x = pg8::cvt_pk_bf16(sigmoidf_(v0[0]), sigmoidf_(v0[1])); w.y = pg8::cvt_pk_bf16(sigmoidf_(v0[2]), sigmoidf_(v0[3]));
                        w.z = pg8::cvt_pk_bf16(sigmoidf_(v1[0]), sigmoidf_(v1[1])); w.w = pg8::cvt_pk_bf16(sigmoidf_(v1[2]), sigmoidf_(v1[3]));
                        *(u32x4*)(gs + (((ai * 4 + m) * 2 + bj) >> 2) * 32768 + tq + (((ai * 4 + m) * 2 + bj) & 3) * 16) = w; }
        } else {
            const bool rmw = (i > 0) && !part;
#pragma unroll
            for (int ai = 0; ai < 2; ++ai) {
                u32x4 gq[4][2], zq[4][2];
                if (part) {
#pragma unroll
                    for (int m = 0; m < 4; ++m)
#pragma unroll
                        for (int bj = 0; bj < 2; ++bj) { gq[m][bj] = *(const u32x4*)(GMC + ((size_t)i * 1024 + row0 + ai * 128 + m * 16) * 1024 + col0 + bj * 128); zq[m][bj] = (u32x4){0u, 0u, 0u, 0u}; }
                } else {
#pragma unroll
                    for (int m = 0; m < 4; ++m)
#pragma unroll
                        for (int bj = 0; bj < 2; ++bj) { gq[m][bj] = *(const u32x4*)(gs + (((ai * 4 + m) * 2 + bj) >> 2) * 32768 + tq + (((ai * 4 + m) * 2 + bj) & 3) * 16);
                            zq[m][bj] = (i > 0) ? *(const u32x4*)(zb + (size_t)(row0 + ai * 128 + m * 16) * 1024 + col0 + bj * 128) : (u32x4){0u, 0u, 0u, 0u}; }
                }
#pragma unroll
                for (int m = 0; m < 4; ++m) { bf16_t* zrow = zb + (size_t)(row0 + ai * 128 + m * 16) * 1024 + col0;
#pragma unroll
                    for (int bj = 0; bj < 2; ++bj) { const f32x4 v0 = acc[ai][bj][m][0], v1 = acc[ai][bj][m][1];
                        const u32x4 g = gq[m][bj], zo = zq[m][bj]; bf16_t* zp = zrow + bj * 128;
                        const float o0 = lo_bf(g.x) * v0[0] + lo_bf(zo.x), o1 = hi_bf(g.x) * v0[1] + hi_bf(zo.x), o2 = lo_bf(g.y) * v0[2] + lo_bf(zo.y), o3 = hi_bf(g.y) * v0[3] + hi_bf(zo.y);
                        const float o4 = lo_bf(g.z) * v1[0] + lo_bf(zo.z), o5 = hi_bf(g.z) * v1[1] + hi_bf(zo.z), o6 = lo_bf(g.w) * v1[2] + lo_bf(zo.w), o7 = hi_bf(g.w) * v1[3] + hi_bf(zo.w);
                        u32x4 w; w.x = pg8::cvt_pk_bf16(o0, o1); w.y = pg8::cvt_pk_bf16(o2, o3); w.z = pg8::cvt_pk_bf16(o4, o5); w.w = pg8::cvt_pk_bf16(o6, o7); *(u32x4*)zp = w; } }
                asm volatile("" ::: "memory"); }
        }
    }
};
struct EpiOut {
    static constexpr bool PERM = false;
    const float* xlat; const float* xctx; float* olat; float* octx; const float* mod;
    __device__ __forceinline__ void operator()(EPI_ARGS) const {
        const int b = u.pm / 17, isctx = (u.pm - b * 17) == 0;
        const float* gate = mod + (isctx ? 4 : b) * 3072 + 2048;
        const int col0 = u.pn * 256 + wc * 32 + 4 * fq;
        f32x4 gv[2][2];
#pragma unroll
        for (int bj = 0; bj < 2; ++bj)
#pragma unroll
            for (int n = 0; n < 2; ++n) gv[bj][n] = *(const f32x4*)(gate + col0 + bj * 128 + n * 16);
        const float* xin = isctx ? xctx : xlat; float* xo = isctx ? octx : olat;
#pragma unroll
        for (int ai = 0; ai < 2; ++ai) {
            f32x4 xq[4][2][2];
#pragma unroll
            for (int m = 0; m < 4; ++m) { const int s = (u.pm - b * 17) * 256 + ai * 128 + wr * 64 + m * 16 + fr;
                const size_t off = isctx ? ((size_t)(b * LC + s) * 1024 + col0) : ((size_t)(b * TT + (s - LC)) * 1024 + col0);
#pragma unroll
                for (int bj = 0; bj < 2; ++bj)
#pragma unroll
                    for (int n = 0; n < 2; ++n) xq[m][bj][n] = *(const f32x4*)(xin + off + bj * 128 + n * 16); }
#pragma unroll
            for (int m = 0; m < 4; ++m) { const int s = (u.pm - b * 17) * 256 + ai * 128 + wr * 64 + m * 16 + fr;
                const size_t off = isctx ? ((size_t)(b * LC + s) * 1024 + col0) : ((size_t)(b * TT + (s - LC)) * 1024 + col0);
#pragma unroll
                for (int bj = 0; bj < 2; ++bj)
#pragma unroll
                    for (int n = 0; n < 2; ++n) *(f32x4*)(xo + off + bj * 128 + n * 16) = xq[m][bj][n] + gv[bj][n] * acc[ai][bj][m][n]; }
            asm volatile("" ::: "memory"); }
    }
};

__device__ __forceinline__ void phase_ret_rope(Ctx& C, bf16_t* RQKV) {
    const float* cs = C.ctl + CT_ROPER; const float* sn = cs + 4096;
    for (int m = C.gw; m < MR; m += C.ngw) {
        const int b = m / SS, s = m - b * SS; const bool lat = s >= LC; const int t = s - LC, prow = lat ? (t >> 6) : 0, pcol = lat ? (t & 63) : 0;
        bf16_t* row = RQKV + (size_t)m * 3072;
#pragma unroll
        for (int j = 0; j < 16; ++j) {
            const int idx = j * 64 + C.lane, f = idx & 63, half = (idx >> 6) & 1, h = (idx >> 7) & 3, tz = idx >> 9;
            bf16_t* p = row + tz * 1024 + h * 256 + half * 128 + f;
            const float x1 = bf2f(p[0]), x2 = bf2f(p[64]);
            float o1 = x1, o2 = x2;
            if (lat) { const int pos = half ? pcol : prow; const float c = cs[pos * 64 + f], sv = sn[pos * 64 + f]; o1 = x1 * c - x2 * sv; o2 = x2 * c + x1 * sv; }
            if (tz) { o1 *= 0.0625f; o2 *= 0.0625f; }
            p[0] = (bf16_t)f2bf(o1); p[64] = (bf16_t)f2bf(o2);
        }
    }
}

#define RS_STEP(o, cnt, st) do { const bool up_ = (C.lane & (st)) != 0; _Pragma("unroll") for (int e_ = 0; e_ < (cnt) / 2; ++e_) { \
        const float send_ = up_ ? o[e_] : o[e_ + (cnt) / 2]; const float keep_ = up_ ? o[e_ + (cnt) / 2] : o[e_]; o[e_] = keep_ + __shfl_xor(send_, (st)); } } while (0)

__device__ __forceinline__ void phase_ret_naive(Ctx& C, int l, const bf16_t* RQKV, bf16_t* OI) {
    LAS unsigned char* qs = C.lds + C.wave * 512;
    const int nbu = (MR / 8) * 16;
    for (int bu = C.bid; bu < nbu; bu += C.G) {
        const int hq = bu & 15, h = hq >> 2, qd = hq & 3, n = (bu >> 4) * 8 + C.wave;
        const int b = n / SS, sn_ = n - b * SS;
        const float lgf = C.ctl[CT_LG + (l * 2 + 0) * 4 + h], lgb = C.ctl[CT_LG + (l * 2 + 1) * 4 + h];
        const int pfn = sn_, pbn = (sn_ < LC) ? (LC - 1 - sn_) : (SS + LC - 1 - sn_);
        asm volatile("s_waitcnt lgkmcnt(0)" ::: "memory");
        *(LAS u32x2*)(qs + C.lane * 8) = *(const u32x2*)(RQKV + (size_t)n * 3072 + h * 256 + C.lane * 4);
        asm volatile("s_waitcnt lgkmcnt(0)" ::: "memory");
        float o[64];
#pragma unroll
        for (int e = 0; e < 64; ++e) o[e] = 0.f;
        for (int sm = C.lane; sm < SS; sm += 64) {
            const bf16_t* krow = RQKV + (size_t)(b * SS + sm) * 3072 + 1024 + h * 256;
            float dot = 0.f;
#pragma unroll 4
            for (int c = 0; c < 32; ++c) { const u32x4 kv = *(const u32x4*)(krow + c * 8); const u32x4 qv = *(const LAS u32x4*)(qs + c * 16);
                dot += lo_bf(kv.x) * lo_bf(qv.x) + hi_bf(kv.x) * hi_bf(qv.x) + lo_bf(kv.y) * lo_bf(qv.y) + hi_bf(kv.y) * hi_bf(qv.y)
                     + lo_bf(kv.z) * lo_bf(qv.z) + hi_bf(kv.z) * hi_bf(qv.z) + lo_bf(kv.w) * lo_bf(qv.w) + hi_bf(kv.w) * hi_bf(qv.w); }
            const int pfm = sm, pbm = (sm < LC) ? (LC - 1 - sm) : (SS + LC - 1 - sm);
            float w = 0.f;
            if (pfn >= pfm) w += EX2(lgf * (float)(pfn - pfm));
            if (pbn >= pbm) w += EX2(lgb * (float)(pbn - pbm));
            const float ws_ = w * dot;
            const bf16_t* vrow = krow + 1024 + qd * 64;
#pragma unroll
            for (int c = 0; c < 8; ++c) { const u32x4 vv = *(const u32x4*)(vrow + c * 8);
                o[c * 8 + 0] += ws_ * lo_bf(vv.x); o[c * 8 + 1] += ws_ * hi_bf(vv.x); o[c * 8 + 2] += ws_ * lo_bf(vv.y); o[c * 8 + 3] += ws_ * hi_bf(vv.y);
                o[c * 8 + 4] += ws_ * lo_bf(vv.z); o[c * 8 + 5] += ws_ * hi_bf(vv.z); o[c * 8 + 6] += ws_ * lo_bf(vv.w); o[c * 8 + 7] += ws_ * hi_bf(vv.w); }
        }
        RS_STEP(o, 64, 32); RS_STEP(o, 32, 16); RS_STEP(o, 16, 8); RS_STEP(o, 8, 4); RS_STEP(o, 4, 2); RS_STEP(o, 2, 1);
        OI[(size_t)n * 1024 + h * 256 + qd * 64 + C.lane] = (bf16_t)f2bf(o[0]);
    }
}
__device__ __forceinline__ void phase_ret_ln(Ctx& C, int l, bf16_t* OI) {
    const float* gain = INP(16) + l * 1024;
    for (int m = C.gw; m < MR; m += C.ngw) {
#pragma unroll
        for (int h = 0; h < 4; ++h) { bf16_t* p = OI + (size_t)m * 1024 + h * 256 + C.lane * 4;
            const u32x2 w = *(const u32x2*)p; float x0 = lo_bf(w.x), x1 = hi_bf(w.x), x2 = lo_bf(w.y), x3 = hi_bf(w.y);
            const float mean = wave_sum((x0 + x1) + (x2 + x3)) * (1.f / 256.f);
            x0 -= mean; x1 -= mean; x2 -= mean; x3 -= mean;
            const float var = wave_sum((x0 * x0 + x1 * x1) + (x2 * x2 + x3 * x3)) * (1.f / 256.f);
            const float rstd = RSQ(var + EPS);
            const f32x4 g = *(const f32x4*)(gain + h * 256 + C.lane * 4);
            u32x2 o; o.x = pk2(x0 * rstd * g.x, x1 * rstd * g.y); o.y = pk2(x2 * rstd * g.z, x3 * rstd * g.w); *(u32x2*)p = o; }
    }
}

__device__ __forceinline__ void phase_md_post(Ctx& C, int l, bf16_t* MD) {
    const float* qn = INP(17) + l * 384; const float* kvn = INP(19) + l * 256; const float* gkr = INP(24) + l * 64;
    const float* cs = C.ctl + CT_ROPEM; const float* sn = cs + 1024;
    for (int m = C.gw; m < MR; m += C.ngw) {
        const int b = m / SS, s = m - b * SS; const bool lat = s >= LC; const int t = s - LC;
        bf16_t* row = MD + (size_t)m * 768;
        {   float x[6]; float ss = 0.f;
#pragma unroll
            for (int j = 0; j < 3; ++j) { const unsigned w = *(const unsigned*)(row + 2 * C.lane + 128 * j); x[2 * j] = lo_bf(w); x[2 * j + 1] = hi_bf(w); ss += x[2 * j] * x[2 * j] + x[2 * j + 1] * x[2 * j + 1]; }
            const float rstd = RSQ(wave_sum(ss) * (1.f / 384.f) + EPS);
#pragma unroll
            for (int j = 0; j < 3; ++j) { const int c = 2 * C.lane + 128 * j; *(unsigned*)(row + c) = pk2(x[2 * j] * rstd * qn[c], x[2 * j + 1] * rstd * qn[c + 1]); } }
        {   float x[4]; float ss = 0.f;
#pragma unroll
            for (int j = 0; j < 2; ++j) { const unsigned w = *(const unsigned*)(row + 384 + 2 * C.lane + 128 * j); x[2 * j] = lo_bf(w); x[2 * j + 1] = hi_bf(w); ss += x[2 * j] * x[2 * j] + x[2 * j + 1] * x[2 * j + 1]; }
            const float rstd = RSQ(wave_sum(ss) * (1.f / 256.f) + EPS);
#pragma unroll
            for (int j = 0; j < 2; ++j) { const int c = 2 * C.lane + 128 * j; *(unsigned*)(row + 384 + c) = pk2(x[2 * j] * rstd * kvn[c], x[2 * j + 1] * rstd * kvn[c + 1]); } }
        {   const float x = bf2f(row[640 + C.lane]);
            const float rstd = RSQ(wave_sum(x * x) * (1.f / 64.f) + EPS);
            float y = x * rstd * gkr[C.lane];
            if (lat) { const float pr = __shfl_xor(y, 16); const float rot = (C.lane & 16) ? pr : -pr; const int f = C.lane & 15, pos = (C.lane < 32) ? (t >> 6) : (t & 63);
                y = y * cs[pos * 16 + f] + rot * sn[pos * 16 + f]; }
            row[640 + C.lane] = (bf16_t)f2bf(y); }
    }
}
__device__ __forceinline__ void phase_qk_post(Ctx& C, int l, bf16_t* QN, bf16_t* QP, bf16_t* KV) {
    const float* gqn = INP(21) + l * 128; const float* gqr = INP(22) + l * 64; const float* gkn = INP(23) + l * 128;
    const float* cs = C.ctl + CT_ROPEM; const float* sn = cs + 1024;
    for (int m = C.gw; m < MR; m += C.ngw) {
        const int b = m / SS, s = m - b * SS; const bool lat = s >= LC; const int t = s - LC;
        bf16_t* qrow = QN + (size_t)m * 1024; bf16_t* prow = QP + (size_t)m * 512; bf16_t* krow = KV + (size_t)m * 2048;
#pragma unroll
        for (int h = 0; h < 8; ++h) {
            {   unsigned* p = (unsigned*)(qrow + h * 128 + 2 * C.lane); const unsigned w = *p; const float x0 = lo_bf(w), x1 = hi_bf(w);
                const float rstd = RSQ(wave_sum(x0 * x0 + x1 * x1) * (1.f / 128.f) + EPS);
                *p = pk2(x0 * rstd * gqn[2 * C.lane] * QSCALE, x1 * rstd * gqn[2 * C.lane + 1] * QSCALE); }
            {   bf16_t* p = prow + h * 64 + C.lane; const float x = bf2f(*p);
                const float rstd = RSQ(wave_sum(x * x) * (1.f / 64.f) + EPS);
                float y = x * rstd * gqr[C.lane];
                if (lat) { const float pr = __shfl_xor(y, 16); const float rot = (C.lane & 16) ? pr : -pr; const int f = C.lane & 15, pos = (C.lane < 32) ? (t >> 6) : (t & 63);
                    y = y * cs[pos * 16 + f] + rot * sn[pos * 16 + f]; }
                *p = (bf16_t)f2bf(y * QSCALE); }
            {   unsigned* p = (unsigned*)(krow + h * 128 + 2 * C.lane); const unsigned w = *p; const float x0 = lo_bf(w), x1 = hi_bf(w);
                const float rstd = RSQ(wave_sum(x0 * x0 + x1 * x1) * (1.f / 128.f) + EPS);
                *p = pk2(x0 * rstd * gkn[2 * C.lane], x1 * rstd * gkn[2 * C.lane + 1]); }
        }
    }
}

__device__ __forceinline__ void phase_attn_naive(Ctx& C, bool with_ctx, bf16_t* QN, const bf16_t* QP, const bf16_t* KV, const bf16_t* MD) {
    LAS unsigned char* qs = C.lds + C.wave * 512;
    const int nlat = NB * 8 * (TT / 8), nctx = with_ctx ? NB * 8 * (LC / 8) : 0;
    for (int bu = C.bid; bu < nlat + nctx; bu += C.G) {
        int b, h, s, nkeys;
        if (bu < nlat) { const int tb = bu % (TT / 8), bh = bu / (TT / 8); b = bh >> 3; h = bh & 7; s = LC + tb * 8 + C.wave; nkeys = SS; }
        else { const int r = bu - nlat, tb = r % (LC / 8), bh = r / (LC / 8); b = bh >> 3; h = bh & 7; s = tb * 8 + C.wave; nkeys = LC; }
        const size_t m = (size_t)b * SS + s;
        asm volatile("s_waitcnt lgkmcnt(0)" ::: "memory");
        if (C.lane < 32) *(LAS u32x2*)(qs + C.lane * 8) = *(const u32x2*)(QN + m * 1024 + h * 128 + C.lane * 4);
        else if (C.lane < 48) *(LAS u32x2*)(qs + 256 + (C.lane - 32) * 8) = *(const u32x2*)(QP + m * 512 + h * 64 + (C.lane - 32) * 4);
        asm volatile("s_waitcnt lgkmcnt(0)" ::: "memory");
        float o[128];
#pragma unroll
        for (int e = 0; e < 128; ++e) o[e] = 0.f;
        float mrun = -1e30f, lrun = 0.f;
        for (int key = C.lane; key < nkeys; key += 64) {
            const size_t kr = (size_t)b * SS + key;
            const bf16_t* kn = KV + kr * 2048 + h * 128; const bf16_t* kro = MD + kr * 768 + 640;
            float dot = 0.f;
#pragma unroll 4
            for (int c = 0; c < 16; ++c) { const u32x4 kv = *(const u32x4*)(kn + c * 8); const u32x4 qv = *(const LAS u32x4*)(qs + c * 16);
                dot += lo_bf(kv.x) * lo_bf(qv.x) + hi_bf(kv.x) * hi_bf(qv.x) + lo_bf(kv.y) * lo_bf(qv.y) + hi_bf(kv.y) * hi_bf(qv.y)
                     + lo_bf(kv.z) * lo_bf(qv.z) + hi_bf(kv.z) * hi_bf(qv.z) + lo_bf(kv.w) * lo_bf(qv.w) + hi_bf(kv.w) * hi_bf(qv.w); }
#pragma unroll 4
            for (int c = 0; c < 8; ++c) { const u32x4 kv = *(const u32x4*)(kro + c * 8); const u32x4 qv = *(const LAS u32x4*)(qs + 256 + c * 16);
                dot += lo_bf(kv.x) * lo_bf(qv.x) + hi_bf(kv.x) * hi_bf(qv.x) + lo_bf(kv.y) * lo_bf(qv.y) + hi_bf(kv.y) * hi_bf(qv.y)
                     + lo_bf(kv.z) * lo_bf(qv.z) + hi_bf(kv.z) * hi_bf(qv.z) + lo_bf(kv.w) * lo_bf(qv.w) + hi_bf(kv.w) * hi_bf(qv.w); }
            const float mnew = fmaxf(mrun, dot), alpha = EX2(mrun - mnew), p = EX2(dot - mnew);
            lrun = lrun * alpha + p; mrun = mnew;
            const bf16_t* vrow = KV + kr * 2048 + 1024 + h * 128;
#pragma unroll
            for (int c = 0; c < 16; ++c) { const u32x4 vv = *(const u32x4*)(vrow + c * 8);
                o[c * 8 + 0] = o[c * 8 + 0] * alpha + p * lo_bf(vv.x); o[c * 8 + 1] = o[c * 8 + 1] * alpha + p * hi_bf(vv.x);
                o[c * 8 + 2] = o[c * 8 + 2] * alpha + p * lo_bf(vv.y); o[c * 8 + 3] = o[c * 8 + 3] * alpha + p * hi_bf(vv.y);
                o[c * 8 + 4] = o[c * 8 + 4] * alpha + p * lo_bf(vv.z); o[c * 8 + 5] = o[c * 8 + 5] * alpha + p * hi_bf(vv.z);
                o[c * 8 + 6] = o[c * 8 + 6] * alpha + p * lo_bf(vv.w); o[c * 8 + 7] = o[c * 8 + 7] * alpha + p * hi_bf(vv.w); }
        }
        const float mall = wave_max(mrun), fsc = EX2(mrun - mall);
        const float lall = wave_sum(lrun * fsc);
#pragma unroll
        for (int e = 0; e < 128; ++e) o[e] *= fsc;
        RS_STEP(o, 128, 32); RS_STEP(o, 64, 16); RS_STEP(o, 32, 8); RS_STEP(o, 16, 4); RS_STEP(o, 8, 2); RS_STEP(o, 4, 1);
        const float inv = 1.f / lall;
        *(unsigned*)(QN + m * 1024 + h * 128 + 2 * C.lane) = pk2(o[0] * inv, o[1] * inv);
    }
}

__device__ __forceinline__ void phase_conv(Ctx& C, int l, const bf16_t* XA, bf16_t* U) {
    const float* cw = INP(8) + l * 4 * 1024; const float* cb = INP(9) + l * 1024;
    const int gt = C.bid * NTHR + C.tid, ngt = C.G * NTHR;
    for (int it = gt; it < MR * 128; it += ngt) {
        const int m = it >> 7, c0 = (it & 127) * 8, b = m / SS, s = m - b * SS;
        const int lo = (s < LC) ? 0 : LC, hi = (s < LC) ? LC : SS;
        float a[8];
#pragma unroll
        for (int e = 0; e < 8; ++e) a[e] = cb[c0 + e];
#pragma unroll
        for (int j = 0; j < 4; ++j) { const int sj = s + j - 2;
            if (sj >= lo && sj < hi) { const u32x4 xv = *(const u32x4*)(XA + (size_t)(b * SS + sj) * 1024 + c0); const float* w = cw + j * 1024 + c0;
                a[0] += w[0] * lo_bf(xv.x); a[1] += w[1] * hi_bf(xv.x); a[2] += w[2] * lo_bf(xv.y); a[3] += w[3] * hi_bf(xv.y);
                a[4] += w[4] * lo_bf(xv.z); a[5] += w[5] * hi_bf(xv.z); a[6] += w[6] * lo_bf(xv.w); a[7] += w[7] * hi_bf(xv.w); } }
        u32x4 o; o.x = pk2(a[0], a[1]); o.y = pk2(a[2], a[3]); o.z = pk2(a[4], a[5]); o.w = pk2(a[6], a[7]);
        *(u32x4*)(U + (size_t)m * 1024 + c0) = o;
    }
}
typedef f16_t f16x2 __attribute__((ext_vector_type(2)));
__device__ __forceinline__ void phase_scan1(Ctx& C, int d, const f16_t* RI, float* SUM) {
    for (int un = C.gw; un < NB * 68 * 8; un += C.ngw) {
        const int cg_ = un & 7, sg = (un >> 3) % 68, b = (un >> 3) / 68, ch = cg_ * 128 + 2 * C.lane;
        float A0 = 1.f, A1 = 1.f, H0 = 0.f, H1 = 0.f;
        const f16_t* base = RI + (size_t)(b * SS + sg * 64) * 2048 + ch;
#pragma unroll 16
        for (int i = 0; i < 64; ++i) { const int r = d ? (63 - i) : i;
            const f16x2 la = *(const f16x2*)(base + (size_t)r * 2048), bc = *(const f16x2*)(base + (size_t)r * 2048 + 1024);
            const float a0 = EX2((float)la[0]), a1 = EX2((float)la[1]);
            H0 = a0 * H0 + (float)bc[0]; H1 = a1 * H1 + (float)bc[1]; A0 *= a0; A1 *= a1; }
        float* sp = SUM + ((size_t)(b * 68 + sg) * 1024 + ch) * 2;
        *(f32x4*)sp = (f32x4){A0, H0, A1, H1};
    }
}
__device__ __forceinline__ void phase_scan3(Ctx& C, int d, const f16_t* RI, const float* SUM, bf16_t* YA) {
    for (int un = C.gw; un < NB * 68 * 8; un += C.ngw) {
        const int cg_ = un & 7, sg = (un >> 3) % 68, b = (un >> 3) / 68, ch = cg_ * 128 + 2 * C.lane;
        float H0 = 0.f, H1 = 0.f;
        const int npre = d ? ((sg < 4) ? (3 - sg) : (71 - sg)) : sg;
#pragma unroll 4
        for (int p = 0; p < npre; ++p) { const int ps = d ? ((p < 4) ? (3 - p) : (71 - p)) : p;
            const f32x4 v = *(const f32x4*)(SUM + ((size_t)(b * 68 + ps) * 1024 + ch) * 2);
            H0 = v[0] * H0 + v[1]; H1 = v[2] * H1 + v[3]; }
        const f16_t* base = RI + (size_t)(b * SS + sg * 64) * 2048 + ch;
        bf16_t* yb = YA + (size_t)(b * SS + sg * 64) * 1024 + ch;
#pragma unroll 16
        for (int i = 0; i < 64; ++i) { const int r = d ? (63 - i) : i;
            const f16x2 la = *(const f16x2*)(base + (size_t)r * 2048), bc = *(const f16x2*)(base + (size_t)r * 2048 + 1024);
            const float a0 = EX2((float)la[0]), a1 = EX2((float)la[1]);
            H0 = a0 * H0 + (float)bc[0]; H1 = a1 * H1 + (float)bc[1];
            unsigned* yp = (unsigned*)(yb + (size_t)r * 1024);
            if (d == 0) *yp = pk2(H0, H1); else { const unsigned w = *yp; *yp = pk2(lo_bf(w) + H0, hi_bf(w) + H1); } }
    }
}

template <int W> __device__ __forceinline__ float group_sum(float v) {
#pragma unroll
    for (int o = 1; o < W; o <<= 1) v += __shfl_xor(v, o);
    return v;
}
__device__ __forceinline__ void phase_h2(Ctx& C, int l, bf16_t* H) {
    const float* gain = INP(6) + l * 1024;
    for (int m0 = C.gw * 2; m0 < MR; m0 += C.ngw * 2) {
        f32x4 v[2][4]; float ss[2];
#pragma unroll
        for (int q = 0; q < 2; ++q) { const float* xr = resid_row(C, l, m0 + q);
#pragma unroll
            for (int j = 0; j < 4; ++j) v[q][j] = *(const f32x4*)(xr + 4 * C.lane + 256 * j); }
        const int b = m0 / SS, s = m0 - b * SS, r = (s < LC) ? 4 : b;
        const float* mod = C.ctl + CT_MOD + (l * 5 + r) * 3072;
#pragma unroll
        for (int q = 0; q < 2; ++q) { float a = 0.f;
#pragma unroll
            for (int j = 0; j < 4; ++j) a += (v[q][j].x * v[q][j].x + v[q][j].y * v[q][j].y) + (v[q][j].z * v[q][j].z + v[q][j].w * v[q][j].w);
            ss[q] = a; }
        ss[0] = wave_sum(ss[0]); ss[1] = wave_sum(ss[1]);
#pragma unroll
        for (int j = 0; j < 4; ++j) { const int c = 4 * C.lane + 256 * j;
            const f32x4 g = *(const f32x4*)(gain + c), sh = *(const f32x4*)(mod + c), sc = *(const f32x4*)(mod + 1024 + c) + 1.0f;
#pragma unroll
            for (int q = 0; q < 2; ++q) { const float rstd = RSQ(ss[q] * (1.f / 1024.f) + EPS);
                const f32x4 o = ((v[q][j] * rstd) * g) * sc + sh;
                u32x2 w; w.x = pk2(o.x, o.y); w.y = pk2(o.z, o.w);
                *(u32x2*)(H + (size_t)(m0 + q) * 1024 + c) = w; } }
    }
}
__device__ __forceinline__ void phase_md_post2(Ctx& C, int l, bf16_t* MD) {
    const float* qn = INP(17) + l * 384; const float* kvn = INP(19) + l * 256; const float* gkr = INP(24) + l * 64;
    const float* cs = C.ctl + CT_ROPEM; const float* sn = cs + 1024;
    const int L = C.lane;
    for (int m0 = C.gw * 2; m0 < MR; m0 += C.ngw * 2) {
        u32x4 w0[2], w1[2];
#pragma unroll
        for (int q = 0; q < 2; ++q) { const bf16_t* row = MD + (size_t)(m0 + q) * 768; w0[q] = *(const u32x4*)(row + 8 * L); w1[q] = (L < 32) ? *(const u32x4*)(row + 512 + 8 * L) : (u32x4){0u, 0u, 0u, 0u}; }
#pragma unroll
        for (int q = 0; q < 2; ++q) { const int m = m0 + q, b = m / SS, s = m - b * SS; const bool lat = s >= LC; const int t = s - LC;
            bf16_t* row = MD + (size_t)m * 768;
            float x0[8], x1[8]; unpack8(w0[q], x0); unpack8(w1[q], x1);
            const float s0 = sumsq8(x0), s1 = sumsq8(x1);
            const float sq = wave_sum(L < 48 ? s0 : 0.f), skv = wave_sum((L >= 48 ? s0 : 0.f) + (L < 16 ? s1 : 0.f)), skr = wave_sum((L >= 16 && L < 24) ? s1 : 0.f);
            const float rq = RSQ(sq * (1.f / 384.f) + EPS), rkv = RSQ(skv * (1.f / 256.f) + EPS), rkr = RSQ(skr * (1.f / 64.f) + EPS);
            {   const float* g = (L < 48) ? (qn + 8 * L) : (kvn + 8 * (L - 48)); const float rs = (L < 48) ? rq : rkv;
#pragma unroll
                for (int e = 0; e < 8; ++e) x0[e] *= rs * g[e];
                *(u32x4*)(row + 8 * L) = pack8u(x0); }
            if (L < 16) {
#pragma unroll
                for (int e = 0; e < 8; ++e) x1[e] *= rkv * kvn[128 + 8 * L + e];
            } else if (L < 24) {
#pragma unroll
                for (int e = 0; e < 8; ++e) x1[e] *= rkr * gkr[8 * (L - 16) + e];
            }
            float pr[8];
#pragma unroll
            for (int e = 0; e < 8; ++e) pr[e] = __shfl_xor(x1[e], 2);
            if (lat && L >= 16 && L < 24) { const int qt = (L - 16) >> 1, f0 = ((L - 16) & 1) * 8, pos = (qt < 2) ? (t >> 6) : (t & 63); const float sg = (qt & 1) ? 1.f : -1.f;
#pragma unroll
                for (int e = 0; e < 8; ++e) x1[e] = x1[e] * cs[pos * 16 + f0 + e] + sg * pr[e] * sn[pos * 16 + f0 + e]; }
            if (L < 24) *(u32x4*)(row + 512 + 8 * L) = pack8u(x1);
        }
    }
}
__device__ __forceinline__ void phase_qk_post2(Ctx& C, int l, bf16_t* QN, bf16_t* QP, bf16_t* KV) {
    const float* gqn = INP(21) + l * 128; const float* gqr = INP(22) + l * 64; const float* gkn = INP(23) + l * 128;
    const float* cs = C.ctl + CT_ROPEM; const float* sn = cs + 1024;
    const int L = C.lane;
    for (int m0 = C.gw * 2; m0 < MR; m0 += C.ngw * 2) {
        u32x4 a[2][2], k[2][2], p[2];
#pragma unroll
        for (int q = 0; q < 2; ++q) { const size_t m = m0 + q;
            a[q][0] = *(const u32x4*)(QN + m * 1024 + 8 * L); a[q][1] = *(const u32x4*)(QN + m * 1024 + 512 + 8 * L);
            k[q][0] = *(const u32x4*)(KV + m * 2048 + 8 * L); k[q][1] = *(const u32x4*)(KV + m * 2048 + 512 + 8 * L);
            p[q] = *(const u32x4*)(QP + m * 512 + 8 * L); }
#pragma unroll
        for (int q = 0; q < 2; ++q) { const int m = m0 + q, b = m / SS, s = m - b * SS; const bool lat = s >= LC; const int t = s - LC;
#pragma unroll
            for (int c = 0; c < 2; ++c) {
                float x[8]; unpack8(a[q][c], x);
                const float rs = RSQ(group_sum<16>(sumsq8(x)) * (1.f / 128.f) + EPS) * QSCALE;
#pragma unroll
                for (int e = 0; e < 8; ++e) x[e] *= rs * gqn[8 * (L & 15) + e];
                *(u32x4*)(QN + (size_t)m * 1024 + c * 512 + 8 * L) = pack8u(x);
                float y[8]; unpack8(k[q][c], y);
                const float rk = RSQ(group_sum<16>(sumsq8(y)) * (1.f / 128.f) + EPS);
#pragma unroll
                for (int e = 0; e < 8; ++e) y[e] *= rk * gkn[8 * (L & 15) + e];
                *(u32x4*)(KV + (size_t)m * 2048 + c * 512 + 8 * L) = pack8u(y); }
            {   float x[8]; unpack8(p[q], x);
                const float rs = RSQ(group_sum<8>(sumsq8(x)) * (1.f / 64.f) + EPS);
#pragma unroll
                for (int e = 0; e < 8; ++e) x[e] *= rs * gqr[8 * (L & 7) + e];
                float pr[8];
#pragma unroll
                for (int e = 0; e < 8; ++e) pr[e] = __shfl_xor(x[e], 2);
                if (lat) { const int qt = (L >> 1) & 3, f0 = (L & 1) * 8, pos = (qt < 2) ? (t >> 6) : (t & 63); const float sg = (qt & 1) ? 1.f : -1.f;
#pragma unroll
                    for (int e = 0; e < 8; ++e) x[e] = x[e] * cs[pos * 16 + f0 + e] + sg * pr[e] * sn[pos * 16 + f0 + e]; }
#pragma unroll
                for (int e = 0; e < 8; ++e) x[e] *= QSCALE;
                *(u32x4*)(QP + (size_t)m * 512 + 8 * L) = pack8u(x); }
        }
    }
}
__device__ __forceinline__ void phase_ret_ln3(Ctx& C, int l, bf16_t* OI, const bf16_t* OB) {
    const float* gain = INP(16) + l * 1024;
    const int L = C.lane;
    for (int m0 = C.gw * 2; m0 < MR; m0 += C.ngw * 2) {
        u32x4 a[2][2], bb[2][2];
#pragma unroll
        for (int q = 0; q < 2; ++q)
#pragma unroll
            for (int c = 0; c < 2; ++c) { a[q][c] = *(const u32x4*)(OI + (size_t)(m0 + q) * 1024 + c * 512 + 8 * L); bb[q][c] = *(const u32x4*)(OB + (size_t)(m0 + q) * 1024 + c * 512 + 8 * L); }
#pragma unroll
        for (int q = 0; q < 2; ++q)
#pragma unroll
            for (int c = 0; c < 2; ++c) { float x[8], y[8]; unpack8(a[q][c], x); unpack8(bb[q][c], y);
                float s = 0.f;
#pragma unroll
                for (int e = 0; e < 8; ++e) { x[e] += y[e]; s += x[e]; }
                const float mean = group_sum<32>(s) * (1.f / 256.f);
                float v = 0.f;
#pragma unroll
                for (int e = 0; e < 8; ++e) { x[e] -= mean; v += x[e] * x[e]; }
                const float rstd = RSQ(group_sum<32>(v) * (1.f / 256.f) + EPS);
#pragma unroll
                for (int e = 0; e < 8; ++e) x[e] *= rstd * gain[c * 512 + 8 * L + e];
                *(u32x4*)(OI + (size_t)(m0 + q) * 1024 + c * 512 + 8 * L) = pack8u(x); }
    }
}

__device__ __forceinline__ void phase_zsum(Ctx& C, const bf16_t* ZP, bf16_t* Z) {
    const int gt = C.bid * NTHR + C.tid, ngt = C.G * NTHR;
    for (int it = gt; it < 1024 * 128; it += ngt) { const int r = it >> 7, c0 = (it & 127) * 8, b = r >> 8, s = r & 255;
        const u32x4 a = *(const u32x4*)(ZP + (size_t)r * 1024 + c0), bq = *(const u32x4*)(ZP + (size_t)(1024 + r) * 1024 + c0), cq = *(const u32x4*)(ZP + (size_t)(2048 + r) * 1024 + c0);
        float x[8], y[8], z[8]; unpack8(a, x); unpack8(bq, y); unpack8(cq, z);
#pragma unroll
        for (int e = 0; e < 8; ++e) x[e] += y[e] + z[e];
        *(u32x4*)(Z + (size_t)(b * SS + s) * 1024 + c0) = pack8u(x); }
}

typedef float f32x16 __attribute__((ext_vector_type(16)));
typedef short v4i16_t __attribute__((ext_vector_type(4)));
constexpr int AT_KP = 400, AT_VP = 320;
constexpr int AT_KB = 64 * AT_KP, AT_VB = 64 * AT_VP, AT_STG = AT_KB + AT_VB, AT_WSF = 2 * AT_STG;
__device__ __forceinline__ int crow(int r, int hi) { return (r & 3) + 8 * (r >> 2) + 4 * hi; }
__device__ __forceinline__ bf16x8 pack8(float a, float b, float c, float d, float e, float f, float g, float h) {
    u32x4 w; w.x = pg8::cvt_pk_bf16(a, b); w.y = pg8::cvt_pk_bf16(c, d); w.z = pg8::cvt_pk_bf16(e, f); w.w = pg8::cvt_pk_bf16(g, h); return __builtin_bit_cast(bf16x8, w); }
__device__ __forceinline__ bf16x8 tr2(LAS unsigned char* p0, LAS unsigned char* p1) {
    const v4i16_t lo = __builtin_amdgcn_ds_read_tr16_b64_v4i16((LAS v4i16_t*)p0), hi = __builtin_amdgcn_ds_read_tr16_b64_v4i16((LAS v4i16_t*)p1);
    return (bf16x8){lo[0], lo[1], lo[2], lo[3], hi[0], hi[1], hi[2], hi[3]}; }

__device__ __forceinline__ void phase_attn(Ctx& C, int l, bool with_ctx, bf16_t* QN, const bf16_t* QP, const bf16_t* KV, const bf16_t* MD) {
    const float* gqn = INP(21) + l * 128; const float* gqr = INP(22) + l * 64; const float* csm = C.ctl + CT_ROPEM;
    const int lane = C.lane, r32 = lane & 31, hi = lane >> 5, wave = C.wave, tid = C.tid;
    LAS unsigned char* lds = C.lds;
    LAS float* wsf = (LAS float*)(lds + AT_WSF + wave * 128);
    const int nunits = 512 + (with_ctx ? 32 : 0);
    const int rowA = tid >> 4, ccA = tid & 15, rowR = tid >> 3, ccR = tid & 7;
    const int i16 = lane & 15, q4 = i16 >> 2, p4 = i16 & 3, g1 = (lane >> 4) & 1;
    const int vb = AT_KB + (4 * hi + q4) * AT_VP + (16 * g1 + 4 * p4) * 2;
    const int wK = rowA * AT_KP + ccA * 16, wR = rowR * AT_KP + 256 + ccR * 16, wV = AT_KB + rowA * AT_VP + ccA * 16;
    for (int un = C.bid; un < nunits; un += C.G) {
        int bh, qb, isctx;
        if (un < 512) { const int x = un & 7, jj = un >> 3; bh = x * 4 + (jj >> 4); qb = jj & 15; isctx = 0; } else { bh = un - 512; qb = 0; isctx = 1; }
        const int b = bh >> 3, h = bh & 7;
        const size_t kb0 = (size_t)b * SS;
        const size_t m0 = kb0 + (isctx ? 0 : LC + qb * 256) + wave * 32;
        const int NT = (isctx ? LC : SS) / 64;
        bf16x8 qf[12];
        {   const bf16_t* qn = QN + (m0 + r32) * 1024 + h * 128 + hi * 8; const bf16_t* qp = QP + (m0 + r32) * 512 + h * 64 + hi * 8;
#pragma unroll
            for (int s = 0; s < 8; ++s) qf[s] = *(const bf16x8*)(qn + s * 16);
#pragma unroll
            for (int s = 0; s < 4; ++s) qf[8 + s] = *(const bf16x8*)(qp + s * 16); }
        {
            int hq = hi; asm volatile("" : "+v"(hq));
            float ssn = 0.f, ssr = 0.f;
#pragma unroll
            for (int s = 0; s < 12; ++s) { float x[8]; unpack8(__builtin_bit_cast(u32x4, qf[s]), x); const float q = sumsq8(x); if (s < 8) ssn += q; else ssr += q; }
            ssn += __shfl_xor(ssn, 32); ssr += __shfl_xor(ssr, 32);
            const float rn = RSQ(ssn * (1.f / 128.f) + EPS) * QSCALE, rr = RSQ(ssr * (1.f / 64.f) + EPS);
#pragma unroll
            for (int s = 0; s < 8; ++s) { float x[8]; unpack8(__builtin_bit_cast(u32x4, qf[s]), x);
                const f32x4 ga = *(const f32x4*)(gqn + 16 * s + 8 * hq), gb = *(const f32x4*)(gqn + 16 * s + 8 * hq + 4);
                x[0] *= rn * ga[0]; x[1] *= rn * ga[1]; x[2] *= rn * ga[2]; x[3] *= rn * ga[3]; x[4] *= rn * gb[0]; x[5] *= rn * gb[1]; x[6] *= rn * gb[2]; x[7] *= rn * gb[3];
                qf[s] = __builtin_bit_cast(bf16x8, pack8u(x)); }
            const int tq = qb * 256 + wave * 32 + r32;
#pragma unroll
            for (int pr = 0; pr < 2; ++pr) {
                float xa[8], xb[8]; unpack8(__builtin_bit_cast(u32x4, qf[8 + 2 * pr]), xa); unpack8(__builtin_bit_cast(u32x4, qf[9 + 2 * pr]), xb);
#pragma unroll
                for (int j = 0; j < 8; ++j) { xa[j] *= rr * gqr[32 * pr + 8 * hq + j]; xb[j] *= rr * gqr[32 * pr + 16 + 8 * hq + j]; }
                if (!isctx) { const int pos = pr ? (tq & 63) : (tq >> 6);
#pragma unroll
                    for (int j = 0; j < 8; ++j) { const float c = csm[pos * 16 + 8 * hq + j], sv = csm[1024 + pos * 16 + 8 * hq + j]; const float a = xa[j] * c - xb[j] * sv, bq = xb[j] * c + xa[j] * sv; xa[j] = a; xb[j] = bq; } }
#pragma unroll
                for (int j = 0; j < 8; ++j) { xa[j] *= QSCALE; xb[j] *= QSCALE; }
                qf[8 + 2 * pr] = __builtin_bit_cast(bf16x8, pack8u(xa)); qf[9 + 2 * pr] = __builtin_bit_cast(bf16x8, pack8u(xb)); }
        }
        f32x16 o[4];
#pragma unroll
        for (int d = 0; d < 4; ++d)
#pragma unroll
            for (int r = 0; r < 16; ++r) o[d][r] = 0.f;
        float mrun = -1e30f, lrun = 0.f;
        u32x4 kn0, kn1, kr0, vv0, vv1;
        const unsigned kvo = (unsigned)(((kb0 + rowA) * 2048 + h * 128 + ccA * 8) * 2);
        const unsigned kro = (unsigned)(((kb0 + rowR) * 768 + 640 + ccR * 8) * 2);
#define AT_LOAD(t) do { const char* kp_ = (const char*)KV + (size_t)(t) * (64 * 2048 * 2); kn0 = *(const u32x4*)(kp_ + kvo); kn1 = *(const u32x4*)(kp_ + 32 * 2048 * 2 + kvo); vv0 = *(const u32x4*)(kp_ + 1024 * 2 + kvo); vv1 = *(const u32x4*)(kp_ + (32 * 2048 + 1024) * 2 + kvo); \
        kr0 = *(const u32x4*)((const char*)MD + (size_t)(t) * (64 * 768 * 2) + kro); } while (0)
#define AT_WRITE(sb) do { int sb_ = (sb); asm volatile("" : "+s"(sb_)); LAS unsigned char* s_ = lds + sb_;     \
        *(LAS u32x4*)(s_ + wK) = kn0; *(LAS u32x4*)(s_ + wK + 32 * AT_KP) = kn1; \
        *(LAS u32x4*)(s_ + wR) = kr0; *(LAS u32x4*)(s_ + wV) = vv0; *(LAS u32x4*)(s_ + wV + 32 * AT_VP) = vv1; } while (0)
#define AT_QK(sbv) do { _Pragma("unroll") for (int r = 0; r < 16; ++r) { p0[r] = 0.f; p1[r] = 0.f; } \
        LAS unsigned char* ka = lds + (sbv) + r32 * AT_KP + hi * 16; __builtin_amdgcn_s_setprio(1); \
        _Pragma("unroll") for (int s = 0; s < 12; ++s) { const bf16x8 a0 = *(const LAS bf16x8*)(ka + s * 32), a1 = *(const LAS bf16x8*)(ka + 32 * AT_KP + s * 32); \
            p0 = __builtin_amdgcn_mfma_f32_32x32x16_bf16(a0, qf[s], p0, 0, 0, 0); p1 = __builtin_amdgcn_mfma_f32_32x32x16_bf16(a1, qf[s], p1, 0, 0, 0); \
            if ((s & 3) == 3) asm volatile("" ::: "memory"); } \
        __builtin_amdgcn_s_setprio(0); } while (0)
#define AT_SM() do { float rm = fmaxf(p0[0], p1[0]); \
        _Pragma("unroll") for (int r = 1; r < 16; ++r) rm = fmaxf(rm, fmaxf(p0[r], p1[r])); \
        rm = fmaxf(rm, __shfl_xor(rm, 32)); \
        if (__any(rm > mrun + 8.f)) { const float mnew = fmaxf(mrun, rm), alpha = EX2(mrun - mnew); mrun = mnew; lrun *= alpha; \
            if (hi == 0) wsf[r32] = alpha; \
            _Pragma("unroll") for (int r = 0; r < 16; ++r) { const float a = wsf[crow(r, hi)]; _Pragma("unroll") for (int d = 0; d < 4; ++d) o[d][r] *= a; } } \
        float ls = 0.f; \
        _Pragma("unroll") for (int r = 0; r < 16; ++r) { p0[r] = EX2(p0[r] - mrun); p1[r] = EX2(p1[r] - mrun); ls += p0[r] + p1[r]; } \
        lrun += ls; \
        pa0 = pack8(p0[0], p0[1], p0[2], p0[3], p0[4], p0[5], p0[6], p0[7]); pa1 = pack8(p0[8], p0[9], p0[10], p0[11], p0[12], p0[13], p0[14], p0[15]); \
        pa2 = pack8(p1[0], p1[1], p1[2], p1[3], p1[4], p1[5], p1[6], p1[7]); pa3 = pack8(p1[8], p1[9], p1[10], p1[11], p1[12], p1[13], p1[14], p1[15]); } while (0)
#define AT_PV(sbv) do { LAS unsigned char* vp = lds + (sbv) + vb; __builtin_amdgcn_s_setprio(1); \
        _Pragma("unroll") for (int d = 0; d < 4; ++d) o[d] = __builtin_amdgcn_mfma_f32_32x32x16_bf16(pa0, tr2(vp + d * 64, vp + d * 64 + 8 * AT_VP), o[d], 0, 0, 0); \
        asm volatile("" ::: "memory"); \
        _Pragma("unroll") for (int d = 0; d < 4; ++d) o[d] = __builtin_amdgcn_mfma_f32_32x32x16_bf16(pa1, tr2(vp + d * 64 + 16 * AT_VP, vp + d * 64 + 24 * AT_VP), o[d], 0, 0, 0); \
        asm volatile("" ::: "memory"); \
        _Pragma("unroll") for (int d = 0; d < 4; ++d) o[d] = __builtin_amdgcn_mfma_f32_32x32x16_bf16(pa2, tr2(vp + d * 64 + 32 * AT_VP, vp + d * 64 + 40 * AT_VP), o[d], 0, 0, 0); \
        asm volatile("" ::: "memory"); \
        _Pragma("unroll") for (int d = 0; d < 4; ++d) o[d] = __builtin_amdgcn_mfma_f32_32x32x16_bf16(pa3, tr2(vp + d * 64 + 48 * AT_VP, vp + d * 64 + 56 * AT_VP), o[d], 0, 0, 0); \
        asm volatile("" ::: "memory"); \
        __builtin_amdgcn_s_setprio(0); } while (0)
        AT_LOAD(0); AT_WRITE(0);
        __syncthreads();
        bf16x8 pa0, pa1, pa2, pa3;
        if (wave < 4) {
            for (int t = 0; t < NT; ++t) {
                const int sb = (t & 1) * AT_STG;
                if (t + 1 < NT) AT_LOAD(t + 1);
                f32x16 p0, p1;
                AT_QK(sb);
                __syncthreads();
                if (t + 1 < NT) AT_WRITE(AT_STG - sb);
                AT_SM(); AT_PV(sb);
                __syncthreads();
            }
            __syncthreads(); __syncthreads();
        } else {
            for (int t = 0; t <= NT; ++t) {
                const int sb = (t & 1) * AT_STG;
                if (t + 1 < NT) AT_LOAD(t + 1);
                if (t > 0) AT_PV(AT_STG - sb);
                __syncthreads();
                if (t + 1 < NT) AT_WRITE(AT_STG - sb);
                if (t < NT) { f32x16 p0, p1; AT_QK(sb); AT_SM(); }
                __syncthreads();
            }
        }
#undef AT_QK
#undef AT_SM
#undef AT_PV
#undef AT_LOAD
#undef AT_WRITE
        const float ltot = lrun + __shfl_xor(lrun, 32);
        if (hi == 0) wsf[r32] = 1.f / ltot;
        bf16_t* op = QN + (m0 + 4 * hi) * 1024 + h * 128 + r32;
#pragma unroll
        for (int r = 0; r < 16; ++r) { const float inv = wsf[crow(r, hi)];
#pragma unroll
            for (int d = 0; d < 4; ++d) op[d * 32] = (bf16_t)f2bf(o[d][r] * inv);
            op += ((r & 3) == 3) ? 5 * 1024 : 1024; OPAQ_G(op); }
        __syncthreads();
    }
}

constexpr int RI_KP = 528, RI_VP = 576, RI_PTP = 272;
constexpr int RI_A = 0, RI_PT = 128 * RI_VP;
__device__ __forceinline__ void phase_ret_intra(Ctx& C, int l, const bf16_t* RQKV, bf16_t* OI) {
    const int lane = C.lane, r32 = lane & 31, hi = lane >> 5, wave = C.wave, tid = C.tid;
    LAS unsigned char* lds = C.lds;
    const int i16 = lane & 15, q4 = i16 >> 2, p4 = i16 & 3, g1 = (lane >> 4) & 1;
    const int nb = wave & 3, wh = wave >> 2;
    const int srow = tid >> 5, scc = tid & 31;
    for (int un = C.bid; un < NB * 4 * 34; un += C.G) {
        const int c = un % 34, bh = un / 34, b = bh >> 2, h = bh & 3;
        const size_t row0 = (size_t)b * SS + c * 128;
        const float lgf = C.ctl[CT_LG + (l * 2 + 0) * 4 + h], lgb = C.ctl[CT_LG + (l * 2 + 1) * 4 + h];
        const bf16_t* gk = RQKV + (row0 + srow) * 3072 + 1024 + h * 256 + scc * 8;
        u32x4 st[8];
        {   const bf16_t* gp = gk;
#pragma unroll
            for (int j = 0; j < 8; ++j) { st[j] = *(const u32x4*)gp; gp += 16 * 3072; OPAQ_G(gp); } }
#pragma unroll
        for (int j = 0; j < 8; ++j) *(LAS u32x4*)(lds + RI_A + (srow + 16 * j) * RI_KP + scc * 16) = st[j];
        __syncthreads();
        {   const bf16_t* gp = gk + 1024;
#pragma unroll
            for (int j = 0; j < 8; ++j) { st[j] = *(const u32x4*)gp; gp += 16 * 3072; OPAQ_G(gp); } }
        {
            f32x16 x0, x1;
#pragma unroll
            for (int r = 0; r < 16; ++r) { x0[r] = 0.f; x1[r] = 0.f; }
            const bf16_t* gq = RQKV + (row0 + nb * 32 + r32) * 3072 + h * 256 + hi * 8;
            LAS unsigned char* ka = lds + RI_A + (wh * 64 + r32) * RI_KP + hi * 16;
#pragma unroll
            for (int s = 0; s < 16; ++s) { const bf16x8 qf = *(const bf16x8*)(gq + s * 16);
                const bf16x8 a0 = *(const LAS bf16x8*)(ka + s * 32), a1 = *(const LAS bf16x8*)(ka + 32 * RI_KP + s * 32);
                x0 = __builtin_amdgcn_mfma_f32_32x32x16_bf16(a0, qf, x0, 0, 0, 0); x1 = __builtin_amdgcn_mfma_f32_32x32x16_bf16(a1, qf, x1, 0, 0, 0);
                if ((s & 3) == 3) asm volatile("" ::: "memory"); }
            const int n = nb * 32 + r32;
            LAS unsigned char* pt = lds + RI_PT + n * RI_PTP + (wh * 64 + 4 * hi) * 2;
#pragma unroll
            for (int g = 0; g < 4; ++g) { float w0[4], w1[4];
#pragma unroll
                for (int e = 0; e < 4; ++e) { const int m0 = wh * 64 + 8 * g + 4 * hi + e; const float d0 = (float)(n - m0), d1 = d0 - 32.f;
                    const float f0 = EX2(lgf * fmaxf(d0, 0.f)) * fminf(fmaxf(d0 + 1.f, 0.f), 1.f) + EX2(lgb * fmaxf(-d0, 0.f)) * fminf(fmaxf(1.f - d0, 0.f), 1.f);
                    const float f1 = EX2(lgf * fmaxf(d1, 0.f)) * fminf(fmaxf(d1 + 1.f, 0.f), 1.f) + EX2(lgb * fmaxf(-d1, 0.f)) * fminf(fmaxf(1.f - d1, 0.f), 1.f);
                    w0[e] = x0[4 * g + e] * f0; w1[e] = x1[4 * g + e] * f1; }
                u32x2 o0, o1; o0.x = pg8::cvt_pk_bf16(w0[0], w0[1]); o0.y = pg8::cvt_pk_bf16(w0[2], w0[3]); o1.x = pg8::cvt_pk_bf16(w1[0], w1[1]); o1.y = pg8::cvt_pk_bf16(w1[2], w1[3]);
                *(LAS u32x2*)(pt + g * 16) = o0; *(LAS u32x2*)(pt + 64 + g * 16) = o1; }
        }
        __syncthreads();
#pragma unroll
        for (int j = 0; j < 8; ++j) *(LAS u32x4*)(lds + RI_A + (srow + 16 * j) * RI_VP + scc * 16) = st[j];
        __syncthreads();
        {
            f32x16 o[4];
#pragma unroll
            for (int d = 0; d < 4; ++d)
#pragma unroll
                for (int r = 0; r < 16; ++r) o[d][r] = 0.f;
            bf16x8 pa[8];
            LAS unsigned char* pr = lds + RI_PT + (nb * 32 + r32) * RI_PTP + hi * 16;
#pragma unroll
            for (int s = 0; s < 8; ++s) pa[s] = *(const LAS bf16x8*)(pr + s * 32);
            LAS unsigned char* vp = lds + RI_A + (8 * hi + q4) * RI_VP + (wh * 128 + 16 * g1 + 4 * p4) * 2;
#pragma unroll
            for (int d = 0; d < 4; ++d) {
#pragma unroll
                for (int s = 0; s < 8; ++s) o[d] = __builtin_amdgcn_mfma_f32_32x32x16_bf16(pa[s], tr2(vp + d * 64 + s * 16 * RI_VP, vp + d * 64 + (s * 16 + 4) * RI_VP), o[d], 0, 0, 0);
                asm volatile("" ::: "memory"); }
            bf16_t* op = OI + (row0 + nb * 32 + 4 * hi) * 1024 + h * 256 + wh * 128 + r32;
#pragma unroll
            for (int r = 0; r < 16; ++r) {
#pragma unroll
                for (int d = 0; d < 4; ++d) op[d * 32] = (bf16_t)f2bf(o[d][r]);
                op += ((r & 3) == 3) ? 5 * 1024 : 1024; OPAQ_G(op); }
        }
        __syncthreads();
    }
}

constexpr int RC_KT = 0, RC_KTP = 576, RC_VT = 128 * 576, RC_VTP = 64, RC_ST = RC_VT + 128 * 64, RC_STP = 528, RC_XO = RC_ST + 32 * 528, RC_END = RC_XO + 16384;
static_assert(RC_END <= 131072, "R-chain LDS");
__device__ __forceinline__ void phase_ret_chain(Ctx& C, int l, const bf16_t* RQKV, bf16_t* OI, bf16_t* OB) {
    const int lane = C.lane, r32 = lane & 31, hi = lane >> 5, wave = C.wave, tid = C.tid;
    LAS unsigned char* lds = C.lds;
    const int i16 = lane & 15, q4 = i16 >> 2, p4 = i16 & 3, g1 = (lane >> 4) & 1;
    const int nb = wave & 3, dh = wave >> 2;
    const int srow = tid >> 5, scc = tid & 31, vrow = tid >> 2, vcc = tid & 3;
    for (int un = C.bid; un < 256; un += C.G) {
        const int x = un & 7, j8 = un >> 3, bhd = x * 4 + (j8 >> 3), sl = j8 & 7, b = bhd >> 3, h = (bhd >> 1) & 3, dir = bhd & 1;
        const float lg = C.ctl[CT_LG + (l * 2 + dir) * 4 + h];
        const float cdec = EX2(lg * 128.f);
        const float vdec = dir ? EX2(lg * (float)vrow) : EX2(lg * (float)(127 - vrow));
        f32x16 sacc;
#pragma unroll
        for (int r = 0; r < 16; ++r) sacc[r] = 0.f;
        for (int i = tid; i < 32 * RC_STP / 16; i += NTHR) *(LAS u32x4*)(lds + RC_ST + i * 16) = (u32x4){0u, 0u, 0u, 0u};
        u32x4 st[8]; u32x4 sv;
#define RC_LOAD(cc_) do { const size_t r0_ = (size_t)b * SS + (cc_) * 128; const bf16_t* gk_ = RQKV + (r0_ + srow) * 3072 + 1024 + h * 256 + scc * 8; \
        _Pragma("unroll") for (int j = 0; j < 8; ++j) { st[j] = *(const u32x4*)gk_; gk_ += 16 * 3072; OPAQ_G(gk_); } \
        sv = *(const u32x4*)(RQKV + (r0_ + vrow) * 3072 + 2048 + h * 256 + sl * 32 + vcc * 8); } while (0)
#define RC_WRITE() do { _Pragma("unroll") for (int j = 0; j < 8; ++j) *(LAS u32x4*)(lds + RC_KT + (srow + 16 * j) * RC_KTP + scc * 16) = st[j]; \
        u32x4 w_; w_.x = pg8::cvt_pk_bf16(lo_bf(sv.x) * vdec, hi_bf(sv.x) * vdec); w_.y = pg8::cvt_pk_bf16(lo_bf(sv.y) * vdec, hi_bf(sv.y) * vdec); \
        w_.z = pg8::cvt_pk_bf16(lo_bf(sv.z) * vdec, hi_bf(sv.z) * vdec); w_.w = pg8::cvt_pk_bf16(lo_bf(sv.w) * vdec, hi_bf(sv.w) * vdec); \
        *(LAS u32x4*)(lds + RC_VT + vrow * RC_VTP + vcc * 16) = w_; } while (0)
        bf16x8 qa[8];
#define RC_QLOAD(dst, cc_) do { const bf16_t* gq_ = RQKV + ((size_t)b * SS + (cc_) * 128 + nb * 32 + r32) * 3072 + h * 256 + dh * 128 + hi * 8; \
        _Pragma("unroll") for (int s = 0; s < 8; ++s) dst[s] = *(const bf16x8*)(gq_ + s * 16); } while (0)
        {   const int c0 = dir ? 1 : 0, c1 = dir ? 0 : 1; RC_LOAD(c0); RC_WRITE(); RC_QLOAD(qa, c0); RC_LOAD(c1); }
        __syncthreads();
        for (int i = 0; i < 34; ++i) {
            const int c = dir ? ((i < 2) ? (1 - i) : (35 - i)) : i;
            const size_t r0 = (size_t)b * SS + c * 128;
            const int cn = (i + 1 < 34) ? (dir ? ((i + 1 < 2) ? (1 - (i + 1)) : (35 - (i + 1))) : (i + 1)) : c;
            unsigned short oiv[8];
            if (dir == 0) { const bf16_t* ip = OI + (r0 + nb * 32 + 16 * dh + 4 * hi) * 1024 + h * 256 + sl * 32 + r32;
#pragma unroll
                for (int r = 0; r < 8; ++r) oiv[r] = ip[(size_t)((r & 3) + 8 * (r >> 2)) * 1024]; }
            f32x16 oacc;
#pragma unroll
            for (int r = 0; r < 16; ++r) oacc[r] = 0.f;
            {   LAS unsigned char* sb = lds + RC_ST + r32 * RC_STP + (dh * 128 + hi * 8) * 2;
#pragma unroll
                for (int s = 0; s < 8; ++s) { const bf16x8 sbf = *(const LAS bf16x8*)(sb + s * 32);
                    oacc = __builtin_amdgcn_mfma_f32_32x32x16_bf16(qa[s], sbf, oacc, 0, 0, 0); } }
            asm volatile("" ::: "memory");
            RC_QLOAD(qa, cn);
#pragma unroll
            for (int r = 0; r < 16; ++r) sacc[r] *= cdec;
            {   LAS unsigned char* kp = lds + RC_KT + (8 * hi + q4) * RC_KTP + (wave * 32 + 16 * g1 + 4 * p4) * 2;
                LAS unsigned char* vp = lds + RC_VT + (8 * hi + q4) * RC_VTP + (16 * g1 + 4 * p4) * 2;
#pragma unroll
                for (int s = 0; s < 8; ++s) sacc = __builtin_amdgcn_mfma_f32_32x32x16_bf16(tr2(kp + s * 16 * RC_KTP, kp + (s * 16 + 4) * RC_KTP), tr2(vp + s * 16 * RC_VTP, vp + (s * 16 + 4) * RC_VTP), sacc, 0, 0, 0); }
            if (dh) {
#pragma unroll
                for (int r = 0; r < 8; ++r) *(LAS float*)(lds + RC_XO + nb * 4096 + r * 256 + lane * 4) = oacc[r];
            } else {
#pragma unroll
                for (int r = 0; r < 8; ++r) *(LAS float*)(lds + RC_XO + nb * 4096 + (r + 8) * 256 + lane * 4) = oacc[r + 8];
            }
            __syncthreads();
#define RC_OUT(O0, X0) do { bf16_t* op = (dir ? OB : OI) + (r0 + nb * 32 + (O0) + 4 * hi) * 1024 + h * 256 + sl * 32 + r32; \
                float xo[8]; \
                _Pragma("unroll") for (int r = 0; r < 8; ++r) xo[r] = *(const LAS float*)(lds + RC_XO + nb * 4096 + (r + (X0)) * 256 + lane * 4); \
                _Pragma("unroll") for (int r = 0; r < 8; ++r) { const int n = nb * 32 + (O0) + (r & 3) + 8 * (r >> 2) + 4 * hi; \
                    const float qd = dir ? EX2(lg * (float)(128 - n)) : EX2(lg * (float)(n + 1)); \
                    float v = (oacc[r + (X0)] + xo[r]) * qd; \
                    if (dir == 0) v += bf2f(oiv[r]); \
                    *op = (bf16_t)f2bf(v); \
                    op += ((r & 3) == 3) ? 5 * 1024 : 1024; OPAQ_G(op); } } while (0)
            if (dh) RC_OUT(16, 8); else RC_OUT(0, 0);
#undef RC_OUT
            {   LAS unsigned char* sp = lds + RC_ST + r32 * RC_STP + (wave * 32 + 4 * hi) * 2;
#pragma unroll
                for (int g = 0; g < 4; ++g) { u32x2 o2; o2.x = pg8::cvt_pk_bf16(sacc[4 * g], sacc[4 * g + 1]); o2.y = pg8::cvt_pk_bf16(sacc[4 * g + 2], sacc[4 * g + 3]); *(LAS u32x2*)(sp + g * 16) = o2; } }
            if (i + 1 < 34) RC_WRITE();
            if (i + 2 < 34) { const int c2 = dir ? ((i + 2 < 2) ? (1 - (i + 2)) : (35 - (i + 2))) : (i + 2); RC_LOAD(c2); }
            __syncthreads();
        }
#undef RC_QLOAD
#undef RC_LOAD
#undef RC_WRITE
    }
}
__device__ __forceinline__ void phase_ret_ln2(Ctx& C, int l, bf16_t* OI, const bf16_t* OB) {
    const float* gain = INP(16) + l * 1024;
    for (int m = C.gw; m < MR; m += C.ngw) {
#pragma unroll
        for (int h = 0; h < 4; ++h) { bf16_t* p = OI + (size_t)m * 1024 + h * 256 + C.lane * 4;
            const u32x2 w = *(const u32x2*)p, w2 = *(const u32x2*)(OB + (size_t)m * 1024 + h * 256 + C.lane * 4);
            float x0 = lo_bf(w.x) + lo_bf(w2.x), x1 = hi_bf(w.x) + hi_bf(w2.x), x2 = lo_bf(w.y) + lo_bf(w2.y), x3 = hi_bf(w.y) + hi_bf(w2.y);
            const float mean = wave_sum((x0 + x1) + (x2 + x3)) * (1.f / 256.f);
            x0 -= mean; x1 -= mean; x2 -= mean; x3 -= mean;
            const float var = wave_sum((x0 * x0 + x1 * x1) + (x2 * x2 + x3 * x3)) * (1.f / 256.f);
            const float rstd = RSQ(var + EPS);
            const f32x4 g = *(const f32x4*)(gain + h * 256 + C.lane * 4);
            u32x2 o; o.x = pk2(x0 * rstd * g.x, x1 * rstd * g.y); o.y = pk2(x2 * rstd * g.z, x3 * rstd * g.w); *(u32x2*)p = o; }
    }
}

constexpr int LR_UP = 272;
constexpr int LR_CP = 272;
constexpr int LR_U = 0, LR_LA = 128 * LR_UP, LR_BC = LR_LA + 128 * LR_CP, LR_Y0 = LR_BC + 128 * LR_CP, LR_XS = LR_Y0 + 128 * LR_CP, LR_END = LR_XS + 4096;
static_assert(LR_END <= 147456 - 1024, "fused LRU LDS");
__device__ __forceinline__ void phase_lru_fused(Ctx& C, int l, const bf16_t* XA, const bf16_t* WTL, bf16_t* Y0, f16_t* CAF, f16_t* CAB, float* SUM) {
    const int lane = C.lane, r32 = lane & 31, hi = lane >> 5, wave = C.wave, tid = C.tid;
    LAS unsigned char* lds = C.lds;
    const float* cw = INP(8) + l * 4 * 1024; const float* cb = INP(9) + l * 1024;
    const int rb = wave & 3, cgp = wave >> 2;
    for (int un = C.bid; un < NB * 8 * 34; un += C.G) {
        const int sg = un % 34, bn = un / 34, b = bn >> 3, n = bn & 7;
        const int R0 = b * SS + sg * 128, lo = (sg < 2) ? b * SS : b * SS + LC, hi_ = (sg < 2) ? b * SS + LC : (b + 1) * SS;
#pragma unroll
        for (int j = 0; j < 4; ++j) { const int item = tid + 512 * j, row = item >> 4, cc = item & 15, ch0 = n * 128 + cc * 8;
            float a[8];
            {   const f32x4 c0 = *(const f32x4*)(cb + ch0), c1 = *(const f32x4*)(cb + ch0 + 4); a[0] = c0[0]; a[1] = c0[1]; a[2] = c0[2]; a[3] = c0[3]; a[4] = c1[0]; a[5] = c1[1]; a[6] = c1[2]; a[7] = c1[3]; }
#pragma unroll
            for (int t = 0; t < 4; ++t) { const int rr = R0 + row + t - 2;
                const f32x4 wA = *(const f32x4*)(cw + t * 1024 + ch0), wB = *(const f32x4*)(cw + t * 1024 + ch0 + 4);
                if (rr >= lo && rr < hi_) { const u32x4 xv = *(const u32x4*)(XA + (size_t)rr * 1024 + ch0);
                    a[0] += wA[0] * lo_bf(xv.x); a[1] += wA[1] * hi_bf(xv.x); a[2] += wA[2] * lo_bf(xv.y); a[3] += wA[3] * hi_bf(xv.y);
                    a[4] += wB[0] * lo_bf(xv.z); a[5] += wB[1] * hi_bf(xv.z); a[6] += wB[2] * lo_bf(xv.w); a[7] += wB[3] * hi_bf(xv.w); } }
            *(LAS u32x4*)(lds + LR_U + row * LR_UP + cc * 16) = pack8u(a); }
        __syncthreads();
        bf16x8 af[8];
        {   LAS unsigned char* ua = lds + LR_U + (rb * 32 + r32) * LR_UP + hi * 16;
#pragma unroll
            for (int s = 0; s < 8; ++s) af[s] = *(const LAS bf16x8*)(ua + s * 32); }
        for (int d = 0; d < 2; ++d) {
            f32x16 aR[2], aI[2];
#pragma unroll
            for (int q = 0; q < 2; ++q)
#pragma unroll
                for (int r = 0; r < 16; ++r) { aR[q][r] = 0.f; aI[q][r] = 0.f; }
            {   const bf16_t* wb = WTL + ((size_t)d * 2048 + n * 256 + cgp * 64 + r32) * 256 + (n & 1) * 128 + hi * 8;
#pragma unroll
                for (int s = 0; s < 8; ++s) {
                    const bf16x8 b0 = *(const bf16x8*)(wb + s * 16), b1 = *(const bf16x8*)(wb + 32 * 256 + s * 16), b2 = *(const bf16x8*)(wb + 128 * 256 + s * 16), b3 = *(const bf16x8*)(wb + 160 * 256 + s * 16);
                    aR[0] = __builtin_amdgcn_mfma_f32_32x32x16_bf16(af[s], b0, aR[0], 0, 0, 0); aR[1] = __builtin_amdgcn_mfma_f32_32x32x16_bf16(af[s], b1, aR[1], 0, 0, 0);
                    aI[0] = __builtin_amdgcn_mfma_f32_32x32x16_bf16(af[s], b2, aI[0], 0, 0, 0); aI[1] = __builtin_amdgcn_mfma_f32_32x32x16_bf16(af[s], b3, aI[1], 0, 0, 0);
                    if ((s & 3) == 3) asm volatile("" ::: "memory"); } }
#pragma unroll
            for (int q = 0; q < 2; ++q) { const int chl = cgp * 64 + q * 32 + r32, ch = n * 128 + chl;
                const float bav = INP(11)[(l * 2 + d) * 1024 + ch], bxv = INP(13)[(l * 2 + d) * 1024 + ch], spv = C.ctl[CT_SP + (l * 2 + d) * 1024 + ch] * (-8.f);
#pragma unroll
                for (int g = 0; g < 4; ++g) { f16_t lav[4], bcv[4];
#pragma unroll
                    for (int e = 0; e < 4; ++e) { const int r = 4 * g + e, t = rb * 32 + crow(r, hi);
                        const float uu = bf2f(*(const LAS bf16_t*)(lds + LR_U + t * LR_UP + chl * 2));
                        const float rg = sigmoidf_(aR[q][r] + bav), ig = sigmoidf_(aI[q][r] + bxv);
                        const float loga = rg * spv, y2 = 2.f * loga;
                        const float om = -y2 * (1.f + y2 * 0.5f * (1.f + y2 * (1.f / 3.f) * (1.f + y2 * 0.25f * (1.f + y2 * 0.2f))));
                        const float bb = SQRT(fmaxf(om, 0.f)) * (ig * uu);
                        lav[e] = (f16_t)(loga * LOG2E); bcv[e] = (f16_t)bb; }
                    typedef f16_t f16x4 __attribute__((ext_vector_type(4)));
                    const int tb = rb * 32 + 8 * g + 4 * hi;
                    *(LAS f16x4*)(lds + LR_LA + chl * LR_CP + tb * 2) = (f16x4){lav[0], lav[1], lav[2], lav[3]};
                    *(LAS f16x4*)(lds + LR_BC + chl * LR_CP + tb * 2) = (f16x4){bcv[0], bcv[1], bcv[2], bcv[3]}; } }
            __syncthreads();
            const int chl = tid & 127, sub = tid >> 7;
            const int tlo = d ? (96 - sub * 32) : (sub * 32);
            f16x8 lv[4], bv[4];
#pragma unroll
            for (int k = 0; k < 4; ++k) { lv[k] = *(const LAS f16x8*)(lds + LR_LA + chl * LR_CP + tlo * 2 + k * 16); bv[k] = *(const LAS f16x8*)(lds + LR_BC + chl * LR_CP + tlo * 2 + k * 16); }
            float av[32], hv[32];
            float A = 1.f, H = 0.f;
#define LR_P1(DD) do { _Pragma("unroll") for (int i = 0; i < 32; ++i) { constexpr int dd_ = DD; const int j = dd_ ? (31 - i) : i; \
                av[j] = EX2((float)lv[j >> 3][j & 7]); H = av[j] * H + (float)bv[j >> 3][j & 7]; A *= av[j]; } } while (0)
            if (d) LR_P1(1); else LR_P1(0);
#undef LR_P1
            *(LAS f32x2*)(lds + LR_XS + (sub * 128 + chl) * 8) = (f32x2){A, H};
            __syncthreads();
            {   A = 1.f; H = 0.f;
                for (int p = 0; p < sub; ++p) { const f32x2 v = *(const LAS f32x2*)(lds + LR_XS + (p * 128 + chl) * 8); H = v.x * H + v.y; A *= v.x; }
                f16_t* cap = (d ? CAB : CAF) + (size_t)(R0 + tlo) * 1024 + n * 128 + chl;
                bf16_t* y0p = Y0 + (size_t)(R0 + tlo) * 1024 + n * 128 + chl;
                LAS unsigned char* ys = lds + LR_Y0 + chl * LR_CP + tlo * 2;
#define LR_P2(DD) do { _Pragma("unroll") for (int i = 0; i < 32; ++i) { constexpr int dd_ = DD; const int j = dd_ ? (31 - i) : i; \
                H = av[j] * H + (float)bv[j >> 3][j & 7]; A *= av[j]; cap[(size_t)j * 1024] = (f16_t)A; hv[j] = H; } } while (0)
                if (d == 0) { LR_P2(0);
#pragma unroll
                    for (int k = 0; k < 4; ++k) { u32x4 w; w.x = pk2(hv[8 * k], hv[8 * k + 1]); w.y = pk2(hv[8 * k + 2], hv[8 * k + 3]); w.z = pk2(hv[8 * k + 4], hv[8 * k + 5]); w.w = pk2(hv[8 * k + 6], hv[8 * k + 7]); *(LAS u32x4*)(ys + k * 16) = w; }
                } else { LR_P2(1);
#pragma unroll
                    for (int k = 0; k < 4; ++k) { const u32x4 yv = *(const LAS u32x4*)(ys + k * 16); float y[8]; unpack8(yv, y);
#pragma unroll
                        for (int e = 0; e < 8; ++e) y0p[(size_t)(8 * k + e) * 1024] = (bf16_t)f2bf(y[e] + hv[8 * k + e]); }
                }
#undef LR_P2
                if (sub == 3) *(f32x2*)(SUM + ((size_t)((d * NB + b) * 34 + sg) * 1024 + n * 128 + chl) * 2) = (f32x2){A, H}; }
            __syncthreads();
        }
    }
    {   const int first = (C.G > 64) ? 64 : 0;
        if (C.bid >= first) { Ctx C2 = C; C2.gw = (C.bid - first) * NWAVES + C.wave; C2.ngw = (C.G - first) * NWAVES; C2.rot = 0; phase_wconv_late(C2, l); } }
}
__device__ __forceinline__ void phase_lru_carry(Ctx& C, const float* SUM, float* HIN) {
    const int gt = C.bid * NTHR + C.tid, ngt = C.G * NTHR;
    for (int it = gt; it < 2 * NB * 1024; it += ngt) { const int ch = it & 1023, b = (it >> 10) & 3, d = it >> 12;
        const float* sp = SUM + ((size_t)((d * NB + b) * 34) * 1024 + ch) * 2; float* hp = HIN + (size_t)((d * NB + b) * 34) * 1024 + ch;
        f32x2 v[34];
#pragma unroll
        for (int p = 0; p < 34; ++p) v[p] = *(const f32x2*)(sp + (size_t)p * 2048);
        float h = 0.f;
        if (d == 0) {
#pragma unroll
            for (int p = 0; p < 34; ++p) { hp[(size_t)p * 1024] = h; h = v[p].x * h + v[p].y; }
        } else {
#pragma unroll
            for (int p = 0; p < 34; ++p) { const int ps = (p < 2) ? (1 - p) : (35 - p); hp[(size_t)ps * 1024] = h; h = v[ps].x * h + v[ps].y; }
        }
    }
}

#ifdef PROBE_TS
#define GSYNC(g) do { { GASP unsigned char* w_ = (GASP unsigned char*)prm.ws; asm volatile("" : "+s"(w_)); xcd_barrier((unsigned*)(unsigned char*)(w_ + WS_BAR), (volatile LAS unsigned*)(ldsb + LDS_ST)); } if (blockIdx.x == 0 && threadIdx.x == 0) { unsigned long long* ts_ = (unsigned long long*)(prm.ws + 8192); const unsigned long long now_ = __builtin_amdgcn_s_memrealtime(); \
    ts_[1 + (g)] += now_ - ts_[0]; ts_[0] = now_; } } while (0)
#else
#define GSYNC(g) do { GASP unsigned char* w_ = (GASP unsigned char*)prm.ws; asm volatile("" : "+s"(w_)); xcd_barrier((unsigned*)(unsigned char*)(w_ + WS_BAR), (volatile LAS unsigned*)(ldsb + LDS_ST)); } while (0)
#endif
#define CTX Ctx C = mkctx(ldsb)
#define WSB wsp_(C.ws)
#define bYB ((bf16_t*)(WSB + AR_YB))
#define bXA ((bf16_t*)(WSB + AR_XA))
#define bMD ((bf16_t*)(WSB + AR_MD))
#define bRQKV ((bf16_t*)(WSB + AR_RQKV))
#define bKV ((bf16_t*)(WSB + AR_KV))
#define bQN ((bf16_t*)(WSB + AR_QN))
#define bQP ((bf16_t*)(WSB + AR_QP))
#define bRI ((f16_t*)(WSB + AR_RI))
#define bSUM ((float*)(WSB + AR_SUM))
#define bOB ((bf16_t*)(WSB + AR_OB))
#define bZ ((bf16_t*)(WSB + AR_Z))
#define xc1 ((float*)(WSB + WS_XC1))
template <int l> __device__ __forceinline__ void run_layer(const Params& prm, LAS unsigned char* ldsb) {
        const bool with_ctx = (l == 0); const int lat_only = with_ctx ? 0 : 1;
        { CTX; phase_wconv_early(C, l); }
        if (l == 0) GSYNC(0);
        { CTX; phase_h2(C, l, bYB); }
        GSYNC(1);
        {   CTX;
            ProbPlain P{bYB, (const bf16_t*)(WSB + W_WT1), 1024, 1024, 1024};
            pg8::StaticOrder S; S.init(68, 19, C.G, C.bid, 0);
            EpiG1 E{WSB, C.ctl + CT_ROPER};
            pg8::gemm_phase<EpiG1, ProbPlain, pg8::StaticOrder, true>(C.lds, P, S, E);
        }
        GSYNC(2);
        { CTX; phase_ret_intra(C, l, bRQKV, bYB); }
        {   CTX;
            const int first = (C.G > 64) ? 32 : 0;
            if (C.bid >= first) { C.gw = (C.bid - first) * NWAVES + C.wave; C.ngw = (C.G - first) * NWAVES; phase_md_post2(C, l, bMD); } }
        GSYNC(4);
        { CTX; phase_ret_chain(C, l, bRQKV, bYB, bOB); }
        GSYNC(5);
        { CTX; phase_ret_ln3(C, l, bYB, bOB); }
        {   CTX; ProbPlain P{bMD, (const bf16_t*)(WSB + W_WTQ), 768, 384, 384};
            pg8::StaticOrder S; S.init(68, 6, C.G, C.bid, 0);
            typedef EpiStore3<AR_QN, 1024, AR_QP, 512, AR_QP, 512, 4, 6> Ep; Ep E{WSB};
            pg8::gemm_phase<Ep, ProbPlain, pg8::StaticOrder, true>(C.lds, P, S, E);
        }
        {   CTX; ProbPlain P{bMD + 384, (const bf16_t*)(WSB + W_WTKV), 768, 256, 256};
            pg8::StaticOrder S; S.init(68, 8, C.G, (C.G == 256) ? ((C.bid + 104) & 255) : C.bid, 0);
            EpiKV E{WSB, INP(23) + l * 128, (LAS float*)(C.lds + 131072)};
            pg8::gemm_phase<EpiKV, ProbPlain, pg8::StaticOrder, true>(C.lds, P, S, E);
        }
        GSYNC(6);
        { CTX; phase_attn(C, l, with_ctx, bQN, bQP, bKV, bMD); }
        GSYNC(8);
        { CTX; phase_lru_fused(C, l, bXA, (const bf16_t*)(WSB + W_WTL), (bf16_t*)(WSB + AR_Y0), (f16_t*)(WSB + AR_CAF), (f16_t*)(WSB + AR_CAB), bSUM); }
        GSYNC(9);
        { CTX; phase_lru_carry(C, bSUM, (float*)(WSB + AR_HIN)); }
        { CTX; phase_h2(C, l, bXA  ); }
        GSYNC(13);
        {   CTX; ProbG P{WSB, 1024, 1024};
            pg8::StaticOrder S; S.init(lat_only ? 64 : 68, 12, C.G, C.bid, lat_only, with_ctx ? 1 : 0);
            EpiGate E{WSB};
            pg8::gemm_phase<EpiGate, ProbG, pg8::StaticOrder, true>(C.lds, P, S, E);
        }
        GSYNC(14);
        {   CTX; ProbD P{WSB, 1024, 1024};
            pg8::ChainOrder S; S.init(C.G, C.bid, with_ctx ? 1 : 0);
            EpiD E{bZ, WSB + AR_GS + (size_t)C.bid * 131072, (bf16_t*)(WSB + AR_ZP), (const bf16_t*)(WSB + AR_GMC)};
            pg8::gemm_phase<EpiD, ProbD, pg8::ChainOrder, true>(C.lds, P, S, E);
        }
        GSYNC(15);
        if (with_ctx) { { CTX; phase_zsum(C, (const bf16_t*)(WSB + AR_ZP), bZ); } GSYNC(12); }
        {   CTX; ProbPlain P{bZ, (const bf16_t*)(WSB + W_WTO), 1024, 1024, 1024};
            pg8::StaticOrder S; S.init(lat_only ? 64 : 68, 4, C.G, C.bid, lat_only);
            EpiOut E{(l == 0) ? INP(0) : (const float*)C.out, INP(2), C.out, xc1, C.ctl + CT_MOD + l * 5 * 3072};
            pg8::gemm_phase<EpiOut, ProbPlain, pg8::StaticOrder, true>(C.lds, P, S, E);
        }
        GSYNC(16);
    }

__global__ void __launch_bounds__(NTHR) fwd_kernel(Params prm) {
    extern __shared__ __attribute__((aligned(16))) unsigned char lds_raw[];
    cg::grid_group grid = cg::this_grid();
    LAS unsigned char* const ldsb = (LAS unsigned char*)lds_raw;
    if (threadIdx.x < 16) ((LAS unsigned*)(ldsb + LDS_ST))[threadIdx.x] = 0u;
    __syncthreads();
    if (threadIdx.x == 0) (void)xb_add(&((unsigned*)(prm.ws + WS_BAR))[XB_XCNT(xb_xcc_id())], 1u);
    grid.sync();


#ifdef PROBE_TS
    if (blockIdx.x == 0 && threadIdx.x == 0) { unsigned long long* ts_ = (unsigned long long*)(prm.ws + 8192); for (int i = 1; i < 32; ++i) ts_[i] = 0ull; ts_[0] = __builtin_amdgcn_s_memrealtime(); }
#endif
    { CTX; phase_prep(C); }
    run_layer<0>(prm, ldsb);
    run_layer<1>(prm, ldsb);
#ifdef PROBE_TS
    if (blockIdx.x == 0 && threadIdx.x == 0) { const unsigned long long* ts_ = (const unsigned long long*)(prm.ws + 8192); unsigned long long tot = 0ull;
        for (int g = 0; g < 17; ++g) if ((PROBE_TS >> g) & 1u) tot += ts_[1 + g];
        prm.out[0] += (float)(((tot / 100ull) + PROBE_Q / 2) / PROBE_Q * PROBE_Q); }
#endif
}

#undef xc1
#undef bZ
extern "C" void kernel_launch(void* const* d_in, const int* in_sizes, int n_in, void* d_out, int out_size, void* d_ws, size_t ws_size, hipStream_t stream) {
    static int grid = 0;
    if (grid == 0) {
        if (n_in != 29 || out_size != NB * TT * DM || ws_size < WS_END) { fprintf(stderr, "kernel_launch: unexpected shapes (n_in %d out %d ws %zu)\n", n_in, out_size, ws_size); grid = -1; return; }
        int dev = 0, cus = 0, per_cu = 0;
        hipGetDevice(&dev);
        hipDeviceGetAttribute(&cus, hipDeviceAttributeMultiprocessorCount, dev);
        if (hipFuncSetAttribute((const void*)fwd_kernel, hipFuncAttributeMaxDynamicSharedMemorySize, LDS_BYTES) != hipSuccess) { fprintf(stderr, "kernel_launch: hipFuncSetAttribute failed\n"); grid = -1; return; }
        if (hipOccupancyMaxActiveBlocksPerMultiprocessor(&per_cu, (const void*)fwd_kernel, NTHR, LDS_BYTES) != hipSuccess || per_cu < 1) { fprintf(stderr, "kernel_launch: occupancy query failed (%d)\n", per_cu); (void)hipGetLastError(); per_cu = 1; }
        grid = cus;
        fprintf(stderr, "kernel_launch: cus %d per_cu %d grid %d\n", cus, per_cu, grid);
    }
    if (grid < 0) return;
    if (hipMemsetAsync((char*)d_ws + WS_BAR, 0, XCD_BAR_WORDS * 4, stream) != hipSuccess) { fprintf(stderr, "kernel_launch: memset failed\n"); return; }
    Params p{};
    for (int i = 0; i < 29; ++i) p.in[i] = (const float*)d_in[i];
    p.out = (float*)d_out; p.ws = (unsigned char*)d_ws;
    void* args[] = {&p};
    hipError_t e = hipLaunchCooperativeKernel((const void*)fwd_kernel, dim3(grid), dim3(NTHR), args, LDS_BYTES, stream);
    if (e != hipSuccess) fprintf(stderr, "cooperative launch failed: %s (grid %d)\n", hipGetErrorString(e), grid);
}
```
